# Optimizing an MI355X kernel written in HIP

```python
import jax, jax.numpy as jnp
from jax import lax
import numpy as np

D_MODEL = 1024
BATCH = 8
SEQ = 8192
DEPTH = 2

GRID_W = 64
CTX_LEN = 256
N_BRANCH = 3
GLA_HEADS = 4
GLA_DK = 64
GLA_DV = 128
GLA_GATE_RANK = 16
GLA_GATE_NORM = 16.0
GLA_CHUNK = 64
MLA_HEADS = 8
MLA_Q_LORA = 256
MLA_KV_LORA = 128
MLA_NOPE = 64
MLA_ROPE = 32
MLA_DV = 64
ROPE_THETA = 10000.0
ROPE_FREQS = MLA_ROPE // 4
Q_BLOCK = 128
SC_W = 512
D_FF = 2816
NORM_EPS = 1e-6
IN_SIZES = (GLA_HEADS * GLA_DK, GLA_HEADS * GLA_DK, GLA_HEADS * GLA_DV, GLA_HEADS * GLA_DV,
            2 * GLA_GATE_RANK, MLA_Q_LORA, MLA_KV_LORA, MLA_ROPE, SC_W, SC_W, SC_W,
            N_BRANCH * D_MODEL)
IN_W = sum(IN_SIZES)

kernel_name = 'hybrid_gla_mla_shortconv_dit'


def rms_norm(x, g):
    xf = x.astype(jnp.float32)
    y = xf * lax.rsqrt(jnp.mean(xf * xf, axis=-1, keepdims=True) + NORM_EPS)
    return (y * g).astype(x.dtype)


def modulate(h, shift, scale):
    return h * (1.0 + scale) + shift


def flip(t):
    return jnp.flip(t, axis=1)


def split_proj(p):
    idx = np.cumsum(IN_SIZES)[:-1].tolist()
    return jnp.split(p, idx, axis=-1)


def dwconv3(u, w):
    L = u.shape[1]
    up = jnp.pad(u, ((0, 0), (1, 1), (0, 0)))
    return up[:, 0:L] * w[0] + up[:, 1:L + 1] * w[1] + up[:, 2:L + 2] * w[2]


def axial_rope(rows):
    row = jnp.repeat(jnp.arange(rows, dtype=jnp.float32), GRID_W)
    col = jnp.tile(jnp.arange(GRID_W, dtype=jnp.float32), rows)
    inv = ROPE_THETA ** (-jnp.arange(ROPE_FREQS, dtype=jnp.float32) / ROPE_FREQS)
    ang = jnp.stack([row[:, None] * inv, col[:, None] * inv], axis=1)
    return jnp.cos(ang), jnp.sin(ang)


def apply_rope(x, cos, sin):
    xr = x.reshape(x.shape[:-1] + (2, 2, ROPE_FREQS)).astype(jnp.float32)
    x0, x1 = xr[..., 0, :], xr[..., 1, :]
    out = jnp.stack([x0 * cos - x1 * sin, x1 * cos + x0 * sin], axis=-2)
    return out.reshape(x.shape).astype(x.dtype)


def gla_heads(t, dh):
    return t.reshape(t.shape[0], t.shape[1], GLA_HEADS, dh)


def gla_log_decay(lr, w2, b2):
    z = (lr @ w2 + b2).astype(jnp.float32)
    return gla_heads(jax.nn.log_sigmoid(z) / GLA_GATE_NORM, GLA_DK)


def gla_chunked(q, k, v, log_a, s0):
    B, L, H, DK = q.shape
    DV = v.shape[-1]
    nc = L // GLA_CHUNK
    to_chunks = lambda t: t.reshape(B, nc, GLA_CHUNK, H, t.shape[-1])
    qc, kc, vc = to_chunks(q), to_chunks(k), to_chunks(v)
    b = jnp.cumsum(to_chunks(log_a).astype(jnp.float32), axis=2)
    b_last = b[:, :, -1:]
    q_in = qc * jnp.exp(b)
    k_in = kc * jnp.exp(-b)
    k_st = kc * jnp.exp(b_last - b)
    lower = jnp.tril(jnp.ones((GLA_CHUNK, GLA_CHUNK), dtype=bool))
    a_intra = jnp.where(lower, jnp.einsum('bnihd,bnjhd->bnhij', q_in, k_in), 0.0)
    o_intra = jnp.einsum('bnhij,bnjhv->bnihv', a_intra, vc)
    u = jnp.einsum('bnjhd,bnjhv->bnhdv', k_st, vc)
    decay = jnp.exp(b_last[:, :, 0])

    def step(s, xs):
        q_n, d_n, u_n = xs
        o_n = jnp.einsum('bihd,bhdv->bihv', q_n, s)
        return d_n[..., None] * s + u_n, o_n

    s_fin, o_inter = lax.scan(step, s0.astype(jnp.float32),
                              (q_in.swapaxes(0, 1), decay.swapaxes(0, 1), u.swapaxes(0, 1)))
    o = o_intra + o_inter.swapaxes(0, 1)
    return o.reshape(B, L, H, DV).astype(v.dtype), s_fin


def gla_final_state(k, v, log_a):
    b = jnp.cumsum(log_a.astype(jnp.float32), axis=1)
    return jnp.einsum('blhd,blhv->bhdv', k * jnp.exp(b[:, -1:] - b), v)


def gla_branch(q_a, k_a, v_a, r_a, alr, lp, s_f0, s_b0):
    B, L = q_a.shape[:2]
    q = gla_heads(q_a, GLA_DK) * GLA_DK ** -0.5
    k = gla_heads(k_a, GLA_DK)
    v = gla_heads(v_a, GLA_DV)
    lr_f, lr_b = jnp.split(alr, 2, axis=-1)
    la_f = gla_log_decay(lr_f, lp['w_gk2'][0], lp['b_gk2'][0])
    la_b = gla_log_decay(lr_b, lp['w_gk2'][1], lp['b_gk2'][1])
    o_f, _ = gla_chunked(q, k, v, la_f, s_f0)
    o_b, _ = gla_chunked(flip(q), flip(k), flip(v), flip(la_b), s_b0)
    o = rms_norm(o_f + flip(o_b), lp['gla_norm_g'].reshape(GLA_HEADS, GLA_DV))
    return (o.reshape(B, L, GLA_HEADS * GLA_DV) * jax.nn.silu(r_a)) @ lp['w_br_a']


def mla_q(cq, lp, rope):
    B, L = cq.shape[:2]
    q = (rms_norm(cq, lp['mla_q_norm_g']) @ lp['w_uq']).reshape(B, L, MLA_HEADS, MLA_NOPE + MLA_ROPE)
    if rope is not None:
        q_rope = apply_rope(q[..., MLA_NOPE:], rope[0][:, None], rope[1][:, None])
        q = jnp.concatenate([q[..., :MLA_NOPE], q_rope], axis=-1)
    return q * (MLA_NOPE + MLA_ROPE) ** -0.5


def mla_kv(ckv, kr, lp, rope):
    B, L = ckv.shape[:2]
    kv = (rms_norm(ckv, lp['mla_kv_norm_g']) @ lp['w_ukv']).reshape(B, L, MLA_HEADS, MLA_NOPE + MLA_DV)
    k_nope, v = kv[..., :MLA_NOPE], kv[..., MLA_NOPE:]
    if rope is not None:
        kr = apply_rope(kr, rope[0], rope[1])
    k_rope = jnp.broadcast_to(kr[:, :, None, :], (B, L, MLA_HEADS, MLA_ROPE))
    return jnp.concatenate([k_nope, k_rope], axis=-1), v


def softmax_attend(q, k, v):
    s = jnp.einsum('bqhd,bkhd->bhqk', q, k).astype(jnp.float32)
    p = jax.nn.softmax(s, axis=-1).astype(v.dtype)
    return jnp.einsum('bhqk,bkhv->bqhv', p, v)


def blocked_attend(q, k, v):
    B, L, H, Dq = q.shape
    qb = q.reshape(B, L // Q_BLOCK, Q_BLOCK, H, Dq).swapaxes(0, 1)
    o = lax.map(lambda qq: softmax_attend(qq, k, v), qb)
    return o.swapaxes(0, 1).reshape(B, L, H, v.shape[-1])


def short_conv_branch(sb, sc, sx, lp):
    return (sb * dwconv3(sc * sx, lp['sc_w'])) @ lp['w_br_c']


def merge_branches(y_a, y_b, y_c, gates, lp):
    g_a, g_b, g_c = jnp.split(jax.nn.sigmoid(gates), N_BRANCH, axis=-1)
    return (g_a * y_a + g_b * y_b + g_c * y_c) @ lp['w_o']


def context_memory(proj_c, lp):
    _, k_a, v_a, _, alr, _, ckv, kr, _, _, _, _ = split_proj(proj_c)
    k = gla_heads(k_a, GLA_DK)
    v = gla_heads(v_a, GLA_DV)
    lr_f, lr_b = jnp.split(alr, 2, axis=-1)
    s_f = gla_final_state(k, v, gla_log_decay(lr_f, lp['w_gk2'][0], lp['b_gk2'][0]))
    s_b = gla_final_state(flip(k), flip(v), flip(gla_log_decay(lr_b, lp['w_gk2'][1], lp['b_gk2'][1])))
    k_m, v_m = mla_kv(ckv, kr, lp, None)
    return (k_m, v_m, s_f, s_b)


def latent_mixers(proj, lp, rope, mem):
    k_ctx, v_ctx, s_f, s_b = mem
    q_a, k_a, v_a, r_a, alr, cq, ckv, kr, sb, sc, sx, gates = split_proj(proj)
    y_a = gla_branch(q_a, k_a, v_a, r_a, alr, lp, s_f, s_b)
    q = mla_q(cq, lp, rope)
    k, v = mla_kv(ckv, kr, lp, rope)
    o = blocked_attend(q, jnp.concatenate([k, k_ctx], axis=1), jnp.concatenate([v, v_ctx], axis=1))
    y_b = o.reshape(o.shape[0], o.shape[1], MLA_HEADS * MLA_DV) @ lp['w_br_b']
    y_c = short_conv_branch(sb, sc, sx, lp)
    return merge_branches(y_a, y_b, y_c, gates, lp)


def context_mixers(proj_c, lp, mem):
    k_ctx, v_ctx, _, _ = mem
    q_a, k_a, v_a, r_a, alr, cq, _, _, sb, sc, sx, gates = split_proj(proj_c)
    zero = jnp.zeros((proj_c.shape[0], GLA_HEADS, GLA_DK, GLA_DV), jnp.float32)
    y_a = gla_branch(q_a, k_a, v_a, r_a, alr, lp, zero, zero)
    o = softmax_attend(mla_q(cq, lp, None), k_ctx, v_ctx)
    y_b = o.reshape(o.shape[0], o.shape[1], MLA_HEADS * MLA_DV) @ lp['w_br_b']
    y_c = short_conv_branch(sb, sc, sx, lp)
    return merge_branches(y_a, y_b, y_c, gates, lp)


def conv_ffn(h, lp):
    g = dwconv3(h @ lp['w_ffn_gate'], lp['ffn_conv_w']) + lp['ffn_conv_b']
    return (jax.nn.silu(g) * (h @ lp['w_ffn_up'])) @ lp['w_ffn_down']


def setup_inputs(seed: int = 0) -> dict:
    key = jax.random.key(seed)
    ks = iter(jax.random.split(key, 32))

    def nrm(shape, scale):
        return jax.random.normal(next(ks), shape, jnp.float32) * scale

    def gain(shape):
        return 1.0 + nrm(shape, 0.05)

    L = DEPTH
    D = D_MODEL
    return {
        'x': nrm((BATCH, SEQ, D), 1.0),
        'c': nrm((BATCH, D), 1.0),
        'ctx': nrm((BATCH, CTX_LEN, D), 1.0),
        'c_ctx': nrm((D,), 1.0),
        'w_ada': nrm((L, D, 6 * D), 0.5 * D ** -0.5),
        'b_ada': nrm((L, 6 * D), 0.02),
        'norm1_g': gain((L, D)),
        'w_in': nrm((L, D, IN_W), D ** -0.5),
        'w_gk2': nrm((L, 2, GLA_GATE_RANK, GLA_HEADS * GLA_DK), GLA_GATE_RANK ** -0.5),
        'b_gk2': nrm((L, 2, GLA_HEADS * GLA_DK), 0.1),
        'gla_norm_g': gain((L, GLA_HEADS * GLA_DV)),
        'mla_q_norm_g': gain((L, MLA_Q_LORA)),
        'w_uq': nrm((L, MLA_Q_LORA, MLA_HEADS * (MLA_NOPE + MLA_ROPE)), MLA_Q_LORA ** -0.5),
        'mla_kv_norm_g': gain((L, MLA_KV_LORA)),
        'w_ukv': nrm((L, MLA_KV_LORA, MLA_HEADS * (MLA_NOPE + MLA_DV)), MLA_KV_LORA ** -0.5),
        'sc_w': nrm((L, 3, SC_W), 3 ** -0.5),
        'w_br_a': nrm((L, GLA_HEADS * GLA_DV, D), (GLA_HEADS * GLA_DV) ** -0.5),
        'w_br_b': nrm((L, MLA_HEADS * MLA_DV, D), (MLA_HEADS * MLA_DV) ** -0.5),
        'w_br_c': nrm((L, SC_W, D), SC_W ** -0.5),
        'w_o': nrm((L, D, D), D ** -0.5),
        'norm2_g': gain((L, D)),
        'w_ffn_gate': nrm((L, D, D_FF), D ** -0.5),
        'w_ffn_up': nrm((L, D, D_FF), D ** -0.5),
        'ffn_conv_w': nrm((L, 3, D_FF), 3 ** -0.5),
        'ffn_conv_b': nrm((L, D_FF), 0.02),
        'w_ffn_down': nrm((L, D_FF, D), D_FF ** -0.5),
        'final_norm_g': gain((D,)),
    }


def reference(x, c, ctx, c_ctx, w_ada, b_ada, norm1_g, w_in, w_gk2, b_gk2, gla_norm_g,
              mla_q_norm_g, w_uq, mla_kv_norm_g, w_ukv, sc_w, w_br_a, w_br_b, w_br_c, w_o,
              norm2_g, w_ffn_gate, w_ffn_up, ffn_conv_w, ffn_conv_b, w_ffn_down, final_norm_g):
    rows = x.shape[1] // GRID_W
    rope = axial_rope(rows)
    xc = ctx
    for l in range(DEPTH):
        last = l == DEPTH - 1
        lp = {
            'w_gk2': w_gk2[l], 'b_gk2': b_gk2[l], 'gla_norm_g': gla_norm_g[l],
            'mla_q_norm_g': mla_q_norm_g[l], 'w_uq': w_uq[l],
            'mla_kv_norm_g': mla_kv_norm_g[l], 'w_ukv': w_ukv[l], 'sc_w': sc_w[l],
            'w_br_a': w_br_a[l], 'w_br_b': w_br_b[l], 'w_br_c': w_br_c[l], 'w_o': w_o[l],
            'w_ffn_gate': w_ffn_gate[l], 'w_ffn_up': w_ffn_up[l], 'ffn_conv_w': ffn_conv_w[l],
            'ffn_conv_b': ffn_conv_b[l], 'w_ffn_down': w_ffn_down[l],
        }
        mod = jax.nn.silu(c) @ w_ada[l] + b_ada[l]
        mod_c = jax.nn.silu(c_ctx) @ w_ada[l] + b_ada[l]
        sh1, sc1, g1, sh2, sc2, g2 = jnp.split(mod[:, None, :], 6, axis=-1)
        sh1c, sc1c, g1c, sh2c, sc2c, g2c = jnp.split(mod_c, 6, axis=-1)
        proj_c = modulate(rms_norm(xc, norm1_g[l]), sh1c, sc1c) @ w_in[l]
        mem = context_memory(proj_c, lp)
        proj = modulate(rms_norm(x, norm1_g[l]), sh1, sc1) @ w_in[l]
        x = x + g1 * latent_mixers(proj, lp, rope, mem)
        if not last:
            xc = xc + g1c * context_mixers(proj_c, lp, mem)
        x = x + g2 * conv_ffn(modulate(rms_norm(x, norm2_g[l]), sh2, sc2), lp)
        if not last:
            xc = xc + g2c * conv_ffn(modulate(rms_norm(xc, norm2_g[l]), sh2c, sc2c), lp)
    return rms_norm(x, final_norm_g)
```

```cpp
#include <hip/hip_runtime.h>
#include <hip/hip_cooperative_groups.h>
#include <cstdio>
#include <cstdint>
namespace cg = cooperative_groups;

typedef unsigned short u16;
typedef __attribute__((ext_vector_type(8))) short bf16x8;
typedef __attribute__((ext_vector_type(4))) float f32x4;
typedef __attribute__((ext_vector_type(16))) float f32x16;

#ifndef SINGLE_LAUNCH
#define SINGLE_LAUNCH 1
#endif

constexpr int DM = 1024, SEQ = 8192, CTXL = 256, NBATCH = 8, INW = 6592, INWP = 6656, DFF = 2816;
constexpr int C_QA = 0, C_KA = 256, C_VA = 512, C_RA = 1024, C_ALR = 1536, C_CQ = 1568, C_CKV = 1824,
              C_KR = 1952, C_SB = 1984, C_SC = 2496, C_SX = 3008, C_GATE = 3520;
constexpr int NKEY = SEQ + CTXL;
constexpr int NCHUNK = NKEY / 64;
constexpr float EPS = 1e-6f;
constexpr int LDS_BYTES = 65536 + 256;
constexpr int SLOT_OFF = 65536;
constexpr int NPH_PER = 11;

constexpr size_t W_IN = 0;
constexpr size_t W_UQ = W_IN + (size_t)INWP * 1024;
constexpr size_t W_UKV = W_UQ + 768 * 256;
constexpr size_t W_BRA = W_UKV + 1024 * 128;
constexpr size_t W_BRB = W_BRA + 1024 * 512;
constexpr size_t W_BRC = W_BRB + 1024 * 512;
constexpr size_t W_O = W_BRC + 1024 * 512;
constexpr size_t W_GU = W_O + 1024 * 1024;
constexpr size_t W_DN = W_GU + (size_t)5632 * 1024;
constexpr size_t W_LAYER = W_DN + (size_t)1024 * 2816;

struct Params {
  const float* in[27];
  float* out;
  float* xc;
  u16* wt;
  float* mod;
  float* rope;
  int* ctr;
  float* rstdq;
  float* rstdkv;
  float* dec;
  u16* proj;
  u16* h;
  u16* m;
  u16* q;
  u16* kf;
  u16* vt;
  u16* uc;
  u16* gq;
  u16* ss;
  int NB, NG, R, nph;
};

extern __shared__ __attribute__((aligned(16))) char smem[];

__device__ __forceinline__ u16 f2bf(float f) {
  unsigned u = __float_as_uint(f);
  u += 0x7fffu + ((u >> 16) & 1u);
  return (u16)(u >> 16);
}
__device__ __forceinline__ float bf2f(u16 h) { return __uint_as_float(((unsigned)h) << 16); }
__device__ __forceinline__ unsigned pack2(float a, float b) { return (unsigned)f2bf(a) | ((unsigned)f2bf(b) << 16); }
__device__ __forceinline__ float bflo(unsigned u) { return __uint_as_float(u << 16); }
__device__ __forceinline__ float bfhi(unsigned u) { return __uint_as_float(u & 0xffff0000u); }
__device__ __forceinline__ float silu_f(float x) { return x / (1.f + __expf(-x)); }
__device__ __forceinline__ float sigmoid_f(float x) { return 1.f / (1.f + __expf(-x)); }

__device__ __forceinline__ void rowinfo(int r, int NB, int& bl, int& pos, int& isctx) {
  const int nl = NB * SEQ;
  if (r < nl) { bl = r >> 13; pos = r & (SEQ - 1); isctx = 0; }
  else { const int rc = r - nl; bl = rc >> 8; pos = rc & (CTXL - 1); isctx = 1; }
}
__device__ __forceinline__ int chunk_row(int bl, int cidx, int NB) {
  return cidx < 128 ? bl * SEQ + cidx * 64 : NB * SEQ + bl * CTXL + (cidx - 128) * 64;
}

__device__ __forceinline__ int next_item(int* ctr) {
  __syncthreads();
  if (threadIdx.x == 0) *(int*)(smem + SLOT_OFF) = atomicAdd(ctr, 1);
  __syncthreads();
  return *(volatile int*)(smem + SLOT_OFF);
}

__device__ __forceinline__ int opaque_tid() {
  int t = threadIdx.x;
  asm volatile("" : "+v"(t));
  return t;
}
#define TIDX opaque_tid()
__device__ __forceinline__ float wave_sum(float v) {
  v += __shfl_xor(v, 32); v += __shfl_xor(v, 16); v += __shfl_xor(v, 8);
  v += __shfl_xor(v, 4); v += __shfl_xor(v, 2); v += __shfl_xor(v, 1);
  return v;
}

__device__ __forceinline__ int lds_byte(int r, int c) {
  const int st = (r >> 4) * 2 + (c >> 5), rr = r & 15, cc = c & 31, ob = rr * 64 + cc * 2;
  return st * 1024 + (ob ^ (((ob >> 9) & 1) << 5));
}
__device__ __forceinline__ void stage_rc(int b, int& R, int& C) {
  const int st = b >> 10, sb = b & 1023, swz = sb ^ (((sb >> 9) & 1) << 5);
  R = (st >> 1) * 16 + (swz >> 6); C = (st & 1) * 32 + ((swz & 63) >> 1);
}

__device__ __forceinline__ void glds16(const void* g, void* l) {
  __builtin_amdgcn_global_load_lds((const __attribute__((address_space(1))) unsigned*)g,
                                   (__attribute__((address_space(3))) unsigned*)l, 16, 0, 0);
}

template <int NWI>
__device__ __forceinline__ void gemm_core(const u16* __restrict__ X, int ldx, const u16* __restrict__ W, int ldw,
                                          int K, f32x4 (&acc)[NWI][4]) {
  const int tid = TIDX, lane = tid & 63, wid = tid >> 6;
  const int wr = wid >> 1, wc = wid & 1, fr = lane & 15, fq = lane >> 4;
#pragma unroll
  for (int a = 0; a < NWI; ++a)
#pragma unroll
    for (int b = 0; b < 4; ++b) acc[a][b] = f32x4{0.f, 0.f, 0.f, 0.f};
  int R0, C0; stage_rc(tid * 16, R0, C0);
  const u16* xg = X + (size_t)R0 * ldx + C0;
  const u16* wg = W + (size_t)R0 * ldw + C0;
  const int xs = 32 * ldx, ws_ = 32 * ldw;
  const int lane_off = (fr * 64 + fq * 16) ^ (((fr >> 3) & 1) << 5);
  const char* xb = smem + wr * 8192 + lane_off;
  const char* wb = smem + 16384 + wc * (NWI * 2048) + lane_off;
  char* sdst = smem + tid * 16;
  const int nt = K >> 6;
  __syncthreads();
#pragma unroll
  for (int i = 0; i < 4; ++i) {
    glds16(xg + i * xs, sdst + i * 4096);
    if (i < NWI) glds16(wg + i * ws_, sdst + 16384 + i * 4096);
  }
  for (int kt = 0; kt < nt; ++kt) {
    asm volatile("s_waitcnt vmcnt(0)" ::: "memory");
    __syncthreads();
    const int cb = (kt & 1) * 32768;
    if (kt + 1 < nt) {
      const int nb = 32768 - cb;
      const int ko = (kt + 1) * 64;
#pragma unroll
      for (int i = 0; i < 4; ++i) {
        glds16(xg + i * xs + ko, sdst + nb + i * 4096);
        if (i < NWI) glds16(wg + i * ws_ + ko, sdst + nb + 16384 + i * 4096);
      }
    }
#pragma unroll
    for (int k = 0; k < 2; ++k) {
      bf16x8 wf[NWI], xf[4];
#pragma unroll
      for (int i = 0; i < NWI; ++i) wf[i] = *(const bf16x8*)(wb + cb + i * 2048 + k * 1024);
#pragma unroll
      for (int i = 0; i < 4; ++i) xf[i] = *(const bf16x8*)(xb + cb + i * 2048 + k * 1024);
#pragma unroll
      for (int wi = 0; wi < NWI; ++wi)
#pragma unroll
        for (int xi = 0; xi < 4; ++xi)
          acc[wi][xi] = __builtin_amdgcn_mfma_f32_16x16x32_bf16(wf[wi], xf[xi], acc[wi][xi], 0, 0, 0);
    }
  }
}

#define EPI_VARS const int tid_ = TIDX, lane_ = tid_ & 63, wid_ = tid_ >> 6; \
  const int wr_ = wid_ >> 1, wc_ = wid_ & 1, fr_ = lane_ & 15, fq_ = lane_ >> 4; (void)fq_; (void)fr_; (void)wr_; (void)wc_;
#define EPI_TR(xi) (wr_ * 64 + (xi) * 16 + fr_)
#define EPI_NN(wi) (wc_ * 64 + (wi) * 16 + fq_ * 4)

__device__ __forceinline__ void tile_order(int t, int MT, int NT, int& mt, int& nt) {
  constexpr int GM = 8;
  const int band = t / (GM * NT), rem = t - band * GM * NT;
  const int m0 = band * GM;
  const int gsz = min(GM, MT - m0);
  nt = rem / gsz; mt = m0 + rem - nt * gsz;
}

__device__ __forceinline__ float* xrow_ptr(const Params& p, int g, int r) {
  int bl, pos, isctx; rowinfo(r, p.NB, bl, pos, isctx);
  const int b = g * p.NB + bl;
  return isctx ? p.xc + ((size_t)b * CTXL + pos) * DM : p.out + ((size_t)b * SEQ + pos) * DM;
}
__device__ __forceinline__ const float* xsrc_row_ptr(const Params& p, int g, int r, int from_input) {
  int bl, pos, isctx; rowinfo(r, p.NB, bl, pos, isctx);
  const int b = g * p.NB + bl;
  if (from_input) return isctx ? p.in[2] + ((size_t)b * CTXL + pos) * DM : p.in[0] + ((size_t)b * SEQ + pos) * DM;
  return isctx ? p.xc + ((size_t)b * CTXL + pos) * DM : p.out + ((size_t)b * SEQ + pos) * DM;
}
__device__ __forceinline__ int mod_index(const Params& p, int g, int r) {
  int bl, pos, isctx; rowinfo(r, p.NB, bl, pos, isctx);
  return isctx ? 8 : g * p.NB + bl;
}

__device__ void conv_tile(const float* __restrict__ src, int K, int N, u16* __restrict__ dst,
                          const float* __restrict__ scale, int ktile, int ntile) {
  float* tile = (float*)smem;
  const int tid = TIDX;
  const int k0 = ktile * 64, n0 = ntile * 64;
  const bool valid = n0 < N;
  if (valid) {
    const int kk = tid >> 4, n4 = (tid & 15) * 4;
#pragma unroll
    for (int i = 0; i < 4; ++i) {
      const int k = kk + 16 * i;
      const float4 v = *(const float4*)(src + (size_t)(k0 + k) * N + n0 + n4);
      const float s = scale ? scale[k0 + k] : 1.f;
      tile[k * 65 + n4 + 0] = v.x * s; tile[k * 65 + n4 + 1] = v.y * s;
      tile[k * 65 + n4 + 2] = v.z * s; tile[k * 65 + n4 + 3] = v.w * s;
    }
  }
  __syncthreads();
  const int nn = tid >> 3, k8 = (tid & 7) * 8;
#pragma unroll
  for (int i = 0; i < 2; ++i) {
    const int n = nn + 32 * i;
    uint4 o = make_uint4(0, 0, 0, 0);
    if (valid) {
      o.x = pack2(tile[(k8 + 0) * 65 + n], tile[(k8 + 1) * 65 + n]);
      o.y = pack2(tile[(k8 + 2) * 65 + n], tile[(k8 + 3) * 65 + n]);
      o.z = pack2(tile[(k8 + 4) * 65 + n], tile[(k8 + 5) * 65 + n]);
      o.w = pack2(tile[(k8 + 6) * 65 + n], tile[(k8 + 7) * 65 + n]);
    }
    *(uint4*)(dst + (size_t)(n0 + n) * K + k0 + k8) = o;
  }
}

__device__ void sincos_d(double a, double& s, double& c) {
  const double k = rint(a * 0.6366197723675814);
  double r = fma(-k, 1.5707963267948966, a);
  r = fma(-k, 6.123233995736766e-17, r);
  const int q = ((int)k) & 3;
  const double r2 = r * r;
  const double sp = r * (1.0 + r2 * (-1.0 / 6 + r2 * (1.0 / 120 + r2 * (-1.0 / 5040 + r2 * (1.0 / 362880 + r2 * (-1.0 / 39916800 + r2 * (1.0 / 6227020800.0)))))));
  const double cp = 1.0 + r2 * (-0.5 + r2 * (1.0 / 24 + r2 * (-1.0 / 720 + r2 * (1.0 / 40320 + r2 * (-1.0 / 3628800 + r2 * (1.0 / 479001600.0 + r2 * (-1.0 / 87178291200.0)))))));
  s = (q == 0) ? sp : (q == 1) ? cp : (q == 2) ? -sp : -cp;
  c = (q == 0) ? cp : (q == 1) ? -sp : (q == 2) ? -cp : sp;
}

constexpr int CV_WIN = 0, CV_UQ = 1664, CV_UKV = 1712, CV_BRA = 1744, CV_BRB = 1872, CV_BRC = 2000,
              CV_WO = 2128, CV_GATE = 2384, CV_UP = 3088, CV_DN = 3792, CV_LAYER = 4496;
constexpr int P0_CONV = 2 * CV_LAYER, P0_ADA = 2 * 192, P0_TOTAL = P0_CONV + P0_ADA + 1;

__device__ void phase0(const Params& p, int* ctr) {
  int it;
  while ((it = next_item(ctr)) < P0_TOTAL) {
    const int tid = TIDX;
    if (it < P0_CONV) {
      const int l = it / CV_LAYER, j = it % CV_LAYER;
      u16* wl = p.wt + (size_t)l * W_LAYER;
      if (j < CV_UQ)       { const int jj = j - CV_WIN;  conv_tile(p.in[7] + (size_t)l * 1024 * INW, 1024, INW, wl + W_IN, nullptr, jj / 104, jj % 104); }
      else if (j < CV_UKV) { const int jj = j - CV_UQ;   conv_tile(p.in[12] + (size_t)l * 256 * 768, 256, 768, wl + W_UQ, p.in[11] + l * 256, jj / 12, jj % 12); }
      else if (j < CV_BRA) { const int jj = j - CV_UKV;  conv_tile(p.in[14] + (size_t)l * 128 * 1024, 128, 1024, wl + W_UKV, p.in[13] + l * 128, jj / 16, jj % 16); }
      else if (j < CV_BRB) { const int jj = j - CV_BRA;  conv_tile(p.in[16] + (size_t)l * 512 * 1024, 512, 1024, wl + W_BRA, nullptr, jj / 16, jj % 16); }
      else if (j < CV_BRC) { const int jj = j - CV_BRB;  conv_tile(p.in[17] + (size_t)l * 512 * 1024, 512, 1024, wl + W_BRB, nullptr, jj / 16, jj % 16); }
      else if (j < CV_WO)  { const int jj = j - CV_BRC;  conv_tile(p.in[18] + (size_t)l * 512 * 1024, 512, 1024, wl + W_BRC, nullptr, jj / 16, jj % 16); }
      else if (j < CV_GATE){ const int jj = j - CV_WO;   conv_tile(p.in[19] + (size_t)l * 1024 * 1024, 1024, 1024, wl + W_O, nullptr, jj / 16, jj % 16); }
      else if (j < CV_UP)  { const int jj = j - CV_GATE; conv_tile(p.in[21] + (size_t)l * 1024 * DFF, 1024, DFF, wl + W_GU, nullptr, jj / 44, jj % 44); }
      else if (j < CV_DN)  { const int jj = j - CV_UP;   conv_tile(p.in[22] + (size_t)l * 1024 * DFF, 1024, DFF, wl + W_GU + (size_t)DFF * 1024, nullptr, jj / 44, jj % 44); }
      else                 { const int jj = j - CV_DN;   conv_tile(p.in[25] + (size_t)l * DFF * 1024, DFF, 1024, wl + W_DN, nullptr, jj / 16, jj % 16); }
    } else if (it < P0_CONV + P0_ADA) {
      const int a = it - P0_CONV, l = a / 192, cg_ = a % 192;
      float* sc = (float*)smem;
      float* red = sc + 9 * 1024;
      for (int e = tid; e < 9 * 1024; e += 256) {
        const int v = e >> 10, k = e & 1023;
        const float cv = (v < 8) ? p.in[1][v * 1024 + k] : p.in[3][k];
        sc[e] = cv / (1.f + expf(-cv));
      }
      __syncthreads();
      const int kg = tid >> 5, cn = tid & 31;
      const float* wa = p.in[4] + (size_t)l * 1024 * 6144 + cg_ * 32 + cn;
      float a0 = 0, a1 = 0, a2 = 0, a3 = 0, a4 = 0, a5 = 0, a6 = 0, a7 = 0, a8 = 0;
#pragma unroll 8
      for (int i = 0; i < 128; ++i) {
        const int k = kg + 8 * i;
        const float w = wa[(size_t)k * 6144];
        a0 += sc[k] * w; a1 += sc[1024 + k] * w; a2 += sc[2048 + k] * w; a3 += sc[3072 + k] * w;
        a4 += sc[4096 + k] * w; a5 += sc[5120 + k] * w; a6 += sc[6144 + k] * w; a7 += sc[7168 + k] * w;
        a8 += sc[8192 + k] * w;
      }
      float* rr = red + kg * 288 + cn;
      rr[0] = a0; rr[32] = a1; rr[64] = a2; rr[96] = a3; rr[128] = a4; rr[160] = a5; rr[192] = a6; rr[224] = a7; rr[256] = a8;
      __syncthreads();
      for (int e = tid; e < 288; e += 256) {
        float s = 0.f;
#pragma unroll
        for (int g8 = 0; g8 < 8; ++g8) s += red[g8 * 288 + e];
        const int v = e >> 5, n = cg_ * 32 + (e & 31);
        p.mod[((size_t)l * 9 + v) * 6144 + n] = s + p.in[5][l * 6144 + n];
      }
    } else {
      for (int e = tid; e < 1024; e += 256) {
        const int pos = e >> 3, f = e & 7;
        const float inv = (f == 0) ? 1.0f : (f == 1) ? 0.31622776601683794f : (f == 2) ? 0.1f : (f == 3) ? 0.031622776601683794f
                        : (f == 4) ? 0.01f : (f == 5) ? 0.0031622776601683794f : (f == 6) ? 0.001f : 0.00031622776601683794f;
        const float ang = (float)pos * inv;
        double s, c; sincos_d((double)ang, s, c);
        p.rope[e * 2] = (float)c; p.rope[e * 2 + 1] = (float)s;
      }
    }
  }
}

__device__ void phase_norm(const Params& p, int l, int g, int which, int* ctr) {
  const int nitems = p.R / 16;
  const float* gam = (which == 0 ? p.in[6] : p.in[20]) + l * DM;
  const int shoff = which == 0 ? 0 : 3072, scoff = which == 0 ? 1024 : 4096;
  const int from_input = (which == 0 && l == 0);
  int it;
  while ((it = next_item(ctr)) < nitems) {
    const int lane = TIDX & 63, wid = TIDX >> 6;
    for (int rr = 0; rr < 4; ++rr) {
      const int r = it * 16 + wid * 4 + rr;
      const float* xr = xsrc_row_ptr(p, g, r, from_input);
      const float* mrow = p.mod + ((size_t)l * 9 + mod_index(p, g, r)) * 6144;
      float4 v[4]; float ss = 0.f;
#pragma unroll
      for (int i = 0; i < 4; ++i) {
        v[i] = *(const float4*)(xr + lane * 4 + i * 256);
        ss += v[i].x * v[i].x + v[i].y * v[i].y + v[i].z * v[i].z + v[i].w * v[i].w;
      }
      ss = wave_sum(ss);
      const float rstd = rsqrtf(ss * (1.f / 1024.f) + EPS);
#pragma unroll
      for (int i = 0; i < 4; ++i) {
        const int c = lane * 4 + i * 256;
        const float4 gg = *(const float4*)(gam + c);
        const float4 sh = *(const float4*)(mrow + shoff + c);
        const float4 sc = *(const float4*)(mrow + scoff + c);
        uint2 o;
        o.x = pack2(v[i].x * rstd * gg.x * (1.f + sc.x) + sh.x, v[i].y * rstd * gg.y * (1.f + sc.y) + sh.y);
        o.y = pack2(v[i].z * rstd * gg.z * (1.f + sc.z) + sh.z, v[i].w * rstd * gg.w * (1.f + sc.w) + sh.w);
        *(uint2*)(p.h + (size_t)r * DM + c) = o;
      }
    }
  }
}

__device__ void phase_proj(const Params& p, int l, int* ctr) {
  const int MT = p.R / 128, NT = INWP / 128;
  const u16* W = p.wt + (size_t)l * W_LAYER + W_IN;
  int it;
  while ((it = next_item(ctr)) < MT * NT) {
    int mt, nt; tile_order(it, MT, NT, mt, nt);
    f32x4 acc[4][4];
    gemm_core<4>(p.h + (size_t)mt * 128 * DM, DM, W + (size_t)nt * 128 * DM, DM, DM, acc);
    EPI_VARS
#pragma unroll
    for (int wi = 0; wi < 4; ++wi)
#pragma unroll
      for (int xi = 0; xi < 4; ++xi) {
        const int r = mt * 128 + EPI_TR(xi), n = nt * 128 + EPI_NN(wi);
        if (n < INW) {
          uint2 o; o.x = pack2(acc[wi][xi][0], acc[wi][xi][1]); o.y = pack2(acc[wi][xi][2], acc[wi][xi][3]);
          *(uint2*)(p.proj + (size_t)r * INW + n) = o;
        }
      }
  }
}

__device__ void postproj_rows(const Params& p, int l, int it) {
  const int lane = TIDX & 63, wid = TIDX >> 6;
  const float* scw = p.in[15] + (size_t)l * 3 * 512;
  for (int rr = 0; rr < 4; ++rr) {
    const int r = it * 16 + wid * 4 + rr;
    int bl, pos, isctx; rowinfo(r, p.NB, bl, pos, isctx);
    const u16* pr = p.proj + (size_t)r * INW;
    {
      const uint2 u = *(const uint2*)(pr + C_CQ + lane * 4);
      const float a = bflo(u.x), b = bfhi(u.x), c = bflo(u.y), d = bfhi(u.y);
      float ss = wave_sum(a * a + b * b + c * c + d * d);
      if (lane == 0) p.rstdq[r] = rsqrtf(ss * (1.f / 256.f) + EPS);
    }
    {
      const unsigned u = *(const unsigned*)(pr + C_CKV + lane * 2);
      const float a = bflo(u), b = bfhi(u);
      float ss = wave_sum(a * a + b * b);
      if (lane == 0) p.rstdkv[r] = rsqrtf(ss * (1.f / 128.f) + EPS);
    }
    {
      const int idx = lane & 31;
      const float val = bf2f(pr[C_KR + idx]);
      const float partner = __shfl_xor(val, 8);
      float o = val;
      if (!isctx) {
        const int axis = idx >> 4, half = (idx >> 3) & 1, f = idx & 7;
        const int pa = axis ? (pos & 63) : (pos >> 6);
        const float c = p.rope[(pa * 8 + f) * 2], s = p.rope[(pa * 8 + f) * 2 + 1];
        o = half ? (val * c + partner * s) : (val * c - partner * s);
      }
      const int j = isctx ? SEQ + pos : pos;
      const u16 ob = f2bf(o);
      if (lane < 32) {
#pragma unroll
        for (int hd = 0; hd < 8; ++hd)
          p.kf[((size_t)(bl * 8 + hd) * NKEY + j) * 96 + 64 + idx] = ob;
      }
    }
    {
      const int L = isctx ? CTXL : SEQ;
      const int c0 = lane * 8;
      const uint4 sb = *(const uint4*)(pr + C_SB + c0);
      const uint4 sc1 = *(const uint4*)(pr + C_SC + c0);
      const uint4 sx1 = *(const uint4*)(pr + C_SX + c0);
      uint4 sc0 = make_uint4(0, 0, 0, 0), sx0 = sc0, sc2 = sc0, sx2 = sc0;
      if (pos > 0) { sc0 = *(const uint4*)(pr - INW + C_SC + c0); sx0 = *(const uint4*)(pr - INW + C_SX + c0); }
      if (pos < L - 1) { sc2 = *(const uint4*)(pr + INW + C_SC + c0); sx2 = *(const uint4*)(pr + INW + C_SX + c0); }
      const float4 w0a = *(const float4*)(scw + c0), w0b = *(const float4*)(scw + c0 + 4);
      const float4 w1a = *(const float4*)(scw + 512 + c0), w1b = *(const float4*)(scw + 512 + c0 + 4);
      const float4 w2a = *(const float4*)(scw + 1024 + c0), w2b = *(const float4*)(scw + 1024 + c0 + 4);
      uint4 o;
#define UC2(SBW, A0, X0, A1, X1, A2, X2, W0L, W0H, W1L, W1H, W2L, W2H) \
      pack2(bflo(SBW) * (W0L * bflo(A0) * bflo(X0) + W1L * bflo(A1) * bflo(X1) + W2L * bflo(A2) * bflo(X2)), \
            bfhi(SBW) * (W0H * bfhi(A0) * bfhi(X0) + W1H * bfhi(A1) * bfhi(X1) + W2H * bfhi(A2) * bfhi(X2)))
      o.x = UC2(sb.x, sc0.x, sx0.x, sc1.x, sx1.x, sc2.x, sx2.x, w0a.x, w0a.y, w1a.x, w1a.y, w2a.x, w2a.y);
      o.y = UC2(sb.y, sc0.y, sx0.y, sc1.y, sx1.y, sc2.y, sx2.y, w0a.z, w0a.w, w1a.z, w1a.w, w2a.z, w2a.w);
      o.z = UC2(sb.z, sc0.z, sx0.z, sc1.z, sx1.z, sc2.z, sx2.z, w0b.x, w0b.y, w1b.x, w1b.y, w2b.x, w2b.y);
      o.w = UC2(sb.w, sc0.w, sx0.w, sc1.w, sx1.w, sc2.w, sx2.w, w0b.z, w0b.w, w1b.z, w1b.w, w2b.z, w2b.w);
#undef UC2
      *(uint4*)(p.uc + (size_t)r * 512 + c0) = o;
    }
  }
}

__device__ __forceinline__ float logsig16(float z) {
  return (fminf(z, 0.f) - log1pf(__expf(-fabsf(z)))) * (1.f / 16.f);
}

__device__ void gla_prep(const Params& p, int l, int it) {
  const int tid = TIDX, lane = tid & 63, wid = tid >> 6;
  const int bl = it / (NCHUNK * 4), rem = it % (NCHUNK * 4), cidx = rem >> 2, h = rem & 3;
  const int r0 = chunk_row(bl, cidx, p.NB);
  float* lr = (float*)smem;
  float* tot = (float*)(smem + 8192);
  u16* vT = (u16*)(smem + 10752);
  u16* kTf = (u16*)(smem + 29184);
  u16* kTb = (u16*)(smem + 38400);
  {
    const int t = tid >> 2, c8 = (tid & 3) * 8;
    const uint4 u = *(const uint4*)(p.proj + (size_t)(r0 + t) * INW + C_ALR + c8);
    float* d = lr + t * 32 + c8;
    d[0] = bflo(u.x); d[1] = bfhi(u.x); d[2] = bflo(u.y); d[3] = bfhi(u.y);
    d[4] = bflo(u.z); d[5] = bfhi(u.z); d[6] = bflo(u.w); d[7] = bfhi(u.w);
    const int dvc = (tid & 3) * 32;
    const u16* vp = p.proj + (size_t)(r0 + t) * INW + C_VA + h * 128 + dvc;
#pragma unroll
    for (int i = 0; i < 4; ++i) {
      const uint4 vv = *(const uint4*)(vp + i * 8);
      u16* dst = vT + (size_t)(dvc + i * 8) * 72 + t;
      dst[0] = (u16)(vv.x & 0xffff); dst[72] = (u16)(vv.x >> 16);
      dst[144] = (u16)(vv.y & 0xffff); dst[216] = (u16)(vv.y >> 16);
      dst[288] = (u16)(vv.z & 0xffff); dst[360] = (u16)(vv.z >> 16);
      dst[432] = (u16)(vv.w & 0xffff); dst[504] = (u16)(vv.w >> 16);
    }
  }
  __syncthreads();
  const int dk = lane, tg = wid;
  const float* w2f = p.in[8] + ((size_t)(l * 2 + 0) * 16) * 256 + h * 64 + dk;
  const float* w2b = p.in[8] + ((size_t)(l * 2 + 1) * 16) * 256 + h * 64 + dk;
  float wf[16], wb[16];
#pragma unroll
  for (int r = 0; r < 16; ++r) { wf[r] = w2f[r * 256]; wb[r] = w2b[r * 256]; }
  const float biasf = p.in[9][(l * 2 + 0) * 256 + h * 64 + dk];
  const float biasb = p.in[9][(l * 2 + 1) * 256 + h * 64 + dk];
  float pf[16], sbk[16];
#pragma unroll
  for (int i = 0; i < 16; ++i) {
    const float* lrow = lr + (tg * 16 + i) * 32;
    float zf = biasf, zb = biasb;
#pragma unroll
    for (int r = 0; r < 16; ++r) { zf += lrow[r] * wf[r]; zb += lrow[16 + r] * wb[r]; }
    pf[i] = logsig16(zf); sbk[i] = logsig16(zb);
  }
#pragma unroll
  for (int i = 1; i < 16; ++i) pf[i] += pf[i - 1];
#pragma unroll
  for (int i = 14; i >= 0; --i) sbk[i] += sbk[i + 1];
  tot[tg * 64 + dk] = pf[15];
  tot[256 + tg * 64 + dk] = sbk[0];
  __syncthreads();
  float offf = 0.f, offb = 0.f, bfl = 0.f, bb0 = 0.f;
#pragma unroll
  for (int g4 = 0; g4 < 4; ++g4) {
    const float a = tot[g4 * 64 + dk], b = tot[256 + g4 * 64 + dk];
    bfl += a; bb0 += b;
    if (g4 < tg) offf += a;
    if (g4 > tg) offb += b;
  }
  u16* gqf = p.gq;
  u16* gkf = p.gq + (size_t)p.R * 256;
  u16* gqb = p.gq + (size_t)p.R * 512;
  u16* gkb = p.gq + (size_t)p.R * 768;
  unsigned kfp[8], kbp[8];
#pragma unroll
  for (int i = 0; i < 16; ++i) {
    const int t = tg * 16 + i;
    const float bfv = offf + pf[i], bbv = offb + sbk[i];
    const float qv = bf2f(p.proj[(size_t)(r0 + t) * INW + C_QA + h * 64 + dk]);
    const float kv = bf2f(p.proj[(size_t)(r0 + t) * INW + C_KA + h * 64 + dk]);
    const size_t go = (size_t)(r0 + t) * 256 + h * 64 + dk;
    gqf[go] = f2bf(qv * __expf(bfv) * 0.125f);
    gkf[go] = f2bf(kv * __expf(-bfv));
    gqb[go] = f2bf(qv * __expf(bbv) * 0.125f);
    gkb[go] = f2bf(kv * __expf(-bbv));
    const u16 ksf = f2bf(kv * __expf(bfl - bfv));
    const u16 ksb = f2bf(kv * __expf(bb0 - bbv));
    if (i & 1) { kfp[i >> 1] |= ((unsigned)ksf) << 16; kbp[i >> 1] |= ((unsigned)ksb) << 16; }
    else { kfp[i >> 1] = ksf; kbp[i >> 1] = ksb; }
  }
  *(uint4*)(kTf + dk * 72 + tg * 16) = make_uint4(kfp[0], kfp[1], kfp[2], kfp[3]);
  *(uint4*)(kTf + dk * 72 + tg * 16 + 8) = make_uint4(kfp[4], kfp[5], kfp[6], kfp[7]);
  *(uint4*)(kTb + dk * 72 + tg * 16) = make_uint4(kbp[0], kbp[1], kbp[2], kbp[3]);
  *(uint4*)(kTb + dk * 72 + tg * 16 + 8) = make_uint4(kbp[4], kbp[5], kbp[6], kbp[7]);
  const size_t cb = ((size_t)(bl * NCHUNK + cidx) * 4 + h) * 2;
  if (tg == 0) {
    p.dec[(cb + 0) * 64 + dk] = __expf(bfl);
    p.dec[(cb + 1) * 64 + dk] = __expf(bb0);
  }
  __syncthreads();
  const int l31 = lane & 31, hh = lane >> 5;
  float* U = (float*)p.h;
#pragma unroll
  for (int dir = 0; dir < 2; ++dir) {
    const u16* kT = dir ? kTb : kTf;
#pragma unroll
    for (int dkt = 0; dkt < 2; ++dkt) {
      f32x16 acc;
#pragma unroll
      for (int e = 0; e < 16; ++e) acc[e] = 0.f;
#pragma unroll
      for (int s = 0; s < 4; ++s) {
        const bf16x8 a = *(const bf16x8*)(vT + (32 * wid + l31) * 72 + 16 * s + 8 * hh);
        const bf16x8 b = *(const bf16x8*)(kT + (32 * dkt + l31) * 72 + 16 * s + 8 * hh);
        acc = __builtin_amdgcn_mfma_f32_32x32x16_bf16(a, b, acc, 0, 0, 0);
      }
      float* up = U + (cb + dir) * 8192;
#pragma unroll
      for (int e = 0; e < 16; ++e) {
        const int dv = 32 * wid + (e & 3) + 8 * (e >> 2) + 4 * hh;
        up[dv * 64 + 32 * dkt + l31] = acc[e];
      }
    }
  }
}

__device__ void phase_postproj(const Params& p, int l, int* ctr) {
  const int n_prep = p.NB * NCHUNK * 4, n_rows = p.R / 16;
  int it;
  while ((it = next_item(ctr)) < n_prep + n_rows) {
    if (it < n_prep) gla_prep(p, l, it);
    else postproj_rows(p, l, it - n_prep);
  }
}

__device__ void gla_scan(const Params& p, int it) {
  const int tid = TIDX;
  const int sl = it & 7, dir = (it >> 3) & 1, h = (it >> 4) & 3, bl = it >> 6;
  const int e0 = sl * 1024 + tid * 4;
  const int dk = e0 & 63;
  const float* U = (const float*)p.h;
  f32x4 S = {0.f, 0.f, 0.f, 0.f};
#pragma unroll 4
  for (int step = 0; step < NCHUNK; ++step) {
    const int cidx = dir ? (NCHUNK - 1 - step) : (step < 4 ? 128 + step : step - 4);
    const size_t base = ((size_t)(bl * NCHUNK + cidx) * 4 + h) * 2 + dir;
    const f32x4 u4 = *(const f32x4*)(U + base * 8192 + e0);
    const f32x4 d4 = *(const f32x4*)(p.dec + base * 64 + dk);
    uint2 o; o.x = pack2(S[0], S[1]); o.y = pack2(S[2], S[3]);
    *(uint2*)(p.ss + base * 8192 + e0) = o;
    S = d4 * S + u4;
  }
}

__device__ void q_tile(const Params& p, int l, int t) {
  const int MT = p.R / 128;
  const int nt = t / MT, mt = t % MT;
  f32x4 acc[4][4];
  gemm_core<4>(p.proj + (size_t)mt * 128 * INW + C_CQ, INW, p.wt + (size_t)l * W_LAYER + W_UQ + (size_t)nt * 128 * 256, 256, 256, acc);
  EPI_VARS
  const float QS = 0.10206207261596577f * 1.4426950408889634f;
  int bl, pos0, isctx; rowinfo(mt * 128, p.NB, bl, pos0, isctx);
#pragma unroll
  for (int xi = 0; xi < 4; ++xi) {
    const int tr = EPI_TR(xi), r = mt * 128 + tr, pos = pos0 + tr;
    const float rs = p.rstdq[r] * QS;
#pragma unroll
    for (int wi = 0; wi < 4; ++wi) {
      const int n = nt * 128 + EPI_NN(wi);
      const int n16 = (nt * 128 + wc_ * 64 + wi * 16) >> 4;
      const int m6 = n16 % 6;
      float v0 = acc[wi][xi][0] * rs, v1 = acc[wi][xi][1] * rs, v2 = acc[wi][xi][2] * rs, v3 = acc[wi][xi][3] * rs;
      if (m6 >= 4 && !isctx) {
        const float p0 = __shfl_xor(v0, 32), p1 = __shfl_xor(v1, 32), p2 = __shfl_xor(v2, 32), p3 = __shfl_xor(v3, 32);
        const int pa = (m6 == 5) ? (pos & 63) : (pos >> 6);
        const int f0 = (fq_ & 1) * 4;
        const float* rp = p.rope + (pa * 8 + f0) * 2;
        const float4 cs01 = *(const float4*)rp, cs23 = *(const float4*)(rp + 4);
        const float sg = (fq_ >= 2) ? 1.f : -1.f;
        v0 = v0 * cs01.x + sg * p0 * cs01.y;
        v1 = v1 * cs01.z + sg * p1 * cs01.w;
        v2 = v2 * cs23.x + sg * p2 * cs23.y;
        v3 = v3 * cs23.z + sg * p3 * cs23.w;
      }
      uint2 o; o.x = pack2(v0, v1); o.y = pack2(v2, v3);
      *(uint2*)(p.q + (size_t)r * 768 + n) = o;
    }
  }
}

__device__ void kv_tile(const Params& p, int l, int t) {
  const int MT = p.R / 128;
  const int nt = t / MT, mt = t % MT;
  f32x4 acc[4][4];
  gemm_core<4>(p.proj + (size_t)mt * 128 * INW + C_CKV, INW, p.wt + (size_t)l * W_LAYER + W_UKV + (size_t)nt * 128 * 128, 128, 128, acc);
  EPI_VARS
  int bl, pos0, isctx; rowinfo(mt * 128, p.NB, bl, pos0, isctx);
  const int j0 = isctx ? SEQ + pos0 : pos0;
#pragma unroll
  for (int xi = 0; xi < 4; ++xi) {
    const int tr = EPI_TR(xi), r = mt * 128 + tr, j = j0 + tr;
    const float rs = p.rstdkv[r];
#pragma unroll
    for (int wi = 0; wi < 4; ++wi) {
      const int wn = EPI_NN(wi);
      const float v0 = acc[wi][xi][0] * rs, v1 = acc[wi][xi][1] * rs, v2 = acc[wi][xi][2] * rs, v3 = acc[wi][xi][3] * rs;
      if (wc_ == 0) {
        uint2 o; o.x = pack2(v0, v1); o.y = pack2(v2, v3);
        *(uint2*)(p.kf + ((size_t)(bl * 8 + nt) * NKEY + j) * 96 + wn) = o;
      } else {
        u16* vp = p.vt + ((size_t)(bl * 8 + nt) * 64 + (wn - 64)) * NKEY + j;
        vp[0] = f2bf(v0); vp[NKEY] = f2bf(v1); vp[2 * NKEY] = f2bf(v2); vp[3 * NKEY] = f2bf(v3);
      }
    }
  }
}

__device__ void phase_qkv(const Params& p, int l, int* ctr) {
  const int MT = p.R / 128;
  const int n_scan = p.NB * 64, n_q = MT * 6, n_kv = MT * 8;
  int it;
  while ((it = next_item(ctr)) < n_scan + n_q + n_kv) {
    if (it < n_scan) gla_scan(p, it);
    else if (it < n_scan + n_q) q_tile(p, l, it - n_scan);
    else kv_tile(p, l, it - n_scan - n_q);
  }
}

__device__ __forceinline__ bf16x8 pack8(const f32x16& a, int o) {
  union { bf16x8 v; unsigned u[4]; } r;
  r.u[0] = pack2(a[o + 0], a[o + 1]); r.u[1] = pack2(a[o + 2], a[o + 3]);
  r.u[2] = pack2(a[o + 4], a[o + 5]); r.u[3] = pack2(a[o + 6], a[o + 7]);
  return r.v;
}
__device__ __forceinline__ bf16x8 ld2x8(const u16* p0) {
  union { bf16x8 v; uint2 u[2]; } r;
  r.u[0] = *(const uint2*)p0; r.u[1] = *(const uint2*)(p0 + 8);
  return r.v;
}

__device__ void attn_item(const Params& p, int it) {
  const int tid = TIDX, lane = tid & 63, wid = tid >> 6, l31 = lane & 31, hh = lane >> 5;
  const int qb = it % 66, bh = it / 66, h = bh & 7, bl = bh >> 3;
  const int r0 = qb < 64 ? bl * SEQ + qb * 128 : p.NB * SEQ + bl * CTXL + (qb - 64) * 128;
  const int kt0 = qb < 64 ? 0 : 128;
  const int nkt = NCHUNK - kt0;
  constexpr int KROW = 208, VROW = 144, BUFB = 64 * KROW + 64 * VROW;
  bf16x8 qf[6];
  {
    const u16* qp = p.q + (size_t)(r0 + 32 * wid + l31) * 768 + h * 96 + 8 * hh;
#pragma unroll
    for (int s = 0; s < 6; ++s) qf[s] = *(const bf16x8*)(qp + 16 * s);
  }
  const u16* kbase = p.kf + (size_t)bh * NKEY * 96;
  const u16* vbase = p.vt + (size_t)bh * 64 * NKEY;
  uint4 kr0, kr1, kr2, vr0, vr1;
  const int kdst0 = (tid / 12) * KROW + (tid % 12) * 16;
  const int kdst1 = ((tid + 256) / 12) * KROW + ((tid + 256) % 12) * 16;
  const int kdst2 = ((tid + 512) / 12) * KROW + ((tid + 512) % 12) * 16;
  const int vdst0 = 64 * KROW + (tid >> 3) * VROW + (tid & 7) * 16;
  const int vdst1 = vdst0 + 32 * VROW;
  const int vsrc0 = (tid >> 3) * NKEY + (tid & 7) * 8;
  const int vsrc1 = vsrc0 + 32 * NKEY;
  {
    const u16* kp = kbase + (size_t)kt0 * 64 * 96 + tid * 8;
    kr0 = *(const uint4*)(kp); kr1 = *(const uint4*)(kp + 2048); kr2 = *(const uint4*)(kp + 4096);
    vr0 = *(const uint4*)(vbase + vsrc0 + kt0 * 64); vr1 = *(const uint4*)(vbase + vsrc1 + kt0 * 64);
    *(uint4*)(smem + kdst0) = kr0; *(uint4*)(smem + kdst1) = kr1; *(uint4*)(smem + kdst2) = kr2;
    *(uint4*)(smem + vdst0) = vr0; *(uint4*)(smem + vdst1) = vr1;
  }
  __syncthreads();
  f32x16 oacc[2];
#pragma unroll
  for (int e = 0; e < 16; ++e) { oacc[0][e] = 0.f; oacc[1][e] = 0.f; }
  float m_run = -1e30f, l_run = 0.f;
  for (int t = 0; t < nkt; ++t) {
    const int cur = t & 1;
    const bool more = (t + 1 < nkt);
    if (more) {
      const u16* kp = kbase + (size_t)(kt0 + t + 1) * 64 * 96 + tid * 8;
      kr0 = *(const uint4*)(kp); kr1 = *(const uint4*)(kp + 2048); kr2 = *(const uint4*)(kp + 4096);
      vr0 = *(const uint4*)(vbase + vsrc0 + (kt0 + t + 1) * 64); vr1 = *(const uint4*)(vbase + vsrc1 + (kt0 + t + 1) * 64);
    }
    const char* Kl = smem + cur * BUFB;
    const char* Vl = Kl + 64 * KROW;
    f32x16 sacc[2];
#pragma unroll
    for (int kb = 0; kb < 2; ++kb) {
#pragma unroll
      for (int e = 0; e < 16; ++e) sacc[kb][e] = 0.f;
#pragma unroll
      for (int s = 0; s < 6; ++s) {
        const bf16x8 a = *(const bf16x8*)(Kl + (32 * kb + l31) * KROW + 32 * s + 16 * hh);
        sacc[kb] = __builtin_amdgcn_mfma_f32_32x32x16_bf16(a, qf[s], sacc[kb], 0, 0, 0);
      }
    }
    float mx = sacc[0][0];
#pragma unroll
    for (int e = 1; e < 16; ++e) mx = fmaxf(mx, sacc[0][e]);
#pragma unroll
    for (int e = 0; e < 16; ++e) mx = fmaxf(mx, sacc[1][e]);
    mx = fmaxf(mx, __shfl_xor(mx, 32));
    const float m_new = fmaxf(m_run, mx);
    const float alpha = exp2f(m_run - m_new);
    m_run = m_new;
    float ps = 0.f;
#pragma unroll
    for (int kb = 0; kb < 2; ++kb)
#pragma unroll
      for (int e = 0; e < 16; ++e) { const float pv = exp2f(sacc[kb][e] - m_new); sacc[kb][e] = pv; ps += pv; }
    l_run = l_run * alpha + ps;
#pragma unroll
    for (int e = 0; e < 16; ++e) { oacc[0][e] *= alpha; oacc[1][e] *= alpha; }
#pragma unroll
    for (int kb = 0; kb < 2; ++kb)
#pragma unroll
      for (int s2 = 0; s2 < 2; ++s2) {
        const bf16x8 pfr = pack8(sacc[kb], 8 * s2);
#pragma unroll
        for (int dt = 0; dt < 2; ++dt) {
          const bf16x8 a = ld2x8((const u16*)(Vl + (32 * dt + l31) * VROW) + 32 * kb + 16 * s2 + 4 * hh);
          oacc[dt] = __builtin_amdgcn_mfma_f32_32x32x16_bf16(a, pfr, oacc[dt], 0, 0, 0);
        }
      }
    if (more) {
      char* nb = smem + (cur ^ 1) * BUFB;
      *(uint4*)(nb + kdst0) = kr0; *(uint4*)(nb + kdst1) = kr1; *(uint4*)(nb + kdst2) = kr2;
      *(uint4*)(nb + vdst0) = vr0; *(uint4*)(nb + vdst1) = vr1;
    }
    __syncthreads();
  }
  l_run += __shfl_xor(l_run, 32);
  const float inv = 1.f / l_run;
  u16* op = p.h + (size_t)p.R * 512 + (size_t)(r0 + 32 * wid + l31) * 512 + h * 64;
#pragma unroll
  for (int dt = 0; dt < 2; ++dt)
#pragma unroll
    for (int gq_ = 0; gq_ < 4; ++gq_) {
      const int dv0 = 32 * dt + 8 * gq_ + 4 * hh;
      uint2 o;
      o.x = pack2(oacc[dt][4 * gq_ + 0] * inv, oacc[dt][4 * gq_ + 1] * inv);
      o.y = pack2(oacc[dt][4 * gq_ + 2] * inv, oacc[dt][4 * gq_ + 3] * inv);
      *(uint2*)(op + dv0) = o;
    }
}

__device__ void gla_out(const Params& p, int l, int it) {
  const int tid = TIDX, lane = tid & 63, wid = tid >> 6, l31 = lane & 31, hh = lane >> 5;
  const int bl = it / (NCHUNK * 4), rem = it % (NCHUNK * 4), cidx = rem >> 2, h = rem & 3;
  const int r0 = chunk_row(bl, cidx, p.NB);
  u16* tiles = (u16*)smem;
  u16* vT = (u16*)(smem + 36864);
  float* part = (float*)(smem + 55296);
  {
    const int t = tid >> 2, c16 = (tid & 3) * 16;
#pragma unroll
    for (int a = 0; a < 4; ++a) {
      const u16* src = p.gq + (size_t)a * p.R * 256 + (size_t)(r0 + t) * 256 + h * 64 + c16;
      const uint4 u0 = *(const uint4*)src, u1 = *(const uint4*)(src + 8);
      u16* d = tiles + a * 4608 + t * 72 + c16;
      *(uint4*)d = u0; *(uint4*)(d + 8) = u1;
    }
    const int dvc = (tid & 3) * 32;
    const u16* vp = p.proj + (size_t)(r0 + t) * INW + C_VA + h * 128 + dvc;
#pragma unroll
    for (int i = 0; i < 4; ++i) {
      const uint4 vv = *(const uint4*)(vp + i * 8);
      u16* dst = vT + (size_t)(dvc + i * 8) * 72 + t;
      dst[0] = (u16)(vv.x & 0xffff); dst[72] = (u16)(vv.x >> 16);
      dst[144] = (u16)(vv.y & 0xffff); dst[216] = (u16)(vv.y >> 16);
      dst[288] = (u16)(vv.z & 0xffff); dst[360] = (u16)(vv.z >> 16);
      dst[432] = (u16)(vv.w & 0xffff); dst[504] = (u16)(vv.w >> 16);
    }
  }
  __syncthreads();
  const int itl = wid & 1, dvh = wid >> 1;
  f32x16 oacc[2];
#pragma unroll
  for (int e = 0; e < 16; ++e) { oacc[0][e] = 0.f; oacc[1][e] = 0.f; }
  const size_t cb = ((size_t)(bl * NCHUNK + cidx) * 4 + h) * 2;
#pragma unroll
  for (int dir = 0; dir < 2; ++dir) {
    const u16* Qt = tiles + (dir * 2) * 4608;
    const u16* Kt = tiles + (dir * 2 + 1) * 4608;
    bf16x8 qfr[4];
#pragma unroll
    for (int s = 0; s < 4; ++s) qfr[s] = *(const bf16x8*)(Qt + (32 * itl + l31) * 72 + 16 * s + 8 * hh);
    f32x16 aacc[2];
#pragma unroll
    for (int jt = 0; jt < 2; ++jt) {
#pragma unroll
      for (int e = 0; e < 16; ++e) aacc[jt][e] = 0.f;
#pragma unroll
      for (int s = 0; s < 4; ++s) {
        const bf16x8 a = *(const bf16x8*)(Kt + (32 * jt + l31) * 72 + 16 * s + 8 * hh);
        aacc[jt] = __builtin_amdgcn_mfma_f32_32x32x16_bf16(a, qfr[s], aacc[jt], 0, 0, 0);
      }
      const int i_tok = 32 * itl + l31;
#pragma unroll
      for (int e = 0; e < 16; ++e) {
        const int j_tok = 32 * jt + (e & 3) + 8 * (e >> 2) + 4 * hh;
        const bool keep = dir ? (j_tok >= i_tok) : (j_tok <= i_tok);
        if (!keep) aacc[jt][e] = 0.f;
      }
    }
    const u16* Sst = p.ss + (cb + dir) * 8192;
#pragma unroll
    for (int dt = 0; dt < 2; ++dt) {
      const int dvrow = 64 * dvh + 32 * dt + l31;
#pragma unroll
      for (int jt = 0; jt < 2; ++jt)
#pragma unroll
        for (int s2 = 0; s2 < 2; ++s2) {
          const bf16x8 pfr = pack8(aacc[jt], 8 * s2);
          const bf16x8 a = ld2x8(vT + dvrow * 72 + 32 * jt + 16 * s2 + 4 * hh);
          oacc[dt] = __builtin_amdgcn_mfma_f32_32x32x16_bf16(a, pfr, oacc[dt], 0, 0, 0);
        }
#pragma unroll
      for (int s = 0; s < 4; ++s) {
        const bf16x8 a = *(const bf16x8*)(Sst + dvrow * 64 + 16 * s + 8 * hh);
        oacc[dt] = __builtin_amdgcn_mfma_f32_32x32x16_bf16(a, qfr[s], oacc[dt], 0, 0, 0);
      }
    }
  }
  float ss = 0.f;
#pragma unroll
  for (int e = 0; e < 16; ++e) ss += oacc[0][e] * oacc[0][e] + oacc[1][e] * oacc[1][e];
  ss += __shfl_xor(ss, 32);
  if (hh == 0) part[wid * 32 + l31] = ss;
  __syncthreads();
  const float totss = part[wid * 32 + l31] + part[(wid ^ 2) * 32 + l31];
  const float rstd = rsqrtf(totss * (1.f / 128.f) + EPS);
  const int r = r0 + 32 * itl + l31;
  const float* gam = p.in[10] + l * 512 + h * 128;
  u16* aa = p.h;
#pragma unroll
  for (int dt = 0; dt < 2; ++dt)
#pragma unroll
    for (int gq_ = 0; gq_ < 4; ++gq_) {
      const int dv0 = 64 * dvh + 32 * dt + 8 * gq_ + 4 * hh;
      const uint2 ra = *(const uint2*)(p.proj + (size_t)r * INW + C_RA + h * 128 + dv0);
      const float4 g4 = *(const float4*)(gam + dv0);
      uint2 o;
      o.x = pack2(oacc[dt][4 * gq_ + 0] * rstd * g4.x * silu_f(bflo(ra.x)), oacc[dt][4 * gq_ + 1] * rstd * g4.y * silu_f(bfhi(ra.x)));
      o.y = pack2(oacc[dt][4 * gq_ + 2] * rstd * g4.z * silu_f(bflo(ra.y)), oacc[dt][4 * gq_ + 3] * rstd * g4.w * silu_f(bfhi(ra.y)));
      *(uint2*)(aa + (size_t)r * 512 + h * 128 + dv0) = o;
    }
}

__device__ void phase_attn(const Params& p, int l, int* ctr) {
  const int n_attn = p.NB * 8 * 66, n_gla = p.NB * NCHUNK * 4;
  int it;
  while ((it = next_item(ctr)) < n_attn + n_gla) {
    if (it < n_attn) attn_item(p, it);
    else gla_out(p, l, it - n_attn);
  }
}

__device__ void phase_merge(const Params& p, int l, int* ctr) {
  const int MT = p.R / 128, NT = 16;
  const u16* wl = p.wt + (size_t)l * W_LAYER;
  int it;
  while ((it = next_item(ctr)) < MT * NT) {
    int mt, nt; tile_order(it, MT, NT, mt, nt);
    f32x4 macc[2][4];
#pragma unroll
    for (int a = 0; a < 2; ++a)
#pragma unroll
      for (int b = 0; b < 4; ++b) macc[a][b] = f32x4{0.f, 0.f, 0.f, 0.f};
    EPI_VARS
#pragma unroll 1
    for (int br = 0; br < 3; ++br) {
      const u16* X = (br == 0) ? p.h : (br == 1) ? p.h + (size_t)p.R * 512 : p.uc;
      const u16* W = wl + (br == 0 ? W_BRA : br == 1 ? W_BRB : W_BRC);
      f32x4 acc[2][4];
      gemm_core<2>(X + (size_t)mt * 128 * 512, 512, W + (size_t)nt * 64 * 512, 512, 512, acc);
#pragma unroll
      for (int wi = 0; wi < 2; ++wi)
#pragma unroll
        for (int xi = 0; xi < 4; ++xi) {
          const int r = mt * 128 + EPI_TR(xi), n = nt * 64 + wc_ * 32 + wi * 16 + fq_ * 4;
          const uint2 gt = *(const uint2*)(p.proj + (size_t)r * INW + C_GATE + br * 1024 + n);
          macc[wi][xi][0] += sigmoid_f(bflo(gt.x)) * acc[wi][xi][0];
          macc[wi][xi][1] += sigmoid_f(bfhi(gt.x)) * acc[wi][xi][1];
          macc[wi][xi][2] += sigmoid_f(bflo(gt.y)) * acc[wi][xi][2];
          macc[wi][xi][3] += sigmoid_f(bfhi(gt.y)) * acc[wi][xi][3];
        }
    }
#pragma unroll
    for (int wi = 0; wi < 2; ++wi)
#pragma unroll
      for (int xi = 0; xi < 4; ++xi) {
        const int r = mt * 128 + EPI_TR(xi), n = nt * 64 + wc_ * 32 + wi * 16 + fq_ * 4;
        uint2 o; o.x = pack2(macc[wi][xi][0], macc[wi][xi][1]); o.y = pack2(macc[wi][xi][2], macc[wi][xi][3]);
        *(uint2*)(p.m + (size_t)r * DM + n) = o;
      }
  }
}

__device__ void phase_resid(const Params& p, int l, int g, int which, int* ctr) {
  const int MT = p.R / 128, NT = 8;
  const u16* wl = p.wt + (size_t)l * W_LAYER;
  const u16* X = which == 0 ? p.m : p.proj + (size_t)p.R * DFF;
  const int ldx = which == 0 ? DM : DFF, K = which == 0 ? DM : DFF;
  const u16* W = wl + (which == 0 ? W_O : W_DN);
  const int goff = which == 0 ? 2048 : 5120;
  const int from_input = (which == 0 && l == 0);
  int it;
  while ((it = next_item(ctr)) < MT * NT) {
    int mt, nt; tile_order(it, MT, NT, mt, nt);
    f32x4 acc[4][4];
    gemm_core<4>(X + (size_t)mt * 128 * ldx, ldx, W + (size_t)nt * 128 * K, K, K, acc);
    EPI_VARS
    const float* mrow = p.mod + ((size_t)l * 9 + mod_index(p, g, mt * 128)) * 6144 + goff;
#pragma unroll
    for (int xi = 0; xi < 4; ++xi) {
      const int r = mt * 128 + EPI_TR(xi);
      const float* xs = xsrc_row_ptr(p, g, r, from_input);
      float* xd = xrow_ptr(p, g, r);
#pragma unroll
      for (int wi = 0; wi < 4; ++wi) {
        const int n = nt * 128 + EPI_NN(wi);
        const float4 xv = *(const float4*)(xs + n);
        const float4 gv = *(const float4*)(mrow + n);
        float4 o;
        o.x = xv.x + gv.x * acc[wi][xi][0]; o.y = xv.y + gv.y * acc[wi][xi][1];
        o.z = xv.z + gv.z * acc[wi][xi][2]; o.w = xv.w + gv.w * acc[wi][xi][3];
        *(float4*)(xd + n) = o;
      }
    }
  }
}

__device__ void phase_gu(const Params& p, int l, int* ctr) {
  const int MT = p.R / 128, NT = 44;
  const u16* W = p.wt + (size_t)l * W_LAYER + W_GU;
  int it;
  while ((it = next_item(ctr)) < MT * NT) {
    int mt, nt; tile_order(it, MT, NT, mt, nt);
    f32x4 acc[4][4];
    gemm_core<4>(p.h + (size_t)mt * 128 * DM, DM, W + (size_t)nt * 128 * DM, DM, DM, acc);
    EPI_VARS
    u16* dst = p.proj + (nt >= 22 ? (size_t)p.R * DFF : 0);
    const int nb = (nt >= 22 ? nt - 22 : nt) * 128;
#pragma unroll
    for (int wi = 0; wi < 4; ++wi)
#pragma unroll
      for (int xi = 0; xi < 4; ++xi) {
        const int r = mt * 128 + EPI_TR(xi), n = nb + EPI_NN(wi);
        uint2 o; o.x = pack2(acc[wi][xi][0], acc[wi][xi][1]); o.y = pack2(acc[wi][xi][2], acc[wi][xi][3]);
        *(uint2*)(dst + (size_t)r * DFF + n) = o;
      }
  }
}

__device__ void phase_act(const Params& p, int l, int* ctr) {
  const int nitems = p.R / 8;
  const float* cw = p.in[23] + (size_t)l * 3 * DFF;
  const float* cb = p.in[24] + (size_t)l * DFF;
  const u16* G = p.proj;
  u16* UP = p.proj + (size_t)p.R * DFF;
  int it;
  while ((it = next_item(ctr)) < nitems) {
    for (int e = TIDX; e < 8 * 352; e += 256) {
      const int rr = e / 352, c0 = (e % 352) * 8;
      const int r = it * 8 + rr;
      int bl, pos, isctx; rowinfo(r, p.NB, bl, pos, isctx);
      const int L = isctx ? CTXL : SEQ;
      const u16* gp = G + (size_t)r * DFF + c0;
      const uint4 g1 = *(const uint4*)gp;
      uint4 g0 = make_uint4(0, 0, 0, 0), g2 = g0;
      if (pos > 0) g0 = *(const uint4*)(gp - DFF);
      if (pos < L - 1) g2 = *(const uint4*)(gp + DFF);
      const uint4 uu = *(const uint4*)(UP + (size_t)r * DFF + c0);
      const float4 w0a = *(const float4*)(cw + c0), w0b = *(const float4*)(cw + c0 + 4);
      const float4 w1a = *(const float4*)(cw + DFF + c0), w1b = *(const float4*)(cw + DFF + c0 + 4);
      const float4 w2a = *(const float4*)(cw + 2 * DFF + c0), w2b = *(const float4*)(cw + 2 * DFF + c0 + 4);
      const float4 ba = *(const float4*)(cb + c0), bb = *(const float4*)(cb + c0 + 4);
      uint4 o;
#define ACT2(G0, G1, G2, UU, W0L, W0H, W1L, W1H, W2L, W2H, BL, BH) \
      pack2(silu_f(W0L * bflo(G0) + W1L * bflo(G1) + W2L * bflo(G2) + BL) * bflo(UU), \
            silu_f(W0H * bfhi(G0) + W1H * bfhi(G1) + W2H * bfhi(G2) + BH) * bfhi(UU))
      o.x = ACT2(g0.x, g1.x, g2.x, uu.x, w0a.x, w0a.y, w1a.x, w1a.y, w2a.x, w2a.y, ba.x, ba.y);
      o.y = ACT2(g0.y, g1.y, g2.y, uu.y, w0a.z, w0a.w, w1a.z, w1a.w, w2a.z, w2a.w, ba.z, ba.w);
      o.z = ACT2(g0.z, g1.z, g2.z, uu.z, w0b.x, w0b.y, w1b.x, w1b.y, w2b.x, w2b.y, bb.x, bb.y);
      o.w = ACT2(g0.w, g1.w, g2.w, uu.w, w0b.z, w0b.w, w1b.z, w1b.w, w2b.z, w2b.w, bb.z, bb.w);
#undef ACT2
      *(uint4*)(UP + (size_t)r * DFF + c0) = o;
    }
  }
}

__device__ void phase_final(const Params& p, int* ctr) {
  const int nitems = NBATCH * SEQ / 16;
  const float* gam = p.in[26];
  int it;
  while ((it = next_item(ctr)) < nitems) {
    const int lane = TIDX & 63, wid = TIDX >> 6;
    for (int rr = 0; rr < 4; ++rr) {
      float* xr = p.out + ((size_t)it * 16 + wid * 4 + rr) * DM;
      float4 v[4]; float ss = 0.f;
#pragma unroll
      for (int i = 0; i < 4; ++i) {
        v[i] = *(const float4*)(xr + lane * 4 + i * 256);
        ss += v[i].x * v[i].x + v[i].y * v[i].y + v[i].z * v[i].z + v[i].w * v[i].w;
      }
      ss = wave_sum(ss);
      const float rstd = rsqrtf(ss * (1.f / 1024.f) + EPS);
#pragma unroll
      for (int i = 0; i < 4; ++i) {
        const int c = lane * 4 + i * 256;
        const float4 gg = *(const float4*)(gam + c);
        float4 o; o.x = v[i].x * rstd * gg.x; o.y = v[i].y * rstd * gg.y; o.z = v[i].z * rstd * gg.z; o.w = v[i].w * rstd * gg.w;
        *(float4*)(xr + c) = o;
      }
    }
  }
}

__device__ void run_phase(const Params& p, int ph) {
  int* ctr = p.ctr + ph;
  if (ph == 0) { phase0(p, ctr); return; }
  if (ph == p.nph - 1) { phase_final(p, ctr); return; }
  const int idx = ph - 1, lg = idx / NPH_PER, sub = idx % NPH_PER;
  const int l = lg / p.NG, g = lg % p.NG;
  switch (sub) {
    case 0: phase_norm(p, l, g, 0, ctr); break;
    case 1: phase_proj(p, l, ctr); break;
    case 2: phase_postproj(p, l, ctr); break;
    case 3: phase_qkv(p, l, ctr); break;
    case 4: phase_attn(p, l, ctr); break;
    case 5: phase_merge(p, l, ctr); break;
    case 6: phase_resid(p, l, g, 0, ctr); break;
    case 7: phase_norm(p, l, g, 1, ctr); break;
    case 8: phase_gu(p, l, ctr); break;
    case 9: phase_act(p, l, ctr); break;
    default: phase_resid(p, l, g, 1, ctr); break;
  }
}

__global__ void __launch_bounds__(256, 2) mega_kernel(Params p, int ph_lo, int ph_hi, int coop) {
  for (int ph = ph_lo; ph < ph_hi; ++ph) {
    run_phase(p, ph);
    if (coop && ph + 1 < ph_hi) cg::this_grid().sync();
  }
}

static inline size_t align_up(size_t v) { return (v + 255) & ~(size_t)255; }

extern "C" void kernel_launch(void* const* d_in, const int* in_sizes, int n_in, void* d_out, int out_size,
                              void* d_ws, size_t ws_size, hipStream_t stream) {
  static int grid_blocks = 0;
  if (!grid_blocks) {
    int dev = 0, cus = 0, per_cu = 0;
    hipGetDevice(&dev);
    hipDeviceGetAttribute(&cus, hipDeviceAttributeMultiprocessorCount, dev);
    hipFuncSetAttribute((const void*)mega_kernel, hipFuncAttributeMaxDynamicSharedMemorySize, LDS_BYTES);
    hipOccupancyMaxActiveBlocksPerMultiprocessor(&per_cu, (const void*)mega_kernel, 256, LDS_BYTES);
    if (per_cu < 1) per_cu = 1;
    if (per_cu > 2) per_cu = 2;
    grid_blocks = cus * per_cu;
  }
  Params p{};
  for (int i = 0; i < 27; ++i) p.in[i] = (const float*)d_in[i];
  p.out = (float*)d_out;
  int NB = 4;
  size_t off[20];
  for (;;) {
    const size_t R = (size_t)NB * (SEQ + CTXL);
    size_t o = 0; int k = 0;
    off[k++] = o; o = align_up(o + 4096);
    off[k++] = o; o = align_up(o + (size_t)2 * 9 * 6144 * 4);
    off[k++] = o; o = align_up(o + 1024 * 2 * 4);
    off[k++] = o; o = align_up(o + (size_t)NBATCH * CTXL * DM * 4);
    off[k++] = o; o = align_up(o + R * 4);
    off[k++] = o; o = align_up(o + R * 4);
    off[k++] = o; o = align_up(o + (size_t)NB * NCHUNK * 4 * 2 * 64 * 4);
    off[k++] = o; o = align_up(o + 2 * W_LAYER * 2);
    off[k++] = o; o = align_up(o + R * INW * 2);
    off[k++] = o; o = o + R * DM * 2;
    off[k++] = o; o = align_up(o + R * DM * 2);
    off[k++] = o; o = align_up(o + R * 768 * 2);
    off[k++] = o; o = align_up(o + (size_t)NB * 8 * NKEY * 96 * 2);
    off[k++] = o; o = align_up(o + (size_t)NB * 8 * 64 * NKEY * 2);
    off[k++] = o; o = align_up(o + R * 512 * 2);
    off[k++] = o; o = align_up(o + R * 1024 * 2);
    off[k++] = o; o = align_up(o + (size_t)NB * NCHUNK * 4 * 2 * 8192 * 2);
    if (o <= ws_size || NB == 1) break;
    NB >>= 1;
  }
  char* ws = (char*)d_ws;
  p.ctr = (int*)(ws + off[0]); p.mod = (float*)(ws + off[1]); p.rope = (float*)(ws + off[2]); p.xc = (float*)(ws + off[3]);
  p.rstdq = (float*)(ws + off[4]); p.rstdkv = (float*)(ws + off[5]); p.dec = (float*)(ws + off[6]); p.wt = (u16*)(ws + off[7]);
  p.proj = (u16*)(ws + off[8]); p.h = (u16*)(ws + off[9]); p.m = (u16*)(ws + off[10]); p.q = (u16*)(ws + off[11]);
  p.kf = (u16*)(ws + off[12]); p.vt = (u16*)(ws + off[13]); p.uc = (u16*)(ws + off[14]); p.gq = (u16*)(ws + off[15]);
  p.ss = (u16*)(ws + off[16]);
  p.NB = NB; p.NG = NBATCH / NB; p.R = NB * (SEQ + CTXL);
  p.nph = 1 + 2 * p.NG * NPH_PER + 1;
  hipMemsetAsync(p.ctr, 0, 4096, stream);
#if SINGLE_LAUNCH
  int lo = 0, hi = p.nph, coop = 1;
  void* args[] = {&p, &lo, &hi, &coop};
  hipError_t e = hipLaunchCooperativeKernel((const void*)mega_kernel, dim3(grid_blocks), dim3(256), args, LDS_BYTES, stream);
  if (e != hipSuccess) fprintf(stderr, "cooperative launch failed: %s (grid %d)\n", hipGetErrorString(e), grid_blocks);
#else
  for (int ph = 0; ph < p.nph; ++ph)
    hipLaunchKernelGGL(mega_kernel, dim3(grid_blocks), dim3(256), LDS_BYTES, stream, p, ph, ph + 1, 0);
#endif
}
```

```cpp
#include <hip/hip_runtime.h>
#include <hip/hip_cooperative_groups.h>
#include <cstdio>
#include <cstdint>
namespace cg = cooperative_groups;

typedef unsigned short u16;
typedef __attribute__((ext_vector_type(8))) short bf16x8;
typedef __attribute__((ext_vector_type(4))) float f32x4;
typedef __attribute__((ext_vector_type(16))) float f32x16;

#ifndef SINGLE_LAUNCH
#define SINGLE_LAUNCH 1
#endif

constexpr int DM = 1024, SEQ = 8192, CTXL = 256, NBATCH = 8, INW = 6592, INWP = 6656, DFF = 2816;
constexpr int C_QA = 0, C_KA = 256, C_VA = 512, C_RA = 1024, C_ALR = 1536, C_CQ = 1568, C_CKV = 1824,
              C_KR = 1952, C_SB = 1984, C_SC = 2496, C_SX = 3008, C_GATE = 3520;
constexpr int NKEY = SEQ + CTXL;
constexpr int NCHUNK = NKEY / 64;
constexpr float EPS = 1e-6f;
constexpr int LDS_BYTES = 65536 + 256;
constexpr int SLOT_OFF = 65536;
constexpr int NPH_PER = 11;

constexpr size_t W_IN = 0;
constexpr size_t W_UQ = W_IN + (size_t)INWP * 1024;
constexpr size_t W_UKV = W_UQ + 768 * 256;
constexpr size_t W_BRA = W_UKV + 1024 * 128;
constexpr size_t W_BRB = W_BRA + 1024 * 512;
constexpr size_t W_BRC = W_BRB + 1024 * 512;
constexpr size_t W_O = W_BRC + 1024 * 512;
constexpr size_t W_GU = W_O + 1024 * 1024;
constexpr size_t W_DN = W_GU + (size_t)5632 * 1024;
constexpr size_t W_LAYER = W_DN + (size_t)1024 * 2816;

struct Params {
  const float* in[27];
  float* out;
  float* xc;
  u16* wt;
  float* mod;
  float* rope;
  int* ctr;
  float* rstdq;
  float* rstdkv;
  float* dec;
  u16* proj;
  u16* h;
  u16* m;
  u16* q;
  u16* kf;
  u16* vt;
  u16* uc;
  u16* gq;
  u16* ss;
  int NB, NG, R, nph;
};

extern __shared__ __attribute__((aligned(16))) char smem[];

typedef __bf16 hbf2 __attribute__((ext_vector_type(2)));
typedef float hf2 __attribute__((ext_vector_type(2)));
__device__ __forceinline__ unsigned pack2(float a, float b) {
  hf2 v = {a, b};
  return __builtin_bit_cast(unsigned, __builtin_convertvector(v, hbf2));
}
__device__ __forceinline__ u16 f2bf(float f) { return (u16)(pack2(f, 0.f) & 0xffffu); }
__device__ __forceinline__ float bf2f(u16 h) { return __uint_as_float(((unsigned)h) << 16); }
__device__ __forceinline__ float bflo(unsigned u) { return __uint_as_float(u << 16); }
__device__ __forceinline__ float bfhi(unsigned u) { return __uint_as_float(u & 0xffff0000u); }
__device__ __forceinline__ float silu_f(float x) { return x / (1.f + __expf(-x)); }
__device__ __forceinline__ float sigmoid_f(float x) { return 1.f / (1.f + __expf(-x)); }

__device__ __forceinline__ void rowinfo(int r, int NB, int& bl, int& pos, int& isctx) {
  const int nl = NB * SEQ;
  if (r < nl) { bl = r >> 13; pos = r & (SEQ - 1); isctx = 0; }
  else { const int rc = r - nl; bl = rc >> 8; pos = rc & (CTXL - 1); isctx = 1; }
}
__device__ __forceinline__ int chunk_row(int bl, int cidx, int NB) {
  return cidx < 128 ? bl * SEQ + cidx * 64 : NB * SEQ + bl * CTXL + (cidx - 128) * 64;
}

template <class CntF, class BodyF>
__device__ __forceinline__ void run_q8(int* ctr8, CntF cntf, BodyF body) {
  volatile int* slot = (volatile int*)(smem + SLOT_OFF);
  int q = blockIdx.x & 7, tries = 0, item;
  __syncthreads();
  if (threadIdx.x == 0) {
    int v = atomicAdd(&ctr8[q], 1);
    while (v >= cntf(q) && tries < 8) { q = (q + 1) & 7; ++tries; if (tries < 8) v = atomicAdd(&ctr8[q], 1); }
    slot[0] = (tries < 8) ? v : -1; slot[1] = q; slot[2] = tries;
  }
  __syncthreads();
  item = slot[0]; q = slot[1]; tries = slot[2];
  while (item >= 0) {
    int nxt = 0;
    if (threadIdx.x == 0) nxt = atomicAdd(&ctr8[q], 1);
    body(q, item);
    __syncthreads();
    if (threadIdx.x == 0) {
      int qq = q, t = tries;
      while (nxt >= cntf(qq) && t < 8) { qq = (qq + 1) & 7; ++t; if (t < 8) nxt = atomicAdd(&ctr8[qq], 1); }
      slot[0] = (t < 8) ? nxt : -1; slot[1] = qq; slot[2] = t;
    }
    __syncthreads();
    item = slot[0]; q = slot[1]; tries = slot[2];
  }
}
#define QA_CNT(N) [=](int q_) { return ((N) - q_ + 7) >> 3; }
#define QA_ID(q_, j_) ((j_) * 8 + (q_))

__device__ __forceinline__ int opaque_tid() {
  int t = threadIdx.x;
  asm volatile("" : "+v"(t));
  return t;
}
#define TIDX opaque_tid()
__device__ __forceinline__ float wave_sum(float v) {
  v += __shfl_xor(v, 32); v += __shfl_xor(v, 16); v += __shfl_xor(v, 8);
  v += __shfl_xor(v, 4); v += __shfl_xor(v, 2); v += __shfl_xor(v, 1);
  return v;
}

__device__ __forceinline__ int lds_byte(int r, int c) {
  const int st = (r >> 4) * 2 + (c >> 5), rr = r & 15, cc = c & 31, ob = rr * 64 + cc * 2;
  return st * 1024 + (ob ^ (((ob >> 9) & 1) << 5));
}
__device__ __forceinline__ void stage_rc(int b, int& R, int& C) {
  const int st = b >> 10, sb = b & 1023, swz = sb ^ (((sb >> 9) & 1) << 5);
  R = (st >> 1) * 16 + (swz >> 6); C = (st & 1) * 32 + ((swz & 63) >> 1);
}

__device__ __forceinline__ void glds16(const void* g, void* l) {
  __builtin_amdgcn_global_load_lds((const __attribute__((address_space(1))) unsigned*)g,
                                   (__attribute__((address_space(3))) unsigned*)l, 16, 0, 0);
}

template <int NWI>
__device__ __forceinline__ void gemm_core(const u16* __restrict__ X, int ldx, const u16* __restrict__ W, int ldw,
                                          int K, f32x4 (&acc)[NWI][4]) {
  const int tid = TIDX, lane = tid & 63, wid = tid >> 6;
  const int wr = wid >> 1, wc = wid & 1, fr = lane & 15, fq = lane >> 4;
#pragma unroll
  for (int a = 0; a < NWI; ++a)
#pragma unroll
    for (int b = 0; b < 4; ++b) acc[a][b] = f32x4{0.f, 0.f, 0.f, 0.f};
  int R0, C0; stage_rc(tid * 16, R0, C0);
  const u16* xg = X + (size_t)R0 * ldx + C0;
  const u16* wg = W + (size_t)R0 * ldw + C0;
  const int xs = 32 * ldx, ws_ = 32 * ldw;
  const int lane_off = (fr * 64 + fq * 16) ^ (((fr >> 3) & 1) << 5);
  const char* xb = smem + wr * 8192 + lane_off;
  const char* wb = smem + 16384 + wc * (NWI * 2048) + lane_off;
  char* sdst = smem + tid * 16;
  const int nt = K >> 6;
  __syncthreads();
#pragma unroll
  for (int i = 0; i < 4; ++i) {
    glds16(xg + i * xs, sdst + i * 4096);
    if (i < NWI) glds16(wg + i * ws_, sdst + 16384 + i * 4096);
  }
  for (int kt = 0; kt < nt; ++kt) {
    asm volatile("s_waitcnt vmcnt(0)" ::: "memory");
    __syncthreads();
    const int cb = (kt & 1) * 32768;
    if (kt + 1 < nt) {
      const int nb = 32768 - cb;
      const int ko = (kt + 1) * 64;
#pragma unroll
      for (int i = 0; i < 4; ++i) {
        glds16(xg + i * xs + ko, sdst + nb + i * 4096);
        if (i < NWI) glds16(wg + i * ws_ + ko, sdst + nb + 16384 + i * 4096);
      }
    }
#pragma unroll
    for (int k = 0; k < 2; ++k) {
      bf16x8 wf[NWI], xf[4];
#pragma unroll
      for (int i = 0; i < NWI; ++i) wf[i] = *(const bf16x8*)(wb + cb + i * 2048 + k * 1024);
#pragma unroll
      for (int i = 0; i < 4; ++i) xf[i] = *(const bf16x8*)(xb + cb + i * 2048 + k * 1024);
#pragma unroll
      for (int wi = 0; wi < NWI; ++wi)
#pragma unroll
        for (int xi = 0; xi < 4; ++xi)
          acc[wi][xi] = __builtin_amdgcn_mfma_f32_16x16x32_bf16(wf[wi], xf[xi], acc[wi][xi], 0, 0, 0);
    }
  }
}

#define EPI_VARS const int tid_ = TIDX, lane_ = tid_ & 63, wid_ = tid_ >> 6; \
  const int wr_ = wid_ >> 1, wc_ = wid_ & 1, fr_ = lane_ & 15, fq_ = lane_ >> 4; (void)fq_; (void)fr_; (void)wr_; (void)wc_;
#define EPI_TR(xi) (wr_ * 64 + (xi) * 16 + fr_)
#define EPI_NN(wi) (wc_ * 64 + (wi) * 16 + fq_ * 4)

__device__ __forceinline__ void tile_order(int t, int MT, int NT, int& mt, int& nt) {
  constexpr int GM = 8;
  const int band = t / (GM * NT), rem = t - band * GM * NT;
  const int m0 = band * GM;
  const int gsz = min(GM, MT - m0);
  nt = rem / gsz; mt = m0 + rem - nt * gsz;
}

__device__ __forceinline__ int mlo(int q, int MT) { return (q * MT) >> 3; }
#define GEMM_CNT(MT, NT) [=](int q_) { return (mlo(q_ + 1, MT) - mlo(q_, MT)) * (NT); }

__device__ __forceinline__ float* xrow_ptr(const Params& p, int g, int r) {
  int bl, pos, isctx; rowinfo(r, p.NB, bl, pos, isctx);
  const int b = g * p.NB + bl;
  return isctx ? p.xc + ((size_t)b * CTXL + pos) * DM : p.out + ((size_t)b * SEQ + pos) * DM;
}
__device__ __forceinline__ const float* xsrc_row_ptr(const Params& p, int g, int r, int from_input) {
  int bl, pos, isctx; rowinfo(r, p.NB, bl, pos, isctx);
  const int b = g * p.NB + bl;
  if (from_input) return isctx ? p.in[2] + ((size_t)b * CTXL + pos) * DM : p.in[0] + ((size_t)b * SEQ + pos) * DM;
  return isctx ? p.xc + ((size_t)b * CTXL + pos) * DM : p.out + ((size_t)b * SEQ + pos) * DM;
}
__device__ __forceinline__ int mod_index(const Params& p, int g, int r) {
  int bl, pos, isctx; rowinfo(r, p.NB, bl, pos, isctx);
  return isctx ? 8 : g * p.NB + bl;
}

__device__ void conv_tile(const float* __restrict__ src, int K, int N, u16* __restrict__ dst,
                          const float* __restrict__ scale, int ktile, int ntile) {
  float* tile = (float*)smem;
  const int tid = TIDX;
  const int k0 = ktile * 64, n0 = ntile * 64;
  const bool valid = n0 < N;
  if (valid) {
    const int kk = tid >> 4, n4 = (tid & 15) * 4;
#pragma unroll
    for (int i = 0; i < 4; ++i) {
      const int k = kk + 16 * i;
      const float4 v = *(const float4*)(src + (size_t)(k0 + k) * N + n0 + n4);
      const float s = scale ? scale[k0 + k] : 1.f;
      tile[k * 65 + n4 + 0] = v.x * s; tile[k * 65 + n4 + 1] = v.y * s;
      tile[k * 65 + n4 + 2] = v.z * s; tile[k * 65 + n4 + 3] = v.w * s;
    }
  }
  __syncthreads();
  const int nn = tid >> 3, k8 = (tid & 7) * 8;
#pragma unroll
  for (int i = 0; i < 2; ++i) {
    const int n = nn + 32 * i;
    uint4 o = make_uint4(0, 0, 0, 0);
    if (valid) {
      o.x = pack2(tile[(k8 + 0) * 65 + n], tile[(k8 + 1) * 65 + n]);
      o.y = pack2(tile[(k8 + 2) * 65 + n], tile[(k8 + 3) * 65 + n]);
      o.z = pack2(tile[(k8 + 4) * 65 + n], tile[(k8 + 5) * 65 + n]);
      o.w = pack2(tile[(k8 + 6) * 65 + n], tile[(k8 + 7) * 65 + n]);
    }
    *(uint4*)(dst + (size_t)(n0 + n) * K + k0 + k8) = o;
  }
}

__device__ void sincos_d(double a, double& s, double& c) {
  const double k = rint(a * 0.6366197723675814);
  double r = fma(-k, 1.5707963267948966, a);
  r = fma(-k, 6.123233995736766e-17, r);
  const int q = ((int)k) & 3;
  const double r2 = r * r;
  const double sp = r * (1.0 + r2 * (-1.0 / 6 + r2 * (1.0 / 120 + r2 * (-1.0 / 5040 + r2 * (1.0 / 362880 + r2 * (-1.0 / 39916800 + r2 * (1.0 / 6227020800.0)))))));
  const double cp = 1.0 + r2 * (-0.5 + r2 * (1.0 / 24 + r2 * (-1.0 / 720 + r2 * (1.0 / 40320 + r2 * (-1.0 / 3628800 + r2 * (1.0 / 479001600.0 + r2 * (-1.0 / 87178291200.0)))))));
  s = (q == 0) ? sp : (q == 1) ? cp : (q == 2) ? -sp : -cp;
  c = (q == 0) ? cp : (q == 1) ? -sp : (q == 2) ? -cp : sp;
}

constexpr int CV_WIN = 0, CV_UQ = 1664, CV_UKV = 1712, CV_BRA = 1744, CV_BRB = 1872, CV_BRC = 2000,
              CV_WO = 2128, CV_GATE = 2384, CV_UP = 3088, CV_DN = 3792, CV_LAYER = 4496;
constexpr int P0_CONV = 2 * CV_LAYER, P0_ADA = 2 * 192, P0_TOTAL = P0_CONV + P0_ADA + 1;

__device__ void phase0(const Params& p, int* ctr) {
  run_q8(ctr, QA_CNT(P0_TOTAL), [&](int q_, int j_) {
    const int it = QA_ID(q_, j_);
    const int tid = TIDX;
    if (it < P0_CONV) {
      const int l = it / CV_LAYER, j = it % CV_LAYER;
      u16* wl = p.wt + (size_t)l * W_LAYER;
      if (j < CV_UQ)       { const int jj = j - CV_WIN;  conv_tile(p.in[7] + (size_t)l * 1024 * INW, 1024, INW, wl + W_IN, nullptr, jj / 104, jj % 104); }
      else if (j < CV_UKV) { const int jj = j - CV_UQ;   conv_tile(p.in[12] + (size_t)l * 256 * 768, 256, 768, wl + W_UQ, p.in[11] + l * 256, jj / 12, jj % 12); }
      else if (j < CV_BRA) { const int jj = j - CV_UKV;  conv_tile(p.in[14] + (size_t)l * 128 * 1024, 128, 1024, wl + W_UKV, p.in[13] + l * 128, jj / 16, jj % 16); }
      else if (j < CV_BRB) { const int jj = j - CV_BRA;  conv_tile(p.in[16] + (size_t)l * 512 * 1024, 512, 1024, wl + W_BRA, nullptr, jj / 16, jj % 16); }
      else if (j < CV_BRC) { const int jj = j - CV_BRB;  conv_tile(p.in[17] + (size_t)l * 512 * 1024, 512, 1024, wl + W_BRB, nullptr, jj / 16, jj % 16); }
      else if (j < CV_WO)  { const int jj = j - CV_BRC;  conv_tile(p.in[18] + (size_t)l * 512 * 1024, 512, 1024, wl + W_BRC, nullptr, jj / 16, jj % 16); }
      else if (j < CV_GATE){ const int jj = j - CV_WO;   conv_tile(p.in[19] + (size_t)l * 1024 * 1024, 1024, 1024, wl + W_O, nullptr, jj / 16, jj % 16); }
      else if (j < CV_UP)  { const int jj = j - CV_GATE; conv_tile(p.in[21] + (size_t)l * 1024 * DFF, 1024, DFF, wl + W_GU, nullptr, jj / 44, jj % 44); }
      else if (j < CV_DN)  { const int jj = j - CV_UP;   conv_tile(p.in[22] + (size_t)l * 1024 * DFF, 1024, DFF, wl + W_GU + (size_t)DFF * 1024, nullptr, jj / 44, jj % 44); }
      else                 { const int jj = j - CV_DN;   conv_tile(p.in[25] + (size_t)l * DFF * 1024, DFF, 1024, wl + W_DN, nullptr, jj / 16, jj % 16); }
    } else if (it < P0_CONV + P0_ADA) {
      const int a = it - P0_CONV, l = a / 192, cg_ = a % 192;
      float* sc = (float*)smem;
      float* red = sc + 9 * 1024;
      for (int e = tid; e < 9 * 1024; e += 256) {
        const int v = e >> 10, k = e & 1023;
        const float cv = (v < 8) ? p.in[1][v * 1024 + k] : p.in[3][k];
        sc[e] = cv / (1.f + expf(-cv));
      }
      __syncthreads();
      const int kg = tid >> 5, cn = tid & 31;
      const float* wa = p.in[4] + (size_t)l * 1024 * 6144 + cg_ * 32 + cn;
      float a0 = 0, a1 = 0, a2 = 0, a3 = 0, a4 = 0, a5 = 0, a6 = 0, a7 = 0, a8 = 0;
#pragma unroll 8
      for (int i = 0; i < 128; ++i) {
        const int k = kg + 8 * i;
        const float w = wa[(size_t)k * 6144];
        a0 += sc[k] * w; a1 += sc[1024 + k] * w; a2 += sc[2048 + k] * w; a3 += sc[3072 + k] * w;
        a4 += sc[4096 + k] * w; a5 += sc[5120 + k] * w; a6 += sc[6144 + k] * w; a7 += sc[7168 + k] * w;
        a8 += sc[8192 + k] * w;
      }
      float* rr = red + kg * 288 + cn;
      rr[0] = a0; rr[32] = a1; rr[64] = a2; rr[96] = a3; rr[128] = a4; rr[160] = a5; rr[192] = a6; rr[224] = a7; rr[256] = a8;
      __syncthreads();
      for (int e = tid; e < 288; e += 256) {
        float s = 0.f;
#pragma unroll
        for (int g8 = 0; g8 < 8; ++g8) s += red[g8 * 288 + e];
        const int v = e >> 5, n = cg_ * 32 + (e & 31);
        p.mod[((size_t)l * 9 + v) * 6144 + n] = s + p.in[5][l * 6144 + n];
      }
    } else {
      for (int e = tid; e < 1024; e += 256) {
        const int pos = e >> 3, f = e & 7;
        const float inv = (f == 0) ? 1.0f : (f == 1) ? 0.31622776601683794f : (f == 2) ? 0.1f : (f == 3) ? 0.031622776601683794f
                        : (f == 4) ? 0.01f : (f == 5) ? 0.0031622776601683794f : (f == 6) ? 0.001f : 0.00031622776601683794f;
        const float ang = (float)pos * inv;
        double s, c; sincos_d((double)ang, s, c);
        p.rope[e * 2] = (float)c; p.rope[e * 2 + 1] = (float)s;
      }
    }
  });
}

__device__ void phase_norm(const Params& p, int l, int g, int which, int* ctr) {
  const int nitems = p.R / 16;
  const float* gam = (which == 0 ? p.in[6] : p.in[20]) + l * DM;
  const int shoff = which == 0 ? 0 : 3072, scoff = which == 0 ? 1024 : 4096;
  const int from_input = (which == 0 && l == 0);
  for (int it = blockIdx.x; it < nitems; it += gridDim.x) {
    const int lane = TIDX & 63, wid = TIDX >> 6;
    for (int rr = 0; rr < 4; ++rr) {
      const int r = it * 16 + wid * 4 + rr;
      const float* xr = xsrc_row_ptr(p, g, r, from_input);
      const float* mrow = p.mod + ((size_t)l * 9 + mod_index(p, g, r)) * 6144;
      float4 v[4]; float ss = 0.f;
#pragma unroll
      for (int i = 0; i < 4; ++i) {
        v[i] = *(const float4*)(xr + lane * 4 + i * 256);
        ss += v[i].x * v[i].x + v[i].y * v[i].y + v[i].z * v[i].z + v[i].w * v[i].w;
      }
      ss = wave_sum(ss);
      const float rstd = rsqrtf(ss * (1.f / 1024.f) + EPS);
#pragma unroll
      for (int i = 0; i < 4; ++i) {
        const int c = lane * 4 + i * 256;
        const float4 gg = *(const float4*)(gam + c);
        const float4 sh = *(const float4*)(mrow + shoff + c);
        const float4 sc = *(const float4*)(mrow + scoff + c);
        uint2 o;
        o.x = pack2(v[i].x * rstd * gg.x * (1.f + sc.x) + sh.x, v[i].y * rstd * gg.y * (1.f + sc.y) + sh.y);
        o.y = pack2(v[i].z * rstd * gg.z * (1.f + sc.z) + sh.z, v[i].w * rstd * gg.w * (1.f + sc.w) + sh.w);
        *(uint2*)(p.h + (size_t)r * DM + c) = o;
      }
    }
  }
}

__device__ void phase_proj(const Params& p, int l, int* ctr) {
  const int MT = p.R / 128, NT = INWP / 128;
  const u16* W = p.wt + (size_t)l * W_LAYER + W_IN;
  run_q8(ctr, GEMM_CNT(MT, NT), [&](int q_, int j_) {
    int mt, nt; tile_order(j_, mlo(q_ + 1, MT) - mlo(q_, MT), NT, mt, nt); mt += mlo(q_, MT);
    f32x4 acc[4][4];
    gemm_core<4>(p.h + (size_t)mt * 128 * DM, DM, W + (size_t)nt * 128 * DM, DM, DM, acc);
    EPI_VARS
#pragma unroll
    for (int wi = 0; wi < 4; ++wi)
#pragma unroll
      for (int xi = 0; xi < 4; ++xi) {
        const int r = mt * 128 + EPI_TR(xi), n = nt * 128 + EPI_NN(wi);
        if (n < INW) {
          uint2 o; o.x = pack2(acc[wi][xi][0], acc[wi][xi][1]); o.y = pack2(acc[wi][xi][2], acc[wi][xi][3]);
          *(uint2*)(p.proj + (size_t)r * INW + n) = o;
        }
      }
  });
}

__device__ void postproj_rows(const Params& p, int l, int it) {
  const int lane = TIDX & 63, wid = TIDX >> 6;
  const float* scw = p.in[15] + (size_t)l * 3 * 512;
  for (int rr = 0; rr < 4; ++rr) {
    const int r = it * 16 + wid * 4 + rr;
    int bl, pos, isctx; rowinfo(r, p.NB, bl, pos, isctx);
    const u16* pr = p.proj + (size_t)r * INW;
    {
      const uint2 u = *(const uint2*)(pr + C_CQ + lane * 4);
      const float a = bflo(u.x), b = bfhi(u.x), c = bflo(u.y), d = bfhi(u.y);
      float ss = wave_sum(a * a + b * b + c * c + d * d);
      if (lane == 0) p.rstdq[r] = rsqrtf(ss * (1.f / 256.f) + EPS);
    }
    {
      const unsigned u = *(const unsigned*)(pr + C_CKV + lane * 2);
      const float a = bflo(u), b = bfhi(u);
      float ss = wave_sum(a * a + b * b);
      if (lane == 0) p.rstdkv[r] = rsqrtf(ss * (1.f / 128.f) + EPS);
    }
    {
      const int idx = lane & 31;
      const float val = bf2f(pr[C_KR + idx]);
      const float partner = __shfl_xor(val, 8);
      float o = val;
      if (!isctx) {
        const int axis = idx >> 4, half = (idx >> 3) & 1, f = idx & 7;
        const int pa = axis ? (pos & 63) : (pos >> 6);
        const float c = p.rope[(pa * 8 + f) * 2], s = p.rope[(pa * 8 + f) * 2 + 1];
        o = half ? (val * c + partner * s) : (val * c - partner * s);
      }
      const int j = isctx ? SEQ + pos : pos;
      const u16 ob = f2bf(o);
      if (lane < 32) {
#pragma unroll
        for (int hd = 0; hd < 8; ++hd)
          p.kf[((size_t)(bl * 8 + hd) * NKEY + j) * 96 + 64 + idx] = ob;
      }
    }
    {
      const int L = isctx ? CTXL : SEQ;
      const int c0 = lane * 8;
      const uint4 sb = *(const uint4*)(pr + C_SB + c0);
      const uint4 sc1 = *(const uint4*)(pr + C_SC + c0);
      const uint4 sx1 = *(const uint4*)(pr + C_SX + c0);
      uint4 sc0 = make_uint4(0, 0, 0, 0), sx0 = sc0, sc2 = sc0, sx2 = sc0;
      if (pos > 0) { sc0 = *(const uint4*)(pr - INW + C_SC + c0); sx0 = *(const uint4*)(pr - INW + C_SX + c0); }
      if (pos < L - 1) { sc2 = *(const uint4*)(pr + INW + C_SC + c0); sx2 = *(const uint4*)(pr + INW + C_SX + c0); }
      const float4 w0a = *(const float4*)(scw + c0), w0b = *(const float4*)(scw + c0 + 4);
      const float4 w1a = *(const float4*)(scw + 512 + c0), w1b = *(const float4*)(scw + 512 + c0 + 4);
      const float4 w2a = *(const float4*)(scw + 1024 + c0), w2b = *(const float4*)(scw + 1024 + c0 + 4);
      uint4 o;
#define UC2(SBW, A0, X0, A1, X1, A2, X2, W0L, W0H, W1L, W1H, W2L, W2H) \
      pack2(bflo(SBW) * (W0L * bflo(A0) * bflo(X0) + W1L * bflo(A1) * bflo(X1) + W2L * bflo(A2) * bflo(X2)), \
            bfhi(SBW) * (W0H * bfhi(A0) * bfhi(X0) + W1H * bfhi(A1) * bfhi(X1) + W2H * bfhi(A2) * bfhi(X2)))
      o.x = UC2(sb.x, sc0.x, sx0.x, sc1.x, sx1.x, sc2.x, sx2.x, w0a.x, w0a.y, w1a.x, w1a.y, w2a.x, w2a.y);
      o.y = UC2(sb.y, sc0.y, sx0.y, sc1.y, sx1.y, sc2.y, sx2.y, w0a.z, w0a.w, w1a.z, w1a.w, w2a.z, w2a.w);
      o.z = UC2(sb.z, sc0.z, sx0.z, sc1.z, sx1.z, sc2.z, sx2.z, w0b.x, w0b.y, w1b.x, w1b.y, w2b.x, w2b.y);
      o.w = UC2(sb.w, sc0.w, sx0.w, sc1.w, sx1.w, sc2.w, sx2.w, w0b.z, w0b.w, w1b.z, w1b.w, w2b.z, w2b.w);
#undef UC2
      *(uint4*)(p.uc + (size_t)r * 512 + c0) = o;
    }
  }
}

__device__ __forceinline__ float logsig16(float z) {
  return (fminf(z, 0.f) - log1pf(__expf(-fabsf(z)))) * (1.f / 16.f);
}

__device__ void gla_prep(const Params& p, int l, int it) {
  const int tid = TIDX, lane = tid & 63, wid = tid >> 6;
  const int bl = it / (NCHUNK * 4), rem = it % (NCHUNK * 4), cidx = rem >> 2, h = rem & 3;
  const int r0 = chunk_row(bl, cidx, p.NB);
  float* lr = (float*)smem;
  float* tot = (float*)(smem + 8192);
  u16* vT = (u16*)(smem + 10752);
  u16* kTf = (u16*)(smem + 29184);
  u16* kTb = (u16*)(smem + 38400);
  {
    const int t = tid >> 2, c8 = (tid & 3) * 8;
    const uint4 u = *(const uint4*)(p.proj + (size_t)(r0 + t) * INW + C_ALR + c8);
    float* d = lr + t * 32 + c8;
    d[0] = bflo(u.x); d[1] = bfhi(u.x); d[2] = bflo(u.y); d[3] = bfhi(u.y);
    d[4] = bflo(u.z); d[5] = bfhi(u.z); d[6] = bflo(u.w); d[7] = bfhi(u.w);
    const int dvc = (tid & 3) * 32;
    const u16* vp = p.proj + (size_t)(r0 + t) * INW + C_VA + h * 128 + dvc;
#pragma unroll
    for (int i = 0; i < 4; ++i) {
      const uint4 vv = *(const uint4*)(vp + i * 8);
      u16* dst = vT + (size_t)(dvc + i * 8) * 72 + t;
      dst[0] = (u16)(vv.x & 0xffff); dst[72] = (u16)(vv.x >> 16);
      dst[144] = (u16)(vv.y & 0xffff); dst[216] = (u16)(vv.y >> 16);
      dst[288] = (u16)(vv.z & 0xffff); dst[360] = (u16)(vv.z >> 16);
      dst[432] = (u16)(vv.w & 0xffff); dst[504] = (u16)(vv.w >> 16);
    }
  }
  __syncthreads();
  const int dk = lane, tg = wid;
  const float* w2f = p.in[8] + ((size_t)(l * 2 + 0) * 16) * 256 + h * 64 + dk;
  const float* w2b = p.in[8] + ((size_t)(l * 2 + 1) * 16) * 256 + h * 64 + dk;
  float wf[16], wb[16];
#pragma unroll
  for (int r = 0; r < 16; ++r) { wf[r] = w2f[r * 256]; wb[r] = w2b[r * 256]; }
  const float biasf = p.in[9][(l * 2 + 0) * 256 + h * 64 + dk];
  const float biasb = p.in[9][(l * 2 + 1) * 256 + h * 64 + dk];
  float pf[16], sbk[16];
#pragma unroll
  for (int i = 0; i < 16; ++i) {
    const float* lrow = lr + (tg * 16 + i) * 32;
    float zf = biasf, zb = biasb;
#pragma unroll
    for (int r = 0; r < 16; ++r) { zf += lrow[r] * wf[r]; zb += lrow[16 + r] * wb[r]; }
    pf[i] = logsig16(zf); sbk[i] = logsig16(zb);
  }
#pragma unroll
  for (int i = 1; i < 16; ++i) pf[i] += pf[i - 1];
#pragma unroll
  for (int i = 14; i >= 0; --i) sbk[i] += sbk[i + 1];
  tot[tg * 64 + dk] = pf[15];
  tot[256 + tg * 64 + dk] = sbk[0];
  __syncthreads();
  float offf = 0.f, offb = 0.f, bfl = 0.f, bb0 = 0.f;
#pragma unroll
  for (int g4 = 0; g4 < 4; ++g4) {
    const float a = tot[g4 * 64 + dk], b = tot[256 + g4 * 64 + dk];
    bfl += a; bb0 += b;
    if (g4 < tg) offf += a;
    if (g4 > tg) offb += b;
  }
  u16* gqf = p.gq;
  u16* gkf = p.gq + (size_t)p.R * 256;
  u16* gqb = p.gq + (size_t)p.R * 512;
  u16* gkb = p.gq + (size_t)p.R * 768;
  unsigned kfp[8], kbp[8];
#pragma unroll
  for (int i = 0; i < 16; ++i) {
    const int t = tg * 16 + i;
    const float bfv = offf + pf[i], bbv = offb + sbk[i];
    const float qv = bf2f(p.proj[(size_t)(r0 + t) * INW + C_QA + h * 64 + dk]);
    const float kv = bf2f(p.proj[(size_t)(r0 + t) * INW + C_KA + h * 64 + dk]);
    const size_t go = (size_t)(r0 + t) * 256 + h * 64 + dk;
    gqf[go] = f2bf(qv * __expf(bfv) * 0.125f);
    gkf[go] = f2bf(kv * __expf(-bfv));
    gqb[go] = f2bf(qv * __expf(bbv) * 0.125f);
    gkb[go] = f2bf(kv * __expf(-bbv));
    const u16 ksf = f2bf(kv * __expf(bfl - bfv));
    const u16 ksb = f2bf(kv * __expf(bb0 - bbv));
    if (i & 1) { kfp[i >> 1] |= ((unsigned)ksf) << 16; kbp[i >> 1] |= ((unsigned)ksb) << 16; }
    else { kfp[i >> 1] = ksf; kbp[i >> 1] = ksb; }
  }
  *(uint4*)(kTf + dk * 72 + tg * 16) = make_uint4(kfp[0], kfp[1], kfp[2], kfp[3]);
  *(uint4*)(kTf + dk * 72 + tg * 16 + 8) = make_uint4(kfp[4], kfp[5], kfp[6], kfp[7]);
  *(uint4*)(kTb + dk * 72 + tg * 16) = make_uint4(kbp[0], kbp[1], kbp[2], kbp[3]);
  *(uint4*)(kTb + dk * 72 + tg * 16 + 8) = make_uint4(kbp[4], kbp[5], kbp[6], kbp[7]);
  const size_t cb = ((size_t)(bl * NCHUNK + cidx) * 4 + h) * 2;
  if (tg == 0) {
    p.dec[(cb + 0) * 64 + dk] = __expf(bfl);
    p.dec[(cb + 1) * 64 + dk] = __expf(bb0);
  }
  __syncthreads();
  const int l31 = lane & 31, hh = lane >> 5;
  float* U = (float*)p.h;
#pragma unroll
  for (int dir = 0; dir < 2; ++dir) {
    const u16* kT = dir ? kTb : kTf;
#pragma unroll
    for (int dkt = 0; dkt < 2; ++dkt) {
      f32x16 acc;
#pragma unroll
      for (int e = 0; e < 16; ++e) acc[e] = 0.f;
#pragma unroll
      for (int s = 0; s < 4; ++s) {
        const bf16x8 a = *(const bf16x8*)(vT + (32 * wid + l31) * 72 + 16 * s + 8 * hh);
        const bf16x8 b = *(const bf16x8*)(kT + (32 * dkt + l31) * 72 + 16 * s + 8 * hh);
        acc = __builtin_amdgcn_mfma_f32_32x32x16_bf16(a, b, acc, 0, 0, 0);
      }
      float* up = U + (cb + dir) * 8192;
#pragma unroll
      for (int e = 0; e < 16; ++e) {
        const int dv = 32 * wid + (e & 3) + 8 * (e >> 2) + 4 * hh;
        up[dv * 64 + 32 * dkt + l31] = acc[e];
      }
    }
  }
}

__device__ void phase_postproj(const Params& p, int l, int* ctr) {
  const int n_prep = p.NB * NCHUNK * 4, n_rows = p.R / 16;
  run_q8(ctr, QA_CNT(n_prep + n_rows), [&](int q_, int j_) {
    const int it = QA_ID(q_, j_);
    if (it < n_prep) gla_prep(p, l, it);
    else postproj_rows(p, l, it - n_prep);
  });
}

__device__ void gla_scan(const Params& p, int it) {
  const int tid = TIDX;
  const int sl = it & 7, dir = (it >> 3) & 1, h = (it >> 4) & 3, bl = it >> 6;
  const int e0 = sl * 1024 + tid * 4;
  const int dk = e0 & 63;
  const float* U = (const float*)p.h;
  f32x4 S = {0.f, 0.f, 0.f, 0.f};
#pragma unroll 4
  for (int step = 0; step < NCHUNK; ++step) {
    const int cidx = dir ? (NCHUNK - 1 - step) : (step < 4 ? 128 + step : step - 4);
    const size_t base = ((size_t)(bl * NCHUNK + cidx) * 4 + h) * 2 + dir;
    const f32x4 u4 = *(const f32x4*)(U + base * 8192 + e0);
    const f32x4 d4 = *(const f32x4*)(p.dec + base * 64 + dk);
    uint2 o; o.x = pack2(S[0], S[1]); o.y = pack2(S[2], S[3]);
    *(uint2*)(p.ss + base * 8192 + e0) = o;
    S = d4 * S + u4;
  }
}

__device__ void q_tile(const Params& p, int l, int t) {
  const int MT = p.R / 128;
  const int nt = t / MT, mt = t % MT;
  f32x4 acc[4][4];
  gemm_core<4>(p.proj + (size_t)mt * 128 * INW + C_CQ, INW, p.wt + (size_t)l * W_LAYER + W_UQ + (size_t)nt * 128 * 256, 256, 256, acc);
  EPI_VARS
  const float QS = 0.10206207261596577f * 1.4426950408889634f;
  int bl, pos0, isctx; rowinfo(mt * 128, p.NB, bl, pos0, isctx);
#pragma unroll
  for (int xi = 0; xi < 4; ++xi) {
    const int tr = EPI_TR(xi), r = mt * 128 + tr, pos = pos0 + tr;
    const float rs = p.rstdq[r] * QS;
#pragma unroll
    for (int wi = 0; wi < 4; ++wi) {
      const int n = nt * 128 + EPI_NN(wi);
      const int n16 = (nt * 128 + wc_ * 64 + wi * 16) >> 4;
      const int m6 = n16 % 6;
      float v0 = acc[wi][xi][0] * rs, v1 = acc[wi][xi][1] * rs, v2 = acc[wi][xi][2] * rs, v3 = acc[wi][xi][3] * rs;
      if (m6 >= 4 && !isctx) {
        const float p0 = __shfl_xor(v0, 32), p1 = __shfl_xor(v1, 32), p2 = __shfl_xor(v2, 32), p3 = __shfl_xor(v3, 32);
        const int pa = (m6 == 5) ? (pos & 63) : (pos >> 6);
        const int f0 = (fq_ & 1) * 4;
        const float* rp = p.rope + (pa * 8 + f0) * 2;
        const float4 cs01 = *(const float4*)rp, cs23 = *(const float4*)(rp + 4);
        const float sg = (fq_ >= 2) ? 1.f : -1.f;
        v0 = v0 * cs01.x + sg * p0 * cs01.y;
        v1 = v1 * cs01.z + sg * p1 * cs01.w;
        v2 = v2 * cs23.x + sg * p2 * cs23.y;
        v3 = v3 * cs23.z + sg * p3 * cs23.w;
      }
      uint2 o; o.x = pack2(v0, v1); o.y = pack2(v2, v3);
      *(uint2*)(p.q + (size_t)r * 768 + n) = o;
    }
  }
}

__device__ void kv_tile(const Params& p, int l, int t) {
  const int MT = p.R / 128;
  const int nt = t / MT, mt = t % MT;
  f32x4 acc[4][4];
  gemm_core<4>(p.proj + (size_t)mt * 128 * INW + C_CKV, INW, p.wt + (size_t)l * W_LAYER + W_UKV + (size_t)nt * 128 * 128, 128, 128, acc);
  EPI_VARS
  int bl, pos0, isctx; rowinfo(mt * 128, p.NB, bl, pos0, isctx);
  const int j0 = isctx ? SEQ + pos0 : pos0;
#pragma unroll
  for (int xi = 0; xi < 4; ++xi) {
    const int tr = EPI_TR(xi), r = mt * 128 + tr, j = j0 + tr;
    const float rs = p.rstdkv[r];
#pragma unroll
    for (int wi = 0; wi < 4; ++wi) {
      const int wn = EPI_NN(wi);
      const float v0 = acc[wi][xi][0] * rs, v1 = acc[wi][xi][1] * rs, v2 = acc[wi][xi][2] * rs, v3 = acc[wi][xi][3] * rs;
      if (wc_ == 0) {
        uint2 o; o.x = pack2(v0, v1); o.y = pack2(v2, v3);
        *(uint2*)(p.kf + ((size_t)(bl * 8 + nt) * NKEY + j) * 96 + wn) = o;
      } else {
        u16* vp = p.vt + ((size_t)(bl * 8 + nt) * 64 + (wn - 64)) * NKEY + j;
        vp[0] = f2bf(v0); vp[NKEY] = f2bf(v1); vp[2 * NKEY] = f2bf(v2); vp[3 * NKEY] = f2bf(v3);
      }
    }
  }
}

__device__ void phase_qkv(const Params& p, int l, int* ctr) {
  const int MT = p.R / 128;
  const int n_scan = p.NB * 64, n_q = MT * 6, n_kv = MT * 8;
  run_q8(ctr, QA_CNT(n_scan + n_q + n_kv), [&](int q_, int j_) {
    const int it = QA_ID(q_, j_);
    if (it < n_scan) gla_scan(p, it);
    else if (it < n_scan + n_q) q_tile(p, l, it - n_scan);
    else kv_tile(p, l, it - n_scan - n_q);
  });
}

__device__ __forceinline__ bf16x8 pack8(const f32x16& a, int o) {
  union { bf16x8 v; unsigned u[4]; } r;
  r.u[0] = pack2(a[o + 0], a[o + 1]); r.u[1] = pack2(a[o + 2], a[o + 3]);
  r.u[2] = pack2(a[o + 4], a[o + 5]); r.u[3] = pack2(a[o + 6], a[o + 7]);
  return r.v;
}
__device__ __forceinline__ bf16x8 ld2x8(const u16* p0) {
  union { bf16x8 v; uint2 u[2]; } r;
  r.u[0] = *(const uint2*)p0; r.u[1] = *(const uint2*)(p0 + 8);
  return r.v;
}

__device__ void attn_item(const Params& p, int it) {
  const int tid = TIDX, lane = tid & 63, wid = tid >> 6, l31 = lane & 31, hh = lane >> 5;
  const int qb = it % 66, bh = it / 66, h = bh & 7, bl = bh >> 3;
  const int r0 = qb < 64 ? bl * SEQ + qb * 128 : p.NB * SEQ + bl * CTXL + (qb - 64) * 128;
  const int kt0 = qb < 64 ? 0 : 128;
  const int nkt = NCHUNK - kt0;
  constexpr int KROW = 208, VROW = 144, BUFB = 64 * KROW + 64 * VROW;
  bf16x8 qf[6];
  {
    const u16* qp = p.q + (size_t)(r0 + 32 * wid + l31) * 768 + h * 96 + 8 * hh;
#pragma unroll
    for (int s = 0; s < 6; ++s) qf[s] = *(const bf16x8*)(qp + 16 * s);
  }
  const u16* kbase = p.kf + (size_t)bh * NKEY * 96;
  const u16* vbase = p.vt + (size_t)bh * 64 * NKEY;
  uint4 kr0, kr1, kr2, vr0, vr1;
  const int kdst0 = (tid / 12) * KROW + (tid % 12) * 16;
  const int kdst1 = ((tid + 256) / 12) * KROW + ((tid + 256) % 12) * 16;
  const int kdst2 = ((tid + 512) / 12) * KROW + ((tid + 512) % 12) * 16;
  const int vdst0 = 64 * KROW + (tid >> 3) * VROW + (tid & 7) * 16;
  const int vdst1 = vdst0 + 32 * VROW;
  const int vsrc0 = (tid >> 3) * NKEY + (tid & 7) * 8;
  const int vsrc1 = vsrc0 + 32 * NKEY;
  {
    const u16* kp = kbase + (size_t)kt0 * 64 * 96 + tid * 8;
    kr0 = *(const uint4*)(kp); kr1 = *(const uint4*)(kp + 2048); kr2 = *(const uint4*)(kp + 4096);
    vr0 = *(const uint4*)(vbase + vsrc0 + kt0 * 64); vr1 = *(const uint4*)(vbase + vsrc1 + kt0 * 64);
    *(uint4*)(smem + kdst0) = kr0; *(uint4*)(smem + kdst1) = kr1; *(uint4*)(smem + kdst2) = kr2;
    *(uint4*)(smem + vdst0) = vr0; *(uint4*)(smem + vdst1) = vr1;
  }
  __syncthreads();
  f32x16 oacc[2];
#pragma unroll
  for (int e = 0; e < 16; ++e) { oacc[0][e] = 0.f; oacc[1][e] = 0.f; }
  float m_run = -1e30f, l_run = 0.f;
  for (int t = 0; t < nkt; ++t) {
    const int cur = t & 1;
    const bool more = (t + 1 < nkt);
    if (more) {
      const u16* kp = kbase + (size_t)(kt0 + t + 1) * 64 * 96 + tid * 8;
      kr0 = *(const uint4*)(kp); kr1 = *(const uint4*)(kp + 2048); kr2 = *(const uint4*)(kp + 4096);
      vr0 = *(const uint4*)(vbase + vsrc0 + (kt0 + t + 1) * 64); vr1 = *(const uint4*)(vbase + vsrc1 + (kt0 + t + 1) * 64);
    }
    const char* Kl = smem + cur * BUFB;
    const char* Vl = Kl + 64 * KROW;
    f32x16 sacc[2];
#pragma unroll
    for (int kb = 0; kb < 2; ++kb) {
#pragma unroll
      for (int e = 0; e < 16; ++e) sacc[kb][e] = 0.f;
#pragma unroll
      for (int s = 0; s < 6; ++s) {
        const bf16x8 a = *(const bf16x8*)(Kl + (32 * kb + l31) * KROW + 32 * s + 16 * hh);
        sacc[kb] = __builtin_amdgcn_mfma_f32_32x32x16_bf16(a, qf[s], sacc[kb], 0, 0, 0);
      }
    }
    float mx = sacc[0][0];
#pragma unroll
    for (int e = 1; e < 16; ++e) mx = fmaxf(mx, sacc[0][e]);
#pragma unroll
    for (int e = 0; e < 16; ++e) mx = fmaxf(mx, sacc[1][e]);
    mx = fmaxf(mx, __shfl_xor(mx, 32));
    const float m_new = fmaxf(m_run, mx);
    const float alpha = __builtin_amdgcn_exp2f(m_run - m_new);
    m_run = m_new;
    float ps = 0.f;
#pragma unroll
    for (int kb = 0; kb < 2; ++kb)
#pragma unroll
      for (int e = 0; e < 16; ++e) { const float pv = __builtin_amdgcn_exp2f(sacc[kb][e] - m_new); sacc[kb][e] = pv; ps += pv; }
    l_run = l_run * alpha + ps;
#pragma unroll
    for (int e = 0; e < 16; ++e) { oacc[0][e] *= alpha; oacc[1][e] *= alpha; }
#pragma unroll
    for (int kb = 0; kb < 2; ++kb)
#pragma unroll
      for (int s2 = 0; s2 < 2; ++s2) {
        const bf16x8 pfr = pack8(sacc[kb], 8 * s2);
#pragma unroll
        for (int dt = 0; dt < 2; ++dt) {
          const bf16x8 a = ld2x8((const u16*)(Vl + (32 * dt + l31) * VROW) + 32 * kb + 16 * s2 + 4 * hh);
          oacc[dt] = __builtin_amdgcn_mfma_f32_32x32x16_bf16(a, pfr, oacc[dt], 0, 0, 0);
        }
      }
    if (more) {
      char* nb = smem + (cur ^ 1) * BUFB;
      *(uint4*)(nb + kdst0) = kr0; *(uint4*)(nb + kdst1) = kr1; *(uint4*)(nb + kdst2) = kr2;
      *(uint4*)(nb + vdst0) = vr0; *(uint4*)(nb + vdst1) = vr1;
    }
    __syncthreads();
  }
  l_run += __shfl_xor(l_run, 32);
  const float inv = 1.f / l_run;
  u16* op = p.h + (size_t)p.R * 512 + (size_t)(r0 + 32 * wid + l31) * 512 + h * 64;
#pragma unroll
  for (int dt = 0; dt < 2; ++dt)
#pragma unroll
    for (int gq_ = 0; gq_ < 4; ++gq_) {
      const int dv0 = 32 * dt + 8 * gq_ + 4 * hh;
      uint2 o;
      o.x = pack2(oacc[dt][4 * gq_ + 0] * inv, oacc[dt][4 * gq_ + 1] * inv);
      o.y = pack2(oacc[dt][4 * gq_ + 2] * inv, oacc[dt][4 * gq_ + 3] * inv);
      *(uint2*)(op + dv0) = o;
    }
}

__device__ void gla_out(const Params& p, int l, int it) {
  const int tid = TIDX, lane = tid & 63, wid = tid >> 6, l31 = lane & 31, hh = lane >> 5;
  const int bl = it / (NCHUNK * 4), rem = it % (NCHUNK * 4), cidx = rem >> 2, h = rem & 3;
  const int r0 = chunk_row(bl, cidx, p.NB);
  u16* tiles = (u16*)smem;
  u16* vT = (u16*)(smem + 36864);
  float* part = (float*)(smem + 55296);
  {
    const int t = tid >> 2, c16 = (tid & 3) * 16;
#pragma unroll
    for (int a = 0; a < 4; ++a) {
      const u16* src = p.gq + (size_t)a * p.R * 256 + (size_t)(r0 + t) * 256 + h * 64 + c16;
      const uint4 u0 = *(const uint4*)src, u1 = *(const uint4*)(src + 8);
      u16* d = tiles + a * 4608 + t * 72 + c16;
      *(uint4*)d = u0; *(uint4*)(d + 8) = u1;
    }
    const int dvc = (tid & 3) * 32;
    const u16* vp = p.proj + (size_t)(r0 + t) * INW + C_VA + h * 128 + dvc;
#pragma unroll
    for (int i = 0; i < 4; ++i) {
      const uint4 vv = *(const uint4*)(vp + i * 8);
      u16* dst = vT + (size_t)(dvc + i * 8) * 72 + t;
      dst[0] = (u16)(vv.x & 0xffff); dst[72] = (u16)(vv.x >> 16);
      dst[144] = (u16)(vv.y & 0xffff); dst[216] = (u16)(vv.y >> 16);
      dst[288] = (u16)(vv.z & 0xffff); dst[360] = (u16)(vv.z >> 16);
      dst[432] = (u16)(vv.w & 0xffff); dst[504] = (u16)(vv.w >> 16);
    }
  }
  __syncthreads();
  const int itl = wid & 1, dvh = wid >> 1;
  f32x16 oacc[2];
#pragma unroll
  for (int e = 0; e < 16; ++e) { oacc[0][e] = 0.f; oacc[1][e] = 0.f; }
  const size_t cb = ((size_t)(bl * NCHUNK + cidx) * 4 + h) * 2;
#pragma unroll
  for (int dir = 0; dir < 2; ++dir) {
    const u16* Qt = tiles + (dir * 2) * 4608;
    const u16* Kt = tiles + (dir * 2 + 1) * 4608;
    bf16x8 qfr[4];
#pragma unroll
    for (int s = 0; s < 4; ++s) qfr[s] = *(const bf16x8*)(Qt + (32 * itl + l31) * 72 + 16 * s + 8 * hh);
    f32x16 aacc[2];
#pragma unroll
    for (int jt = 0; jt < 2; ++jt) {
#pragma unroll
      for (int e = 0; e < 16; ++e) aacc[jt][e] = 0.f;
#pragma unroll
      for (int s = 0; s < 4; ++s) {
        const bf16x8 a = *(const bf16x8*)(Kt + (32 * jt + l31) * 72 + 16 * s + 8 * hh);
        aacc[jt] = __builtin_amdgcn_mfma_f32_32x32x16_bf16(a, qfr[s], aacc[jt], 0, 0, 0);
      }
      const int i_tok = 32 * itl + l31;
#pragma unroll
      for (int e = 0; e < 16; ++e) {
        const int j_tok = 32 * jt + (e & 3) + 8 * (e >> 2) + 4 * hh;
        const bool keep = dir ? (j_tok >= i_tok) : (j_tok <= i_tok);
        if (!keep) aacc[jt][e] = 0.f;
      }
    }
    const u16* Sst = p.ss + (cb + dir) * 8192;
#pragma unroll
    for (int dt = 0; dt < 2; ++dt) {
      const int dvrow = 64 * dvh + 32 * dt + l31;
#pragma unroll
      for (int jt = 0; jt < 2; ++jt)
#pragma unroll
        for (int s2 = 0; s2 < 2; ++s2) {
          const bf16x8 pfr = pack8(aacc[jt], 8 * s2);
          const bf16x8 a = ld2x8(vT + dvrow * 72 + 32 * jt + 16 * s2 + 4 * hh);
          oacc[dt] = __builtin_amdgcn_mfma_f32_32x32x16_bf16(a, pfr, oacc[dt], 0, 0, 0);
        }
#pragma unroll
      for (int s = 0; s < 4; ++s) {
        const bf16x8 a = *(const bf16x8*)(Sst + dvrow * 64 + 16 * s + 8 * hh);
        oacc[dt] = __builtin_amdgcn_mfma_f32_32x32x16_bf16(a, qfr[s], oacc[dt], 0, 0, 0);
      }
    }
  }
  float ss = 0.f;
#pragma unroll
  for (int e = 0; e < 16; ++e) ss += oacc[0][e] * oacc[0][e] + oacc[1][e] * oacc[1][e];
  ss += __shfl_xor(ss, 32);
  if (hh == 0) part[wid * 32 + l31] = ss;
  __syncthreads();
  const float totss = part[wid * 32 + l31] + part[(wid ^ 2) * 32 + l31];
  const float rstd = rsqrtf(totss * (1.f / 128.f) + EPS);
  const int r = r0 + 32 * itl + l31;
  const float* gam = p.in[10] + l * 512 + h * 128;
  u16* aa = p.h;
#pragma unroll
  for (int dt = 0; dt < 2; ++dt)
#pragma unroll
    for (int gq_ = 0; gq_ < 4; ++gq_) {
      const int dv0 = 64 * dvh + 32 * dt + 8 * gq_ + 4 * hh;
      const uint2 ra = *(const uint2*)(p.proj + (size_t)r * INW + C_RA + h * 128 + dv0);
      const float4 g4 = *(const float4*)(gam + dv0);
      uint2 o;
      o.x = pack2(oacc[dt][4 * gq_ + 0] * rstd * g4.x * silu_f(bflo(ra.x)), oacc[dt][4 * gq_ + 1] * rstd * g4.y * silu_f(bfhi(ra.x)));
      o.y = pack2(oacc[dt][4 * gq_ + 2] * rstd * g4.z * silu_f(bflo(ra.y)), oacc[dt][4 * gq_ + 3] * rstd * g4.w * silu_f(bfhi(ra.y)));
      *(uint2*)(aa + (size_t)r * 512 + h * 128 + dv0) = o;
    }
}

__device__ void phase_attn(const Params& p, int l, int* ctr) {
  const int n_attn = p.NB * 8 * 66, n_gla = p.NB * NCHUNK * 4;
  const int per_q = n_attn >> 3;
  run_q8(ctr, [=](int q_) { return per_q + ((n_gla - q_ + 7) >> 3); }, [&](int q_, int j_) {
    if (j_ < per_q) attn_item(p, ((j_ / 66) * 8 + q_) * 66 + (j_ % 66));
    else gla_out(p, l, QA_ID(q_, j_ - per_q));
  });
}

__device__ void phase_merge(const Params& p, int l, int* ctr) {
  const int MT = p.R / 128, NT = 16;
  const u16* wl = p.wt + (size_t)l * W_LAYER;
  run_q8(ctr, GEMM_CNT(MT, NT), [&](int q_, int j_) {
    int mt, nt; tile_order(j_, mlo(q_ + 1, MT) - mlo(q_, MT), NT, mt, nt); mt += mlo(q_, MT);
    f32x4 macc[2][4];
#pragma unroll
    for (int a = 0; a < 2; ++a)
#pragma unroll
      for (int b = 0; b < 4; ++b) macc[a][b] = f32x4{0.f, 0.f, 0.f, 0.f};
    EPI_VARS
#pragma unroll 1
    for (int br = 0; br < 3; ++br) {
      const u16* X = (br == 0) ? p.h : (br == 1) ? p.h + (size_t)p.R * 512 : p.uc;
      const u16* W = wl + (br == 0 ? W_BRA : br == 1 ? W_BRB : W_BRC);
      f32x4 acc[2][4];
      uint2 gts[2][4];
#pragma unroll
      for (int wi = 0; wi < 2; ++wi)
#pragma unroll
        for (int xi = 0; xi < 4; ++xi) {
          const int r = mt * 128 + EPI_TR(xi), n = nt * 64 + wc_ * 32 + wi * 16 + fq_ * 4;
          gts[wi][xi] = *(const uint2*)(p.proj + (size_t)r * INW + C_GATE + br * 1024 + n);
        }
      gemm_core<2>(X + (size_t)mt * 128 * 512, 512, W + (size_t)nt * 64 * 512, 512, 512, acc);
#pragma unroll
      for (int wi = 0; wi < 2; ++wi)
#pragma unroll
        for (int xi = 0; xi < 4; ++xi) {
          const uint2 gt = gts[wi][xi];
          macc[wi][xi][0] += sigmoid_f(bflo(gt.x)) * acc[wi][xi][0];
          macc[wi][xi][1] += sigmoid_f(bfhi(gt.x)) * acc[wi][xi][1];
          macc[wi][xi][2] += sigmoid_f(bflo(gt.y)) * acc[wi][xi][2];
          macc[wi][xi][3] += sigmoid_f(bfhi(gt.y)) * acc[wi][xi][3];
        }
    }
#pragma unroll
    for (int wi = 0; wi < 2; ++wi)
#pragma unroll
      for (int xi = 0; xi < 4; ++xi) {
        const int r = mt * 128 + EPI_TR(xi), n = nt * 64 + wc_ * 32 + wi * 16 + fq_ * 4;
        uint2 o; o.x = pack2(macc[wi][xi][0], macc[wi][xi][1]); o.y = pack2(macc[wi][xi][2], macc[wi][xi][3]);
        *(uint2*)(p.m + (size_t)r * DM + n) = o;
      }
  });
}

__device__ void phase_resid(const Params& p, int l, int g, int which, int* ctr) {
  const int MT = p.R / 128, NT = 8;
  const u16* wl = p.wt + (size_t)l * W_LAYER;
  const u16* X = which == 0 ? p.m : p.proj + (size_t)p.R * DFF;
  const int ldx = which == 0 ? DM : DFF, K = which == 0 ? DM : DFF;
  const u16* W = wl + (which == 0 ? W_O : W_DN);
  const int goff = which == 0 ? 2048 : 5120;
  const int from_input = (which == 0 && l == 0);
  run_q8(ctr, GEMM_CNT(MT, NT), [&](int q_, int j_) {
    int mt, nt; tile_order(j_, mlo(q_ + 1, MT) - mlo(q_, MT), NT, mt, nt); mt += mlo(q_, MT);
    f32x4 acc[4][4];
    gemm_core<4>(X + (size_t)mt * 128 * ldx, ldx, W + (size_t)nt * 128 * K, K, K, acc);
    EPI_VARS
    const float* mrow = p.mod + ((size_t)l * 9 + mod_index(p, g, mt * 128)) * 6144 + goff;
#pragma unroll
    for (int xi = 0; xi < 4; ++xi) {
      const int r = mt * 128 + EPI_TR(xi);
      const float* xs = xsrc_row_ptr(p, g, r, from_input);
      float* xd = xrow_ptr(p, g, r);
#pragma unroll
      for (int wi = 0; wi < 4; ++wi) {
        const int n = nt * 128 + EPI_NN(wi);
        const float4 xv = *(const float4*)(xs + n);
        const float4 gv = *(const float4*)(mrow + n);
        float4 o;
        o.x = xv.x + gv.x * acc[wi][xi][0]; o.y = xv.y + gv.y * acc[wi][xi][1];
        o.z = xv.z + gv.z * acc[wi][xi][2]; o.w = xv.w + gv.w * acc[wi][xi][3];
        *(float4*)(xd + n) = o;
      }
    }
  });
}

__device__ void phase_gu(const Params& p, int l, int* ctr) {
  const int MT = p.R / 128, NT = 44;
  const u16* W = p.wt + (size_t)l * W_LAYER + W_GU;
  run_q8(ctr, GEMM_CNT(MT, NT), [&](int q_, int j_) {
    int mt, nt; tile_order(j_, mlo(q_ + 1, MT) - mlo(q_, MT), NT, mt, nt); mt += mlo(q_, MT);
    f32x4 acc[4][4];
    gemm_core<4>(p.h + (size_t)mt * 128 * DM, DM, W + (size_t)nt * 128 * DM, DM, DM, acc);
    EPI_VARS
    u16* dst = p.proj + (nt >= 22 ? (size_t)p.R * DFF : 0);
    const int nb = (nt >= 22 ? nt - 22 : nt) * 128;
#pragma unroll
    for (int wi = 0; wi < 4; ++wi)
#pragma unroll
      for (int xi = 0; xi < 4; ++xi) {
        const int r = mt * 128 + EPI_TR(xi), n = nb + EPI_NN(wi);
        uint2 o; o.x = pack2(acc[wi][xi][0], acc[wi][xi][1]); o.y = pack2(acc[wi][xi][2], acc[wi][xi][3]);
        *(uint2*)(dst + (size_t)r * DFF + n) = o;
      }
  });
}

__device__ void phase_act(const Params& p, int l, int* ctr) {
  const int nitems = p.R / 8;
  const float* cw = p.in[23] + (size_t)l * 3 * DFF;
  const float* cb = p.in[24] + (size_t)l * DFF;
  const u16* G = p.proj;
  u16* UP = p.proj + (size_t)p.R * DFF;
  for (int it = blockIdx.x; it < nitems; it += gridDim.x) {
    for (int e = TIDX; e < 8 * 352; e += 256) {
      const int rr = e / 352, c0 = (e % 352) * 8;
      const int r = it * 8 + rr;
      int bl, pos, isctx; rowinfo(r, p.NB, bl, pos, isctx);
      const int L = isctx ? CTXL : SEQ;
      const u16* gp = G + (size_t)r * DFF + c0;
      const uint4 g1 = *(const uint4*)gp;
      uint4 g0 = make_uint4(0, 0, 0, 0), g2 = g0;
      if (pos > 0) g0 = *(const uint4*)(gp - DFF);
      if (pos < L - 1) g2 = *(const uint4*)(gp + DFF);
      const uint4 uu = *(const uint4*)(UP + (size_t)r * DFF + c0);
      const float4 w0a = *(const float4*)(cw + c0), w0b = *(const float4*)(cw + c0 + 4);
      const float4 w1a = *(const float4*)(cw + DFF + c0), w1b = *(const float4*)(cw + DFF + c0 + 4);
      const float4 w2a = *(const float4*)(cw + 2 * DFF + c0), w2b = *(const float4*)(cw + 2 * DFF + c0 + 4);
      const float4 ba = *(const float4*)(cb + c0), bb = *(const float4*)(cb + c0 + 4);
      uint4 o;
#define ACT2(G0, G1, G2, UU, W0L, W0H, W1L, W1H, W2L, W2H, BL, BH) \
      pack2(silu_f(W0L * bflo(G0) + W1L * bflo(G1) + W2L * bflo(G2) + BL) * bflo(UU), \
            silu_f(W0H * bfhi(G0) + W1H * bfhi(G1) + W2H * bfhi(G2) + BH) * bfhi(UU))
      o.x = ACT2(g0.x, g1.x, g2.x, uu.x, w0a.x, w0a.y, w1a.x, w1a.y, w2a.x, w2a.y, ba.x, ba.y);
      o.y = ACT2(g0.y, g1.y, g2.y, uu.y, w0a.z, w0a.w, w1a.z, w1a.w, w2a.z, w2a.w, ba.z, ba.w);
      o.z = ACT2(g0.z, g1.z, g2.z, uu.z, w0b.x, w0b.y, w1b.x, w1b.y, w2b.x, w2b.y, bb.x, bb.y);
      o.w = ACT2(g0.w, g1.w, g2.w, uu.w, w0b.z, w0b.w, w1b.z, w1b.w, w2b.z, w2b.w, bb.z, bb.w);
#undef ACT2
      *(uint4*)(UP + (size_t)r * DFF + c0) = o;
    }
  }
}

__device__ void phase_final(const Params& p, int* ctr) {
  const int nitems = NBATCH * SEQ / 16;
  const float* gam = p.in[26];
  for (int it = blockIdx.x; it < nitems; it += gridDim.x) {
    const int lane = TIDX & 63, wid = TIDX >> 6;
    for (int rr = 0; rr < 4; ++rr) {
      float* xr = p.out + ((size_t)it * 16 + wid * 4 + rr) * DM;
      float4 v[4]; float ss = 0.f;
#pragma unroll
      for (int i = 0; i < 4; ++i) {
        v[i] = *(const float4*)(xr + lane * 4 + i * 256);
        ss += v[i].x * v[i].x + v[i].y * v[i].y + v[i].z * v[i].z + v[i].w * v[i].w;
      }
      ss = wave_sum(ss);
      const float rstd = rsqrtf(ss * (1.f / 1024.f) + EPS);
#pragma unroll
      for (int i = 0; i < 4; ++i) {
        const int c = lane * 4 + i * 256;
        const float4 gg = *(const float4*)(gam + c);
        float4 o; o.x = v[i].x * rstd * gg.x; o.y = v[i].y * rstd * gg.y; o.z = v[i].z * rstd * gg.z; o.w = v[i].w * rstd * gg.w;
        *(float4*)(xr + c) = o;
      }
    }
  }
}

__device__ void run_phase(const Params& p, int ph, int* ctr) {
  if (ph == 0) { phase0(p, ctr); return; }
  if (ph == p.nph - 1) { phase_final(p, ctr); return; }
  const int idx = ph - 1, lg = idx / NPH_PER, sub = idx % NPH_PER;
  const int l = lg / p.NG, g = lg % p.NG;
  switch (sub) {
    case 0: phase_norm(p, l, g, 0, ctr); break;
    case 1: phase_proj(p, l, ctr); break;
    case 2: phase_postproj(p, l, ctr); break;
    case 3: phase_qkv(p, l, ctr); break;
    case 4: phase_attn(p, l, ctr); break;
    case 5: phase_merge(p, l, ctr); break;
    case 6: phase_resid(p, l, g, 0, ctr); break;
    case 7: phase_norm(p, l, g, 1, ctr); break;
    case 8: phase_gu(p, l, ctr); break;
    case 9: phase_act(p, l, ctr); break;
    default: phase_resid(p, l, g, 1, ctr); break;
  }
}

__global__ void __launch_bounds__(256, 2) mega_kernel(Params p, int ph_lo, int ph_hi, int coop) {
  for (int ph = ph_lo; ph < ph_hi; ++ph) {
#ifdef PROBE_MASK
    const int nrep = (ph > 0 && ph < p.nph - 1 && ((PROBE_MASK >> ((ph - 1) % NPH_PER)) & 1)) ? 2 : 1;
#else
    const int nrep = 1;
#endif
    for (int rep = 0; rep < nrep; ++rep) {
      if (rep) cg::this_grid().sync();
      run_phase(p, ph, p.ctr + rep * 512 + ph * 8);
    }
    if (coop && ph + 1 < ph_hi) cg::this_grid().sync();
  }
}

static inline size_t align_up(size_t v) { return (v + 255) & ~(size_t)255; }

extern "C" void kernel_launch(void* const* d_in, const int* in_sizes, int n_in, void* d_out, int out_size,
                              void* d_ws, size_t ws_size, hipStream_t stream) {
  static int grid_blocks = 0;
  if (!grid_blocks) {
    int dev = 0, cus = 0, per_cu = 0;
    hipGetDevice(&dev);
    hipDeviceGetAttribute(&cus, hipDeviceAttributeMultiprocessorCount, dev);
    hipFuncSetAttribute((const void*)mega_kernel, hipFuncAttributeMaxDynamicSharedMemorySize, LDS_BYTES);
    hipOccupancyMaxActiveBlocksPerMultiprocessor(&per_cu, (const void*)mega_kernel, 256, LDS_BYTES);
    if (per_cu < 1) per_cu = 1;
    if (per_cu > 2) per_cu = 2;
    grid_blocks = cus * per_cu;
  }
  Params p{};
  for (int i = 0; i < 27; ++i) p.in[i] = (const float*)d_in[i];
  p.out = (float*)d_out;
  int NB = 4;
  size_t off[20];
  for (;;) {
    const size_t R = (size_t)NB * (SEQ + CTXL);
    size_t o = 0; int k = 0;
    off[k++] = o; o = align_up(o + 4096);
    off[k++] = o; o = align_up(o + (size_t)2 * 9 * 6144 * 4);
    off[k++] = o; o = align_up(o + 1024 * 2 * 4);
    off[k++] = o; o = align_up(o + (size_t)NBATCH * CTXL * DM * 4);
    off[k++] = o; o = align_up(o + R * 4);
    off[k++] = o; o = align_up(o + R * 4);
    off[k++] = o; o = align_up(o + (size_t)NB * NCHUNK * 4 * 2 * 64 * 4);
    off[k++] = o; o = align_up(o + 2 * W_LAYER * 2);
    off[k++] = o; o = align_up(o + R * INW * 2);
    off[k++] = o; o = o + R * DM * 2;
    off[k++] = o; o = align_up(o + R * DM * 2);
    off[k++] = o; o = align_up(o + R * 768 * 2);
    off[k++] = o; o = align_up(o + (size_t)NB * 8 * NKEY * 96 * 2);
    off[k++] = o; o = align_up(o + (size_t)NB * 8 * 64 * NKEY * 2);
    off[k++] = o; o = align_up(o + R * 512 * 2);
    off[k++] = o; o = align_up(o + R * 1024 * 2);
    off[k++] = o; o = align_up(o + (size_t)NB * NCHUNK * 4 * 2 * 8192 * 2);
    if (o <= ws_size || NB == 1) break;
    NB >>= 1;
  }
  char* ws = (char*)d_ws;
  p.ctr = (int*)(ws + off[0]); p.mod = (float*)(ws + off[1]); p.rope = (float*)(ws + off[2]); p.xc = (float*)(ws + off[3]);
  p.rstdq = (float*)(ws + off[4]); p.rstdkv = (float*)(ws + off[5]); p.dec = (float*)(ws + off[6]); p.wt = (u16*)(ws + off[7]);
  p.proj = (u16*)(ws + off[8]); p.h = (u16*)(ws + off[9]); p.m = (u16*)(ws + off[10]); p.q = (u16*)(ws + off[11]);
  p.kf = (u16*)(ws + off[12]); p.vt = (u16*)(ws + off[13]); p.uc = (u16*)(ws + off[14]); p.gq = (u16*)(ws + off[15]);
  p.ss = (u16*)(ws + off[16]);
  p.NB = NB; p.NG = NBATCH / NB; p.R = NB * (SEQ + CTXL);
  p.nph = 1 + 2 * p.NG * NPH_PER + 1;
  hipMemsetAsync(p.ctr, 0, 4096, stream);
#if SINGLE_LAUNCH
  int lo = 0, hi = p.nph, coop = 1;
  void* args[] = {&p, &lo, &hi, &coop};
  hipError_t e = hipLaunchCooperativeKernel((const void*)mega_kernel, dim3(grid_blocks), dim3(256), args, LDS_BYTES, stream);
  if (e != hipSuccess) fprintf(stderr, "cooperative launch failed: %s (grid %d)\n", hipGetErrorString(e), grid_blocks);
#else
  for (int ph = 0; ph < p.nph; ++ph)
    hipLaunchKernelGGL(mega_kernel, dim3(grid_blocks), dim3(256), LDS_BYTES, stream, p, ph, ph + 1, 0);
#endif
}
```

```cpp
#include <hip/hip_runtime.h>
#include <hip/hip_cooperative_groups.h>
#include <cstdio>
#include <cstdint>
namespace cg = cooperative_groups;

typedef unsigned short u16;
typedef __attribute__((ext_vector_type(8))) short bf16x8;
typedef __attribute__((ext_vector_type(4))) float f32x4;
typedef __attribute__((ext_vector_type(16))) float f32x16;

#ifndef SINGLE_LAUNCH
#define SINGLE_LAUNCH 1
#endif

constexpr int DM = 1024, SEQ = 8192, CTXL = 256, NBATCH = 8, INW = 6592, INWP = 6656, DFF = 2816;
constexpr int C_QA = 0, C_KA = 256, C_VA = 512, C_RA = 1024, C_ALR = 1536, C_CQ = 1568, C_CKV = 1824,
              C_KR = 1952, C_SB = 1984, C_SC = 2496, C_SX = 3008, C_GATE = 3520;
constexpr int NKEY = SEQ + CTXL;
constexpr int NCHUNK = NKEY / 64;
constexpr float EPS = 1e-6f;
constexpr int LDS_BYTES = 65536 + 256;
constexpr int SLOT_OFF = 65536;
constexpr int NPH_PER = 11;
constexpr int NBG = 4;
constexpr int NGRP = NBATCH / NBG;
constexpr int RG = NBG * (SEQ + CTXL);
constexpr int NPHASES = 1 + 2 * NGRP * NPH_PER + 1;

constexpr size_t W_IN = 0;
constexpr size_t W_UQ = W_IN + (size_t)INWP * 1024;
constexpr size_t W_UKV = W_UQ + 768 * 256;
constexpr size_t W_BRA = W_UKV + 1024 * 128;
constexpr size_t W_BRB = W_BRA + 1024 * 512;
constexpr size_t W_BRC = W_BRB + 1024 * 512;
constexpr size_t W_O = W_BRC + 1024 * 512;
constexpr size_t W_GU = W_O + 1024 * 1024;
constexpr size_t W_DN = W_GU + (size_t)5632 * 1024;
constexpr size_t W_LAYER = W_DN + (size_t)1024 * 2816;

struct KArgs {
  const float* in[27];
  float* out;
  char* ws;
};
struct Params {
  const float* in[27];
  float* out;
  float* xc;
  u16* wt;
  float* mod;
  float* rope;
  int* ctr;
  float* rstdq;
  float* rstdkv;
  float* dec;
  u16* proj;
  u16* h;
  u16* m;
  u16* q;
  u16* kf;
  u16* vt;
  u16* uc;
  u16* gq;
  u16* ss;
};
constexpr size_t al256(size_t v) { return (v + 255) & ~(size_t)255; }
constexpr size_t O_CTR = 0;
constexpr size_t O_MOD = al256(O_CTR + 4096);
constexpr size_t O_ROPE = al256(O_MOD + (size_t)2 * 9 * 6144 * 4);
constexpr size_t O_XC = al256(O_ROPE + 1024 * 2 * 4);
constexpr size_t O_RSQ = al256(O_XC + (size_t)NBATCH * CTXL * DM * 4);
constexpr size_t O_RSKV = al256(O_RSQ + (size_t)RG * 4);
constexpr size_t O_DEC = al256(O_RSKV + (size_t)RG * 4);
constexpr size_t O_WT = al256(O_DEC + (size_t)NBG * NCHUNK * 4 * 2 * 64 * 4);
constexpr size_t O_PROJ = al256(O_WT + 2 * W_LAYER * 2);
constexpr size_t O_H = al256(O_PROJ + (size_t)RG * INW * 2);
constexpr size_t O_M = O_H + (size_t)RG * DM * 2;
constexpr size_t O_Q = al256(O_M + (size_t)RG * DM * 2);
constexpr size_t O_KF = al256(O_Q + (size_t)RG * 768 * 2);
constexpr size_t O_VT = al256(O_KF + (size_t)NBG * 8 * NKEY * 96 * 2);
constexpr size_t O_UC = al256(O_VT + (size_t)NBG * 8 * 64 * NKEY * 2);
constexpr size_t O_GQ = al256(O_UC + (size_t)RG * 512 * 2);
constexpr size_t O_SS = al256(O_GQ + (size_t)RG * 1024 * 2);
constexpr size_t WS_END = al256(O_SS + (size_t)NBG * NCHUNK * 4 * 2 * 8192 * 2);
static_assert(WS_END <= ((size_t)1 << 30), "workspace layout must fit 1 GiB");

extern __shared__ __attribute__((aligned(16))) char smem[];

typedef __bf16 hbf2 __attribute__((ext_vector_type(2)));
typedef float hf2 __attribute__((ext_vector_type(2)));
__device__ __forceinline__ unsigned pack2(float a, float b) {
  hf2 v = {a, b};
  return __builtin_bit_cast(unsigned, __builtin_convertvector(v, hbf2));
}
__device__ __forceinline__ u16 f2bf(float f) { return (u16)(pack2(f, 0.f) & 0xffffu); }
__device__ __forceinline__ float bf2f(u16 h) { return __uint_as_float(((unsigned)h) << 16); }
__device__ __forceinline__ float bflo(unsigned u) { return __uint_as_float(u << 16); }
__device__ __forceinline__ float bfhi(unsigned u) { return __uint_as_float(u & 0xffff0000u); }
__device__ __forceinline__ float silu_f(float x) { return x / (1.f + __expf(-x)); }
__device__ __forceinline__ float sigmoid_f(float x) { return 1.f / (1.f + __expf(-x)); }

__device__ __forceinline__ void rowinfo(int r, int NB, int& bl, int& pos, int& isctx) {
  const int nl = NB * SEQ;
  if (r < nl) { bl = r >> 13; pos = r & (SEQ - 1); isctx = 0; }
  else { const int rc = r - nl; bl = rc >> 8; pos = rc & (CTXL - 1); isctx = 1; }
}
__device__ __forceinline__ int chunk_row(int bl, int cidx, int NB) {
  return cidx < 128 ? bl * SEQ + cidx * 64 : NB * SEQ + bl * CTXL + (cidx - 128) * 64;
}

template <class CntF, class BodyF>
__device__ __forceinline__ void run_q8(int* ctr8, CntF cntf, BodyF body) {
  volatile int* slot = (volatile int*)(smem + SLOT_OFF);
  int q = blockIdx.x & 7, tries = 0, item;
  __syncthreads();
  if (threadIdx.x == 0) {
    int v = atomicAdd(&ctr8[q], 1);
    while (v >= cntf(q) && tries < 8) { q = (q + 1) & 7; ++tries; if (tries < 8) v = atomicAdd(&ctr8[q], 1); }
    slot[0] = (tries < 8) ? v : -1; slot[1] = q; slot[2] = tries;
  }
  __syncthreads();
  item = slot[0]; q = slot[1]; tries = slot[2];
  while (item >= 0) {
    int nxt = 0;
    if (threadIdx.x == 0) nxt = atomicAdd(&ctr8[q], 1);
    body(q, item);
    __syncthreads();
    if (threadIdx.x == 0) {
      int qq = q, t = tries;
      while (nxt >= cntf(qq) && t < 8) { qq = (qq + 1) & 7; ++t; if (t < 8) nxt = atomicAdd(&ctr8[qq], 1); }
      slot[0] = (t < 8) ? nxt : -1; slot[1] = qq; slot[2] = t;
    }
    __syncthreads();
    item = slot[0]; q = slot[1]; tries = slot[2];
  }
}
#define QA_CNT(N) [=](int q_) { return ((N) - q_ + 7) >> 3; }
#define QA_ID(q_, j_) ((j_) * 8 + (q_))

__device__ __forceinline__ int opaque_tid() {
  int t = threadIdx.x;
  asm volatile("" : "+v"(t));
  return t;
}
#define TIDX opaque_tid()
__device__ __forceinline__ float wave_sum(float v) {
  v += __shfl_xor(v, 32); v += __shfl_xor(v, 16); v += __shfl_xor(v, 8);
  v += __shfl_xor(v, 4); v += __shfl_xor(v, 2); v += __shfl_xor(v, 1);
  return v;
}

__device__ __forceinline__ int lds_byte(int r, int c) {
  const int st = (r >> 4) * 2 + (c >> 5), rr = r & 15, cc = c & 31, ob = rr * 64 + cc * 2;
  return st * 1024 + (ob ^ (((ob >> 9) & 1) << 5));
}
__device__ __forceinline__ void stage_rc(int b, int& R, int& C) {
  const int st = b >> 10, sb = b & 1023, swz = sb ^ (((sb >> 9) & 1) << 5);
  R = (st >> 1) * 16 + (swz >> 6); C = (st & 1) * 32 + ((swz & 63) >> 1);
}

__device__ __forceinline__ void glds16(const void* g, void* l) {
  __builtin_amdgcn_global_load_lds((const __attribute__((address_space(1))) unsigned*)g,
                                   (__attribute__((address_space(3))) unsigned*)l, 16, 0, 0);
}

template <int NWI>
__device__ __forceinline__ void gemm_core(const u16* __restrict__ X, int ldx, const u16* __restrict__ W, int ldw,
                                          int K, f32x4 (&acc)[NWI][4]) {
  const int tid = TIDX, lane = tid & 63, wid = tid >> 6;
  const int wr = wid >> 1, wc = wid & 1, fr = lane & 15, fq = lane >> 4;
#pragma unroll
  for (int a = 0; a < NWI; ++a)
#pragma unroll
    for (int b = 0; b < 4; ++b) acc[a][b] = f32x4{0.f, 0.f, 0.f, 0.f};
  const int srow = tid >> 3, schunk = (tid & 7) ^ ((tid >> 4) & 7);
  const u16* xg = X + (size_t)srow * ldx + schunk * 8;
  const u16* wg = W + (size_t)srow * ldw + schunk * 8;
  const int xs = 32 * ldx, ws_ = 32 * ldw;
  const int g = fr >> 1;
  const int lo0 = fr * 128 + ((fq ^ g) << 4), lo1 = fr * 128 + (((fq ^ g) ^ 4) << 4);
  const char* xb = smem + wr * 8192;
  const char* wb = smem + 16384 + wc * (NWI * 2048);
  char* sdst = smem + tid * 16;
  const int nt = K >> 6;
  __syncthreads();
#pragma unroll
  for (int i = 0; i < 4; ++i) {
    glds16(xg + i * xs, sdst + i * 4096);
    if (i < NWI) glds16(wg + i * ws_, sdst + 16384 + i * 4096);
  }
  for (int kt = 0; kt < nt; ++kt) {
    asm volatile("s_waitcnt vmcnt(0)" ::: "memory");
    __syncthreads();
    const int cb = (kt & 1) * 32768;
    if (kt + 1 < nt) {
      const int nb = 32768 - cb;
      const int ko = (kt + 1) * 64;
#pragma unroll
      for (int i = 0; i < 4; ++i) {
        glds16(xg + i * xs + ko, sdst + nb + i * 4096);
        if (i < NWI) glds16(wg + i * ws_ + ko, sdst + nb + 16384 + i * 4096);
      }
    }
    bf16x8 wf[2][NWI], xf[2][4];
#pragma unroll
    for (int i = 0; i < NWI; ++i) {
      wf[0][i] = *(const bf16x8*)(wb + cb + i * 2048 + lo0);
      wf[1][i] = *(const bf16x8*)(wb + cb + i * 2048 + lo1);
    }
#pragma unroll
    for (int i = 0; i < 4; ++i) {
      xf[0][i] = *(const bf16x8*)(xb + cb + i * 2048 + lo0);
      xf[1][i] = *(const bf16x8*)(xb + cb + i * 2048 + lo1);
    }
    __builtin_amdgcn_sched_barrier(0);
#pragma unroll
    for (int k = 0; k < 2; ++k)
#pragma unroll
      for (int wi = 0; wi < NWI; ++wi)
#pragma unroll
        for (int xi = 0; xi < 4; ++xi)
          acc[wi][xi] = __builtin_amdgcn_mfma_f32_16x16x32_bf16(wf[k][wi], xf[k][xi], acc[wi][xi], 0, 0, 0);
    __builtin_amdgcn_sched_barrier(0);
  }
}

#define EPI_VARS const int tid_ = TIDX, lane_ = tid_ & 63, wid_ = tid_ >> 6; \
  const int wr_ = wid_ >> 1, wc_ = wid_ & 1, fr_ = lane_ & 15, fq_ = lane_ >> 4; (void)fq_; (void)fr_; (void)wr_; (void)wc_;
#define EPI_TR(xi) (wr_ * 64 + (xi) * 16 + fr_)
#define EPI_NN(wi) (wc_ * 64 + (wi) * 16 + fq_ * 4)

template <int NWI>
__device__ __forceinline__ void store_tile_bf16(const uint2 (&o)[NWI][4], u16* dst_wave, size_t ld) {
  constexpr int RB = NWI * 32, CPR = RB / 16;
  const int tid = TIDX, lane = tid & 63, wid = tid >> 6, fr = lane & 15, fq = lane >> 4;
  char* lb = smem + wid * 8192;
#pragma unroll
  for (int wi = 0; wi < NWI; ++wi)
#pragma unroll
    for (int xi = 0; xi < 4; ++xi) {
      const int r = xi * 16 + fr, c = wi * 2 + (fq >> 1);
      *(uint2*)(lb + r * RB + ((c ^ (r & (CPR - 1))) << 4) + (fq & 1) * 8) = o[wi][xi];
    }
#pragma unroll
  for (int it = 0; it < CPR; ++it) {
    const int idx = it * 64 + lane, row = idx / CPR, c = idx % CPR;
    const uint4 v = *(const uint4*)(lb + row * RB + ((c ^ (row & (CPR - 1))) << 4));
    *(uint4*)(dst_wave + (size_t)row * ld + c * 8) = v;
  }
}

__device__ __forceinline__ void tile_order(int t, int MT, int NT, int& mt, int& nt) {
  constexpr int GM = 8;
  const int band = t / (GM * NT), rem = t - band * GM * NT;
  const int m0 = band * GM;
  const int gsz = min(GM, MT - m0);
  nt = rem / gsz; mt = m0 + rem - nt * gsz;
}

__device__ __forceinline__ int mlo(int q, int MT) { return (q * MT) >> 3; }
#define GEMM_CNT(MT, NT) [=](int q_) { return (mlo(q_ + 1, MT) - mlo(q_, MT)) * (NT); }

__device__ __forceinline__ float* xrow_ptr(const Params& p, int g, int r) {
  int bl, pos, isctx; rowinfo(r, NBG, bl, pos, isctx);
  const int b = g * NBG + bl;
  return isctx ? p.xc + ((size_t)b * CTXL + pos) * DM : p.out + ((size_t)b * SEQ + pos) * DM;
}
__device__ __forceinline__ const float* xsrc_row_ptr(const Params& p, int g, int r, int from_input) {
  int bl, pos, isctx; rowinfo(r, NBG, bl, pos, isctx);
  const int b = g * NBG + bl;
  if (from_input) return isctx ? p.in[2] + ((size_t)b * CTXL + pos) * DM : p.in[0] + ((size_t)b * SEQ + pos) * DM;
  return isctx ? p.xc + ((size_t)b * CTXL + pos) * DM : p.out + ((size_t)b * SEQ + pos) * DM;
}
__device__ __forceinline__ int mod_index(const Params& p, int g, int r) {
  int bl, pos, isctx; rowinfo(r, NBG, bl, pos, isctx);
  return isctx ? 8 : g * NBG + bl;
}

__device__ void conv_tile(const float* __restrict__ src, int K, int N, u16* __restrict__ dst,
                          const float* __restrict__ scale, int ktile, int ntile) {
  float* tile = (float*)smem;
  const int tid = TIDX;
  const int k0 = ktile * 64, n0 = ntile * 64;
  const bool valid = n0 < N;
  if (valid) {
    const int kk = tid >> 4, n4 = (tid & 15) * 4;
#pragma unroll
    for (int i = 0; i < 4; ++i) {
      const int k = kk + 16 * i;
      const float4 v = *(const float4*)(src + (size_t)(k0 + k) * N + n0 + n4);
      const float s = scale ? scale[k0 + k] : 1.f;
      tile[k * 65 + n4 + 0] = v.x * s; tile[k * 65 + n4 + 1] = v.y * s;
      tile[k * 65 + n4 + 2] = v.z * s; tile[k * 65 + n4 + 3] = v.w * s;
    }
  }
  __syncthreads();
  const int nn = tid >> 3, k8 = (tid & 7) * 8;
#pragma unroll
  for (int i = 0; i < 2; ++i) {
    const int n = nn + 32 * i;
    uint4 o = make_uint4(0, 0, 0, 0);
    if (valid) {
      o.x = pack2(tile[(k8 + 0) * 65 + n], tile[(k8 + 1) * 65 + n]);
      o.y = pack2(tile[(k8 + 2) * 65 + n], tile[(k8 + 3) * 65 + n]);
      o.z = pack2(tile[(k8 + 4) * 65 + n], tile[(k8 + 5) * 65 + n]);
      o.w = pack2(tile[(k8 + 6) * 65 + n], tile[(k8 + 7) * 65 + n]);
    }
    *(uint4*)(dst + (size_t)(n0 + n) * K + k0 + k8) = o;
  }
}

__device__ void sincos_d(double a, double& s, double& c) {
  const double k = rint(a * 0.6366197723675814);
  double r = fma(-k, 1.5707963267948966, a);
  r = fma(-k, 6.123233995736766e-17, r);
  const int q = ((int)k) & 3;
  const double r2 = r * r;
  const double sp = r * (1.0 + r2 * (-1.0 / 6 + r2 * (1.0 / 120 + r2 * (-1.0 / 5040 + r2 * (1.0 / 362880 + r2 * (-1.0 / 39916800 + r2 * (1.0 / 6227020800.0)))))));
  const double cp = 1.0 + r2 * (-0.5 + r2 * (1.0 / 24 + r2 * (-1.0 / 720 + r2 * (1.0 / 40320 + r2 * (-1.0 / 3628800 + r2 * (1.0 / 479001600.0 + r2 * (-1.0 / 87178291200.0)))))));
  s = (q == 0) ? sp : (q == 1) ? cp : (q == 2) ? -sp : -cp;
  c = (q == 0) ? cp : (q == 1) ? -sp : (q == 2) ? -cp : sp;
}

constexpr int CV_WIN = 0, CV_UQ = 1664, CV_UKV = 1712, CV_BRA = 1744, CV_BRB = 1872, CV_BRC = 2000,
              CV_WO = 2128, CV_GATE = 2384, CV_UP = 3088, CV_DN = 3792, CV_LAYER = 4496;
constexpr int P0_CONV = 2 * CV_LAYER, P0_ADA = 2 * 192, P0_TOTAL = P0_CONV + P0_ADA + 1;

__device__ void phase0(const Params& p, int* ctr) {
  run_q8(ctr, QA_CNT(P0_TOTAL), [&](int q_, int j_) {
    const int it = QA_ID(q_, j_);
    const int tid = TIDX;
    if (it < P0_CONV) {
      const int l = it / CV_LAYER, j = it % CV_LAYER;
      u16* wl = p.wt + (size_t)l * W_LAYER;
      if (j < CV_UQ)       { const int jj = j - CV_WIN;  conv_tile(p.in[7] + (size_t)l * 1024 * INW, 1024, INW, wl + W_IN, nullptr, jj / 104, jj % 104); }
      else if (j < CV_UKV) { const int jj = j - CV_UQ;   conv_tile(p.in[12] + (size_t)l * 256 * 768, 256, 768, wl + W_UQ, p.in[11] + l * 256, jj / 12, jj % 12); }
      else if (j < CV_BRA) { const int jj = j - CV_UKV;  conv_tile(p.in[14] + (size_t)l * 128 * 1024, 128, 1024, wl + W_UKV, p.in[13] + l * 128, jj / 16, jj % 16); }
      else if (j < CV_BRB) { const int jj = j - CV_BRA;  conv_tile(p.in[16] + (size_t)l * 512 * 1024, 512, 1024, wl + W_BRA, nullptr, jj / 16, jj % 16); }
      else if (j < CV_BRC) { const int jj = j - CV_BRB;  conv_tile(p.in[17] + (size_t)l * 512 * 1024, 512, 1024, wl + W_BRB, nullptr, jj / 16, jj % 16); }
      else if (j < CV_WO)  { const int jj = j - CV_BRC;  conv_tile(p.in[18] + (size_t)l * 512 * 1024, 512, 1024, wl + W_BRC, nullptr, jj / 16, jj % 16); }
      else if (j < CV_GATE){ const int jj = j - CV_WO;   conv_tile(p.in[19] + (size_t)l * 1024 * 1024, 1024, 1024, wl + W_O, nullptr, jj / 16, jj % 16); }
      else if (j < CV_UP)  { const int jj = j - CV_GATE; conv_tile(p.in[21] + (size_t)l * 1024 * DFF, 1024, DFF, wl + W_GU, nullptr, jj / 44, jj % 44); }
      else if (j < CV_DN)  { const int jj = j - CV_UP;   conv_tile(p.in[22] + (size_t)l * 1024 * DFF, 1024, DFF, wl + W_GU + (size_t)DFF * 1024, nullptr, jj / 44, jj % 44); }
      else                 { const int jj = j - CV_DN;   conv_tile(p.in[25] + (size_t)l * DFF * 1024, DFF, 1024, wl + W_DN, nullptr, jj / 16, jj % 16); }
    } else if (it < P0_CONV + P0_ADA) {
      const int a = it - P0_CONV, l = a / 192, cg_ = a % 192;
      float* sc = (float*)smem;
      float* red = sc + 9 * 1024;
      for (int e = tid; e < 9 * 1024; e += 256) {
        const int v = e >> 10, k = e & 1023;
        const float cv = (v < 8) ? p.in[1][v * 1024 + k] : p.in[3][k];
        sc[e] = cv / (1.f + expf(-cv));
      }
      __syncthreads();
      const int kg = tid >> 5, cn = tid & 31;
      const float* wa = p.in[4] + (size_t)l * 1024 * 6144 + cg_ * 32 + cn;
      float a0 = 0, a1 = 0, a2 = 0, a3 = 0, a4 = 0, a5 = 0, a6 = 0, a7 = 0, a8 = 0;
#pragma unroll 8
      for (int i = 0; i < 128; ++i) {
        const int k = kg + 8 * i;
        const float w = wa[(size_t)k * 6144];
        a0 += sc[k] * w; a1 += sc[1024 + k] * w; a2 += sc[2048 + k] * w; a3 += sc[3072 + k] * w;
        a4 += sc[4096 + k] * w; a5 += sc[5120 + k] * w; a6 += sc[6144 + k] * w; a7 += sc[7168 + k] * w;
        a8 += sc[8192 + k] * w;
      }
      float* rr = red + kg * 288 + cn;
      rr[0] = a0; rr[32] = a1; rr[64] = a2; rr[96] = a3; rr[128] = a4; rr[160] = a5; rr[192] = a6; rr[224] = a7; rr[256] = a8;
      __syncthreads();
      for (int e = tid; e < 288; e += 256) {
        float s = 0.f;
#pragma unroll
        for (int g8 = 0; g8 < 8; ++g8) s += red[g8 * 288 + e];
        const int v = e >> 5, n = cg_ * 32 + (e & 31);
        p.mod[((size_t)l * 9 + v) * 6144 + n] = s + p.in[5][l * 6144 + n];
      }
    } else {
      for (int e = tid; e < 1024; e += 256) {
        const int pos = e >> 3, f = e & 7;
        const float inv = (f == 0) ? 1.0f : (f == 1) ? 0.31622776601683794f : (f == 2) ? 0.1f : (f == 3) ? 0.031622776601683794f
                        : (f == 4) ? 0.01f : (f == 5) ? 0.0031622776601683794f : (f == 6) ? 0.001f : 0.00031622776601683794f;
        const float ang = (float)pos * inv;
        double s, c; sincos_d((double)ang, s, c);
        p.rope[e * 2] = (float)c; p.rope[e * 2 + 1] = (float)s;
      }
    }
  });
}

__device__ void phase_norm(const Params& p, int l, int g, int which, int* ctr) {
  const int nitems = RG / 16;
  const float* gam = (which == 0 ? p.in[6] : p.in[20]) + l * DM;
  const int shoff = which == 0 ? 0 : 3072, scoff = which == 0 ? 1024 : 4096;
  const int from_input = (which == 0 && l == 0);
  for (int it = blockIdx.x; it < nitems; it += gridDim.x) {
    const int lane = TIDX & 63, wid = TIDX >> 6;
    for (int rr = 0; rr < 4; ++rr) {
      const int r = it * 16 + wid * 4 + rr;
      const float* xr = xsrc_row_ptr(p, g, r, from_input);
      const float* mrow = p.mod + ((size_t)l * 9 + mod_index(p, g, r)) * 6144;
      float4 v[4]; float ss = 0.f;
#pragma unroll
      for (int i = 0; i < 4; ++i) {
        v[i] = *(const float4*)(xr + lane * 4 + i * 256);
        ss += v[i].x * v[i].x + v[i].y * v[i].y + v[i].z * v[i].z + v[i].w * v[i].w;
      }
      ss = wave_sum(ss);
      const float rstd = rsqrtf(ss * (1.f / 1024.f) + EPS);
#pragma unroll
      for (int i = 0; i < 4; ++i) {
        const int c = lane * 4 + i * 256;
        const float4 gg = *(const float4*)(gam + c);
        const float4 sh = *(const float4*)(mrow + shoff + c);
        const float4 sc = *(const float4*)(mrow + scoff + c);
        uint2 o;
        o.x = pack2(v[i].x * rstd * gg.x * (1.f + sc.x) + sh.x, v[i].y * rstd * gg.y * (1.f + sc.y) + sh.y);
        o.y = pack2(v[i].z * rstd * gg.z * (1.f + sc.z) + sh.z, v[i].w * rstd * gg.w * (1.f + sc.w) + sh.w);
        *(uint2*)(p.h + (size_t)r * DM + c) = o;
      }
    }
  }
}

__device__ void phase_proj(const Params& p, int l, int* ctr) {
  const int MT = RG / 128, NT = INWP / 128;
  const u16* W = p.wt + (size_t)l * W_LAYER + W_IN;
  run_q8(ctr, GEMM_CNT(MT, NT), [&](int q_, int j_) {
    int mt, nt; tile_order(j_, mlo(q_ + 1, MT) - mlo(q_, MT), NT, mt, nt); mt += mlo(q_, MT);
    f32x4 acc[4][4];
    gemm_core<4>(p.h + (size_t)mt * 128 * DM, DM, W + (size_t)nt * 128 * DM, DM, DM, acc);
    EPI_VARS
    uint2 o[4][4];
#pragma unroll
    for (int wi = 0; wi < 4; ++wi)
#pragma unroll
      for (int xi = 0; xi < 4; ++xi) {
        o[wi][xi].x = pack2(acc[wi][xi][0], acc[wi][xi][1]); o[wi][xi].y = pack2(acc[wi][xi][2], acc[wi][xi][3]);
      }
    if (nt * 128 + wc_ * 64 < INW)
      store_tile_bf16<4>(o, p.proj + (size_t)(mt * 128 + wr_ * 64) * INW + nt * 128 + wc_ * 64, INW);
  });
}

__device__ void postproj_rows(const Params& p, int l, int it) {
  const int lane = TIDX & 63, wid = TIDX >> 6;
  const float* scw = p.in[15] + (size_t)l * 3 * 512;
  for (int rr = 0; rr < 4; ++rr) {
    const int r = it * 16 + wid * 4 + rr;
    int bl, pos, isctx; rowinfo(r, NBG, bl, pos, isctx);
    const u16* pr = p.proj + (size_t)r * INW;
    {
      const uint2 u = *(const uint2*)(pr + C_CQ + lane * 4);
      const float a = bflo(u.x), b = bfhi(u.x), c = bflo(u.y), d = bfhi(u.y);
      float ss = wave_sum(a * a + b * b + c * c + d * d);
      if (lane == 0) p.rstdq[r] = rsqrtf(ss * (1.f / 256.f) + EPS);
    }
    {
      const unsigned u = *(const unsigned*)(pr + C_CKV + lane * 2);
      const float a = bflo(u), b = bfhi(u);
      float ss = wave_sum(a * a + b * b);
      if (lane == 0) p.rstdkv[r] = rsqrtf(ss * (1.f / 128.f) + EPS);
    }
    {
      const int idx = lane & 31;
      const float val = bf2f(pr[C_KR + idx]);
      const float partner = __shfl_xor(val, 8);
      float o = val;
      if (!isctx) {
        const int axis = idx >> 4, half = (idx >> 3) & 1, f = idx & 7;
        const int pa = axis ? (pos & 63) : (pos >> 6);
        const float c = p.rope[(pa * 8 + f) * 2], s = p.rope[(pa * 8 + f) * 2 + 1];
        o = half ? (val * c + partner * s) : (val * c - partner * s);
      }
      const int j = isctx ? SEQ + pos : pos;
      const u16 ob = f2bf(o);
      if (lane < 32) {
#pragma unroll
        for (int hd = 0; hd < 8; ++hd)
          p.kf[((size_t)(bl * 8 + hd) * NKEY + j) * 96 + 64 + idx] = ob;
      }
    }
    {
      const int L = isctx ? CTXL : SEQ;
      const int c0 = lane * 8;
      const uint4 sb = *(const uint4*)(pr + C_SB + c0);
      const uint4 sc1 = *(const uint4*)(pr + C_SC + c0);
      const uint4 sx1 = *(const uint4*)(pr + C_SX + c0);
      uint4 sc0 = make_uint4(0, 0, 0, 0), sx0 = sc0, sc2 = sc0, sx2 = sc0;
      if (pos > 0) { sc0 = *(const uint4*)(pr - INW + C_SC + c0); sx0 = *(const uint4*)(pr - INW + C_SX + c0); }
      if (pos < L - 1) { sc2 = *(const uint4*)(pr + INW + C_SC + c0); sx2 = *(const uint4*)(pr + INW + C_SX + c0); }
      const float4 w0a = *(const float4*)(scw + c0), w0b = *(const float4*)(scw + c0 + 4);
      const float4 w1a = *(const float4*)(scw + 512 + c0), w1b = *(const float4*)(scw + 512 + c0 + 4);
      const float4 w2a = *(const float4*)(scw + 1024 + c0), w2b = *(const float4*)(scw + 1024 + c0 + 4);
      uint4 o;
#define UC2(SBW, A0, X0, A1, X1, A2, X2, W0L, W0H, W1L, W1H, W2L, W2H) \
      pack2(bflo(SBW) * (W0L * bflo(A0) * bflo(X0) + W1L * bflo(A1) * bflo(X1) + W2L * bflo(A2) * bflo(X2)), \
            bfhi(SBW) * (W0H * bfhi(A0) * bfhi(X0) + W1H * bfhi(A1) * bfhi(X1) + W2H * bfhi(A2) * bfhi(X2)))
      o.x = UC2(sb.x, sc0.x, sx0.x, sc1.x, sx1.x, sc2.x, sx2.x, w0a.x, w0a.y, w1a.x, w1a.y, w2a.x, w2a.y);
      o.y = UC2(sb.y, sc0.y, sx0.y, sc1.y, sx1.y, sc2.y, sx2.y, w0a.z, w0a.w, w1a.z, w1a.w, w2a.z, w2a.w);
      o.z = UC2(sb.z, sc0.z, sx0.z, sc1.z, sx1.z, sc2.z, sx2.z, w0b.x, w0b.y, w1b.x, w1b.y, w2b.x, w2b.y);
      o.w = UC2(sb.w, sc0.w, sx0.w, sc1.w, sx1.w, sc2.w, sx2.w, w0b.z, w0b.w, w1b.z, w1b.w, w2b.z, w2b.w);
#undef UC2
      *(uint4*)(p.uc + (size_t)r * 512 + c0) = o;
    }
  }
}

__device__ __forceinline__ float logsig16(float z) {
  return (fminf(z, 0.f) - log1pf(__expf(-fabsf(z)))) * (1.f / 16.f);
}

__device__ void gla_prep(const Params& p, int l, int it) {
  const int tid = TIDX, lane = tid & 63, wid = tid >> 6;
  const int bl = it / (NCHUNK * 4), rem = it % (NCHUNK * 4), cidx = rem >> 2, h = rem & 3;
  const int r0 = chunk_row(bl, cidx, NBG);
  float* lr = (float*)smem;
  float* tot = (float*)(smem + 8192);
  u16* vT = (u16*)(smem + 10752);
  u16* kTf = (u16*)(smem + 29184);
  u16* kTb = (u16*)(smem + 38400);
  {
    const int t = tid >> 2, c8 = (tid & 3) * 8;
    const uint4 u = *(const uint4*)(p.proj + (size_t)(r0 + t) * INW + C_ALR + c8);
    float* d = lr + t * 32 + c8;
    d[0] = bflo(u.x); d[1] = bfhi(u.x); d[2] = bflo(u.y); d[3] = bfhi(u.y);
    d[4] = bflo(u.z); d[5] = bfhi(u.z); d[6] = bflo(u.w); d[7] = bfhi(u.w);
    const int dvc = (tid & 3) * 32;
    const u16* vp = p.proj + (size_t)(r0 + t) * INW + C_VA + h * 128 + dvc;
#pragma unroll
    for (int i = 0; i < 4; ++i) {
      const uint4 vv = *(const uint4*)(vp + i * 8);
      u16* dst = vT + (size_t)(dvc + i * 8) * 72 + t;
      dst[0] = (u16)(vv.x & 0xffff); dst[72] = (u16)(vv.x >> 16);
      dst[144] = (u16)(vv.y & 0xffff); dst[216] = (u16)(vv.y >> 16);
      dst[288] = (u16)(vv.z & 0xffff); dst[360] = (u16)(vv.z >> 16);
      dst[432] = (u16)(vv.w & 0xffff); dst[504] = (u16)(vv.w >> 16);
    }
  }
  __syncthreads();
  const int dk = lane, tg = wid;
  const float* w2f = p.in[8] + ((size_t)(l * 2 + 0) * 16) * 256 + h * 64 + dk;
  const float* w2b = p.in[8] + ((size_t)(l * 2 + 1) * 16) * 256 + h * 64 + dk;
  float wf[16], wb[16];
#pragma unroll
  for (int r = 0; r < 16; ++r) { wf[r] = w2f[r * 256]; wb[r] = w2b[r * 256]; }
  const float biasf = p.in[9][(l * 2 + 0) * 256 + h * 64 + dk];
  const float biasb = p.in[9][(l * 2 + 1) * 256 + h * 64 + dk];
  float pf[16], sbk[16];
#pragma unroll
  for (int i = 0; i < 16; ++i) {
    const float* lrow = lr + (tg * 16 + i) * 32;
    float zf = biasf, zb = biasb;
#pragma unroll
    for (int r = 0; r < 16; ++r) { zf += lrow[r] * wf[r]; zb += lrow[16 + r] * wb[r]; }
    pf[i] = logsig16(zf); sbk[i] = logsig16(zb);
  }
#pragma unroll
  for (int i = 1; i < 16; ++i) pf[i] += pf[i - 1];
#pragma unroll
  for (int i = 14; i >= 0; --i) sbk[i] += sbk[i + 1];
  tot[tg * 64 + dk] = pf[15];
  tot[256 + tg * 64 + dk] = sbk[0];
  __syncthreads();
  float offf = 0.f, offb = 0.f, bfl = 0.f, bb0 = 0.f;
#pragma unroll
  for (int g4 = 0; g4 < 4; ++g4) {
    const float a = tot[g4 * 64 + dk], b = tot[256 + g4 * 64 + dk];
    bfl += a; bb0 += b;
    if (g4 < tg) offf += a;
    if (g4 > tg) offb += b;
  }
  u16* gqf = p.gq;
  u16* gkf = p.gq + (size_t)RG * 256;
  u16* gqb = p.gq + (size_t)RG * 512;
  u16* gkb = p.gq + (size_t)RG * 768;
  unsigned kfp[8], kbp[8];
#pragma unroll
  for (int i = 0; i < 16; ++i) {
    const int t = tg * 16 + i;
    const float bfv = offf + pf[i], bbv = offb + sbk[i];
    const float qv = bf2f(p.proj[(size_t)(r0 + t) * INW + C_QA + h * 64 + dk]);
    const float kv = bf2f(p.proj[(size_t)(r0 + t) * INW + C_KA + h * 64 + dk]);
    const size_t go = (size_t)(r0 + t) * 256 + h * 64 + dk;
    gqf[go] = f2bf(qv * __expf(bfv) * 0.125f);
    gkf[go] = f2bf(kv * __expf(-bfv));
    gqb[go] = f2bf(qv * __expf(bbv) * 0.125f);
    gkb[go] = f2bf(kv * __expf(-bbv));
    const u16 ksf = f2bf(kv * __expf(bfl - bfv));
    const u16 ksb = f2bf(kv * __expf(bb0 - bbv));
    if (i & 1) { kfp[i >> 1] |= ((unsigned)ksf) << 16; kbp[i >> 1] |= ((unsigned)ksb) << 16; }
    else { kfp[i >> 1] = ksf; kbp[i >> 1] = ksb; }
  }
  *(uint4*)(kTf + dk * 72 + tg * 16) = make_uint4(kfp[0], kfp[1], kfp[2], kfp[3]);
  *(uint4*)(kTf + dk * 72 + tg * 16 + 8) = make_uint4(kfp[4], kfp[5], kfp[6], kfp[7]);
  *(uint4*)(kTb + dk * 72 + tg * 16) = make_uint4(kbp[0], kbp[1], kbp[2], kbp[3]);
  *(uint4*)(kTb + dk * 72 + tg * 16 + 8) = make_uint4(kbp[4], kbp[5], kbp[6], kbp[7]);
  const size_t cb = ((size_t)(bl * NCHUNK + cidx) * 4 + h) * 2;
  if (tg == 0) {
    p.dec[(cb + 0) * 64 + dk] = __expf(bfl);
    p.dec[(cb + 1) * 64 + dk] = __expf(bb0);
  }
  __syncthreads();
  const int l31 = lane & 31, hh = lane >> 5;
  float* U = (float*)p.h;
#pragma unroll
  for (int dir = 0; dir < 2; ++dir) {
    const u16* kT = dir ? kTb : kTf;
#pragma unroll
    for (int dkt = 0; dkt < 2; ++dkt) {
      f32x16 acc;
#pragma unroll
      for (int e = 0; e < 16; ++e) acc[e] = 0.f;
#pragma unroll
      for (int s = 0; s < 4; ++s) {
        const bf16x8 a = *(const bf16x8*)(vT + (32 * wid + l31) * 72 + 16 * s + 8 * hh);
        const bf16x8 b = *(const bf16x8*)(kT + (32 * dkt + l31) * 72 + 16 * s + 8 * hh);
        acc = __builtin_amdgcn_mfma_f32_32x32x16_bf16(a, b, acc, 0, 0, 0);
      }
      float* up = U + (cb + dir) * 8192;
#pragma unroll
      for (int e = 0; e < 16; ++e) {
        const int dv = 32 * wid + (e & 3) + 8 * (e >> 2) + 4 * hh;
        up[dv * 64 + 32 * dkt + l31] = acc[e];
      }
    }
  }
}

__device__ void phase_postproj(const Params& p, int l, int* ctr) {
  const int n_prep = NBG * NCHUNK * 4, n_rows = RG / 16;
  run_q8(ctr, QA_CNT(n_prep + n_rows), [&](int q_, int j_) {
    const int it = QA_ID(q_, j_);
    if (it < n_prep) gla_prep(p, l, it);
    else postproj_rows(p, l, it - n_prep);
  });
}

__device__ void gla_scan(const Params& p, int it) {
  const int tid = TIDX;
  const int sl = it & 7, dir = (it >> 3) & 1, h = (it >> 4) & 3, bl = it >> 6;
  const int e0 = sl * 1024 + tid * 4;
  const int dk = e0 & 63;
  const float* U = (const float*)p.h;
  f32x4 S = {0.f, 0.f, 0.f, 0.f};
#pragma unroll 4
  for (int step = 0; step < NCHUNK; ++step) {
    const int cidx = dir ? (NCHUNK - 1 - step) : (step < 4 ? 128 + step : step - 4);
    const size_t base = ((size_t)(bl * NCHUNK + cidx) * 4 + h) * 2 + dir;
    const f32x4 u4 = *(const f32x4*)(U + base * 8192 + e0);
    const f32x4 d4 = *(const f32x4*)(p.dec + base * 64 + dk);
    uint2 o; o.x = pack2(S[0], S[1]); o.y = pack2(S[2], S[3]);
    *(uint2*)(p.ss + base * 8192 + e0) = o;
    S = d4 * S + u4;
  }
}

__device__ void q_tile(const Params& p, int l, int t) {
  const int MT = RG / 128;
  const int nt = t / MT, mt = t % MT;
  f32x4 acc[4][4];
  gemm_core<4>(p.proj + (size_t)mt * 128 * INW + C_CQ, INW, p.wt + (size_t)l * W_LAYER + W_UQ + (size_t)nt * 128 * 256, 256, 256, acc);
  EPI_VARS
  const float QS = 0.10206207261596577f * 1.4426950408889634f;
  int bl, pos0, isctx; rowinfo(mt * 128, NBG, bl, pos0, isctx);
  float rsq[4];
  uint2 qo[4][4];
#pragma unroll
  for (int xi = 0; xi < 4; ++xi) rsq[xi] = p.rstdq[mt * 128 + EPI_TR(xi)] * QS;
#pragma unroll
  for (int xi = 0; xi < 4; ++xi) {
    const int tr = EPI_TR(xi), r = mt * 128 + tr, pos = pos0 + tr;
    const float rs = rsq[xi];
#pragma unroll
    for (int wi = 0; wi < 4; ++wi) {
      const int n16 = (nt * 128 + wc_ * 64 + wi * 16) >> 4;
      const int m6 = n16 % 6;
      float v0 = acc[wi][xi][0] * rs, v1 = acc[wi][xi][1] * rs, v2 = acc[wi][xi][2] * rs, v3 = acc[wi][xi][3] * rs;
      if (m6 >= 4 && !isctx) {
        const float p0 = __shfl_xor(v0, 32), p1 = __shfl_xor(v1, 32), p2 = __shfl_xor(v2, 32), p3 = __shfl_xor(v3, 32);
        const int pa = (m6 == 5) ? (pos & 63) : (pos >> 6);
        const int f0 = (fq_ & 1) * 4;
        const float* rp = p.rope + (pa * 8 + f0) * 2;
        const float4 cs01 = *(const float4*)rp, cs23 = *(const float4*)(rp + 4);
        const float sg = (fq_ >= 2) ? 1.f : -1.f;
        v0 = v0 * cs01.x + sg * p0 * cs01.y;
        v1 = v1 * cs01.z + sg * p1 * cs01.w;
        v2 = v2 * cs23.x + sg * p2 * cs23.y;
        v3 = v3 * cs23.z + sg * p3 * cs23.w;
      }
      qo[wi][xi].x = pack2(v0, v1); qo[wi][xi].y = pack2(v2, v3);
    }
  }
  store_tile_bf16<4>(qo, p.q + (size_t)(mt * 128 + wr_ * 64) * 768 + nt * 128 + wc_ * 64, 768);
}

__device__ void kv_tile(const Params& p, int l, int t) {
  const int MT = RG / 128;
  const int nt = t / MT, mt = t % MT;
  f32x4 acc[4][4];
  gemm_core<4>(p.proj + (size_t)mt * 128 * INW + C_CKV, INW, p.wt + (size_t)l * W_LAYER + W_UKV + (size_t)nt * 128 * 128, 128, 128, acc);
  EPI_VARS
  int bl, pos0, isctx; rowinfo(mt * 128, NBG, bl, pos0, isctx);
  const int j0 = isctx ? SEQ + pos0 : pos0;
  float rskv[4];
#pragma unroll
  for (int xi = 0; xi < 4; ++xi) rskv[xi] = p.rstdkv[mt * 128 + EPI_TR(xi)];
#pragma unroll
  for (int xi = 0; xi < 4; ++xi) {
    const int tr = EPI_TR(xi), r = mt * 128 + tr, j = j0 + tr;
    const float rs = rskv[xi];
#pragma unroll
    for (int wi = 0; wi < 4; ++wi) {
      const int wn = EPI_NN(wi);
      const float v0 = acc[wi][xi][0] * rs, v1 = acc[wi][xi][1] * rs, v2 = acc[wi][xi][2] * rs, v3 = acc[wi][xi][3] * rs;
      if (wc_ == 0) {
        uint2 o; o.x = pack2(v0, v1); o.y = pack2(v2, v3);
        *(uint2*)(p.kf + ((size_t)(bl * 8 + nt) * NKEY + j) * 96 + wn) = o;
      } else {
        u16* vp = p.vt + ((size_t)(bl * 8 + nt) * 64 + (wn - 64)) * NKEY + j;
        vp[0] = f2bf(v0); vp[NKEY] = f2bf(v1); vp[2 * NKEY] = f2bf(v2); vp[3 * NKEY] = f2bf(v3);
      }
    }
  }
}

__device__ void phase_qkv(const Params& p, int l, int* ctr) {
  const int MT = RG / 128;
  const int n_scan = NBG * 64, n_q = MT * 6, n_kv = MT * 8;
  run_q8(ctr, QA_CNT(n_scan + n_q + n_kv), [&](int q_, int j_) {
    const int it = QA_ID(q_, j_);
    if (it < n_scan) gla_scan(p, it);
    else if (it < n_scan + n_q) q_tile(p, l, it - n_scan);
    else kv_tile(p, l, it - n_scan - n_q);
  });
}

__device__ __forceinline__ bf16x8 pack8(const f32x16& a, int o) {
  union { bf16x8 v; unsigned u[4]; } r;
  r.u[0] = pack2(a[o + 0], a[o + 1]); r.u[1] = pack2(a[o + 2], a[o + 3]);
  r.u[2] = pack2(a[o + 4], a[o + 5]); r.u[3] = pack2(a[o + 6], a[o + 7]);
  return r.v;
}
__device__ __forceinline__ bf16x8 ld2x8(const u16* p0) {
  union { bf16x8 v; uint2 u[2]; } r;
  r.u[0] = *(const uint2*)p0; r.u[1] = *(const uint2*)(p0 + 8);
  return r.v;
}

__device__ void attn_item(const Params& p, int it) {
  const int tid = TIDX, lane = tid & 63, wid = tid >> 6, l31 = lane & 31, hh = lane >> 5;
  const int qb = it % 66, bh = it / 66, h = bh & 7, bl = bh >> 3;
  const int r0 = qb < 64 ? bl * SEQ + qb * 128 : NBG * SEQ + bl * CTXL + (qb - 64) * 128;
  const int kt0 = qb < 64 ? 0 : 128;
  const int nkt = NCHUNK - kt0;
  constexpr int KROW = 208, VROW = 144, BUFB = 64 * KROW + 64 * VROW;
  bf16x8 qf[6];
  {
    const u16* qp = p.q + (size_t)(r0 + 32 * wid + l31) * 768 + h * 96 + 8 * hh;
#pragma unroll
    for (int s = 0; s < 6; ++s) qf[s] = *(const bf16x8*)(qp + 16 * s);
  }
  const u16* kbase = p.kf + (size_t)bh * NKEY * 96;
  const u16* vbase = p.vt + (size_t)bh * 64 * NKEY;
  uint4 kr0, kr1, kr2, vr0, vr1;
  const int kdst0 = (tid / 12) * KROW + (tid % 12) * 16;
  const int kdst1 = ((tid + 256) / 12) * KROW + ((tid + 256) % 12) * 16;
  const int kdst2 = ((tid + 512) / 12) * KROW + ((tid + 512) % 12) * 16;
  const int vdst0 = 64 * KROW + (tid >> 3) * VROW + (tid & 7) * 16;
  const int vdst1 = vdst0 + 32 * VROW;
  const int vsrc0 = (tid >> 3) * NKEY + (tid & 7) * 8;
  const int vsrc1 = vsrc0 + 32 * NKEY;
  {
    const u16* kp = kbase + (size_t)kt0 * 64 * 96 + tid * 8;
    kr0 = *(const uint4*)(kp); kr1 = *(const uint4*)(kp + 2048); kr2 = *(const uint4*)(kp + 4096);
    vr0 = *(const uint4*)(vbase + vsrc0 + kt0 * 64); vr1 = *(const uint4*)(vbase + vsrc1 + kt0 * 64);
    *(uint4*)(smem + kdst0) = kr0; *(uint4*)(smem + kdst1) = kr1; *(uint4*)(smem + kdst2) = kr2;
    *(uint4*)(smem + vdst0) = vr0; *(uint4*)(smem + vdst1) = vr1;
  }
  __builtin_amdgcn_s_waitcnt(0x0F70);
  __syncthreads();
  f32x16 oacc[2];
#pragma unroll
  for (int e = 0; e < 16; ++e) { oacc[0][e] = 0.f; oacc[1][e] = 0.f; }
  float m_run = -1e30f, l_run = 0.f;
  for (int t = 0; t < nkt; ++t) {
    const int cur = t & 1;
    {
      const int tn = kt0 + min(t + 1, nkt - 1);
      const u16* kp = kbase + (size_t)tn * 64 * 96 + tid * 8;
      kr0 = *(const uint4*)(kp); kr1 = *(const uint4*)(kp + 2048); kr2 = *(const uint4*)(kp + 4096);
      vr0 = *(const uint4*)(vbase + vsrc0 + tn * 64); vr1 = *(const uint4*)(vbase + vsrc1 + tn * 64);
    }
    __builtin_amdgcn_sched_barrier(0);
    const char* Kl = smem + cur * BUFB;
    const char* Vl = Kl + 64 * KROW;
    f32x16 sacc[2];
#pragma unroll
    for (int kb = 0; kb < 2; ++kb) {
#pragma unroll
      for (int e = 0; e < 16; ++e) sacc[kb][e] = 0.f;
#pragma unroll
      for (int s = 0; s < 6; ++s) {
        const bf16x8 a = *(const bf16x8*)(Kl + (32 * kb + l31) * KROW + 32 * s + 16 * hh);
        sacc[kb] = __builtin_amdgcn_mfma_f32_32x32x16_bf16(a, qf[s], sacc[kb], 0, 0, 0);
      }
    }
    float mx = sacc[0][0];
#pragma unroll
    for (int e = 1; e < 16; ++e) mx = fmaxf(mx, sacc[0][e]);
#pragma unroll
    for (int e = 0; e < 16; ++e) mx = fmaxf(mx, sacc[1][e]);
    mx = fmaxf(mx, __shfl_xor(mx, 32));
    const float m_new = fmaxf(m_run, mx);
    const float alpha = __builtin_amdgcn_exp2f(m_run - m_new);
    m_run = m_new;
    float ps = 0.f;
#pragma unroll
    for (int kb = 0; kb < 2; ++kb)
#pragma unroll
      for (int e = 0; e < 16; ++e) { const float pv = __builtin_amdgcn_exp2f(sacc[kb][e] - m_new); sacc[kb][e] = pv; ps += pv; }
    l_run = l_run * alpha + ps;
#pragma unroll
    for (int e = 0; e < 16; ++e) { oacc[0][e] *= alpha; oacc[1][e] *= alpha; }
#pragma unroll
    for (int kb = 0; kb < 2; ++kb)
#pragma unroll
      for (int s2 = 0; s2 < 2; ++s2) {
        const bf16x8 pfr = pack8(sacc[kb], 8 * s2);
#pragma unroll
        for (int dt = 0; dt < 2; ++dt) {
          const bf16x8 a = ld2x8((const u16*)(Vl + (32 * dt + l31) * VROW) + 32 * kb + 16 * s2 + 4 * hh);
          oacc[dt] = __builtin_amdgcn_mfma_f32_32x32x16_bf16(a, pfr, oacc[dt], 0, 0, 0);
        }
      }
    __builtin_amdgcn_sched_barrier(0);
    {
      char* nb = smem + (cur ^ 1) * BUFB;
      *(uint4*)(nb + kdst0) = kr0; *(uint4*)(nb + kdst1) = kr1; *(uint4*)(nb + kdst2) = kr2;
      *(uint4*)(nb + vdst0) = vr0; *(uint4*)(nb + vdst1) = vr1;
    }
    __syncthreads();
  }
  l_run += __shfl_xor(l_run, 32);
  const float inv = 1.f / l_run;
  u16* op = p.h + (size_t)RG * 512 + (size_t)(r0 + 32 * wid + l31) * 512 + h * 64;
#pragma unroll
  for (int dt = 0; dt < 2; ++dt)
#pragma unroll
    for (int gq_ = 0; gq_ < 4; ++gq_) {
      const int dv0 = 32 * dt + 8 * gq_ + 4 * hh;
      uint2 o;
      o.x = pack2(oacc[dt][4 * gq_ + 0] * inv, oacc[dt][4 * gq_ + 1] * inv);
      o.y = pack2(oacc[dt][4 * gq_ + 2] * inv, oacc[dt][4 * gq_ + 3] * inv);
      *(uint2*)(op + dv0) = o;
    }
}

__device__ void gla_out(const Params& p, int l, int it) {
  const int tid = TIDX, lane = tid & 63, wid = tid >> 6, l31 = lane & 31, hh = lane >> 5;
  const int bl = it / (NCHUNK * 4), rem = it % (NCHUNK * 4), cidx = rem >> 2, h = rem & 3;
  const int r0 = chunk_row(bl, cidx, NBG);
  u16* tiles = (u16*)smem;
  u16* vT = (u16*)(smem + 36864);
  float* part = (float*)(smem + 55296);
  {
    const int t = tid >> 2, c16 = (tid & 3) * 16;
#pragma unroll
    for (int a = 0; a < 4; ++a) {
      const u16* src = p.gq + (size_t)a * RG * 256 + (size_t)(r0 + t) * 256 + h * 64 + c16;
      const uint4 u0 = *(const uint4*)src, u1 = *(const uint4*)(src + 8);
      u16* d = tiles + a * 4608 + t * 72 + c16;
      *(uint4*)d = u0; *(uint4*)(d + 8) = u1;
    }
    const int dvc = (tid & 3) * 32;
    const u16* vp = p.proj + (size_t)(r0 + t) * INW + C_VA + h * 128 + dvc;
#pragma unroll
    for (int i = 0; i < 4; ++i) {
      const uint4 vv = *(const uint4*)(vp + i * 8);
      u16* dst = vT + (size_t)(dvc + i * 8) * 72 + t;
      dst[0] = (u16)(vv.x & 0xffff); dst[72] = (u16)(vv.x >> 16);
      dst[144] = (u16)(vv.y & 0xffff); dst[216] = (u16)(vv.y >> 16);
      dst[288] = (u16)(vv.z & 0xffff); dst[360] = (u16)(vv.z >> 16);
      dst[432] = (u16)(vv.w & 0xffff); dst[504] = (u16)(vv.w >> 16);
    }
  }
  const int itl = wid & 1, dvh = wid >> 1;
  const size_t cb = ((size_t)(bl * NCHUNK + cidx) * 4 + h) * 2;
  bf16x8 sfr[2][2][4];
#pragma unroll
  for (int dir = 0; dir < 2; ++dir)
#pragma unroll
    for (int dt = 0; dt < 2; ++dt)
#pragma unroll
      for (int s4 = 0; s4 < 4; ++s4)
        sfr[dir][dt][s4] = *(const bf16x8*)(p.ss + (cb + dir) * 8192 + (64 * dvh + 32 * dt + l31) * 64 + 16 * s4 + 8 * hh);
  __syncthreads();
  f32x16 oacc[2];
#pragma unroll
  for (int e = 0; e < 16; ++e) { oacc[0][e] = 0.f; oacc[1][e] = 0.f; }
#pragma unroll
  for (int dir = 0; dir < 2; ++dir) {
    const u16* Qt = tiles + (dir * 2) * 4608;
    const u16* Kt = tiles + (dir * 2 + 1) * 4608;
    bf16x8 qfr[4];
#pragma unroll
    for (int s = 0; s < 4; ++s) qfr[s] = *(const bf16x8*)(Qt + (32 * itl + l31) * 72 + 16 * s + 8 * hh);
    f32x16 aacc[2];
#pragma unroll
    for (int jt = 0; jt < 2; ++jt) {
#pragma unroll
      for (int e = 0; e < 16; ++e) aacc[jt][e] = 0.f;
#pragma unroll
      for (int s = 0; s < 4; ++s) {
        const bf16x8 a = *(const bf16x8*)(Kt + (32 * jt + l31) * 72 + 16 * s + 8 * hh);
        aacc[jt] = __builtin_amdgcn_mfma_f32_32x32x16_bf16(a, qfr[s], aacc[jt], 0, 0, 0);
      }
      const int i_tok = 32 * itl + l31;
#pragma unroll
      for (int e = 0; e < 16; ++e) {
        const int j_tok = 32 * jt + (e & 3) + 8 * (e >> 2) + 4 * hh;
        const bool keep = dir ? (j_tok >= i_tok) : (j_tok <= i_tok);
        if (!keep) aacc[jt][e] = 0.f;
      }
    }
#pragma unroll
    for (int dt = 0; dt < 2; ++dt) {
      const int dvrow = 64 * dvh + 32 * dt + l31;
#pragma unroll
      for (int jt = 0; jt < 2; ++jt)
#pragma unroll
        for (int s2 = 0; s2 < 2; ++s2) {
          const bf16x8 pfr = pack8(aacc[jt], 8 * s2);
          const bf16x8 a = ld2x8(vT + dvrow * 72 + 32 * jt + 16 * s2 + 4 * hh);
          oacc[dt] = __builtin_amdgcn_mfma_f32_32x32x16_bf16(a, pfr, oacc[dt], 0, 0, 0);
        }
#pragma unroll
      for (int s = 0; s < 4; ++s) {
        oacc[dt] = __builtin_amdgcn_mfma_f32_32x32x16_bf16(sfr[dir][dt][s], qfr[s], oacc[dt], 0, 0, 0);
      }
    }
  }
  float ss = 0.f;
#pragma unroll
  for (int e = 0; e < 16; ++e) ss += oacc[0][e] * oacc[0][e] + oacc[1][e] * oacc[1][e];
  ss += __shfl_xor(ss, 32);
  if (hh == 0) part[wid * 32 + l31] = ss;
  __syncthreads();
  const float totss = part[wid * 32 + l31] + part[(wid ^ 2) * 32 + l31];
  const float rstd = rsqrtf(totss * (1.f / 128.f) + EPS);
  const int r = r0 + 32 * itl + l31;
  const float* gam = p.in[10] + l * 512 + h * 128;
  u16* aa = p.h;
#pragma unroll
  for (int dt = 0; dt < 2; ++dt)
#pragma unroll
    for (int gq_ = 0; gq_ < 4; ++gq_) {
      const int dv0 = 64 * dvh + 32 * dt + 8 * gq_ + 4 * hh;
      const uint2 ra = *(const uint2*)(p.proj + (size_t)r * INW + C_RA + h * 128 + dv0);
      const float4 g4 = *(const float4*)(gam + dv0);
      uint2 o;
      o.x = pack2(oacc[dt][4 * gq_ + 0] * rstd * g4.x * silu_f(bflo(ra.x)), oacc[dt][4 * gq_ + 1] * rstd * g4.y * silu_f(bfhi(ra.x)));
      o.y = pack2(oacc[dt][4 * gq_ + 2] * rstd * g4.z * silu_f(bflo(ra.y)), oacc[dt][4 * gq_ + 3] * rstd * g4.w * silu_f(bfhi(ra.y)));
      *(uint2*)(aa + (size_t)r * 512 + h * 128 + dv0) = o;
    }
}

__device__ void phase_attn(const Params& p, int l, int* ctr) {
  const int n_attn = NBG * 8 * 66, n_gla = NBG * NCHUNK * 4;
  const int per_q = n_attn >> 3;
  run_q8(ctr, [=](int q_) { return per_q + ((n_gla - q_ + 7) >> 3); }, [&](int q_, int j_) {
    if (j_ < per_q) attn_item(p, ((j_ / 66) * 8 + q_) * 66 + (j_ % 66));
    else gla_out(p, l, QA_ID(q_, j_ - per_q));
  });
}

__device__ void phase_merge(const Params& p, int l, int* ctr) {
  const int MT = RG / 128, NT = 16;
  const u16* wl = p.wt + (size_t)l * W_LAYER;
  run_q8(ctr, GEMM_CNT(MT, NT), [&](int q_, int j_) {
    int mt, nt; tile_order(j_, mlo(q_ + 1, MT) - mlo(q_, MT), NT, mt, nt); mt += mlo(q_, MT);
    f32x4 macc[2][4];
#pragma unroll
    for (int a = 0; a < 2; ++a)
#pragma unroll
      for (int b = 0; b < 4; ++b) macc[a][b] = f32x4{0.f, 0.f, 0.f, 0.f};
    EPI_VARS
#pragma unroll 1
    for (int br = 0; br < 3; ++br) {
      const u16* X = (br == 0) ? p.h : (br == 1) ? p.h + (size_t)RG * 512 : p.uc;
      const u16* W = wl + (br == 0 ? W_BRA : br == 1 ? W_BRB : W_BRC);
      f32x4 acc[2][4];
      uint2 gts[2][4];
#pragma unroll
      for (int wi = 0; wi < 2; ++wi)
#pragma unroll
        for (int xi = 0; xi < 4; ++xi) {
          const int r = mt * 128 + EPI_TR(xi), n = nt * 64 + wc_ * 32 + wi * 16 + fq_ * 4;
          gts[wi][xi] = *(const uint2*)(p.proj + (size_t)r * INW + C_GATE + br * 1024 + n);
        }
      gemm_core<2>(X + (size_t)mt * 128 * 512, 512, W + (size_t)nt * 64 * 512, 512, 512, acc);
#pragma unroll
      for (int wi = 0; wi < 2; ++wi)
#pragma unroll
        for (int xi = 0; xi < 4; ++xi) {
          const uint2 gt = gts[wi][xi];
          macc[wi][xi][0] += sigmoid_f(bflo(gt.x)) * acc[wi][xi][0];
          macc[wi][xi][1] += sigmoid_f(bfhi(gt.x)) * acc[wi][xi][1];
          macc[wi][xi][2] += sigmoid_f(bflo(gt.y)) * acc[wi][xi][2];
          macc[wi][xi][3] += sigmoid_f(bfhi(gt.y)) * acc[wi][xi][3];
        }
    }
    uint2 o[2][4];
#pragma unroll
    for (int wi = 0; wi < 2; ++wi)
#pragma unroll
      for (int xi = 0; xi < 4; ++xi) {
        o[wi][xi].x = pack2(macc[wi][xi][0], macc[wi][xi][1]); o[wi][xi].y = pack2(macc[wi][xi][2], macc[wi][xi][3]);
      }
    store_tile_bf16<2>(o, p.m + (size_t)(mt * 128 + wr_ * 64) * DM + nt * 64 + wc_ * 32, DM);
  });
}

__device__ void phase_resid(const Params& p, int l, int g, int which, int* ctr) {
  const int MT = RG / 128, NT = 8;
  const u16* wl = p.wt + (size_t)l * W_LAYER;
  const u16* X = which == 0 ? p.m : p.proj + (size_t)RG * DFF;
  const int ldx = which == 0 ? DM : DFF, K = which == 0 ? DM : DFF;
  const u16* W = wl + (which == 0 ? W_O : W_DN);
  const int goff = which == 0 ? 2048 : 5120;
  const int from_input = (which == 0 && l == 0);
  run_q8(ctr, GEMM_CNT(MT, NT), [&](int q_, int j_) {
    int mt, nt; tile_order(j_, mlo(q_ + 1, MT) - mlo(q_, MT), NT, mt, nt); mt += mlo(q_, MT);
    f32x4 acc[4][4];
    gemm_core<4>(X + (size_t)mt * 128 * ldx, ldx, W + (size_t)nt * 128 * K, K, K, acc);
    EPI_VARS
    const float* mrow = p.mod + ((size_t)l * 9 + mod_index(p, g, mt * 128)) * 6144 + goff;
    float4 gv[4];
#pragma unroll
    for (int wi = 0; wi < 4; ++wi) gv[wi] = *(const float4*)(mrow + nt * 128 + EPI_NN(wi));
#pragma unroll
    for (int xi = 0; xi < 4; ++xi) {
      const int r = mt * 128 + EPI_TR(xi);
      const float* xs = xsrc_row_ptr(p, g, r, from_input);
      float* xd = xrow_ptr(p, g, r);
      float4 xv[4];
#pragma unroll
      for (int wi = 0; wi < 4; ++wi) xv[wi] = *(const float4*)(xs + nt * 128 + EPI_NN(wi));
#pragma unroll
      for (int wi = 0; wi < 4; ++wi) {
        float4 o;
        o.x = xv[wi].x + gv[wi].x * acc[wi][xi][0]; o.y = xv[wi].y + gv[wi].y * acc[wi][xi][1];
        o.z = xv[wi].z + gv[wi].z * acc[wi][xi][2]; o.w = xv[wi].w + gv[wi].w * acc[wi][xi][3];
        *(float4*)(xd + nt * 128 + EPI_NN(wi)) = o;
      }
    }
  });
}

__device__ void phase_gu(const Params& p, int l, int* ctr) {
  const int MT = RG / 128, NT = 44;
  const u16* W = p.wt + (size_t)l * W_LAYER + W_GU;
  run_q8(ctr, GEMM_CNT(MT, NT), [&](int q_, int j_) {
    int mt, nt; tile_order(j_, mlo(q_ + 1, MT) - mlo(q_, MT), NT, mt, nt); mt += mlo(q_, MT);
    f32x4 acc[4][4];
    gemm_core<4>(p.h + (size_t)mt * 128 * DM, DM, W + (size_t)nt * 128 * DM, DM, DM, acc);
    EPI_VARS
    u16* dst = p.proj + (nt >= 22 ? (size_t)RG * DFF : 0);
    const int nb = (nt >= 22 ? nt - 22 : nt) * 128;
    uint2 o[4][4];
#pragma unroll
    for (int wi = 0; wi < 4; ++wi)
#pragma unroll
      for (int xi = 0; xi < 4; ++xi) {
        o[wi][xi].x = pack2(acc[wi][xi][0], acc[wi][xi][1]); o[wi][xi].y = pack2(acc[wi][xi][2], acc[wi][xi][3]);
      }
    store_tile_bf16<4>(o, dst + (size_t)(mt * 128 + wr_ * 64) * DFF + nb + wc_ * 64, DFF);
  });
}

__device__ void phase_act(const Params& p, int l, int* ctr) {
  const int nitems = RG / 8;
  const float* cw = p.in[23] + (size_t)l * 3 * DFF;
  const float* cb = p.in[24] + (size_t)l * DFF;
  const u16* G = p.proj;
  u16* UP = p.proj + (size_t)RG * DFF;
  for (int it = blockIdx.x; it < nitems; it += gridDim.x) {
    for (int e = TIDX; e < 8 * 352; e += 256) {
      const int rr = e / 352, c0 = (e % 352) * 8;
      const int r = it * 8 + rr;
      int bl, pos, isctx; rowinfo(r, NBG, bl, pos, isctx);
      const int L = isctx ? CTXL : SEQ;
      const u16* gp = G + (size_t)r * DFF + c0;
      const uint4 g1 = *(const uint4*)gp;
      uint4 g0 = make_uint4(0, 0, 0, 0), g2 = g0;
      if (pos > 0) g0 = *(const uint4*)(gp - DFF);
      if (pos < L - 1) g2 = *(const uint4*)(gp + DFF);
      const uint4 uu = *(const uint4*)(UP + (size_t)r * DFF + c0);
      const float4 w0a = *(const float4*)(cw + c0), w0b = *(const float4*)(cw + c0 + 4);
      const float4 w1a = *(const float4*)(cw + DFF + c0), w1b = *(const float4*)(cw + DFF + c0 + 4);
      const float4 w2a = *(const float4*)(cw + 2 * DFF + c0), w2b = *(const float4*)(cw + 2 * DFF + c0 + 4);
      const float4 ba = *(const float4*)(cb + c0), bb = *(const float4*)(cb + c0 + 4);
      uint4 o;
#define ACT2(G0, G1, G2, UU, W0L, W0H, W1L, W1H, W2L, W2H, BL, BH) \
      pack2(silu_f(W0L * bflo(G0) + W1L * bflo(G1) + W2L * bflo(G2) + BL) * bflo(UU), \
            silu_f(W0H * bfhi(G0) + W1H * bfhi(G1) + W2H * bfhi(G2) + BH) * bfhi(UU))
      o.x = ACT2(g0.x, g1.x, g2.x, uu.x, w0a.x, w0a.y, w1a.x, w1a.y, w2a.x, w2a.y, ba.x, ba.y);
      o.y = ACT2(g0.y, g1.y, g2.y, uu.y, w0a.z, w0a.w, w1a.z, w1a.w, w2a.z, w2a.w, ba.z, ba.w);
      o.z = ACT2(g0.z, g1.z, g2.z, uu.z, w0b.x, w0b.y, w1b.x, w1b.y, w2b.x, w2b.y, bb.x, bb.y);
      o.w = ACT2(g0.w, g1.w, g2.w, uu.w, w0b.z, w0b.w, w1b.z, w1b.w, w2b.z, w2b.w, bb.z, bb.w);
#undef ACT2
      *(uint4*)(UP + (size_t)r * DFF + c0) = o;
    }
  }
}

__device__ void phase_final(const Params& p, int* ctr) {
  const int nitems = NBATCH * SEQ / 16;
  const float* gam = p.in[26];
  for (int it = blockIdx.x; it < nitems; it += gridDim.x) {
    const int lane = TIDX & 63, wid = TIDX >> 6;
    for (int rr = 0; rr < 4; ++rr) {
      float* xr = p.out + ((size_t)it * 16 + wid * 4 + rr) * DM;
      float4 v[4]; float ss = 0.f;
#pragma unroll
      for (int i = 0; i < 4; ++i) {
        v[i] = *(const float4*)(xr + lane * 4 + i * 256);
        ss += v[i].x * v[i].x + v[i].y * v[i].y + v[i].z * v[i].z + v[i].w * v[i].w;
      }
      ss = wave_sum(ss);
      const float rstd = rsqrtf(ss * (1.f / 1024.f) + EPS);
#pragma unroll
      for (int i = 0; i < 4; ++i) {
        const int c = lane * 4 + i * 256;
        const float4 gg = *(const float4*)(gam + c);
        float4 o; o.x = v[i].x * rstd * gg.x; o.y = v[i].y * rstd * gg.y; o.z = v[i].z * rstd * gg.z; o.w = v[i].w * rstd * gg.w;
        *(float4*)(xr + c) = o;
      }
    }
  }
}

__device__ void run_phase(const Params& p, int ph, int* ctr) {
  if (ph == 0) { phase0(p, ctr); return; }
  if (ph == NPHASES - 1) { phase_final(p, ctr); return; }
  const int idx = ph - 1, lg = idx / NPH_PER, sub = idx % NPH_PER;
  const int l = lg / NGRP, g = lg % NGRP;
  switch (sub) {
    case 0: phase_norm(p, l, g, 0, ctr); break;
    case 1: phase_proj(p, l, ctr); break;
    case 2: phase_postproj(p, l, ctr); break;
    case 3: phase_qkv(p, l, ctr); break;
    case 4: phase_attn(p, l, ctr); break;
    case 5: phase_merge(p, l, ctr); break;
    case 6: phase_resid(p, l, g, 0, ctr); break;
    case 7: phase_norm(p, l, g, 1, ctr); break;
    case 8: phase_gu(p, l, ctr); break;
    case 9: phase_act(p, l, ctr); break;
    default: phase_resid(p, l, g, 1, ctr); break;
  }
}

__global__ void __launch_bounds__(256, 2) mega_kernel(KArgs ka, int ph_lo, int ph_hi, int coop) {
  Params p;
#pragma unroll
  for (int i = 0; i < 27; ++i) p.in[i] = ka.in[i];
  p.out = ka.out;
  char* ws = ka.ws;
  p.ctr = (int*)(ws + O_CTR); p.mod = (float*)(ws + O_MOD); p.rope = (float*)(ws + O_ROPE); p.xc = (float*)(ws + O_XC);
  p.rstdq = (float*)(ws + O_RSQ); p.rstdkv = (float*)(ws + O_RSKV); p.dec = (float*)(ws + O_DEC); p.wt = (u16*)(ws + O_WT);
  p.proj = (u16*)(ws + O_PROJ); p.h = (u16*)(ws + O_H); p.m = (u16*)(ws + O_M); p.q = (u16*)(ws + O_Q);
  p.kf = (u16*)(ws + O_KF); p.vt = (u16*)(ws + O_VT); p.uc = (u16*)(ws + O_UC); p.gq = (u16*)(ws + O_GQ);
  p.ss = (u16*)(ws + O_SS);
  for (int ph = ph_lo; ph < ph_hi; ++ph) {
#ifdef PROBE_MASK
    const int nrep = (ph > 0 && ph < NPHASES - 1 && ((PROBE_MASK >> ((ph - 1) % NPH_PER)) & 1)) ? 2 : 1;
#else
    const int nrep = 1;
#endif
    for (int rep = 0; rep < nrep; ++rep) {
      if (rep) cg::this_grid().sync();
      run_phase(p, ph, p.ctr + rep * 512 + ph * 8);
    }
    if (coop && ph + 1 < ph_hi) cg::this_grid().sync();
  }
}

static inline size_t align_up(size_t v) { return (v + 255) & ~(size_t)255; }

extern "C" void kernel_launch(void* const* d_in, const int* in_sizes, int n_in, void* d_out, int out_size,
                              void* d_ws, size_t ws_size, hipStream_t stream) {
  static int grid_blocks = 0;
  if (!grid_blocks) {
    int dev = 0, cus = 0, per_cu = 0;
    hipGetDevice(&dev);
    hipDeviceGetAttribute(&cus, hipDeviceAttributeMultiprocessorCount, dev);
    hipFuncSetAttribute((const void*)mega_kernel, hipFuncAttributeMaxDynamicSharedMemorySize, LDS_BYTES);
    hipOccupancyMaxActiveBlocksPerMultiprocessor(&per_cu, (const void*)mega_kernel, 256, LDS_BYTES);
    if (per_cu < 1) per_cu = 1;
    if (per_cu > 2) per_cu = 2;
    grid_blocks = cus * per_cu;
  }
  KArgs p{};
  for (int i = 0; i < 27; ++i) p.in[i] = (const float*)d_in[i];
  p.out = (float*)d_out;
  p.ws = (char*)d_ws;
  if (ws_size < WS_END) { fprintf(stderr, "workspace too small: %zu < %zu\n", ws_size, (size_t)WS_END); return; }
  hipMemsetAsync((char*)d_ws + O_CTR, 0, 4096, stream);
#if SINGLE_LAUNCH
  int lo = 0, hi = NPHASES, coop = 1;
  void* args[] = {&p, &lo, &hi, &coop};
  hipError_t e = hipLaunchCooperativeKernel((const void*)mega_kernel, dim3(grid_blocks), dim3(256), args, LDS_BYTES, stream);
  if (e != hipSuccess) fprintf(stderr, "cooperative launch failed: %s (grid %d)\n", hipGetErrorString(e), grid_blocks);
#else
  for (int ph = 0; ph < NPHASES; ++ph)
    hipLaunchKernelGGL(mega_kernel, dim3(grid_blocks), dim3(256), LDS_BYTES, stream, p, ph, ph + 1, 0);
#endif
}
```

```cpp
#include <hip/hip_runtime.h>
#include <hip/hip_cooperative_groups.h>
#include <cstdio>
#include <cstdint>
namespace cg = cooperative_groups;

typedef unsigned short u16;
typedef __attribute__((ext_vector_type(8))) short bf16x8;
typedef __attribute__((ext_vector_type(4))) float f32x4;
typedef __attribute__((ext_vector_type(16))) float f32x16;

#ifndef SINGLE_LAUNCH
#define SINGLE_LAUNCH 1
#endif

constexpr int DM = 1024, SEQ = 8192, CTXL = 256, NBATCH = 8, INW = 6592, INWP = 6656, DFF = 2816;
constexpr int C_QA = 0, C_KA = 256, C_VA = 512, C_RA = 1024, C_ALR = 1536, C_CQ = 1568, C_CKV = 1824,
              C_KR = 1952, C_SB = 1984, C_SC = 2496, C_SX = 3008, C_GATE = 3520;
constexpr int NKEY = SEQ + CTXL;
constexpr int NCHUNK = NKEY / 64;
constexpr float EPS = 1e-6f;
constexpr int LDS_BYTES = 65536 + 256;
constexpr int SLOT_OFF = 65536;
constexpr int NPH_PER = 11;
constexpr int NBG = 4;
constexpr int NGRP = NBATCH / NBG;
constexpr int RG = NBG * (SEQ + CTXL);
constexpr int NPHASES = 1 + 2 * NGRP * NPH_PER + 1;

constexpr size_t W_IN = 0;
constexpr size_t W_UQ = W_IN + (size_t)INWP * 1024;
constexpr size_t W_UKV = W_UQ + 768 * 256;
constexpr size_t W_BRA = W_UKV + 1024 * 128;
constexpr size_t W_BRB = W_BRA + 1024 * 512;
constexpr size_t W_BRC = W_BRB + 1024 * 512;
constexpr size_t W_O = W_BRC + 1024 * 512;
constexpr size_t W_GU = W_O + 1024 * 1024;
constexpr size_t W_DN = W_GU + (size_t)5632 * 1024;
constexpr size_t W_LAYER = W_DN + (size_t)1024 * 2816;

struct KArgs {
  const float* in[27];
  float* out;
  char* ws;
};
struct Params {
  const float* in[27];
  float* out;
  float* xc;
  u16* wt;
  float* mod;
  float* rope;
  int* ctr;
  float* rstdq;
  float* rstdkv;
  float* dec;
  u16* proj;
  u16* h;
  u16* m;
  u16* q;
  u16* kf;
  u16* vt;
  u16* uc;
  u16* gq;
  u16* ss;
};
constexpr size_t al256(size_t v) { return (v + 255) & ~(size_t)255; }
constexpr size_t XCD_BAR_BYTES = 3456 * 4;
constexpr size_t O_CTR = 0;
constexpr size_t O_BAR = O_CTR + 4096;
constexpr size_t O_MOD = al256(O_BAR + XCD_BAR_BYTES);
constexpr size_t O_ROPE = al256(O_MOD + (size_t)2 * 9 * 6144 * 4);
constexpr size_t O_XC = al256(O_ROPE + 1024 * 2 * 4);
constexpr size_t O_RSQ = al256(O_XC + (size_t)NBATCH * CTXL * DM * 4);
constexpr size_t O_RSKV = al256(O_RSQ + (size_t)RG * 4);
constexpr size_t O_DEC = al256(O_RSKV + (size_t)RG * 4);
constexpr size_t O_WT = al256(O_DEC + (size_t)NBG * NCHUNK * 4 * 2 * 64 * 4);
constexpr size_t O_PROJ = al256(O_WT + 2 * W_LAYER * 2);
constexpr size_t O_H = al256(O_PROJ + (size_t)RG * INW * 2);
constexpr size_t O_M = O_H + (size_t)RG * DM * 2;
constexpr size_t O_Q = al256(O_M + (size_t)RG * DM * 2);
constexpr size_t O_KF = al256(O_Q + (size_t)RG * 768 * 2);
constexpr size_t O_VT = al256(O_KF + (size_t)NBG * 8 * NKEY * 96 * 2);
constexpr size_t O_UC = al256(O_VT + (size_t)NBG * 8 * 64 * NKEY * 2);
constexpr size_t O_GQ = al256(O_UC + (size_t)RG * 512 * 2);
constexpr size_t O_SS = al256(O_GQ + (size_t)RG * 1024 * 2);
constexpr size_t WS_END = al256(O_SS + (size_t)NBG * NCHUNK * 4 * 2 * 8192 * 2);
static_assert(WS_END <= ((size_t)1 << 30), "workspace layout must fit 1 GiB");

extern __shared__ __attribute__((aligned(16))) char smem[];

typedef __bf16 hbf2 __attribute__((ext_vector_type(2)));
typedef float hf2 __attribute__((ext_vector_type(2)));
__device__ __forceinline__ unsigned pack2(float a, float b) {
  hf2 v = {a, b};
  return __builtin_bit_cast(unsigned, __builtin_convertvector(v, hbf2));
}
__device__ __forceinline__ u16 f2bf(float f) { return (u16)(pack2(f, 0.f) & 0xffffu); }
__device__ __forceinline__ float bf2f(u16 h) { return __uint_as_float(((unsigned)h) << 16); }
__device__ __forceinline__ float bflo(unsigned u) { return __uint_as_float(u << 16); }
__device__ __forceinline__ float bfhi(unsigned u) { return __uint_as_float(u & 0xffff0000u); }
__device__ __forceinline__ float silu_f(float x) { return x / (1.f + __expf(-x)); }
__device__ __forceinline__ float sigmoid_f(float x) { return 1.f / (1.f + __expf(-x)); }

__device__ __forceinline__ void rowinfo(int r, int NB, int& bl, int& pos, int& isctx) {
  const int nl = NB * SEQ;
  if (r < nl) { bl = r >> 13; pos = r & (SEQ - 1); isctx = 0; }
  else { const int rc = r - nl; bl = rc >> 8; pos = rc & (CTXL - 1); isctx = 1; }
}
__device__ __forceinline__ int chunk_row(int bl, int cidx, int NB) {
  return cidx < 128 ? bl * SEQ + cidx * 64 : NB * SEQ + bl * CTXL + (cidx - 128) * 64;
}

template <class CntF, class BodyF>
__device__ __forceinline__ void run_q8(int* ctr8, CntF cntf, BodyF body) {
  volatile int* slot = (volatile int*)(smem + SLOT_OFF);
  int q = blockIdx.x & 7, tries = 0, item;
  __syncthreads();
  if (threadIdx.x == 0) {
    int v = atomicAdd(&ctr8[q], 1);
    while (v >= cntf(q) && tries < 8) { q = (q + 1) & 7; ++tries; if (tries < 8) v = atomicAdd(&ctr8[q], 1); }
    slot[0] = (tries < 8) ? v : -1; slot[1] = q; slot[2] = tries;
  }
  __syncthreads();
  item = slot[0]; q = slot[1]; tries = slot[2];
  while (item >= 0) {
    int nxt = 0;
    if (threadIdx.x == 0) nxt = atomicAdd(&ctr8[q], 1);
    body(q, item);
    __syncthreads();
    if (threadIdx.x == 0) {
      int qq = q, t = tries;
      while (nxt >= cntf(qq) && t < 8) { qq = (qq + 1) & 7; ++t; if (t < 8) nxt = atomicAdd(&ctr8[qq], 1); }
      slot[0] = (t < 8) ? nxt : -1; slot[1] = qq; slot[2] = t;
    }
    __syncthreads();
    item = slot[0]; q = slot[1]; tries = slot[2];
  }
}
#define QA_CNT(N) [=](int q_) { return ((N) - q_ + 7) >> 3; }
#define QA_ID(q_, j_) ((j_) * 8 + (q_))

__device__ __forceinline__ int opaque_tid() {
  int t = threadIdx.x;
  asm volatile("" : "+v"(t));
  return t;
}
#define TIDX opaque_tid()
__device__ __forceinline__ float wave_sum(float v) {
  v += __shfl_xor(v, 32); v += __shfl_xor(v, 16); v += __shfl_xor(v, 8);
  v += __shfl_xor(v, 4); v += __shfl_xor(v, 2); v += __shfl_xor(v, 1);
  return v;
}

__device__ __forceinline__ int lds_byte(int r, int c) {
  const int st = (r >> 4) * 2 + (c >> 5), rr = r & 15, cc = c & 31, ob = rr * 64 + cc * 2;
  return st * 1024 + (ob ^ (((ob >> 9) & 1) << 5));
}
__device__ __forceinline__ void stage_rc(int b, int& R, int& C) {
  const int st = b >> 10, sb = b & 1023, swz = sb ^ (((sb >> 9) & 1) << 5);
  R = (st >> 1) * 16 + (swz >> 6); C = (st & 1) * 32 + ((swz & 63) >> 1);
}

__device__ __forceinline__ void glds16(const void* g, void* l) {
  __builtin_amdgcn_global_load_lds((const __attribute__((address_space(1))) unsigned*)g,
                                   (__attribute__((address_space(3))) unsigned*)l, 16, 0, 0);
}

template <int NWI>
__device__ __forceinline__ void gemm_core(const u16* __restrict__ X, int ldx, const u16* __restrict__ W, int ldw,
                                          int K, f32x4 (&acc)[NWI][4]) {
  const int tid = TIDX, lane = tid & 63, wid = tid >> 6;
  const int wr = wid >> 1, wc = wid & 1, fr = lane & 15, fq = lane >> 4;
#pragma unroll
  for (int a = 0; a < NWI; ++a)
#pragma unroll
    for (int b = 0; b < 4; ++b) acc[a][b] = f32x4{0.f, 0.f, 0.f, 0.f};
  const int srow = tid >> 3, schunk = (tid & 7) ^ ((tid >> 4) & 7);
  const u16* xg = X + (size_t)srow * ldx + schunk * 8;
  const u16* wg = W + (size_t)srow * ldw + schunk * 8;
  const int xs = 32 * ldx, ws_ = 32 * ldw;
  const int g = fr >> 1;
  const int lo0 = fr * 128 + ((fq ^ g) << 4), lo1 = fr * 128 + (((fq ^ g) ^ 4) << 4);
  const char* xb = smem + wr * 8192;
  const char* wb = smem + 16384 + wc * (NWI * 2048);
  char* sdst = smem + tid * 16;
  const int nt = K >> 6;
  __syncthreads();
#pragma unroll
  for (int i = 0; i < 4; ++i) {
    glds16(xg + i * xs, sdst + i * 4096);
    if (i < NWI) glds16(wg + i * ws_, sdst + 16384 + i * 4096);
  }
  for (int kt = 0; kt < nt; ++kt) {
    asm volatile("s_waitcnt vmcnt(0)" ::: "memory");
    __syncthreads();
    const int cb = (kt & 1) * 32768;
    if (kt + 1 < nt) {
      const int nb = 32768 - cb;
      const int ko = (kt + 1) * 64;
#pragma unroll
      for (int i = 0; i < 4; ++i) {
        glds16(xg + i * xs + ko, sdst + nb + i * 4096);
        if (i < NWI) glds16(wg + i * ws_ + ko, sdst + nb + 16384 + i * 4096);
      }
    }
    bf16x8 wf[2][NWI], xf[2][4];
#pragma unroll
    for (int i = 0; i < NWI; ++i) {
      wf[0][i] = *(const bf16x8*)(wb + cb + i * 2048 + lo0);
      wf[1][i] = *(const bf16x8*)(wb + cb + i * 2048 + lo1);
    }
#pragma unroll
    for (int i = 0; i < 4; ++i) {
      xf[0][i] = *(const bf16x8*)(xb + cb + i * 2048 + lo0);
      xf[1][i] = *(const bf16x8*)(xb + cb + i * 2048 + lo1);
    }
    __builtin_amdgcn_sched_barrier(0);
#pragma unroll
    for (int k = 0; k < 2; ++k)
#pragma unroll
      for (int wi = 0; wi < NWI; ++wi)
#pragma unroll
        for (int xi = 0; xi < 4; ++xi)
          acc[wi][xi] = __builtin_amdgcn_mfma_f32_16x16x32_bf16(wf[k][wi], xf[k][xi], acc[wi][xi], 0, 0, 0);
    __builtin_amdgcn_sched_barrier(0);
  }
}

#define EPI_VARS const int tid_ = TIDX, lane_ = tid_ & 63, wid_ = tid_ >> 6; \
  const int wr_ = wid_ >> 1, wc_ = wid_ & 1, fr_ = lane_ & 15, fq_ = lane_ >> 4; (void)fq_; (void)fr_; (void)wr_; (void)wc_;
#define EPI_TR(xi) (wr_ * 64 + (xi) * 16 + fr_)
#define EPI_NN(wi) (wc_ * 64 + (wi) * 16 + fq_ * 4)

template <int NWI>
__device__ __forceinline__ void store_tile_bf16(const uint2 (&o)[NWI][4], u16* dst_wave, size_t ld) {
  constexpr int RB = NWI * 32, CPR = RB / 16;
  const int tid = TIDX, lane = tid & 63, wid = tid >> 6, fr = lane & 15, fq = lane >> 4;
  char* lb = smem + wid * 8192;
#pragma unroll
  for (int wi = 0; wi < NWI; ++wi)
#pragma unroll
    for (int xi = 0; xi < 4; ++xi) {
      const int r = xi * 16 + fr, c = wi * 2 + (fq >> 1);
      *(uint2*)(lb + r * RB + ((c ^ (r & (CPR - 1))) << 4) + (fq & 1) * 8) = o[wi][xi];
    }
#pragma unroll
  for (int it = 0; it < CPR; ++it) {
    const int idx = it * 64 + lane, row = idx / CPR, c = idx % CPR;
    const uint4 v = *(const uint4*)(lb + row * RB + ((c ^ (row & (CPR - 1))) << 4));
    *(uint4*)(dst_wave + (size_t)row * ld + c * 8) = v;
  }
}

__device__ __forceinline__ void tile_order(int t, int MT, int NT, int& mt, int& nt) {
  constexpr int GM = 8;
  const int band = t / (GM * NT), rem = t - band * GM * NT;
  const int m0 = band * GM;
  const int gsz = min(GM, MT - m0);
  nt = rem / gsz; mt = m0 + rem - nt * gsz;
}

__device__ __forceinline__ int mlo(int q, int MT) { return (q * MT) >> 3; }
#define GEMM_CNT(MT, NT) [=](int q_) { return (mlo(q_ + 1, MT) - mlo(q_, MT)) * (NT); }

__device__ __forceinline__ float* xrow_ptr(const Params& p, int g, int r) {
  int bl, pos, isctx; rowinfo(r, NBG, bl, pos, isctx);
  const int b = g * NBG + bl;
  return isctx ? p.xc + ((size_t)b * CTXL + pos) * DM : p.out + ((size_t)b * SEQ + pos) * DM;
}
__device__ __forceinline__ const float* xsrc_row_ptr(const Params& p, int g, int r, int from_input) {
  int bl, pos, isctx; rowinfo(r, NBG, bl, pos, isctx);
  const int b = g * NBG + bl;
  if (from_input) return isctx ? p.in[2] + ((size_t)b * CTXL + pos) * DM : p.in[0] + ((size_t)b * SEQ + pos) * DM;
  return isctx ? p.xc + ((size_t)b * CTXL + pos) * DM : p.out + ((size_t)b * SEQ + pos) * DM;
}
__device__ __forceinline__ int mod_index(const Params& p, int g, int r) {
  int bl, pos, isctx; rowinfo(r, NBG, bl, pos, isctx);
  return isctx ? 8 : g * NBG + bl;
}

__device__ void conv_tile(const float* __restrict__ src, int K, int N, u16* __restrict__ dst,
                          const float* __restrict__ scale, int ktile, int ntile) {
  float* tile = (float*)smem;
  const int tid = TIDX;
  const int k0 = ktile * 64, n0 = ntile * 64;
  const bool valid = n0 < N;
  if (valid) {
    const int kk = tid >> 4, n4 = (tid & 15) * 4;
#pragma unroll
    for (int i = 0; i < 4; ++i) {
      const int k = kk + 16 * i;
      const float4 v = *(const float4*)(src + (size_t)(k0 + k) * N + n0 + n4);
      const float s = scale ? scale[k0 + k] : 1.f;
      tile[k * 65 + n4 + 0] = v.x * s; tile[k * 65 + n4 + 1] = v.y * s;
      tile[k * 65 + n4 + 2] = v.z * s; tile[k * 65 + n4 + 3] = v.w * s;
    }
  }
  __syncthreads();
  const int nn = tid >> 3, k8 = (tid & 7) * 8;
#pragma unroll
  for (int i = 0; i < 2; ++i) {
    const int n = nn + 32 * i;
    uint4 o = make_uint4(0, 0, 0, 0);
    if (valid) {
      o.x = pack2(tile[(k8 + 0) * 65 + n], tile[(k8 + 1) * 65 + n]);
      o.y = pack2(tile[(k8 + 2) * 65 + n], tile[(k8 + 3) * 65 + n]);
      o.z = pack2(tile[(k8 + 4) * 65 + n], tile[(k8 + 5) * 65 + n]);
      o.w = pack2(tile[(k8 + 6) * 65 + n], tile[(k8 + 7) * 65 + n]);
    }
    *(uint4*)(dst + (size_t)(n0 + n) * K + k0 + k8) = o;
  }
}

__device__ void sincos_d(double a, double& s, double& c) {
  const double k = rint(a * 0.6366197723675814);
  double r = fma(-k, 1.5707963267948966, a);
  r = fma(-k, 6.123233995736766e-17, r);
  const int q = ((int)k) & 3;
  const double r2 = r * r;
  const double sp = r * (1.0 + r2 * (-1.0 / 6 + r2 * (1.0 / 120 + r2 * (-1.0 / 5040 + r2 * (1.0 / 362880 + r2 * (-1.0 / 39916800 + r2 * (1.0 / 6227020800.0)))))));
  const double cp = 1.0 + r2 * (-0.5 + r2 * (1.0 / 24 + r2 * (-1.0 / 720 + r2 * (1.0 / 40320 + r2 * (-1.0 / 3628800 + r2 * (1.0 / 479001600.0 + r2 * (-1.0 / 87178291200.0)))))));
  s = (q == 0) ? sp : (q == 1) ? cp : (q == 2) ? -sp : -cp;
  c = (q == 0) ? cp : (q == 1) ? -sp : (q == 2) ? -cp : sp;
}

constexpr int CV_WIN = 0, CV_UQ = 1664, CV_UKV = 1712, CV_BRA = 1744, CV_BRB = 1872, CV_BRC = 2000,
              CV_WO = 2128, CV_GATE = 2384, CV_UP = 3088, CV_DN = 3792, CV_LAYER = 4496;
constexpr int P0_CONV = 2 * CV_LAYER, P0_ADA = 2 * 192, P0_TOTAL = P0_CONV + P0_ADA + 1;

__device__ void phase0(const Params& p, int* ctr) {
  run_q8(ctr, QA_CNT(P0_TOTAL), [&](int q_, int j_) {
    const int it = QA_ID(q_, j_);
    const int tid = TIDX;
    if (it < P0_CONV) {
      const int l = it / CV_LAYER, j = it % CV_LAYER;
      u16* wl = p.wt + (size_t)l * W_LAYER;
      if (j < CV_UQ)       { const int jj = j - CV_WIN;  conv_tile(p.in[7] + (size_t)l * 1024 * INW, 1024, INW, wl + W_IN, nullptr, jj / 104, jj % 104); }
      else if (j < CV_UKV) { const int jj = j - CV_UQ;   conv_tile(p.in[12] + (size_t)l * 256 * 768, 256, 768, wl + W_UQ, p.in[11] + l * 256, jj / 12, jj % 12); }
      else if (j < CV_BRA) { const int jj = j - CV_UKV;  conv_tile(p.in[14] + (size_t)l * 128 * 1024, 128, 1024, wl + W_UKV, p.in[13] + l * 128, jj / 16, jj % 16); }
      else if (j < CV_BRB) { const int jj = j - CV_BRA;  conv_tile(p.in[16] + (size_t)l * 512 * 1024, 512, 1024, wl + W_BRA, nullptr, jj / 16, jj % 16); }
      else if (j < CV_BRC) { const int jj = j - CV_BRB;  conv_tile(p.in[17] + (size_t)l * 512 * 1024, 512, 1024, wl + W_BRB, nullptr, jj / 16, jj % 16); }
      else if (j < CV_WO)  { const int jj = j - CV_BRC;  conv_tile(p.in[18] + (size_t)l * 512 * 1024, 512, 1024, wl + W_BRC, nullptr, jj / 16, jj % 16); }
      else if (j < CV_GATE){ const int jj = j - CV_WO;   conv_tile(p.in[19] + (size_t)l * 1024 * 1024, 1024, 1024, wl + W_O, nullptr, jj / 16, jj % 16); }
      else if (j < CV_UP)  { const int jj = j - CV_GATE; conv_tile(p.in[21] + (size_t)l * 1024 * DFF, 1024, DFF, wl + W_GU, nullptr, jj / 44, jj % 44); }
      else if (j < CV_DN)  { const int jj = j - CV_UP;   conv_tile(p.in[22] + (size_t)l * 1024 * DFF, 1024, DFF, wl + W_GU + (size_t)DFF * 1024, nullptr, jj / 44, jj % 44); }
      else                 { const int jj = j - CV_DN;   conv_tile(p.in[25] + (size_t)l * DFF * 1024, DFF, 1024, wl + W_DN, nullptr, jj / 16, jj % 16); }
    } else if (it < P0_CONV + P0_ADA) {
      const int a = it - P0_CONV, l = a / 192, cg_ = a % 192;
      float* sc = (float*)smem;
      float* red = sc + 9 * 1024;
      for (int e = tid; e < 9 * 1024; e += 256) {
        const int v = e >> 10, k = e & 1023;
        const float cv = (v < 8) ? p.in[1][v * 1024 + k] : p.in[3][k];
        sc[e] = cv / (1.f + expf(-cv));
      }
      __syncthreads();
      const int kg = tid >> 5, cn = tid & 31;
      const float* wa = p.in[4] + (size_t)l * 1024 * 6144 + cg_ * 32 + cn;
      float a0 = 0, a1 = 0, a2 = 0, a3 = 0, a4 = 0, a5 = 0, a6 = 0, a7 = 0, a8 = 0;
#pragma unroll 8
      for (int i = 0; i < 128; ++i) {
        const int k = kg + 8 * i;
        const float w = wa[(size_t)k * 6144];
        a0 += sc[k] * w; a1 += sc[1024 + k] * w; a2 += sc[2048 + k] * w; a3 += sc[3072 + k] * w;
        a4 += sc[4096 + k] * w; a5 += sc[5120 + k] * w; a6 += sc[6144 + k] * w; a7 += sc[7168 + k] * w;
        a8 += sc[8192 + k] * w;
      }
      float* rr = red + kg * 288 + cn;
      rr[0] = a0; rr[32] = a1; rr[64] = a2; rr[96] = a3; rr[128] = a4; rr[160] = a5; rr[192] = a6; rr[224] = a7; rr[256] = a8;
      __syncthreads();
      for (int e = tid; e < 288; e += 256) {
        float s = 0.f;
#pragma unroll
        for (int g8 = 0; g8 < 8; ++g8) s += red[g8 * 288 + e];
        const int v = e >> 5, n = cg_ * 32 + (e & 31);
        p.mod[((size_t)l * 9 + v) * 6144 + n] = s + p.in[5][l * 6144 + n];
      }
    } else {
      for (int e = tid; e < 1024; e += 256) {
        const int pos = e >> 3, f = e & 7;
        const float inv = (f == 0) ? 1.0f : (f == 1) ? 0.31622776601683794f : (f == 2) ? 0.1f : (f == 3) ? 0.031622776601683794f
                        : (f == 4) ? 0.01f : (f == 5) ? 0.0031622776601683794f : (f == 6) ? 0.001f : 0.00031622776601683794f;
        const float ang = (float)pos * inv;
        double s, c; sincos_d((double)ang, s, c);
        p.rope[e * 2] = (float)c; p.rope[e * 2 + 1] = (float)s;
      }
    }
  });
}

__device__ void phase_norm(const Params& p, int l, int g, int which, int* ctr) {
  const int nitems = RG / 16;
  const float* gam = (which == 0 ? p.in[6] : p.in[20]) + l * DM;
  const int shoff = which == 0 ? 0 : 3072, scoff = which == 0 ? 1024 : 4096;
  const int from_input = (which == 0 && l == 0);
  for (int it = blockIdx.x; it < nitems; it += gridDim.x) {
    const int lane = TIDX & 63, wid = TIDX >> 6;
    const int r0 = it * 16 + wid * 4;
    const float* xr = xsrc_row_ptr(p, g, r0, from_input);
    const float* mrow = p.mod + ((size_t)l * 9 + mod_index(p, g, r0)) * 6144;
    float4 v[4][4], gg[4], sh[4], sc[4];
#pragma unroll
    for (int rr = 0; rr < 4; ++rr)
#pragma unroll
      for (int i = 0; i < 4; ++i) v[rr][i] = *(const float4*)(xr + (size_t)rr * DM + lane * 4 + i * 256);
#pragma unroll
    for (int i = 0; i < 4; ++i) {
      const int c = lane * 4 + i * 256;
      gg[i] = *(const float4*)(gam + c); sh[i] = *(const float4*)(mrow + shoff + c); sc[i] = *(const float4*)(mrow + scoff + c);
    }
#pragma unroll
    for (int rr = 0; rr < 4; ++rr) {
      float ss = 0.f;
#pragma unroll
      for (int i = 0; i < 4; ++i)
        ss += v[rr][i].x * v[rr][i].x + v[rr][i].y * v[rr][i].y + v[rr][i].z * v[rr][i].z + v[rr][i].w * v[rr][i].w;
      ss = wave_sum(ss);
      const float rstd = rsqrtf(ss * (1.f / 1024.f) + EPS);
#pragma unroll
      for (int i = 0; i < 4; ++i) {
        const int c = lane * 4 + i * 256;
        uint2 o;
        o.x = pack2(v[rr][i].x * rstd * gg[i].x * (1.f + sc[i].x) + sh[i].x, v[rr][i].y * rstd * gg[i].y * (1.f + sc[i].y) + sh[i].y);
        o.y = pack2(v[rr][i].z * rstd * gg[i].z * (1.f + sc[i].z) + sh[i].z, v[rr][i].w * rstd * gg[i].w * (1.f + sc[i].w) + sh[i].w);
        *(uint2*)(p.h + (size_t)(r0 + rr) * DM + c) = o;
      }
    }
  }
}

__device__ void phase_proj(const Params& p, int l, int* ctr) {
  const int MT = RG / 128, NT = INWP / 128;
  const u16* W = p.wt + (size_t)l * W_LAYER + W_IN;
  run_q8(ctr, GEMM_CNT(MT, NT), [&](int q_, int j_) {
    int mt, nt; tile_order(j_, mlo(q_ + 1, MT) - mlo(q_, MT), NT, mt, nt); mt += mlo(q_, MT);
    f32x4 acc[4][4];
    gemm_core<4>(p.h + (size_t)mt * 128 * DM, DM, W + (size_t)nt * 128 * DM, DM, DM, acc);
    EPI_VARS
    uint2 o[4][4];
#pragma unroll
    for (int wi = 0; wi < 4; ++wi)
#pragma unroll
      for (int xi = 0; xi < 4; ++xi) {
        o[wi][xi].x = pack2(acc[wi][xi][0], acc[wi][xi][1]); o[wi][xi].y = pack2(acc[wi][xi][2], acc[wi][xi][3]);
      }
    if (nt * 128 + wc_ * 64 < INW)
      store_tile_bf16<4>(o, p.proj + (size_t)(mt * 128 + wr_ * 64) * INW + nt * 128 + wc_ * 64, INW);
  });
}

__device__ void postproj_rows(const Params& p, int l, int it) {
  const int lane = TIDX & 63, wid = TIDX >> 6;
  const float* scw = p.in[15] + (size_t)l * 3 * 512;
  for (int rr = 0; rr < 4; ++rr) {
    const int r = it * 16 + wid * 4 + rr;
    int bl, pos, isctx; rowinfo(r, NBG, bl, pos, isctx);
    const u16* pr = p.proj + (size_t)r * INW;
    const int Lr = isctx ? CTXL : SEQ;
    const int c0 = lane * 8;
    const uint2 u_cq = *(const uint2*)(pr + C_CQ + lane * 4);
    const unsigned u_ckv = *(const unsigned*)(pr + C_CKV + lane * 2);
    const u16 u_kr = pr[C_KR + (lane & 31)];
    const uint4 sb = *(const uint4*)(pr + C_SB + c0);
    const uint4 sc1 = *(const uint4*)(pr + C_SC + c0);
    const uint4 sx1 = *(const uint4*)(pr + C_SX + c0);
    uint4 sc0 = make_uint4(0, 0, 0, 0), sx0 = sc0, sc2 = sc0, sx2 = sc0;
    if (pos > 0) { sc0 = *(const uint4*)(pr - INW + C_SC + c0); sx0 = *(const uint4*)(pr - INW + C_SX + c0); }
    if (pos < Lr - 1) { sc2 = *(const uint4*)(pr + INW + C_SC + c0); sx2 = *(const uint4*)(pr + INW + C_SX + c0); }
    {
      const uint2 u = u_cq;
      const float a = bflo(u.x), b = bfhi(u.x), c = bflo(u.y), d = bfhi(u.y);
      float ss = wave_sum(a * a + b * b + c * c + d * d);
      if (lane == 0) p.rstdq[r] = rsqrtf(ss * (1.f / 256.f) + EPS);
    }
    {
      const unsigned u = u_ckv;
      const float a = bflo(u), b = bfhi(u);
      float ss = wave_sum(a * a + b * b);
      if (lane == 0) p.rstdkv[r] = rsqrtf(ss * (1.f / 128.f) + EPS);
    }
    {
      const int idx = lane & 31;
      const float val = bf2f(u_kr);
      const float partner = __shfl_xor(val, 8);
      float o = val;
      if (!isctx) {
        const int axis = idx >> 4, half = (idx >> 3) & 1, f = idx & 7;
        const int pa = axis ? (pos & 63) : (pos >> 6);
        const float c = p.rope[(pa * 8 + f) * 2], s = p.rope[(pa * 8 + f) * 2 + 1];
        o = half ? (val * c + partner * s) : (val * c - partner * s);
      }
      const int j = isctx ? SEQ + pos : pos;
      const u16 ob = f2bf(o);
      if (lane < 32) {
#pragma unroll
        for (int hd = 0; hd < 8; ++hd)
          p.kf[((size_t)(bl * 8 + hd) * NKEY + j) * 96 + 64 + idx] = ob;
      }
    }
    {
      const float4 w0a = *(const float4*)(scw + c0), w0b = *(const float4*)(scw + c0 + 4);
      const float4 w1a = *(const float4*)(scw + 512 + c0), w1b = *(const float4*)(scw + 512 + c0 + 4);
      const float4 w2a = *(const float4*)(scw + 1024 + c0), w2b = *(const float4*)(scw + 1024 + c0 + 4);
      uint4 o;
#define UC2(SBW, A0, X0, A1, X1, A2, X2, W0L, W0H, W1L, W1H, W2L, W2H) \
      pack2(bflo(SBW) * (W0L * bflo(A0) * bflo(X0) + W1L * bflo(A1) * bflo(X1) + W2L * bflo(A2) * bflo(X2)), \
            bfhi(SBW) * (W0H * bfhi(A0) * bfhi(X0) + W1H * bfhi(A1) * bfhi(X1) + W2H * bfhi(A2) * bfhi(X2)))
      o.x = UC2(sb.x, sc0.x, sx0.x, sc1.x, sx1.x, sc2.x, sx2.x, w0a.x, w0a.y, w1a.x, w1a.y, w2a.x, w2a.y);
      o.y = UC2(sb.y, sc0.y, sx0.y, sc1.y, sx1.y, sc2.y, sx2.y, w0a.z, w0a.w, w1a.z, w1a.w, w2a.z, w2a.w);
      o.z = UC2(sb.z, sc0.z, sx0.z, sc1.z, sx1.z, sc2.z, sx2.z, w0b.x, w0b.y, w1b.x, w1b.y, w2b.x, w2b.y);
      o.w = UC2(sb.w, sc0.w, sx0.w, sc1.w, sx1.w, sc2.w, sx2.w, w0b.z, w0b.w, w1b.z, w1b.w, w2b.z, w2b.w);
#undef UC2
      *(uint4*)(p.uc + (size_t)r * 512 + c0) = o;
    }
  }
}

__device__ __forceinline__ float logsig16(float z) {
  return (fminf(z, 0.f) - log1pf(__expf(-fabsf(z)))) * (1.f / 16.f);
}

__device__ void gla_prep(const Params& p, int l, int it) {
  const int tid = TIDX, lane = tid & 63, wid = tid >> 6;
  const int bl = it / (NCHUNK * 4), rem = it % (NCHUNK * 4), cidx = rem >> 2, h = rem & 3;
  const int r0 = chunk_row(bl, cidx, NBG);
  float* lr = (float*)smem;
  float* tot = (float*)(smem + 8192);
  u16* vT = (u16*)(smem + 10752);
  u16* kTf = (u16*)(smem + 29184);
  u16* kTb = (u16*)(smem + 38400);
  {
    const int t = tid >> 2, c8 = (tid & 3) * 8;
    const uint4 u = *(const uint4*)(p.proj + (size_t)(r0 + t) * INW + C_ALR + c8);
    float* d = lr + t * 32 + c8;
    d[0] = bflo(u.x); d[1] = bfhi(u.x); d[2] = bflo(u.y); d[3] = bfhi(u.y);
    d[4] = bflo(u.z); d[5] = bfhi(u.z); d[6] = bflo(u.w); d[7] = bfhi(u.w);
    const int dvc = (tid & 3) * 32;
    const u16* vp = p.proj + (size_t)(r0 + t) * INW + C_VA + h * 128 + dvc;
#pragma unroll
    for (int i = 0; i < 4; ++i) {
      const uint4 vv = *(const uint4*)(vp + i * 8);
      u16* dst = vT + (size_t)(dvc + i * 8) * 72 + t;
      dst[0] = (u16)(vv.x & 0xffff); dst[72] = (u16)(vv.x >> 16);
      dst[144] = (u16)(vv.y & 0xffff); dst[216] = (u16)(vv.y >> 16);
      dst[288] = (u16)(vv.z & 0xffff); dst[360] = (u16)(vv.z >> 16);
      dst[432] = (u16)(vv.w & 0xffff); dst[504] = (u16)(vv.w >> 16);
    }
  }
  __syncthreads();
  const int dk = lane, tg = wid;
  const float* w2f = p.in[8] + ((size_t)(l * 2 + 0) * 16) * 256 + h * 64 + dk;
  const float* w2b = p.in[8] + ((size_t)(l * 2 + 1) * 16) * 256 + h * 64 + dk;
  float wf[16], wb[16];
#pragma unroll
  for (int r = 0; r < 16; ++r) { wf[r] = w2f[r * 256]; wb[r] = w2b[r * 256]; }
  const float biasf = p.in[9][(l * 2 + 0) * 256 + h * 64 + dk];
  const float biasb = p.in[9][(l * 2 + 1) * 256 + h * 64 + dk];
  float pf[16], sbk[16];
#pragma unroll
  for (int i = 0; i < 16; ++i) {
    const float* lrow = lr + (tg * 16 + i) * 32;
    float zf = biasf, zb = biasb;
#pragma unroll
    for (int r = 0; r < 16; ++r) { zf += lrow[r] * wf[r]; zb += lrow[16 + r] * wb[r]; }
    pf[i] = logsig16(zf); sbk[i] = logsig16(zb);
  }
#pragma unroll
  for (int i = 1; i < 16; ++i) pf[i] += pf[i - 1];
#pragma unroll
  for (int i = 14; i >= 0; --i) sbk[i] += sbk[i + 1];
  tot[tg * 64 + dk] = pf[15];
  tot[256 + tg * 64 + dk] = sbk[0];
  __syncthreads();
  float offf = 0.f, offb = 0.f, bfl = 0.f, bb0 = 0.f;
#pragma unroll
  for (int g4 = 0; g4 < 4; ++g4) {
    const float a = tot[g4 * 64 + dk], b = tot[256 + g4 * 64 + dk];
    bfl += a; bb0 += b;
    if (g4 < tg) offf += a;
    if (g4 > tg) offb += b;
  }
  u16* gqf = p.gq;
  u16* gkf = p.gq + (size_t)RG * 256;
  u16* gqb = p.gq + (size_t)RG * 512;
  u16* gkb = p.gq + (size_t)RG * 768;
  unsigned kfp[8], kbp[8];
#pragma unroll
  for (int i = 0; i < 16; ++i) {
    const int t = tg * 16 + i;
    const float bfv = offf + pf[i], bbv = offb + sbk[i];
    const float qv = bf2f(p.proj[(size_t)(r0 + t) * INW + C_QA + h * 64 + dk]);
    const float kv = bf2f(p.proj[(size_t)(r0 + t) * INW + C_KA + h * 64 + dk]);
    const size_t go = (size_t)(r0 + t) * 256 + h * 64 + dk;
    gqf[go] = f2bf(qv * __expf(bfv) * 0.125f);
    gkf[go] = f2bf(kv * __expf(-bfv));
    gqb[go] = f2bf(qv * __expf(bbv) * 0.125f);
    gkb[go] = f2bf(kv * __expf(-bbv));
    const u16 ksf = f2bf(kv * __expf(bfl - bfv));
    const u16 ksb = f2bf(kv * __expf(bb0 - bbv));
    if (i & 1) { kfp[i >> 1] |= ((unsigned)ksf) << 16; kbp[i >> 1] |= ((unsigned)ksb) << 16; }
    else { kfp[i >> 1] = ksf; kbp[i >> 1] = ksb; }
  }
  *(uint4*)(kTf + dk * 72 + tg * 16) = make_uint4(kfp[0], kfp[1], kfp[2], kfp[3]);
  *(uint4*)(kTf + dk * 72 + tg * 16 + 8) = make_uint4(kfp[4], kfp[5], kfp[6], kfp[7]);
  *(uint4*)(kTb + dk * 72 + tg * 16) = make_uint4(kbp[0], kbp[1], kbp[2], kbp[3]);
  *(uint4*)(kTb + dk * 72 + tg * 16 + 8) = make_uint4(kbp[4], kbp[5], kbp[6], kbp[7]);
  const size_t cb = ((size_t)(bl * NCHUNK + cidx) * 4 + h) * 2;
  if (tg == 0) {
    p.dec[(cb + 0) * 64 + dk] = __expf(bfl);
    p.dec[(cb + 1) * 64 + dk] = __expf(bb0);
  }
  __syncthreads();
  const int l31 = lane & 31, hh = lane >> 5;
  float* U = (float*)p.h;
#pragma unroll
  for (int dir = 0; dir < 2; ++dir) {
    const u16* kT = dir ? kTb : kTf;
#pragma unroll
    for (int dkt = 0; dkt < 2; ++dkt) {
      f32x16 acc;
#pragma unroll
      for (int e = 0; e < 16; ++e) acc[e] = 0.f;
#pragma unroll
      for (int s = 0; s < 4; ++s) {
        const bf16x8 a = *(const bf16x8*)(vT + (32 * wid + l31) * 72 + 16 * s + 8 * hh);
        const bf16x8 b = *(const bf16x8*)(kT + (32 * dkt + l31) * 72 + 16 * s + 8 * hh);
        acc = __builtin_amdgcn_mfma_f32_32x32x16_bf16(a, b, acc, 0, 0, 0);
      }
      float* up = U + (cb + dir) * 8192;
#pragma unroll
      for (int e = 0; e < 16; ++e) {
        const int dv = 32 * wid + (e & 3) + 8 * (e >> 2) + 4 * hh;
        up[dv * 64 + 32 * dkt + l31] = acc[e];
      }
    }
  }
}

__device__ void phase_postproj(const Params& p, int l, int* ctr) {
  const int n_prep = NBG * NCHUNK * 4, n_rows = RG / 16;
  run_q8(ctr, QA_CNT(n_prep + n_rows), [&](int q_, int j_) {
    const int it = QA_ID(q_, j_);
    if (it < n_prep) gla_prep(p, l, it);
    else postproj_rows(p, l, it - n_prep);
  });
}

__device__ void gla_scan(const Params& p, int it) {
  const int tid = TIDX;
  const int sl = it & 7, dir = (it >> 3) & 1, h = (it >> 4) & 3, bl = it >> 6;
  const int e0 = sl * 1024 + tid * 4;
  const int dk = e0 & 63;
  const float* U = (const float*)p.h;
  f32x4 S = {0.f, 0.f, 0.f, 0.f};
  for (int s0 = 0; s0 < NCHUNK; s0 += 12) {
    f32x4 u4[12], d4[12];
#pragma unroll
    for (int j = 0; j < 12; ++j) {
      const int step = s0 + j;
      const int cidx = dir ? (NCHUNK - 1 - step) : (step < 4 ? 128 + step : step - 4);
      const size_t base = ((size_t)(bl * NCHUNK + cidx) * 4 + h) * 2 + dir;
      u4[j] = *(const f32x4*)(U + base * 8192 + e0);
      d4[j] = *(const f32x4*)(p.dec + base * 64 + dk);
    }
#pragma unroll
    for (int j = 0; j < 12; ++j) {
      const int step = s0 + j;
      const int cidx = dir ? (NCHUNK - 1 - step) : (step < 4 ? 128 + step : step - 4);
      const size_t base = ((size_t)(bl * NCHUNK + cidx) * 4 + h) * 2 + dir;
      uint2 o; o.x = pack2(S[0], S[1]); o.y = pack2(S[2], S[3]);
      *(uint2*)(p.ss + base * 8192 + e0) = o;
      S = d4[j] * S + u4[j];
    }
  }
}

__device__ void q_tile(const Params& p, int l, int t) {
  const int MT = RG / 128;
  const int nt = t / MT, mt = t % MT;
  f32x4 acc[4][4];
  gemm_core<4>(p.proj + (size_t)mt * 128 * INW + C_CQ, INW, p.wt + (size_t)l * W_LAYER + W_UQ + (size_t)nt * 128 * 256, 256, 256, acc);
  EPI_VARS
  const float QS = 0.10206207261596577f * 1.4426950408889634f;
  int bl, pos0, isctx; rowinfo(mt * 128, NBG, bl, pos0, isctx);
  float rsq[4];
  uint2 qo[4][4];
#pragma unroll
  for (int xi = 0; xi < 4; ++xi) rsq[xi] = p.rstdq[mt * 128 + EPI_TR(xi)] * QS;
#pragma unroll
  for (int xi = 0; xi < 4; ++xi) {
    const int tr = EPI_TR(xi), r = mt * 128 + tr, pos = pos0 + tr;
    const float rs = rsq[xi];
#pragma unroll
    for (int wi = 0; wi < 4; ++wi) {
      const int n16 = (nt * 128 + wc_ * 64 + wi * 16) >> 4;
      const int m6 = n16 % 6;
      float v0 = acc[wi][xi][0] * rs, v1 = acc[wi][xi][1] * rs, v2 = acc[wi][xi][2] * rs, v3 = acc[wi][xi][3] * rs;
      if (m6 >= 4 && !isctx) {
        const float p0 = __shfl_xor(v0, 32), p1 = __shfl_xor(v1, 32), p2 = __shfl_xor(v2, 32), p3 = __shfl_xor(v3, 32);
        const int pa = (m6 == 5) ? (pos & 63) : (pos >> 6);
        const int f0 = (fq_ & 1) * 4;
        const float* rp = p.rope + (pa * 8 + f0) * 2;
        const float4 cs01 = *(const float4*)rp, cs23 = *(const float4*)(rp + 4);
        const float sg = (fq_ >= 2) ? 1.f : -1.f;
        v0 = v0 * cs01.x + sg * p0 * cs01.y;
        v1 = v1 * cs01.z + sg * p1 * cs01.w;
        v2 = v2 * cs23.x + sg * p2 * cs23.y;
        v3 = v3 * cs23.z + sg * p3 * cs23.w;
      }
      qo[wi][xi].x = pack2(v0, v1); qo[wi][xi].y = pack2(v2, v3);
    }
  }
  store_tile_bf16<4>(qo, p.q + (size_t)(mt * 128 + wr_ * 64) * 768 + nt * 128 + wc_ * 64, 768);
}

__device__ void kv_tile(const Params& p, int l, int t) {
  const int MT = RG / 128;
  const int nt = t / MT, mt = t % MT;
  f32x4 acc[4][4];
  gemm_core<4>(p.proj + (size_t)mt * 128 * INW + C_CKV, INW, p.wt + (size_t)l * W_LAYER + W_UKV + (size_t)nt * 128 * 128, 128, 128, acc);
  EPI_VARS
  int bl, pos0, isctx; rowinfo(mt * 128, NBG, bl, pos0, isctx);
  const int j0 = isctx ? SEQ + pos0 : pos0;
  float rskv[4];
#pragma unroll
  for (int xi = 0; xi < 4; ++xi) rskv[xi] = p.rstdkv[mt * 128 + EPI_TR(xi)];
#pragma unroll
  for (int xi = 0; xi < 4; ++xi) {
    const int tr = EPI_TR(xi), r = mt * 128 + tr, j = j0 + tr;
    const float rs = rskv[xi];
#pragma unroll
    for (int wi = 0; wi < 4; ++wi) {
      const int wn = EPI_NN(wi);
      const float v0 = acc[wi][xi][0] * rs, v1 = acc[wi][xi][1] * rs, v2 = acc[wi][xi][2] * rs, v3 = acc[wi][xi][3] * rs;
      if (wc_ == 0) {
        uint2 o; o.x = pack2(v0, v1); o.y = pack2(v2, v3);
        *(uint2*)(p.kf + ((size_t)(bl * 8 + nt) * NKEY + j) * 96 + wn) = o;
      } else {
        u16* vp = p.vt + ((size_t)(bl * 8 + nt) * 64 + (wn - 64)) * NKEY + j;
        vp[0] = f2bf(v0); vp[NKEY] = f2bf(v1); vp[2 * NKEY] = f2bf(v2); vp[3 * NKEY] = f2bf(v3);
      }
    }
  }
}

__device__ void phase_qkv(const Params& p, int l, int* ctr) {
  const int MT = RG / 128;
  const int n_scan = NBG * 64, n_q = MT * 6, n_kv = MT * 8;
  run_q8(ctr, QA_CNT(n_scan + n_q + n_kv), [&](int q_, int j_) {
    const int it = QA_ID(q_, j_);
    if (it < n_scan) gla_scan(p, it);
    else if (it < n_scan + n_q) q_tile(p, l, it - n_scan);
    else kv_tile(p, l, it - n_scan - n_q);
  });
}

__device__ __forceinline__ bf16x8 pack8(const f32x16& a, int o) {
  union { bf16x8 v; unsigned u[4]; } r;
  r.u[0] = pack2(a[o + 0], a[o + 1]); r.u[1] = pack2(a[o + 2], a[o + 3]);
  r.u[2] = pack2(a[o + 4], a[o + 5]); r.u[3] = pack2(a[o + 6], a[o + 7]);
  return r.v;
}
__device__ __forceinline__ bf16x8 ld2x8(const u16* p0) {
  union { bf16x8 v; uint2 u[2]; } r;
  r.u[0] = *(const uint2*)p0; r.u[1] = *(const uint2*)(p0 + 8);
  return r.v;
}

__device__ void attn_item(const Params& p, int it) {
  const int tid = TIDX, lane = tid & 63, wid = tid >> 6, l31 = lane & 31, hh = lane >> 5;
  const int qb = it % 66, bh = it / 66, h = bh & 7, bl = bh >> 3;
  const int r0 = qb < 64 ? bl * SEQ + qb * 128 : NBG * SEQ + bl * CTXL + (qb - 64) * 128;
  const int kt0 = qb < 64 ? 0 : 128;
  const int nkt = NCHUNK - kt0;
  constexpr int KROW = 208, VROW = 144, BUFB = 64 * KROW + 64 * VROW;
  bf16x8 qf[6];
  {
    const u16* qp = p.q + (size_t)(r0 + 32 * wid + l31) * 768 + h * 96 + 8 * hh;
#pragma unroll
    for (int s = 0; s < 6; ++s) qf[s] = *(const bf16x8*)(qp + 16 * s);
  }
  const u16* kbase = p.kf + (size_t)bh * NKEY * 96;
  const u16* vbase = p.vt + (size_t)bh * 64 * NKEY;
  uint4 kr0, kr1, kr2, vr0, vr1;
  const int kdst0 = (tid / 12) * KROW + (tid % 12) * 16;
  const int kdst1 = ((tid + 256) / 12) * KROW + ((tid + 256) % 12) * 16;
  const int kdst2 = ((tid + 512) / 12) * KROW + ((tid + 512) % 12) * 16;
  const int vdst0 = 64 * KROW + (tid >> 3) * VROW + (tid & 7) * 16;
  const int vdst1 = vdst0 + 32 * VROW;
  const int vsrc0 = (tid >> 3) * NKEY + (tid & 7) * 8;
  const int vsrc1 = vsrc0 + 32 * NKEY;
  {
    const u16* kp = kbase + (size_t)kt0 * 64 * 96 + tid * 8;
    kr0 = *(const uint4*)(kp); kr1 = *(const uint4*)(kp + 2048); kr2 = *(const uint4*)(kp + 4096);
    vr0 = *(const uint4*)(vbase + vsrc0 + kt0 * 64); vr1 = *(const uint4*)(vbase + vsrc1 + kt0 * 64);
    *(uint4*)(smem + kdst0) = kr0; *(uint4*)(smem + kdst1) = kr1; *(uint4*)(smem + kdst2) = kr2;
    *(uint4*)(smem + vdst0) = vr0; *(uint4*)(smem + vdst1) = vr1;
  }
  __builtin_amdgcn_s_waitcnt(0x0F70);
  __syncthreads();
  f32x16 oacc[2];
#pragma unroll
  for (int e = 0; e < 16; ++e) { oacc[0][e] = 0.f; oacc[1][e] = 0.f; }
  float m_run = -1e30f, l_run = 0.f;
  for (int t = 0; t < nkt; ++t) {
    const int cur = t & 1;
    {
      const int tn = kt0 + min(t + 1, nkt - 1);
      const u16* kp = kbase + (size_t)tn * 64 * 96 + tid * 8;
      kr0 = *(const uint4*)(kp); kr1 = *(const uint4*)(kp + 2048); kr2 = *(const uint4*)(kp + 4096);
      vr0 = *(const uint4*)(vbase + vsrc0 + tn * 64); vr1 = *(const uint4*)(vbase + vsrc1 + tn * 64);
    }
    __builtin_amdgcn_sched_barrier(0);
    const char* Kl = smem + cur * BUFB;
    const char* Vl = Kl + 64 * KROW;
    f32x16 sacc[2];
#pragma unroll
    for (int kb = 0; kb < 2; ++kb) {
#pragma unroll
      for (int e = 0; e < 16; ++e) sacc[kb][e] = 0.f;
#pragma unroll
      for (int s = 0; s < 6; ++s) {
        const bf16x8 a = *(const bf16x8*)(Kl + (32 * kb + l31) * KROW + 32 * s + 16 * hh);
        sacc[kb] = __builtin_amdgcn_mfma_f32_32x32x16_bf16(a, qf[s], sacc[kb], 0, 0, 0);
      }
    }
    float mx = sacc[0][0];
#pragma unroll
    for (int e = 1; e < 16; ++e) mx = fmaxf(mx, sacc[0][e]);
#pragma unroll
    for (int e = 0; e < 16; ++e) mx = fmaxf(mx, sacc[1][e]);
    mx = fmaxf(mx, __shfl_xor(mx, 32));
    const float m_new = fmaxf(m_run, mx);
    const float alpha = __builtin_amdgcn_exp2f(m_run - m_new);
    m_run = m_new;
    float ps = 0.f;
#pragma unroll
    for (int kb = 0; kb < 2; ++kb)
#pragma unroll
      for (int e = 0; e < 16; ++e) { const float pv = __builtin_amdgcn_exp2f(sacc[kb][e] - m_new); sacc[kb][e] = pv; ps += pv; }
    l_run = l_run * alpha + ps;
#pragma unroll
    for (int e = 0; e < 16; ++e) { oacc[0][e] *= alpha; oacc[1][e] *= alpha; }
#pragma unroll
    for (int kb = 0; kb < 2; ++kb)
#pragma unroll
      for (int s2 = 0; s2 < 2; ++s2) {
        const bf16x8 pfr = pack8(sacc[kb], 8 * s2);
#pragma unroll
        for (int dt = 0; dt < 2; ++dt) {
          const bf16x8 a = ld2x8((const u16*)(Vl + (32 * dt + l31) * VROW) + 32 * kb + 16 * s2 + 4 * hh);
          oacc[dt] = __builtin_amdgcn_mfma_f32_32x32x16_bf16(a, pfr, oacc[dt], 0, 0, 0);
        }
      }
    __builtin_amdgcn_sched_barrier(0);
    {
      char* nb = smem + (cur ^ 1) * BUFB;
      *(uint4*)(nb + kdst0) = kr0; *(uint4*)(nb + kdst1) = kr1; *(uint4*)(nb + kdst2) = kr2;
      *(uint4*)(nb + vdst0) = vr0; *(uint4*)(nb + vdst1) = vr1;
    }
    __syncthreads();
  }
  l_run += __shfl_xor(l_run, 32);
  const float inv = 1.f / l_run;
  u16* op = p.h + (size_t)RG * 512 + (size_t)(r0 + 32 * wid + l31) * 512 + h * 64;
#pragma unroll
  for (int dt = 0; dt < 2; ++dt)
#pragma unroll
    for (int gq_ = 0; gq_ < 4; ++gq_) {
      const int dv0 = 32 * dt + 8 * gq_ + 4 * hh;
      uint2 o;
      o.x = pack2(oacc[dt][4 * gq_ + 0] * inv, oacc[dt][4 * gq_ + 1] * inv);
      o.y = pack2(oacc[dt][4 * gq_ + 2] * inv, oacc[dt][4 * gq_ + 3] * inv);
      *(uint2*)(op + dv0) = o;
    }
}

__device__ void gla_out(const Params& p, int l, int it) {
  const int tid = TIDX, lane = tid & 63, wid = tid >> 6, l31 = lane & 31, hh = lane >> 5;
  const int bl = it / (NCHUNK * 4), rem = it % (NCHUNK * 4), cidx = rem >> 2, h = rem & 3;
  const int r0 = chunk_row(bl, cidx, NBG);
  u16* tiles = (u16*)smem;
  u16* vT = (u16*)(smem + 36864);
  float* part = (float*)(smem + 55296);
  {
    const int t = tid >> 2, c16 = (tid & 3) * 16;
#pragma unroll
    for (int a = 0; a < 4; ++a) {
      const u16* src = p.gq + (size_t)a * RG * 256 + (size_t)(r0 + t) * 256 + h * 64 + c16;
      const uint4 u0 = *(const uint4*)src, u1 = *(const uint4*)(src + 8);
      u16* d = tiles + a * 4608 + t * 72 + c16;
      *(uint4*)d = u0; *(uint4*)(d + 8) = u1;
    }
    const int dvc = (tid & 3) * 32;
    const u16* vp = p.proj + (size_t)(r0 + t) * INW + C_VA + h * 128 + dvc;
#pragma unroll
    for (int i = 0; i < 4; ++i) {
      const uint4 vv = *(const uint4*)(vp + i * 8);
      u16* dst = vT + (size_t)(dvc + i * 8) * 72 + t;
      dst[0] = (u16)(vv.x & 0xffff); dst[72] = (u16)(vv.x >> 16);
      dst[144] = (u16)(vv.y & 0xffff); dst[216] = (u16)(vv.y >> 16);
      dst[288] = (u16)(vv.z & 0xffff); dst[360] = (u16)(vv.z >> 16);
      dst[432] = (u16)(vv.w & 0xffff); dst[504] = (u16)(vv.w >> 16);
    }
  }
  const int itl = wid & 1, dvh = wid >> 1;
  const size_t cb = ((size_t)(bl * NCHUNK + cidx) * 4 + h) * 2;
  bf16x8 sfr[2][2][4];
#pragma unroll
  for (int dir = 0; dir < 2; ++dir)
#pragma unroll
    for (int dt = 0; dt < 2; ++dt)
#pragma unroll
      for (int s4 = 0; s4 < 4; ++s4)
        sfr[dir][dt][s4] = *(const bf16x8*)(p.ss + (cb + dir) * 8192 + (64 * dvh + 32 * dt + l31) * 64 + 16 * s4 + 8 * hh);
  __syncthreads();
  f32x16 oacc[2];
#pragma unroll
  for (int e = 0; e < 16; ++e) { oacc[0][e] = 0.f; oacc[1][e] = 0.f; }
#pragma unroll
  for (int dir = 0; dir < 2; ++dir) {
    const u16* Qt = tiles + (dir * 2) * 4608;
    const u16* Kt = tiles + (dir * 2 + 1) * 4608;
    bf16x8 qfr[4];
#pragma unroll
    for (int s = 0; s < 4; ++s) qfr[s] = *(const bf16x8*)(Qt + (32 * itl + l31) * 72 + 16 * s + 8 * hh);
    f32x16 aacc[2];
#pragma unroll
    for (int jt = 0; jt < 2; ++jt) {
#pragma unroll
      for (int e = 0; e < 16; ++e) aacc[jt][e] = 0.f;
#pragma unroll
      for (int s = 0; s < 4; ++s) {
        const bf16x8 a = *(const bf16x8*)(Kt + (32 * jt + l31) * 72 + 16 * s + 8 * hh);
        aacc[jt] = __builtin_amdgcn_mfma_f32_32x32x16_bf16(a, qfr[s], aacc[jt], 0, 0, 0);
      }
      const int i_tok = 32 * itl + l31;
#pragma unroll
      for (int e = 0; e < 16; ++e) {
        const int j_tok = 32 * jt + (e & 3) + 8 * (e >> 2) + 4 * hh;
        const bool keep = dir ? (j_tok >= i_tok) : (j_tok <= i_tok);
        if (!keep) aacc[jt][e] = 0.f;
      }
    }
#pragma unroll
    for (int dt = 0; dt < 2; ++dt) {
      const int dvrow = 64 * dvh + 32 * dt + l31;
#pragma unroll
      for (int jt = 0; jt < 2; ++jt)
#pragma unroll
        for (int s2 = 0; s2 < 2; ++s2) {
          const bf16x8 pfr = pack8(aacc[jt], 8 * s2);
          const bf16x8 a = ld2x8(vT + dvrow * 72 + 32 * jt + 16 * s2 + 4 * hh);
          oacc[dt] = __builtin_amdgcn_mfma_f32_32x32x16_bf16(a, pfr, oacc[dt], 0, 0, 0);
        }
#pragma unroll
      for (int s = 0; s < 4; ++s) {
        oacc[dt] = __builtin_amdgcn_mfma_f32_32x32x16_bf16(sfr[dir][dt][s], qfr[s], oacc[dt], 0, 0, 0);
      }
    }
  }
  float ss = 0.f;
#pragma unroll
  for (int e = 0; e < 16; ++e) ss += oacc[0][e] * oacc[0][e] + oacc[1][e] * oacc[1][e];
  ss += __shfl_xor(ss, 32);
  if (hh == 0) part[wid * 32 + l31] = ss;
  __syncthreads();
  const float totss = part[wid * 32 + l31] + part[(wid ^ 2) * 32 + l31];
  const float rstd = rsqrtf(totss * (1.f / 128.f) + EPS);
  const int r = r0 + 32 * itl + l31;
  const float* gam = p.in[10] + l * 512 + h * 128;
  u16* aa = p.h;
#pragma unroll
  for (int dt = 0; dt < 2; ++dt)
#pragma unroll
    for (int gq_ = 0; gq_ < 4; ++gq_) {
      const int dv0 = 64 * dvh + 32 * dt + 8 * gq_ + 4 * hh;
      const uint2 ra = *(const uint2*)(p.proj + (size_t)r * INW + C_RA + h * 128 + dv0);
      const float4 g4 = *(const float4*)(gam + dv0);
      uint2 o;
      o.x = pack2(oacc[dt][4 * gq_ + 0] * rstd * g4.x * silu_f(bflo(ra.x)), oacc[dt][4 * gq_ + 1] * rstd * g4.y * silu_f(bfhi(ra.x)));
      o.y = pack2(oacc[dt][4 * gq_ + 2] * rstd * g4.z * silu_f(bflo(ra.y)), oacc[dt][4 * gq_ + 3] * rstd * g4.w * silu_f(bfhi(ra.y)));
      *(uint2*)(aa + (size_t)r * 512 + h * 128 + dv0) = o;
    }
}

__device__ void phase_attn(const Params& p, int l, int* ctr) {
  const int n_attn = NBG * 8 * 66, n_gla = NBG * NCHUNK * 4;
  const int per_q = n_attn >> 3;
  run_q8(ctr, [=](int q_) { return per_q + ((n_gla - q_ + 7) >> 3); }, [&](int q_, int j_) {
    if (j_ < per_q) attn_item(p, ((j_ / 66) * 8 + q_) * 66 + (j_ % 66));
    else gla_out(p, l, QA_ID(q_, j_ - per_q));
  });
}

__device__ void phase_merge(const Params& p, int l, int* ctr) {
  const int MT = RG / 128, NT = 16;
  const u16* wl = p.wt + (size_t)l * W_LAYER;
  run_q8(ctr, GEMM_CNT(MT, NT), [&](int q_, int j_) {
    int mt, nt; tile_order(j_, mlo(q_ + 1, MT) - mlo(q_, MT), NT, mt, nt); mt += mlo(q_, MT);
    f32x4 macc[2][4];
#pragma unroll
    for (int a = 0; a < 2; ++a)
#pragma unroll
      for (int b = 0; b < 4; ++b) macc[a][b] = f32x4{0.f, 0.f, 0.f, 0.f};
    EPI_VARS
#pragma unroll 1
    for (int br = 0; br < 3; ++br) {
      const u16* X = (br == 0) ? p.h : (br == 1) ? p.h + (size_t)RG * 512 : p.uc;
      const u16* W = wl + (br == 0 ? W_BRA : br == 1 ? W_BRB : W_BRC);
      f32x4 acc[2][4];
      uint2 gts[2][4];
#pragma unroll
      for (int wi = 0; wi < 2; ++wi)
#pragma unroll
        for (int xi = 0; xi < 4; ++xi) {
          const int r = mt * 128 + EPI_TR(xi), n = nt * 64 + wc_ * 32 + wi * 16 + fq_ * 4;
          gts[wi][xi] = *(const uint2*)(p.proj + (size_t)r * INW + C_GATE + br * 1024 + n);
        }
      gemm_core<2>(X + (size_t)mt * 128 * 512, 512, W + (size_t)nt * 64 * 512, 512, 512, acc);
#pragma unroll
      for (int wi = 0; wi < 2; ++wi)
#pragma unroll
        for (int xi = 0; xi < 4; ++xi) {
          const uint2 gt = gts[wi][xi];
          macc[wi][xi][0] += sigmoid_f(bflo(gt.x)) * acc[wi][xi][0];
          macc[wi][xi][1] += sigmoid_f(bfhi(gt.x)) * acc[wi][xi][1];
          macc[wi][xi][2] += sigmoid_f(bflo(gt.y)) * acc[wi][xi][2];
          macc[wi][xi][3] += sigmoid_f(bfhi(gt.y)) * acc[wi][xi][3];
        }
    }
    uint2 o[2][4];
#pragma unroll
    for (int wi = 0; wi < 2; ++wi)
#pragma unroll
      for (int xi = 0; xi < 4; ++xi) {
        o[wi][xi].x = pack2(macc[wi][xi][0], macc[wi][xi][1]); o[wi][xi].y = pack2(macc[wi][xi][2], macc[wi][xi][3]);
      }
    store_tile_bf16<2>(o, p.m + (size_t)(mt * 128 + wr_ * 64) * DM + nt * 64 + wc_ * 32, DM);
  });
}

__device__ void phase_resid(const Params& p, int l, int g, int which, int* ctr) {
  const int MT = RG / 128, NT = 8;
  const u16* wl = p.wt + (size_t)l * W_LAYER;
  const u16* X = which == 0 ? p.m : p.proj + (size_t)RG * DFF;
  const int ldx = which == 0 ? DM : DFF, K = which == 0 ? DM : DFF;
  const u16* W = wl + (which == 0 ? W_O : W_DN);
  const int goff = which == 0 ? 2048 : 5120;
  const int from_input = (which == 0 && l == 0);
  run_q8(ctr, GEMM_CNT(MT, NT), [&](int q_, int j_) {
    int mt, nt; tile_order(j_, mlo(q_ + 1, MT) - mlo(q_, MT), NT, mt, nt); mt += mlo(q_, MT);
    f32x4 acc[4][4];
    gemm_core<4>(X + (size_t)mt * 128 * ldx, ldx, W + (size_t)nt * 128 * K, K, K, acc);
    EPI_VARS
    const float* mrow = p.mod + ((size_t)l * 9 + mod_index(p, g, mt * 128)) * 6144 + goff;
    float4 gv[4];
#pragma unroll
    for (int wi = 0; wi < 4; ++wi) gv[wi] = *(const float4*)(mrow + nt * 128 + EPI_NN(wi));
#pragma unroll
    for (int xi = 0; xi < 4; ++xi) {
      const int r = mt * 128 + EPI_TR(xi);
      const float* xs = xsrc_row_ptr(p, g, r, from_input);
      float* xd = xrow_ptr(p, g, r);
      float4 xv[4];
#pragma unroll
      for (int wi = 0; wi < 4; ++wi) xv[wi] = *(const float4*)(xs + nt * 128 + EPI_NN(wi));
#pragma unroll
      for (int wi = 0; wi < 4; ++wi) {
        float4 o;
        o.x = xv[wi].x + gv[wi].x * acc[wi][xi][0]; o.y = xv[wi].y + gv[wi].y * acc[wi][xi][1];
        o.z = xv[wi].z + gv[wi].z * acc[wi][xi][2]; o.w = xv[wi].w + gv[wi].w * acc[wi][xi][3];
        *(float4*)(xd + nt * 128 + EPI_NN(wi)) = o;
      }
    }
  });
}

__device__ void phase_gu(const Params& p, int l, int* ctr) {
  const int MT = RG / 128, NT = 44;
  const u16* W = p.wt + (size_t)l * W_LAYER + W_GU;
  run_q8(ctr, GEMM_CNT(MT, NT), [&](int q_, int j_) {
    int mt, nt; tile_order(j_, mlo(q_ + 1, MT) - mlo(q_, MT), NT, mt, nt); mt += mlo(q_, MT);
    f32x4 acc[4][4];
    gemm_core<4>(p.h + (size_t)mt * 128 * DM, DM, W + (size_t)nt * 128 * DM, DM, DM, acc);
    EPI_VARS
    u16* dst = p.proj + (nt >= 22 ? (size_t)RG * DFF : 0);
    const int nb = (nt >= 22 ? nt - 22 : nt) * 128;
    uint2 o[4][4];
#pragma unroll
    for (int wi = 0; wi < 4; ++wi)
#pragma unroll
      for (int xi = 0; xi < 4; ++xi) {
        o[wi][xi].x = pack2(acc[wi][xi][0], acc[wi][xi][1]); o[wi][xi].y = pack2(acc[wi][xi][2], acc[wi][xi][3]);
      }
    store_tile_bf16<4>(o, dst + (size_t)(mt * 128 + wr_ * 64) * DFF + nb + wc_ * 64, DFF);
  });
}

struct ActIn { uint4 g0, g1, g2, uu; float4 w0a, w0b, w1a, w1b, w2a, w2b, ba, bb; };
__device__ __forceinline__ void act_load(ActIn& a, const u16* G, const u16* UP, const float* cw, const float* cb, int r, int c0) {
  int bl, pos, isctx; rowinfo(r, NBG, bl, pos, isctx);
  const int L = isctx ? CTXL : SEQ;
  const u16* gp = G + (size_t)r * DFF + c0;
  a.g1 = *(const uint4*)gp;
  a.g0 = make_uint4(0, 0, 0, 0); a.g2 = a.g0;
  if (pos > 0) a.g0 = *(const uint4*)(gp - DFF);
  if (pos < L - 1) a.g2 = *(const uint4*)(gp + DFF);
  a.uu = *(const uint4*)(UP + (size_t)r * DFF + c0);
  a.w0a = *(const float4*)(cw + c0); a.w0b = *(const float4*)(cw + c0 + 4);
  a.w1a = *(const float4*)(cw + DFF + c0); a.w1b = *(const float4*)(cw + DFF + c0 + 4);
  a.w2a = *(const float4*)(cw + 2 * DFF + c0); a.w2b = *(const float4*)(cw + 2 * DFF + c0 + 4);
  a.ba = *(const float4*)(cb + c0); a.bb = *(const float4*)(cb + c0 + 4);
}
__device__ __forceinline__ uint4 act_compute(const ActIn& a) {
  uint4 o;
#define ACT2(G0, G1, G2, UU, W0L, W0H, W1L, W1H, W2L, W2H, BL, BH) \
  pack2(silu_f(W0L * bflo(G0) + W1L * bflo(G1) + W2L * bflo(G2) + BL) * bflo(UU), \
        silu_f(W0H * bfhi(G0) + W1H * bfhi(G1) + W2H * bfhi(G2) + BH) * bfhi(UU))
  o.x = ACT2(a.g0.x, a.g1.x, a.g2.x, a.uu.x, a.w0a.x, a.w0a.y, a.w1a.x, a.w1a.y, a.w2a.x, a.w2a.y, a.ba.x, a.ba.y);
  o.y = ACT2(a.g0.y, a.g1.y, a.g2.y, a.uu.y, a.w0a.z, a.w0a.w, a.w1a.z, a.w1a.w, a.w2a.z, a.w2a.w, a.ba.z, a.ba.w);
  o.z = ACT2(a.g0.z, a.g1.z, a.g2.z, a.uu.z, a.w0b.x, a.w0b.y, a.w1b.x, a.w1b.y, a.w2b.x, a.w2b.y, a.bb.x, a.bb.y);
  o.w = ACT2(a.g0.w, a.g1.w, a.g2.w, a.uu.w, a.w0b.z, a.w0b.w, a.w1b.z, a.w1b.w, a.w2b.z, a.w2b.w, a.bb.z, a.bb.w);
#undef ACT2
  return o;
}

__device__ void phase_act(const Params& p, int l, int* ctr) {
  const int nitems = RG / 8;
  const float* cw = p.in[23] + (size_t)l * 3 * DFF;
  const float* cb = p.in[24] + (size_t)l * DFF;
  const u16* G = p.proj;
  u16* UP = p.proj + (size_t)RG * DFF;
  for (int it = blockIdx.x; it < nitems; it += gridDim.x) {
    const int tid = TIDX;
    for (int k = 0; k < 12; k += 2) {
      const int e0 = tid + k * 256, e1 = e0 + 256;
      const bool two = (k + 1 < 11);
      const int r0 = it * 8 + e0 / 352, c00 = (e0 % 352) * 8;
      const int r1 = it * 8 + (two ? e1 / 352 : 0), c01 = two ? (e1 % 352) * 8 : 0;
      ActIn a0, a1;
      act_load(a0, G, UP, cw, cb, r0, c00);
      act_load(a1, G, UP, cw, cb, r1, c01);
      const uint4 o0 = act_compute(a0), o1 = act_compute(a1);
      *(uint4*)(UP + (size_t)r0 * DFF + c00) = o0;
      if (two) *(uint4*)(UP + (size_t)r1 * DFF + c01) = o1;
    }
  }
}

__device__ void phase_final(const Params& p, int* ctr) {
  const int nitems = NBATCH * SEQ / 16;
  const float* gam = p.in[26];
  for (int it = blockIdx.x; it < nitems; it += gridDim.x) {
    const int lane = TIDX & 63, wid = TIDX >> 6;
    float* xr = p.out + ((size_t)it * 16 + wid * 4) * DM;
    float4 v[4][4], gg[4];
#pragma unroll
    for (int rr = 0; rr < 4; ++rr)
#pragma unroll
      for (int i = 0; i < 4; ++i) v[rr][i] = *(const float4*)(xr + (size_t)rr * DM + lane * 4 + i * 256);
#pragma unroll
    for (int i = 0; i < 4; ++i) gg[i] = *(const float4*)(gam + lane * 4 + i * 256);
#pragma unroll
    for (int rr = 0; rr < 4; ++rr) {
      float ss = 0.f;
#pragma unroll
      for (int i = 0; i < 4; ++i)
        ss += v[rr][i].x * v[rr][i].x + v[rr][i].y * v[rr][i].y + v[rr][i].z * v[rr][i].z + v[rr][i].w * v[rr][i].w;
      ss = wave_sum(ss);
      const float rstd = rsqrtf(ss * (1.f / 1024.f) + EPS);
#pragma unroll
      for (int i = 0; i < 4; ++i) {
        float4 o; o.x = v[rr][i].x * rstd * gg[i].x; o.y = v[rr][i].y * rstd * gg[i].y; o.z = v[rr][i].z * rstd * gg[i].z; o.w = v[rr][i].w * rstd * gg[i].w;
        *(float4*)(xr + (size_t)rr * DM + lane * 4 + i * 256) = o;
      }
    }
  }
}

#define XB_TMO      128
#define XB_XCNT(j)  (256  + 64 * (j))
#define XB_XSUB(j)  (1280 + 64 * (j))
#define XB_XGEN(j)  (2304 + 64 * (j))
#define XB_TOP      3328
#define XB_TOPGEN   3392
#define XCD_BAR_WORDS 3456
#define XB_SPIN_CAP (1u << 22)
#define LAS __attribute__((address_space(3)))
__device__ __forceinline__ unsigned xb_ld(unsigned* p)              { return __hip_atomic_load(p, __ATOMIC_RELAXED, __HIP_MEMORY_SCOPE_AGENT); }
__device__ __forceinline__ unsigned xb_add(unsigned* p, unsigned v) { return __hip_atomic_fetch_add(p, v, __ATOMIC_RELAXED, __HIP_MEMORY_SCOPE_AGENT); }
__device__ __forceinline__ unsigned xb_xcc_id() { return (unsigned)__builtin_amdgcn_s_getreg((3 << 11) | 20) & 0xFu; }
#define XB_SPIN(cond, bar) do { unsigned _sp = 0; while (cond) { __builtin_amdgcn_s_sleep(1); \
    if ((++_sp & 255u) == 0u) { if (xb_ld(&(bar)[XB_TMO])) break; if (_sp > XB_SPIN_CAP) { atomicAdd(&(bar)[XB_TMO], 1u); break; } } } } while (0)
struct XcdBarrier { unsigned* bar; unsigned x; volatile LAS unsigned* st; };
__device__ __forceinline__ XcdBarrier xcd_barrier_post(unsigned* bar, volatile LAS unsigned* st) {
  XcdBarrier b; b.bar = bar; b.x = xb_xcc_id(); b.st = st;
  if (threadIdx.x == 0) (void)xb_add(&bar[XB_XCNT(b.x)], 1u);
  return b;
}
__device__ __forceinline__ void xcd_barrier_complete(unsigned* bar, unsigned x, unsigned& nloc, unsigned& nx) {
  const unsigned G = gridDim.x * gridDim.y * gridDim.z;
  unsigned sum, cnt, mine, sp = 0u;
  for (;;) {
    sum = 0u; cnt = 0u; mine = 0u;
#pragma unroll
    for (unsigned j = 0; j < 16; ++j) { const unsigned c = xb_ld(&bar[XB_XCNT(j)]); sum += c; cnt += (c > 0u) ? 1u : 0u; mine = (j == x) ? c : mine; }
    if (sum == G) break;
    __builtin_amdgcn_s_sleep(1);
    if ((++sp & 255u) == 0u) { if (xb_ld(&bar[XB_TMO])) break; if (sp > XB_SPIN_CAP) { atomicAdd(&bar[XB_TMO], 1u); break; } }
  }
  nloc = mine > 0u ? mine : 1u; nx = cnt > 0u ? cnt : 1u;
}
__device__ __forceinline__ void xcd_barrier(const XcdBarrier& b) {
  asm volatile("s_waitcnt vmcnt(0)" ::: "memory");
  __syncthreads();
  if (threadIdx.x == 0) {
    unsigned* bar = b.bar;
    __builtin_amdgcn_s_waitcnt(0);
    unsigned nloc = b.st[0], nx = b.st[1];
    if (nloc == 0u) { xcd_barrier_complete(bar, b.x, nloc, nx); b.st[0] = nloc; b.st[1] = nx; }
    const unsigned old = xb_add(&bar[XB_XSUB(b.x)], 1u);
    const unsigned gen = old / nloc;
    if (old + 1u == (gen + 1u) * nloc) {
      __builtin_amdgcn_fence(__ATOMIC_RELEASE, "agent");
      asm volatile("s_waitcnt vmcnt(0)" ::: "memory");
      const unsigned og = xb_add(&bar[XB_TOP], 1u);
      const unsigned tg = og / nx;
      if (og + 1u == (tg + 1u) * nx) xb_add(&bar[XB_TOPGEN], 1u);
      else XB_SPIN(xb_ld(&bar[XB_TOPGEN]) == tg, bar);
      __builtin_amdgcn_fence(__ATOMIC_ACQUIRE, "agent");
      xb_add(&bar[XB_XGEN(b.x)], 1u);
      asm volatile("s_waitcnt vmcnt(0)" ::: "memory");
    } else {
      XB_SPIN(xb_ld(&bar[XB_XGEN(b.x)]) == gen, bar);
      __builtin_amdgcn_fence(__ATOMIC_ACQUIRE, "agent");
      asm volatile("s_waitcnt vmcnt(0)" ::: "memory");
    }
  }
  __syncthreads();
}

__device__ void run_phase(const Params& p, int ph, int* ctr) {
  if (ph == 0) { phase0(p, ctr); return; }
  if (ph == NPHASES - 1) { phase_final(p, ctr); return; }
  const int idx = ph - 1, lg = idx / NPH_PER, sub = idx % NPH_PER;
  const int l = lg / NGRP, g = lg % NGRP;
  switch (sub) {
    case 0: phase_norm(p, l, g, 0, ctr); break;
    case 1: phase_proj(p, l, ctr); break;
    case 2: phase_postproj(p, l, ctr); break;
    case 3: phase_qkv(p, l, ctr); break;
    case 4: phase_attn(p, l, ctr); break;
    case 5: phase_merge(p, l, ctr); break;
    case 6: phase_resid(p, l, g, 0, ctr); break;
    case 7: phase_norm(p, l, g, 1, ctr); break;
    case 8: phase_gu(p, l, ctr); break;
    case 9: phase_act(p, l, ctr); break;
    default: phase_resid(p, l, g, 1, ctr); break;
  }
}

__global__ void __launch_bounds__(256, 2) mega_kernel(KArgs ka, int ph_lo, int ph_hi, int coop) {
  Params p;
#pragma unroll
  for (int i = 0; i < 27; ++i) p.in[i] = ka.in[i];
  p.out = ka.out;
  char* ws = ka.ws;
  p.ctr = (int*)(ws + O_CTR); p.mod = (float*)(ws + O_MOD); p.rope = (float*)(ws + O_ROPE); p.xc = (float*)(ws + O_XC);
  p.rstdq = (float*)(ws + O_RSQ); p.rstdkv = (float*)(ws + O_RSKV); p.dec = (float*)(ws + O_DEC); p.wt = (u16*)(ws + O_WT);
  p.proj = (u16*)(ws + O_PROJ); p.h = (u16*)(ws + O_H); p.m = (u16*)(ws + O_M); p.q = (u16*)(ws + O_Q);
  p.kf = (u16*)(ws + O_KF); p.vt = (u16*)(ws + O_VT); p.uc = (u16*)(ws + O_UC); p.gq = (u16*)(ws + O_GQ);
  p.ss = (u16*)(ws + O_SS);
  volatile LAS unsigned* st = (volatile LAS unsigned*)(smem + SLOT_OFF + 64);
  if (threadIdx.x == 0) { st[0] = 0u; st[1] = 0u; }
  __syncthreads();
  XcdBarrier xb;
  xb.bar = (unsigned*)(ws + O_BAR); xb.x = 0; xb.st = st;
  if (coop) xb = xcd_barrier_post((unsigned*)(ws + O_BAR), st);
  for (int ph = ph_lo; ph < ph_hi; ++ph) {
#ifdef PROBE_MASK
    const int nrep = (ph > 0 && ph < NPHASES - 1 && ((PROBE_MASK >> ((ph - 1) % NPH_PER)) & 1)) ? 2 : 1;
#else
    const int nrep = 1;
#endif
    for (int rep = 0; rep < nrep; ++rep) {
      if (rep) xcd_barrier(xb);
      run_phase(p, ph, p.ctr + rep * 512 + ph * 8);
    }
    if (coop && ph + 1 < ph_hi) {
      if (ph == ph_lo) cg::this_grid().sync();
      else xcd_barrier(xb);
    }
  }
}

static inline size_t align_up(size_t v) { return (v + 255) & ~(size_t)255; }

extern "C" void kernel_launch(void* const* d_in, const int* in_sizes, int n_in, void* d_out, int out_size,
                              void* d_ws, size_t ws_size, hipStream_t stream) {
  static int grid_blocks = 0;
  if (!grid_blocks) {
    int dev = 0, cus = 0, per_cu = 0;
    hipGetDevice(&dev);
    hipDeviceGetAttribute(&cus, hipDeviceAttributeMultiprocessorCount, dev);
    hipFuncSetAttribute((const void*)mega_kernel, hipFuncAttributeMaxDynamicSharedMemorySize, LDS_BYTES);
    hipOccupancyMaxActiveBlocksPerMultiprocessor(&per_cu, (const void*)mega_kernel, 256, LDS_BYTES);
    if (per_cu < 1) per_cu = 1;
    if (per_cu > 2) per_cu = 2;
    grid_blocks = cus * per_cu;
  }
  KArgs p{};
  for (int i = 0; i < 27; ++i) p.in[i] = (const float*)d_in[i];
  p.out = (float*)d_out;
  p.ws = (char*)d_ws;
  if (ws_size < WS_END) { fprintf(stderr, "workspace too small: %zu < %zu\n", ws_size, (size_t)WS_END); return; }
  hipMemsetAsync((char*)d_ws + O_CTR, 0, 4096 + XCD_BAR_BYTES, stream);
#if SINGLE_LAUNCH
  int lo = 0, hi = NPHASES, coop = 1;
  void* args[] = {&p, &lo, &hi, &coop};
  hipError_t e = hipLaunchCooperativeKernel((const void*)mega_kernel, dim3(grid_blocks), dim3(256), args, LDS_BYTES, stream);
  if (e != hipSuccess) fprintf(stderr, "cooperative launch failed: %s (grid %d)\n", hipGetErrorString(e), grid_blocks);
#else
  for (int ph = 0; ph < NPHASES; ++ph)
    hipLaunchKernelGGL(mega_kernel, dim3(grid_blocks), dim3(256), LDS_BYTES, stream, p, ph, ph + 1, 0);
#endif
}
```

```cpp
#include <hip/hip_runtime.h>
#include <hip/hip_cooperative_groups.h>
#include <cstdio>
#include <cstdint>
namespace cg = cooperative_groups;

typedef unsigned short u16;
typedef __attribute__((ext_vector_type(8))) short bf16x8;
typedef __attribute__((ext_vector_type(4))) float f32x4;
typedef __attribute__((ext_vector_type(16))) float f32x16;

#ifndef SINGLE_LAUNCH
#define SINGLE_LAUNCH 1
#endif

constexpr int DM = 1024, SEQ = 8192, CTXL = 256, NBATCH = 8, INW = 6592, INWP = 6656, DFF = 2816;
constexpr int C_QA = 0, C_KA = 256, C_VA = 512, C_RA = 1024, C_ALR = 1536, C_CQ = 1568, C_CKV = 1824,
              C_KR = 1952, C_SB = 1984, C_SC = 2496, C_SX = 3008, C_GATE = 3520;
constexpr int NKEY = SEQ + CTXL;
constexpr int NCHUNK = NKEY / 64;
constexpr float EPS = 1e-6f;
constexpr int LDS_BYTES = 65536 + 256;
constexpr int SLOT_OFF = 65536;
constexpr int NPH_PER = 11;
constexpr int NBG = 4;
constexpr int NGRP = NBATCH / NBG;
constexpr int RG = NBG * (SEQ + CTXL);
constexpr int NPHASES = 1 + 2 * NGRP * NPH_PER + 1;

constexpr size_t W_IN = 0;
constexpr size_t W_UQ = W_IN + (size_t)INWP * 1024;
constexpr size_t W_UKV = W_UQ + 768 * 256;
constexpr size_t W_BRA = W_UKV + 1024 * 128;
constexpr size_t W_BRB = W_BRA + 1024 * 512;
constexpr size_t W_BRC = W_BRB + 1024 * 512;
constexpr size_t W_O = W_BRC + 1024 * 512;
constexpr size_t W_GU = W_O + 1024 * 1024;
constexpr size_t W_DN = W_GU + (size_t)5632 * 1024;
constexpr size_t W_LAYER = W_DN + (size_t)1024 * 2816;

struct KArgs {
  const float* in[27];
  float* out;
  char* ws;
};
struct Params {
  const float* in[27];
  float* out;
  float* xc;
  u16* wt;
  float* mod;
  float* rope;
  int* ctr;
  float* rstdq;
  float* rstdkv;
  float* dec;
  u16* proj;
  u16* h;
  u16* m;
  u16* q;
  u16* kf;
  u16* vt;
  u16* uc;
  u16* gq;
  u16* ss;
};
constexpr size_t al256(size_t v) { return (v + 255) & ~(size_t)255; }
constexpr size_t XCD_BAR_BYTES = 3456 * 4;
constexpr size_t O_CTR = 0;
constexpr size_t O_BAR = O_CTR + 4096;
constexpr size_t O_MOD = al256(O_BAR + XCD_BAR_BYTES);
constexpr size_t O_ROPE = al256(O_MOD + (size_t)2 * 9 * 6144 * 4);
constexpr size_t O_XC = al256(O_ROPE + 1024 * 2 * 4);
constexpr size_t O_RSQ = al256(O_XC + (size_t)NBATCH * CTXL * DM * 4);
constexpr size_t O_RSKV = al256(O_RSQ + (size_t)RG * 4);
constexpr size_t O_DEC = al256(O_RSKV + (size_t)RG * 4);
constexpr size_t O_WT = al256(O_DEC + (size_t)NBG * NCHUNK * 4 * 2 * 64 * 4);
constexpr size_t O_PROJ = al256(O_WT + 2 * W_LAYER * 2);
constexpr size_t O_H = al256(O_PROJ + (size_t)RG * INW * 2);
constexpr size_t O_M = O_H + (size_t)RG * DM * 2;
constexpr size_t O_Q = al256(O_M + (size_t)RG * DM * 2);
constexpr size_t O_KF = al256(O_Q + (size_t)RG * 768 * 2);
constexpr size_t O_VT = al256(O_KF + (size_t)NBG * 8 * NKEY * 96 * 2);
constexpr size_t O_UC = al256(O_VT + (size_t)NBG * 8 * 64 * NKEY * 2);
constexpr size_t O_GQ = al256(O_UC + (size_t)RG * 512 * 2);
constexpr size_t O_SS = al256(O_GQ + (size_t)RG * 1024 * 2);
constexpr size_t WS_END = al256(O_SS + (size_t)NBG * NCHUNK * 4 * 2 * 8192 * 2);
static_assert(WS_END <= ((size_t)1 << 30), "workspace layout must fit 1 GiB");

extern __shared__ __attribute__((aligned(16))) char smem[];

typedef __bf16 hbf2 __attribute__((ext_vector_type(2)));
typedef float hf2 __attribute__((ext_vector_type(2)));
__device__ __forceinline__ unsigned pack2(float a, float b) {
  hf2 v = {a, b};
  return __builtin_bit_cast(unsigned, __builtin_convertvector(v, hbf2));
}
__device__ __forceinline__ u16 f2bf(float f) { return (u16)(pack2(f, 0.f) & 0xffffu); }
__device__ __forceinline__ float bf2f(u16 h) { return __uint_as_float(((unsigned)h) << 16); }
__device__ __forceinline__ float bflo(unsigned u) { return __uint_as_float(u << 16); }
__device__ __forceinline__ float bfhi(unsigned u) { return __uint_as_float(u & 0xffff0000u); }
__device__ __forceinline__ float silu_f(float x) { return x / (1.f + __expf(-x)); }
__device__ __forceinline__ float sigmoid_f(float x) { return 1.f / (1.f + __expf(-x)); }

__device__ __forceinline__ void rowinfo(int r, int NB, int& bl, int& pos, int& isctx) {
  const int nl = NB * SEQ;
  if (r < nl) { bl = r >> 13; pos = r & (SEQ - 1); isctx = 0; }
  else { const int rc = r - nl; bl = rc >> 8; pos = rc & (CTXL - 1); isctx = 1; }
}
__device__ __forceinline__ int chunk_row(int bl, int cidx, int NB) {
  return cidx < 128 ? bl * SEQ + cidx * 64 : NB * SEQ + bl * CTXL + (cidx - 128) * 64;
}

template <class CntF, class BodyF>
__device__ __forceinline__ void run_q8(int* ctr8, CntF cntf, BodyF body) {
  volatile int* slot = (volatile int*)(smem + SLOT_OFF);
  int q = blockIdx.x & 7, tries = 0, item;
  __syncthreads();
  if (threadIdx.x == 0) {
    int v = atomicAdd(&ctr8[q], 1);
    while (v >= cntf(q) && tries < 8) { q = (q + 1) & 7; ++tries; if (tries < 8) v = atomicAdd(&ctr8[q], 1); }
    slot[0] = (tries < 8) ? v : -1; slot[1] = q; slot[2] = tries;
  }
  __syncthreads();
  item = slot[0]; q = slot[1]; tries = slot[2];
  while (item >= 0) {
    int nxt = 0;
    if (threadIdx.x == 0) nxt = atomicAdd(&ctr8[q], 1);
    body(q, item);
    __syncthreads();
    if (threadIdx.x == 0) {
      int qq = q, t = tries;
      while (nxt >= cntf(qq) && t < 8) { qq = (qq + 1) & 7; ++t; if (t < 8) nxt = atomicAdd(&ctr8[qq], 1); }
      slot[0] = (t < 8) ? nxt : -1; slot[1] = qq; slot[2] = t;
    }
    __syncthreads();
    item = slot[0]; q = slot[1]; tries = slot[2];
  }
}
#define QA_CNT(N) [=](int q_) { return ((N) - q_ + 7) >> 3; }
#define QA_ID(q_, j_) ((j_) * 8 + (q_))

__device__ __forceinline__ int opaque_tid() {
  int t = threadIdx.x;
  asm volatile("" : "+v"(t));
  return t;
}
#define TIDX opaque_tid()
__device__ __forceinline__ float wave_sum(float v) {
  v += __shfl_xor(v, 32); v += __shfl_xor(v, 16); v += __shfl_xor(v, 8);
  v += __shfl_xor(v, 4); v += __shfl_xor(v, 2); v += __shfl_xor(v, 1);
  return v;
}

__device__ __forceinline__ int lds_byte(int r, int c) {
  const int st = (r >> 4) * 2 + (c >> 5), rr = r & 15, cc = c & 31, ob = rr * 64 + cc * 2;
  return st * 1024 + (ob ^ (((ob >> 9) & 1) << 5));
}
__device__ __forceinline__ void stage_rc(int b, int& R, int& C) {
  const int st = b >> 10, sb = b & 1023, swz = sb ^ (((sb >> 9) & 1) << 5);
  R = (st >> 1) * 16 + (swz >> 6); C = (st & 1) * 32 + ((swz & 63) >> 1);
}

__device__ __forceinline__ void glds16(const void* g, void* l) {
  __builtin_amdgcn_global_load_lds((const __attribute__((address_space(1))) unsigned*)g,
                                   (__attribute__((address_space(3))) unsigned*)l, 16, 0, 0);
}

template <int NWI>
__device__ __forceinline__ void gemm_core(const u16* __restrict__ X, int ldx, const u16* __restrict__ W, int ldw,
                                          int K, f32x4 (&acc)[NWI][4]) {
  const int tid = TIDX, lane = tid & 63, wid = tid >> 6;
  const int wr = wid >> 1, wc = wid & 1, fr = lane & 15, fq = lane >> 4;
#pragma unroll
  for (int a = 0; a < NWI; ++a)
#pragma unroll
    for (int b = 0; b < 4; ++b) acc[a][b] = f32x4{0.f, 0.f, 0.f, 0.f};
  const int srow = tid >> 3, schunk = (tid & 7) ^ ((tid >> 4) & 7);
  const u16* xg = X + (size_t)srow * ldx + schunk * 8;
  const u16* wg = W + (size_t)srow * ldw + schunk * 8;
  const int xs = 32 * ldx, ws_ = 32 * ldw;
  const int g = fr >> 1;
  const int lo0 = fr * 128 + ((fq ^ g) << 4), lo1 = fr * 128 + (((fq ^ g) ^ 4) << 4);
  const char* xb = smem + wr * 8192;
  const char* wb = smem + 16384 + wc * (NWI * 2048);
  char* sdst = smem + tid * 16;
  const int nt = K >> 6;
  __syncthreads();
#pragma unroll
  for (int i = 0; i < 4; ++i) {
    glds16(xg + i * xs, sdst + i * 4096);
    if (i < NWI) glds16(wg + i * ws_, sdst + 16384 + i * 4096);
  }
  for (int kt = 0; kt < nt; ++kt) {
    asm volatile("s_waitcnt vmcnt(0)" ::: "memory");
    __syncthreads();
    const int cb = (kt & 1) * 32768;
    if (kt + 1 < nt) {
      const int nb = 32768 - cb;
      const int ko = (kt + 1) * 64;
#pragma unroll
      for (int i = 0; i < 4; ++i) {
        glds16(xg + i * xs + ko, sdst + nb + i * 4096);
        if (i < NWI) glds16(wg + i * ws_ + ko, sdst + nb + 16384 + i * 4096);
      }
    }
    bf16x8 wf[2][NWI], xf[2][4];
#pragma unroll
    for (int i = 0; i < NWI; ++i) {
      wf[0][i] = *(const bf16x8*)(wb + cb + i * 2048 + lo0);
      wf[1][i] = *(const bf16x8*)(wb + cb + i * 2048 + lo1);
    }
#pragma unroll
    for (int i = 0; i < 4; ++i) {
      xf[0][i] = *(const bf16x8*)(xb + cb + i * 2048 + lo0);
      xf[1][i] = *(const bf16x8*)(xb + cb + i * 2048 + lo1);
    }
    __builtin_amdgcn_sched_barrier(0);
#pragma unroll
    for (int k = 0; k < 2; ++k)
#pragma unroll
      for (int wi = 0; wi < NWI; ++wi)
#pragma unroll
        for (int xi = 0; xi < 4; ++xi)
          acc[wi][xi] = __builtin_amdgcn_mfma_f32_16x16x32_bf16(wf[k][wi], xf[k][xi], acc[wi][xi], 0, 0, 0);
    __builtin_amdgcn_sched_barrier(0);
  }
}

#define EPI_VARS const int tid_ = TIDX, lane_ = tid_ & 63, wid_ = tid_ >> 6; \
  const int wr_ = wid_ >> 1, wc_ = wid_ & 1, fr_ = lane_ & 15, fq_ = lane_ >> 4; (void)fq_; (void)fr_; (void)wr_; (void)wc_;
#define EPI_TR(xi) (wr_ * 64 + (xi) * 16 + fr_)
#define EPI_NN(wi) (wc_ * 64 + (wi) * 16 + fq_ * 4)

template <int NWI>
__device__ __forceinline__ void store_tile_bf16(const uint2 (&o)[NWI][4], u16* dst_wave, size_t ld) {
  constexpr int RB = NWI * 32, CPR = RB / 16;
  const int tid = TIDX, lane = tid & 63, wid = tid >> 6, fr = lane & 15, fq = lane >> 4;
  char* lb = smem + wid * 8192;
#pragma unroll
  for (int wi = 0; wi < NWI; ++wi)
#pragma unroll
    for (int xi = 0; xi < 4; ++xi) {
      const int r = xi * 16 + fr, c = wi * 2 + (fq >> 1);
      *(uint2*)(lb + r * RB + ((c ^ (r & (CPR - 1))) << 4) + (fq & 1) * 8) = o[wi][xi];
    }
#pragma unroll
  for (int it = 0; it < CPR; ++it) {
    const int idx = it * 64 + lane, row = idx / CPR, c = idx % CPR;
    const uint4 v = *(const uint4*)(lb + row * RB + ((c ^ (row & (CPR - 1))) << 4));
    *(uint4*)(dst_wave + (size_t)row * ld + c * 8) = v;
  }
}

__device__ __forceinline__ void tile_order(int t, int MT, int NT, int& mt, int& nt) {
  constexpr int GM = 8;
  const int band = t / (GM * NT), rem = t - band * GM * NT;
  const int m0 = band * GM;
  const int gsz = min(GM, MT - m0);
  nt = rem / gsz; mt = m0 + rem - nt * gsz;
}

__device__ __forceinline__ int mlo(int q, int MT) { return (q * MT) >> 3; }
#define GEMM_CNT(MT, NT) [=](int q_) { return (mlo(q_ + 1, MT) - mlo(q_, MT)) * (NT); }

__device__ __forceinline__ float* xrow_ptr(const Params& p, int g, int r) {
  int bl, pos, isctx; rowinfo(r, NBG, bl, pos, isctx);
  const int b = g * NBG + bl;
  return isctx ? p.xc + ((size_t)b * CTXL + pos) * DM : p.out + ((size_t)b * SEQ + pos) * DM;
}
__device__ __forceinline__ const float* xsrc_row_ptr(const Params& p, int g, int r, int from_input) {
  int bl, pos, isctx; rowinfo(r, NBG, bl, pos, isctx);
  const int b = g * NBG + bl;
  if (from_input) return isctx ? p.in[2] + ((size_t)b * CTXL + pos) * DM : p.in[0] + ((size_t)b * SEQ + pos) * DM;
  return isctx ? p.xc + ((size_t)b * CTXL + pos) * DM : p.out + ((size_t)b * SEQ + pos) * DM;
}
__device__ __forceinline__ int mod_index(const Params& p, int g, int r) {
  int bl, pos, isctx; rowinfo(r, NBG, bl, pos, isctx);
  return isctx ? 8 : g * NBG + bl;
}

__device__ void conv_tile(const float* __restrict__ src, int K, int N, u16* __restrict__ dst,
                          const float* __restrict__ scale, int ktile, int ntile) {
  float* tile = (float*)smem;
  const int tid = TIDX;
  const int k0 = ktile * 64, n0 = ntile * 64;
  const bool valid = n0 < N;
  if (valid) {
    const int kk = tid >> 4, n4 = (tid & 15) * 4;
#pragma unroll
    for (int i = 0; i < 4; ++i) {
      const int k = kk + 16 * i;
      const float4 v = *(const float4*)(src + (size_t)(k0 + k) * N + n0 + n4);
      const float s = scale ? scale[k0 + k] : 1.f;
      tile[k * 65 + n4 + 0] = v.x * s; tile[k * 65 + n4 + 1] = v.y * s;
      tile[k * 65 + n4 + 2] = v.z * s; tile[k * 65 + n4 + 3] = v.w * s;
    }
  }
  __syncthreads();
  const int nn = tid >> 3, k8 = (tid & 7) * 8;
#pragma unroll
  for (int i = 0; i < 2; ++i) {
    const int n = nn + 32 * i;
    uint4 o = make_uint4(0, 0, 0, 0);
    if (valid) {
      o.x = pack2(tile[(k8 + 0) * 65 + n], tile[(k8 + 1) * 65 + n]);
      o.y = pack2(tile[(k8 + 2) * 65 + n], tile[(k8 + 3) * 65 + n]);
      o.z = pack2(tile[(k8 + 4) * 65 + n], tile[(k8 + 5) * 65 + n]);
      o.w = pack2(tile[(k8 + 6) * 65 + n], tile[(k8 + 7) * 65 + n]);
    }
    *(uint4*)(dst + (size_t)(n0 + n) * K + k0 + k8) = o;
  }
}

__device__ void sincos_d(double a, double& s, double& c) {
  const double k = rint(a * 0.6366197723675814);
  double r = fma(-k, 1.5707963267948966, a);
  r = fma(-k, 6.123233995736766e-17, r);
  const int q = ((int)k) & 3;
  const double r2 = r * r;
  const double sp = r * (1.0 + r2 * (-1.0 / 6 + r2 * (1.0 / 120 + r2 * (-1.0 / 5040 + r2 * (1.0 / 362880 + r2 * (-1.0 / 39916800 + r2 * (1.0 / 6227020800.0)))))));
  const double cp = 1.0 + r2 * (-0.5 + r2 * (1.0 / 24 + r2 * (-1.0 / 720 + r2 * (1.0 / 40320 + r2 * (-1.0 / 3628800 + r2 * (1.0 / 479001600.0 + r2 * (-1.0 / 87178291200.0)))))));
  s = (q == 0) ? sp : (q == 1) ? cp : (q == 2) ? -sp : -cp;
  c = (q == 0) ? cp : (q == 1) ? -sp : (q == 2) ? -cp : sp;
}

constexpr int CV_WIN = 0, CV_UQ = 1664, CV_UKV = 1712, CV_BRA = 1744, CV_BRB = 1872, CV_BRC = 2000,
              CV_WO = 2128, CV_GATE = 2384, CV_UP = 3088, CV_DN = 3792, CV_LAYER = 4496;
constexpr int P0_CONV = 2 * CV_LAYER, P0_ADA = 2 * 192, P0_TOTAL = P0_CONV + P0_ADA + 1;

__device__ void phase0(const Params& p, int* ctr) {
  run_q8(ctr, QA_CNT(P0_TOTAL), [&](int q_, int j_) {
    const int it = QA_ID(q_, j_);
    const int tid = TIDX;
    if (it < P0_CONV) {
      const int l = it / CV_LAYER, j = it % CV_LAYER;
      u16* wl = p.wt + (size_t)l * W_LAYER;
      if (j < CV_UQ)       { const int jj = j - CV_WIN;  conv_tile(p.in[7] + (size_t)l * 1024 * INW, 1024, INW, wl + W_IN, nullptr, jj / 104, jj % 104); }
      else if (j < CV_UKV) { const int jj = j - CV_UQ;   conv_tile(p.in[12] + (size_t)l * 256 * 768, 256, 768, wl + W_UQ, p.in[11] + l * 256, jj / 12, jj % 12); }
      else if (j < CV_BRA) { const int jj = j - CV_UKV;  conv_tile(p.in[14] + (size_t)l * 128 * 1024, 128, 1024, wl + W_UKV, p.in[13] + l * 128, jj / 16, jj % 16); }
      else if (j < CV_BRB) { const int jj = j - CV_BRA;  conv_tile(p.in[16] + (size_t)l * 512 * 1024, 512, 1024, wl + W_BRA, nullptr, jj / 16, jj % 16); }
      else if (j < CV_BRC) { const int jj = j - CV_BRB;  conv_tile(p.in[17] + (size_t)l * 512 * 1024, 512, 1024, wl + W_BRB, nullptr, jj / 16, jj % 16); }
      else if (j < CV_WO)  { const int jj = j - CV_BRC;  conv_tile(p.in[18] + (size_t)l * 512 * 1024, 512, 1024, wl + W_BRC, nullptr, jj / 16, jj % 16); }
      else if (j < CV_GATE){ const int jj = j - CV_WO;   conv_tile(p.in[19] + (size_t)l * 1024 * 1024, 1024, 1024, wl + W_O, nullptr, jj / 16, jj % 16); }
      else if (j < CV_UP)  { const int jj = j - CV_GATE; conv_tile(p.in[21] + (size_t)l * 1024 * DFF, 1024, DFF, wl + W_GU, nullptr, jj / 44, jj % 44); }
      else if (j < CV_DN)  { const int jj = j - CV_UP;   conv_tile(p.in[22] + (size_t)l * 1024 * DFF, 1024, DFF, wl + W_GU + (size_t)DFF * 1024, nullptr, jj / 44, jj % 44); }
      else                 { const int jj = j - CV_DN;   conv_tile(p.in[25] + (size_t)l * DFF * 1024, DFF, 1024, wl + W_DN, nullptr, jj / 16, jj % 16); }
    } else if (it < P0_CONV + P0_ADA) {
      const int a = it - P0_CONV, l = a / 192, cg_ = a % 192;
      float* sc = (float*)smem;
      float* red = sc + 9 * 1024;
      for (int e = tid; e < 9 * 1024; e += 256) {
        const int v = e >> 10, k = e & 1023;
        const float cv = (v < 8) ? p.in[1][v * 1024 + k] : p.in[3][k];
        sc[e] = cv / (1.f + expf(-cv));
      }
      __syncthreads();
      const int kg = tid >> 5, cn = tid & 31;
      const float* wa = p.in[4] + (size_t)l * 1024 * 6144 + cg_ * 32 + cn;
      float a0 = 0, a1 = 0, a2 = 0, a3 = 0, a4 = 0, a5 = 0, a6 = 0, a7 = 0, a8 = 0;
#pragma unroll 8
      for (int i = 0; i < 128; ++i) {
        const int k = kg + 8 * i;
        const float w = wa[(size_t)k * 6144];
        a0 += sc[k] * w; a1 += sc[1024 + k] * w; a2 += sc[2048 + k] * w; a3 += sc[3072 + k] * w;
        a4 += sc[4096 + k] * w; a5 += sc[5120 + k] * w; a6 += sc[6144 + k] * w; a7 += sc[7168 + k] * w;
        a8 += sc[8192 + k] * w;
      }
      float* rr = red + kg * 288 + cn;
      rr[0] = a0; rr[32] = a1; rr[64] = a2; rr[96] = a3; rr[128] = a4; rr[160] = a5; rr[192] = a6; rr[224] = a7; rr[256] = a8;
      __syncthreads();
      for (int e = tid; e < 288; e += 256) {
        float s = 0.f;
#pragma unroll
        for (int g8 = 0; g8 < 8; ++g8) s += red[g8 * 288 + e];
        const int v = e >> 5, n = cg_ * 32 + (e & 31);
        p.mod[((size_t)l * 9 + v) * 6144 + n] = s + p.in[5][l * 6144 + n];
      }
    } else {
      for (int e = tid; e < 1024; e += 256) {
        const int pos = e >> 3, f = e & 7;
        const float inv = (f == 0) ? 1.0f : (f == 1) ? 0.31622776601683794f : (f == 2) ? 0.1f : (f == 3) ? 0.031622776601683794f
                        : (f == 4) ? 0.01f : (f == 5) ? 0.0031622776601683794f : (f == 6) ? 0.001f : 0.00031622776601683794f;
        const float ang = (float)pos * inv;
        double s, c; sincos_d((double)ang, s, c);
        p.rope[e * 2] = (float)c; p.rope[e * 2 + 1] = (float)s;
      }
    }
  });
}

__device__ void phase_norm(const Params& p, int l, int g, int which, int* ctr) {
  const int nitems = (which == 1 && l == 1) ? NBG * SEQ / 16 : RG / 16;
  const float* gam = (which == 0 ? p.in[6] : p.in[20]) + l * DM;
  const int shoff = which == 0 ? 0 : 3072, scoff = which == 0 ? 1024 : 4096;
  const int from_input = (which == 0 && l == 0);
  for (int it = blockIdx.x; it < nitems; it += gridDim.x) {
    const int lane = TIDX & 63, wid = TIDX >> 6;
    const int r0 = it * 16 + wid * 4;
    const float* xr = xsrc_row_ptr(p, g, r0, from_input);
    const float* mrow = p.mod + ((size_t)l * 9 + mod_index(p, g, r0)) * 6144;
    float4 v[4][4], gg[4], sh[4], sc[4];
#pragma unroll
    for (int rr = 0; rr < 4; ++rr)
#pragma unroll
      for (int i = 0; i < 4; ++i) v[rr][i] = *(const float4*)(xr + (size_t)rr * DM + lane * 4 + i * 256);
#pragma unroll
    for (int i = 0; i < 4; ++i) {
      const int c = lane * 4 + i * 256;
      gg[i] = *(const float4*)(gam + c); sh[i] = *(const float4*)(mrow + shoff + c); sc[i] = *(const float4*)(mrow + scoff + c);
    }
#pragma unroll
    for (int rr = 0; rr < 4; ++rr) {
      float ss = 0.f;
#pragma unroll
      for (int i = 0; i < 4; ++i)
        ss += v[rr][i].x * v[rr][i].x + v[rr][i].y * v[rr][i].y + v[rr][i].z * v[rr][i].z + v[rr][i].w * v[rr][i].w;
      ss = wave_sum(ss);
      const float rstd = rsqrtf(ss * (1.f / 1024.f) + EPS);
#pragma unroll
      for (int i = 0; i < 4; ++i) {
        const int c = lane * 4 + i * 256;
        uint2 o;
        o.x = pack2(v[rr][i].x * rstd * gg[i].x * (1.f + sc[i].x) + sh[i].x, v[rr][i].y * rstd * gg[i].y * (1.f + sc[i].y) + sh[i].y);
        o.y = pack2(v[rr][i].z * rstd * gg[i].z * (1.f + sc[i].z) + sh[i].z, v[rr][i].w * rstd * gg[i].w * (1.f + sc[i].w) + sh[i].w);
        *(uint2*)(p.h + (size_t)(r0 + rr) * DM + c) = o;
      }
    }
  }
}

__device__ void phase_proj(const Params& p, int l, int* ctr) {
  const int MT = RG / 128, NT = INWP / 128;
  const u16* W = p.wt + (size_t)l * W_LAYER + W_IN;
  run_q8(ctr, GEMM_CNT(MT, NT), [&](int q_, int j_) {
    int mt, nt; tile_order(j_, mlo(q_ + 1, MT) - mlo(q_, MT), NT, mt, nt); mt += mlo(q_, MT);
    f32x4 acc[4][4];
    gemm_core<4>(p.h + (size_t)mt * 128 * DM, DM, W + (size_t)nt * 128 * DM, DM, DM, acc);
    EPI_VARS
    uint2 o[4][4];
#pragma unroll
    for (int wi = 0; wi < 4; ++wi)
#pragma unroll
      for (int xi = 0; xi < 4; ++xi) {
        o[wi][xi].x = pack2(acc[wi][xi][0], acc[wi][xi][1]); o[wi][xi].y = pack2(acc[wi][xi][2], acc[wi][xi][3]);
      }
    if (nt * 128 + wc_ * 64 < INW)
      store_tile_bf16<4>(o, p.proj + (size_t)(mt * 128 + wr_ * 64) * INW + nt * 128 + wc_ * 64, INW);
  });
}

__device__ void postproj_rows(const Params& p, int l, int it) {
  const int lane = TIDX & 63, wid = TIDX >> 6;
  const float* scw = p.in[15] + (size_t)l * 3 * 512;
  for (int rr = 0; rr < 4; ++rr) {
    const int r = it * 16 + wid * 4 + rr;
    int bl, pos, isctx; rowinfo(r, NBG, bl, pos, isctx);
    const u16* pr = p.proj + (size_t)r * INW;
    const int Lr = isctx ? CTXL : SEQ;
    const int c0 = lane * 8;
    const uint2 u_cq = *(const uint2*)(pr + C_CQ + lane * 4);
    const unsigned u_ckv = *(const unsigned*)(pr + C_CKV + lane * 2);
    const u16 u_kr = pr[C_KR + (lane & 31)];
    const uint4 sb = *(const uint4*)(pr + C_SB + c0);
    const uint4 sc1 = *(const uint4*)(pr + C_SC + c0);
    const uint4 sx1 = *(const uint4*)(pr + C_SX + c0);
    uint4 sc0 = make_uint4(0, 0, 0, 0), sx0 = sc0, sc2 = sc0, sx2 = sc0;
    if (pos > 0) { sc0 = *(const uint4*)(pr - INW + C_SC + c0); sx0 = *(const uint4*)(pr - INW + C_SX + c0); }
    if (pos < Lr - 1) { sc2 = *(const uint4*)(pr + INW + C_SC + c0); sx2 = *(const uint4*)(pr + INW + C_SX + c0); }
    {
      const uint2 u = u_cq;
      const float a = bflo(u.x), b = bfhi(u.x), c = bflo(u.y), d = bfhi(u.y);
      float ss = wave_sum(a * a + b * b + c * c + d * d);
      if (lane == 0) p.rstdq[r] = rsqrtf(ss * (1.f / 256.f) + EPS);
    }
    {
      const unsigned u = u_ckv;
      const float a = bflo(u), b = bfhi(u);
      float ss = wave_sum(a * a + b * b);
      if (lane == 0) p.rstdkv[r] = rsqrtf(ss * (1.f / 128.f) + EPS);
    }
    {
      const int idx = lane & 31;
      const float val = bf2f(u_kr);
      const float partner = __shfl_xor(val, 8);
      float o = val;
      if (!isctx) {
        const int axis = idx >> 4, half = (idx >> 3) & 1, f = idx & 7;
        const int pa = axis ? (pos & 63) : (pos >> 6);
        const float c = p.rope[(pa * 8 + f) * 2], s = p.rope[(pa * 8 + f) * 2 + 1];
        o = half ? (val * c + partner * s) : (val * c - partner * s);
      }
      const int j = isctx ? SEQ + pos : pos;
      const u16 ob = f2bf(o);
      if (lane < 32) {
#pragma unroll
        for (int hd = 0; hd < 8; ++hd)
          p.kf[((size_t)(bl * 8 + hd) * NKEY + j) * 96 + 64 + idx] = ob;
      }
    }
    {
      const float4 w0a = *(const float4*)(scw + c0), w0b = *(const float4*)(scw + c0 + 4);
      const float4 w1a = *(const float4*)(scw + 512 + c0), w1b = *(const float4*)(scw + 512 + c0 + 4);
      const float4 w2a = *(const float4*)(scw + 1024 + c0), w2b = *(const float4*)(scw + 1024 + c0 + 4);
      uint4 o;
#define UC2(SBW, A0, X0, A1, X1, A2, X2, W0L, W0H, W1L, W1H, W2L, W2H) \
      pack2(bflo(SBW) * (W0L * bflo(A0) * bflo(X0) + W1L * bflo(A1) * bflo(X1) + W2L * bflo(A2) * bflo(X2)), \
            bfhi(SBW) * (W0H * bfhi(A0) * bfhi(X0) + W1H * bfhi(A1) * bfhi(X1) + W2H * bfhi(A2) * bfhi(X2)))
      o.x = UC2(sb.x, sc0.x, sx0.x, sc1.x, sx1.x, sc2.x, sx2.x, w0a.x, w0a.y, w1a.x, w1a.y, w2a.x, w2a.y);
      o.y = UC2(sb.y, sc0.y, sx0.y, sc1.y, sx1.y, sc2.y, sx2.y, w0a.z, w0a.w, w1a.z, w1a.w, w2a.z, w2a.w);
      o.z = UC2(sb.z, sc0.z, sx0.z, sc1.z, sx1.z, sc2.z, sx2.z, w0b.x, w0b.y, w1b.x, w1b.y, w2b.x, w2b.y);
      o.w = UC2(sb.w, sc0.w, sx0.w, sc1.w, sx1.w, sc2.w, sx2.w, w0b.z, w0b.w, w1b.z, w1b.w, w2b.z, w2b.w);
#undef UC2
      *(uint4*)(p.uc + (size_t)r * 512 + c0) = o;
    }
  }
}

__device__ __forceinline__ float logsig16(float z) {
  return (fminf(z, 0.f) - log1pf(__expf(-fabsf(z)))) * (1.f / 16.f);
}

__device__ void gla_prep(const Params& p, int l, int it) {
  const int tid = TIDX, lane = tid & 63, wid = tid >> 6;
  const int bl = it / (NCHUNK * 4), rem = it % (NCHUNK * 4), cidx = rem >> 2, h = rem & 3;
  const int r0 = chunk_row(bl, cidx, NBG);
  float* lr = (float*)smem;
  float* tot = (float*)(smem + 8192);
  u16* vT = (u16*)(smem + 10752);
  u16* kTf = (u16*)(smem + 29184);
  u16* kTb = (u16*)(smem + 38400);
  {
    const int t = tid >> 2, c8 = (tid & 3) * 8;
    const uint4 u = *(const uint4*)(p.proj + (size_t)(r0 + t) * INW + C_ALR + c8);
    float* d = lr + t * 32 + c8;
    d[0] = bflo(u.x); d[1] = bfhi(u.x); d[2] = bflo(u.y); d[3] = bfhi(u.y);
    d[4] = bflo(u.z); d[5] = bfhi(u.z); d[6] = bflo(u.w); d[7] = bfhi(u.w);
    const int dvc = (tid & 3) * 32;
    const u16* vp = p.proj + (size_t)(r0 + t) * INW + C_VA + h * 128 + dvc;
#pragma unroll
    for (int i = 0; i < 4; ++i) {
      const uint4 vv = *(const uint4*)(vp + i * 8);
      u16* dst = vT + (size_t)(dvc + i * 8) * 72 + t;
      dst[0] = (u16)(vv.x & 0xffff); dst[72] = (u16)(vv.x >> 16);
      dst[144] = (u16)(vv.y & 0xffff); dst[216] = (u16)(vv.y >> 16);
      dst[288] = (u16)(vv.z & 0xffff); dst[360] = (u16)(vv.z >> 16);
      dst[432] = (u16)(vv.w & 0xffff); dst[504] = (u16)(vv.w >> 16);
    }
  }
  __syncthreads();
  const int dk = lane, tg = wid;
  const float* w2f = p.in[8] + ((size_t)(l * 2 + 0) * 16) * 256 + h * 64 + dk;
  const float* w2b = p.in[8] + ((size_t)(l * 2 + 1) * 16) * 256 + h * 64 + dk;
  float wf[16], wb[16];
#pragma unroll
  for (int r = 0; r < 16; ++r) { wf[r] = w2f[r * 256]; wb[r] = w2b[r * 256]; }
  const float biasf = p.in[9][(l * 2 + 0) * 256 + h * 64 + dk];
  const float biasb = p.in[9][(l * 2 + 1) * 256 + h * 64 + dk];
  float pf[16], sbk[16];
#pragma unroll
  for (int i = 0; i < 16; ++i) {
    const float* lrow = lr + (tg * 16 + i) * 32;
    float zf = biasf, zb = biasb;
#pragma unroll
    for (int r = 0; r < 16; ++r) { zf += lrow[r] * wf[r]; zb += lrow[16 + r] * wb[r]; }
    pf[i] = logsig16(zf); sbk[i] = logsig16(zb);
  }
#pragma unroll
  for (int i = 1; i < 16; ++i) pf[i] += pf[i - 1];
#pragma unroll
  for (int i = 14; i >= 0; --i) sbk[i] += sbk[i + 1];
  tot[tg * 64 + dk] = pf[15];
  tot[256 + tg * 64 + dk] = sbk[0];
  __syncthreads();
  float offf = 0.f, offb = 0.f, bfl = 0.f, bb0 = 0.f;
#pragma unroll
  for (int g4 = 0; g4 < 4; ++g4) {
    const float a = tot[g4 * 64 + dk], b = tot[256 + g4 * 64 + dk];
    bfl += a; bb0 += b;
    if (g4 < tg) offf += a;
    if (g4 > tg) offb += b;
  }
  u16* gqf = p.gq;
  u16* gkf = p.gq + (size_t)RG * 256;
  u16* gqb = p.gq + (size_t)RG * 512;
  u16* gkb = p.gq + (size_t)RG * 768;
  unsigned kfp[8], kbp[8];
#pragma unroll
  for (int i = 0; i < 16; ++i) {
    const int t = tg * 16 + i;
    const float bfv = offf + pf[i], bbv = offb + sbk[i];
    const float qv = bf2f(p.proj[(size_t)(r0 + t) * INW + C_QA + h * 64 + dk]);
    const float kv = bf2f(p.proj[(size_t)(r0 + t) * INW + C_KA + h * 64 + dk]);
    const size_t go = (size_t)(r0 + t) * 256 + h * 64 + dk;
    gqf[go] = f2bf(qv * __expf(bfv) * 0.125f);
    gkf[go] = f2bf(kv * __expf(-bfv));
    gqb[go] = f2bf(qv * __expf(bbv) * 0.125f);
    gkb[go] = f2bf(kv * __expf(-bbv));
    const u16 ksf = f2bf(kv * __expf(bfl - bfv));
    const u16 ksb = f2bf(kv * __expf(bb0 - bbv));
    if (i & 1) { kfp[i >> 1] |= ((unsigned)ksf) << 16; kbp[i >> 1] |= ((unsigned)ksb) << 16; }
    else { kfp[i >> 1] = ksf; kbp[i >> 1] = ksb; }
  }
  *(uint4*)(kTf + dk * 72 + tg * 16) = make_uint4(kfp[0], kfp[1], kfp[2], kfp[3]);
  *(uint4*)(kTf + dk * 72 + tg * 16 + 8) = make_uint4(kfp[4], kfp[5], kfp[6], kfp[7]);
  *(uint4*)(kTb + dk * 72 + tg * 16) = make_uint4(kbp[0], kbp[1], kbp[2], kbp[3]);
  *(uint4*)(kTb + dk * 72 + tg * 16 + 8) = make_uint4(kbp[4], kbp[5], kbp[6], kbp[7]);
  const size_t cb = ((size_t)(bl * NCHUNK + cidx) * 4 + h) * 2;
  if (tg == 0) {
    p.dec[(cb + 0) * 64 + dk] = __expf(bfl);
    p.dec[(cb + 1) * 64 + dk] = __expf(bb0);
  }
  __syncthreads();
  const int l31 = lane & 31, hh = lane >> 5;
  float* U = (float*)p.h;
#pragma unroll
  for (int dir = 0; dir < 2; ++dir) {
    const u16* kT = dir ? kTb : kTf;
#pragma unroll
    for (int dkt = 0; dkt < 2; ++dkt) {
      f32x16 acc;
#pragma unroll
      for (int e = 0; e < 16; ++e) acc[e] = 0.f;
#pragma unroll
      for (int s = 0; s < 4; ++s) {
        const bf16x8 a = *(const bf16x8*)(vT + (32 * wid + l31) * 72 + 16 * s + 8 * hh);
        const bf16x8 b = *(const bf16x8*)(kT + (32 * dkt + l31) * 72 + 16 * s + 8 * hh);
        acc = __builtin_amdgcn_mfma_f32_32x32x16_bf16(a, b, acc, 0, 0, 0);
      }
      float* up = U + (cb + dir) * 8192;
#pragma unroll
      for (int e = 0; e < 16; ++e) {
        const int dv = 32 * wid + (e & 3) + 8 * (e >> 2) + 4 * hh;
        up[dv * 64 + 32 * dkt + l31] = acc[e];
      }
    }
  }
}

__device__ void phase_postproj(const Params& p, int l, int* ctr) {
  const int n_prep = NBG * NCHUNK * 4, n_rows = RG / 16;
  run_q8(ctr, QA_CNT(n_prep + n_rows), [&](int q_, int j_) {
    const int it = QA_ID(q_, j_);
    if (it < n_prep) gla_prep(p, l, it);
    else postproj_rows(p, l, it - n_prep);
  });
}

__device__ void gla_scan(const Params& p, int it) {
  const int tid = TIDX;
  const int sl = it & 7, dir = (it >> 3) & 1, h = (it >> 4) & 3, bl = it >> 6;
  const int e0 = sl * 1024 + tid * 4;
  const int dk = e0 & 63;
  const float* U = (const float*)p.h;
  f32x4 S = {0.f, 0.f, 0.f, 0.f};
  for (int s0 = 0; s0 < NCHUNK; s0 += 12) {
    f32x4 u4[12], d4[12];
#pragma unroll
    for (int j = 0; j < 12; ++j) {
      const int step = s0 + j;
      const int cidx = dir ? (NCHUNK - 1 - step) : (step < 4 ? 128 + step : step - 4);
      const size_t base = ((size_t)(bl * NCHUNK + cidx) * 4 + h) * 2 + dir;
      u4[j] = *(const f32x4*)(U + base * 8192 + e0);
      d4[j] = *(const f32x4*)(p.dec + base * 64 + dk);
    }
#pragma unroll
    for (int j = 0; j < 12; ++j) {
      const int step = s0 + j;
      const int cidx = dir ? (NCHUNK - 1 - step) : (step < 4 ? 128 + step : step - 4);
      const size_t base = ((size_t)(bl * NCHUNK + cidx) * 4 + h) * 2 + dir;
      uint2 o; o.x = pack2(S[0], S[1]); o.y = pack2(S[2], S[3]);
      *(uint2*)(p.ss + base * 8192 + e0) = o;
      S = d4[j] * S + u4[j];
    }
  }
}

__device__ void q_tile(const Params& p, int l, int t) {
  const int MT = RG / 128;
  const int nt = t / MT, mt = t % MT;
  f32x4 acc[4][4];
  gemm_core<4>(p.proj + (size_t)mt * 128 * INW + C_CQ, INW, p.wt + (size_t)l * W_LAYER + W_UQ + (size_t)nt * 128 * 256, 256, 256, acc);
  EPI_VARS
  const float QS = 0.10206207261596577f * 1.4426950408889634f;
  int bl, pos0, isctx; rowinfo(mt * 128, NBG, bl, pos0, isctx);
  float rsq[4];
  uint2 qo[4][4];
#pragma unroll
  for (int xi = 0; xi < 4; ++xi) rsq[xi] = p.rstdq[mt * 128 + EPI_TR(xi)] * QS;
#pragma unroll
  for (int xi = 0; xi < 4; ++xi) {
    const int tr = EPI_TR(xi), r = mt * 128 + tr, pos = pos0 + tr;
    const float rs = rsq[xi];
#pragma unroll
    for (int wi = 0; wi < 4; ++wi) {
      const int n16 = (nt * 128 + wc_ * 64 + wi * 16) >> 4;
      const int m6 = n16 % 6;
      float v0 = acc[wi][xi][0] * rs, v1 = acc[wi][xi][1] * rs, v2 = acc[wi][xi][2] * rs, v3 = acc[wi][xi][3] * rs;
      if (m6 >= 4 && !isctx) {
        const float p0 = __shfl_xor(v0, 32), p1 = __shfl_xor(v1, 32), p2 = __shfl_xor(v2, 32), p3 = __shfl_xor(v3, 32);
        const int pa = (m6 == 5) ? (pos & 63) : (pos >> 6);
        const int f0 = (fq_ & 1) * 4;
        const float* rp = p.rope + (pa * 8 + f0) * 2;
        const float4 cs01 = *(const float4*)rp, cs23 = *(const float4*)(rp + 4);
        const float sg = (fq_ >= 2) ? 1.f : -1.f;
        v0 = v0 * cs01.x + sg * p0 * cs01.y;
        v1 = v1 * cs01.z + sg * p1 * cs01.w;
        v2 = v2 * cs23.x + sg * p2 * cs23.y;
        v3 = v3 * cs23.z + sg * p3 * cs23.w;
      }
      qo[wi][xi].x = pack2(v0, v1); qo[wi][xi].y = pack2(v2, v3);
    }
  }
  store_tile_bf16<4>(qo, p.q + (size_t)(mt * 128 + wr_ * 64) * 768 + nt * 128 + wc_ * 64, 768);
}

__device__ void kv_tile(const Params& p, int l, int t) {
  const int MT = RG / 128;
  const int nt = t / MT, mt = t % MT;
  f32x4 acc[4][4];
  gemm_core<4>(p.proj + (size_t)mt * 128 * INW + C_CKV, INW, p.wt + (size_t)l * W_LAYER + W_UKV + (size_t)nt * 128 * 128, 128, 128, acc);
  EPI_VARS
  int bl, pos0, isctx; rowinfo(mt * 128, NBG, bl, pos0, isctx);
  const int j0 = isctx ? SEQ + pos0 : pos0;
  float rskv[4];
#pragma unroll
  for (int xi = 0; xi < 4; ++xi) rskv[xi] = p.rstdkv[mt * 128 + EPI_TR(xi)];
#pragma unroll
  for (int xi = 0; xi < 4; ++xi) {
    const int tr = EPI_TR(xi), r = mt * 128 + tr, j = j0 + tr;
    const float rs = rskv[xi];
#pragma unroll
    for (int wi = 0; wi < 4; ++wi) {
      const int wn = EPI_NN(wi);
      const float v0 = acc[wi][xi][0] * rs, v1 = acc[wi][xi][1] * rs, v2 = acc[wi][xi][2] * rs, v3 = acc[wi][xi][3] * rs;
      if (wc_ == 0) {
        uint2 o; o.x = pack2(v0, v1); o.y = pack2(v2, v3);
        *(uint2*)(p.kf + ((size_t)(bl * 8 + nt) * NKEY + j) * 96 + wn) = o;
      } else {
        u16* vp = p.vt + ((size_t)(bl * 8 + nt) * 64 + (wn - 64)) * NKEY + j;
        vp[0] = f2bf(v0); vp[NKEY] = f2bf(v1); vp[2 * NKEY] = f2bf(v2); vp[3 * NKEY] = f2bf(v3);
      }
    }
  }
}

__device__ void phase_qkv(const Params& p, int l, int* ctr) {
  const int MT = RG / 128;
  const int n_scan = NBG * 64, n_q = MT * 6, n_kv = MT * 8;
  run_q8(ctr, QA_CNT(n_scan + n_q + n_kv), [&](int q_, int j_) {
    const int it = QA_ID(q_, j_);
    if (it < n_scan) gla_scan(p, it);
    else if (it < n_scan + n_q) q_tile(p, l, it - n_scan);
    else kv_tile(p, l, it - n_scan - n_q);
  });
}

__device__ __forceinline__ bf16x8 pack8(const f32x16& a, int o) {
  union { bf16x8 v; unsigned u[4]; } r;
  r.u[0] = pack2(a[o + 0], a[o + 1]); r.u[1] = pack2(a[o + 2], a[o + 3]);
  r.u[2] = pack2(a[o + 4], a[o + 5]); r.u[3] = pack2(a[o + 6], a[o + 7]);
  return r.v;
}
__device__ __forceinline__ bf16x8 ld2x8(const u16* p0) {
  union { bf16x8 v; uint2 u[2]; } r;
  r.u[0] = *(const uint2*)p0; r.u[1] = *(const uint2*)(p0 + 8);
  return r.v;
}

__device__ void attn_item(const Params& p, int it) {
  const int tid = TIDX, lane = tid & 63, wid = tid >> 6, l31 = lane & 31, hh = lane >> 5;
  const int qb = it % 66, bh = it / 66, h = bh & 7, bl = bh >> 3;
  const int r0 = qb < 64 ? bl * SEQ + qb * 128 : NBG * SEQ + bl * CTXL + (qb - 64) * 128;
  const int kt0 = qb < 64 ? 0 : 128;
  const int nkt = NCHUNK - kt0;
  constexpr int KROW = 208, VROW = 144, BUFB = 64 * KROW + 64 * VROW;
  bf16x8 qf[6];
  {
    const u16* qp = p.q + (size_t)(r0 + 32 * wid + l31) * 768 + h * 96 + 8 * hh;
#pragma unroll
    for (int s = 0; s < 6; ++s) qf[s] = *(const bf16x8*)(qp + 16 * s);
  }
  const u16* kbase = p.kf + (size_t)bh * NKEY * 96;
  const u16* vbase = p.vt + (size_t)bh * 64 * NKEY;
  uint4 kr0, kr1, kr2, vr0, vr1;
  const int kdst0 = (tid / 12) * KROW + (tid % 12) * 16;
  const int kdst1 = ((tid + 256) / 12) * KROW + ((tid + 256) % 12) * 16;
  const int kdst2 = ((tid + 512) / 12) * KROW + ((tid + 512) % 12) * 16;
  const int vdst0 = 64 * KROW + (tid >> 3) * VROW + (tid & 7) * 16;
  const int vdst1 = vdst0 + 32 * VROW;
  const int vsrc0 = (tid >> 3) * NKEY + (tid & 7) * 8;
  const int vsrc1 = vsrc0 + 32 * NKEY;
  {
    const u16* kp = kbase + (size_t)kt0 * 64 * 96 + tid * 8;
    kr0 = *(const uint4*)(kp); kr1 = *(const uint4*)(kp + 2048); kr2 = *(const uint4*)(kp + 4096);
    vr0 = *(const uint4*)(vbase + vsrc0 + kt0 * 64); vr1 = *(const uint4*)(vbase + vsrc1 + kt0 * 64);
    *(uint4*)(smem + kdst0) = kr0; *(uint4*)(smem + kdst1) = kr1; *(uint4*)(smem + kdst2) = kr2;
    *(uint4*)(smem + vdst0) = vr0; *(uint4*)(smem + vdst1) = vr1;
  }
  __builtin_amdgcn_s_waitcnt(0x0F70);
  __syncthreads();
  f32x16 oacc[2];
#pragma unroll
  for (int e = 0; e < 16; ++e) { oacc[0][e] = 0.f; oacc[1][e] = 0.f; }
  float m_run = -1e30f, l_run = 0.f;
  for (int t = 0; t < nkt; ++t) {
    const int cur = t & 1;
    {
      const int tn = kt0 + min(t + 1, nkt - 1);
      const u16* kp = kbase + (size_t)tn * 64 * 96 + tid * 8;
      kr0 = *(const uint4*)(kp); kr1 = *(const uint4*)(kp + 2048); kr2 = *(const uint4*)(kp + 4096);
      vr0 = *(const uint4*)(vbase + vsrc0 + tn * 64); vr1 = *(const uint4*)(vbase + vsrc1 + tn * 64);
    }
    __builtin_amdgcn_sched_barrier(0);
    const char* Kl = smem + cur * BUFB;
    const char* Vl = Kl + 64 * KROW;
    f32x16 sacc[2];
#pragma unroll
    for (int kb = 0; kb < 2; ++kb) {
#pragma unroll
      for (int e = 0; e < 16; ++e) sacc[kb][e] = 0.f;
#pragma unroll
      for (int s = 0; s < 6; ++s) {
        const bf16x8 a = *(const bf16x8*)(Kl + (32 * kb + l31) * KROW + 32 * s + 16 * hh);
        sacc[kb] = __builtin_amdgcn_mfma_f32_32x32x16_bf16(a, qf[s], sacc[kb], 0, 0, 0);
      }
    }
    float mx = sacc[0][0];
#pragma unroll
    for (int e = 1; e < 16; ++e) mx = fmaxf(mx, sacc[0][e]);
#pragma unroll
    for (int e = 0; e < 16; ++e) mx = fmaxf(mx, sacc[1][e]);
    {
      const unsigned mu = __float_as_uint(mx);
      const auto sw = __builtin_amdgcn_permlane32_swap(mu, mu, false, false);
      mx = fmaxf(__uint_as_float(sw[0]), __uint_as_float(sw[1]));
    }
    if (!__all(mx - m_run <= 8.f)) {
      const float m_new = fmaxf(m_run, mx);
      const float alpha = __builtin_amdgcn_exp2f(m_run - m_new);
      m_run = m_new;
      l_run *= alpha;
#pragma unroll
      for (int e = 0; e < 16; ++e) { oacc[0][e] *= alpha; oacc[1][e] *= alpha; }
    }
    float ps = 0.f;
#pragma unroll
    for (int kb = 0; kb < 2; ++kb)
#pragma unroll
      for (int e = 0; e < 16; ++e) { const float pv = __builtin_amdgcn_exp2f(sacc[kb][e] - m_run); sacc[kb][e] = pv; ps += pv; }
    l_run += ps;
#pragma unroll
    for (int kb = 0; kb < 2; ++kb)
#pragma unroll
      for (int s2 = 0; s2 < 2; ++s2) {
        const bf16x8 pfr = pack8(sacc[kb], 8 * s2);
#pragma unroll
        for (int dt = 0; dt < 2; ++dt) {
          const bf16x8 a = ld2x8((const u16*)(Vl + (32 * dt + l31) * VROW) + 32 * kb + 16 * s2 + 4 * hh);
          oacc[dt] = __builtin_amdgcn_mfma_f32_32x32x16_bf16(a, pfr, oacc[dt], 0, 0, 0);
        }
      }
    __builtin_amdgcn_sched_barrier(0);
    {
      char* nb = smem + (cur ^ 1) * BUFB;
      *(uint4*)(nb + kdst0) = kr0; *(uint4*)(nb + kdst1) = kr1; *(uint4*)(nb + kdst2) = kr2;
      *(uint4*)(nb + vdst0) = vr0; *(uint4*)(nb + vdst1) = vr1;
    }
    __syncthreads();
  }
  l_run += __shfl_xor(l_run, 32);
  const float inv = 1.f / l_run;
  u16* op = p.h + (size_t)RG * 512 + (size_t)(r0 + 32 * wid + l31) * 512 + h * 64;
#pragma unroll
  for (int dt = 0; dt < 2; ++dt)
#pragma unroll
    for (int gq_ = 0; gq_ < 4; ++gq_) {
      const int dv0 = 32 * dt + 8 * gq_ + 4 * hh;
      uint2 o;
      o.x = pack2(oacc[dt][4 * gq_ + 0] * inv, oacc[dt][4 * gq_ + 1] * inv);
      o.y = pack2(oacc[dt][4 * gq_ + 2] * inv, oacc[dt][4 * gq_ + 3] * inv);
      *(uint2*)(op + dv0) = o;
    }
}

__device__ void gla_out(const Params& p, int l, int it) {
  const int tid = TIDX, lane = tid & 63, wid = tid >> 6, l31 = lane & 31, hh = lane >> 5;
  const int bl = it / (NCHUNK * 4), rem = it % (NCHUNK * 4), cidx = rem >> 2, h = rem & 3;
  const int r0 = chunk_row(bl, cidx, NBG);
  u16* tiles = (u16*)smem;
  u16* vT = (u16*)(smem + 36864);
  float* part = (float*)(smem + 55296);
  {
    const int t = tid >> 2, c16 = (tid & 3) * 16;
#pragma unroll
    for (int a = 0; a < 4; ++a) {
      const u16* src = p.gq + (size_t)a * RG * 256 + (size_t)(r0 + t) * 256 + h * 64 + c16;
      const uint4 u0 = *(const uint4*)src, u1 = *(const uint4*)(src + 8);
      u16* d = tiles + a * 4608 + t * 72 + c16;
      *(uint4*)d = u0; *(uint4*)(d + 8) = u1;
    }
    const int dvc = (tid & 3) * 32;
    const u16* vp = p.proj + (size_t)(r0 + t) * INW + C_VA + h * 128 + dvc;
#pragma unroll
    for (int i = 0; i < 4; ++i) {
      const uint4 vv = *(const uint4*)(vp + i * 8);
      u16* dst = vT + (size_t)(dvc + i * 8) * 72 + t;
      dst[0] = (u16)(vv.x & 0xffff); dst[72] = (u16)(vv.x >> 16);
      dst[144] = (u16)(vv.y & 0xffff); dst[216] = (u16)(vv.y >> 16);
      dst[288] = (u16)(vv.z & 0xffff); dst[360] = (u16)(vv.z >> 16);
      dst[432] = (u16)(vv.w & 0xffff); dst[504] = (u16)(vv.w >> 16);
    }
  }
  const int itl = wid & 1, dvh = wid >> 1;
  const size_t cb = ((size_t)(bl * NCHUNK + cidx) * 4 + h) * 2;
  bf16x8 sfr[2][2][4];
#pragma unroll
  for (int dir = 0; dir < 2; ++dir)
#pragma unroll
    for (int dt = 0; dt < 2; ++dt)
#pragma unroll
      for (int s4 = 0; s4 < 4; ++s4)
        sfr[dir][dt][s4] = *(const bf16x8*)(p.ss + (cb + dir) * 8192 + (64 * dvh + 32 * dt + l31) * 64 + 16 * s4 + 8 * hh);
  __syncthreads();
  f32x16 oacc[2];
#pragma unroll
  for (int e = 0; e < 16; ++e) { oacc[0][e] = 0.f; oacc[1][e] = 0.f; }
#pragma unroll
  for (int dir = 0; dir < 2; ++dir) {
    const u16* Qt = tiles + (dir * 2) * 4608;
    const u16* Kt = tiles + (dir * 2 + 1) * 4608;
    bf16x8 qfr[4];
#pragma unroll
    for (int s = 0; s < 4; ++s) qfr[s] = *(const bf16x8*)(Qt + (32 * itl + l31) * 72 + 16 * s + 8 * hh);
    f32x16 aacc[2];
#pragma unroll
    for (int jt = 0; jt < 2; ++jt) {
#pragma unroll
      for (int e = 0; e < 16; ++e) aacc[jt][e] = 0.f;
#pragma unroll
      for (int s = 0; s < 4; ++s) {
        const bf16x8 a = *(const bf16x8*)(Kt + (32 * jt + l31) * 72 + 16 * s + 8 * hh);
        aacc[jt] = __builtin_amdgcn_mfma_f32_32x32x16_bf16(a, qfr[s], aacc[jt], 0, 0, 0);
      }
      const int i_tok = 32 * itl + l31;
#pragma unroll
      for (int e = 0; e < 16; ++e) {
        const int j_tok = 32 * jt + (e & 3) + 8 * (e >> 2) + 4 * hh;
        const bool keep = dir ? (j_tok >= i_tok) : (j_tok <= i_tok);
        if (!keep) aacc[jt][e] = 0.f;
      }
    }
#pragma unroll
    for (int dt = 0; dt < 2; ++dt) {
      const int dvrow = 64 * dvh + 32 * dt + l31;
#pragma unroll
      for (int jt = 0; jt < 2; ++jt)
#pragma unroll
        for (int s2 = 0; s2 < 2; ++s2) {
          const bf16x8 pfr = pack8(aacc[jt], 8 * s2);
          const bf16x8 a = ld2x8(vT + dvrow * 72 + 32 * jt + 16 * s2 + 4 * hh);
          oacc[dt] = __builtin_amdgcn_mfma_f32_32x32x16_bf16(a, pfr, oacc[dt], 0, 0, 0);
        }
#pragma unroll
      for (int s = 0; s < 4; ++s) {
        oacc[dt] = __builtin_amdgcn_mfma_f32_32x32x16_bf16(sfr[dir][dt][s], qfr[s], oacc[dt], 0, 0, 0);
      }
    }
  }
  float ss = 0.f;
#pragma unroll
  for (int e = 0; e < 16; ++e) ss += oacc[0][e] * oacc[0][e] + oacc[1][e] * oacc[1][e];
  ss += __shfl_xor(ss, 32);
  if (hh == 0) part[wid * 32 + l31] = ss;
  __syncthreads();
  const float totss = part[wid * 32 + l31] + part[(wid ^ 2) * 32 + l31];
  const float rstd = rsqrtf(totss * (1.f / 128.f) + EPS);
  const int r = r0 + 32 * itl + l31;
  const float* gam = p.in[10] + l * 512 + h * 128;
  u16* aa = p.h;
#pragma unroll
  for (int dt = 0; dt < 2; ++dt)
#pragma unroll
    for (int gq_ = 0; gq_ < 4; ++gq_) {
      const int dv0 = 64 * dvh + 32 * dt + 8 * gq_ + 4 * hh;
      const uint2 ra = *(const uint2*)(p.proj + (size_t)r * INW + C_RA + h * 128 + dv0);
      const float4 g4 = *(const float4*)(gam + dv0);
      uint2 o;
      o.x = pack2(oacc[dt][4 * gq_ + 0] * rstd * g4.x * silu_f(bflo(ra.x)), oacc[dt][4 * gq_ + 1] * rstd * g4.y * silu_f(bfhi(ra.x)));
      o.y = pack2(oacc[dt][4 * gq_ + 2] * rstd * g4.z * silu_f(bflo(ra.y)), oacc[dt][4 * gq_ + 3] * rstd * g4.w * silu_f(bfhi(ra.y)));
      *(uint2*)(aa + (size_t)r * 512 + h * 128 + dv0) = o;
    }
}

__device__ void phase_attn(const Params& p, int l, int* ctr) {
  const int nqb = (l == 1) ? 64 : 66, nck = (l == 1) ? 128 : NCHUNK;
  const int per_q = NBG * nqb;
  const int n_gla = NBG * nck * 4;
  run_q8(ctr, [=](int q_) { return per_q + ((n_gla - q_ + 7) >> 3); }, [&](int q_, int j_) {
    if (j_ < per_q) attn_item(p, ((j_ / nqb) * 8 + q_) * 66 + (j_ % nqb));
    else {
      const int gi = QA_ID(q_, j_ - per_q);
      gla_out(p, l, (gi / (nck * 4)) * (NCHUNK * 4) + gi % (nck * 4));
    }
  });
}

__device__ void phase_merge(const Params& p, int l, int* ctr) {
  const int MT = (l == 1 ? NBG * SEQ / 128 : RG / 128), NT = 16;
  const u16* wl = p.wt + (size_t)l * W_LAYER;
  run_q8(ctr, GEMM_CNT(MT, NT), [&](int q_, int j_) {
    int mt, nt; tile_order(j_, mlo(q_ + 1, MT) - mlo(q_, MT), NT, mt, nt); mt += mlo(q_, MT);
    const int tid = TIDX, lane = tid & 63, wid = tid >> 6;
    const int wr = wid >> 1, wc = wid & 1, fr = lane & 15, fq = lane >> 4;
    f32x4 macc[2][4], acc[2][4];
#pragma unroll
    for (int a = 0; a < 2; ++a)
#pragma unroll
      for (int b = 0; b < 4; ++b) { macc[a][b] = f32x4{0.f, 0.f, 0.f, 0.f}; acc[a][b] = f32x4{0.f, 0.f, 0.f, 0.f}; }
    const int srow = tid >> 3, schunk = (tid & 7) ^ ((tid >> 4) & 7);
    const size_t xo = (size_t)(mt * 128 + srow) * 512 + schunk * 8;
    const size_t wo = (size_t)(nt * 64 + srow) * 512 + schunk * 8;
    const u16* xg0 = p.h + xo;
    const u16* xg1 = p.h + (size_t)RG * 512 + xo;
    const u16* xg2 = p.uc + xo;
    const u16* wg0 = wl + W_BRA + wo;
    const u16* wg1 = wl + W_BRB + wo;
    const u16* wg2 = wl + W_BRC + wo;
    const int g = fr >> 1;
    const int lo0 = fr * 128 + ((fq ^ g) << 4), lo1 = fr * 128 + (((fq ^ g) ^ 4) << 4);
    const char* xb = smem + wr * 8192;
    const char* wb = smem + 16384 + wc * 4096;
    char* sdst = smem + tid * 16;
    const u16* gbase = p.proj + (size_t)(mt * 128 + wr * 64 + fr) * INW + C_GATE + nt * 64 + wc * 32 + fq * 4;
    uint2 gts[2][4];
#pragma unroll
    for (int wi = 0; wi < 2; ++wi)
#pragma unroll
      for (int xi = 0; xi < 4; ++xi) gts[wi][xi] = *(const uint2*)(gbase + (size_t)xi * 16 * INW + wi * 16);
    __syncthreads();
#pragma unroll
    for (int i = 0; i < 4; ++i) {
      glds16(xg0 + i * (32 * 512), sdst + i * 4096);
      if (i < 2) glds16(wg0 + i * (32 * 512), sdst + 16384 + i * 4096);
    }
    for (int kt = 0; kt < 24; ++kt) {
      asm volatile("s_waitcnt vmcnt(0)" ::: "memory");
      __syncthreads();
      const int cb = (kt & 1) * 32768;
      if (kt + 1 < 24) {
        const int nbr = (kt + 1) >> 3, ko = ((kt + 1) & 7) * 64, nb = 32768 - cb;
        const u16* xg = (nbr == 0 ? xg0 : nbr == 1 ? xg1 : xg2) + ko;
        const u16* wg = (nbr == 0 ? wg0 : nbr == 1 ? wg1 : wg2) + ko;
#pragma unroll
        for (int i = 0; i < 4; ++i) {
          glds16(xg + i * (32 * 512), sdst + nb + i * 4096);
          if (i < 2) glds16(wg + i * (32 * 512), sdst + nb + 16384 + i * 4096);
        }
      }
      bf16x8 wf[2][2], xf[2][4];
#pragma unroll
      for (int i = 0; i < 2; ++i) {
        wf[0][i] = *(const bf16x8*)(wb + cb + i * 2048 + lo0);
        wf[1][i] = *(const bf16x8*)(wb + cb + i * 2048 + lo1);
      }
#pragma unroll
      for (int i = 0; i < 4; ++i) {
        xf[0][i] = *(const bf16x8*)(xb + cb + i * 2048 + lo0);
        xf[1][i] = *(const bf16x8*)(xb + cb + i * 2048 + lo1);
      }
      __builtin_amdgcn_sched_barrier(0);
#pragma unroll
      for (int k = 0; k < 2; ++k)
#pragma unroll
        for (int wi = 0; wi < 2; ++wi)
#pragma unroll
          for (int xi = 0; xi < 4; ++xi)
            acc[wi][xi] = __builtin_amdgcn_mfma_f32_16x16x32_bf16(wf[k][wi], xf[k][xi], acc[wi][xi], 0, 0, 0);
      __builtin_amdgcn_sched_barrier(0);
      if ((kt & 7) == 7) {
        const int br = kt >> 3;
#pragma unroll
        for (int wi = 0; wi < 2; ++wi)
#pragma unroll
          for (int xi = 0; xi < 4; ++xi) {
            const uint2 gt = gts[wi][xi];
            macc[wi][xi][0] += sigmoid_f(bflo(gt.x)) * acc[wi][xi][0];
            macc[wi][xi][1] += sigmoid_f(bfhi(gt.x)) * acc[wi][xi][1];
            macc[wi][xi][2] += sigmoid_f(bflo(gt.y)) * acc[wi][xi][2];
            macc[wi][xi][3] += sigmoid_f(bfhi(gt.y)) * acc[wi][xi][3];
            acc[wi][xi] = f32x4{0.f, 0.f, 0.f, 0.f};
            if (br < 2) gts[wi][xi] = *(const uint2*)(gbase + (size_t)xi * 16 * INW + wi * 16 + (br + 1) * 1024);
          }
      }
    }
    uint2 o[2][4];
#pragma unroll
    for (int wi = 0; wi < 2; ++wi)
#pragma unroll
      for (int xi = 0; xi < 4; ++xi) {
        o[wi][xi].x = pack2(macc[wi][xi][0], macc[wi][xi][1]); o[wi][xi].y = pack2(macc[wi][xi][2], macc[wi][xi][3]);
      }
    store_tile_bf16<2>(o, p.m + (size_t)(mt * 128 + wr * 64) * DM + nt * 64 + wc * 32, DM);
  });
}

__device__ void phase_resid(const Params& p, int l, int g, int which, int* ctr) {
  const int MT = (l == 1 ? NBG * SEQ / 128 : RG / 128), NT = 8;
  const u16* wl = p.wt + (size_t)l * W_LAYER;
  const u16* X = which == 0 ? p.m : p.proj + (size_t)RG * DFF;
  const int ldx = which == 0 ? DM : DFF, K = which == 0 ? DM : DFF;
  const u16* W = wl + (which == 0 ? W_O : W_DN);
  const int goff = which == 0 ? 2048 : 5120;
  const int from_input = (which == 0 && l == 0);
  run_q8(ctr, GEMM_CNT(MT, NT), [&](int q_, int j_) {
    int mt, nt; tile_order(j_, mlo(q_ + 1, MT) - mlo(q_, MT), NT, mt, nt); mt += mlo(q_, MT);
    f32x4 acc[4][4];
    gemm_core<4>(X + (size_t)mt * 128 * ldx, ldx, W + (size_t)nt * 128 * K, K, K, acc);
    EPI_VARS
    const float* mrow = p.mod + ((size_t)l * 9 + mod_index(p, g, mt * 128)) * 6144 + goff;
    float4 gv[4];
#pragma unroll
    for (int wi = 0; wi < 4; ++wi) gv[wi] = *(const float4*)(mrow + nt * 128 + EPI_NN(wi));
#pragma unroll
    for (int xi = 0; xi < 4; ++xi) {
      const int r = mt * 128 + EPI_TR(xi);
      const float* xs = xsrc_row_ptr(p, g, r, from_input);
      float* xd = xrow_ptr(p, g, r);
      float4 xv[4];
#pragma unroll
      for (int wi = 0; wi < 4; ++wi) xv[wi] = *(const float4*)(xs + nt * 128 + EPI_NN(wi));
#pragma unroll
      for (int wi = 0; wi < 4; ++wi) {
        float4 o;
        o.x = xv[wi].x + gv[wi].x * acc[wi][xi][0]; o.y = xv[wi].y + gv[wi].y * acc[wi][xi][1];
        o.z = xv[wi].z + gv[wi].z * acc[wi][xi][2]; o.w = xv[wi].w + gv[wi].w * acc[wi][xi][3];
        *(float4*)(xd + nt * 128 + EPI_NN(wi)) = o;
      }
    }
  });
}

__device__ void phase_gu(const Params& p, int l, int* ctr) {
  const int MT = (l == 1 ? NBG * SEQ / 128 : RG / 128), NT = 44;
  const u16* W = p.wt + (size_t)l * W_LAYER + W_GU;
  run_q8(ctr, GEMM_CNT(MT, NT), [&](int q_, int j_) {
    int mt, nt; tile_order(j_, mlo(q_ + 1, MT) - mlo(q_, MT), NT, mt, nt); mt += mlo(q_, MT);
    f32x4 acc[4][4];
    gemm_core<4>(p.h + (size_t)mt * 128 * DM, DM, W + (size_t)nt * 128 * DM, DM, DM, acc);
    EPI_VARS
    u16* dst = p.proj + (nt >= 22 ? (size_t)RG * DFF : 0);
    const int nb = (nt >= 22 ? nt - 22 : nt) * 128;
    uint2 o[4][4];
#pragma unroll
    for (int wi = 0; wi < 4; ++wi)
#pragma unroll
      for (int xi = 0; xi < 4; ++xi) {
        o[wi][xi].x = pack2(acc[wi][xi][0], acc[wi][xi][1]); o[wi][xi].y = pack2(acc[wi][xi][2], acc[wi][xi][3]);
      }
    store_tile_bf16<4>(o, dst + (size_t)(mt * 128 + wr_ * 64) * DFF + nb + wc_ * 64, DFF);
  });
}

struct ActIn { uint4 g0, g1, g2, uu; float4 w0a, w0b, w1a, w1b, w2a, w2b, ba, bb; };
__device__ __forceinline__ void act_load(ActIn& a, const u16* G, const u16* UP, const float* cw, const float* cb, int r, int c0) {
  int bl, pos, isctx; rowinfo(r, NBG, bl, pos, isctx);
  const int L = isctx ? CTXL : SEQ;
  const u16* gp = G + (size_t)r * DFF + c0;
  a.g1 = *(const uint4*)gp;
  a.g0 = make_uint4(0, 0, 0, 0); a.g2 = a.g0;
  if (pos > 0) a.g0 = *(const uint4*)(gp - DFF);
  if (pos < L - 1) a.g2 = *(const uint4*)(gp + DFF);
  a.uu = *(const uint4*)(UP + (size_t)r * DFF + c0);
  a.w0a = *(const float4*)(cw + c0); a.w0b = *(const float4*)(cw + c0 + 4);
  a.w1a = *(const float4*)(cw + DFF + c0); a.w1b = *(const float4*)(cw + DFF + c0 + 4);
  a.w2a = *(const float4*)(cw + 2 * DFF + c0); a.w2b = *(const float4*)(cw + 2 * DFF + c0 + 4);
  a.ba = *(const float4*)(cb + c0); a.bb = *(const float4*)(cb + c0 + 4);
}
__device__ __forceinline__ uint4 act_compute(const ActIn& a) {
  uint4 o;
#define ACT2(G0, G1, G2, UU, W0L, W0H, W1L, W1H, W2L, W2H, BL, BH) \
  pack2(silu_f(W0L * bflo(G0) + W1L * bflo(G1) + W2L * bflo(G2) + BL) * bflo(UU), \
        silu_f(W0H * bfhi(G0) + W1H * bfhi(G1) + W2H * bfhi(G2) + BH) * bfhi(UU))
  o.x = ACT2(a.g0.x, a.g1.x, a.g2.x, a.uu.x, a.w0a.x, a.w0a.y, a.w1a.x, a.w1a.y, a.w2a.x, a.w2a.y, a.ba.x, a.ba.y);
  o.y = ACT2(a.g0.y, a.g1.y, a.g2.y, a.uu.y, a.w0a.z, a.w0a.w, a.w1a.z, a.w1a.w, a.w2a.z, a.w2a.w, a.ba.z, a.ba.w);
  o.z = ACT2(a.g0.z, a.g1.z, a.g2.z, a.uu.z, a.w0b.x, a.w0b.y, a.w1b.x, a.w1b.y, a.w2b.x, a.w2b.y, a.bb.x, a.bb.y);
  o.w = ACT2(a.g0.w, a.g1.w, a.g2.w, a.uu.w, a.w0b.z, a.w0b.w, a.w1b.z, a.w1b.w, a.w2b.z, a.w2b.w, a.bb.z, a.bb.w);
#undef ACT2
  return o;
}

__device__ void phase_act(const Params& p, int l, int* ctr) {
  const int nitems = (l == 1) ? NBG * SEQ / 8 : RG / 8;
  const float* cw = p.in[23] + (size_t)l * 3 * DFF;
  const float* cb = p.in[24] + (size_t)l * DFF;
  const u16* G = p.proj;
  u16* UP = p.proj + (size_t)RG * DFF;
  for (int it = blockIdx.x; it < nitems; it += gridDim.x) {
    const int tid = TIDX;
    for (int k = 0; k < 12; k += 2) {
      const int e0 = tid + k * 256, e1 = e0 + 256;
      const bool two = (k + 1 < 11);
      const int r0 = it * 8 + e0 / 352, c00 = (e0 % 352) * 8;
      const int r1 = it * 8 + (two ? e1 / 352 : 0), c01 = two ? (e1 % 352) * 8 : 0;
      ActIn a0, a1;
      act_load(a0, G, UP, cw, cb, r0, c00);
      act_load(a1, G, UP, cw, cb, r1, c01);
      const uint4 o0 = act_compute(a0), o1 = act_compute(a1);
      *(uint4*)(UP + (size_t)r0 * DFF + c00) = o0;
      if (two) *(uint4*)(UP + (size_t)r1 * DFF + c01) = o1;
    }
  }
}

__device__ void phase_final(const Params& p, int* ctr) {
  const int nitems = NBATCH * SEQ / 16;
  const float* gam = p.in[26];
  for (int it = blockIdx.x; it < nitems; it += gridDim.x) {
    const int lane = TIDX & 63, wid = TIDX >> 6;
    float* xr = p.out + ((size_t)it * 16 + wid * 4) * DM;
    float4 v[4][4], gg[4];
#pragma unroll
    for (int rr = 0; rr < 4; ++rr)
#pragma unroll
      for (int i = 0; i < 4; ++i) v[rr][i] = *(const float4*)(xr + (size_t)rr * DM + lane * 4 + i * 256);
#pragma unroll
    for (int i = 0; i < 4; ++i) gg[i] = *(const float4*)(gam + lane * 4 + i * 256);
#pragma unroll
    for (int rr = 0; rr < 4; ++rr) {
      float ss = 0.f;
#pragma unroll
      for (int i = 0; i < 4; ++i)
        ss += v[rr][i].x * v[rr][i].x + v[rr][i].y * v[rr][i].y + v[rr][i].z * v[rr][i].z + v[rr][i].w * v[rr][i].w;
      ss = wave_sum(ss);
      const float rstd = rsqrtf(ss * (1.f / 1024.f) + EPS);
#pragma unroll
      for (int i = 0; i < 4; ++i) {
        float4 o; o.x = v[rr][i].x * rstd * gg[i].x; o.y = v[rr][i].y * rstd * gg[i].y; o.z = v[rr][i].z * rstd * gg[i].z; o.w = v[rr][i].w * rstd * gg[i].w;
        *(float4*)(xr + (size_t)rr * DM + lane * 4 + i * 256) = o;
      }
    }
  }
}

#define XB_TMO      128
#define XB_XCNT(j)  (256  + 64 * (j))
#define XB_XSUB(j)  (1280 + 64 * (j))
#define XB_XGEN(j)  (2304 + 64 * (j))
#define XB_TOP      3328
#define XB_TOPGEN   3392
#define XCD_BAR_WORDS 3456
#define XB_SPIN_CAP (1u << 22)
#define LAS __attribute__((address_space(3)))
__device__ __forceinline__ unsigned xb_ld(unsigned* p)              { return __hip_atomic_load(p, __ATOMIC_RELAXED, __HIP_MEMORY_SCOPE_AGENT); }
__device__ __forceinline__ unsigned xb_add(unsigned* p, unsigned v) { return __hip_atomic_fetch_add(p, v, __ATOMIC_RELAXED, __HIP_MEMORY_SCOPE_AGENT); }
__device__ __forceinline__ unsigned xb_xcc_id() { return (unsigned)__builtin_amdgcn_s_getreg((3 << 11) | 20) & 0xFu; }
#define XB_SPIN(cond, bar) do { unsigned _sp = 0; while (cond) { __builtin_amdgcn_s_sleep(1); \
    if ((++_sp & 255u) == 0u) { if (xb_ld(&(bar)[XB_TMO])) break; if (_sp > XB_SPIN_CAP) { atomicAdd(&(bar)[XB_TMO], 1u); break; } } } } while (0)
struct XcdBarrier { unsigned* bar; unsigned x; volatile LAS unsigned* st; };
__device__ __forceinline__ XcdBarrier xcd_barrier_post(unsigned* bar, volatile LAS unsigned* st) {
  XcdBarrier b; b.bar = bar; b.x = xb_xcc_id(); b.st = st;
  if (threadIdx.x == 0) (void)xb_add(&bar[XB_XCNT(b.x)], 1u);
  return b;
}
__device__ __forceinline__ void xcd_barrier_complete(unsigned* bar, unsigned x, unsigned& nloc, unsigned& nx) {
  const unsigned G = gridDim.x * gridDim.y * gridDim.z;
  unsigned sum, cnt, mine, sp = 0u;
  for (;;) {
    sum = 0u; cnt = 0u; mine = 0u;
#pragma unroll
    for (unsigned j = 0; j < 16; ++j) { const unsigned c = xb_ld(&bar[XB_XCNT(j)]); sum += c; cnt += (c > 0u) ? 1u : 0u; mine = (j == x) ? c : mine; }
    if (sum == G) break;
    __builtin_amdgcn_s_sleep(1);
    if ((++sp & 255u) == 0u) { if (xb_ld(&bar[XB_TMO])) break; if (sp > XB_SPIN_CAP) { atomicAdd(&bar[XB_TMO], 1u); break; } }
  }
  nloc = mine > 0u ? mine : 1u; nx = cnt > 0u ? cnt : 1u;
}
__device__ __forceinline__ void xcd_barrier(const XcdBarrier& b) {
  asm volatile("s_waitcnt vmcnt(0)" ::: "memory");
  __syncthreads();
  if (threadIdx.x == 0) {
    unsigned* bar = b.bar;
    __builtin_amdgcn_s_waitcnt(0);
    unsigned nloc = b.st[0], nx = b.st[1];
    if (nloc == 0u) { xcd_barrier_complete(bar, b.x, nloc, nx); b.st[0] = nloc; b.st[1] = nx; }
    const unsigned old = xb_add(&bar[XB_XSUB(b.x)], 1u);
    const unsigned gen = old / nloc;
    if (old + 1u == (gen + 1u) * nloc) {
      __builtin_amdgcn_fence(__ATOMIC_RELEASE, "agent");
      asm volatile("s_waitcnt vmcnt(0)" ::: "memory");
      const unsigned og = xb_add(&bar[XB_TOP], 1u);
      const unsigned tg = og / nx;
      if (og + 1u == (tg + 1u) * nx) xb_add(&bar[XB_TOPGEN], 1u);
      else XB_SPIN(xb_ld(&bar[XB_TOPGEN]) == tg, bar);
      __builtin_amdgcn_fence(__ATOMIC_ACQUIRE, "agent");
      xb_add(&bar[XB_XGEN(b.x)], 1u);
      asm volatile("s_waitcnt vmcnt(0)" ::: "memory");
    } else {
      XB_SPIN(xb_ld(&bar[XB_XGEN(b.x)]) == gen, bar);
      __builtin_amdgcn_fence(__ATOMIC_ACQUIRE, "agent");
      asm volatile("s_waitcnt vmcnt(0)" ::: "memory");
    }
  }
  __syncthreads();
}

__device__ void run_phase(const Params& p, int ph, int* ctr) {
  if (ph == 0) { phase0(p, ctr); return; }
  if (ph == NPHASES - 1) { phase_final(p, ctr); return; }
  const int idx = ph - 1, lg = idx / NPH_PER, sub = idx % NPH_PER;
  const int l = lg / NGRP, g = lg % NGRP;
  switch (sub) {
    case 0: phase_norm(p, l, g, 0, ctr); break;
    case 1: phase_proj(p, l, ctr); break;
    case 2: phase_postproj(p, l, ctr); break;
    case 3: phase_qkv(p, l, ctr); break;
    case 4: phase_attn(p, l, ctr); break;
    case 5: phase_merge(p, l, ctr); break;
    case 6: phase_resid(p, l, g, 0, ctr); break;
    case 7: phase_norm(p, l, g, 1, ctr); break;
    case 8: phase_gu(p, l, ctr); break;
    case 9: phase_act(p, l, ctr); break;
    default: phase_resid(p, l, g, 1, ctr); break;
  }
}

__global__ void __launch_bounds__(256, 2) mega_kernel(KArgs ka, int ph_lo, int ph_hi, int coop) {
  Params p;
#pragma unroll
  for (int i = 0; i < 27; ++i) p.in[i] = ka.in[i];
  p.out = ka.out;
  char* ws = ka.ws;
  p.ctr = (int*)(ws + O_CTR); p.mod = (float*)(ws + O_MOD); p.rope = (float*)(ws + O_ROPE); p.xc = (float*)(ws + O_XC);
  p.rstdq = (float*)(ws + O_RSQ); p.rstdkv = (float*)(ws + O_RSKV); p.dec = (float*)(ws + O_DEC); p.wt = (u16*)(ws + O_WT);
  p.proj = (u16*)(ws + O_PROJ); p.h = (u16*)(ws + O_H); p.m = (u16*)(ws + O_M); p.q = (u16*)(ws + O_Q);
  p.kf = (u16*)(ws + O_KF); p.vt = (u16*)(ws + O_VT); p.uc = (u16*)(ws + O_UC); p.gq = (u16*)(ws + O_GQ);
  p.ss = (u16*)(ws + O_SS);
  volatile LAS unsigned* st = (volatile LAS unsigned*)(smem + SLOT_OFF + 64);
  if (threadIdx.x == 0) { st[0] = 0u; st[1] = 0u; }
  __syncthreads();
  XcdBarrier xb;
  xb.bar = (unsigned*)(ws + O_BAR); xb.x = 0; xb.st = st;
  if (coop) xb = xcd_barrier_post((unsigned*)(ws + O_BAR), st);
  for (int ph = ph_lo; ph < ph_hi; ++ph) {
#ifdef PROBE_MASK
    const int nrep = (ph > 0 && ph < NPHASES - 1 && ((PROBE_MASK >> ((ph - 1) % NPH_PER)) & 1)) ? 2 : 1;
#else
    const int nrep = 1;
#endif
    for (int rep = 0; rep < nrep; ++rep) {
      if (rep) xcd_barrier(xb);
      run_phase(p, ph, p.ctr + rep * 512 + ph * 8);
    }
    if (coop && ph + 1 < ph_hi) {
      if (ph == ph_lo) cg::this_grid().sync();
      else xcd_barrier(xb);
    }
  }
}

static inline size_t align_up(size_t v) { return (v + 255) & ~(size_t)255; }

extern "C" void kernel_launch(void* const* d_in, const int* in_sizes, int n_in, void* d_out, int out_size,
                              void* d_ws, size_t ws_size, hipStream_t stream) {
  static int grid_blocks = 0;
  if (!grid_blocks) {
    int dev = 0, cus = 0, per_cu = 0;
    hipGetDevice(&dev);
    hipDeviceGetAttribute(&cus, hipDeviceAttributeMultiprocessorCount, dev);
    hipFuncSetAttribute((const void*)mega_kernel, hipFuncAttributeMaxDynamicSharedMemorySize, LDS_BYTES);
    hipOccupancyMaxActiveBlocksPerMultiprocessor(&per_cu, (const void*)mega_kernel, 256, LDS_BYTES);
    if (per_cu < 1) per_cu = 1;
    if (per_cu > 2) per_cu = 2;
    grid_blocks = cus * per_cu;
  }
  KArgs p{};
  for (int i = 0; i < 27; ++i) p.in[i] = (const float*)d_in[i];
  p.out = (float*)d_out;
  p.ws = (char*)d_ws;
  if (ws_size < WS_END) { fprintf(stderr, "workspace too small: %zu < %zu\n", ws_size, (size_t)WS_END); return; }
  hipMemsetAsync((char*)d_ws + O_CTR, 0, 4096 + XCD_BAR_BYTES, stream);
#if SINGLE_LAUNCH
  int lo = 0, hi = NPHASES, coop = 1;
  void* args[] = {&p, &lo, &hi, &coop};
  hipError_t e = hipLaunchCooperativeKernel((const void*)mega_kernel, dim3(grid_blocks), dim3(256), args, LDS_BYTES, stream);
  if (e != hipSuccess) fprintf(stderr, "cooperative launch failed: %s (grid %d)\n", hipGetErrorString(e), grid_blocks);
#else
  for (int ph = 0; ph < NPHASES; ++ph)
    hipLaunchKernelGGL(mega_kernel, dim3(grid_blocks), dim3(256), LDS_BYTES, stream, p, ph, ph + 1, 0);
#endif
}
```

```cpp
#include <hip/hip_runtime.h>
#include <hip/hip_cooperative_groups.h>
#include <cstdio>
#include <cstdint>
namespace cg = cooperative_groups;

typedef unsigned short u16;
typedef __attribute__((ext_vector_type(8))) short bf16x8;
typedef __attribute__((ext_vector_type(4))) float f32x4;
typedef __attribute__((ext_vector_type(16))) float f32x16;

#ifndef SINGLE_LAUNCH
#define SINGLE_LAUNCH 1
#endif

constexpr int DM = 1024, SEQ = 8192, CTXL = 256, NBATCH = 8, INW = 6592, INWP = 6656, DFF = 2816;
constexpr int C_QA = 0, C_KA = 256, C_VA = 512, C_RA = 1024, C_ALR = 1536, C_CQ = 1568, C_CKV = 1824,
              C_KR = 1952, C_SB = 1984, C_SC = 2496, C_SX = 3008, C_GATE = 3520;
constexpr int NKEY = SEQ + CTXL;
constexpr int NCHUNK = NKEY / 64;
constexpr float EPS = 1e-6f;
constexpr int LDS_BYTES = 65536 + 256;
constexpr int SLOT_OFF = 65536;
constexpr int NPH_PER = 11;
constexpr int NBG = 4;
constexpr int NGRP = NBATCH / NBG;
constexpr int RG = NBG * (SEQ + CTXL);
constexpr int NPHASES = 1 + 2 * NGRP * NPH_PER + 1;

constexpr size_t W_IN = 0;
constexpr size_t W_UQ = W_IN + (size_t)INWP * 1024;
constexpr size_t W_UKV = W_UQ + 768 * 256;
constexpr size_t W_BRA = W_UKV + 1024 * 128;
constexpr size_t W_BRB = W_BRA + 1024 * 512;
constexpr size_t W_BRC = W_BRB + 1024 * 512;
constexpr size_t W_O = W_BRC + 1024 * 512;
constexpr size_t W_GU = W_O + 1024 * 1024;
constexpr size_t W_DN = W_GU + (size_t)5632 * 1024;
constexpr size_t W_LAYER = W_DN + (size_t)1024 * 2816;

struct KArgs {
  const float* in[27];
  float* out;
  char* ws;
};
struct Params {
  const float* in[27];
  float* out;
  float* xc;
  u16* wt;
  float* mod;
  float* rope;
  int* ctr;
  float* rstdq;
  float* rstdkv;
  float* dec;
  u16* proj;
  u16* h;
  u16* m;
  u16* q;
  u16* kf;
  u16* vt;
  u16* uc;
  u16* gq;
  u16* ss;
};
constexpr size_t al256(size_t v) { return (v + 255) & ~(size_t)255; }
constexpr size_t XCD_BAR_BYTES = 3456 * 4;
constexpr size_t O_CTR = 0;
constexpr size_t O_BAR = O_CTR + 4096;
constexpr size_t O_MOD = al256(O_BAR + XCD_BAR_BYTES);
constexpr size_t O_ROPE = al256(O_MOD + (size_t)2 * 9 * 6144 * 4);
constexpr size_t O_XC = al256(O_ROPE + 1024 * 2 * 4);
constexpr size_t O_RSQ = al256(O_XC + (size_t)NBATCH * CTXL * DM * 4);
constexpr size_t O_RSKV = al256(O_RSQ + (size_t)RG * 4);
constexpr size_t O_DEC = al256(O_RSKV + (size_t)RG * 4);
constexpr size_t O_WT = al256(O_DEC + (size_t)NBG * NCHUNK * 4 * 2 * 64 * 4);
constexpr size_t O_PROJ = al256(O_WT + 2 * W_LAYER * 2);
constexpr size_t O_H = al256(O_PROJ + (size_t)RG * INW * 2);
constexpr size_t O_M = O_H + (size_t)RG * DM * 2;
constexpr size_t O_Q = al256(O_M + (size_t)RG * DM * 2);
constexpr size_t O_KF = al256(O_Q + (size_t)RG * 768 * 2);
constexpr size_t O_VT = al256(O_KF + (size_t)NBG * 8 * NKEY * 96 * 2);
constexpr size_t O_UC = al256(O_VT + (size_t)NBG * 8 * 64 * NKEY * 2);
constexpr size_t O_GQ = al256(O_UC + (size_t)RG * 512 * 2);
constexpr size_t O_SS = al256(O_GQ + (size_t)RG * 1024 * 2);
constexpr size_t WS_END = al256(O_SS + (size_t)NBG * NCHUNK * 4 * 2 * 8192 * 2);
static_assert(WS_END <= ((size_t)1 << 30), "workspace layout must fit 1 GiB");

extern __shared__ __attribute__((aligned(16))) char smem[];

typedef __bf16 hbf2 __attribute__((ext_vector_type(2)));
typedef float hf2 __attribute__((ext_vector_type(2)));
__device__ __forceinline__ unsigned pack2(float a, float b) {
  hf2 v = {a, b};
  return __builtin_bit_cast(unsigned, __builtin_convertvector(v, hbf2));
}
__device__ __forceinline__ u16 f2bf(float f) { return (u16)(pack2(f, 0.f) & 0xffffu); }
__device__ __forceinline__ float bf2f(u16 h) { return __uint_as_float(((unsigned)h) << 16); }
__device__ __forceinline__ float bflo(unsigned u) { return __uint_as_float(u << 16); }
__device__ __forceinline__ float bfhi(unsigned u) { return __uint_as_float(u & 0xffff0000u); }
__device__ __forceinline__ float silu_f(float x) { return x / (1.f + __expf(-x)); }
__device__ __forceinline__ float sigmoid_f(float x) { return 1.f / (1.f + __expf(-x)); }

__device__ __forceinline__ void rowinfo(int r, int NB, int& bl, int& pos, int& isctx) {
  const int nl = NB * SEQ;
  if (r < nl) { bl = r >> 13; pos = r & (SEQ - 1); isctx = 0; }
  else { const int rc = r - nl; bl = rc >> 8; pos = rc & (CTXL - 1); isctx = 1; }
}
__device__ __forceinline__ int chunk_row(int bl, int cidx, int NB) {
  return cidx < 128 ? bl * SEQ + cidx * 64 : NB * SEQ + bl * CTXL + (cidx - 128) * 64;
}

template <class CntF, class BodyF>
__device__ __forceinline__ void run_q8(int* ctr8, CntF cntf, BodyF body) {
  volatile int* slot = (volatile int*)(smem + SLOT_OFF);
  int q = blockIdx.x & 7, tries = 0, item;
  __syncthreads();
  if (threadIdx.x == 0) {
    int v = atomicAdd(&ctr8[q], 1);
    while (v >= cntf(q) && tries < 8) { q = (q + 1) & 7; ++tries; if (tries < 8) v = atomicAdd(&ctr8[q], 1); }
    slot[0] = (tries < 8) ? v : -1; slot[1] = q; slot[2] = tries;
  }
  __syncthreads();
  item = slot[0]; q = slot[1]; tries = slot[2];
  while (item >= 0) {
    int nxt = 0;
    if (threadIdx.x == 0) nxt = atomicAdd(&ctr8[q], 1);
    body(q, item);
    __syncthreads();
    if (threadIdx.x == 0) {
      int qq = q, t = tries;
      while (nxt >= cntf(qq) && t < 8) { qq = (qq + 1) & 7; ++t; if (t < 8) nxt = atomicAdd(&ctr8[qq], 1); }
      slot[0] = (t < 8) ? nxt : -1; slot[1] = qq; slot[2] = t;
    }
    __syncthreads();
    item = slot[0]; q = slot[1]; tries = slot[2];
  }
}
#define QA_CNT(N) [=](int q_) { return ((N) - q_ + 7) >> 3; }
#define QA_ID(q_, j_) ((j_) * 8 + (q_))

__device__ __forceinline__ int opaque_tid() {
  int t = threadIdx.x;
  asm volatile("" : "+v"(t));
  return t;
}
#define TIDX opaque_tid()
__device__ __forceinline__ float wave_sum(float v) {
  v += __shfl_xor(v, 32); v += __shfl_xor(v, 16); v += __shfl_xor(v, 8);
  v += __shfl_xor(v, 4); v += __shfl_xor(v, 2); v += __shfl_xor(v, 1);
  return v;
}

__device__ __forceinline__ int lds_byte(int r, int c) {
  const int st = (r >> 4) * 2 + (c >> 5), rr = r & 15, cc = c & 31, ob = rr * 64 + cc * 2;
  return st * 1024 + (ob ^ (((ob >> 9) & 1) << 5));
}
__device__ __forceinline__ void stage_rc(int b, int& R, int& C) {
  const int st = b >> 10, sb = b & 1023, swz = sb ^ (((sb >> 9) & 1) << 5);
  R = (st >> 1) * 16 + (swz >> 6); C = (st & 1) * 32 + ((swz & 63) >> 1);
}

__device__ __forceinline__ void glds16(const void* g, void* l) {
  __builtin_amdgcn_global_load_lds((const __attribute__((address_space(1))) unsigned*)g,
                                   (__attribute__((address_space(3))) unsigned*)l, 16, 0, 0);
}

template <int NWI>
__device__ __forceinline__ void gemm_core(const u16* __restrict__ X, int ldx, const u16* __restrict__ W, int ldw,
                                          int K, f32x4 (&acc)[NWI][4]) {
  const int tid = TIDX, lane = tid & 63, wid = tid >> 6;
  const int wr = wid >> 1, wc = wid & 1, fr = lane & 15, fq = lane >> 4;
#pragma unroll
  for (int a = 0; a < NWI; ++a)
#pragma unroll
    for (int b = 0; b < 4; ++b) acc[a][b] = f32x4{0.f, 0.f, 0.f, 0.f};
  const int srow = tid >> 3, schunk = (tid & 7) ^ ((tid >> 4) & 7);
  const u16* xg = X + (size_t)srow * ldx + schunk * 8;
  const u16* wg = W + (size_t)srow * ldw + schunk * 8;
  const int xs = 32 * ldx, ws_ = 32 * ldw;
  const int g = fr >> 1;
  const int lo0 = fr * 128 + ((fq ^ g) << 4), lo1 = fr * 128 + (((fq ^ g) ^ 4) << 4);
  const char* xb = smem + wr * 8192;
  const char* wb = smem + 16384 + wc * (NWI * 2048);
  char* sdst = smem + tid * 16;
  const int nt = K >> 6;
  __syncthreads();
#pragma unroll
  for (int i = 0; i < 4; ++i) {
    glds16(xg + i * xs, sdst + i * 4096);
    if (i < NWI) glds16(wg + i * ws_, sdst + 16384 + i * 4096);
  }
  for (int kt = 0; kt < nt; ++kt) {
    asm volatile("s_waitcnt vmcnt(0)" ::: "memory");
    __syncthreads();
    const int cb = (kt & 1) * 32768;
    if (kt + 1 < nt) {
      const int nb = 32768 - cb;
      const int ko = (kt + 1) * 64;
#pragma unroll
      for (int i = 0; i < 4; ++i) {
        glds16(xg + i * xs + ko, sdst + nb + i * 4096);
        if (i < NWI) glds16(wg + i * ws_ + ko, sdst + nb + 16384 + i * 4096);
      }
    }
    bf16x8 wf[2][NWI], xf[2][4];
#pragma unroll
    for (int i = 0; i < NWI; ++i) {
      wf[0][i] = *(const bf16x8*)(wb + cb + i * 2048 + lo0);
      wf[1][i] = *(const bf16x8*)(wb + cb + i * 2048 + lo1);
    }
#pragma unroll
    for (int i = 0; i < 4; ++i) {
      xf[0][i] = *(const bf16x8*)(xb + cb + i * 2048 + lo0);
      xf[1][i] = *(const bf16x8*)(xb + cb + i * 2048 + lo1);
    }
    __builtin_amdgcn_sched_barrier(0);
#pragma unroll
    for (int k = 0; k < 2; ++k)
#pragma unroll
      for (int wi = 0; wi < NWI; ++wi)
#pragma unroll
        for (int xi = 0; xi < 4; ++xi)
          acc[wi][xi] = __builtin_amdgcn_mfma_f32_16x16x32_bf16(wf[k][wi], xf[k][xi], acc[wi][xi], 0, 0, 0);
    __builtin_amdgcn_sched_barrier(0);
  }
}

#define EPI_VARS const int tid_ = TIDX, lane_ = tid_ & 63, wid_ = tid_ >> 6; \
  const int wr_ = wid_ >> 1, wc_ = wid_ & 1, fr_ = lane_ & 15, fq_ = lane_ >> 4; (void)fq_; (void)fr_; (void)wr_; (void)wc_;
#define EPI_TR(xi) (wr_ * 64 + (xi) * 16 + fr_)
#define EPI_NN(wi) (wc_ * 64 + (wi) * 16 + fq_ * 4)

template <int NWI>
__device__ __forceinline__ void store_tile_bf16(const uint2 (&o)[NWI][4], u16* dst_wave, size_t ld) {
  constexpr int RB = NWI * 32, CPR = RB / 16;
  const int tid = TIDX, lane = tid & 63, wid = tid >> 6, fr = lane & 15, fq = lane >> 4;
  char* lb = smem + wid * 8192;
#pragma unroll
  for (int wi = 0; wi < NWI; ++wi)
#pragma unroll
    for (int xi = 0; xi < 4; ++xi) {
      const int r = xi * 16 + fr, c = wi * 2 + (fq >> 1);
      *(uint2*)(lb + r * RB + ((c ^ (r & (CPR - 1))) << 4) + (fq & 1) * 8) = o[wi][xi];
    }
#pragma unroll
  for (int it = 0; it < CPR; ++it) {
    const int idx = it * 64 + lane, row = idx / CPR, c = idx % CPR;
    const uint4 v = *(const uint4*)(lb + row * RB + ((c ^ (row & (CPR - 1))) << 4));
    *(uint4*)(dst_wave + (size_t)row * ld + c * 8) = v;
  }
}

__device__ __forceinline__ void tile_order(int t, int MT, int NT, int& mt, int& nt) {
  constexpr int GM = 8;
  const int band = t / (GM * NT), rem = t - band * GM * NT;
  const int m0 = band * GM;
  const int gsz = min(GM, MT - m0);
  nt = rem / gsz; mt = m0 + rem - nt * gsz;
}

__device__ __forceinline__ int mlo(int q, int MT) { return (q * MT) >> 3; }
#define GEMM_CNT(MT, NT) [=](int q_) { return (mlo(q_ + 1, MT) - mlo(q_, MT)) * (NT); }

__device__ __forceinline__ float* xrow_ptr(const Params& p, int g, int r) {
  int bl, pos, isctx; rowinfo(r, NBG, bl, pos, isctx);
  const int b = g * NBG + bl;
  return isctx ? p.xc + ((size_t)b * CTXL + pos) * DM : p.out + ((size_t)b * SEQ + pos) * DM;
}
__device__ __forceinline__ const float* xsrc_row_ptr(const Params& p, int g, int r, int from_input) {
  int bl, pos, isctx; rowinfo(r, NBG, bl, pos, isctx);
  const int b = g * NBG + bl;
  if (from_input) return isctx ? p.in[2] + ((size_t)b * CTXL + pos) * DM : p.in[0] + ((size_t)b * SEQ + pos) * DM;
  return isctx ? p.xc + ((size_t)b * CTXL + pos) * DM : p.out + ((size_t)b * SEQ + pos) * DM;
}
__device__ __forceinline__ int mod_index(const Params& p, int g, int r) {
  int bl, pos, isctx; rowinfo(r, NBG, bl, pos, isctx);
  return isctx ? 8 : g * NBG + bl;
}

__device__ void conv_tile(const float* __restrict__ src, int K, int N, u16* __restrict__ dst,
                          const float* __restrict__ scale, int ktile, int ntile) {
  float* tile = (float*)smem;
  const int tid = TIDX;
  const int k0 = ktile * 64, n0 = ntile * 64;
  const bool valid = n0 < N;
  if (valid) {
    const int kk = tid >> 4, n4 = (tid & 15) * 4;
#pragma unroll
    for (int i = 0; i < 4; ++i) {
      const int k = kk + 16 * i;
      const float4 v = *(const float4*)(src + (size_t)(k0 + k) * N + n0 + n4);
      const float s = scale ? scale[k0 + k] : 1.f;
      tile[k * 65 + n4 + 0] = v.x * s; tile[k * 65 + n4 + 1] = v.y * s;
      tile[k * 65 + n4 + 2] = v.z * s; tile[k * 65 + n4 + 3] = v.w * s;
    }
  }
  __syncthreads();
  const int nn = tid >> 3, k8 = (tid & 7) * 8;
#pragma unroll
  for (int i = 0; i < 2; ++i) {
    const int n = nn + 32 * i;
    uint4 o = make_uint4(0, 0, 0, 0);
    if (valid) {
      o.x = pack2(tile[(k8 + 0) * 65 + n], tile[(k8 + 1) * 65 + n]);
      o.y = pack2(tile[(k8 + 2) * 65 + n], tile[(k8 + 3) * 65 + n]);
      o.z = pack2(tile[(k8 + 4) * 65 + n], tile[(k8 + 5) * 65 + n]);
      o.w = pack2(tile[(k8 + 6) * 65 + n], tile[(k8 + 7) * 65 + n]);
    }
    *(uint4*)(dst + (size_t)(n0 + n) * K + k0 + k8) = o;
  }
}

__device__ void sincos_d(double a, double& s, double& c) {
  const double k = rint(a * 0.6366197723675814);
  double r = fma(-k, 1.5707963267948966, a);
  r = fma(-k, 6.123233995736766e-17, r);
  const int q = ((int)k) & 3;
  const double r2 = r * r;
  const double sp = r * (1.0 + r2 * (-1.0 / 6 + r2 * (1.0 / 120 + r2 * (-1.0 / 5040 + r2 * (1.0 / 362880 + r2 * (-1.0 / 39916800 + r2 * (1.0 / 6227020800.0)))))));
  const double cp = 1.0 + r2 * (-0.5 + r2 * (1.0 / 24 + r2 * (-1.0 / 720 + r2 * (1.0 / 40320 + r2 * (-1.0 / 3628800 + r2 * (1.0 / 479001600.0 + r2 * (-1.0 / 87178291200.0)))))));
  s = (q == 0) ? sp : (q == 1) ? cp : (q == 2) ? -sp : -cp;
  c = (q == 0) ? cp : (q == 1) ? -sp : (q == 2) ? -cp : sp;
}

constexpr int CV_WIN = 0, CV_UQ = 1664, CV_UKV = 1712, CV_BRA = 1744, CV_BRB = 1872, CV_BRC = 2000,
              CV_WO = 2128, CV_GATE = 2384, CV_UP = 3088, CV_DN = 3792, CV_LAYER = 4496;
constexpr int P0_CONV = 2 * CV_LAYER, P0_ADA = 2 * 192, P0_TOTAL = P0_CONV + P0_ADA + 1;

__device__ void phase0(const Params& p, int* ctr) {
  run_q8(ctr, QA_CNT(P0_TOTAL), [&](int q_, int j_) {
    const int it = QA_ID(q_, j_);
    const int tid = TIDX;
    if (it < P0_CONV) {
      const int l = it / CV_LAYER, j = it % CV_LAYER;
      u16* wl = p.wt + (size_t)l * W_LAYER;
      if (j < CV_UQ)       { const int jj = j - CV_WIN;  conv_tile(p.in[7] + (size_t)l * 1024 * INW, 1024, INW, wl + W_IN, nullptr, jj / 104, jj % 104); }
      else if (j < CV_UKV) { const int jj = j - CV_UQ;   conv_tile(p.in[12] + (size_t)l * 256 * 768, 256, 768, wl + W_UQ, p.in[11] + l * 256, jj / 12, jj % 12); }
      else if (j < CV_BRA) { const int jj = j - CV_UKV;  conv_tile(p.in[14] + (size_t)l * 128 * 1024, 128, 1024, wl + W_UKV, p.in[13] + l * 128, jj / 16, jj % 16); }
      else if (j < CV_BRB) { const int jj = j - CV_BRA;  conv_tile(p.in[16] + (size_t)l * 512 * 1024, 512, 1024, wl + W_BRA, nullptr, jj / 16, jj % 16); }
      else if (j < CV_BRC) { const int jj = j - CV_BRB;  conv_tile(p.in[17] + (size_t)l * 512 * 1024, 512, 1024, wl + W_BRB, nullptr, jj / 16, jj % 16); }
      else if (j < CV_WO)  { const int jj = j - CV_BRC;  conv_tile(p.in[18] + (size_t)l * 512 * 1024, 512, 1024, wl + W_BRC, nullptr, jj / 16, jj % 16); }
      else if (j < CV_GATE){ const int jj = j - CV_WO;   conv_tile(p.in[19] + (size_t)l * 1024 * 1024, 1024, 1024, wl + W_O, nullptr, jj / 16, jj % 16); }
      else if (j < CV_UP)  { const int jj = j - CV_GATE; conv_tile(p.in[21] + (size_t)l * 1024 * DFF, 1024, DFF, wl + W_GU, nullptr, jj / 44, jj % 44); }
      else if (j < CV_DN)  { const int jj = j - CV_UP;   conv_tile(p.in[22] + (size_t)l * 1024 * DFF, 1024, DFF, wl + W_GU + (size_t)DFF * 1024, nullptr, jj / 44, jj % 44); }
      else                 { const int jj = j - CV_DN;   conv_tile(p.in[25] + (size_t)l * DFF * 1024, DFF, 1024, wl + W_DN, nullptr, jj / 16, jj % 16); }
    } else if (it < P0_CONV + P0_ADA) {
      const int a = it - P0_CONV, l = a / 192, cg_ = a % 192;
      float* sc = (float*)smem;
      float* red = sc + 9 * 1024;
      for (int e = tid; e < 9 * 1024; e += 256) {
        const int v = e >> 10, k = e & 1023;
        const float cv = (v < 8) ? p.in[1][v * 1024 + k] : p.in[3][k];
        sc[e] = cv / (1.f + expf(-cv));
      }
      __syncthreads();
      const int kg = tid >> 5, cn = tid & 31;
      const float* wa = p.in[4] + (size_t)l * 1024 * 6144 + cg_ * 32 + cn;
      float a0 = 0, a1 = 0, a2 = 0, a3 = 0, a4 = 0, a5 = 0, a6 = 0, a7 = 0, a8 = 0;
#pragma unroll 8
      for (int i = 0; i < 128; ++i) {
        const int k = kg + 8 * i;
        const float w = wa[(size_t)k * 6144];
        a0 += sc[k] * w; a1 += sc[1024 + k] * w; a2 += sc[2048 + k] * w; a3 += sc[3072 + k] * w;
        a4 += sc[4096 + k] * w; a5 += sc[5120 + k] * w; a6 += sc[6144 + k] * w; a7 += sc[7168 + k] * w;
        a8 += sc[8192 + k] * w;
      }
      float* rr = red + kg * 288 + cn;
      rr[0] = a0; rr[32] = a1; rr[64] = a2; rr[96] = a3; rr[128] = a4; rr[160] = a5; rr[192] = a6; rr[224] = a7; rr[256] = a8;
      __syncthreads();
      for (int e = tid; e < 288; e += 256) {
        float s = 0.f;
#pragma unroll
        for (int g8 = 0; g8 < 8; ++g8) s += red[g8 * 288 + e];
        const int v = e >> 5, n = cg_ * 32 + (e & 31);
        p.mod[((size_t)l * 9 + v) * 6144 + n] = s + p.in[5][l * 6144 + n];
      }
    } else {
      for (int e = tid; e < 1024; e += 256) {
        const int pos = e >> 3, f = e & 7;
        const float inv = (f == 0) ? 1.0f : (f == 1) ? 0.31622776601683794f : (f == 2) ? 0.1f : (f == 3) ? 0.031622776601683794f
                        : (f == 4) ? 0.01f : (f == 5) ? 0.0031622776601683794f : (f == 6) ? 0.001f : 0.00031622776601683794f;
        const float ang = (float)pos * inv;
        double s, c; sincos_d((double)ang, s, c);
        p.rope[e * 2] = (float)c; p.rope[e * 2 + 1] = (float)s;
      }
    }
  });
}

__device__ void phase_norm(const Params& p, int l, int g, int which, int* ctr) {
  const int nitems = (which == 1 && l == 1) ? NBG * SEQ / 16 : RG / 16;
  const float* gam = (which == 0 ? p.in[6] : p.in[20]) + l * DM;
  const int shoff = which == 0 ? 0 : 3072, scoff = which == 0 ? 1024 : 4096;
  const int from_input = (which == 0 && l == 0);
  for (int it = blockIdx.x; it < nitems; it += gridDim.x) {
    const int lane = TIDX & 63, wid = TIDX >> 6;
    const int r0 = it * 16 + wid * 4;
    const float* xr = xsrc_row_ptr(p, g, r0, from_input);
    const float* mrow = p.mod + ((size_t)l * 9 + mod_index(p, g, r0)) * 6144;
    float4 v[4][4], gg[4], sh[4], sc[4];
#pragma unroll
    for (int rr = 0; rr < 4; ++rr)
#pragma unroll
      for (int i = 0; i < 4; ++i) v[rr][i] = *(const float4*)(xr + (size_t)rr * DM + lane * 4 + i * 256);
#pragma unroll
    for (int i = 0; i < 4; ++i) {
      const int c = lane * 4 + i * 256;
      gg[i] = *(const float4*)(gam + c); sh[i] = *(const float4*)(mrow + shoff + c); sc[i] = *(const float4*)(mrow + scoff + c);
    }
#pragma unroll
    for (int rr = 0; rr < 4; ++rr) {
      float ss = 0.f;
#pragma unroll
      for (int i = 0; i < 4; ++i)
        ss += v[rr][i].x * v[rr][i].x + v[rr][i].y * v[rr][i].y + v[rr][i].z * v[rr][i].z + v[rr][i].w * v[rr][i].w;
      ss = wave_sum(ss);
      const float rstd = rsqrtf(ss * (1.f / 1024.f) + EPS);
#pragma unroll
      for (int i = 0; i < 4; ++i) {
        const int c = lane * 4 + i * 256;
        uint2 o;
        o.x = pack2(v[rr][i].x * rstd * gg[i].x * (1.f + sc[i].x) + sh[i].x, v[rr][i].y * rstd * gg[i].y * (1.f + sc[i].y) + sh[i].y);
        o.y = pack2(v[rr][i].z * rstd * gg[i].z * (1.f + sc[i].z) + sh[i].z, v[rr][i].w * rstd * gg[i].w * (1.f + sc[i].w) + sh[i].w);
        *(uint2*)(p.h + (size_t)(r0 + rr) * DM + c) = o;
      }
    }
  }
}

__device__ void phase_proj(const Params& p, int l, int* ctr) {
  const int MT = RG / 128, NT = INWP / 128;
  const u16* W = p.wt + (size_t)l * W_LAYER + W_IN;
  run_q8(ctr, GEMM_CNT(MT, NT), [&](int q_, int j_) {
    int mt, nt; tile_order(j_, mlo(q_ + 1, MT) - mlo(q_, MT), NT, mt, nt); mt += mlo(q_, MT);
    f32x4 acc[4][4];
    gemm_core<4>(p.h + (size_t)mt * 128 * DM, DM, W + (size_t)nt * 128 * DM, DM, DM, acc);
    EPI_VARS
    uint2 o[4][4];
#pragma unroll
    for (int wi = 0; wi < 4; ++wi)
#pragma unroll
      for (int xi = 0; xi < 4; ++xi) {
        o[wi][xi].x = pack2(acc[wi][xi][0], acc[wi][xi][1]); o[wi][xi].y = pack2(acc[wi][xi][2], acc[wi][xi][3]);
      }
    if (nt * 128 + wc_ * 64 < INW)
      store_tile_bf16<4>(o, p.proj + (size_t)(mt * 128 + wr_ * 64) * INW + nt * 128 + wc_ * 64, INW);
  });
}

__device__ void postproj_rows(const Params& p, int l, int it) {
  const int lane = TIDX & 63, wid = TIDX >> 6;
  const float* scw = p.in[15] + (size_t)l * 3 * 512;
  for (int rr = 0; rr < 4; ++rr) {
    const int r = it * 16 + wid * 4 + rr;
    int bl, pos, isctx; rowinfo(r, NBG, bl, pos, isctx);
    const u16* pr = p.proj + (size_t)r * INW;
    const int Lr = isctx ? CTXL : SEQ;
    const int c0 = lane * 8;
    const uint2 u_cq = *(const uint2*)(pr + C_CQ + lane * 4);
    const unsigned u_ckv = *(const unsigned*)(pr + C_CKV + lane * 2);
    const u16 u_kr = pr[C_KR + (lane & 31)];
    const uint4 sb = *(const uint4*)(pr + C_SB + c0);
    const uint4 sc1 = *(const uint4*)(pr + C_SC + c0);
    const uint4 sx1 = *(const uint4*)(pr + C_SX + c0);
    uint4 sc0 = make_uint4(0, 0, 0, 0), sx0 = sc0, sc2 = sc0, sx2 = sc0;
    if (pos > 0) { sc0 = *(const uint4*)(pr - INW + C_SC + c0); sx0 = *(const uint4*)(pr - INW + C_SX + c0); }
    if (pos < Lr - 1) { sc2 = *(const uint4*)(pr + INW + C_SC + c0); sx2 = *(const uint4*)(pr + INW + C_SX + c0); }
    {
      const uint2 u = u_cq;
      const float a = bflo(u.x), b = bfhi(u.x), c = bflo(u.y), d = bfhi(u.y);
      float ss = wave_sum(a * a + b * b + c * c + d * d);
      if (lane == 0) p.rstdq[r] = rsqrtf(ss * (1.f / 256.f) + EPS);
    }
    {
      const unsigned u = u_ckv;
      const float a = bflo(u), b = bfhi(u);
      float ss = wave_sum(a * a + b * b);
      if (lane == 0) p.rstdkv[r] = rsqrtf(ss * (1.f / 128.f) + EPS);
    }
    {
      const int idx = lane & 31;
      const float val = bf2f(u_kr);
      const float partner = __shfl_xor(val, 8);
      float o = val;
      if (!isctx) {
        const int axis = idx >> 4, half = (idx >> 3) & 1, f = idx & 7;
        const int pa = axis ? (pos & 63) : (pos >> 6);
        const float c = p.rope[(pa * 8 + f) * 2], s = p.rope[(pa * 8 + f) * 2 + 1];
        o = half ? (val * c + partner * s) : (val * c - partner * s);
      }
      const int j = isctx ? SEQ + pos : pos;
      const u16 ob = f2bf(o);
      if (lane < 32) {
#pragma unroll
        for (int hd = 0; hd < 8; ++hd)
          p.kf[((size_t)(bl * 8 + hd) * NKEY + j) * 96 + 64 + idx] = ob;
      }
    }
    {
      const float4 w0a = *(const float4*)(scw + c0), w0b = *(const float4*)(scw + c0 + 4);
      const float4 w1a = *(const float4*)(scw + 512 + c0), w1b = *(const float4*)(scw + 512 + c0 + 4);
      const float4 w2a = *(const float4*)(scw + 1024 + c0), w2b = *(const float4*)(scw + 1024 + c0 + 4);
      uint4 o;
#define UC2(SBW, A0, X0, A1, X1, A2, X2, W0L, W0H, W1L, W1H, W2L, W2H) \
      pack2(bflo(SBW) * (W0L * bflo(A0) * bflo(X0) + W1L * bflo(A1) * bflo(X1) + W2L * bflo(A2) * bflo(X2)), \
            bfhi(SBW) * (W0H * bfhi(A0) * bfhi(X0) + W1H * bfhi(A1) * bfhi(X1) + W2H * bfhi(A2) * bfhi(X2)))
      o.x = UC2(sb.x, sc0.x, sx0.x, sc1.x, sx1.x, sc2.x, sx2.x, w0a.x, w0a.y, w1a.x, w1a.y, w2a.x, w2a.y);
      o.y = UC2(sb.y, sc0.y, sx0.y, sc1.y, sx1.y, sc2.y, sx2.y, w0a.z, w0a.w, w1a.z, w1a.w, w2a.z, w2a.w);
      o.z = UC2(sb.z, sc0.z, sx0.z, sc1.z, sx1.z, sc2.z, sx2.z, w0b.x, w0b.y, w1b.x, w1b.y, w2b.x, w2b.y);
      o.w = UC2(sb.w, sc0.w, sx0.w, sc1.w, sx1.w, sc2.w, sx2.w, w0b.z, w0b.w, w1b.z, w1b.w, w2b.z, w2b.w);
#undef UC2
      *(uint4*)(p.uc + (size_t)r * 512 + c0) = o;
    }
  }
}

__device__ __forceinline__ float logsig16(float z) {
  return (fminf(z, 0.f) - log1pf(__expf(-fabsf(z)))) * (1.f / 16.f);
}

__device__ void gla_prep(const Params& p, int l, int it) {
  const int tid = TIDX, lane = tid & 63, wid = tid >> 6;
  const int bl = it / (NCHUNK * 4), rem = it % (NCHUNK * 4), cidx = rem >> 2, h = rem & 3;
  const int r0 = chunk_row(bl, cidx, NBG);
  float* lr = (float*)smem;
  float* tot = (float*)(smem + 8192);
  u16* vT = (u16*)(smem + 10752);
  u16* kTf = (u16*)(smem + 29184);
  u16* kTb = (u16*)(smem + 38400);
  {
    const int t = tid >> 2, c8 = (tid & 3) * 8;
    const uint4 u = *(const uint4*)(p.proj + (size_t)(r0 + t) * INW + C_ALR + c8);
    float* d = lr + t * 32 + c8;
    d[0] = bflo(u.x); d[1] = bfhi(u.x); d[2] = bflo(u.y); d[3] = bfhi(u.y);
    d[4] = bflo(u.z); d[5] = bfhi(u.z); d[6] = bflo(u.w); d[7] = bfhi(u.w);
    const int dvc = (tid & 3) * 32;
    const u16* vp = p.proj + (size_t)(r0 + t) * INW + C_VA + h * 128 + dvc;
#pragma unroll
    for (int i = 0; i < 4; ++i) {
      const uint4 vv = *(const uint4*)(vp + i * 8);
      u16* dst = vT + (size_t)(dvc + i * 8) * 72 + t;
      dst[0] = (u16)(vv.x & 0xffff); dst[72] = (u16)(vv.x >> 16);
      dst[144] = (u16)(vv.y & 0xffff); dst[216] = (u16)(vv.y >> 16);
      dst[288] = (u16)(vv.z & 0xffff); dst[360] = (u16)(vv.z >> 16);
      dst[432] = (u16)(vv.w & 0xffff); dst[504] = (u16)(vv.w >> 16);
    }
  }
  __syncthreads();
  const int dk = lane, tg = wid;
  const float* w2f = p.in[8] + ((size_t)(l * 2 + 0) * 16) * 256 + h * 64 + dk;
  const float* w2b = p.in[8] + ((size_t)(l * 2 + 1) * 16) * 256 + h * 64 + dk;
  float wf[16], wb[16];
#pragma unroll
  for (int r = 0; r < 16; ++r) { wf[r] = w2f[r * 256]; wb[r] = w2b[r * 256]; }
  const float biasf = p.in[9][(l * 2 + 0) * 256 + h * 64 + dk];
  const float biasb = p.in[9][(l * 2 + 1) * 256 + h * 64 + dk];
  float pf[16], sbk[16];
#pragma unroll
  for (int i = 0; i < 16; ++i) {
    const float* lrow = lr + (tg * 16 + i) * 32;
    float zf = biasf, zb = biasb;
#pragma unroll
    for (int r = 0; r < 16; ++r) { zf += lrow[r] * wf[r]; zb += lrow[16 + r] * wb[r]; }
    pf[i] = logsig16(zf); sbk[i] = logsig16(zb);
  }
#pragma unroll
  for (int i = 1; i < 16; ++i) pf[i] += pf[i - 1];
#pragma unroll
  for (int i = 14; i >= 0; --i) sbk[i] += sbk[i + 1];
  tot[tg * 64 + dk] = pf[15];
  tot[256 + tg * 64 + dk] = sbk[0];
  __syncthreads();
  float offf = 0.f, offb = 0.f, bfl = 0.f, bb0 = 0.f;
#pragma unroll
  for (int g4 = 0; g4 < 4; ++g4) {
    const float a = tot[g4 * 64 + dk], b = tot[256 + g4 * 64 + dk];
    bfl += a; bb0 += b;
    if (g4 < tg) offf += a;
    if (g4 > tg) offb += b;
  }
  u16* gqf = p.gq;
  u16* gkf = p.gq + (size_t)RG * 256;
  u16* gqb = p.gq + (size_t)RG * 512;
  u16* gkb = p.gq + (size_t)RG * 768;
  unsigned kfp[8], kbp[8];
#pragma unroll
  for (int i = 0; i < 16; ++i) {
    const int t = tg * 16 + i;
    const float bfv = offf + pf[i], bbv = offb + sbk[i];
    const float qv = bf2f(p.proj[(size_t)(r0 + t) * INW + C_QA + h * 64 + dk]);
    const float kv = bf2f(p.proj[(size_t)(r0 + t) * INW + C_KA + h * 64 + dk]);
    const size_t go = (size_t)(r0 + t) * 256 + h * 64 + dk;
    gqf[go] = f2bf(qv * __expf(bfv) * 0.125f);
    gkf[go] = f2bf(kv * __expf(-bfv));
    gqb[go] = f2bf(qv * __expf(bbv) * 0.125f);
    gkb[go] = f2bf(kv * __expf(-bbv));
    const u16 ksf = f2bf(kv * __expf(bfl - bfv));
    const u16 ksb = f2bf(kv * __expf(bb0 - bbv));
    if (i & 1) { kfp[i >> 1] |= ((unsigned)ksf) << 16; kbp[i >> 1] |= ((unsigned)ksb) << 16; }
    else { kfp[i >> 1] = ksf; kbp[i >> 1] = ksb; }
  }
  *(uint4*)(kTf + dk * 72 + tg * 16) = make_uint4(kfp[0], kfp[1], kfp[2], kfp[3]);
  *(uint4*)(kTf + dk * 72 + tg * 16 + 8) = make_uint4(kfp[4], kfp[5], kfp[6], kfp[7]);
  *(uint4*)(kTb + dk * 72 + tg * 16) = make_uint4(kbp[0], kbp[1], kbp[2], kbp[3]);
  *(uint4*)(kTb + dk * 72 + tg * 16 + 8) = make_uint4(kbp[4], kbp[5], kbp[6], kbp[7]);
  const size_t cb = ((size_t)(bl * NCHUNK + cidx) * 4 + h) * 2;
  if (tg == 0) {
    p.dec[(cb + 0) * 64 + dk] = __expf(bfl);
    p.dec[(cb + 1) * 64 + dk] = __expf(bb0);
  }
  __syncthreads();
  const int l31 = lane & 31, hh = lane >> 5;
  float* U = (float*)p.h;
#pragma unroll
  for (int dir = 0; dir < 2; ++dir) {
    const u16* kT = dir ? kTb : kTf;
#pragma unroll
    for (int dkt = 0; dkt < 2; ++dkt) {
      f32x16 acc;
#pragma unroll
      for (int e = 0; e < 16; ++e) acc[e] = 0.f;
#pragma unroll
      for (int s = 0; s < 4; ++s) {
        const bf16x8 a = *(const bf16x8*)(vT + (32 * wid + l31) * 72 + 16 * s + 8 * hh);
        const bf16x8 b = *(const bf16x8*)(kT + (32 * dkt + l31) * 72 + 16 * s + 8 * hh);
        acc = __builtin_amdgcn_mfma_f32_32x32x16_bf16(a, b, acc, 0, 0, 0);
      }
      float* up = U + (cb + dir) * 8192;
#pragma unroll
      for (int e = 0; e < 16; ++e) {
        const int dv = 32 * wid + (e & 3) + 8 * (e >> 2) + 4 * hh;
        up[dv * 64 + 32 * dkt + l31] = acc[e];
      }
    }
  }
}

__device__ void phase_postproj(const Params& p, int l, int* ctr) {
  const int n_prep = NBG * NCHUNK * 4, n_rows = RG / 16;
  run_q8(ctr, QA_CNT(n_prep + n_rows), [&](int q_, int j_) {
    const int it = QA_ID(q_, j_);
    if (it < n_prep) gla_prep(p, l, it);
    else postproj_rows(p, l, it - n_prep);
  });
}

__device__ void gla_scan(const Params& p, int it) {
  const int tid = TIDX;
  const int sl = it & 7, dir = (it >> 3) & 1, h = (it >> 4) & 3, bl = it >> 6;
  const int e0 = sl * 1024 + tid * 4;
  const int dk = e0 & 63;
  const float* U = (const float*)p.h;
  f32x4 S = {0.f, 0.f, 0.f, 0.f};
  for (int s0 = 0; s0 < NCHUNK; s0 += 12) {
    f32x4 u4[12], d4[12];
#pragma unroll
    for (int j = 0; j < 12; ++j) {
      const int step = s0 + j;
      const int cidx = dir ? (NCHUNK - 1 - step) : (step < 4 ? 128 + step : step - 4);
      const size_t base = ((size_t)(bl * NCHUNK + cidx) * 4 + h) * 2 + dir;
      u4[j] = *(const f32x4*)(U + base * 8192 + e0);
      d4[j] = *(const f32x4*)(p.dec + base * 64 + dk);
    }
#pragma unroll
    for (int j = 0; j < 12; ++j) {
      const int step = s0 + j;
      const int cidx = dir ? (NCHUNK - 1 - step) : (step < 4 ? 128 + step : step - 4);
      const size_t base = ((size_t)(bl * NCHUNK + cidx) * 4 + h) * 2 + dir;
      uint2 o; o.x = pack2(S[0], S[1]); o.y = pack2(S[2], S[3]);
      *(uint2*)(p.ss + base * 8192 + e0) = o;
      S = d4[j] * S + u4[j];
    }
  }
}

__device__ void q_tile(const Params& p, int l, int t) {
  const int MT = RG / 128;
  const int nt = t / MT, mt = t % MT;
  f32x4 acc[4][4];
  gemm_core<4>(p.proj + (size_t)mt * 128 * INW + C_CQ, INW, p.wt + (size_t)l * W_LAYER + W_UQ + (size_t)nt * 128 * 256, 256, 256, acc);
  EPI_VARS
  const float QS = 0.10206207261596577f * 1.4426950408889634f;
  int bl, pos0, isctx; rowinfo(mt * 128, NBG, bl, pos0, isctx);
  float rsq[4];
  uint2 qo[4][4];
#pragma unroll
  for (int xi = 0; xi < 4; ++xi) rsq[xi] = p.rstdq[mt * 128 + EPI_TR(xi)] * QS;
#pragma unroll
  for (int xi = 0; xi < 4; ++xi) {
    const int tr = EPI_TR(xi), r = mt * 128 + tr, pos = pos0 + tr;
    const float rs = rsq[xi];
#pragma unroll
    for (int wi = 0; wi < 4; ++wi) {
      const int n16 = (nt * 128 + wc_ * 64 + wi * 16) >> 4;
      const int m6 = n16 % 6;
      float v0 = acc[wi][xi][0] * rs, v1 = acc[wi][xi][1] * rs, v2 = acc[wi][xi][2] * rs, v3 = acc[wi][xi][3] * rs;
      if (m6 >= 4 && !isctx) {
        const float p0 = __shfl_xor(v0, 32), p1 = __shfl_xor(v1, 32), p2 = __shfl_xor(v2, 32), p3 = __shfl_xor(v3, 32);
        const int pa = (m6 == 5) ? (pos & 63) : (pos >> 6);
        const int f0 = (fq_ & 1) * 4;
        const float* rp = p.rope + (pa * 8 + f0) * 2;
        const float4 cs01 = *(const float4*)rp, cs23 = *(const float4*)(rp + 4);
        const float sg = (fq_ >= 2) ? 1.f : -1.f;
        v0 = v0 * cs01.x + sg * p0 * cs01.y;
        v1 = v1 * cs01.z + sg * p1 * cs01.w;
        v2 = v2 * cs23.x + sg * p2 * cs23.y;
        v3 = v3 * cs23.z + sg * p3 * cs23.w;
      }
      qo[wi][xi].x = pack2(v0, v1); qo[wi][xi].y = pack2(v2, v3);
    }
  }
  store_tile_bf16<4>(qo, p.q + (size_t)(mt * 128 + wr_ * 64) * 768 + nt * 128 + wc_ * 64, 768);
}

__device__ void kv_tile(const Params& p, int l, int t) {
  const int MT = RG / 128;
  const int nt = t / MT, mt = t % MT;
  f32x4 acc[4][4];
  gemm_core<4>(p.proj + (size_t)mt * 128 * INW + C_CKV, INW, p.wt + (size_t)l * W_LAYER + W_UKV + (size_t)nt * 128 * 128, 128, 128, acc);
  EPI_VARS
  int bl, pos0, isctx; rowinfo(mt * 128, NBG, bl, pos0, isctx);
  const int j0 = isctx ? SEQ + pos0 : pos0;
  float rskv[4];
#pragma unroll
  for (int xi = 0; xi < 4; ++xi) rskv[xi] = p.rstdkv[mt * 128 + EPI_TR(xi)];
#pragma unroll
  for (int xi = 0; xi < 4; ++xi) {
    const int tr = EPI_TR(xi), r = mt * 128 + tr, j = j0 + tr;
    const float rs = rskv[xi];
#pragma unroll
    for (int wi = 0; wi < 4; ++wi) {
      const int wn = EPI_NN(wi);
      const float v0 = acc[wi][xi][0] * rs, v1 = acc[wi][xi][1] * rs, v2 = acc[wi][xi][2] * rs, v3 = acc[wi][xi][3] * rs;
      if (wc_ == 0) {
        uint2 o; o.x = pack2(v0, v1); o.y = pack2(v2, v3);
        *(uint2*)(p.kf + ((size_t)(bl * 8 + nt) * NKEY + j) * 96 + wn) = o;
      } else {
        u16* vp = p.vt + ((size_t)(bl * 8 + nt) * 64 + (wn - 64)) * NKEY + j;
        vp[0] = f2bf(v0); vp[NKEY] = f2bf(v1); vp[2 * NKEY] = f2bf(v2); vp[3 * NKEY] = f2bf(v3);
      }
    }
  }
}

__device__ void phase_qkv(const Params& p, int l, int* ctr) {
  const int MT = RG / 128;
  const int n_scan = NBG * 64, n_q = MT * 6, n_kv = MT * 8;
  run_q8(ctr, QA_CNT(n_scan + n_q + n_kv), [&](int q_, int j_) {
    const int it = QA_ID(q_, j_);
    if (it < n_scan) gla_scan(p, it);
    else if (it < n_scan + n_q) q_tile(p, l, it - n_scan);
    else kv_tile(p, l, it - n_scan - n_q);
  });
}

__device__ __forceinline__ bf16x8 pack8(const f32x16& a, int o) {
  union { bf16x8 v; unsigned u[4]; } r;
  r.u[0] = pack2(a[o + 0], a[o + 1]); r.u[1] = pack2(a[o + 2], a[o + 3]);
  r.u[2] = pack2(a[o + 4], a[o + 5]); r.u[3] = pack2(a[o + 6], a[o + 7]);
  return r.v;
}
__device__ __forceinline__ bf16x8 ld2x8(const u16* p0) {
  union { bf16x8 v; uint2 u[2]; } r;
  r.u[0] = *(const uint2*)p0; r.u[1] = *(const uint2*)(p0 + 8);
  return r.v;
}

__device__ void attn_item(const Params& p, int it) {
  const int tid = TIDX, lane = tid & 63, wid = tid >> 6, l31 = lane & 31, hh = lane >> 5;
  const int qb = it % 66, bh = it / 66, h = bh & 7, bl = bh >> 3;
  const int r0 = qb < 64 ? bl * SEQ + qb * 128 : NBG * SEQ + bl * CTXL + (qb - 64) * 128;
  const int kt0 = qb < 64 ? 0 : 128;
  const int nkt = NCHUNK - kt0;
  constexpr int KROW = 208, VROW = 144, BUFB = 64 * KROW + 64 * VROW;
  bf16x8 qf[6];
  {
    const u16* qp = p.q + (size_t)(r0 + 32 * wid + l31) * 768 + h * 96 + 8 * hh;
#pragma unroll
    for (int s = 0; s < 6; ++s) qf[s] = *(const bf16x8*)(qp + 16 * s);
  }
  const u16* kbase = p.kf + (size_t)bh * NKEY * 96;
  const u16* vbase = p.vt + (size_t)bh * 64 * NKEY;
  uint4 kr0, kr1, kr2, vr0, vr1;
  const int kdst0 = (tid / 12) * KROW + (tid % 12) * 16;
  const int kdst1 = ((tid + 256) / 12) * KROW + ((tid + 256) % 12) * 16;
  const int kdst2 = ((tid + 512) / 12) * KROW + ((tid + 512) % 12) * 16;
  const int vdst0 = 64 * KROW + (tid >> 3) * VROW + (tid & 7) * 16;
  const int vdst1 = vdst0 + 32 * VROW;
  const int vsrc0 = (tid >> 3) * NKEY + (tid & 7) * 8;
  const int vsrc1 = vsrc0 + 32 * NKEY;
  {
    const u16* kp = kbase + (size_t)kt0 * 64 * 96 + tid * 8;
    kr0 = *(const uint4*)(kp); kr1 = *(const uint4*)(kp + 2048); kr2 = *(const uint4*)(kp + 4096);
    vr0 = *(const uint4*)(vbase + vsrc0 + kt0 * 64); vr1 = *(const uint4*)(vbase + vsrc1 + kt0 * 64);
    *(uint4*)(smem + kdst0) = kr0; *(uint4*)(smem + kdst1) = kr1; *(uint4*)(smem + kdst2) = kr2;
    *(uint4*)(smem + vdst0) = vr0; *(uint4*)(smem + vdst1) = vr1;
  }
  __builtin_amdgcn_s_waitcnt(0x0F70);
  __syncthreads();
  f32x16 oacc[2];
#pragma unroll
  for (int e = 0; e < 16; ++e) { oacc[0][e] = 0.f; oacc[1][e] = 0.f; }
  float m_run = -1e30f, l_run = 0.f;
  for (int t = 0; t < nkt; ++t) {
    const int cur = t & 1;
    {
      const int tn = kt0 + min(t + 1, nkt - 1);
      const u16* kp = kbase + (size_t)tn * 64 * 96 + tid * 8;
      kr0 = *(const uint4*)(kp); kr1 = *(const uint4*)(kp + 2048); kr2 = *(const uint4*)(kp + 4096);
      vr0 = *(const uint4*)(vbase + vsrc0 + tn * 64); vr1 = *(const uint4*)(vbase + vsrc1 + tn * 64);
    }
    __builtin_amdgcn_sched_barrier(0);
    const char* Kl = smem + cur * BUFB;
    const char* Vl = Kl + 64 * KROW;
    f32x16 sacc[2];
#pragma unroll
    for (int kb = 0; kb < 2; ++kb) {
#pragma unroll
      for (int e = 0; e < 16; ++e) sacc[kb][e] = 0.f;
#pragma unroll
      for (int s = 0; s < 6; ++s) {
        const bf16x8 a = *(const bf16x8*)(Kl + (32 * kb + l31) * KROW + 32 * s + 16 * hh);
        sacc[kb] = __builtin_amdgcn_mfma_f32_32x32x16_bf16(a, qf[s], sacc[kb], 0, 0, 0);
      }
    }
    float mx = sacc[0][0];
#pragma unroll
    for (int e = 1; e < 16; ++e) mx = fmaxf(mx, sacc[0][e]);
#pragma unroll
    for (int e = 0; e < 16; ++e) mx = fmaxf(mx, sacc[1][e]);
    {
      const unsigned mu = __float_as_uint(mx);
      const auto sw = __builtin_amdgcn_permlane32_swap(mu, mu, false, false);
      mx = fmaxf(__uint_as_float(sw[0]), __uint_as_float(sw[1]));
    }
    if (!__all(mx - m_run <= 8.f)) {
      const float m_new = fmaxf(m_run, mx);
      const float alpha = __builtin_amdgcn_exp2f(m_run - m_new);
      m_run = m_new;
      l_run *= alpha;
#pragma unroll
      for (int e = 0; e < 16; ++e) { oacc[0][e] *= alpha; oacc[1][e] *= alpha; }
    }
    float ps = 0.f;
#pragma unroll
    for (int kb = 0; kb < 2; ++kb)
#pragma unroll
      for (int e = 0; e < 16; ++e) { const float pv = __builtin_amdgcn_exp2f(sacc[kb][e] - m_run); sacc[kb][e] = pv; ps += pv; }
    l_run += ps;
#pragma unroll
    for (int kb = 0; kb < 2; ++kb)
#pragma unroll
      for (int s2 = 0; s2 < 2; ++s2) {
        const bf16x8 pfr = pack8(sacc[kb], 8 * s2);
#pragma unroll
        for (int dt = 0; dt < 2; ++dt) {
          const bf16x8 a = ld2x8((const u16*)(Vl + (32 * dt + l31) * VROW) + 32 * kb + 16 * s2 + 4 * hh);
          oacc[dt] = __builtin_amdgcn_mfma_f32_32x32x16_bf16(a, pfr, oacc[dt], 0, 0, 0);
        }
      }
    __builtin_amdgcn_sched_barrier(0);
    {
      char* nb = smem + (cur ^ 1) * BUFB;
      *(uint4*)(nb + kdst0) = kr0; *(uint4*)(nb + kdst1) = kr1; *(uint4*)(nb + kdst2) = kr2;
      *(uint4*)(nb + vdst0) = vr0; *(uint4*)(nb + vdst1) = vr1;
    }
    __syncthreads();
  }
  l_run += __shfl_xor(l_run, 32);
  const float inv = 1.f / l_run;
  u16* op = p.h + (size_t)RG * 512 + (size_t)(r0 + 32 * wid + l31) * 512 + h * 64;
#pragma unroll
  for (int dt = 0; dt < 2; ++dt)
#pragma unroll
    for (int gq_ = 0; gq_ < 4; ++gq_) {
      const int dv0 = 32 * dt + 8 * gq_ + 4 * hh;
      uint2 o;
      o.x = pack2(oacc[dt][4 * gq_ + 0] * inv, oacc[dt][4 * gq_ + 1] * inv);
      o.y = pack2(oacc[dt][4 * gq_ + 2] * inv, oacc[dt][4 * gq_ + 3] * inv);
      *(uint2*)(op + dv0) = o;
    }
}

__device__ void gla_out(const Params& p, int l, int it) {
  const int tid = TIDX, lane = tid & 63, wid = tid >> 6, l31 = lane & 31, hh = lane >> 5;
  const int bl = it / (NCHUNK * 4), rem = it % (NCHUNK * 4), cidx = rem >> 2, h = rem & 3;
  const int r0 = chunk_row(bl, cidx, NBG);
  u16* tiles = (u16*)smem;
  u16* vT = (u16*)(smem + 36864);
  float* part = (float*)(smem + 55296);
  {
    const int t = tid >> 2, c16 = (tid & 3) * 16;
#pragma unroll
    for (int a = 0; a < 4; ++a) {
      const u16* src = p.gq + (size_t)a * RG * 256 + (size_t)(r0 + t) * 256 + h * 64 + c16;
      const uint4 u0 = *(const uint4*)src, u1 = *(const uint4*)(src + 8);
      u16* d = tiles + a * 4608 + t * 72 + c16;
      *(uint4*)d = u0; *(uint4*)(d + 8) = u1;
    }
    const int dvc = (tid & 3) * 32;
    const u16* vp = p.proj + (size_t)(r0 + t) * INW + C_VA + h * 128 + dvc;
#pragma unroll
    for (int i = 0; i < 4; ++i) {
      const uint4 vv = *(const uint4*)(vp + i * 8);
      u16* dst = vT + (size_t)(dvc + i * 8) * 72 + t;
      dst[0] = (u16)(vv.x & 0xffff); dst[72] = (u16)(vv.x >> 16);
      dst[144] = (u16)(vv.y & 0xffff); dst[216] = (u16)(vv.y >> 16);
      dst[288] = (u16)(vv.z & 0xffff); dst[360] = (u16)(vv.z >> 16);
      dst[432] = (u16)(vv.w & 0xffff); dst[504] = (u16)(vv.w >> 16);
    }
  }
  const int itl = wid & 1, dvh = wid >> 1;
  const size_t cb = ((size_t)(bl * NCHUNK + cidx) * 4 + h) * 2;
  bf16x8 sfr[2][2][4];
#pragma unroll
  for (int dir = 0; dir < 2; ++dir)
#pragma unroll
    for (int dt = 0; dt < 2; ++dt)
#pragma unroll
      for (int s4 = 0; s4 < 4; ++s4)
        sfr[dir][dt][s4] = *(const bf16x8*)(p.ss + (cb + dir) * 8192 + (64 * dvh + 32 * dt + l31) * 64 + 16 * s4 + 8 * hh);
  __syncthreads();
  f32x16 oacc[2];
#pragma unroll
  for (int e = 0; e < 16; ++e) { oacc[0][e] = 0.f; oacc[1][e] = 0.f; }
#pragma unroll
  for (int dir = 0; dir < 2; ++dir) {
    const u16* Qt = tiles + (dir * 2) * 4608;
    const u16* Kt = tiles + (dir * 2 + 1) * 4608;
    bf16x8 qfr[4];
#pragma unroll
    for (int s = 0; s < 4; ++s) qfr[s] = *(const bf16x8*)(Qt + (32 * itl + l31) * 72 + 16 * s + 8 * hh);
    f32x16 aacc[2];
#pragma unroll
    for (int jt = 0; jt < 2; ++jt) {
#pragma unroll
      for (int e = 0; e < 16; ++e) aacc[jt][e] = 0.f;
#pragma unroll
      for (int s = 0; s < 4; ++s) {
        const bf16x8 a = *(const bf16x8*)(Kt + (32 * jt + l31) * 72 + 16 * s + 8 * hh);
        aacc[jt] = __builtin_amdgcn_mfma_f32_32x32x16_bf16(a, qfr[s], aacc[jt], 0, 0, 0);
      }
      const int i_tok = 32 * itl + l31;
#pragma unroll
      for (int e = 0; e < 16; ++e) {
        const int j_tok = 32 * jt + (e & 3) + 8 * (e >> 2) + 4 * hh;
        const bool keep = dir ? (j_tok >= i_tok) : (j_tok <= i_tok);
        if (!keep) aacc[jt][e] = 0.f;
      }
    }
#pragma unroll
    for (int dt = 0; dt < 2; ++dt) {
      const int dvrow = 64 * dvh + 32 * dt + l31;
#pragma unroll
      for (int jt = 0; jt < 2; ++jt)
#pragma unroll
        for (int s2 = 0; s2 < 2; ++s2) {
          const bf16x8 pfr = pack8(aacc[jt], 8 * s2);
          const bf16x8 a = ld2x8(vT + dvrow * 72 + 32 * jt + 16 * s2 + 4 * hh);
          oacc[dt] = __builtin_amdgcn_mfma_f32_32x32x16_bf16(a, pfr, oacc[dt], 0, 0, 0);
        }
#pragma unroll
      for (int s = 0; s < 4; ++s) {
        oacc[dt] = __builtin_amdgcn_mfma_f32_32x32x16_bf16(sfr[dir][dt][s], qfr[s], oacc[dt], 0, 0, 0);
      }
    }
  }
  float ss = 0.f;
#pragma unroll
  for (int e = 0; e < 16; ++e) ss += oacc[0][e] * oacc[0][e] + oacc[1][e] * oacc[1][e];
  ss += __shfl_xor(ss, 32);
  if (hh == 0) part[wid * 32 + l31] = ss;
  __syncthreads();
  const float totss = part[wid * 32 + l31] + part[(wid ^ 2) * 32 + l31];
  const float rstd = rsqrtf(totss * (1.f / 128.f) + EPS);
  const int r = r0 + 32 * itl + l31;
  const float* gam = p.in[10] + l * 512 + h * 128;
  u16* aa = p.h;
#pragma unroll
  for (int dt = 0; dt < 2; ++dt)
#pragma unroll
    for (int gq_ = 0; gq_ < 4; ++gq_) {
      const int dv0 = 64 * dvh + 32 * dt + 8 * gq_ + 4 * hh;
      const uint2 ra = *(const uint2*)(p.proj + (size_t)r * INW + C_RA + h * 128 + dv0);
      const float4 g4 = *(const float4*)(gam + dv0);
      uint2 o;
      o.x = pack2(oacc[dt][4 * gq_ + 0] * rstd * g4.x * silu_f(bflo(ra.x)), oacc[dt][4 * gq_ + 1] * rstd * g4.y * silu_f(bfhi(ra.x)));
      o.y = pack2(oacc[dt][4 * gq_ + 2] * rstd * g4.z * silu_f(bflo(ra.y)), oacc[dt][4 * gq_ + 3] * rstd * g4.w * silu_f(bfhi(ra.y)));
      *(uint2*)(aa + (size_t)r * 512 + h * 128 + dv0) = o;
    }
}

__device__ void phase_attn(const Params& p, int l, int* ctr) {
  const int nqb = (l == 1) ? 64 : 66, nck = (l == 1) ? 128 : NCHUNK;
  const int per_q = NBG * nqb;
  const int n_gla = NBG * nck * 4;
  run_q8(ctr, [=](int q_) { return per_q + ((n_gla - q_ + 7) >> 3); }, [&](int q_, int j_) {
    if (j_ < per_q) attn_item(p, ((j_ / nqb) * 8 + q_) * 66 + (j_ % nqb));
    else {
      const int gi = QA_ID(q_, j_ - per_q);
      gla_out(p, l, (gi / (nck * 4)) * (NCHUNK * 4) + gi % (nck * 4));
    }
  });
}

__device__ void phase_merge(const Params& p, int l, int* ctr) {
  const int MT = (l == 1 ? NBG * SEQ / 128 : RG / 128), NT = 16;
  const u16* wl = p.wt + (size_t)l * W_LAYER;
  run_q8(ctr, GEMM_CNT(MT, NT), [&](int q_, int j_) {
    int mt, nt; tile_order(j_, mlo(q_ + 1, MT) - mlo(q_, MT), NT, mt, nt); mt += mlo(q_, MT);
    const int tid = TIDX, lane = tid & 63, wid = tid >> 6;
    const int wr = wid >> 1, wc = wid & 1, fr = lane & 15, fq = lane >> 4;
    f32x4 macc[2][4], acc[2][4];
#pragma unroll
    for (int a = 0; a < 2; ++a)
#pragma unroll
      for (int b = 0; b < 4; ++b) { macc[a][b] = f32x4{0.f, 0.f, 0.f, 0.f}; acc[a][b] = f32x4{0.f, 0.f, 0.f, 0.f}; }
    const int srow = tid >> 3, schunk = (tid & 7) ^ ((tid >> 4) & 7);
    const size_t xo = (size_t)(mt * 128 + srow) * 512 + schunk * 8;
    const size_t wo = (size_t)(nt * 64 + srow) * 512 + schunk * 8;
    const u16* xg0 = p.h + xo;
    const u16* xg1 = p.h + (size_t)RG * 512 + xo;
    const u16* xg2 = p.uc + xo;
    const u16* wg0 = wl + W_BRA + wo;
    const u16* wg1 = wl + W_BRB + wo;
    const u16* wg2 = wl + W_BRC + wo;
    const int g = fr >> 1;
    const int lo0 = fr * 128 + ((fq ^ g) << 4), lo1 = fr * 128 + (((fq ^ g) ^ 4) << 4);
    const char* xb = smem + wr * 8192;
    const char* wb = smem + 16384 + wc * 4096;
    char* sdst = smem + tid * 16;
    const u16* gbase = p.proj + (size_t)(mt * 128 + wr * 64 + fr) * INW + C_GATE + nt * 64 + wc * 32 + fq * 4;
    uint2 gts[2][4];
#pragma unroll
    for (int wi = 0; wi < 2; ++wi)
#pragma unroll
      for (int xi = 0; xi < 4; ++xi) gts[wi][xi] = *(const uint2*)(gbase + (size_t)xi * 16 * INW + wi * 16);
    __syncthreads();
#pragma unroll
    for (int i = 0; i < 4; ++i) {
      glds16(xg0 + i * (32 * 512), sdst + i * 4096);
      if (i < 2) glds16(wg0 + i * (32 * 512), sdst + 16384 + i * 4096);
    }
    for (int kt = 0; kt < 24; ++kt) {
      asm volatile("s_waitcnt vmcnt(0)" ::: "memory");
      __syncthreads();
      const int cb = (kt & 1) * 32768;
      if (kt + 1 < 24) {
        const int nbr = (kt + 1) >> 3, ko = ((kt + 1) & 7) * 64, nb = 32768 - cb;
        const u16* xg = (nbr == 0 ? xg0 : nbr == 1 ? xg1 : xg2) + ko;
        const u16* wg = (nbr == 0 ? wg0 : nbr == 1 ? wg1 : wg2) + ko;
#pragma unroll
        for (int i = 0; i < 4; ++i) {
          glds16(xg + i * (32 * 512), sdst + nb + i * 4096);
          if (i < 2) glds16(wg + i * (32 * 512), sdst + nb + 16384 + i * 4096);
        }
      }
      bf16x8 wf[2][2], xf[2][4];
#pragma unroll
      for (int i = 0; i < 2; ++i) {
        wf[0][i] = *(const bf16x8*)(wb + cb + i * 2048 + lo0);
        wf[1][i] = *(const bf16x8*)(wb + cb + i * 2048 + lo1);
      }
#pragma unroll
      for (int i = 0; i < 4; ++i) {
        xf[0][i] = *(const bf16x8*)(xb + cb + i * 2048 + lo0);
        xf[1][i] = *(const bf16x8*)(xb + cb + i * 2048 + lo1);
      }
      __builtin_amdgcn_sched_barrier(0);
#pragma unroll
      for (int k = 0; k < 2; ++k)
#pragma unroll
        for (int wi = 0; wi < 2; ++wi)
#pragma unroll
          for (int xi = 0; xi < 4; ++xi)
            acc[wi][xi] = __builtin_amdgcn_mfma_f32_16x16x32_bf16(wf[k][wi], xf[k][xi], acc[wi][xi], 0, 0, 0);
      __builtin_amdgcn_sched_barrier(0);
      if ((kt & 7) == 7) {
        const int br = kt >> 3;
#pragma unroll
        for (int wi = 0; wi < 2; ++wi)
#pragma unroll
          for (int xi = 0; xi < 4; ++xi) {
            const uint2 gt = gts[wi][xi];
            macc[wi][xi][0] += sigmoid_f(bflo(gt.x)) * acc[wi][xi][0];
            macc[wi][xi][1] += sigmoid_f(bfhi(gt.x)) * acc[wi][xi][1];
            macc[wi][xi][2] += sigmoid_f(bflo(gt.y)) * acc[wi][xi][2];
            macc[wi][xi][3] += sigmoid_f(bfhi(gt.y)) * acc[wi][xi][3];
            acc[wi][xi] = f32x4{0.f, 0.f, 0.f, 0.f};
            if (br < 2) gts[wi][xi] = *(const uint2*)(gbase + (size_t)xi * 16 * INW + wi * 16 + (br + 1) * 1024);
          }
      }
    }
    uint2 o[2][4];
#pragma unroll
    for (int wi = 0; wi < 2; ++wi)
#pragma unroll
      for (int xi = 0; xi < 4; ++xi) {
        o[wi][xi].x = pack2(macc[wi][xi][0], macc[wi][xi][1]); o[wi][xi].y = pack2(macc[wi][xi][2], macc[wi][xi][3]);
      }
    store_tile_bf16<2>(o, p.m + (size_t)(mt * 128 + wr * 64) * DM + nt * 64 + wc * 32, DM);
  });
}

__device__ void phase_resid(const Params& p, int l, int g, int which, int* ctr) {
  const int MT = (l == 1 ? NBG * SEQ / 128 : RG / 128), NT = 8;
  const u16* wl = p.wt + (size_t)l * W_LAYER;
  const u16* X = which == 0 ? p.m : p.proj + (size_t)RG * DFF;
  const int ldx = which == 0 ? DM : DFF, K = which == 0 ? DM : DFF;
  const u16* W = wl + (which == 0 ? W_O : W_DN);
  const int goff = which == 0 ? 2048 : 5120;
  const int from_input = (which == 0 && l == 0);
  run_q8(ctr, GEMM_CNT(MT, NT), [&](int q_, int j_) {
    int mt, nt; tile_order(j_, mlo(q_ + 1, MT) - mlo(q_, MT), NT, mt, nt); mt += mlo(q_, MT);
    f32x4 acc[4][4];
    gemm_core<4>(X + (size_t)mt * 128 * ldx, ldx, W + (size_t)nt * 128 * K, K, K, acc);
    EPI_VARS
    const float* mrow = p.mod + ((size_t)l * 9 + mod_index(p, g, mt * 128)) * 6144 + goff + nt * 128 + wc_ * 64;
    __syncthreads();
    char* lb = smem + wid_ * 16384;
#pragma unroll
    for (int wi = 0; wi < 4; ++wi)
#pragma unroll
      for (int xi = 0; xi < 4; ++xi) {
        const int r = xi * 16 + fr_, c = wi * 4 + fq_;
        *(f32x4*)(lb + r * 256 + ((c ^ (r & 15)) << 4)) = acc[wi][xi];
      }
    const int c16 = lane_ & 15, rsub = lane_ >> 4;
    const float* xs = xsrc_row_ptr(p, g, mt * 128 + wr_ * 64, from_input) + nt * 128 + wc_ * 64 + c16 * 4;
    float* xd = xrow_ptr(p, g, mt * 128 + wr_ * 64) + nt * 128 + wc_ * 64 + c16 * 4;
    const float4 gv = *(const float4*)(mrow + c16 * 4);
#pragma unroll
    for (int half = 0; half < 2; ++half) {
      float4 xv[8];
#pragma unroll
      for (int it = 0; it < 8; ++it) xv[it] = *(const float4*)(xs + (size_t)((half * 8 + it) * 4 + rsub) * DM);
#pragma unroll
      for (int it = 0; it < 8; ++it) {
        const int row = (half * 8 + it) * 4 + rsub;
        const f32x4 a = *(const f32x4*)(lb + row * 256 + ((c16 ^ (row & 15)) << 4));
        float4 o;
        o.x = xv[it].x + gv.x * a[0]; o.y = xv[it].y + gv.y * a[1]; o.z = xv[it].z + gv.z * a[2]; o.w = xv[it].w + gv.w * a[3];
        *(float4*)(xd + (size_t)row * DM) = o;
      }
    }
  });
}

__device__ void phase_gu(const Params& p, int l, int* ctr) {
  const int MT = (l == 1 ? NBG * SEQ / 128 : RG / 128), NT = 44;
  const u16* W = p.wt + (size_t)l * W_LAYER + W_GU;
  run_q8(ctr, GEMM_CNT(MT, NT), [&](int q_, int j_) {
    int mt, nt; tile_order(j_, mlo(q_ + 1, MT) - mlo(q_, MT), NT, mt, nt); mt += mlo(q_, MT);
    f32x4 acc[4][4];
    gemm_core<4>(p.h + (size_t)mt * 128 * DM, DM, W + (size_t)nt * 128 * DM, DM, DM, acc);
    EPI_VARS
    u16* dst = p.proj + (nt >= 22 ? (size_t)RG * DFF : 0);
    const int nb = (nt >= 22 ? nt - 22 : nt) * 128;
    uint2 o[4][4];
#pragma unroll
    for (int wi = 0; wi < 4; ++wi)
#pragma unroll
      for (int xi = 0; xi < 4; ++xi) {
        o[wi][xi].x = pack2(acc[wi][xi][0], acc[wi][xi][1]); o[wi][xi].y = pack2(acc[wi][xi][2], acc[wi][xi][3]);
      }
    store_tile_bf16<4>(o, dst + (size_t)(mt * 128 + wr_ * 64) * DFF + nb + wc_ * 64, DFF);
  });
}

struct ActIn { uint4 g0, g1, g2, uu; float4 w0a, w0b, w1a, w1b, w2a, w2b, ba, bb; };
__device__ __forceinline__ void act_load(ActIn& a, const u16* G, const u16* UP, const float* cw, const float* cb, int r, int c0) {
  int bl, pos, isctx; rowinfo(r, NBG, bl, pos, isctx);
  const int L = isctx ? CTXL : SEQ;
  const u16* gp = G + (size_t)r * DFF + c0;
  a.g1 = *(const uint4*)gp;
  a.g0 = make_uint4(0, 0, 0, 0); a.g2 = a.g0;
  if (pos > 0) a.g0 = *(const uint4*)(gp - DFF);
  if (pos < L - 1) a.g2 = *(const uint4*)(gp + DFF);
  a.uu = *(const uint4*)(UP + (size_t)r * DFF + c0);
  a.w0a = *(const float4*)(cw + c0); a.w0b = *(const float4*)(cw + c0 + 4);
  a.w1a = *(const float4*)(cw + DFF + c0); a.w1b = *(const float4*)(cw + DFF + c0 + 4);
  a.w2a = *(const float4*)(cw + 2 * DFF + c0); a.w2b = *(const float4*)(cw + 2 * DFF + c0 + 4);
  a.ba = *(const float4*)(cb + c0); a.bb = *(const float4*)(cb + c0 + 4);
}
__device__ __forceinline__ uint4 act_compute(const ActIn& a) {
  uint4 o;
#define ACT2(G0, G1, G2, UU, W0L, W0H, W1L, W1H, W2L, W2H, BL, BH) \
  pack2(silu_f(W0L * bflo(G0) + W1L * bflo(G1) + W2L * bflo(G2) + BL) * bflo(UU), \
        silu_f(W0H * bfhi(G0) + W1H * bfhi(G1) + W2H * bfhi(G2) + BH) * bfhi(UU))
  o.x = ACT2(a.g0.x, a.g1.x, a.g2.x, a.uu.x, a.w0a.x, a.w0a.y, a.w1a.x, a.w1a.y, a.w2a.x, a.w2a.y, a.ba.x, a.ba.y);
  o.y = ACT2(a.g0.y, a.g1.y, a.g2.y, a.uu.y, a.w0a.z, a.w0a.w, a.w1a.z, a.w1a.w, a.w2a.z, a.w2a.w, a.ba.z, a.ba.w);
  o.z = ACT2(a.g0.z, a.g1.z, a.g2.z, a.uu.z, a.w0b.x, a.w0b.y, a.w1b.x, a.w1b.y, a.w2b.x, a.w2b.y, a.bb.x, a.bb.y);
  o.w = ACT2(a.g0.w, a.g1.w, a.g2.w, a.uu.w, a.w0b.z, a.w0b.w, a.w1b.z, a.w1b.w, a.w2b.z, a.w2b.w, a.bb.z, a.bb.w);
#undef ACT2
  return o;
}

__device__ void phase_act(const Params& p, int l, int* ctr) {
  const int nitems = (l == 1) ? NBG * SEQ / 8 : RG / 8;
  const float* cw = p.in[23] + (size_t)l * 3 * DFF;
  const float* cb = p.in[24] + (size_t)l * DFF;
  const u16* G = p.proj;
  u16* UP = p.proj + (size_t)RG * DFF;
  for (int it = blockIdx.x; it < nitems; it += gridDim.x) {
    const int tid = TIDX;
    for (int k = 0; k < 12; k += 2) {
      const int e0 = tid + k * 256, e1 = e0 + 256;
      const bool two = (k + 1 < 11);
      const int r0 = it * 8 + e0 / 352, c00 = (e0 % 352) * 8;
      const int r1 = it * 8 + (two ? e1 / 352 : 0), c01 = two ? (e1 % 352) * 8 : 0;
      ActIn a0, a1;
      act_load(a0, G, UP, cw, cb, r0, c00);
      act_load(a1, G, UP, cw, cb, r1, c01);
      const uint4 o0 = act_compute(a0), o1 = act_compute(a1);
      *(uint4*)(UP + (size_t)r0 * DFF + c00) = o0;
      if (two) *(uint4*)(UP + (size_t)r1 * DFF + c01) = o1;
    }
  }
}

__device__ void phase_final(const Params& p, int* ctr) {
  const int nitems = NBATCH * SEQ / 16;
  const float* gam = p.in[26];
  for (int it = blockIdx.x; it < nitems; it += gridDim.x) {
    const int lane = TIDX & 63, wid = TIDX >> 6;
    float* xr = p.out + ((size_t)it * 16 + wid * 4) * DM;
    float4 v[4][4], gg[4];
#pragma unroll
    for (int rr = 0; rr < 4; ++rr)
#pragma unroll
      for (int i = 0; i < 4; ++i) v[rr][i] = *(const float4*)(xr + (size_t)rr * DM + lane * 4 + i * 256);
#pragma unroll
    for (int i = 0; i < 4; ++i) gg[i] = *(const float4*)(gam + lane * 4 + i * 256);
#pragma unroll
    for (int rr = 0; rr < 4; ++rr) {
      float ss = 0.f;
#pragma unroll
      for (int i = 0; i < 4; ++i)
        ss += v[rr][i].x * v[rr][i].x + v[rr][i].y * v[rr][i].y + v[rr][i].z * v[rr][i].z + v[rr][i].w * v[rr][i].w;
      ss = wave_sum(ss);
      const float rstd = rsqrtf(ss * (1.f / 1024.f) + EPS);
#pragma unroll
      for (int i = 0; i < 4; ++i) {
        float4 o; o.x = v[rr][i].x * rstd * gg[i].x; o.y = v[rr][i].y * rstd * gg[i].y; o.z = v[rr][i].z * rstd * gg[i].z; o.w = v[rr][i].w * rstd * gg[i].w;
        *(float4*)(xr + (size_t)rr * DM + lane * 4 + i * 256) = o;
      }
    }
  }
}

#define XB_TMO      128
#define XB_XCNT(j)  (256  + 64 * (j))
#define XB_XSUB(j)  (1280 + 64 * (j))
#define XB_XGEN(j)  (2304 + 64 * (j))
#define XB_TOP      3328
#define XB_TOPGEN   3392
#define XCD_BAR_WORDS 3456
#define XB_SPIN_CAP (1u << 22)
#define LAS __attribute__((address_space(3)))
__device__ __forceinline__ unsigned xb_ld(unsigned* p)              { return __hip_atomic_load(p, __ATOMIC_RELAXED, __HIP_MEMORY_SCOPE_AGENT); }
__device__ __forceinline__ unsigned xb_add(unsigned* p, unsigned v) { return __hip_atomic_fetch_add(p, v, __ATOMIC_RELAXED, __HIP_MEMORY_SCOPE_AGENT); }
__device__ __forceinline__ unsigned xb_xcc_id() { return (unsigned)__builtin_amdgcn_s_getreg((3 << 11) | 20) & 0xFu; }
#define XB_SPIN(cond, bar) do { unsigned _sp = 0; while (cond) { __builtin_amdgcn_s_sleep(1); \
    if ((++_sp & 255u) == 0u) { if (xb_ld(&(bar)[XB_TMO])) break; if (_sp > XB_SPIN_CAP) { atomicAdd(&(bar)[XB_TMO], 1u); break; } } } } while (0)
struct XcdBarrier { unsigned* bar; unsigned x; volatile LAS unsigned* st; };
__device__ __forceinline__ XcdBarrier xcd_barrier_post(unsigned* bar, volatile LAS unsigned* st) {
  XcdBarrier b; b.bar = bar; b.x = xb_xcc_id(); b.st = st;
  if (threadIdx.x == 0) (void)xb_add(&bar[XB_XCNT(b.x)], 1u);
  return b;
}
__device__ __forceinline__ void xcd_barrier_complete(unsigned* bar, unsigned x, unsigned& nloc, unsigned& nx) {
  const unsigned G = gridDim.x * gridDim.y * gridDim.z;
  unsigned sum, cnt, mine, sp = 0u;
  for (;;) {
    sum = 0u; cnt = 0u; mine = 0u;
#pragma unroll
    for (unsigned j = 0; j < 16; ++j) { const unsigned c = xb_ld(&bar[XB_XCNT(j)]); sum += c; cnt += (c > 0u) ? 1u : 0u; mine = (j == x) ? c : mine; }
    if (sum == G) break;
    __builtin_amdgcn_s_sleep(1);
    if ((++sp & 255u) == 0u) { if (xb_ld(&bar[XB_TMO])) break; if (sp > XB_SPIN_CAP) { atomicAdd(&bar[XB_TMO], 1u); break; } }
  }
  nloc = mine > 0u ? mine : 1u; nx = cnt > 0u ? cnt : 1u;
}
__device__ __forceinline__ void xcd_barrier(const XcdBarrier& b) {
  asm volatile("s_waitcnt vmcnt(0)" ::: "memory");
  __syncthreads();
  if (threadIdx.x == 0) {
    unsigned* bar = b.bar;
    __builtin_amdgcn_s_waitcnt(0);
    unsigned nloc = b.st[0], nx = b.st[1];
    if (nloc == 0u) { xcd_barrier_complete(bar, b.x, nloc, nx); b.st[0] = nloc; b.st[1] = nx; }
    const unsigned old = xb_add(&bar[XB_XSUB(b.x)], 1u);
    const unsigned gen = old / nloc;
    if (old + 1u == (gen + 1u) * nloc) {
      __builtin_amdgcn_fence(__ATOMIC_RELEASE, "agent");
      asm volatile("s_waitcnt vmcnt(0)" ::: "memory");
      const unsigned og = xb_add(&bar[XB_TOP], 1u);
      const unsigned tg = og / nx;
      if (og + 1u == (tg + 1u) * nx) xb_add(&bar[XB_TOPGEN], 1u);
      else XB_SPIN(xb_ld(&bar[XB_TOPGEN]) == tg, bar);
      __builtin_amdgcn_fence(__ATOMIC_ACQUIRE, "agent");
      xb_add(&bar[XB_XGEN(b.x)], 1u);
      asm volatile("s_waitcnt vmcnt(0)" ::: "memory");
    } else {
      XB_SPIN(xb_ld(&bar[XB_XGEN(b.x)]) == gen, bar);
      __builtin_amdgcn_fence(__ATOMIC_ACQUIRE, "agent");
      asm volatile("s_waitcnt vmcnt(0)" ::: "memory");
    }
  }
  __syncthreads();
}

__device__ void run_phase(const Params& p, int ph, int* ctr) {
  if (ph == 0) { phase0(p, ctr); return; }
  if (ph == NPHASES - 1) { phase_final(p, ctr); return; }
  const int idx = ph - 1, lg = idx / NPH_PER, sub = idx % NPH_PER;
  const int l = lg / NGRP, g = lg % NGRP;
  switch (sub) {
    case 0: phase_norm(p, l, g, 0, ctr); break;
    case 1: phase_proj(p, l, ctr); break;
    case 2: phase_postproj(p, l, ctr); break;
    case 3: phase_qkv(p, l, ctr); break;
    case 4: phase_attn(p, l, ctr); break;
    case 5: phase_merge(p, l, ctr); break;
    case 6: phase_resid(p, l, g, 0, ctr); break;
    case 7: phase_norm(p, l, g, 1, ctr); break;
    case 8: phase_gu(p, l, ctr); break;
    case 9: phase_act(p, l, ctr); break;
    default: phase_resid(p, l, g, 1, ctr); break;
  }
}

__global__ void __launch_bounds__(256, 2) mega_kernel(KArgs ka, int ph_lo, int ph_hi, int coop) {
  Params p;
#pragma unroll
  for (int i = 0; i < 27; ++i) p.in[i] = ka.in[i];
  p.out = ka.out;
  char* ws = ka.ws;
  p.ctr = (int*)(ws + O_CTR); p.mod = (float*)(ws + O_MOD); p.rope = (float*)(ws + O_ROPE); p.xc = (float*)(ws + O_XC);
  p.rstdq = (float*)(ws + O_RSQ); p.rstdkv = (float*)(ws + O_RSKV); p.dec = (float*)(ws + O_DEC); p.wt = (u16*)(ws + O_WT);
  p.proj = (u16*)(ws + O_PROJ); p.h = (u16*)(ws + O_H); p.m = (u16*)(ws + O_M); p.q = (u16*)(ws + O_Q);
  p.kf = (u16*)(ws + O_KF); p.vt = (u16*)(ws + O_VT); p.uc = (u16*)(ws + O_UC); p.gq = (u16*)(ws + O_GQ);
  p.ss = (u16*)(ws + O_SS);
  volatile LAS unsigned* st = (volatile LAS unsigned*)(smem + SLOT_OFF + 64);
  if (threadIdx.x == 0) { st[0] = 0u; st[1] = 0u; }
  __syncthreads();
  XcdBarrier xb;
  xb.bar = (unsigned*)(ws + O_BAR); xb.x = 0; xb.st = st;
  if (coop) xb = xcd_barrier_post((unsigned*)(ws + O_BAR), st);
  for (int ph = ph_lo; ph < ph_hi; ++ph) {
#ifdef PROBE_MASK
    const int nrep = (ph > 0 && ph < NPHASES - 1 && ((PROBE_MASK >> ((ph - 1) % NPH_PER)) & 1)) ? 2 : 1;
#else
    const int nrep = 1;
#endif
    for (int rep = 0; rep < nrep; ++rep) {
      if (rep) xcd_barrier(xb);
      run_phase(p, ph, p.ctr + rep * 512 + ph * 8);
    }
    if (coop && ph + 1 < ph_hi) {
      if (ph == ph_lo) cg::this_grid().sync();
      else xcd_barrier(xb);
    }
  }
}

static inline size_t align_up(size_t v) { return (v + 255) & ~(size_t)255; }

extern "C" void kernel_launch(void* const* d_in, const int* in_sizes, int n_in, void* d_out, int out_size,
                              void* d_ws, size_t ws_size, hipStream_t stream) {
  static int grid_blocks = 0;
  if (!grid_blocks) {
    int dev = 0, cus = 0, per_cu = 0;
    hipGetDevice(&dev);
    hipDeviceGetAttribute(&cus, hipDeviceAttributeMultiprocessorCount, dev);
    hipFuncSetAttribute((const void*)mega_kernel, hipFuncAttributeMaxDynamicSharedMemorySize, LDS_BYTES);
    hipOccupancyMaxActiveBlocksPerMultiprocessor(&per_cu, (const void*)mega_kernel, 256, LDS_BYTES);
    if (per_cu < 1) per_cu = 1;
    if (per_cu > 2) per_cu = 2;
    grid_blocks = cus * per_cu;
  }
  KArgs p{};
  for (int i = 0; i < 27; ++i) p.in[i] = (const float*)d_in[i];
  p.out = (float*)d_out;
  p.ws = (char*)d_ws;
  if (ws_size < WS_END) { fprintf(stderr, "workspace too small: %zu < %zu\n", ws_size, (size_t)WS_END); return; }
  hipMemsetAsync((char*)d_ws + O_CTR, 0, 4096 + XCD_BAR_BYTES, stream);
#if SINGLE_LAUNCH
  int lo = 0, hi = NPHASES, coop = 1;
  void* args[] = {&p, &lo, &hi, &coop};
  hipError_t e = hipLaunchCooperativeKernel((const void*)mega_kernel, dim3(grid_blocks), dim3(256), args, LDS_BYTES, stream);
  if (e != hipSuccess) fprintf(stderr, "cooperative launch failed: %s (grid %d)\n", hipGetErrorString(e), grid_blocks);
#else
  for (int ph = 0; ph < NPHASES; ++ph)
    hipLaunchKernelGGL(mega_kernel, dim3(grid_blocks), dim3(256), LDS_BYTES, stream, p, ph, ph + 1, 0);
#endif
}
```

```cpp
#include <hip/hip_runtime.h>
#include <hip/hip_cooperative_groups.h>
#include <cstdio>
#include <cstdint>
namespace cg = cooperative_groups;

typedef unsigned short u16;
typedef __attribute__((ext_vector_type(8))) short bf16x8;
typedef __attribute__((ext_vector_type(4))) float f32x4;
typedef __attribute__((ext_vector_type(16))) float f32x16;

#ifndef SINGLE_LAUNCH
#define SINGLE_LAUNCH 1
#endif

constexpr int DM = 1024, SEQ = 8192, CTXL = 256, NBATCH = 8, INW = 6592, INWP = 6656, DFF = 2816;
constexpr int C_QA = 0, C_KA = 256, C_VA = 512, C_RA = 1024, C_ALR = 1536, C_CQ = 1568, C_CKV = 1824,
              C_KR = 1952, C_SB = 1984, C_SC = 2496, C_SX = 3008, C_GATE = 3520;
constexpr int NKEY = SEQ + CTXL;
constexpr int NCHUNK = NKEY / 64;
constexpr float EPS = 1e-6f;
constexpr int LDS_BYTES = 65536 + 256;
constexpr int SLOT_OFF = 65536;
constexpr int NPH_PER = 11;
constexpr int NBG = 4;
constexpr int NGRP = NBATCH / NBG;
constexpr int RG = NBG * (SEQ + CTXL);
constexpr int NPHASES = 1 + 2 * NGRP * NPH_PER + 1;

constexpr size_t W_IN = 0;
constexpr size_t W_UQ = W_IN + (size_t)INWP * 1024;
constexpr size_t W_UKV = W_UQ + 768 * 256;
constexpr size_t W_BRA = W_UKV + 1024 * 128;
constexpr size_t W_BRB = W_BRA + 1024 * 512;
constexpr size_t W_BRC = W_BRB + 1024 * 512;
constexpr size_t W_O = W_BRC + 1024 * 512;
constexpr size_t W_GU = W_O + 1024 * 1024;
constexpr size_t W_DN = W_GU + (size_t)5632 * 1024;
constexpr size_t W_LAYER = W_DN + (size_t)1024 * 2816;

struct KArgs {
  const float* in[27];
  float* out;
  char* ws;
};
struct Params {
  const float* in[27];
  float* out;
  float* xc;
  u16* wt;
  float* mod;
  float* rope;
  int* ctr;
  float* rstdq;
  float* rstdkv;
  float* dec;
  u16* proj;
  u16* h;
  u16* m;
  u16* q;
  u16* kf;
  u16* vt;
  u16* uc;
  u16* gq;
  u16* ss;
};
constexpr size_t al256(size_t v) { return (v + 255) & ~(size_t)255; }
constexpr size_t XCD_BAR_BYTES = 3456 * 4;
constexpr size_t O_CTR = 0;
constexpr size_t O_BAR = O_CTR + 4096;
constexpr size_t O_MOD = al256(O_BAR + XCD_BAR_BYTES);
constexpr size_t O_ROPE = al256(O_MOD + (size_t)2 * 9 * 6144 * 4);
constexpr size_t O_XC = al256(O_ROPE + 1024 * 2 * 4);
constexpr size_t O_RSQ = al256(O_XC + (size_t)NBATCH * CTXL * DM * 4);
constexpr size_t O_RSKV = al256(O_RSQ + (size_t)RG * 4);
constexpr size_t O_DEC = al256(O_RSKV + (size_t)RG * 4);
constexpr size_t O_WT = al256(O_DEC + (size_t)NBG * NCHUNK * 4 * 2 * 64 * 4);
constexpr size_t O_PROJ = al256(O_WT + 2 * W_LAYER * 2);
constexpr size_t O_H = al256(O_PROJ + (size_t)RG * INW * 2);
constexpr size_t O_M = O_H + (size_t)RG * DM * 2;
constexpr size_t O_Q = al256(O_M + (size_t)RG * DM * 2);
constexpr size_t O_KF = al256(O_Q + (size_t)RG * 768 * 2);
constexpr size_t O_VT = al256(O_KF + (size_t)NBG * 8 * NKEY * 96 * 2);
constexpr size_t O_UC = al256(O_VT + (size_t)NBG * 8 * 64 * NKEY * 2);
constexpr size_t O_GQ = al256(O_UC + (size_t)RG * 512 * 2);
constexpr size_t O_SS = al256(O_GQ + (size_t)RG * 1024 * 2);
constexpr size_t WS_END = al256(O_SS + (size_t)NBG * NCHUNK * 4 * 2 * 8192 * 2);
static_assert(WS_END <= ((size_t)1 << 30), "workspace layout must fit 1 GiB");

extern __shared__ __attribute__((aligned(16))) char smem[];

typedef __bf16 hbf2 __attribute__((ext_vector_type(2)));
typedef float hf2 __attribute__((ext_vector_type(2)));
__device__ __forceinline__ unsigned pack2(float a, float b) {
  hf2 v = {a, b};
  return __builtin_bit_cast(unsigned, __builtin_convertvector(v, hbf2));
}
__device__ __forceinline__ u16 f2bf(float f) { return (u16)(pack2(f, 0.f) & 0xffffu); }
__device__ __forceinline__ float bf2f(u16 h) { return __uint_as_float(((unsigned)h) << 16); }
__device__ __forceinline__ float bflo(unsigned u) { return __uint_as_float(u << 16); }
__device__ __forceinline__ float bfhi(unsigned u) { return __uint_as_float(u & 0xffff0000u); }
__device__ __forceinline__ float silu_f(float x) { return x / (1.f + __expf(-x)); }
__device__ __forceinline__ float sigmoid_f(float x) { return 1.f / (1.f + __expf(-x)); }

__device__ __forceinline__ void rowinfo(int r, int NB, int& bl, int& pos, int& isctx) {
  const int nl = NB * SEQ;
  if (r < nl) { bl = r >> 13; pos = r & (SEQ - 1); isctx = 0; }
  else { const int rc = r - nl; bl = rc >> 8; pos = rc & (CTXL - 1); isctx = 1; }
}
__device__ __forceinline__ int chunk_row(int bl, int cidx, int NB) {
  return cidx < 128 ? bl * SEQ + cidx * 64 : NB * SEQ + bl * CTXL + (cidx - 128) * 64;
}

template <class CntF, class BodyF>
__device__ __forceinline__ void run_q8(int* ctr8, CntF cntf, BodyF body) {
  volatile int* slot = (volatile int*)(smem + SLOT_OFF);
  int q = blockIdx.x & 7, tries = 0, item;
  __syncthreads();
  if (threadIdx.x == 0) {
    int v = atomicAdd(&ctr8[q], 1);
    while (v >= cntf(q) && tries < 8) { q = (q + 1) & 7; ++tries; if (tries < 8) v = atomicAdd(&ctr8[q], 1); }
    slot[0] = (tries < 8) ? v : -1; slot[1] = q; slot[2] = tries;
  }
  __syncthreads();
  item = slot[0]; q = slot[1]; tries = slot[2];
  while (item >= 0) {
    int nxt = 0;
    if (threadIdx.x == 0) nxt = atomicAdd(&ctr8[q], 1);
    body(q, item);
    __syncthreads();
    if (threadIdx.x == 0) {
      int qq = q, t = tries;
      while (nxt >= cntf(qq) && t < 8) { qq = (qq + 1) & 7; ++t; if (t < 8) nxt = atomicAdd(&ctr8[qq], 1); }
      slot[0] = (t < 8) ? nxt : -1; slot[1] = qq; slot[2] = t;
    }
    __syncthreads();
    item = slot[0]; q = slot[1]; tries = slot[2];
  }
}
#define QA_CNT(N) [=](int q_) { return ((N) - q_ + 7) >> 3; }
#define QA_ID(q_, j_) ((j_) * 8 + (q_))

__device__ __forceinline__ int opaque_tid() {
  int t = threadIdx.x;
  asm volatile("" : "+v"(t));
  return t;
}
#define TIDX opaque_tid()
__device__ __forceinline__ float wave_sum(float v) {
  v += __shfl_xor(v, 32); v += __shfl_xor(v, 16); v += __shfl_xor(v, 8);
  v += __shfl_xor(v, 4); v += __shfl_xor(v, 2); v += __shfl_xor(v, 1);
  return v;
}

__device__ __forceinline__ int lds_byte(int r, int c) {
  const int st = (r >> 4) * 2 + (c >> 5), rr = r & 15, cc = c & 31, ob = rr * 64 + cc * 2;
  return st * 1024 + (ob ^ (((ob >> 9) & 1) << 5));
}
__device__ __forceinline__ void stage_rc(int b, int& R, int& C) {
  const int st = b >> 10, sb = b & 1023, swz = sb ^ (((sb >> 9) & 1) << 5);
  R = (st >> 1) * 16 + (swz >> 6); C = (st & 1) * 32 + ((swz & 63) >> 1);
}

__device__ __forceinline__ void glds16(const void* g, void* l) {
  __builtin_amdgcn_global_load_lds((const __attribute__((address_space(1))) unsigned*)g,
                                   (__attribute__((address_space(3))) unsigned*)l, 16, 0, 0);
}

template <int NWI>
__device__ __forceinline__ void gemm_core(const u16* __restrict__ X, int ldx, const u16* __restrict__ W, int ldw,
                                          int K, f32x4 (&acc)[NWI][4]) {
  const int tid = TIDX, lane = tid & 63, wid = tid >> 6;
  const int wr = wid >> 1, wc = wid & 1, fr = lane & 15, fq = lane >> 4;
#pragma unroll
  for (int a = 0; a < NWI; ++a)
#pragma unroll
    for (int b = 0; b < 4; ++b) acc[a][b] = f32x4{0.f, 0.f, 0.f, 0.f};
  const int srow = tid >> 3, schunk = (tid & 7) ^ ((tid >> 4) & 7);
  const u16* xg = X + (size_t)srow * ldx + schunk * 8;
  const u16* wg = W + (size_t)srow * ldw + schunk * 8;
  const int xs = 32 * ldx, ws_ = 32 * ldw;
  const int g = fr >> 1;
  const int lo0 = fr * 128 + ((fq ^ g) << 4), lo1 = fr * 128 + (((fq ^ g) ^ 4) << 4);
  const char* xb = smem + wr * 8192;
  const char* wb = smem + 16384 + wc * (NWI * 2048);
  char* sdst = smem + tid * 16;
  const int nt = K >> 6;
  __syncthreads();
#pragma unroll
  for (int i = 0; i < 4; ++i) {
    glds16(xg + i * xs, sdst + i * 4096);
    if (i < NWI) glds16(wg + i * ws_, sdst + 16384 + i * 4096);
  }
  for (int kt = 0; kt < nt; ++kt) {
    asm volatile("s_waitcnt vmcnt(0)" ::: "memory");
    __syncthreads();
    const int cb = (kt & 1) * 32768;
    if (kt + 1 < nt) {
      const int nb = 32768 - cb;
      const int ko = (kt + 1) * 64;
#pragma unroll
      for (int i = 0; i < 4; ++i) {
        glds16(xg + i * xs + ko, sdst + nb + i * 4096);
        if (i < NWI) glds16(wg + i * ws_ + ko, sdst + nb + 16384 + i * 4096);
      }
    }
    bf16x8 wf[2][NWI], xf[2][4];
#pragma unroll
    for (int i = 0; i < NWI; ++i) {
      wf[0][i] = *(const bf16x8*)(wb + cb + i * 2048 + lo0);
      wf[1][i] = *(const bf16x8*)(wb + cb + i * 2048 + lo1);
    }
#pragma unroll
    for (int i = 0; i < 4; ++i) {
      xf[0][i] = *(const bf16x8*)(xb + cb + i * 2048 + lo0);
      xf[1][i] = *(const bf16x8*)(xb + cb + i * 2048 + lo1);
    }
    __builtin_amdgcn_sched_barrier(0);
#pragma unroll
    for (int k = 0; k < 2; ++k)
#pragma unroll
      for (int wi = 0; wi < NWI; ++wi)
#pragma unroll
        for (int xi = 0; xi < 4; ++xi)
          acc[wi][xi] = __builtin_amdgcn_mfma_f32_16x16x32_bf16(wf[k][wi], xf[k][xi], acc[wi][xi], 0, 0, 0);
    __builtin_amdgcn_sched_barrier(0);
  }
}

#define EPI_VARS const int tid_ = TIDX, lane_ = tid_ & 63, wid_ = tid_ >> 6; \
  const int wr_ = wid_ >> 1, wc_ = wid_ & 1, fr_ = lane_ & 15, fq_ = lane_ >> 4; (void)fq_; (void)fr_; (void)wr_; (void)wc_;
#define EPI_TR(xi) (wr_ * 64 + (xi) * 16 + fr_)
#define EPI_NN(wi) (wc_ * 64 + (wi) * 16 + fq_ * 4)

template <int NWI>
__device__ __forceinline__ void store_tile_bf16(const uint2 (&o)[NWI][4], u16* dst_wave, size_t ld) {
  constexpr int RB = NWI * 32, CPR = RB / 16;
  const int tid = TIDX, lane = tid & 63, wid = tid >> 6, fr = lane & 15, fq = lane >> 4;
  char* lb = smem + wid * 8192;
#pragma unroll
  for (int wi = 0; wi < NWI; ++wi)
#pragma unroll
    for (int xi = 0; xi < 4; ++xi) {
      const int r = xi * 16 + fr, c = wi * 2 + (fq >> 1);
      *(uint2*)(lb + r * RB + ((c ^ (r & (CPR - 1))) << 4) + (fq & 1) * 8) = o[wi][xi];
    }
#pragma unroll
  for (int it = 0; it < CPR; ++it) {
    const int idx = it * 64 + lane, row = idx / CPR, c = idx % CPR;
    const uint4 v = *(const uint4*)(lb + row * RB + ((c ^ (row & (CPR - 1))) << 4));
    *(uint4*)(dst_wave + (size_t)row * ld + c * 8) = v;
  }
}

__device__ __forceinline__ void tile_order(int t, int MT, int NT, int& mt, int& nt) {
  constexpr int GM = 4;
  const int band = t / (GM * NT), rem = t - band * GM * NT;
  const int m0 = band * GM;
  const int gsz = min(GM, MT - m0);
  nt = rem / gsz; mt = m0 + rem - nt * gsz;
}

__device__ __forceinline__ int mlo(int q, int MT) { return (q * MT) >> 3; }
#define GEMM_CNT(MT, NT) [=](int q_) { return (mlo(q_ + 1, MT) - mlo(q_, MT)) * (NT); }

__device__ __forceinline__ float* xrow_ptr(const Params& p, int g, int r) {
  int bl, pos, isctx; rowinfo(r, NBG, bl, pos, isctx);
  const int b = g * NBG + bl;
  return isctx ? p.xc + ((size_t)b * CTXL + pos) * DM : p.out + ((size_t)b * SEQ + pos) * DM;
}
__device__ __forceinline__ const float* xsrc_row_ptr(const Params& p, int g, int r, int from_input) {
  int bl, pos, isctx; rowinfo(r, NBG, bl, pos, isctx);
  const int b = g * NBG + bl;
  if (from_input) return isctx ? p.in[2] + ((size_t)b * CTXL + pos) * DM : p.in[0] + ((size_t)b * SEQ + pos) * DM;
  return isctx ? p.xc + ((size_t)b * CTXL + pos) * DM : p.out + ((size_t)b * SEQ + pos) * DM;
}
__device__ __forceinline__ int mod_index(const Params& p, int g, int r) {
  int bl, pos, isctx; rowinfo(r, NBG, bl, pos, isctx);
  return isctx ? 8 : g * NBG + bl;
}

__device__ void conv_tile4(const float* __restrict__ src, int K, int N, u16* __restrict__ dst,
                           const float* __restrict__ scale, int ktile, int ngrp) {
  float* tile = (float*)smem;
  const int tid = TIDX;
  const int k0 = ktile * 64;
  const int kk = tid >> 4, n4 = (tid & 15) * 4;
  float4 v[4][4];
  float sc[4];
#pragma unroll
  for (int i = 0; i < 4; ++i) sc[i] = scale ? scale[k0 + kk + 16 * i] : 1.f;
#pragma unroll
  for (int t = 0; t < 4; ++t) {
    const int n0 = (ngrp * 4 + t) * 64;
#pragma unroll
    for (int i = 0; i < 4; ++i) {
      v[t][i] = make_float4(0.f, 0.f, 0.f, 0.f);
      if (n0 < N) v[t][i] = *(const float4*)(src + (size_t)(k0 + kk + 16 * i) * N + n0 + n4);
    }
  }
  const int nn = tid >> 3, k8 = (tid & 7) * 8;
#pragma unroll
  for (int t = 0; t < 4; ++t) {
    const int n0 = (ngrp * 4 + t) * 64;
    __syncthreads();
#pragma unroll
    for (int i = 0; i < 4; ++i) {
      const int k = kk + 16 * i;
      tile[k * 65 + n4 + 0] = v[t][i].x * sc[i]; tile[k * 65 + n4 + 1] = v[t][i].y * sc[i];
      tile[k * 65 + n4 + 2] = v[t][i].z * sc[i]; tile[k * 65 + n4 + 3] = v[t][i].w * sc[i];
    }
    __syncthreads();
#pragma unroll
    for (int i = 0; i < 2; ++i) {
      const int n = nn + 32 * i;
      uint4 o;
      o.x = pack2(tile[(k8 + 0) * 65 + n], tile[(k8 + 1) * 65 + n]);
      o.y = pack2(tile[(k8 + 2) * 65 + n], tile[(k8 + 3) * 65 + n]);
      o.z = pack2(tile[(k8 + 4) * 65 + n], tile[(k8 + 5) * 65 + n]);
      o.w = pack2(tile[(k8 + 6) * 65 + n], tile[(k8 + 7) * 65 + n]);
      *(uint4*)(dst + (size_t)(n0 + n) * K + k0 + k8) = o;
    }
  }
}

__device__ void sincos_d(double a, double& s, double& c) {
  const double k = rint(a * 0.6366197723675814);
  double r = fma(-k, 1.5707963267948966, a);
  r = fma(-k, 6.123233995736766e-17, r);
  const int q = ((int)k) & 3;
  const double r2 = r * r;
  const double sp = r * (1.0 + r2 * (-1.0 / 6 + r2 * (1.0 / 120 + r2 * (-1.0 / 5040 + r2 * (1.0 / 362880 + r2 * (-1.0 / 39916800 + r2 * (1.0 / 6227020800.0)))))));
  const double cp = 1.0 + r2 * (-0.5 + r2 * (1.0 / 24 + r2 * (-1.0 / 720 + r2 * (1.0 / 40320 + r2 * (-1.0 / 3628800 + r2 * (1.0 / 479001600.0 + r2 * (-1.0 / 87178291200.0)))))));
  s = (q == 0) ? sp : (q == 1) ? cp : (q == 2) ? -sp : -cp;
  c = (q == 0) ? cp : (q == 1) ? -sp : (q == 2) ? -cp : sp;
}

constexpr int CV_WIN = 0, CV_UQ = 416, CV_UKV = 428, CV_BRA = 436, CV_BRB = 468, CV_BRC = 500,
              CV_WO = 532, CV_GATE = 596, CV_UP = 772, CV_DN = 948, CV_LAYER = 1124;
constexpr int P0_CONV = 2 * CV_LAYER, P0_ADA = 2 * 192, P0_TOTAL = P0_CONV + P0_ADA + 1;

__device__ void phase0(const Params& p, int* ctr) {
  run_q8(ctr, QA_CNT(P0_TOTAL), [&](int q_, int j_) {
    const int it = QA_ID(q_, j_);
    const int tid = TIDX;
    if (it >= P0_ADA + 1) {
      const int ci = it - (P0_ADA + 1);
      const int l = ci / CV_LAYER, j = ci % CV_LAYER;
      u16* wl = p.wt + (size_t)l * W_LAYER;
      if (j < CV_UQ)       { const int jj = j - CV_WIN;  conv_tile4(p.in[7] + (size_t)l * 1024 * INW, 1024, INW, wl + W_IN, nullptr, jj / 26, jj % 26); }
      else if (j < CV_UKV) { const int jj = j - CV_UQ;   conv_tile4(p.in[12] + (size_t)l * 256 * 768, 256, 768, wl + W_UQ, p.in[11] + l * 256, jj / 3, jj % 3); }
      else if (j < CV_BRA) { const int jj = j - CV_UKV;  conv_tile4(p.in[14] + (size_t)l * 128 * 1024, 128, 1024, wl + W_UKV, p.in[13] + l * 128, jj / 4, jj % 4); }
      else if (j < CV_BRB) { const int jj = j - CV_BRA;  conv_tile4(p.in[16] + (size_t)l * 512 * 1024, 512, 1024, wl + W_BRA, nullptr, jj / 4, jj % 4); }
      else if (j < CV_BRC) { const int jj = j - CV_BRB;  conv_tile4(p.in[17] + (size_t)l * 512 * 1024, 512, 1024, wl + W_BRB, nullptr, jj / 4, jj % 4); }
      else if (j < CV_WO)  { const int jj = j - CV_BRC;  conv_tile4(p.in[18] + (size_t)l * 512 * 1024, 512, 1024, wl + W_BRC, nullptr, jj / 4, jj % 4); }
      else if (j < CV_GATE){ const int jj = j - CV_WO;   conv_tile4(p.in[19] + (size_t)l * 1024 * 1024, 1024, 1024, wl + W_O, nullptr, jj / 4, jj % 4); }
      else if (j < CV_UP)  { const int jj = j - CV_GATE; conv_tile4(p.in[21] + (size_t)l * 1024 * DFF, 1024, DFF, wl + W_GU, nullptr, jj / 11, jj % 11); }
      else if (j < CV_DN)  { const int jj = j - CV_UP;   conv_tile4(p.in[22] + (size_t)l * 1024 * DFF, 1024, DFF, wl + W_GU + (size_t)DFF * 1024, nullptr, jj / 11, jj % 11); }
      else                 { const int jj = j - CV_DN;   conv_tile4(p.in[25] + (size_t)l * DFF * 1024, DFF, 1024, wl + W_DN, nullptr, jj / 4, jj % 4); }
    } else if (it < P0_ADA) {
      const int a = it, l = a / 192, cg_ = a % 192;
      float* sc = (float*)smem;
      float* red = sc + 9 * 1024;
      for (int e = tid; e < 9 * 1024; e += 256) {
        const int v = e >> 10, k = e & 1023;
        const float cv = (v < 8) ? p.in[1][v * 1024 + k] : p.in[3][k];
        sc[e] = cv / (1.f + expf(-cv));
      }
      __syncthreads();
      const int kg = tid >> 5, cn = tid & 31;
      const float* wa = p.in[4] + (size_t)l * 1024 * 6144 + cg_ * 32 + cn;
      float a0 = 0, a1 = 0, a2 = 0, a3 = 0, a4 = 0, a5 = 0, a6 = 0, a7 = 0, a8 = 0;
#pragma unroll 8
      for (int i = 0; i < 128; ++i) {
        const int k = kg + 8 * i;
        const float w = wa[(size_t)k * 6144];
        a0 += sc[k] * w; a1 += sc[1024 + k] * w; a2 += sc[2048 + k] * w; a3 += sc[3072 + k] * w;
        a4 += sc[4096 + k] * w; a5 += sc[5120 + k] * w; a6 += sc[6144 + k] * w; a7 += sc[7168 + k] * w;
        a8 += sc[8192 + k] * w;
      }
      float* rr = red + kg * 288 + cn;
      rr[0] = a0; rr[32] = a1; rr[64] = a2; rr[96] = a3; rr[128] = a4; rr[160] = a5; rr[192] = a6; rr[224] = a7; rr[256] = a8;
      __syncthreads();
      for (int e = tid; e < 288; e += 256) {
        float s = 0.f;
#pragma unroll
        for (int g8 = 0; g8 < 8; ++g8) s += red[g8 * 288 + e];
        const int v = e >> 5, n = cg_ * 32 + (e & 31);
        p.mod[((size_t)l * 9 + v) * 6144 + n] = s + p.in[5][l * 6144 + n];
      }
    } else {
      for (int e = tid; e < 1024; e += 256) {
        const int pos = e >> 3, f = e & 7;
        const float inv = (f == 0) ? 1.0f : (f == 1) ? 0.31622776601683794f : (f == 2) ? 0.1f : (f == 3) ? 0.031622776601683794f
                        : (f == 4) ? 0.01f : (f == 5) ? 0.0031622776601683794f : (f == 6) ? 0.001f : 0.00031622776601683794f;
        const float ang = (float)pos * inv;
        double s, c; sincos_d((double)ang, s, c);
        p.rope[e * 2] = (float)c; p.rope[e * 2 + 1] = (float)s;
      }
    }
  });
}

__device__ void phase_norm(const Params& p, int l, int g, int which, int* ctr) {
  const int nitems = (which == 1 && l == 1) ? NBG * SEQ / 16 : RG / 16;
  const float* gam = (which == 0 ? p.in[6] : p.in[20]) + l * DM;
  const int shoff = which == 0 ? 0 : 3072, scoff = which == 0 ? 1024 : 4096;
  const int from_input = (which == 0 && l == 0);
  for (int it = blockIdx.x; it < nitems; it += gridDim.x) {
    const int lane = TIDX & 63, wid = TIDX >> 6;
    const int r0 = it * 16 + wid * 4;
    const float* xr = xsrc_row_ptr(p, g, r0, from_input);
    const float* mrow = p.mod + ((size_t)l * 9 + mod_index(p, g, r0)) * 6144;
    float4 v[4][4], gg[4], sh[4], sc[4];
#pragma unroll
    for (int rr = 0; rr < 4; ++rr)
#pragma unroll
      for (int i = 0; i < 4; ++i) v[rr][i] = *(const float4*)(xr + (size_t)rr * DM + lane * 4 + i * 256);
#pragma unroll
    for (int i = 0; i < 4; ++i) {
      const int c = lane * 4 + i * 256;
      gg[i] = *(const float4*)(gam + c); sh[i] = *(const float4*)(mrow + shoff + c); sc[i] = *(const float4*)(mrow + scoff + c);
    }
#pragma unroll
    for (int rr = 0; rr < 4; ++rr) {
      float ss = 0.f;
#pragma unroll
      for (int i = 0; i < 4; ++i)
        ss += v[rr][i].x * v[rr][i].x + v[rr][i].y * v[rr][i].y + v[rr][i].z * v[rr][i].z + v[rr][i].w * v[rr][i].w;
      ss = wave_sum(ss);
      const float rstd = rsqrtf(ss * (1.f / 1024.f) + EPS);
#pragma unroll
      for (int i = 0; i < 4; ++i) {
        const int c = lane * 4 + i * 256;
        uint2 o;
        o.x = pack2(v[rr][i].x * rstd * gg[i].x * (1.f + sc[i].x) + sh[i].x, v[rr][i].y * rstd * gg[i].y * (1.f + sc[i].y) + sh[i].y);
        o.y = pack2(v[rr][i].z * rstd * gg[i].z * (1.f + sc[i].z) + sh[i].z, v[rr][i].w * rstd * gg[i].w * (1.f + sc[i].w) + sh[i].w);
        *(uint2*)(p.h + (size_t)(r0 + rr) * DM + c) = o;
      }
    }
  }
}

__device__ void phase_proj(const Params& p, int l, int* ctr) {
  const int MT = RG / 128, NT = INWP / 128;
  const u16* W = p.wt + (size_t)l * W_LAYER + W_IN;
  run_q8(ctr, GEMM_CNT(MT, NT), [&](int q_, int j_) {
    int mt, nt; tile_order(j_, mlo(q_ + 1, MT) - mlo(q_, MT), NT, mt, nt); mt += mlo(q_, MT);
    f32x4 acc[4][4];
    gemm_core<4>(p.h + (size_t)mt * 128 * DM, DM, W + (size_t)nt * 128 * DM, DM, DM, acc);
    EPI_VARS
    uint2 o[4][4];
#pragma unroll
    for (int wi = 0; wi < 4; ++wi)
#pragma unroll
      for (int xi = 0; xi < 4; ++xi) {
        o[wi][xi].x = pack2(acc[wi][xi][0], acc[wi][xi][1]); o[wi][xi].y = pack2(acc[wi][xi][2], acc[wi][xi][3]);
      }
    if (nt * 128 + wc_ * 64 < INW)
      store_tile_bf16<4>(o, p.proj + (size_t)(mt * 128 + wr_ * 64) * INW + nt * 128 + wc_ * 64, INW);
  });
}

__device__ void postproj_rows(const Params& p, int l, int it) {
  const int lane = TIDX & 63, wid = TIDX >> 6;
  const float* scw = p.in[15] + (size_t)l * 3 * 512;
  for (int rr = 0; rr < 4; ++rr) {
    const int r = it * 16 + wid * 4 + rr;
    int bl, pos, isctx; rowinfo(r, NBG, bl, pos, isctx);
    const u16* pr = p.proj + (size_t)r * INW;
    const int Lr = isctx ? CTXL : SEQ;
    const int c0 = lane * 8;
    const uint2 u_cq = *(const uint2*)(pr + C_CQ + lane * 4);
    const unsigned u_ckv = *(const unsigned*)(pr + C_CKV + lane * 2);
    const u16 u_kr = pr[C_KR + (lane & 31)];
    const uint4 sb = *(const uint4*)(pr + C_SB + c0);
    const uint4 sc1 = *(const uint4*)(pr + C_SC + c0);
    const uint4 sx1 = *(const uint4*)(pr + C_SX + c0);
    uint4 sc0 = make_uint4(0, 0, 0, 0), sx0 = sc0, sc2 = sc0, sx2 = sc0;
    if (pos > 0) { sc0 = *(const uint4*)(pr - INW + C_SC + c0); sx0 = *(const uint4*)(pr - INW + C_SX + c0); }
    if (pos < Lr - 1) { sc2 = *(const uint4*)(pr + INW + C_SC + c0); sx2 = *(const uint4*)(pr + INW + C_SX + c0); }
    {
      const uint2 u = u_cq;
      const float a = bflo(u.x), b = bfhi(u.x), c = bflo(u.y), d = bfhi(u.y);
      float ss = wave_sum(a * a + b * b + c * c + d * d);
      if (lane == 0) p.rstdq[r] = rsqrtf(ss * (1.f / 256.f) + EPS);
    }
    {
      const unsigned u = u_ckv;
      const float a = bflo(u), b = bfhi(u);
      float ss = wave_sum(a * a + b * b);
      if (lane == 0) p.rstdkv[r] = rsqrtf(ss * (1.f / 128.f) + EPS);
    }
    {
      const int idx = lane & 31;
      const float val = bf2f(u_kr);
      const float partner = __shfl_xor(val, 8);
      float o = val;
      if (!isctx) {
        const int axis = idx >> 4, half = (idx >> 3) & 1, f = idx & 7;
        const int pa = axis ? (pos & 63) : (pos >> 6);
        const float c = p.rope[(pa * 8 + f) * 2], s = p.rope[(pa * 8 + f) * 2 + 1];
        o = half ? (val * c + partner * s) : (val * c - partner * s);
      }
      const int j = isctx ? SEQ + pos : pos;
      const u16 ob = f2bf(o);
      if (lane < 32) {
#pragma unroll
        for (int hd = 0; hd < 8; ++hd)
          p.kf[((size_t)(bl * 8 + hd) * NKEY + j) * 96 + 64 + idx] = ob;
      }
    }
    {
      const float4 w0a = *(const float4*)(scw + c0), w0b = *(const float4*)(scw + c0 + 4);
      const float4 w1a = *(const float4*)(scw + 512 + c0), w1b = *(const float4*)(scw + 512 + c0 + 4);
      const float4 w2a = *(const float4*)(scw + 1024 + c0), w2b = *(const float4*)(scw + 1024 + c0 + 4);
      uint4 o;
#define UC2(SBW, A0, X0, A1, X1, A2, X2, W0L, W0H, W1L, W1H, W2L, W2H) \
      pack2(bflo(SBW) * (W0L * bflo(A0) * bflo(X0) + W1L * bflo(A1) * bflo(X1) + W2L * bflo(A2) * bflo(X2)), \
            bfhi(SBW) * (W0H * bfhi(A0) * bfhi(X0) + W1H * bfhi(A1) * bfhi(X1) + W2H * bfhi(A2) * bfhi(X2)))
      o.x = UC2(sb.x, sc0.x, sx0.x, sc1.x, sx1.x, sc2.x, sx2.x, w0a.x, w0a.y, w1a.x, w1a.y, w2a.x, w2a.y);
      o.y = UC2(sb.y, sc0.y, sx0.y, sc1.y, sx1.y, sc2.y, sx2.y, w0a.z, w0a.w, w1a.z, w1a.w, w2a.z, w2a.w);
      o.z = UC2(sb.z, sc0.z, sx0.z, sc1.z, sx1.z, sc2.z, sx2.z, w0b.x, w0b.y, w1b.x, w1b.y, w2b.x, w2b.y);
      o.w = UC2(sb.w, sc0.w, sx0.w, sc1.w, sx1.w, sc2.w, sx2.w, w0b.z, w0b.w, w1b.z, w1b.w, w2b.z, w2b.w);
#undef UC2
      *(uint4*)(p.uc + (size_t)r * 512 + c0) = o;
    }
  }
}

__device__ __forceinline__ float logsig16(float z) {
  return (fminf(z, 0.f) - log1pf(__expf(-fabsf(z)))) * (1.f / 16.f);
}

__device__ void gla_prep(const Params& p, int l, int it) {
  const int tid = TIDX, lane = tid & 63, wid = tid >> 6;
  const int bl = it / (NCHUNK * 4), rem = it % (NCHUNK * 4), cidx = rem >> 2, h = rem & 3;
  const int r0 = chunk_row(bl, cidx, NBG);
  float* lr = (float*)smem;
  float* tot = (float*)(smem + 8192);
  u16* vT = (u16*)(smem + 10752);
  u16* kTf = (u16*)(smem + 29184);
  u16* kTb = (u16*)(smem + 38400);
  {
    const int t = tid >> 2, c8 = (tid & 3) * 8;
    const uint4 u = *(const uint4*)(p.proj + (size_t)(r0 + t) * INW + C_ALR + c8);
    float* d = lr + t * 32 + c8;
    d[0] = bflo(u.x); d[1] = bfhi(u.x); d[2] = bflo(u.y); d[3] = bfhi(u.y);
    d[4] = bflo(u.z); d[5] = bfhi(u.z); d[6] = bflo(u.w); d[7] = bfhi(u.w);
    const int dvc = (tid & 3) * 32;
    const u16* vp = p.proj + (size_t)(r0 + t) * INW + C_VA + h * 128 + dvc;
#pragma unroll
    for (int i = 0; i < 4; ++i) {
      const uint4 vv = *(const uint4*)(vp + i * 8);
      u16* dst = vT + (size_t)(dvc + i * 8) * 72 + t;
      dst[0] = (u16)(vv.x & 0xffff); dst[72] = (u16)(vv.x >> 16);
      dst[144] = (u16)(vv.y & 0xffff); dst[216] = (u16)(vv.y >> 16);
      dst[288] = (u16)(vv.z & 0xffff); dst[360] = (u16)(vv.z >> 16);
      dst[432] = (u16)(vv.w & 0xffff); dst[504] = (u16)(vv.w >> 16);
    }
  }
  __syncthreads();
  const int dk = lane, tg = wid;
  const float* w2f = p.in[8] + ((size_t)(l * 2 + 0) * 16) * 256 + h * 64 + dk;
  const float* w2b = p.in[8] + ((size_t)(l * 2 + 1) * 16) * 256 + h * 64 + dk;
  float wf[16], wb[16];
#pragma unroll
  for (int r = 0; r < 16; ++r) { wf[r] = w2f[r * 256]; wb[r] = w2b[r * 256]; }
  const float biasf = p.in[9][(l * 2 + 0) * 256 + h * 64 + dk];
  const float biasb = p.in[9][(l * 2 + 1) * 256 + h * 64 + dk];
  float pf[16], sbk[16];
#pragma unroll
  for (int i = 0; i < 16; ++i) {
    const float* lrow = lr + (tg * 16 + i) * 32;
    float zf = biasf, zb = biasb;
#pragma unroll
    for (int r = 0; r < 16; ++r) { zf += lrow[r] * wf[r]; zb += lrow[16 + r] * wb[r]; }
    pf[i] = logsig16(zf); sbk[i] = logsig16(zb);
  }
#pragma unroll
  for (int i = 1; i < 16; ++i) pf[i] += pf[i - 1];
#pragma unroll
  for (int i = 14; i >= 0; --i) sbk[i] += sbk[i + 1];
  tot[tg * 64 + dk] = pf[15];
  tot[256 + tg * 64 + dk] = sbk[0];
  __syncthreads();
  float offf = 0.f, offb = 0.f, bfl = 0.f, bb0 = 0.f;
#pragma unroll
  for (int g4 = 0; g4 < 4; ++g4) {
    const float a = tot[g4 * 64 + dk], b = tot[256 + g4 * 64 + dk];
    bfl += a; bb0 += b;
    if (g4 < tg) offf += a;
    if (g4 > tg) offb += b;
  }
  u16* gqf = p.gq;
  u16* gkf = p.gq + (size_t)RG * 256;
  u16* gqb = p.gq + (size_t)RG * 512;
  u16* gkb = p.gq + (size_t)RG * 768;
  unsigned kfp[8], kbp[8];
#pragma unroll
  for (int i = 0; i < 16; ++i) {
    const int t = tg * 16 + i;
    const float bfv = offf + pf[i], bbv = offb + sbk[i];
    const float qv = bf2f(p.proj[(size_t)(r0 + t) * INW + C_QA + h * 64 + dk]);
    const float kv = bf2f(p.proj[(size_t)(r0 + t) * INW + C_KA + h * 64 + dk]);
    const size_t go = (size_t)(r0 + t) * 256 + h * 64 + dk;
    gqf[go] = f2bf(qv * __expf(bfv) * 0.125f);
    gkf[go] = f2bf(kv * __expf(-bfv));
    gqb[go] = f2bf(qv * __expf(bbv) * 0.125f);
    gkb[go] = f2bf(kv * __expf(-bbv));
    const u16 ksf = f2bf(kv * __expf(bfl - bfv));
    const u16 ksb = f2bf(kv * __expf(bb0 - bbv));
    if (i & 1) { kfp[i >> 1] |= ((unsigned)ksf) << 16; kbp[i >> 1] |= ((unsigned)ksb) << 16; }
    else { kfp[i >> 1] = ksf; kbp[i >> 1] = ksb; }
  }
  *(uint4*)(kTf + dk * 72 + tg * 16) = make_uint4(kfp[0], kfp[1], kfp[2], kfp[3]);
  *(uint4*)(kTf + dk * 72 + tg * 16 + 8) = make_uint4(kfp[4], kfp[5], kfp[6], kfp[7]);
  *(uint4*)(kTb + dk * 72 + tg * 16) = make_uint4(kbp[0], kbp[1], kbp[2], kbp[3]);
  *(uint4*)(kTb + dk * 72 + tg * 16 + 8) = make_uint4(kbp[4], kbp[5], kbp[6], kbp[7]);
  const size_t cb = ((size_t)(bl * NCHUNK + cidx) * 4 + h) * 2;
  if (tg == 0) {
    p.dec[(cb + 0) * 64 + dk] = __expf(bfl);
    p.dec[(cb + 1) * 64 + dk] = __expf(bb0);
  }
  __syncthreads();
  const int l31 = lane & 31, hh = lane >> 5;
  float* U = (float*)p.h;
#pragma unroll
  for (int dir = 0; dir < 2; ++dir) {
    const u16* kT = dir ? kTb : kTf;
#pragma unroll
    for (int dkt = 0; dkt < 2; ++dkt) {
      f32x16 acc;
#pragma unroll
      for (int e = 0; e < 16; ++e) acc[e] = 0.f;
#pragma unroll
      for (int s = 0; s < 4; ++s) {
        const bf16x8 a = *(const bf16x8*)(vT + (32 * wid + l31) * 72 + 16 * s + 8 * hh);
        const bf16x8 b = *(const bf16x8*)(kT + (32 * dkt + l31) * 72 + 16 * s + 8 * hh);
        acc = __builtin_amdgcn_mfma_f32_32x32x16_bf16(a, b, acc, 0, 0, 0);
      }
      float* up = U + (cb + dir) * 8192;
#pragma unroll
      for (int e = 0; e < 16; ++e) {
        const int dv = 32 * wid + (e & 3) + 8 * (e >> 2) + 4 * hh;
        up[dv * 64 + 32 * dkt + l31] = acc[e];
      }
    }
  }
}

__device__ void phase_postproj(const Params& p, int l, int* ctr) {
  const int n_prep = NBG * NCHUNK * 4, n_rows = RG / 16;
  run_q8(ctr, QA_CNT(n_prep + n_rows), [&](int q_, int j_) {
    const int it = QA_ID(q_, j_);
    if (it < n_prep) gla_prep(p, l, it);
    else postproj_rows(p, l, it - n_prep);
  });
}

__device__ void gla_scan(const Params& p, int it) {
  const int tid = TIDX;
  const int sl = it & 7, dir = (it >> 3) & 1, h = (it >> 4) & 3, bl = it >> 6;
  const int e0 = sl * 1024 + tid * 4;
  const int dk = e0 & 63;
  const float* U = (const float*)p.h;
  f32x4 S = {0.f, 0.f, 0.f, 0.f};
  for (int s0 = 0; s0 < NCHUNK; s0 += 12) {
    f32x4 u4[12], d4[12];
#pragma unroll
    for (int j = 0; j < 12; ++j) {
      const int step = s0 + j;
      const int cidx = dir ? (NCHUNK - 1 - step) : (step < 4 ? 128 + step : step - 4);
      const size_t base = ((size_t)(bl * NCHUNK + cidx) * 4 + h) * 2 + dir;
      u4[j] = *(const f32x4*)(U + base * 8192 + e0);
      d4[j] = *(const f32x4*)(p.dec + base * 64 + dk);
    }
#pragma unroll
    for (int j = 0; j < 12; ++j) {
      const int step = s0 + j;
      const int cidx = dir ? (NCHUNK - 1 - step) : (step < 4 ? 128 + step : step - 4);
      const size_t base = ((size_t)(bl * NCHUNK + cidx) * 4 + h) * 2 + dir;
      uint2 o; o.x = pack2(S[0], S[1]); o.y = pack2(S[2], S[3]);
      *(uint2*)(p.ss + base * 8192 + e0) = o;
      S = d4[j] * S + u4[j];
    }
  }
}

__device__ void q_tile(const Params& p, int l, int t) {
  const int MT = RG / 128;
  const int nt = t / MT, mt = t % MT;
  f32x4 acc[4][4];
  gemm_core<4>(p.proj + (size_t)mt * 128 * INW + C_CQ, INW, p.wt + (size_t)l * W_LAYER + W_UQ + (size_t)nt * 128 * 256, 256, 256, acc);
  EPI_VARS
  const float QS = 0.10206207261596577f * 1.4426950408889634f;
  int bl, pos0, isctx; rowinfo(mt * 128, NBG, bl, pos0, isctx);
  float rsq[4];
  uint2 qo[4][4];
#pragma unroll
  for (int xi = 0; xi < 4; ++xi) rsq[xi] = p.rstdq[mt * 128 + EPI_TR(xi)] * QS;
#pragma unroll
  for (int xi = 0; xi < 4; ++xi) {
    const int tr = EPI_TR(xi), r = mt * 128 + tr, pos = pos0 + tr;
    const float rs = rsq[xi];
#pragma unroll
    for (int wi = 0; wi < 4; ++wi) {
      const int n16 = (nt * 128 + wc_ * 64 + wi * 16) >> 4;
      const int m6 = n16 % 6;
      float v0 = acc[wi][xi][0] * rs, v1 = acc[wi][xi][1] * rs, v2 = acc[wi][xi][2] * rs, v3 = acc[wi][xi][3] * rs;
      if (m6 >= 4 && !isctx) {
        const float p0 = __shfl_xor(v0, 32), p1 = __shfl_xor(v1, 32), p2 = __shfl_xor(v2, 32), p3 = __shfl_xor(v3, 32);
        const int pa = (m6 == 5) ? (pos & 63) : (pos >> 6);
        const int f0 = (fq_ & 1) * 4;
        const float* rp = p.rope + (pa * 8 + f0) * 2;
        const float4 cs01 = *(const float4*)rp, cs23 = *(const float4*)(rp + 4);
        const float sg = (fq_ >= 2) ? 1.f : -1.f;
        v0 = v0 * cs01.x + sg * p0 * cs01.y;
        v1 = v1 * cs01.z + sg * p1 * cs01.w;
        v2 = v2 * cs23.x + sg * p2 * cs23.y;
        v3 = v3 * cs23.z + sg * p3 * cs23.w;
      }
      qo[wi][xi].x = pack2(v0, v1); qo[wi][xi].y = pack2(v2, v3);
    }
  }
  store_tile_bf16<4>(qo, p.q + (size_t)(mt * 128 + wr_ * 64) * 768 + nt * 128 + wc_ * 64, 768);
}

__device__ void kv_tile(const Params& p, int l, int t) {
  const int MT = RG / 128;
  const int nt = t / MT, mt = t % MT;
  f32x4 acc[4][4];
  gemm_core<4>(p.proj + (size_t)mt * 128 * INW + C_CKV, INW, p.wt + (size_t)l * W_LAYER + W_UKV + (size_t)nt * 128 * 128, 128, 128, acc);
  EPI_VARS
  int bl, pos0, isctx; rowinfo(mt * 128, NBG, bl, pos0, isctx);
  const int j0 = isctx ? SEQ + pos0 : pos0;
  float rskv[4];
#pragma unroll
  for (int xi = 0; xi < 4; ++xi) rskv[xi] = p.rstdkv[mt * 128 + EPI_TR(xi)];
#pragma unroll
  for (int xi = 0; xi < 4; ++xi) {
    const int tr = EPI_TR(xi), r = mt * 128 + tr, j = j0 + tr;
    const float rs = rskv[xi];
#pragma unroll
    for (int wi = 0; wi < 4; ++wi) {
      const int wn = EPI_NN(wi);
      const float v0 = acc[wi][xi][0] * rs, v1 = acc[wi][xi][1] * rs, v2 = acc[wi][xi][2] * rs, v3 = acc[wi][xi][3] * rs;
      if (wc_ == 0) {
        uint2 o; o.x = pack2(v0, v1); o.y = pack2(v2, v3);
        *(uint2*)(p.kf + ((size_t)(bl * 8 + nt) * NKEY + j) * 96 + wn) = o;
      } else {
        u16* vp = p.vt + ((size_t)(bl * 8 + nt) * 64 + (wn - 64)) * NKEY + j;
        vp[0] = f2bf(v0); vp[NKEY] = f2bf(v1); vp[2 * NKEY] = f2bf(v2); vp[3 * NKEY] = f2bf(v3);
      }
    }
  }
}

__device__ void phase_qkv(const Params& p, int l, int* ctr) {
  const int MT = RG / 128;
  const int n_scan = NBG * 64, n_q = MT * 6, n_kv = MT * 8;
  run_q8(ctr, QA_CNT(n_scan + n_q + n_kv), [&](int q_, int j_) {
    const int it = QA_ID(q_, j_);
    if (it < n_scan) gla_scan(p, it);
    else if (it < n_scan + n_q) q_tile(p, l, it - n_scan);
    else kv_tile(p, l, it - n_scan - n_q);
  });
}

__device__ __forceinline__ bf16x8 pack8(const f32x16& a, int o) {
  union { bf16x8 v; unsigned u[4]; } r;
  r.u[0] = pack2(a[o + 0], a[o + 1]); r.u[1] = pack2(a[o + 2], a[o + 3]);
  r.u[2] = pack2(a[o + 4], a[o + 5]); r.u[3] = pack2(a[o + 6], a[o + 7]);
  return r.v;
}
__device__ __forceinline__ bf16x8 ld2x8(const u16* p0) {
  union { bf16x8 v; uint2 u[2]; } r;
  r.u[0] = *(const uint2*)p0; r.u[1] = *(const uint2*)(p0 + 8);
  return r.v;
}

__device__ void attn_item(const Params& p, int it) {
  const int tid = TIDX, lane = tid & 63, wid = tid >> 6, l31 = lane & 31, hh = lane >> 5;
  const int qb = it % 66, bh = it / 66, h = bh & 7, bl = bh >> 3;
  const int r0 = qb < 64 ? bl * SEQ + qb * 128 : NBG * SEQ + bl * CTXL + (qb - 64) * 128;
  const int kt0 = qb < 64 ? 0 : 128;
  const int nkt = NCHUNK - kt0;
  constexpr int KROW = 208, VROW = 144, BUFB = 64 * KROW + 64 * VROW;
  bf16x8 qf[6];
  {
    const u16* qp = p.q + (size_t)(r0 + 32 * wid + l31) * 768 + h * 96 + 8 * hh;
#pragma unroll
    for (int s = 0; s < 6; ++s) qf[s] = *(const bf16x8*)(qp + 16 * s);
  }
  const u16* kbase = p.kf + (size_t)bh * NKEY * 96;
  const u16* vbase = p.vt + (size_t)bh * 64 * NKEY;
  uint4 kr0, kr1, kr2, vr0, vr1;
  const int kdst0 = (tid / 12) * KROW + (tid % 12) * 16;
  const int kdst1 = ((tid + 256) / 12) * KROW + ((tid + 256) % 12) * 16;
  const int kdst2 = ((tid + 512) / 12) * KROW + ((tid + 512) % 12) * 16;
  const int vdst0 = 64 * KROW + (tid >> 3) * VROW + (tid & 7) * 16;
  const int vdst1 = vdst0 + 32 * VROW;
  const int vsrc0 = (tid >> 3) * NKEY + (tid & 7) * 8;
  const int vsrc1 = vsrc0 + 32 * NKEY;
  {
    const u16* kp = kbase + (size_t)kt0 * 64 * 96 + tid * 8;
    kr0 = *(const uint4*)(kp); kr1 = *(const uint4*)(kp + 2048); kr2 = *(const uint4*)(kp + 4096);
    vr0 = *(const uint4*)(vbase + vsrc0 + kt0 * 64); vr1 = *(const uint4*)(vbase + vsrc1 + kt0 * 64);
    *(uint4*)(smem + kdst0) = kr0; *(uint4*)(smem + kdst1) = kr1; *(uint4*)(smem + kdst2) = kr2;
    *(uint4*)(smem + vdst0) = vr0; *(uint4*)(smem + vdst1) = vr1;
  }
  __builtin_amdgcn_s_waitcnt(0x0F70);
  __syncthreads();
  f32x16 oacc[2];
#pragma unroll
  for (int e = 0; e < 16; ++e) { oacc[0][e] = 0.f; oacc[1][e] = 0.f; }
  float m_run = 0.f, l_run = 0.f;
  for (int t = 0; t < nkt; ++t) {
    const int cur = t & 1;
    {
      const int tn = kt0 + min(t + 1, nkt - 1);
      const u16* kp = kbase + (size_t)tn * 64 * 96 + tid * 8;
      kr0 = *(const uint4*)(kp); kr1 = *(const uint4*)(kp + 2048); kr2 = *(const uint4*)(kp + 4096);
      vr0 = *(const uint4*)(vbase + vsrc0 + tn * 64); vr1 = *(const uint4*)(vbase + vsrc1 + tn * 64);
    }
    __builtin_amdgcn_sched_barrier(0);
    const char* Kl = smem + cur * BUFB;
    const char* Vl = Kl + 64 * KROW;
    f32x16 sacc[2];
#pragma unroll
    for (int kb = 0; kb < 2; ++kb) {
#pragma unroll
      for (int e = 0; e < 16; ++e) sacc[kb][e] = -m_run;
#pragma unroll
      for (int s = 0; s < 6; ++s) {
        const bf16x8 a = *(const bf16x8*)(Kl + (32 * kb + l31) * KROW + 32 * s + 16 * hh);
        sacc[kb] = __builtin_amdgcn_mfma_f32_32x32x16_bf16(a, qf[s], sacc[kb], 0, 0, 0);
      }
    }
    float mx = sacc[0][0];
#pragma unroll
    for (int e = 1; e < 16; ++e) mx = fmaxf(mx, sacc[0][e]);
#pragma unroll
    for (int e = 0; e < 16; ++e) mx = fmaxf(mx, sacc[1][e]);
    {
      const unsigned mu = __float_as_uint(mx);
      const auto sw = __builtin_amdgcn_permlane32_swap(mu, mu, false, false);
      mx = fmaxf(__uint_as_float(sw[0]), __uint_as_float(sw[1]));
    }
    if (t == 0 || !__all(mx <= 8.f)) {
      const float d = (t == 0) ? mx : fmaxf(mx, 0.f);
      const float alpha = __builtin_amdgcn_exp2f(-d);
      m_run += d;
      l_run *= alpha;
#pragma unroll
      for (int e = 0; e < 16; ++e) { oacc[0][e] *= alpha; oacc[1][e] *= alpha; sacc[0][e] -= d; sacc[1][e] -= d; }
    }
    float ps = 0.f;
#pragma unroll
    for (int kb = 0; kb < 2; ++kb)
#pragma unroll
      for (int e = 0; e < 16; ++e) { const float pv = __builtin_amdgcn_exp2f(sacc[kb][e]); sacc[kb][e] = pv; ps += pv; }
    l_run += ps;
#pragma unroll
    for (int kb = 0; kb < 2; ++kb)
#pragma unroll
      for (int s2 = 0; s2 < 2; ++s2) {
        const bf16x8 pfr = pack8(sacc[kb], 8 * s2);
#pragma unroll
        for (int dt = 0; dt < 2; ++dt) {
          const bf16x8 a = ld2x8((const u16*)(Vl + (32 * dt + l31) * VROW) + 32 * kb + 16 * s2 + 4 * hh);
          oacc[dt] = __builtin_amdgcn_mfma_f32_32x32x16_bf16(a, pfr, oacc[dt], 0, 0, 0);
        }
      }
    __builtin_amdgcn_sched_barrier(0);
    {
      char* nb = smem + (cur ^ 1) * BUFB;
      *(uint4*)(nb + kdst0) = kr0; *(uint4*)(nb + kdst1) = kr1; *(uint4*)(nb + kdst2) = kr2;
      *(uint4*)(nb + vdst0) = vr0; *(uint4*)(nb + vdst1) = vr1;
    }
    __syncthreads();
  }
  l_run += __shfl_xor(l_run, 32);
  const float inv = 1.f / l_run;
  u16* op = p.h + (size_t)RG * 512 + (size_t)(r0 + 32 * wid + l31) * 512 + h * 64;
#pragma unroll
  for (int dt = 0; dt < 2; ++dt)
#pragma unroll
    for (int gq_ = 0; gq_ < 4; ++gq_) {
      const int dv0 = 32 * dt + 8 * gq_ + 4 * hh;
      uint2 o;
      o.x = pack2(oacc[dt][4 * gq_ + 0] * inv, oacc[dt][4 * gq_ + 1] * inv);
      o.y = pack2(oacc[dt][4 * gq_ + 2] * inv, oacc[dt][4 * gq_ + 3] * inv);
      *(uint2*)(op + dv0) = o;
    }
}

__device__ void gla_out(const Params& p, int l, int it) {
  const int tid = TIDX, lane = tid & 63, wid = tid >> 6, l31 = lane & 31, hh = lane >> 5;
  const int bl = it / (NCHUNK * 4), rem = it % (NCHUNK * 4), cidx = rem >> 2, h = rem & 3;
  const int r0 = chunk_row(bl, cidx, NBG);
  u16* tiles = (u16*)smem;
  u16* vT = (u16*)(smem + 36864);
  float* part = (float*)(smem + 55296);
  {
    const int t = tid >> 2, c16 = (tid & 3) * 16;
#pragma unroll
    for (int a = 0; a < 4; ++a) {
      const u16* src = p.gq + (size_t)a * RG * 256 + (size_t)(r0 + t) * 256 + h * 64 + c16;
      const uint4 u0 = *(const uint4*)src, u1 = *(const uint4*)(src + 8);
      u16* d = tiles + a * 4608 + t * 72 + c16;
      *(uint4*)d = u0; *(uint4*)(d + 8) = u1;
    }
    const int dvc = (tid & 3) * 32;
    const u16* vp = p.proj + (size_t)(r0 + t) * INW + C_VA + h * 128 + dvc;
#pragma unroll
    for (int i = 0; i < 4; ++i) {
      const uint4 vv = *(const uint4*)(vp + i * 8);
      u16* dst = vT + (size_t)(dvc + i * 8) * 72 + t;
      dst[0] = (u16)(vv.x & 0xffff); dst[72] = (u16)(vv.x >> 16);
      dst[144] = (u16)(vv.y & 0xffff); dst[216] = (u16)(vv.y >> 16);
      dst[288] = (u16)(vv.z & 0xffff); dst[360] = (u16)(vv.z >> 16);
      dst[432] = (u16)(vv.w & 0xffff); dst[504] = (u16)(vv.w >> 16);
    }
  }
  const int itl = wid & 1, dvh = wid >> 1;
  const size_t cb = ((size_t)(bl * NCHUNK + cidx) * 4 + h) * 2;
  bf16x8 sfr[2][2][4];
#pragma unroll
  for (int dir = 0; dir < 2; ++dir)
#pragma unroll
    for (int dt = 0; dt < 2; ++dt)
#pragma unroll
      for (int s4 = 0; s4 < 4; ++s4)
        sfr[dir][dt][s4] = *(const bf16x8*)(p.ss + (cb + dir) * 8192 + (64 * dvh + 32 * dt + l31) * 64 + 16 * s4 + 8 * hh);
  __syncthreads();
  f32x16 oacc[2];
#pragma unroll
  for (int e = 0; e < 16; ++e) { oacc[0][e] = 0.f; oacc[1][e] = 0.f; }
#pragma unroll
  for (int dir = 0; dir < 2; ++dir) {
    const u16* Qt = tiles + (dir * 2) * 4608;
    const u16* Kt = tiles + (dir * 2 + 1) * 4608;
    bf16x8 qfr[4];
#pragma unroll
    for (int s = 0; s < 4; ++s) qfr[s] = *(const bf16x8*)(Qt + (32 * itl + l31) * 72 + 16 * s + 8 * hh);
    f32x16 aacc[2];
#pragma unroll
    for (int jt = 0; jt < 2; ++jt) {
#pragma unroll
      for (int e = 0; e < 16; ++e) aacc[jt][e] = 0.f;
#pragma unroll
      for (int s = 0; s < 4; ++s) {
        const bf16x8 a = *(const bf16x8*)(Kt + (32 * jt + l31) * 72 + 16 * s + 8 * hh);
        aacc[jt] = __builtin_amdgcn_mfma_f32_32x32x16_bf16(a, qfr[s], aacc[jt], 0, 0, 0);
      }
      const int i_tok = 32 * itl + l31;
#pragma unroll
      for (int e = 0; e < 16; ++e) {
        const int j_tok = 32 * jt + (e & 3) + 8 * (e >> 2) + 4 * hh;
        const bool keep = dir ? (j_tok >= i_tok) : (j_tok <= i_tok);
        if (!keep) aacc[jt][e] = 0.f;
      }
    }
#pragma unroll
    for (int dt = 0; dt < 2; ++dt) {
      const int dvrow = 64 * dvh + 32 * dt + l31;
#pragma unroll
      for (int jt = 0; jt < 2; ++jt)
#pragma unroll
        for (int s2 = 0; s2 < 2; ++s2) {
          const bf16x8 pfr = pack8(aacc[jt], 8 * s2);
          const bf16x8 a = ld2x8(vT + dvrow * 72 + 32 * jt + 16 * s2 + 4 * hh);
          oacc[dt] = __builtin_amdgcn_mfma_f32_32x32x16_bf16(a, pfr, oacc[dt], 0, 0, 0);
        }
#pragma unroll
      for (int s = 0; s < 4; ++s) {
        oacc[dt] = __builtin_amdgcn_mfma_f32_32x32x16_bf16(sfr[dir][dt][s], qfr[s], oacc[dt], 0, 0, 0);
      }
    }
  }
  float ss = 0.f;
#pragma unroll
  for (int e = 0; e < 16; ++e) ss += oacc[0][e] * oacc[0][e] + oacc[1][e] * oacc[1][e];
  ss += __shfl_xor(ss, 32);
  if (hh == 0) part[wid * 32 + l31] = ss;
  __syncthreads();
  const float totss = part[wid * 32 + l31] + part[(wid ^ 2) * 32 + l31];
  const float rstd = rsqrtf(totss * (1.f / 128.f) + EPS);
  const int r = r0 + 32 * itl + l31;
  const float* gam = p.in[10] + l * 512 + h * 128;
  u16* aa = p.h;
#pragma unroll
  for (int dt = 0; dt < 2; ++dt)
#pragma unroll
    for (int gq_ = 0; gq_ < 4; ++gq_) {
      const int dv0 = 64 * dvh + 32 * dt + 8 * gq_ + 4 * hh;
      const uint2 ra = *(const uint2*)(p.proj + (size_t)r * INW + C_RA + h * 128 + dv0);
      const float4 g4 = *(const float4*)(gam + dv0);
      uint2 o;
      o.x = pack2(oacc[dt][4 * gq_ + 0] * rstd * g4.x * silu_f(bflo(ra.x)), oacc[dt][4 * gq_ + 1] * rstd * g4.y * silu_f(bfhi(ra.x)));
      o.y = pack2(oacc[dt][4 * gq_ + 2] * rstd * g4.z * silu_f(bflo(ra.y)), oacc[dt][4 * gq_ + 3] * rstd * g4.w * silu_f(bfhi(ra.y)));
      *(uint2*)(aa + (size_t)r * 512 + h * 128 + dv0) = o;
    }
}

__device__ void phase_attn(const Params& p, int l, int* ctr) {
  const int nqb = (l == 1) ? 64 : 66, nck = (l == 1) ? 128 : NCHUNK;
  const int per_q = NBG * nqb;
  const int n_gla = NBG * nck * 4;
  run_q8(ctr, [=](int q_) { return per_q + ((n_gla - q_ + 7) >> 3); }, [&](int q_, int j_) {
    if (j_ < per_q) attn_item(p, ((j_ / nqb) * 8 + q_) * 66 + (j_ % nqb));
    else {
      const int gi = QA_ID(q_, j_ - per_q);
      gla_out(p, l, (gi / (nck * 4)) * (NCHUNK * 4) + gi % (nck * 4));
    }
  });
}

__device__ void phase_merge(const Params& p, int l, int* ctr) {
  const int MT = (l == 1 ? NBG * SEQ / 128 : RG / 128), NT = 16;
  const u16* wl = p.wt + (size_t)l * W_LAYER;
  run_q8(ctr, GEMM_CNT(MT, NT), [&](int q_, int j_) {
    int mt, nt; tile_order(j_, mlo(q_ + 1, MT) - mlo(q_, MT), NT, mt, nt); mt += mlo(q_, MT);
    const int tid = TIDX, lane = tid & 63, wid = tid >> 6;
    const int wr = wid >> 1, wc = wid & 1, fr = lane & 15, fq = lane >> 4;
    f32x4 macc[2][4], acc[2][4];
#pragma unroll
    for (int a = 0; a < 2; ++a)
#pragma unroll
      for (int b = 0; b < 4; ++b) { macc[a][b] = f32x4{0.f, 0.f, 0.f, 0.f}; acc[a][b] = f32x4{0.f, 0.f, 0.f, 0.f}; }
    const int srow = tid >> 3, schunk = (tid & 7) ^ ((tid >> 4) & 7);
    const size_t xo = (size_t)(mt * 128 + srow) * 512 + schunk * 8;
    const size_t wo = (size_t)(nt * 64 + srow) * 512 + schunk * 8;
    const u16* xg0 = p.h + xo;
    const u16* xg1 = p.h + (size_t)RG * 512 + xo;
    const u16* xg2 = p.uc + xo;
    const u16* wg0 = wl + W_BRA + wo;
    const u16* wg1 = wl + W_BRB + wo;
    const u16* wg2 = wl + W_BRC + wo;
    const int g = fr >> 1;
    const int lo0 = fr * 128 + ((fq ^ g) << 4), lo1 = fr * 128 + (((fq ^ g) ^ 4) << 4);
    const char* xb = smem + wr * 8192;
    const char* wb = smem + 16384 + wc * 4096;
    char* sdst = smem + tid * 16;
    const u16* gbase = p.proj + (size_t)(mt * 128 + wr * 64 + fr) * INW + C_GATE + nt * 64 + wc * 32 + fq * 4;
    uint2 gts[2][4];
#pragma unroll
    for (int wi = 0; wi < 2; ++wi)
#pragma unroll
      for (int xi = 0; xi < 4; ++xi) gts[wi][xi] = *(const uint2*)(gbase + (size_t)xi * 16 * INW + wi * 16);
    __syncthreads();
#pragma unroll
    for (int i = 0; i < 4; ++i) {
      glds16(xg0 + i * (32 * 512), sdst + i * 4096);
      if (i < 2) glds16(wg0 + i * (32 * 512), sdst + 16384 + i * 4096);
    }
    for (int kt = 0; kt < 24; ++kt) {
      asm volatile("s_waitcnt vmcnt(0)" ::: "memory");
      __syncthreads();
      const int cb = (kt & 1) * 32768;
      if (kt + 1 < 24) {
        const int nbr = (kt + 1) >> 3, ko = ((kt + 1) & 7) * 64, nb = 32768 - cb;
        const u16* xg = (nbr == 0 ? xg0 : nbr == 1 ? xg1 : xg2) + ko;
        const u16* wg = (nbr == 0 ? wg0 : nbr == 1 ? wg1 : wg2) + ko;
#pragma unroll
        for (int i = 0; i < 4; ++i) {
          glds16(xg + i * (32 * 512), sdst + nb + i * 4096);
          if (i < 2) glds16(wg + i * (32 * 512), sdst + nb + 16384 + i * 4096);
        }
      }
      bf16x8 wf[2][2], xf[2][4];
#pragma unroll
      for (int i = 0; i < 2; ++i) {
        wf[0][i] = *(const bf16x8*)(wb + cb + i * 2048 + lo0);
        wf[1][i] = *(const bf16x8*)(wb + cb + i * 2048 + lo1);
      }
#pragma unroll
      for (int i = 0; i < 4; ++i) {
        xf[0][i] = *(const bf16x8*)(xb + cb + i * 2048 + lo0);
        xf[1][i] = *(const bf16x8*)(xb + cb + i * 2048 + lo1);
      }
      __builtin_amdgcn_sched_barrier(0);
#pragma unroll
      for (int k = 0; k < 2; ++k)
#pragma unroll
        for (int wi = 0; wi < 2; ++wi)
#pragma unroll
          for (int xi = 0; xi < 4; ++xi)
            acc[wi][xi] = __builtin_amdgcn_mfma_f32_16x16x32_bf16(wf[k][wi], xf[k][xi], acc[wi][xi], 0, 0, 0);
      __builtin_amdgcn_sched_barrier(0);
      if ((kt & 7) == 7) {
        const int br = kt >> 3;
#pragma unroll
        for (int wi = 0; wi < 2; ++wi)
#pragma unroll
          for (int xi = 0; xi < 4; ++xi) {
            const uint2 gt = gts[wi][xi];
            macc[wi][xi][0] += sigmoid_f(bflo(gt.x)) * acc[wi][xi][0];
            macc[wi][xi][1] += sigmoid_f(bfhi(gt.x)) * acc[wi][xi][1];
            macc[wi][xi][2] += sigmoid_f(bflo(gt.y)) * acc[wi][xi][2];
            macc[wi][xi][3] += sigmoid_f(bfhi(gt.y)) * acc[wi][xi][3];
            acc[wi][xi] = f32x4{0.f, 0.f, 0.f, 0.f};
            if (br < 2) gts[wi][xi] = *(const uint2*)(gbase + (size_t)xi * 16 * INW + wi * 16 + (br + 1) * 1024);
          }
      }
    }
    uint2 o[2][4];
#pragma unroll
    for (int wi = 0; wi < 2; ++wi)
#pragma unroll
      for (int xi = 0; xi < 4; ++xi) {
        o[wi][xi].x = pack2(macc[wi][xi][0], macc[wi][xi][1]); o[wi][xi].y = pack2(macc[wi][xi][2], macc[wi][xi][3]);
      }
    store_tile_bf16<2>(o, p.m + (size_t)(mt * 128 + wr * 64) * DM + nt * 64 + wc * 32, DM);
  });
}

__device__ void phase_resid(const Params& p, int l, int g, int which, int* ctr) {
  const int MT = (l == 1 ? NBG * SEQ / 128 : RG / 128), NT = 8;
  const u16* wl = p.wt + (size_t)l * W_LAYER;
  const u16* X = which == 0 ? p.m : p.proj + (size_t)RG * DFF;
  const int ldx = which == 0 ? DM : DFF, K = which == 0 ? DM : DFF;
  const u16* W = wl + (which == 0 ? W_O : W_DN);
  const int goff = which == 0 ? 2048 : 5120;
  const int from_input = (which == 0 && l == 0);
  run_q8(ctr, GEMM_CNT(MT, NT), [&](int q_, int j_) {
    int mt, nt; tile_order(j_, mlo(q_ + 1, MT) - mlo(q_, MT), NT, mt, nt); mt += mlo(q_, MT);
    f32x4 acc[4][4];
    gemm_core<4>(X + (size_t)mt * 128 * ldx, ldx, W + (size_t)nt * 128 * K, K, K, acc);
    EPI_VARS
    const float* mrow = p.mod + ((size_t)l * 9 + mod_index(p, g, mt * 128)) * 6144 + goff + nt * 128 + wc_ * 64;
    __syncthreads();
    char* lb = smem + wid_ * 16384;
#pragma unroll
    for (int wi = 0; wi < 4; ++wi)
#pragma unroll
      for (int xi = 0; xi < 4; ++xi) {
        const int r = xi * 16 + fr_, c = wi * 4 + fq_;
        *(f32x4*)(lb + r * 256 + ((c ^ (r & 15)) << 4)) = acc[wi][xi];
      }
    const int c16 = lane_ & 15, rsub = lane_ >> 4;
    const float* xs = xsrc_row_ptr(p, g, mt * 128 + wr_ * 64, from_input) + nt * 128 + wc_ * 64 + c16 * 4;
    float* xd = xrow_ptr(p, g, mt * 128 + wr_ * 64) + nt * 128 + wc_ * 64 + c16 * 4;
    const float4 gv = *(const float4*)(mrow + c16 * 4);
#pragma unroll
    for (int half = 0; half < 2; ++half) {
      float4 xv[8];
#pragma unroll
      for (int it = 0; it < 8; ++it) xv[it] = *(const float4*)(xs + (size_t)((half * 8 + it) * 4 + rsub) * DM);
#pragma unroll
      for (int it = 0; it < 8; ++it) {
        const int row = (half * 8 + it) * 4 + rsub;
        const f32x4 a = *(const f32x4*)(lb + row * 256 + ((c16 ^ (row & 15)) << 4));
        float4 o;
        o.x = xv[it].x + gv.x * a[0]; o.y = xv[it].y + gv.y * a[1]; o.z = xv[it].z + gv.z * a[2]; o.w = xv[it].w + gv.w * a[3];
        *(float4*)(xd + (size_t)row * DM) = o;
      }
    }
  });
}

__device__ void phase_gu(const Params& p, int l, int* ctr) {
  const int MT = (l == 1 ? NBG * SEQ / 128 : RG / 128), NT = 44;
  const u16* W = p.wt + (size_t)l * W_LAYER + W_GU;
  run_q8(ctr, GEMM_CNT(MT, NT), [&](int q_, int j_) {
    int mt, nt; tile_order(j_, mlo(q_ + 1, MT) - mlo(q_, MT), NT, mt, nt); mt += mlo(q_, MT);
    f32x4 acc[4][4];
    gemm_core<4>(p.h + (size_t)mt * 128 * DM, DM, W + (size_t)nt * 128 * DM, DM, DM, acc);
    EPI_VARS
    u16* dst = p.proj + (nt >= 22 ? (size_t)RG * DFF : 0);
    const int nb = (nt >= 22 ? nt - 22 : nt) * 128;
    uint2 o[4][4];
#pragma unroll
    for (int wi = 0; wi < 4; ++wi)
#pragma unroll
      for (int xi = 0; xi < 4; ++xi) {
        o[wi][xi].x = pack2(acc[wi][xi][0], acc[wi][xi][1]); o[wi][xi].y = pack2(acc[wi][xi][2], acc[wi][xi][3]);
      }
    store_tile_bf16<4>(o, dst + (size_t)(mt * 128 + wr_ * 64) * DFF + nb + wc_ * 64, DFF);
  });
}

struct ActIn { uint4 g0, g1, g2, uu; float4 w0a, w0b, w1a, w1b, w2a, w2b, ba, bb; };
__device__ __forceinline__ void act_load(ActIn& a, const u16* G, const u16* UP, const float* cw, const float* cb, int r, int c0) {
  int bl, pos, isctx; rowinfo(r, NBG, bl, pos, isctx);
  const int L = isctx ? CTXL : SEQ;
  const u16* gp = G + (size_t)r * DFF + c0;
  a.g1 = *(const uint4*)gp;
  a.g0 = make_uint4(0, 0, 0, 0); a.g2 = a.g0;
  if (pos > 0) a.g0 = *(const uint4*)(gp - DFF);
  if (pos < L - 1) a.g2 = *(const uint4*)(gp + DFF);
  a.uu = *(const uint4*)(UP + (size_t)r * DFF + c0);
  a.w0a = *(const float4*)(cw + c0); a.w0b = *(const float4*)(cw + c0 + 4);
  a.w1a = *(const float4*)(cw + DFF + c0); a.w1b = *(const float4*)(cw + DFF + c0 + 4);
  a.w2a = *(const float4*)(cw + 2 * DFF + c0); a.w2b = *(const float4*)(cw + 2 * DFF + c0 + 4);
  a.ba = *(const float4*)(cb + c0); a.bb = *(const float4*)(cb + c0 + 4);
}
__device__ __forceinline__ uint4 act_compute(const ActIn& a) {
  uint4 o;
#define ACT2(G0, G1, G2, UU, W0L, W0H, W1L, W1H, W2L, W2H, BL, BH) \
  pack2(silu_f(W0L * bflo(G0) + W1L * bflo(G1) + W2L * bflo(G2) + BL) * bflo(UU), \
        silu_f(W0H * bfhi(G0) + W1H * bfhi(G1) + W2H * bfhi(G2) + BH) * bfhi(UU))
  o.x = ACT2(a.g0.x, a.g1.x, a.g2.x, a.uu.x, a.w0a.x, a.w0a.y, a.w1a.x, a.w1a.y, a.w2a.x, a.w2a.y, a.ba.x, a.ba.y);
  o.y = ACT2(a.g0.y, a.g1.y, a.g2.y, a.uu.y, a.w0a.z, a.w0a.w, a.w1a.z, a.w1a.w, a.w2a.z, a.w2a.w, a.ba.z, a.ba.w);
  o.z = ACT2(a.g0.z, a.g1.z, a.g2.z, a.uu.z, a.w0b.x, a.w0b.y, a.w1b.x, a.w1b.y, a.w2b.x, a.w2b.y, a.bb.x, a.bb.y);
  o.w = ACT2(a.g0.w, a.g1.w, a.g2.w, a.uu.w, a.w0b.z, a.w0b.w, a.w1b.z, a.w1b.w, a.w2b.z, a.w2b.w, a.bb.z, a.bb.w);
#undef ACT2
  return o;
}

__device__ void phase_act(const Params& p, int l, int* ctr) {
  const int nitems = (l == 1) ? NBG * SEQ / 8 : RG / 8;
  const float* cw = p.in[23] + (size_t)l * 3 * DFF;
  const float* cb = p.in[24] + (size_t)l * DFF;
  const u16* G = p.proj;
  u16* UP = p.proj + (size_t)RG * DFF;
  for (int it = blockIdx.x; it < nitems; it += gridDim.x) {
    const int tid = TIDX;
    for (int k = 0; k < 12; k += 2) {
      const int e0 = tid + k * 256, e1 = e0 + 256;
      const bool two = (k + 1 < 11);
      const int r0 = it * 8 + e0 / 352, c00 = (e0 % 352) * 8;
      const int r1 = it * 8 + (two ? e1 / 352 : 0), c01 = two ? (e1 % 352) * 8 : 0;
      ActIn a0, a1;
      act_load(a0, G, UP, cw, cb, r0, c00);
      act_load(a1, G, UP, cw, cb, r1, c01);
      const uint4 o0 = act_compute(a0), o1 = act_compute(a1);
      *(uint4*)(UP + (size_t)r0 * DFF + c00) = o0;
      if (two) *(uint4*)(UP + (size_t)r1 * DFF + c01) = o1;
    }
  }
}

__device__ void phase_final(const Params& p, int* ctr) {
  const int nitems = NBATCH * SEQ / 16;
  const float* gam = p.in[26];
  for (int it = blockIdx.x; it < nitems; it += gridDim.x) {
    const int lane = TIDX & 63, wid = TIDX >> 6;
    float* xr = p.out + ((size_t)it * 16 + wid * 4) * DM;
    float4 v[4][4], gg[4];
#pragma unroll
    for (int rr = 0; rr < 4; ++rr)
#pragma unroll
      for (int i = 0; i < 4; ++i) v[rr][i] = *(const float4*)(xr + (size_t)rr * DM + lane * 4 + i * 256);
#pragma unroll
    for (int i = 0; i < 4; ++i) gg[i] = *(const float4*)(gam + lane * 4 + i * 256);
#pragma unroll
    for (int rr = 0; rr < 4; ++rr) {
      float ss = 0.f;
#pragma unroll
      for (int i = 0; i < 4; ++i)
        ss += v[rr][i].x * v[rr][i].x + v[rr][i].y * v[rr][i].y + v[rr][i].z * v[rr][i].z + v[rr][i].w * v[rr][i].w;
      ss = wave_sum(ss);
      const float rstd = rsqrtf(ss * (1.f / 1024.f) + EPS);
#pragma unroll
      for (int i = 0; i < 4; ++i) {
        float4 o; o.x = v[rr][i].x * rstd * gg[i].x; o.y = v[rr][i].y * rstd * gg[i].y; o.z = v[rr][i].z * rstd * gg[i].z; o.w = v[rr][i].w * rstd * gg[i].w;
        *(float4*)(xr + (size_t)rr * DM + lane * 4 + i * 256) = o;
      }
    }
  }
}

#define XB_TMO      128
#define XB_XCNT(j)  (256  + 64 * (j))
#define XB_XSUB(j)  (1280 + 64 * (j))
#define XB_XGEN(j)  (2304 + 64 * (j))
#define XB_TOP      3328
#define XB_TOPGEN   3392
#define XCD_BAR_WORDS 3456
#define XB_SPIN_CAP (1u << 22)
#define LAS __attribute__((address_space(3)))
__device__ __forceinline__ unsigned xb_ld(unsigned* p)              { return __hip_atomic_load(p, __ATOMIC_RELAXED, __HIP_MEMORY_SCOPE_AGENT); }
__device__ __forceinline__ unsigned xb_add(unsigned* p, unsigned v) { return __hip_atomic_fetch_add(p, v, __ATOMIC_RELAXED, __HIP_MEMORY_SCOPE_AGENT); }
__device__ __forceinline__ unsigned xb_xcc_id() { return (unsigned)__builtin_amdgcn_s_getreg((3 << 11) | 20) & 0xFu; }
#define XB_SPIN(cond, bar) do { unsigned _sp = 0; while (cond) { __builtin_amdgcn_s_sleep(1); \
    if ((++_sp & 255u) == 0u) { if (xb_ld(&(bar)[XB_TMO])) break; if (_sp > XB_SPIN_CAP) { atomicAdd(&(bar)[XB_TMO], 1u); break; } } } } while (0)
struct XcdBarrier { unsigned* bar; unsigned x; volatile LAS unsigned* st; };
__device__ __forceinline__ XcdBarrier xcd_barrier_post(unsigned* bar, volatile LAS unsigned* st) {
  XcdBarrier b; b.bar = bar; b.x = xb_xcc_id(); b.st = st;
  if (threadIdx.x == 0) (void)xb_add(&bar[XB_XCNT(b.x)], 1u);
  return b;
}
__device__ __forceinline__ void xcd_barrier_complete(unsigned* bar, unsigned x, unsigned& nloc, unsigned& nx) {
  const unsigned G = gridDim.x * gridDim.y * gridDim.z;
  unsigned sum, cnt, mine, sp = 0u;
  for (;;) {
    sum = 0u; cnt = 0u; mine = 0u;
#pragma unroll
    for (unsigned j = 0; j < 16; ++j) { const unsigned c = xb_ld(&bar[XB_XCNT(j)]); sum += c; cnt += (c > 0u) ? 1u : 0u; mine = (j == x) ? c : mine; }
    if (sum == G) break;
    __builtin_amdgcn_s_sleep(1);
    if ((++sp & 255u) == 0u) { if (xb_ld(&bar[XB_TMO])) break; if (sp > XB_SPIN_CAP) { atomicAdd(&bar[XB_TMO], 1u); break; } }
  }
  nloc = mine > 0u ? mine : 1u; nx = cnt > 0u ? cnt : 1u;
}
__device__ __forceinline__ void xcd_barrier(const XcdBarrier& b) {
  asm volatile("s_waitcnt vmcnt(0)" ::: "memory");
  __syncthreads();
  if (threadIdx.x == 0) {
    unsigned* bar = b.bar;
    __builtin_amdgcn_s_waitcnt(0);
    unsigned nloc = b.st[0], nx = b.st[1];
    if (nloc == 0u) { xcd_barrier_complete(bar, b.x, nloc, nx); b.st[0] = nloc; b.st[1] = nx; }
    const unsigned old = xb_add(&bar[XB_XSUB(b.x)], 1u);
    const unsigned gen = old / nloc;
    if (old + 1u == (gen + 1u) * nloc) {
      __builtin_amdgcn_fence(__ATOMIC_RELEASE, "agent");
      asm volatile("s_waitcnt vmcnt(0)" ::: "memory");
      const unsigned og = xb_add(&bar[XB_TOP], 1u);
      const unsigned tg = og / nx;
      if (og + 1u == (tg + 1u) * nx) xb_add(&bar[XB_TOPGEN], 1u);
      else XB_SPIN(xb_ld(&bar[XB_TOPGEN]) == tg, bar);
      __builtin_amdgcn_fence(__ATOMIC_ACQUIRE, "agent");
      xb_add(&bar[XB_XGEN(b.x)], 1u);
      asm volatile("s_waitcnt vmcnt(0)" ::: "memory");
    } else {
      XB_SPIN(xb_ld(&bar[XB_XGEN(b.x)]) == gen, bar);
      __builtin_amdgcn_fence(__ATOMIC_ACQUIRE, "agent");
      asm volatile("s_waitcnt vmcnt(0)" ::: "memory");
    }
  }
  __syncthreads();
}

__device__ void run_phase(const Params& p, int ph, int* ctr) {
  if (ph == 0) { phase0(p, ctr); return; }
  if (ph == NPHASES - 1) { phase_final(p, ctr); return; }
  const int idx = ph - 1, lg = idx / NPH_PER, sub = idx % NPH_PER;
  const int l = lg / NGRP, g = lg % NGRP;
  switch (sub) {
    case 0: phase_norm(p, l, g, 0, ctr); break;
    case 1: phase_proj(p, l, ctr); break;
    case 2: phase_postproj(p, l, ctr); break;
    case 3: phase_qkv(p, l, ctr); break;
    case 4: phase_attn(p, l, ctr); break;
    case 5: phase_merge(p, l, ctr); break;
    case 6: phase_resid(p, l, g, 0, ctr); break;
    case 7: phase_norm(p, l, g, 1, ctr); break;
    case 8: phase_gu(p, l, ctr); break;
    case 9: phase_act(p, l, ctr); break;
    default: phase_resid(p, l, g, 1, ctr); break;
  }
}

__global__ void __launch_bounds__(256, 2) mega_kernel(KArgs ka, int ph_lo, int ph_hi, int coop) {
  Params p;
#pragma unroll
  for (int i = 0; i < 27; ++i) p.in[i] = ka.in[i];
  p.out = ka.out;
  char* ws = ka.ws;
  p.ctr = (int*)(ws + O_CTR); p.mod = (float*)(ws + O_MOD); p.rope = (float*)(ws + O_ROPE); p.xc = (float*)(ws + O_XC);
  p.rstdq = (float*)(ws + O_RSQ); p.rstdkv = (float*)(ws + O_RSKV); p.dec = (float*)(ws + O_DEC); p.wt = (u16*)(ws + O_WT);
  p.proj = (u16*)(ws + O_PROJ); p.h = (u16*)(ws + O_H); p.m = (u16*)(ws + O_M); p.q = (u16*)(ws + O_Q);
  p.kf = (u16*)(ws + O_KF); p.vt = (u16*)(ws + O_VT); p.uc = (u16*)(ws + O_UC); p.gq = (u16*)(ws + O_GQ);
  p.ss = (u16*)(ws + O_SS);
  volatile LAS unsigned* st = (volatile LAS unsigned*)(smem + SLOT_OFF + 64);
  if (threadIdx.x == 0) { st[0] = 0u; st[1] = 0u; }
  __syncthreads();
  XcdBarrier xb;
  xb.bar = (unsigned*)(ws + O_BAR); xb.x = 0; xb.st = st;
  if (coop) xb = xcd_barrier_post((unsigned*)(ws + O_BAR), st);
  for (int ph = ph_lo; ph < ph_hi; ++ph) {
#ifdef PROBE_MASK
    const int nrep = (ph > 0 && ph < NPHASES - 1 && ((PROBE_MASK >> ((ph - 1) % NPH_PER)) & 1)) ? 2 : 1;
#else
    const int nrep = 1;
#endif
    for (int rep = 0; rep < nrep; ++rep) {
      if (rep) xcd_barrier(xb);
      run_phase(p, ph, p.ctr + rep * 512 + ph * 8);
    }
    if (coop && ph + 1 < ph_hi) {
      if (ph == ph_lo) cg::this_grid().sync();
      else xcd_barrier(xb);
    }
  }
}

static inline size_t align_up(size_t v) { return (v + 255) & ~(size_t)255; }

extern "C" void kernel_launch(void* const* d_in, const int* in_sizes, int n_in, void* d_out, int out_size,
                              void* d_ws, size_t ws_size, hipStream_t stream) {
  static int grid_blocks = 0;
  if (!grid_blocks) {
    int dev = 0, cus = 0, per_cu = 0;
    hipGetDevice(&dev);
    hipDeviceGetAttribute(&cus, hipDeviceAttributeMultiprocessorCount, dev);
    hipFuncSetAttribute((const void*)mega_kernel, hipFuncAttributeMaxDynamicSharedMemorySize, LDS_BYTES);
    hipOccupancyMaxActiveBlocksPerMultiprocessor(&per_cu, (const void*)mega_kernel, 256, LDS_BYTES);
    if (per_cu < 1) per_cu = 1;
    if (per_cu > 2) per_cu = 2;
    grid_blocks = cus * per_cu;
  }
  KArgs p{};
  for (int i = 0; i < 27; ++i) p.in[i] = (const float*)d_in[i];
  p.out = (float*)d_out;
  p.ws = (char*)d_ws;
  if (ws_size < WS_END) { fprintf(stderr, "workspace too small: %zu < %zu\n", ws_size, (size_t)WS_END); return; }
  hipMemsetAsync((char*)d_ws + O_CTR, 0, 4096 + XCD_BAR_BYTES, stream);
#if SINGLE_LAUNCH
  int lo = 0, hi = NPHASES, coop = 1;
  void* args[] = {&p, &lo, &hi, &coop};
  hipError_t e = hipLaunchCooperativeKernel((const void*)mega_kernel, dim3(grid_blocks), dim3(256), args, LDS_BYTES, stream);
  if (e != hipSuccess) fprintf(stderr, "cooperative launch failed: %s (grid %d)\n", hipGetErrorString(e), grid_blocks);
#else
  for (int ph = 0; ph < NPHASES; ++ph)
    hipLaunchKernelGGL(mega_kernel, dim3(grid_blocks), dim3(256), LDS_BYTES, stream, p, ph, ph + 1, 0);
#endif
}
```

```cpp
#include <hip/hip_runtime.h>
#include <hip/hip_cooperative_groups.h>
#include <cstdio>
#include <cstdint>
namespace cg = cooperative_groups;

typedef unsigned short u16;
typedef __attribute__((ext_vector_type(8))) short bf16x8;
typedef __attribute__((ext_vector_type(4))) float f32x4;
typedef __attribute__((ext_vector_type(16))) float f32x16;

#ifndef SINGLE_LAUNCH
#define SINGLE_LAUNCH 1
#endif

constexpr int DM = 1024, SEQ = 8192, CTXL = 256, NBATCH = 8, INW = 6592, INWP = 6656, DFF = 2816;
constexpr int C_QA = 0, C_KA = 256, C_VA = 512, C_RA = 1024, C_ALR = 1536, C_CQ = 1568, C_CKV = 1824,
              C_KR = 1952, C_SB = 1984, C_SC = 2496, C_SX = 3008, C_GATE = 3520;
constexpr int NKEY = SEQ + CTXL;
constexpr int NCHUNK = NKEY / 64;
constexpr float EPS = 1e-6f;
constexpr int LDS_BYTES = 65536 + 256;
constexpr int SLOT_OFF = 65536;
constexpr int NPH_PER = 11;
constexpr int NBG = 4;
constexpr int NGRP = NBATCH / NBG;
constexpr int RG = NBG * (SEQ + CTXL);
constexpr int NPHASES = 1 + 2 * NGRP * NPH_PER + 1;

constexpr size_t W_IN = 0;
constexpr size_t W_UQ = W_IN + (size_t)INWP * 1024;
constexpr size_t W_UKV = W_UQ + 768 * 256;
constexpr size_t W_BRA = W_UKV + 1024 * 128;
constexpr size_t W_BRB = W_BRA + 1024 * 512;
constexpr size_t W_BRC = W_BRB + 1024 * 512;
constexpr size_t W_O = W_BRC + 1024 * 512;
constexpr size_t W_GU = W_O + 1024 * 1024;
constexpr size_t W_DN = W_GU + (size_t)5632 * 1024;
constexpr size_t W_LAYER = W_DN + (size_t)1024 * 2816;

struct KArgs {
  const float* in[27];
  float* out;
  char* ws;
};
struct Params {
  const float* in[27];
  float* out;
  float* xc;
  u16* wt;
  float* mod;
  float* rope;
  int* ctr;
  float* rstdq;
  float* rstdkv;
  float* dec;
  u16* proj;
  u16* h;
  u16* m;
  u16* q;
  u16* kf;
  u16* vt;
  u16* uc;
  u16* gq;
  u16* ss;
};
constexpr size_t al256(size_t v) { return (v + 255) & ~(size_t)255; }
constexpr size_t XCD_BAR_BYTES = 3456 * 4;
constexpr size_t O_CTR = 0;
constexpr size_t O_BAR = O_CTR + 4096;
constexpr size_t O_MOD = al256(O_BAR + XCD_BAR_BYTES);
constexpr size_t O_ROPE = al256(O_MOD + (size_t)2 * 9 * 6144 * 4);
constexpr size_t O_XC = al256(O_ROPE + 1024 * 2 * 4);
constexpr size_t O_RSQ = al256(O_XC + (size_t)NBATCH * CTXL * DM * 4);
constexpr size_t O_RSKV = al256(O_RSQ + (size_t)RG * 4);
constexpr size_t O_DEC = al256(O_RSKV + (size_t)RG * 4);
constexpr size_t O_WT = al256(O_DEC + (size_t)NBG * NCHUNK * 4 * 2 * 64 * 4);
constexpr size_t O_PROJ = al256(O_WT + 2 * W_LAYER * 2);
constexpr size_t O_H = al256(O_PROJ + (size_t)RG * INW * 2);
constexpr size_t O_M = O_H + (size_t)RG * DM * 2;
constexpr size_t O_Q = al256(O_M + (size_t)RG * DM * 2);
constexpr size_t O_KF = al256(O_Q + (size_t)RG * 768 * 2);
constexpr size_t O_VT = al256(O_KF + (size_t)NBG * 8 * NKEY * 96 * 2);
constexpr size_t O_UC = al256(O_VT + (size_t)NBG * 8 * 64 * NKEY * 2);
constexpr size_t O_GQ = al256(O_UC + (size_t)RG * 512 * 2);
constexpr size_t O_SS = al256(O_GQ + (size_t)RG * 1024 * 2);
constexpr size_t WS_END = al256(O_SS + (size_t)NBG * NCHUNK * 4 * 2 * 8192 * 2);
static_assert(WS_END <= ((size_t)1 << 30), "workspace layout must fit 1 GiB");

extern __shared__ __attribute__((aligned(16))) char smem[];

typedef __bf16 hbf2 __attribute__((ext_vector_type(2)));
typedef float hf2 __attribute__((ext_vector_type(2)));
__device__ __forceinline__ unsigned pack2(float a, float b) {
  hf2 v = {a, b};
  return __builtin_bit_cast(unsigned, __builtin_convertvector(v, hbf2));
}
__device__ __forceinline__ u16 f2bf(float f) { return (u16)(pack2(f, 0.f) & 0xffffu); }
__device__ __forceinline__ float bf2f(u16 h) { return __uint_as_float(((unsigned)h) << 16); }
__device__ __forceinline__ float bflo(unsigned u) { return __uint_as_float(u << 16); }
__device__ __forceinline__ float bfhi(unsigned u) { return __uint_as_float(u & 0xffff0000u); }
__device__ __forceinline__ float silu_f(float x) { return x / (1.f + __expf(-x)); }
__device__ __forceinline__ float sigmoid_f(float x) { return 1.f / (1.f + __expf(-x)); }

__device__ __forceinline__ void rowinfo(int r, int NB, int& bl, int& pos, int& isctx) {
  const int nl = NB * SEQ;
  if (r < nl) { bl = r >> 13; pos = r & (SEQ - 1); isctx = 0; }
  else { const int rc = r - nl; bl = rc >> 8; pos = rc & (CTXL - 1); isctx = 1; }
}
__device__ __forceinline__ int chunk_row(int bl, int cidx, int NB) {
  return cidx < 128 ? bl * SEQ + cidx * 64 : NB * SEQ + bl * CTXL + (cidx - 128) * 64;
}

template <class CntF, class BodyF>
__device__ __forceinline__ void run_q8(int* ctr8, CntF cntf, BodyF body) {
  volatile int* slot = (volatile int*)(smem + SLOT_OFF);
  int q = blockIdx.x & 7, tries = 0, item;
  __syncthreads();
  if (threadIdx.x == 0) {
    int v = atomicAdd(&ctr8[q], 1);
    while (v >= cntf(q) && tries < 8) { q = (q + 1) & 7; ++tries; if (tries < 8) v = atomicAdd(&ctr8[q], 1); }
    slot[0] = (tries < 8) ? v : -1; slot[1] = q; slot[2] = tries;
  }
  __syncthreads();
  item = slot[0]; q = slot[1]; tries = slot[2];
  while (item >= 0) {
    int nxt = 0;
    if (threadIdx.x == 0) nxt = atomicAdd(&ctr8[q], 1);
    body(q, item);
    __syncthreads();
    if (threadIdx.x == 0) {
      int qq = q, t = tries;
      while (nxt >= cntf(qq) && t < 8) { qq = (qq + 1) & 7; ++t; if (t < 8) nxt = atomicAdd(&ctr8[qq], 1); }
      slot[0] = (t < 8) ? nxt : -1; slot[1] = qq; slot[2] = t;
    }
    __syncthreads();
    item = slot[0]; q = slot[1]; tries = slot[2];
  }
}
#define QA_CNT(N) [=](int q_) { return ((N) - q_ + 7) >> 3; }
#define QA_ID(q_, j_) ((j_) * 8 + (q_))

__device__ __forceinline__ int opaque_tid() {
  int t = threadIdx.x;
  asm volatile("" : "+v"(t));
  return t;
}
#define TIDX opaque_tid()
__device__ __forceinline__ float wave_sum(float v) {
  v += __shfl_xor(v, 32); v += __shfl_xor(v, 16); v += __shfl_xor(v, 8);
  v += __shfl_xor(v, 4); v += __shfl_xor(v, 2); v += __shfl_xor(v, 1);
  return v;
}

__device__ __forceinline__ int lds_byte(int r, int c) {
  const int st = (r >> 4) * 2 + (c >> 5), rr = r & 15, cc = c & 31, ob = rr * 64 + cc * 2;
  return st * 1024 + (ob ^ (((ob >> 9) & 1) << 5));
}
__device__ __forceinline__ void stage_rc(int b, int& R, int& C) {
  const int st = b >> 10, sb = b & 1023, swz = sb ^ (((sb >> 9) & 1) << 5);
  R = (st >> 1) * 16 + (swz >> 6); C = (st & 1) * 32 + ((swz & 63) >> 1);
}

__device__ __forceinline__ void glds16(const void* g, void* l) {
  __builtin_amdgcn_global_load_lds((const __attribute__((address_space(1))) unsigned*)g,
                                   (__attribute__((address_space(3))) unsigned*)l, 16, 0, 0);
}

template <int NWI>
__device__ __forceinline__ void gemm_core(const u16* __restrict__ X, int ldx, const u16* __restrict__ W, int ldw,
                                          int K, f32x4 (&acc)[NWI][4]) {
  const int tid = TIDX, lane = tid & 63, wid = tid >> 6;
  const int wr = wid >> 1, wc = wid & 1, fr = lane & 15, fq = lane >> 4;
#pragma unroll
  for (int a = 0; a < NWI; ++a)
#pragma unroll
    for (int b = 0; b < 4; ++b) acc[a][b] = f32x4{0.f, 0.f, 0.f, 0.f};
  const int srow = tid >> 3, schunk = (tid & 7) ^ ((tid >> 4) & 7);
  const u16* xg = X + (size_t)srow * ldx + schunk * 8;
  const u16* wg = W + (size_t)srow * ldw + schunk * 8;
  const int xs = 32 * ldx, ws_ = 32 * ldw;
  const int g = fr >> 1;
  const int lo0 = fr * 128 + ((fq ^ g) << 4), lo1 = fr * 128 + (((fq ^ g) ^ 4) << 4);
  const char* xb = smem + wr * 8192;
  const char* wb = smem + 16384 + wc * (NWI * 2048);
  char* sdst = smem + tid * 16;
  const int nt = K >> 6;
  __syncthreads();
#pragma unroll
  for (int i = 0; i < 4; ++i) {
    glds16(xg + i * xs, sdst + i * 4096);
    if (i < NWI) glds16(wg + i * ws_, sdst + 16384 + i * 4096);
  }
  for (int kt = 0; kt < nt; ++kt) {
    asm volatile("s_waitcnt vmcnt(0)" ::: "memory");
    __syncthreads();
    const int cb = (kt & 1) * 32768;
    if (kt + 1 < nt) {
      const int nb = 32768 - cb;
      const int ko = (kt + 1) * 64;
#pragma unroll
      for (int i = 0; i < 4; ++i) {
        glds16(xg + i * xs + ko, sdst + nb + i * 4096);
        if (i < NWI) glds16(wg + i * ws_ + ko, sdst + nb + 16384 + i * 4096);
      }
    }
    bf16x8 wf[2][NWI], xf[2][4];
#pragma unroll
    for (int i = 0; i < NWI; ++i) {
      wf[0][i] = *(const bf16x8*)(wb + cb + i * 2048 + lo0);
      wf[1][i] = *(const bf16x8*)(wb + cb + i * 2048 + lo1);
    }
#pragma unroll
    for (int i = 0; i < 4; ++i) {
      xf[0][i] = *(const bf16x8*)(xb + cb + i * 2048 + lo0);
      xf[1][i] = *(const bf16x8*)(xb + cb + i * 2048 + lo1);
    }
    __builtin_amdgcn_sched_barrier(0);
#pragma unroll
    for (int k = 0; k < 2; ++k)
#pragma unroll
      for (int wi = 0; wi < NWI; ++wi)
#pragma unroll
        for (int xi = 0; xi < 4; ++xi)
          acc[wi][xi] = __builtin_amdgcn_mfma_f32_16x16x32_bf16(wf[k][wi], xf[k][xi], acc[wi][xi], 0, 0, 0);
    __builtin_amdgcn_sched_barrier(0);
  }
}

#define EPI_VARS const int tid_ = TIDX, lane_ = tid_ & 63, wid_ = tid_ >> 6; \
  const int wr_ = wid_ >> 1, wc_ = wid_ & 1, fr_ = lane_ & 15, fq_ = lane_ >> 4; (void)fq_; (void)fr_; (void)wr_; (void)wc_;
#define EPI_TR(xi) (wr_ * 64 + (xi) * 16 + fr_)
#define EPI_NN(wi) (wc_ * 64 + (wi) * 16 + fq_ * 4)

template <int NWI>
__device__ __forceinline__ void store_tile_bf16(const uint2 (&o)[NWI][4], u16* dst_wave, size_t ld) {
  constexpr int RB = NWI * 32, CPR = RB / 16;
  const int tid = TIDX, lane = tid & 63, wid = tid >> 6, fr = lane & 15, fq = lane >> 4;
  char* lb = smem + wid * 8192;
#pragma unroll
  for (int wi = 0; wi < NWI; ++wi)
#pragma unroll
    for (int xi = 0; xi < 4; ++xi) {
      const int r = xi * 16 + fr, c = wi * 2 + (fq >> 1);
      *(uint2*)(lb + r * RB + ((c ^ (r & (CPR - 1))) << 4) + (fq & 1) * 8) = o[wi][xi];
    }
#pragma unroll
  for (int it = 0; it < CPR; ++it) {
    const int idx = it * 64 + lane, row = idx / CPR, c = idx % CPR;
    const uint4 v = *(const uint4*)(lb + row * RB + ((c ^ (row & (CPR - 1))) << 4));
    *(uint4*)(dst_wave + (size_t)row * ld + c * 8) = v;
  }
}

__device__ __forceinline__ void tile_order(int t, int MT, int NT, int& mt, int& nt) {
  constexpr int GM = 4;
  const int band = t / (GM * NT), rem = t - band * GM * NT;
  const int m0 = band * GM;
  const int gsz = min(GM, MT - m0);
  nt = rem / gsz; mt = m0 + rem - nt * gsz;
}

__device__ __forceinline__ int mlo(int q, int MT) { return (q * MT) >> 3; }
#define GEMM_CNT(MT, NT) [=](int q_) { return (mlo(q_ + 1, MT) - mlo(q_, MT)) * (NT); }

__device__ __forceinline__ float* xrow_ptr(const Params& p, int g, int r) {
  int bl, pos, isctx; rowinfo(r, NBG, bl, pos, isctx);
  const int b = g * NBG + bl;
  return isctx ? p.xc + ((size_t)b * CTXL + pos) * DM : p.out + ((size_t)b * SEQ + pos) * DM;
}
__device__ __forceinline__ const float* xsrc_row_ptr(const Params& p, int g, int r, int from_input) {
  int bl, pos, isctx; rowinfo(r, NBG, bl, pos, isctx);
  const int b = g * NBG + bl;
  if (from_input) return isctx ? p.in[2] + ((size_t)b * CTXL + pos) * DM : p.in[0] + ((size_t)b * SEQ + pos) * DM;
  return isctx ? p.xc + ((size_t)b * CTXL + pos) * DM : p.out + ((size_t)b * SEQ + pos) * DM;
}
__device__ __forceinline__ int mod_index(const Params& p, int g, int r) {
  int bl, pos, isctx; rowinfo(r, NBG, bl, pos, isctx);
  return isctx ? 8 : g * NBG + bl;
}

__device__ void conv_tile4(const float* __restrict__ src, int K, int N, u16* __restrict__ dst,
                           const float* __restrict__ scale, int ktile, int ngrp) {
  float* tile = (float*)smem;
  const int tid = TIDX;
  const int k0 = ktile * 64;
  const int kk = tid >> 4, n4 = (tid & 15) * 4;
  float4 v[4][4];
  float sc[4];
#pragma unroll
  for (int i = 0; i < 4; ++i) sc[i] = scale ? scale[k0 + kk + 16 * i] : 1.f;
#pragma unroll
  for (int t = 0; t < 4; ++t) {
    const int n0 = (ngrp * 4 + t) * 64;
#pragma unroll
    for (int i = 0; i < 4; ++i) {
      v[t][i] = make_float4(0.f, 0.f, 0.f, 0.f);
      if (n0 < N) v[t][i] = *(const float4*)(src + (size_t)(k0 + kk + 16 * i) * N + n0 + n4);
    }
  }
  const int nn = tid >> 3, k8 = (tid & 7) * 8;
#pragma unroll
  for (int t = 0; t < 4; ++t) {
    const int n0 = (ngrp * 4 + t) * 64;
    __syncthreads();
#pragma unroll
    for (int i = 0; i < 4; ++i) {
      const int k = kk + 16 * i;
      tile[k * 65 + n4 + 0] = v[t][i].x * sc[i]; tile[k * 65 + n4 + 1] = v[t][i].y * sc[i];
      tile[k * 65 + n4 + 2] = v[t][i].z * sc[i]; tile[k * 65 + n4 + 3] = v[t][i].w * sc[i];
    }
    __syncthreads();
#pragma unroll
    for (int i = 0; i < 2; ++i) {
      const int n = nn + 32 * i;
      uint4 o;
      o.x = pack2(tile[(k8 + 0) * 65 + n], tile[(k8 + 1) * 65 + n]);
      o.y = pack2(tile[(k8 + 2) * 65 + n], tile[(k8 + 3) * 65 + n]);
      o.z = pack2(tile[(k8 + 4) * 65 + n], tile[(k8 + 5) * 65 + n]);
      o.w = pack2(tile[(k8 + 6) * 65 + n], tile[(k8 + 7) * 65 + n]);
      *(uint4*)(dst + (size_t)(n0 + n) * K + k0 + k8) = o;
    }
  }
}

__device__ void sincos_d(double a, double& s, double& c) {
  const double k = rint(a * 0.6366197723675814);
  double r = fma(-k, 1.5707963267948966, a);
  r = fma(-k, 6.123233995736766e-17, r);
  const int q = ((int)k) & 3;
  const double r2 = r * r;
  const double sp = r * (1.0 + r2 * (-1.0 / 6 + r2 * (1.0 / 120 + r2 * (-1.0 / 5040 + r2 * (1.0 / 362880 + r2 * (-1.0 / 39916800 + r2 * (1.0 / 6227020800.0)))))));
  const double cp = 1.0 + r2 * (-0.5 + r2 * (1.0 / 24 + r2 * (-1.0 / 720 + r2 * (1.0 / 40320 + r2 * (-1.0 / 3628800 + r2 * (1.0 / 479001600.0 + r2 * (-1.0 / 87178291200.0)))))));
  s = (q == 0) ? sp : (q == 1) ? cp : (q == 2) ? -sp : -cp;
  c = (q == 0) ? cp : (q == 1) ? -sp : (q == 2) ? -cp : sp;
}

constexpr int CV_WIN = 0, CV_UQ = 416, CV_UKV = 428, CV_BRA = 436, CV_BRB = 468, CV_BRC = 500,
              CV_WO = 532, CV_GATE = 596, CV_UP = 772, CV_DN = 948, CV_LAYER = 1124;
constexpr int P0_CONV = 2 * CV_LAYER, P0_ADA = 2 * 192, P0_TOTAL = P0_CONV + P0_ADA + 1;

__device__ void phase0(const Params& p, int* ctr) {
  run_q8(ctr, QA_CNT(P0_TOTAL), [&](int q_, int j_) {
    const int it = QA_ID(q_, j_);
    const int tid = TIDX;
    if (it >= P0_ADA + 1) {
      const int ci = it - (P0_ADA + 1);
      const int l = ci / CV_LAYER, j = ci % CV_LAYER;
      u16* wl = p.wt + (size_t)l * W_LAYER;
      if (j < CV_UQ)       { const int jj = j - CV_WIN;  conv_tile4(p.in[7] + (size_t)l * 1024 * INW, 1024, INW, wl + W_IN, nullptr, jj / 26, jj % 26); }
      else if (j < CV_UKV) { const int jj = j - CV_UQ;   conv_tile4(p.in[12] + (size_t)l * 256 * 768, 256, 768, wl + W_UQ, p.in[11] + l * 256, jj / 3, jj % 3); }
      else if (j < CV_BRA) { const int jj = j - CV_UKV;  conv_tile4(p.in[14] + (size_t)l * 128 * 1024, 128, 1024, wl + W_UKV, p.in[13] + l * 128, jj / 4, jj % 4); }
      else if (j < CV_BRB) { const int jj = j - CV_BRA;  conv_tile4(p.in[16] + (size_t)l * 512 * 1024, 512, 1024, wl + W_BRA, nullptr, jj / 4, jj % 4); }
      else if (j < CV_BRC) { const int jj = j - CV_BRB;  conv_tile4(p.in[17] + (size_t)l * 512 * 1024, 512, 1024, wl + W_BRB, nullptr, jj / 4, jj % 4); }
      else if (j < CV_WO)  { const int jj = j - CV_BRC;  conv_tile4(p.in[18] + (size_t)l * 512 * 1024, 512, 1024, wl + W_BRC, nullptr, jj / 4, jj % 4); }
      else if (j < CV_GATE){ const int jj = j - CV_WO;   conv_tile4(p.in[19] + (size_t)l * 1024 * 1024, 1024, 1024, wl + W_O, nullptr, jj / 4, jj % 4); }
      else if (j < CV_UP)  { const int jj = j - CV_GATE; conv_tile4(p.in[21] + (size_t)l * 1024 * DFF, 1024, DFF, wl + W_GU, nullptr, jj / 11, jj % 11); }
      else if (j < CV_DN)  { const int jj = j - CV_UP;   conv_tile4(p.in[22] + (size_t)l * 1024 * DFF, 1024, DFF, wl + W_GU + (size_t)DFF * 1024, nullptr, jj / 11, jj % 11); }
      else                 { const int jj = j - CV_DN;   conv_tile4(p.in[25] + (size_t)l * DFF * 1024, DFF, 1024, wl + W_DN, nullptr, jj / 4, jj % 4); }
    } else if (it < P0_ADA) {
      const int a = it, l = a / 192, cg_ = a % 192;
      float* sc = (float*)smem;
      float* red = sc + 9 * 1024;
      for (int e = tid; e < 9 * 1024; e += 256) {
        const int v = e >> 10, k = e & 1023;
        const float cv = (v < 8) ? p.in[1][v * 1024 + k] : p.in[3][k];
        sc[e] = cv / (1.f + expf(-cv));
      }
      __syncthreads();
      const int kg = tid >> 5, cn = tid & 31;
      const float* wa = p.in[4] + (size_t)l * 1024 * 6144 + cg_ * 32 + cn;
      float a0 = 0, a1 = 0, a2 = 0, a3 = 0, a4 = 0, a5 = 0, a6 = 0, a7 = 0, a8 = 0;
#pragma unroll 8
      for (int i = 0; i < 128; ++i) {
        const int k = kg + 8 * i;
        const float w = wa[(size_t)k * 6144];
        a0 += sc[k] * w; a1 += sc[1024 + k] * w; a2 += sc[2048 + k] * w; a3 += sc[3072 + k] * w;
        a4 += sc[4096 + k] * w; a5 += sc[5120 + k] * w; a6 += sc[6144 + k] * w; a7 += sc[7168 + k] * w;
        a8 += sc[8192 + k] * w;
      }
      float* rr = red + kg * 288 + cn;
      rr[0] = a0; rr[32] = a1; rr[64] = a2; rr[96] = a3; rr[128] = a4; rr[160] = a5; rr[192] = a6; rr[224] = a7; rr[256] = a8;
      __syncthreads();
      for (int e = tid; e < 288; e += 256) {
        float s = 0.f;
#pragma unroll
        for (int g8 = 0; g8 < 8; ++g8) s += red[g8 * 288 + e];
        const int v = e >> 5, n = cg_ * 32 + (e & 31);
        p.mod[((size_t)l * 9 + v) * 6144 + n] = s + p.in[5][l * 6144 + n];
      }
    } else {
      for (int e = tid; e < 1024; e += 256) {
        const int pos = e >> 3, f = e & 7;
        const float inv = (f == 0) ? 1.0f : (f == 1) ? 0.31622776601683794f : (f == 2) ? 0.1f : (f == 3) ? 0.031622776601683794f
                        : (f == 4) ? 0.01f : (f == 5) ? 0.0031622776601683794f : (f == 6) ? 0.001f : 0.00031622776601683794f;
        const float ang = (float)pos * inv;
        double s, c; sincos_d((double)ang, s, c);
        p.rope[e * 2] = (float)c; p.rope[e * 2 + 1] = (float)s;
      }
    }
  });
}

__device__ void phase_norm(const Params& p, int l, int g, int which, int* ctr) {
  const int nitems = (which == 1 && l == 1) ? NBG * SEQ / 16 : RG / 16;
  const float* gam = (which == 0 ? p.in[6] : p.in[20]) + l * DM;
  const int shoff = which == 0 ? 0 : 3072, scoff = which == 0 ? 1024 : 4096;
  const int from_input = (which == 0 && l == 0);
  for (int it = blockIdx.x; it < nitems; it += gridDim.x) {
    const int lane = TIDX & 63, wid = TIDX >> 6;
    const int r0 = it * 16 + wid * 4;
    const float* xr = xsrc_row_ptr(p, g, r0, from_input);
    const float* mrow = p.mod + ((size_t)l * 9 + mod_index(p, g, r0)) * 6144;
    float4 v[4][4], gg[4], sh[4], sc[4];
#pragma unroll
    for (int rr = 0; rr < 4; ++rr)
#pragma unroll
      for (int i = 0; i < 4; ++i) v[rr][i] = *(const float4*)(xr + (size_t)rr * DM + lane * 4 + i * 256);
#pragma unroll
    for (int i = 0; i < 4; ++i) {
      const int c = lane * 4 + i * 256;
      gg[i] = *(const float4*)(gam + c); sh[i] = *(const float4*)(mrow + shoff + c); sc[i] = *(const float4*)(mrow + scoff + c);
    }
#pragma unroll
    for (int rr = 0; rr < 4; ++rr) {
      float ss = 0.f;
#pragma unroll
      for (int i = 0; i < 4; ++i)
        ss += v[rr][i].x * v[rr][i].x + v[rr][i].y * v[rr][i].y + v[rr][i].z * v[rr][i].z + v[rr][i].w * v[rr][i].w;
      ss = wave_sum(ss);
      const float rstd = rsqrtf(ss * (1.f / 1024.f) + EPS);
#pragma unroll
      for (int i = 0; i < 4; ++i) {
        const int c = lane * 4 + i * 256;
        uint2 o;
        o.x = pack2(v[rr][i].x * rstd * gg[i].x * (1.f + sc[i].x) + sh[i].x, v[rr][i].y * rstd * gg[i].y * (1.f + sc[i].y) + sh[i].y);
        o.y = pack2(v[rr][i].z * rstd * gg[i].z * (1.f + sc[i].z) + sh[i].z, v[rr][i].w * rstd * gg[i].w * (1.f + sc[i].w) + sh[i].w);
        *(uint2*)(p.h + (size_t)(r0 + rr) * DM + c) = o;
      }
    }
  }
}

__device__ void phase_proj(const Params& p, int l, int* ctr) {
  const int MT = RG / 128, NT = INWP / 128;
  const u16* W = p.wt + (size_t)l * W_LAYER + W_IN;
  run_q8(ctr, GEMM_CNT(MT, NT), [&](int q_, int j_) {
    int mt, nt; tile_order(j_, mlo(q_ + 1, MT) - mlo(q_, MT), NT, mt, nt); mt += mlo(q_, MT);
    f32x4 acc[4][4];
    gemm_core<4>(p.h + (size_t)mt * 128 * DM, DM, W + (size_t)nt * 128 * DM, DM, DM, acc);
    EPI_VARS
    uint2 o[4][4];
#pragma unroll
    for (int wi = 0; wi < 4; ++wi)
#pragma unroll
      for (int xi = 0; xi < 4; ++xi) {
        o[wi][xi].x = pack2(acc[wi][xi][0], acc[wi][xi][1]); o[wi][xi].y = pack2(acc[wi][xi][2], acc[wi][xi][3]);
      }
    if (nt * 128 + wc_ * 64 < INW)
      store_tile_bf16<4>(o, p.proj + (size_t)(mt * 128 + wr_ * 64) * INW + nt * 128 + wc_ * 64, INW);
  });
}

__device__ void postproj_rows(const Params& p, int l, int it) {
  const int lane = TIDX & 63, wid = TIDX >> 6;
  const float* scw = p.in[15] + (size_t)l * 3 * 512;
  for (int rr = 0; rr < 4; ++rr) {
    const int r = it * 16 + wid * 4 + rr;
    int bl, pos, isctx; rowinfo(r, NBG, bl, pos, isctx);
    const u16* pr = p.proj + (size_t)r * INW;
    const int Lr = isctx ? CTXL : SEQ;
    const int c0 = lane * 8;
    const uint2 u_cq = *(const uint2*)(pr + C_CQ + lane * 4);
    const unsigned u_ckv = *(const unsigned*)(pr + C_CKV + lane * 2);
    const u16 u_kr = pr[C_KR + (lane & 31)];
    const uint4 sb = *(const uint4*)(pr + C_SB + c0);
    const uint4 sc1 = *(const uint4*)(pr + C_SC + c0);
    const uint4 sx1 = *(const uint4*)(pr + C_SX + c0);
    uint4 sc0 = make_uint4(0, 0, 0, 0), sx0 = sc0, sc2 = sc0, sx2 = sc0;
    if (pos > 0) { sc0 = *(const uint4*)(pr - INW + C_SC + c0); sx0 = *(const uint4*)(pr - INW + C_SX + c0); }
    if (pos < Lr - 1) { sc2 = *(const uint4*)(pr + INW + C_SC + c0); sx2 = *(const uint4*)(pr + INW + C_SX + c0); }
    {
      const uint2 u = u_cq;
      const float a = bflo(u.x), b = bfhi(u.x), c = bflo(u.y), d = bfhi(u.y);
      float ss = wave_sum(a * a + b * b + c * c + d * d);
      if (lane == 0) p.rstdq[r] = rsqrtf(ss * (1.f / 256.f) + EPS);
    }
    {
      const unsigned u = u_ckv;
      const float a = bflo(u), b = bfhi(u);
      float ss = wave_sum(a * a + b * b);
      if (lane == 0) p.rstdkv[r] = rsqrtf(ss * (1.f / 128.f) + EPS);
    }
    {
      const int idx = lane & 31;
      const float val = bf2f(u_kr);
      const float partner = __shfl_xor(val, 8);
      float o = val;
      if (!isctx) {
        const int axis = idx >> 4, half = (idx >> 3) & 1, f = idx & 7;
        const int pa = axis ? (pos & 63) : (pos >> 6);
        const float c = p.rope[(pa * 8 + f) * 2], s = p.rope[(pa * 8 + f) * 2 + 1];
        o = half ? (val * c + partner * s) : (val * c - partner * s);
      }
      const int j = isctx ? SEQ + pos : pos;
      const u16 ob = f2bf(o);
      if (lane < 32) {
#pragma unroll
        for (int hd = 0; hd < 8; ++hd)
          p.kf[((size_t)(bl * 8 + hd) * NKEY + j) * 96 + 64 + idx] = ob;
      }
    }
    {
      const float4 w0a = *(const float4*)(scw + c0), w0b = *(const float4*)(scw + c0 + 4);
      const float4 w1a = *(const float4*)(scw + 512 + c0), w1b = *(const float4*)(scw + 512 + c0 + 4);
      const float4 w2a = *(const float4*)(scw + 1024 + c0), w2b = *(const float4*)(scw + 1024 + c0 + 4);
      uint4 o;
#define UC2(SBW, A0, X0, A1, X1, A2, X2, W0L, W0H, W1L, W1H, W2L, W2H) \
      pack2(bflo(SBW) * (W0L * bflo(A0) * bflo(X0) + W1L * bflo(A1) * bflo(X1) + W2L * bflo(A2) * bflo(X2)), \
            bfhi(SBW) * (W0H * bfhi(A0) * bfhi(X0) + W1H * bfhi(A1) * bfhi(X1) + W2H * bfhi(A2) * bfhi(X2)))
      o.x = UC2(sb.x, sc0.x, sx0.x, sc1.x, sx1.x, sc2.x, sx2.x, w0a.x, w0a.y, w1a.x, w1a.y, w2a.x, w2a.y);
      o.y = UC2(sb.y, sc0.y, sx0.y, sc1.y, sx1.y, sc2.y, sx2.y, w0a.z, w0a.w, w1a.z, w1a.w, w2a.z, w2a.w);
      o.z = UC2(sb.z, sc0.z, sx0.z, sc1.z, sx1.z, sc2.z, sx2.z, w0b.x, w0b.y, w1b.x, w1b.y, w2b.x, w2b.y);
      o.w = UC2(sb.w, sc0.w, sx0.w, sc1.w, sx1.w, sc2.w, sx2.w, w0b.z, w0b.w, w1b.z, w1b.w, w2b.z, w2b.w);
#undef UC2
      *(uint4*)(p.uc + (size_t)r * 512 + c0) = o;
    }
  }
}

__device__ __forceinline__ float logsig16(float z) {
  return (fminf(z, 0.f) - __logf(1.f + __expf(-fabsf(z)))) * (1.f / 16.f);
}

__device__ void gla_prep(const Params& p, int l, int it) {
  const int tid = TIDX, lane = tid & 63, wid = tid >> 6;
  const int bl = it / (NCHUNK * 4), rem = it % (NCHUNK * 4), cidx = rem >> 2, h = rem & 3;
  const int r0 = chunk_row(bl, cidx, NBG);
  float* lr = (float*)smem;
  float* tot = (float*)(smem + 8192);
  u16* vT = (u16*)(smem + 10752);
  u16* kTf = (u16*)(smem + 29184);
  u16* kTb = (u16*)(smem + 38400);
  {
    const int t = tid >> 2, c8 = (tid & 3) * 8;
    const uint4 u = *(const uint4*)(p.proj + (size_t)(r0 + t) * INW + C_ALR + c8);
    float* d = lr + t * 32 + c8;
    d[0] = bflo(u.x); d[1] = bfhi(u.x); d[2] = bflo(u.y); d[3] = bfhi(u.y);
    d[4] = bflo(u.z); d[5] = bfhi(u.z); d[6] = bflo(u.w); d[7] = bfhi(u.w);
    const int dvc = (tid & 3) * 32;
    const u16* vp = p.proj + (size_t)(r0 + t) * INW + C_VA + h * 128 + dvc;
#pragma unroll
    for (int i = 0; i < 4; ++i) {
      const uint4 vv = *(const uint4*)(vp + i * 8);
      u16* dst = vT + (size_t)(dvc + i * 8) * 72 + t;
      dst[0] = (u16)(vv.x & 0xffff); dst[72] = (u16)(vv.x >> 16);
      dst[144] = (u16)(vv.y & 0xffff); dst[216] = (u16)(vv.y >> 16);
      dst[288] = (u16)(vv.z & 0xffff); dst[360] = (u16)(vv.z >> 16);
      dst[432] = (u16)(vv.w & 0xffff); dst[504] = (u16)(vv.w >> 16);
    }
  }
  __syncthreads();
  const int dk = lane, tg = wid;
  const float* w2f = p.in[8] + ((size_t)(l * 2 + 0) * 16) * 256 + h * 64 + dk;
  const float* w2b = p.in[8] + ((size_t)(l * 2 + 1) * 16) * 256 + h * 64 + dk;
  float wf[16], wb[16];
#pragma unroll
  for (int r = 0; r < 16; ++r) { wf[r] = w2f[r * 256]; wb[r] = w2b[r * 256]; }
  const float biasf = p.in[9][(l * 2 + 0) * 256 + h * 64 + dk];
  const float biasb = p.in[9][(l * 2 + 1) * 256 + h * 64 + dk];
  float pf[16], sbk[16];
#pragma unroll
  for (int i = 0; i < 16; ++i) {
    const float* lrow = lr + (tg * 16 + i) * 32;
    float zf = biasf, zb = biasb;
#pragma unroll
    for (int r = 0; r < 16; ++r) { zf += lrow[r] * wf[r]; zb += lrow[16 + r] * wb[r]; }
    pf[i] = logsig16(zf); sbk[i] = logsig16(zb);
  }
#pragma unroll
  for (int i = 1; i < 16; ++i) pf[i] += pf[i - 1];
#pragma unroll
  for (int i = 14; i >= 0; --i) sbk[i] += sbk[i + 1];
  tot[tg * 64 + dk] = pf[15];
  tot[256 + tg * 64 + dk] = sbk[0];
  __syncthreads();
  float offf = 0.f, offb = 0.f, bfl = 0.f, bb0 = 0.f;
#pragma unroll
  for (int g4 = 0; g4 < 4; ++g4) {
    const float a = tot[g4 * 64 + dk], b = tot[256 + g4 * 64 + dk];
    bfl += a; bb0 += b;
    if (g4 < tg) offf += a;
    if (g4 > tg) offb += b;
  }
  u16* gqf = p.gq;
  u16* gkf = p.gq + (size_t)RG * 256;
  u16* gqb = p.gq + (size_t)RG * 512;
  u16* gkb = p.gq + (size_t)RG * 768;
  unsigned kfp[8], kbp[8];
#pragma unroll
  for (int i = 0; i < 16; ++i) {
    const int t = tg * 16 + i;
    const float bfv = offf + pf[i], bbv = offb + sbk[i];
    const float qv = bf2f(p.proj[(size_t)(r0 + t) * INW + C_QA + h * 64 + dk]);
    const float kv = bf2f(p.proj[(size_t)(r0 + t) * INW + C_KA + h * 64 + dk]);
    const size_t go = (size_t)(r0 + t) * 256 + h * 64 + dk;
    gqf[go] = f2bf(qv * __expf(bfv) * 0.125f);
    gkf[go] = f2bf(kv * __expf(-bfv));
    gqb[go] = f2bf(qv * __expf(bbv) * 0.125f);
    gkb[go] = f2bf(kv * __expf(-bbv));
    const u16 ksf = f2bf(kv * __expf(bfl - bfv));
    const u16 ksb = f2bf(kv * __expf(bb0 - bbv));
    if (i & 1) { kfp[i >> 1] |= ((unsigned)ksf) << 16; kbp[i >> 1] |= ((unsigned)ksb) << 16; }
    else { kfp[i >> 1] = ksf; kbp[i >> 1] = ksb; }
  }
  *(uint4*)(kTf + dk * 72 + tg * 16) = make_uint4(kfp[0], kfp[1], kfp[2], kfp[3]);
  *(uint4*)(kTf + dk * 72 + tg * 16 + 8) = make_uint4(kfp[4], kfp[5], kfp[6], kfp[7]);
  *(uint4*)(kTb + dk * 72 + tg * 16) = make_uint4(kbp[0], kbp[1], kbp[2], kbp[3]);
  *(uint4*)(kTb + dk * 72 + tg * 16 + 8) = make_uint4(kbp[4], kbp[5], kbp[6], kbp[7]);
  const size_t cb = ((size_t)(bl * NCHUNK + cidx) * 4 + h) * 2;
  if (tg == 0) {
    p.dec[(cb + 0) * 64 + dk] = __expf(bfl);
    p.dec[(cb + 1) * 64 + dk] = __expf(bb0);
  }
  __syncthreads();
  const int l31 = lane & 31, hh = lane >> 5;
  u16* U = p.h;
#pragma unroll
  for (int dir = 0; dir < 2; ++dir) {
    const u16* kT = dir ? kTb : kTf;
#pragma unroll
    for (int dkt = 0; dkt < 2; ++dkt) {
      f32x16 acc;
#pragma unroll
      for (int e = 0; e < 16; ++e) acc[e] = 0.f;
#pragma unroll
      for (int s = 0; s < 4; ++s) {
        const bf16x8 a = *(const bf16x8*)(vT + (32 * wid + l31) * 72 + 16 * s + 8 * hh);
        const bf16x8 b = *(const bf16x8*)(kT + (32 * dkt + l31) * 72 + 16 * s + 8 * hh);
        acc = __builtin_amdgcn_mfma_f32_32x32x16_bf16(a, b, acc, 0, 0, 0);
      }
      u16* up = U + (cb + dir) * 8192;
#pragma unroll
      for (int e = 0; e < 16; ++e) {
        const int dv = 32 * wid + (e & 3) + 8 * (e >> 2) + 4 * hh;
        up[dv * 64 + 32 * dkt + l31] = f2bf(acc[e]);
      }
    }
  }
}

__device__ void phase_postproj(const Params& p, int l, int* ctr) {
  const int n_prep = NBG * NCHUNK * 4, n_rows = RG / 16;
  run_q8(ctr, QA_CNT(n_prep + n_rows), [&](int q_, int j_) {
    const int it = QA_ID(q_, j_);
    if (it < n_prep) gla_prep(p, l, it);
    else postproj_rows(p, l, it - n_prep);
  });
}

__device__ void gla_scan(const Params& p, int it) {
  const int tid = TIDX;
  const int sl = it & 7, dir = (it >> 3) & 1, h = (it >> 4) & 3, bl = it >> 6;
  const int e0 = sl * 1024 + tid * 4;
  const int dk = e0 & 63;
  const u16* U = p.h;
  f32x4 S = {0.f, 0.f, 0.f, 0.f};
  for (int s0 = 0; s0 < NCHUNK; s0 += 12) {
    uint2 u4[12]; f32x4 d4[12];
#pragma unroll
    for (int j = 0; j < 12; ++j) {
      const int step = s0 + j;
      const int cidx = dir ? (NCHUNK - 1 - step) : (step < 4 ? 128 + step : step - 4);
      const size_t base = ((size_t)(bl * NCHUNK + cidx) * 4 + h) * 2 + dir;
      u4[j] = *(const uint2*)(U + base * 8192 + e0);
      d4[j] = *(const f32x4*)(p.dec + base * 64 + dk);
    }
#pragma unroll
    for (int j = 0; j < 12; ++j) {
      const int step = s0 + j;
      const int cidx = dir ? (NCHUNK - 1 - step) : (step < 4 ? 128 + step : step - 4);
      const size_t base = ((size_t)(bl * NCHUNK + cidx) * 4 + h) * 2 + dir;
      uint2 o; o.x = pack2(S[0], S[1]); o.y = pack2(S[2], S[3]);
      *(uint2*)(p.ss + base * 8192 + e0) = o;
      S = d4[j] * S + f32x4{bflo(u4[j].x), bfhi(u4[j].x), bflo(u4[j].y), bfhi(u4[j].y)};
    }
  }
}

__device__ void q_tile(const Params& p, int l, int t) {
  const int MT = RG / 128;
  const int nt = t / MT, mt = t % MT;
  f32x4 acc[4][4];
  gemm_core<4>(p.proj + (size_t)mt * 128 * INW + C_CQ, INW, p.wt + (size_t)l * W_LAYER + W_UQ + (size_t)nt * 128 * 256, 256, 256, acc);
  EPI_VARS
  const float QS = 0.10206207261596577f * 1.4426950408889634f;
  int bl, pos0, isctx; rowinfo(mt * 128, NBG, bl, pos0, isctx);
  float rsq[4];
  uint2 qo[4][4];
#pragma unroll
  for (int xi = 0; xi < 4; ++xi) rsq[xi] = p.rstdq[mt * 128 + EPI_TR(xi)] * QS;
#pragma unroll
  for (int xi = 0; xi < 4; ++xi) {
    const int tr = EPI_TR(xi), r = mt * 128 + tr, pos = pos0 + tr;
    const float rs = rsq[xi];
#pragma unroll
    for (int wi = 0; wi < 4; ++wi) {
      const int n16 = (nt * 128 + wc_ * 64 + wi * 16) >> 4;
      const int m6 = n16 % 6;
      float v0 = acc[wi][xi][0] * rs, v1 = acc[wi][xi][1] * rs, v2 = acc[wi][xi][2] * rs, v3 = acc[wi][xi][3] * rs;
      if (m6 >= 4 && !isctx) {
        const float p0 = __shfl_xor(v0, 32), p1 = __shfl_xor(v1, 32), p2 = __shfl_xor(v2, 32), p3 = __shfl_xor(v3, 32);
        const int pa = (m6 == 5) ? (pos & 63) : (pos >> 6);
        const int f0 = (fq_ & 1) * 4;
        const float* rp = p.rope + (pa * 8 + f0) * 2;
        const float4 cs01 = *(const float4*)rp, cs23 = *(const float4*)(rp + 4);
        const float sg = (fq_ >= 2) ? 1.f : -1.f;
        v0 = v0 * cs01.x + sg * p0 * cs01.y;
        v1 = v1 * cs01.z + sg * p1 * cs01.w;
        v2 = v2 * cs23.x + sg * p2 * cs23.y;
        v3 = v3 * cs23.z + sg * p3 * cs23.w;
      }
      qo[wi][xi].x = pack2(v0, v1); qo[wi][xi].y = pack2(v2, v3);
    }
  }
  store_tile_bf16<4>(qo, p.q + (size_t)(mt * 128 + wr_ * 64) * 768 + nt * 128 + wc_ * 64, 768);
}

__device__ void kv_tile(const Params& p, int l, int t) {
  const int MT = RG / 128;
  const int nt = t / MT, mt = t % MT;
  f32x4 acc[4][4];
  gemm_core<4>(p.proj + (size_t)mt * 128 * INW + C_CKV, INW, p.wt + (size_t)l * W_LAYER + W_UKV + (size_t)nt * 128 * 128, 128, 128, acc);
  EPI_VARS
  int bl, pos0, isctx; rowinfo(mt * 128, NBG, bl, pos0, isctx);
  const int j0 = isctx ? SEQ + pos0 : pos0;
  float rskv[4];
#pragma unroll
  for (int xi = 0; xi < 4; ++xi) rskv[xi] = p.rstdkv[mt * 128 + EPI_TR(xi)];
#pragma unroll
  for (int xi = 0; xi < 4; ++xi) {
    const int tr = EPI_TR(xi), r = mt * 128 + tr, j = j0 + tr;
    const float rs = rskv[xi];
#pragma unroll
    for (int wi = 0; wi < 4; ++wi) {
      const int wn = EPI_NN(wi);
      const float v0 = acc[wi][xi][0] * rs, v1 = acc[wi][xi][1] * rs, v2 = acc[wi][xi][2] * rs, v3 = acc[wi][xi][3] * rs;
      if (wc_ == 0) {
        uint2 o; o.x = pack2(v0, v1); o.y = pack2(v2, v3);
        *(uint2*)(p.kf + ((size_t)(bl * 8 + nt) * NKEY + j) * 96 + wn) = o;
      } else {
        u16* vp = p.vt + ((size_t)(bl * 8 + nt) * 64 + (wn - 64)) * NKEY + j;
        vp[0] = f2bf(v0); vp[NKEY] = f2bf(v1); vp[2 * NKEY] = f2bf(v2); vp[3 * NKEY] = f2bf(v3);
      }
    }
  }
}

__device__ void phase_qkv(const Params& p, int l, int* ctr) {
  const int MT = RG / 128;
  const int n_scan = NBG * 64, n_q = MT * 6, n_kv = MT * 8;
  run_q8(ctr, QA_CNT(n_scan + n_q + n_kv), [&](int q_, int j_) {
    const int it = QA_ID(q_, j_);
    if (it < n_scan) gla_scan(p, it);
    else if (it < n_scan + n_q) q_tile(p, l, it - n_scan);
    else kv_tile(p, l, it - n_scan - n_q);
  });
}

__device__ __forceinline__ bf16x8 pack8(const f32x16& a, int o) {
  union { bf16x8 v; unsigned u[4]; } r;
  r.u[0] = pack2(a[o + 0], a[o + 1]); r.u[1] = pack2(a[o + 2], a[o + 3]);
  r.u[2] = pack2(a[o + 4], a[o + 5]); r.u[3] = pack2(a[o + 6], a[o + 7]);
  return r.v;
}
__device__ __forceinline__ bf16x8 ld2x8(const u16* p0) {
  union { bf16x8 v; uint2 u[2]; } r;
  r.u[0] = *(const uint2*)p0; r.u[1] = *(const uint2*)(p0 + 8);
  return r.v;
}

__device__ void attn_item(const Params& p, int it) {
  const int tid = TIDX, lane = tid & 63, wid = tid >> 6, l31 = lane & 31, hh = lane >> 5;
  const int qb = it % 66, bh = it / 66, h = bh & 7, bl = bh >> 3;
  const int r0 = qb < 64 ? bl * SEQ + qb * 128 : NBG * SEQ + bl * CTXL + (qb - 64) * 128;
  const int kt0 = qb < 64 ? 0 : 128;
  const int nkt = NCHUNK - kt0;
  constexpr int KROW = 208, VROW = 144, BUFB = 64 * KROW + 64 * VROW;
  bf16x8 qf[6];
  {
    const u16* qp = p.q + (size_t)(r0 + 32 * wid + l31) * 768 + h * 96 + 8 * hh;
#pragma unroll
    for (int s = 0; s < 6; ++s) qf[s] = *(const bf16x8*)(qp + 16 * s);
  }
  const u16* kbase = p.kf + (size_t)bh * NKEY * 96;
  const u16* vbase = p.vt + (size_t)bh * 64 * NKEY;
  uint4 kr0, kr1, kr2, vr0, vr1;
  const int kdst0 = (tid / 12) * KROW + (tid % 12) * 16;
  const int kdst1 = ((tid + 256) / 12) * KROW + ((tid + 256) % 12) * 16;
  const int kdst2 = ((tid + 512) / 12) * KROW + ((tid + 512) % 12) * 16;
  const int vdst0 = 64 * KROW + (tid >> 3) * VROW + (tid & 7) * 16;
  const int vdst1 = vdst0 + 32 * VROW;
  const int vsrc0 = (tid >> 3) * NKEY + (tid & 7) * 8;
  const int vsrc1 = vsrc0 + 32 * NKEY;
  {
    const u16* kp = kbase + (size_t)kt0 * 64 * 96 + tid * 8;
    kr0 = *(const uint4*)(kp); kr1 = *(const uint4*)(kp + 2048); kr2 = *(const uint4*)(kp + 4096);
    vr0 = *(const uint4*)(vbase + vsrc0 + kt0 * 64); vr1 = *(const uint4*)(vbase + vsrc1 + kt0 * 64);
    *(uint4*)(smem + kdst0) = kr0; *(uint4*)(smem + kdst1) = kr1; *(uint4*)(smem + kdst2) = kr2;
    *(uint4*)(smem + vdst0) = vr0; *(uint4*)(smem + vdst1) = vr1;
  }
  __builtin_amdgcn_s_waitcnt(0x0F70);
  __syncthreads();
  f32x16 oacc[2];
#pragma unroll
  for (int e = 0; e < 16; ++e) { oacc[0][e] = 0.f; oacc[1][e] = 0.f; }
  float m_run = 0.f, l_run = 0.f;
  for (int t = 0; t < nkt; ++t) {
    const int cur = t & 1;
    {
      const int tn = kt0 + min(t + 1, nkt - 1);
      const u16* kp = kbase + (size_t)tn * 64 * 96 + tid * 8;
      kr0 = *(const uint4*)(kp); kr1 = *(const uint4*)(kp + 2048); kr2 = *(const uint4*)(kp + 4096);
      vr0 = *(const uint4*)(vbase + vsrc0 + tn * 64); vr1 = *(const uint4*)(vbase + vsrc1 + tn * 64);
    }
    __builtin_amdgcn_sched_barrier(0);
    const char* Kl = smem + cur * BUFB;
    const char* Vl = Kl + 64 * KROW;
    f32x16 sacc[2];
#pragma unroll
    for (int kb = 0; kb < 2; ++kb) {
#pragma unroll
      for (int e = 0; e < 16; ++e) sacc[kb][e] = -m_run;
#pragma unroll
      for (int s = 0; s < 6; ++s) {
        const bf16x8 a = *(const bf16x8*)(Kl + (32 * kb + l31) * KROW + 32 * s + 16 * hh);
        sacc[kb] = __builtin_amdgcn_mfma_f32_32x32x16_bf16(a, qf[s], sacc[kb], 0, 0, 0);
      }
    }
    float mx = sacc[0][0];
#pragma unroll
    for (int e = 1; e < 16; ++e) mx = fmaxf(mx, sacc[0][e]);
#pragma unroll
    for (int e = 0; e < 16; ++e) mx = fmaxf(mx, sacc[1][e]);
    {
      const unsigned mu = __float_as_uint(mx);
      const auto sw = __builtin_amdgcn_permlane32_swap(mu, mu, false, false);
      mx = fmaxf(__uint_as_float(sw[0]), __uint_as_float(sw[1]));
    }
    if (t == 0 || !__all(mx <= 8.f)) {
      const float d = (t == 0) ? mx : fmaxf(mx, 0.f);
      const float alpha = __builtin_amdgcn_exp2f(-d);
      m_run += d;
      l_run *= alpha;
#pragma unroll
      for (int e = 0; e < 16; ++e) { oacc[0][e] *= alpha; oacc[1][e] *= alpha; sacc[0][e] -= d; sacc[1][e] -= d; }
    }
    float ps = 0.f;
#pragma unroll
    for (int kb = 0; kb < 2; ++kb)
#pragma unroll
      for (int e = 0; e < 16; ++e) { const float pv = __builtin_amdgcn_exp2f(sacc[kb][e]); sacc[kb][e] = pv; ps += pv; }
    l_run += ps;
#pragma unroll
    for (int kb = 0; kb < 2; ++kb)
#pragma unroll
      for (int s2 = 0; s2 < 2; ++s2) {
        const bf16x8 pfr = pack8(sacc[kb], 8 * s2);
#pragma unroll
        for (int dt = 0; dt < 2; ++dt) {
          const bf16x8 a = ld2x8((const u16*)(Vl + (32 * dt + l31) * VROW) + 32 * kb + 16 * s2 + 4 * hh);
          oacc[dt] = __builtin_amdgcn_mfma_f32_32x32x16_bf16(a, pfr, oacc[dt], 0, 0, 0);
        }
      }
    __builtin_amdgcn_sched_barrier(0);
    {
      char* nb = smem + (cur ^ 1) * BUFB;
      *(uint4*)(nb + kdst0) = kr0; *(uint4*)(nb + kdst1) = kr1; *(uint4*)(nb + kdst2) = kr2;
      *(uint4*)(nb + vdst0) = vr0; *(uint4*)(nb + vdst1) = vr1;
    }
    __syncthreads();
  }
  l_run += __shfl_xor(l_run, 32);
  const float inv = 1.f / l_run;
  u16* op = p.h + (size_t)RG * 512 + (size_t)(r0 + 32 * wid + l31) * 512 + h * 64;
#pragma unroll
  for (int dt = 0; dt < 2; ++dt)
#pragma unroll
    for (int gq_ = 0; gq_ < 4; ++gq_) {
      const int dv0 = 32 * dt + 8 * gq_ + 4 * hh;
      uint2 o;
      o.x = pack2(oacc[dt][4 * gq_ + 0] * inv, oacc[dt][4 * gq_ + 1] * inv);
      o.y = pack2(oacc[dt][4 * gq_ + 2] * inv, oacc[dt][4 * gq_ + 3] * inv);
      *(uint2*)(op + dv0) = o;
    }
}

__device__ void gla_out(const Params& p, int l, int it) {
  const int tid = TIDX, lane = tid & 63, wid = tid >> 6, l31 = lane & 31, hh = lane >> 5;
  const int bl = it / (NCHUNK * 4), rem = it % (NCHUNK * 4), cidx = rem >> 2, h = rem & 3;
  const int r0 = chunk_row(bl, cidx, NBG);
  u16* tiles = (u16*)smem;
  u16* vT = (u16*)(smem + 36864);
  float* part = (float*)(smem + 55296);
  {
    const int t = tid >> 2, c16 = (tid & 3) * 16;
#pragma unroll
    for (int a = 0; a < 4; ++a) {
      const u16* src = p.gq + (size_t)a * RG * 256 + (size_t)(r0 + t) * 256 + h * 64 + c16;
      const uint4 u0 = *(const uint4*)src, u1 = *(const uint4*)(src + 8);
      u16* d = tiles + a * 4608 + t * 72 + c16;
      *(uint4*)d = u0; *(uint4*)(d + 8) = u1;
    }
    const int dvc = (tid & 3) * 32;
    const u16* vp = p.proj + (size_t)(r0 + t) * INW + C_VA + h * 128 + dvc;
#pragma unroll
    for (int i = 0; i < 4; ++i) {
      const uint4 vv = *(const uint4*)(vp + i * 8);
      u16* dst = vT + (size_t)(dvc + i * 8) * 72 + t;
      dst[0] = (u16)(vv.x & 0xffff); dst[72] = (u16)(vv.x >> 16);
      dst[144] = (u16)(vv.y & 0xffff); dst[216] = (u16)(vv.y >> 16);
      dst[288] = (u16)(vv.z & 0xffff); dst[360] = (u16)(vv.z >> 16);
      dst[432] = (u16)(vv.w & 0xffff); dst[504] = (u16)(vv.w >> 16);
    }
  }
  const int itl = wid & 1, dvh = wid >> 1;
  const size_t cb = ((size_t)(bl * NCHUNK + cidx) * 4 + h) * 2;
  bf16x8 sfr[2][2][4];
#pragma unroll
  for (int dir = 0; dir < 2; ++dir)
#pragma unroll
    for (int dt = 0; dt < 2; ++dt)
#pragma unroll
      for (int s4 = 0; s4 < 4; ++s4)
        sfr[dir][dt][s4] = *(const bf16x8*)(p.ss + (cb + dir) * 8192 + (64 * dvh + 32 * dt + l31) * 64 + 16 * s4 + 8 * hh);
  __syncthreads();
  f32x16 oacc[2];
#pragma unroll
  for (int e = 0; e < 16; ++e) { oacc[0][e] = 0.f; oacc[1][e] = 0.f; }
#pragma unroll
  for (int dir = 0; dir < 2; ++dir) {
    const u16* Qt = tiles + (dir * 2) * 4608;
    const u16* Kt = tiles + (dir * 2 + 1) * 4608;
    bf16x8 qfr[4];
#pragma unroll
    for (int s = 0; s < 4; ++s) qfr[s] = *(const bf16x8*)(Qt + (32 * itl + l31) * 72 + 16 * s + 8 * hh);
    f32x16 aacc[2];
#pragma unroll
    for (int jt = 0; jt < 2; ++jt) {
#pragma unroll
      for (int e = 0; e < 16; ++e) aacc[jt][e] = 0.f;
#pragma unroll
      for (int s = 0; s < 4; ++s) {
        const bf16x8 a = *(const bf16x8*)(Kt + (32 * jt + l31) * 72 + 16 * s + 8 * hh);
        aacc[jt] = __builtin_amdgcn_mfma_f32_32x32x16_bf16(a, qfr[s], aacc[jt], 0, 0, 0);
      }
      const int i_tok = 32 * itl + l31;
#pragma unroll
      for (int e = 0; e < 16; ++e) {
        const int j_tok = 32 * jt + (e & 3) + 8 * (e >> 2) + 4 * hh;
        const bool keep = dir ? (j_tok >= i_tok) : (j_tok <= i_tok);
        if (!keep) aacc[jt][e] = 0.f;
      }
    }
#pragma unroll
    for (int dt = 0; dt < 2; ++dt) {
      const int dvrow = 64 * dvh + 32 * dt + l31;
#pragma unroll
      for (int jt = 0; jt < 2; ++jt)
#pragma unroll
        for (int s2 = 0; s2 < 2; ++s2) {
          const bf16x8 pfr = pack8(aacc[jt], 8 * s2);
          const bf16x8 a = ld2x8(vT + dvrow * 72 + 32 * jt + 16 * s2 + 4 * hh);
          oacc[dt] = __builtin_amdgcn_mfma_f32_32x32x16_bf16(a, pfr, oacc[dt], 0, 0, 0);
        }
#pragma unroll
      for (int s = 0; s < 4; ++s) {
        oacc[dt] = __builtin_amdgcn_mfma_f32_32x32x16_bf16(sfr[dir][dt][s], qfr[s], oacc[dt], 0, 0, 0);
      }
    }
  }
  float ss = 0.f;
#pragma unroll
  for (int e = 0; e < 16; ++e) ss += oacc[0][e] * oacc[0][e] + oacc[1][e] * oacc[1][e];
  ss += __shfl_xor(ss, 32);
  if (hh == 0) part[wid * 32 + l31] = ss;
  __syncthreads();
  const float totss = part[wid * 32 + l31] + part[(wid ^ 2) * 32 + l31];
  const float rstd = rsqrtf(totss * (1.f / 128.f) + EPS);
  const int r = r0 + 32 * itl + l31;
  const float* gam = p.in[10] + l * 512 + h * 128;
  u16* aa = p.h;
#pragma unroll
  for (int dt = 0; dt < 2; ++dt)
#pragma unroll
    for (int gq_ = 0; gq_ < 4; ++gq_) {
      const int dv0 = 64 * dvh + 32 * dt + 8 * gq_ + 4 * hh;
      const uint2 ra = *(const uint2*)(p.proj + (size_t)r * INW + C_RA + h * 128 + dv0);
      const float4 g4 = *(const float4*)(gam + dv0);
      uint2 o;
      o.x = pack2(oacc[dt][4 * gq_ + 0] * rstd * g4.x * silu_f(bflo(ra.x)), oacc[dt][4 * gq_ + 1] * rstd * g4.y * silu_f(bfhi(ra.x)));
      o.y = pack2(oacc[dt][4 * gq_ + 2] * rstd * g4.z * silu_f(bflo(ra.y)), oacc[dt][4 * gq_ + 3] * rstd * g4.w * silu_f(bfhi(ra.y)));
      *(uint2*)(aa + (size_t)r * 512 + h * 128 + dv0) = o;
    }
}

__device__ void phase_attn(const Params& p, int l, int* ctr) {
  const int nqb = (l == 1) ? 64 : 66, nck = (l == 1) ? 128 : NCHUNK;
  const int per_q = NBG * nqb;
  const int n_gla = NBG * nck * 4;
  run_q8(ctr, [=](int q_) { return per_q + ((n_gla - q_ + 7) >> 3); }, [&](int q_, int j_) {
    if (j_ < per_q) attn_item(p, ((j_ / nqb) * 8 + q_) * 66 + (j_ % nqb));
    else {
      const int gi = QA_ID(q_, j_ - per_q);
      gla_out(p, l, (gi / (nck * 4)) * (NCHUNK * 4) + gi % (nck * 4));
    }
  });
}

__device__ void phase_merge(const Params& p, int l, int* ctr) {
  const int MT = (l == 1 ? NBG * SEQ / 128 : RG / 128), NT = 16;
  const u16* wl = p.wt + (size_t)l * W_LAYER;
  run_q8(ctr, GEMM_CNT(MT, NT), [&](int q_, int j_) {
    int mt, nt; tile_order(j_, mlo(q_ + 1, MT) - mlo(q_, MT), NT, mt, nt); mt += mlo(q_, MT);
    const int tid = TIDX, lane = tid & 63, wid = tid >> 6;
    const int wr = wid >> 1, wc = wid & 1, fr = lane & 15, fq = lane >> 4;
    f32x4 macc[2][4], acc[2][4];
#pragma unroll
    for (int a = 0; a < 2; ++a)
#pragma unroll
      for (int b = 0; b < 4; ++b) { macc[a][b] = f32x4{0.f, 0.f, 0.f, 0.f}; acc[a][b] = f32x4{0.f, 0.f, 0.f, 0.f}; }
    const int srow = tid >> 3, schunk = (tid & 7) ^ ((tid >> 4) & 7);
    const size_t xo = (size_t)(mt * 128 + srow) * 512 + schunk * 8;
    const size_t wo = (size_t)(nt * 64 + srow) * 512 + schunk * 8;
    const u16* xg0 = p.h + xo;
    const u16* xg1 = p.h + (size_t)RG * 512 + xo;
    const u16* xg2 = p.uc + xo;
    const u16* wg0 = wl + W_BRA + wo;
    const u16* wg1 = wl + W_BRB + wo;
    const u16* wg2 = wl + W_BRC + wo;
    const int g = fr >> 1;
    const int lo0 = fr * 128 + ((fq ^ g) << 4), lo1 = fr * 128 + (((fq ^ g) ^ 4) << 4);
    const char* xb = smem + wr * 8192;
    const char* wb = smem + 16384 + wc * 4096;
    char* sdst = smem + tid * 16;
    const u16* gbase = p.proj + (size_t)(mt * 128 + wr * 64 + fr) * INW + C_GATE + nt * 64 + wc * 32 + fq * 4;
    uint2 gts[2][4];
#pragma unroll
    for (int wi = 0; wi < 2; ++wi)
#pragma unroll
      for (int xi = 0; xi < 4; ++xi) gts[wi][xi] = *(const uint2*)(gbase + (size_t)xi * 16 * INW + wi * 16);
    __syncthreads();
#pragma unroll
    for (int i = 0; i < 4; ++i) {
      glds16(xg0 + i * (32 * 512), sdst + i * 4096);
      if (i < 2) glds16(wg0 + i * (32 * 512), sdst + 16384 + i * 4096);
    }
    for (int kt = 0; kt < 24; ++kt) {
      asm volatile("s_waitcnt vmcnt(0)" ::: "memory");
      __syncthreads();
      const int cb = (kt & 1) * 32768;
      if (kt + 1 < 24) {
        const int nbr = (kt + 1) >> 3, ko = ((kt + 1) & 7) * 64, nb = 32768 - cb;
        const u16* xg = (nbr == 0 ? xg0 : nbr == 1 ? xg1 : xg2) + ko;
        const u16* wg = (nbr == 0 ? wg0 : nbr == 1 ? wg1 : wg2) + ko;
#pragma unroll
        for (int i = 0; i < 4; ++i) {
          glds16(xg + i * (32 * 512), sdst + nb + i * 4096);
          if (i < 2) glds16(wg + i * (32 * 512), sdst + nb + 16384 + i * 4096);
        }
      }
      bf16x8 wf[2][2], xf[2][4];
#pragma unroll
      for (int i = 0; i < 2; ++i) {
        wf[0][i] = *(const bf16x8*)(wb + cb + i * 2048 + lo0);
        wf[1][i] = *(const bf16x8*)(wb + cb + i * 2048 + lo1);
      }
#pragma unroll
      for (int i = 0; i < 4; ++i) {
        xf[0][i] = *(const bf16x8*)(xb + cb + i * 2048 + lo0);
        xf[1][i] = *(const bf16x8*)(xb + cb + i * 2048 + lo1);
      }
      __builtin_amdgcn_sched_barrier(0);
#pragma unroll
      for (int k = 0; k < 2; ++k)
#pragma unroll
        for (int wi = 0; wi < 2; ++wi)
#pragma unroll
          for (int xi = 0; xi < 4; ++xi)
            acc[wi][xi] = __builtin_amdgcn_mfma_f32_16x16x32_bf16(wf[k][wi], xf[k][xi], acc[wi][xi], 0, 0, 0);
      __builtin_amdgcn_sched_barrier(0);
      if ((kt & 7) == 7) {
        const int br = kt >> 3;
#pragma unroll
        for (int wi = 0; wi < 2; ++wi)
#pragma unroll
          for (int xi = 0; xi < 4; ++xi) {
            const uint2 gt = gts[wi][xi];
            macc[wi][xi][0] += sigmoid_f(bflo(gt.x)) * acc[wi][xi][0];
            macc[wi][xi][1] += sigmoid_f(bfhi(gt.x)) * acc[wi][xi][1];
            macc[wi][xi][2] += sigmoid_f(bflo(gt.y)) * acc[wi][xi][2];
            macc[wi][xi][3] += sigmoid_f(bfhi(gt.y)) * acc[wi][xi][3];
            acc[wi][xi] = f32x4{0.f, 0.f, 0.f, 0.f};
            if (br < 2) gts[wi][xi] = *(const uint2*)(gbase + (size_t)xi * 16 * INW + wi * 16 + (br + 1) * 1024);
          }
      }
    }
    uint2 o[2][4];
#pragma unroll
    for (int wi = 0; wi < 2; ++wi)
#pragma unroll
      for (int xi = 0; xi < 4; ++xi) {
        o[wi][xi].x = pack2(macc[wi][xi][0], macc[wi][xi][1]); o[wi][xi].y = pack2(macc[wi][xi][2], macc[wi][xi][3]);
      }
    store_tile_bf16<2>(o, p.m + (size_t)(mt * 128 + wr * 64) * DM + nt * 64 + wc * 32, DM);
  });
}

__device__ void phase_resid(const Params& p, int l, int g, int which, int* ctr) {
  const int MT = (l == 1 ? NBG * SEQ / 128 : RG / 128), NT = 8;
  const u16* wl = p.wt + (size_t)l * W_LAYER;
  const u16* X = which == 0 ? p.m : p.proj + (size_t)RG * DFF;
  const int ldx = which == 0 ? DM : DFF, K = which == 0 ? DM : DFF;
  const u16* W = wl + (which == 0 ? W_O : W_DN);
  const int goff = which == 0 ? 2048 : 5120;
  const int from_input = (which == 0 && l == 0);
  run_q8(ctr, GEMM_CNT(MT, NT), [&](int q_, int j_) {
    int mt, nt; tile_order(j_, mlo(q_ + 1, MT) - mlo(q_, MT), NT, mt, nt); mt += mlo(q_, MT);
    f32x4 acc[4][4];
    gemm_core<4>(X + (size_t)mt * 128 * ldx, ldx, W + (size_t)nt * 128 * K, K, K, acc);
    EPI_VARS
    const float* mrow = p.mod + ((size_t)l * 9 + mod_index(p, g, mt * 128)) * 6144 + goff + nt * 128 + wc_ * 64;
    __syncthreads();
    char* lb = smem + wid_ * 16384;
#pragma unroll
    for (int wi = 0; wi < 4; ++wi)
#pragma unroll
      for (int xi = 0; xi < 4; ++xi) {
        const int r = xi * 16 + fr_, c = wi * 4 + fq_;
        *(f32x4*)(lb + r * 256 + ((c ^ (r & 15)) << 4)) = acc[wi][xi];
      }
    const int c16 = lane_ & 15, rsub = lane_ >> 4;
    const float* xs = xsrc_row_ptr(p, g, mt * 128 + wr_ * 64, from_input) + nt * 128 + wc_ * 64 + c16 * 4;
    float* xd = xrow_ptr(p, g, mt * 128 + wr_ * 64) + nt * 128 + wc_ * 64 + c16 * 4;
    const float4 gv = *(const float4*)(mrow + c16 * 4);
#pragma unroll
    for (int half = 0; half < 2; ++half) {
      float4 xv[8];
#pragma unroll
      for (int it = 0; it < 8; ++it) xv[it] = *(const float4*)(xs + (size_t)((half * 8 + it) * 4 + rsub) * DM);
#pragma unroll
      for (int it = 0; it < 8; ++it) {
        const int row = (half * 8 + it) * 4 + rsub;
        const f32x4 a = *(const f32x4*)(lb + row * 256 + ((c16 ^ (row & 15)) << 4));
        float4 o;
        o.x = xv[it].x + gv.x * a[0]; o.y = xv[it].y + gv.y * a[1]; o.z = xv[it].z + gv.z * a[2]; o.w = xv[it].w + gv.w * a[3];
        *(float4*)(xd + (size_t)row * DM) = o;
      }
    }
  });
}

__device__ void phase_gu(const Params& p, int l, int* ctr) {
  const int MT = (l == 1 ? NBG * SEQ / 128 : RG / 128), NT = 44;
  const u16* W = p.wt + (size_t)l * W_LAYER + W_GU;
  run_q8(ctr, GEMM_CNT(MT, NT), [&](int q_, int j_) {
    int mt, nt; tile_order(j_, mlo(q_ + 1, MT) - mlo(q_, MT), NT, mt, nt); mt += mlo(q_, MT);
    f32x4 acc[4][4];
    gemm_core<4>(p.h + (size_t)mt * 128 * DM, DM, W + (size_t)nt * 128 * DM, DM, DM, acc);
    EPI_VARS
    u16* dst = p.proj + (nt >= 22 ? (size_t)RG * DFF : 0);
    const int nb = (nt >= 22 ? nt - 22 : nt) * 128;
    uint2 o[4][4];
#pragma unroll
    for (int wi = 0; wi < 4; ++wi)
#pragma unroll
      for (int xi = 0; xi < 4; ++xi) {
        o[wi][xi].x = pack2(acc[wi][xi][0], acc[wi][xi][1]); o[wi][xi].y = pack2(acc[wi][xi][2], acc[wi][xi][3]);
      }
    store_tile_bf16<4>(o, dst + (size_t)(mt * 128 + wr_ * 64) * DFF + nb + wc_ * 64, DFF);
  });
}

struct ActIn { uint4 g0, g1, g2, uu; float4 w0a, w0b, w1a, w1b, w2a, w2b, ba, bb; };
__device__ __forceinline__ void act_load(ActIn& a, const u16* G, const u16* UP, const float* cw, const float* cb, int r, int c0) {
  int bl, pos, isctx; rowinfo(r, NBG, bl, pos, isctx);
  const int L = isctx ? CTXL : SEQ;
  const u16* gp = G + (size_t)r * DFF + c0;
  a.g1 = *(const uint4*)gp;
  a.g0 = make_uint4(0, 0, 0, 0); a.g2 = a.g0;
  if (pos > 0) a.g0 = *(const uint4*)(gp - DFF);
  if (pos < L - 1) a.g2 = *(const uint4*)(gp + DFF);
  a.uu = *(const uint4*)(UP + (size_t)r * DFF + c0);
  a.w0a = *(const float4*)(cw + c0); a.w0b = *(const float4*)(cw + c0 + 4);
  a.w1a = *(const float4*)(cw + DFF + c0); a.w1b = *(const float4*)(cw + DFF + c0 + 4);
  a.w2a = *(const float4*)(cw + 2 * DFF + c0); a.w2b = *(const float4*)(cw + 2 * DFF + c0 + 4);
  a.ba = *(const float4*)(cb + c0); a.bb = *(const float4*)(cb + c0 + 4);
}
__device__ __forceinline__ uint4 act_compute(const ActIn& a) {
  uint4 o;
#define ACT2(G0, G1, G2, UU, W0L, W0H, W1L, W1H, W2L, W2H, BL, BH) \
  pack2(silu_f(W0L * bflo(G0) + W1L * bflo(G1) + W2L * bflo(G2) + BL) * bflo(UU), \
        silu_f(W0H * bfhi(G0) + W1H * bfhi(G1) + W2H * bfhi(G2) + BH) * bfhi(UU))
  o.x = ACT2(a.g0.x, a.g1.x, a.g2.x, a.uu.x, a.w0a.x, a.w0a.y, a.w1a.x, a.w1a.y, a.w2a.x, a.w2a.y, a.ba.x, a.ba.y);
  o.y = ACT2(a.g0.y, a.g1.y, a.g2.y, a.uu.y, a.w0a.z, a.w0a.w, a.w1a.z, a.w1a.w, a.w2a.z, a.w2a.w, a.ba.z, a.ba.w);
  o.z = ACT2(a.g0.z, a.g1.z, a.g2.z, a.uu.z, a.w0b.x, a.w0b.y, a.w1b.x, a.w1b.y, a.w2b.x, a.w2b.y, a.bb.x, a.bb.y);
  o.w = ACT2(a.g0.w, a.g1.w, a.g2.w, a.uu.w, a.w0b.z, a.w0b.w, a.w1b.z, a.w1b.w, a.w2b.z, a.w2b.w, a.bb.z, a.bb.w);
#undef ACT2
  return o;
}

__device__ void phase_act(const Params& p, int l, int* ctr) {
  const int nitems = (l == 1) ? NBG * SEQ / 8 : RG / 8;
  const float* cw = p.in[23] + (size_t)l * 3 * DFF;
  const float* cb = p.in[24] + (size_t)l * DFF;
  const u16* G = p.proj;
  u16* UP = p.proj + (size_t)RG * DFF;
  for (int it = blockIdx.x; it < nitems; it += gridDim.x) {
    const int tid = TIDX;
    for (int k = 0; k < 12; k += 2) {
      const int e0 = tid + k * 256, e1 = e0 + 256;
      const bool two = (k + 1 < 11);
      const int r0 = it * 8 + e0 / 352, c00 = (e0 % 352) * 8;
      const int r1 = it * 8 + (two ? e1 / 352 : 0), c01 = two ? (e1 % 352) * 8 : 0;
      ActIn a0, a1;
      act_load(a0, G, UP, cw, cb, r0, c00);
      act_load(a1, G, UP, cw, cb, r1, c01);
      const uint4 o0 = act_compute(a0), o1 = act_compute(a1);
      *(uint4*)(UP + (size_t)r0 * DFF + c00) = o0;
      if (two) *(uint4*)(UP + (size_t)r1 * DFF + c01) = o1;
    }
  }
}

__device__ void phase_final(const Params& p, int* ctr) {
  const int nitems = NBATCH * SEQ / 16;
  const float* gam = p.in[26];
  for (int it = blockIdx.x; it < nitems; it += gridDim.x) {
    const int lane = TIDX & 63, wid = TIDX >> 6;
    float* xr = p.out + ((size_t)it * 16 + wid * 4) * DM;
    float4 v[4][4], gg[4];
#pragma unroll
    for (int rr = 0; rr < 4; ++rr)
#pragma unroll
      for (int i = 0; i < 4; ++i) v[rr][i] = *(const float4*)(xr + (size_t)rr * DM + lane * 4 + i * 256);
#pragma unroll
    for (int i = 0; i < 4; ++i) gg[i] = *(const float4*)(gam + lane * 4 + i * 256);
#pragma unroll
    for (int rr = 0; rr < 4; ++rr) {
      float ss = 0.f;
#pragma unroll
      for (int i = 0; i < 4; ++i)
        ss += v[rr][i].x * v[rr][i].x + v[rr][i].y * v[rr][i].y + v[rr][i].z * v[rr][i].z + v[rr][i].w * v[rr][i].w;
      ss = wave_sum(ss);
      const float rstd = rsqrtf(ss * (1.f / 1024.f) + EPS);
#pragma unroll
      for (int i = 0; i < 4; ++i) {
        float4 o; o.x = v[rr][i].x * rstd * gg[i].x; o.y = v[rr][i].y * rstd * gg[i].y; o.z = v[rr][i].z * rstd * gg[i].z; o.w = v[rr][i].w * rstd * gg[i].w;
        *(float4*)(xr + (size_t)rr * DM + lane * 4 + i * 256) = o;
      }
    }
  }
}

#define XB_TMO      128
#define XB_XCNT(j)  (256  + 64 * (j))
#define XB_XSUB(j)  (1280 + 64 * (j))
#define XB_XGEN(j)  (2304 + 64 * (j))
#define XB_TOP      3328
#define XB_TOPGEN   3392
#define XCD_BAR_WORDS 3456
#define XB_SPIN_CAP (1u << 22)
#define LAS __attribute__((address_space(3)))
__device__ __forceinline__ unsigned xb_ld(unsigned* p)              { return __hip_atomic_load(p, __ATOMIC_RELAXED, __HIP_MEMORY_SCOPE_AGENT); }
__device__ __forceinline__ unsigned xb_add(unsigned* p, unsigned v) { return __hip_atomic_fetch_add(p, v, __ATOMIC_RELAXED, __HIP_MEMORY_SCOPE_AGENT); }
__device__ __forceinline__ unsigned xb_xcc_id() { return (unsigned)__builtin_amdgcn_s_getreg((3 << 11) | 20) & 0xFu; }
#define XB_SPIN(cond, bar) do { unsigned _sp = 0; while (cond) { __builtin_amdgcn_s_sleep(1); \
    if ((++_sp & 255u) == 0u) { if (xb_ld(&(bar)[XB_TMO])) break; if (_sp > XB_SPIN_CAP) { atomicAdd(&(bar)[XB_TMO], 1u); break; } } } } while (0)
struct XcdBarrier { unsigned* bar; unsigned x; volatile LAS unsigned* st; };
__device__ __forceinline__ XcdBarrier xcd_barrier_post(unsigned* bar, volatile LAS unsigned* st) {
  XcdBarrier b; b.bar = bar; b.x = xb_xcc_id(); b.st = st;
  if (threadIdx.x == 0) (void)xb_add(&bar[XB_XCNT(b.x)], 1u);
  return b;
}
__device__ __forceinline__ void xcd_barrier_complete(unsigned* bar, unsigned x, unsigned& nloc, unsigned& nx) {
  const unsigned G = gridDim.x * gridDim.y * gridDim.z;
  unsigned sum, cnt, mine, sp = 0u;
  for (;;) {
    sum = 0u; cnt = 0u; mine = 0u;
#pragma unroll
    for (unsigned j = 0; j < 16; ++j) { const unsigned c = xb_ld(&bar[XB_XCNT(j)]); sum += c; cnt += (c > 0u) ? 1u : 0u; mine = (j == x) ? c : mine; }
    if (sum == G) break;
    __builtin_amdgcn_s_sleep(1);
    if ((++sp & 255u) == 0u) { if (xb_ld(&bar[XB_TMO])) break; if (sp > XB_SPIN_CAP) { atomicAdd(&bar[XB_TMO], 1u); break; } }
  }
  nloc = mine > 0u ? mine : 1u; nx = cnt > 0u ? cnt : 1u;
}
__device__ __forceinline__ void xcd_barrier(const XcdBarrier& b) {
  asm volatile("s_waitcnt vmcnt(0)" ::: "memory");
  __syncthreads();
  if (threadIdx.x == 0) {
    unsigned* bar = b.bar;
    __builtin_amdgcn_s_waitcnt(0);
    unsigned nloc = b.st[0], nx = b.st[1];
    if (nloc == 0u) { xcd_barrier_complete(bar, b.x, nloc, nx); b.st[0] = nloc; b.st[1] = nx; }
    const unsigned old = xb_add(&bar[XB_XSUB(b.x)], 1u);
    const unsigned gen = old / nloc;
    if (old + 1u == (gen + 1u) * nloc) {
      __builtin_amdgcn_fence(__ATOMIC_RELEASE, "agent");
      asm volatile("s_waitcnt vmcnt(0)" ::: "memory");
      const unsigned og = xb_add(&bar[XB_TOP], 1u);
      const unsigned tg = og / nx;
      if (og + 1u == (tg + 1u) * nx) xb_add(&bar[XB_TOPGEN], 1u);
      else XB_SPIN(xb_ld(&bar[XB_TOPGEN]) == tg, bar);
      __builtin_amdgcn_fence(__ATOMIC_ACQUIRE, "agent");
      xb_add(&bar[XB_XGEN(b.x)], 1u);
      asm volatile("s_waitcnt vmcnt(0)" ::: "memory");
    } else {
      XB_SPIN(xb_ld(&bar[XB_XGEN(b.x)]) == gen, bar);
      __builtin_amdgcn_fence(__ATOMIC_ACQUIRE, "agent");
      asm volatile("s_waitcnt vmcnt(0)" ::: "memory");
    }
  }
  __syncthreads();
}

__device__ void run_phase(const Params& p, int ph, int* ctr) {
  if (ph == 0) { phase0(p, ctr); return; }
  if (ph == NPHASES - 1) { phase_final(p, ctr); return; }
  const int idx = ph - 1, lg = idx / NPH_PER, sub = idx % NPH_PER;
  const int l = lg / NGRP, g = lg % NGRP;
  switch (sub) {
    case 0: phase_norm(p, l, g, 0, ctr); break;
    case 1: phase_proj(p, l, ctr); break;
    case 2: phase_postproj(p, l, ctr); break;
    case 3: phase_qkv(p, l, ctr); break;
    case 4: phase_attn(p, l, ctr); break;
    case 5: phase_merge(p, l, ctr); break;
    case 6: phase_resid(p, l, g, 0, ctr); break;
    case 7: phase_norm(p, l, g, 1, ctr); break;
    case 8: phase_gu(p, l, ctr); break;
    case 9: phase_act(p, l, ctr); break;
    default: phase_resid(p, l, g, 1, ctr); break;
  }
}

__global__ void __launch_bounds__(256, 2) mega_kernel(KArgs ka, int ph_lo, int ph_hi, int coop) {
  Params p;
#pragma unroll
  for (int i = 0; i < 27; ++i) p.in[i] = ka.in[i];
  p.out = ka.out;
  char* ws = ka.ws;
  p.ctr = (int*)(ws + O_CTR); p.mod = (float*)(ws + O_MOD); p.rope = (float*)(ws + O_ROPE); p.xc = (float*)(ws + O_XC);
  p.rstdq = (float*)(ws + O_RSQ); p.rstdkv = (float*)(ws + O_RSKV); p.dec = (float*)(ws + O_DEC); p.wt = (u16*)(ws + O_WT);
  p.proj = (u16*)(ws + O_PROJ); p.h = (u16*)(ws + O_H); p.m = (u16*)(ws + O_M); p.q = (u16*)(ws + O_Q);
  p.kf = (u16*)(ws + O_KF); p.vt = (u16*)(ws + O_VT); p.uc = (u16*)(ws + O_UC); p.gq = (u16*)(ws + O_GQ);
  p.ss = (u16*)(ws + O_SS);
  volatile LAS unsigned* st = (volatile LAS unsigned*)(smem + SLOT_OFF + 64);
  if (threadIdx.x == 0) { st[0] = 0u; st[1] = 0u; }
  __syncthreads();
  XcdBarrier xb;
  xb.bar = (unsigned*)(ws + O_BAR); xb.x = 0; xb.st = st;
  if (coop) xb = xcd_barrier_post((unsigned*)(ws + O_BAR), st);
  for (int ph = ph_lo; ph < ph_hi; ++ph) {
#ifdef PROBE_MASK
    const int nrep = (ph > 0 && ph < NPHASES - 1 && ((PROBE_MASK >> ((ph - 1) % NPH_PER)) & 1)) ? 2 : 1;
#else
    const int nrep = 1;
#endif
    for (int rep = 0; rep < nrep; ++rep) {
      if (rep) xcd_barrier(xb);
      run_phase(p, ph, p.ctr + rep * 512 + ph * 8);
    }
    if (coop && ph + 1 < ph_hi) {
      if (ph == ph_lo) cg::this_grid().sync();
      else xcd_barrier(xb);
    }
  }
}

static inline size_t align_up(size_t v) { return (v + 255) & ~(size_t)255; }

extern "C" void kernel_launch(void* const* d_in, const int* in_sizes, int n_in, void* d_out, int out_size,
                              void* d_ws, size_t ws_size, hipStream_t stream) {
  static int grid_blocks = 0;
  if (!grid_blocks) {
    int dev = 0, cus = 0, per_cu = 0;
    hipGetDevice(&dev);
    hipDeviceGetAttribute(&cus, hipDeviceAttributeMultiprocessorCount, dev);
    hipFuncSetAttribute((const void*)mega_kernel, hipFuncAttributeMaxDynamicSharedMemorySize, LDS_BYTES);
    hipOccupancyMaxActiveBlocksPerMultiprocessor(&per_cu, (const void*)mega_kernel, 256, LDS_BYTES);
    if (per_cu < 1) per_cu = 1;
    if (per_cu > 2) per_cu = 2;
    grid_blocks = cus * per_cu;
  }
  KArgs p{};
  for (int i = 0; i < 27; ++i) p.in[i] = (const float*)d_in[i];
  p.out = (float*)d_out;
  p.ws = (char*)d_ws;
  if (ws_size < WS_END) { fprintf(stderr, "workspace too small: %zu < %zu\n", ws_size, (size_t)WS_END); return; }
  hipMemsetAsync((char*)d_ws + O_CTR, 0, 4096 + XCD_BAR_BYTES, stream);
#if SINGLE_LAUNCH
  int lo = 0, hi = NPHASES, coop = 1;
  void* args[] = {&p, &lo, &hi, &coop};
  hipError_t e = hipLaunchCooperativeKernel((const void*)mega_kernel, dim3(grid_blocks), dim3(256), args, LDS_BYTES, stream);
  if (e != hipSuccess) fprintf(stderr, "cooperative launch failed: %s (grid %d)\n", hipGetErrorString(e), grid_blocks);
#else
  for (int ph = 0; ph < NPHASES; ++ph)
    hipLaunchKernelGGL(mega_kernel, dim3(grid_blocks), dim3(256), LDS_BYTES, stream, p, ph, ph + 1, 0);
#endif
}
```

```cpp
#include <hip/hip_runtime.h>
#include <hip/hip_cooperative_groups.h>
#include <cstdio>
#include <cstdint>
namespace cg = cooperative_groups;

typedef unsigned short u16;
typedef __attribute__((ext_vector_type(8))) short bf16x8;
typedef __attribute__((ext_vector_type(4))) float f32x4;
typedef __attribute__((ext_vector_type(16))) float f32x16;

#ifndef SINGLE_LAUNCH
#define SINGLE_LAUNCH 1
#endif

constexpr int DM = 1024, SEQ = 8192, CTXL = 256, NBATCH = 8, INW = 6592, INWP = 6656, DFF = 2816;
constexpr int C_QA = 0, C_KA = 256, C_VA = 512, C_RA = 1024, C_ALR = 1536, C_CQ = 1568, C_CKV = 1824,
              C_KR = 1952, C_SB = 1984, C_SC = 2496, C_SX = 3008, C_GATE = 3520;
constexpr int NKEY = SEQ + CTXL;
constexpr int NCHUNK = NKEY / 64;
constexpr float EPS = 1e-6f;
constexpr int LDS_BYTES = 65536 + 256;
constexpr int SLOT_OFF = 65536;
constexpr int NPH_PER = 11;
constexpr int NBG = 4;
constexpr int NGRP = NBATCH / NBG;
constexpr int RG = NBG * (SEQ + CTXL);
constexpr int NPHASES = 1 + 2 * NGRP * NPH_PER + 1;

constexpr size_t W_IN = 0;
constexpr size_t W_UQ = W_IN + (size_t)INWP * 1024;
constexpr size_t W_UKV = W_UQ + 768 * 256;
constexpr size_t W_BRA = W_UKV + 1024 * 128;
constexpr size_t W_BRB = W_BRA + 1024 * 512;
constexpr size_t W_BRC = W_BRB + 1024 * 512;
constexpr size_t W_O = W_BRC + 1024 * 512;
constexpr size_t W_GU = W_O + 1024 * 1024;
constexpr size_t W_DN = W_GU + (size_t)5632 * 1024;
constexpr size_t W_LAYER = W_DN + (size_t)1024 * 2816;

struct KArgs {
  const float* in[27];
  float* out;
  char* ws;
};
struct Params {
  const float* in[27];
  float* out;
  float* xc;
  u16* wt;
  float* mod;
  float* rope;
  int* ctr;
  float* rstdq;
  float* rstdkv;
  float* dec;
  u16* proj;
  u16* h;
  u16* m;
  u16* q;
  u16* kf;
  u16* vt;
  u16* uc;
  u16* gq;
  u16* ss;
};
constexpr size_t al256(size_t v) { return (v + 255) & ~(size_t)255; }
constexpr size_t XCD_BAR_BYTES = 3456 * 4;
constexpr size_t O_CTR = 0;
constexpr size_t O_BAR = O_CTR + 4096;
constexpr size_t O_MOD = al256(O_BAR + XCD_BAR_BYTES);
constexpr size_t O_ROPE = al256(O_MOD + (size_t)2 * 9 * 6144 * 4);
constexpr size_t O_XC = al256(O_ROPE + 1024 * 2 * 4);
constexpr size_t O_RSQ = al256(O_XC + (size_t)NBATCH * CTXL * DM * 4);
constexpr size_t O_RSKV = al256(O_RSQ + (size_t)RG * 4);
constexpr size_t O_DEC = al256(O_RSKV + (size_t)RG * 4);
constexpr size_t O_WT = al256(O_DEC + (size_t)NBG * NCHUNK * 4 * 2 * 64 * 4);
constexpr size_t O_PROJ = al256(O_WT + 2 * W_LAYER * 2);
constexpr size_t O_H = al256(O_PROJ + (size_t)RG * INW * 2);
constexpr size_t O_M = O_H + (size_t)RG * DM * 2;
constexpr size_t O_Q = al256(O_M + (size_t)RG * DM * 2);
constexpr size_t O_KF = al256(O_Q + (size_t)RG * 768 * 2);
constexpr size_t O_VT = al256(O_KF + (size_t)NBG * 8 * NKEY * 96 * 2);
constexpr size_t O_UC = al256(O_VT + (size_t)NBG * 8 * 64 * NKEY * 2);
constexpr size_t O_GQ = al256(O_UC + (size_t)RG * 512 * 2);
constexpr size_t O_SS = al256(O_GQ + (size_t)RG * 1024 * 2);
constexpr size_t WS_END = al256(O_SS + (size_t)NBG * NCHUNK * 4 * 2 * 8192 * 2);
static_assert(WS_END <= ((size_t)1 << 30), "workspace layout must fit 1 GiB");

extern __shared__ __attribute__((aligned(16))) char smem[];

typedef __bf16 hbf2 __attribute__((ext_vector_type(2)));
typedef float hf2 __attribute__((ext_vector_type(2)));
__device__ __forceinline__ unsigned pack2(float a, float b) {
  hf2 v = {a, b};
  return __builtin_bit_cast(unsigned, __builtin_convertvector(v, hbf2));
}
__device__ __forceinline__ u16 f2bf(float f) { return (u16)(pack2(f, 0.f) & 0xffffu); }
__device__ __forceinline__ float bf2f(u16 h) { return __uint_as_float(((unsigned)h) << 16); }
__device__ __forceinline__ float bflo(unsigned u) { return __uint_as_float(u << 16); }
__device__ __forceinline__ float bfhi(unsigned u) { return __uint_as_float(u & 0xffff0000u); }
__device__ __forceinline__ float silu_f(float x) { return x / (1.f + __expf(-x)); }
__device__ __forceinline__ float sigmoid_f(float x) { return 1.f / (1.f + __expf(-x)); }

__device__ __forceinline__ void rowinfo(int r, int NB, int& bl, int& pos, int& isctx) {
  const int nl = NB * SEQ;
  if (r < nl) { bl = r >> 13; pos = r & (SEQ - 1); isctx = 0; }
  else { const int rc = r - nl; bl = rc >> 8; pos = rc & (CTXL - 1); isctx = 1; }
}
__device__ __forceinline__ int chunk_row(int bl, int cidx, int NB) {
  return cidx < 128 ? bl * SEQ + cidx * 64 : NB * SEQ + bl * CTXL + (cidx - 128) * 64;
}

template <class CntF, class BodyF>
__device__ __forceinline__ void run_q8(int* ctr8, CntF cntf, BodyF body) {
  volatile int* slot = (volatile int*)(smem + SLOT_OFF);
  int q = blockIdx.x & 7, tries = 0, item;
  __syncthreads();
  if (threadIdx.x == 0) {
    int v = atomicAdd(&ctr8[q], 1);
    while (v >= cntf(q) && tries < 8) { q = (q + 1) & 7; ++tries; if (tries < 8) v = atomicAdd(&ctr8[q], 1); }
    slot[0] = (tries < 8) ? v : -1; slot[1] = q; slot[2] = tries;
  }
  __syncthreads();
  item = slot[0]; q = slot[1]; tries = slot[2];
  while (item >= 0) {
    int nxt = 0;
    if (threadIdx.x == 0) nxt = atomicAdd(&ctr8[q], 1);
    body(q, item);
    __syncthreads();
    if (threadIdx.x == 0) {
      int qq = q, t = tries;
      while (nxt >= cntf(qq) && t < 8) { qq = (qq + 1) & 7; ++t; if (t < 8) nxt = atomicAdd(&ctr8[qq], 1); }
      slot[0] = (t < 8) ? nxt : -1; slot[1] = qq; slot[2] = t;
    }
    __syncthreads();
    item = slot[0]; q = slot[1]; tries = slot[2];
  }
}
#define QA_CNT(N) [=](int q_) { return ((N) - q_ + 7) >> 3; }
#define QA_ID(q_, j_) ((j_) * 8 + (q_))

__device__ __forceinline__ int opaque_tid() {
  int t = threadIdx.x;
  asm volatile("" : "+v"(t));
  return t;
}
#define TIDX opaque_tid()
template <int M>
__device__ __forceinline__ float xor_lane(float v) {
  if constexpr (M == 32) {
    const unsigned u = __float_as_uint(v);
    const auto sw = __builtin_amdgcn_permlane32_swap(u, u, false, false);
    const int lane = __builtin_amdgcn_mbcnt_hi(~0u, __builtin_amdgcn_mbcnt_lo(~0u, 0u));
    return __uint_as_float(lane < 32 ? sw[1] : sw[0]);
  } else {
    return __uint_as_float((unsigned)__builtin_amdgcn_ds_swizzle((int)__float_as_uint(v), 0x1f | (M << 10)));
  }
}
__device__ __forceinline__ float wave_sum(float v) {
  v += xor_lane<32>(v); v += xor_lane<16>(v); v += xor_lane<8>(v);
  v += xor_lane<4>(v); v += xor_lane<2>(v); v += xor_lane<1>(v);
  return v;
}

__device__ __forceinline__ int lds_byte(int r, int c) {
  const int st = (r >> 4) * 2 + (c >> 5), rr = r & 15, cc = c & 31, ob = rr * 64 + cc * 2;
  return st * 1024 + (ob ^ (((ob >> 9) & 1) << 5));
}
__device__ __forceinline__ void stage_rc(int b, int& R, int& C) {
  const int st = b >> 10, sb = b & 1023, swz = sb ^ (((sb >> 9) & 1) << 5);
  R = (st >> 1) * 16 + (swz >> 6); C = (st & 1) * 32 + ((swz & 63) >> 1);
}

__device__ __forceinline__ void glds16(const void* g, void* l) {
  __builtin_amdgcn_global_load_lds((const __attribute__((address_space(1))) unsigned*)g,
                                   (__attribute__((address_space(3))) unsigned*)l, 16, 0, 0);
}

template <int NWI>
__device__ __forceinline__ void gemm_core(const u16* __restrict__ X, int ldx, const u16* __restrict__ W, int ldw,
                                          int K, f32x4 (&acc)[NWI][4]) {
  const int tid = TIDX, lane = tid & 63, wid = tid >> 6;
  const int wr = wid >> 1, wc = wid & 1, fr = lane & 15, fq = lane >> 4;
#pragma unroll
  for (int a = 0; a < NWI; ++a)
#pragma unroll
    for (int b = 0; b < 4; ++b) acc[a][b] = f32x4{0.f, 0.f, 0.f, 0.f};
  const int srow = tid >> 3, schunk = (tid & 7) ^ ((tid >> 4) & 7);
  const u16* xg = X + (size_t)srow * ldx + schunk * 8;
  const u16* wg = W + (size_t)srow * ldw + schunk * 8;
  const int xs = 32 * ldx, ws_ = 32 * ldw;
  const int g = fr >> 1;
  const int lo0 = fr * 128 + ((fq ^ g) << 4), lo1 = fr * 128 + (((fq ^ g) ^ 4) << 4);
  const char* xb = smem + wr * 8192;
  const char* wb = smem + 16384 + wc * (NWI * 2048);
  char* sdst = smem + tid * 16;
  const int nt = K >> 6;
  __syncthreads();
#pragma unroll
  for (int i = 0; i < 4; ++i) {
    glds16(xg + i * xs, sdst + i * 4096);
    if (i < NWI) glds16(wg + i * ws_, sdst + 16384 + i * 4096);
  }
  for (int kt = 0; kt < nt; ++kt) {
    asm volatile("s_waitcnt vmcnt(0)" ::: "memory");
    __syncthreads();
    const int cb = (kt & 1) * 32768;
    if (kt + 1 < nt) {
      const int nb = 32768 - cb;
      const int ko = (kt + 1) * 64;
#pragma unroll
      for (int i = 0; i < 4; ++i) {
        glds16(xg + i * xs + ko, sdst + nb + i * 4096);
        if (i < NWI) glds16(wg + i * ws_ + ko, sdst + nb + 16384 + i * 4096);
      }
    }
    bf16x8 wf[2][NWI], xf[2][4];
#pragma unroll
    for (int i = 0; i < NWI; ++i) {
      wf[0][i] = *(const bf16x8*)(wb + cb + i * 2048 + lo0);
      wf[1][i] = *(const bf16x8*)(wb + cb + i * 2048 + lo1);
    }
#pragma unroll
    for (int i = 0; i < 4; ++i) {
      xf[0][i] = *(const bf16x8*)(xb + cb + i * 2048 + lo0);
      xf[1][i] = *(const bf16x8*)(xb + cb + i * 2048 + lo1);
    }
    __builtin_amdgcn_sched_barrier(0);
#pragma unroll
    for (int k = 0; k < 2; ++k)
#pragma unroll
      for (int wi = 0; wi < NWI; ++wi)
#pragma unroll
        for (int xi = 0; xi < 4; ++xi)
          acc[wi][xi] = __builtin_amdgcn_mfma_f32_16x16x32_bf16(wf[k][wi], xf[k][xi], acc[wi][xi], 0, 0, 0);
    __builtin_amdgcn_sched_barrier(0);
  }
}

#define EPI_VARS const int tid_ = TIDX, lane_ = tid_ & 63, wid_ = tid_ >> 6; \
  const int wr_ = wid_ >> 1, wc_ = wid_ & 1, fr_ = lane_ & 15, fq_ = lane_ >> 4; (void)fq_; (void)fr_; (void)wr_; (void)wc_;
#define EPI_TR(xi) (wr_ * 64 + (xi) * 16 + fr_)
#define EPI_NN(wi) (wc_ * 64 + (wi) * 16 + fq_ * 4)

template <int NWI>
__device__ __forceinline__ void store_tile_bf16(const uint2 (&o)[NWI][4], u16* dst_wave, size_t ld) {
  constexpr int RB = NWI * 32, CPR = RB / 16;
  const int tid = TIDX, lane = tid & 63, wid = tid >> 6, fr = lane & 15, fq = lane >> 4;
  char* lb = smem + wid * 8192;
#pragma unroll
  for (int wi = 0; wi < NWI; ++wi)
#pragma unroll
    for (int xi = 0; xi < 4; ++xi) {
      const int r = xi * 16 + fr, c = wi * 2 + (fq >> 1);
      *(uint2*)(lb + r * RB + ((c ^ (r & (CPR - 1))) << 4) + (fq & 1) * 8) = o[wi][xi];
    }
#pragma unroll
  for (int it = 0; it < CPR; ++it) {
    const int idx = it * 64 + lane, row = idx / CPR, c = idx % CPR;
    const uint4 v = *(const uint4*)(lb + row * RB + ((c ^ (row & (CPR - 1))) << 4));
    *(uint4*)(dst_wave + (size_t)row * ld + c * 8) = v;
  }
}

__device__ __forceinline__ void tile_order(int t, int MT, int NT, int& mt, int& nt) {
  constexpr int GM = 4;
  const int band = t / (GM * NT), rem = t - band * GM * NT;
  const int m0 = band * GM;
  const int gsz = min(GM, MT - m0);
  nt = rem / gsz; mt = m0 + rem - nt * gsz;
}

__device__ __forceinline__ int mlo(int q, int MT) { return (q * MT) >> 3; }
#define GEMM_CNT(MT, NT) [=](int q_) { return (mlo(q_ + 1, MT) - mlo(q_, MT)) * (NT); }

__device__ __forceinline__ float* xrow_ptr(const Params& p, int g, int r) {
  int bl, pos, isctx; rowinfo(r, NBG, bl, pos, isctx);
  const int b = g * NBG + bl;
  return isctx ? p.xc + ((size_t)b * CTXL + pos) * DM : p.out + ((size_t)b * SEQ + pos) * DM;
}
__device__ __forceinline__ const float* xsrc_row_ptr(const Params& p, int g, int r, int from_input) {
  int bl, pos, isctx; rowinfo(r, NBG, bl, pos, isctx);
  const int b = g * NBG + bl;
  if (from_input) return isctx ? p.in[2] + ((size_t)b * CTXL + pos) * DM : p.in[0] + ((size_t)b * SEQ + pos) * DM;
  return isctx ? p.xc + ((size_t)b * CTXL + pos) * DM : p.out + ((size_t)b * SEQ + pos) * DM;
}
__device__ __forceinline__ int mod_index(const Params& p, int g, int r) {
  int bl, pos, isctx; rowinfo(r, NBG, bl, pos, isctx);
  return isctx ? 8 : g * NBG + bl;
}

__device__ void conv_tile4(const float* __restrict__ src, int K, int N, u16* __restrict__ dst,
                           const float* __restrict__ scale, int ktile, int ngrp) {
  float* tile = (float*)smem;
  const int tid = TIDX;
  const int k0 = ktile * 64;
  const int kk = tid >> 4, n4 = (tid & 15) * 4;
  float4 v[4][4];
  float sc[4];
#pragma unroll
  for (int i = 0; i < 4; ++i) sc[i] = scale ? scale[k0 + kk + 16 * i] : 1.f;
#pragma unroll
  for (int t = 0; t < 4; ++t) {
    const int n0 = (ngrp * 4 + t) * 64;
#pragma unroll
    for (int i = 0; i < 4; ++i) {
      v[t][i] = make_float4(0.f, 0.f, 0.f, 0.f);
      if (n0 < N) v[t][i] = *(const float4*)(src + (size_t)(k0 + kk + 16 * i) * N + n0 + n4);
    }
  }
  const int nn = tid >> 3, k8 = (tid & 7) * 8;
#pragma unroll
  for (int t = 0; t < 4; ++t) {
    const int n0 = (ngrp * 4 + t) * 64;
    __syncthreads();
#pragma unroll
    for (int i = 0; i < 4; ++i) {
      const int k = kk + 16 * i;
      tile[k * 65 + n4 + 0] = v[t][i].x * sc[i]; tile[k * 65 + n4 + 1] = v[t][i].y * sc[i];
      tile[k * 65 + n4 + 2] = v[t][i].z * sc[i]; tile[k * 65 + n4 + 3] = v[t][i].w * sc[i];
    }
    __syncthreads();
#pragma unroll
    for (int i = 0; i < 2; ++i) {
      const int n = nn + 32 * i;
      uint4 o;
      o.x = pack2(tile[(k8 + 0) * 65 + n], tile[(k8 + 1) * 65 + n]);
      o.y = pack2(tile[(k8 + 2) * 65 + n], tile[(k8 + 3) * 65 + n]);
      o.z = pack2(tile[(k8 + 4) * 65 + n], tile[(k8 + 5) * 65 + n]);
      o.w = pack2(tile[(k8 + 6) * 65 + n], tile[(k8 + 7) * 65 + n]);
      *(uint4*)(dst + (size_t)(n0 + n) * K + k0 + k8) = o;
    }
  }
}

__device__ void sincos_d(double a, double& s, double& c) {
  const double k = rint(a * 0.6366197723675814);
  double r = fma(-k, 1.5707963267948966, a);
  r = fma(-k, 6.123233995736766e-17, r);
  const int q = ((int)k) & 3;
  const double r2 = r * r;
  const double sp = r * (1.0 + r2 * (-1.0 / 6 + r2 * (1.0 / 120 + r2 * (-1.0 / 5040 + r2 * (1.0 / 362880 + r2 * (-1.0 / 39916800 + r2 * (1.0 / 6227020800.0)))))));
  const double cp = 1.0 + r2 * (-0.5 + r2 * (1.0 / 24 + r2 * (-1.0 / 720 + r2 * (1.0 / 40320 + r2 * (-1.0 / 3628800 + r2 * (1.0 / 479001600.0 + r2 * (-1.0 / 87178291200.0)))))));
  s = (q == 0) ? sp : (q == 1) ? cp : (q == 2) ? -sp : -cp;
  c = (q == 0) ? cp : (q == 1) ? -sp : (q == 2) ? -cp : sp;
}

constexpr int CV_WIN = 0, CV_UQ = 416, CV_UKV = 428, CV_BRA = 436, CV_BRB = 468, CV_BRC = 500,
              CV_WO = 532, CV_GATE = 596, CV_UP = 772, CV_DN = 948, CV_LAYER = 1124;
constexpr int P0_CONV = 2 * CV_LAYER, P0_ADA = 2 * 192, P0_TOTAL = P0_CONV + P0_ADA + 1;

__device__ void phase0(const Params& p, int* ctr) {
  run_q8(ctr, QA_CNT(P0_TOTAL), [&](int q_, int j_) {
    const int it = QA_ID(q_, j_);
    const int tid = TIDX;
    if (it >= P0_ADA + 1) {
      const int ci = it - (P0_ADA + 1);
      const int l = ci / CV_LAYER, j = ci % CV_LAYER;
      u16* wl = p.wt + (size_t)l * W_LAYER;
      if (j < CV_UQ)       { const int jj = j - CV_WIN;  conv_tile4(p.in[7] + (size_t)l * 1024 * INW, 1024, INW, wl + W_IN, nullptr, jj / 26, jj % 26); }
      else if (j < CV_UKV) { const int jj = j - CV_UQ;   conv_tile4(p.in[12] + (size_t)l * 256 * 768, 256, 768, wl + W_UQ, p.in[11] + l * 256, jj / 3, jj % 3); }
      else if (j < CV_BRA) { const int jj = j - CV_UKV;  conv_tile4(p.in[14] + (size_t)l * 128 * 1024, 128, 1024, wl + W_UKV, p.in[13] + l * 128, jj / 4, jj % 4); }
      else if (j < CV_BRB) { const int jj = j - CV_BRA;  conv_tile4(p.in[16] + (size_t)l * 512 * 1024, 512, 1024, wl + W_BRA, nullptr, jj / 4, jj % 4); }
      else if (j < CV_BRC) { const int jj = j - CV_BRB;  conv_tile4(p.in[17] + (size_t)l * 512 * 1024, 512, 1024, wl + W_BRB, nullptr, jj / 4, jj % 4); }
      else if (j < CV_WO)  { const int jj = j - CV_BRC;  conv_tile4(p.in[18] + (size_t)l * 512 * 1024, 512, 1024, wl + W_BRC, nullptr, jj / 4, jj % 4); }
      else if (j < CV_GATE){ const int jj = j - CV_WO;   conv_tile4(p.in[19] + (size_t)l * 1024 * 1024, 1024, 1024, wl + W_O, nullptr, jj / 4, jj % 4); }
      else if (j < CV_UP)  { const int jj = j - CV_GATE; conv_tile4(p.in[21] + (size_t)l * 1024 * DFF, 1024, DFF, wl + W_GU, nullptr, jj / 11, jj % 11); }
      else if (j < CV_DN)  { const int jj = j - CV_UP;   conv_tile4(p.in[22] + (size_t)l * 1024 * DFF, 1024, DFF, wl + W_GU + (size_t)DFF * 1024, nullptr, jj / 11, jj % 11); }
      else                 { const int jj = j - CV_DN;   conv_tile4(p.in[25] + (size_t)l * DFF * 1024, DFF, 1024, wl + W_DN, nullptr, jj / 4, jj % 4); }
    } else if (it < P0_ADA) {
      const int a = it, l = a / 192, cg_ = a % 192;
      float* sc = (float*)smem;
      float* red = sc + 9 * 1024;
      for (int e = tid; e < 9 * 1024; e += 256) {
        const int v = e >> 10, k = e & 1023;
        const float cv = (v < 8) ? p.in[1][v * 1024 + k] : p.in[3][k];
        sc[e] = cv / (1.f + expf(-cv));
      }
      __syncthreads();
      const int kg = tid >> 5, cn = tid & 31;
      const float* wa = p.in[4] + (size_t)l * 1024 * 6144 + cg_ * 32 + cn;
      float a0 = 0, a1 = 0, a2 = 0, a3 = 0, a4 = 0, a5 = 0, a6 = 0, a7 = 0, a8 = 0;
#pragma unroll 8
      for (int i = 0; i < 128; ++i) {
        const int k = kg + 8 * i;
        const float w = wa[(size_t)k * 6144];
        a0 += sc[k] * w; a1 += sc[1024 + k] * w; a2 += sc[2048 + k] * w; a3 += sc[3072 + k] * w;
        a4 += sc[4096 + k] * w; a5 += sc[5120 + k] * w; a6 += sc[6144 + k] * w; a7 += sc[7168 + k] * w;
        a8 += sc[8192 + k] * w;
      }
      float* rr = red + kg * 288 + cn;
      rr[0] = a0; rr[32] = a1; rr[64] = a2; rr[96] = a3; rr[128] = a4; rr[160] = a5; rr[192] = a6; rr[224] = a7; rr[256] = a8;
      __syncthreads();
      for (int e = tid; e < 288; e += 256) {
        float s = 0.f;
#pragma unroll
        for (int g8 = 0; g8 < 8; ++g8) s += red[g8 * 288 + e];
        const int v = e >> 5, n = cg_ * 32 + (e & 31);
        p.mod[((size_t)l * 9 + v) * 6144 + n] = s + p.in[5][l * 6144 + n];
      }
    } else {
      for (int e = tid; e < 1024; e += 256) {
        const int pos = e >> 3, f = e & 7;
        const float inv = (f == 0) ? 1.0f : (f == 1) ? 0.31622776601683794f : (f == 2) ? 0.1f : (f == 3) ? 0.031622776601683794f
                        : (f == 4) ? 0.01f : (f == 5) ? 0.0031622776601683794f : (f == 6) ? 0.001f : 0.00031622776601683794f;
        const float ang = (float)pos * inv;
        double s, c; sincos_d((double)ang, s, c);
        p.rope[e * 2] = (float)c; p.rope[e * 2 + 1] = (float)s;
      }
    }
  });
}

__device__ void phase_norm(const Params& p, int l, int g, int which, int* ctr) {
  const int nitems = (which == 1 && l == 1) ? NBG * SEQ / 16 : RG / 16;
  const float* gam = (which == 0 ? p.in[6] : p.in[20]) + l * DM;
  const int shoff = which == 0 ? 0 : 3072, scoff = which == 0 ? 1024 : 4096;
  const int from_input = (which == 0 && l == 0);
  for (int it = blockIdx.x; it < nitems; it += gridDim.x) {
    const int lane = TIDX & 63, wid = TIDX >> 6;
    const int r0 = it * 16 + wid * 4;
    const float* xr = xsrc_row_ptr(p, g, r0, from_input);
    const float* mrow = p.mod + ((size_t)l * 9 + mod_index(p, g, r0)) * 6144;
    float4 v[4][4], gg[4], sh[4], sc[4];
#pragma unroll
    for (int rr = 0; rr < 4; ++rr)
#pragma unroll
      for (int i = 0; i < 4; ++i) v[rr][i] = *(const float4*)(xr + (size_t)rr * DM + lane * 4 + i * 256);
#pragma unroll
    for (int i = 0; i < 4; ++i) {
      const int c = lane * 4 + i * 256;
      gg[i] = *(const float4*)(gam + c); sh[i] = *(const float4*)(mrow + shoff + c); sc[i] = *(const float4*)(mrow + scoff + c);
    }
#pragma unroll
    for (int rr = 0; rr < 4; ++rr) {
      float ss = 0.f;
#pragma unroll
      for (int i = 0; i < 4; ++i)
        ss += v[rr][i].x * v[rr][i].x + v[rr][i].y * v[rr][i].y + v[rr][i].z * v[rr][i].z + v[rr][i].w * v[rr][i].w;
      ss = wave_sum(ss);
      const float rstd = rsqrtf(ss * (1.f / 1024.f) + EPS);
#pragma unroll
      for (int i = 0; i < 4; ++i) {
        const int c = lane * 4 + i * 256;
        uint2 o;
        o.x = pack2(v[rr][i].x * rstd * gg[i].x * (1.f + sc[i].x) + sh[i].x, v[rr][i].y * rstd * gg[i].y * (1.f + sc[i].y) + sh[i].y);
        o.y = pack2(v[rr][i].z * rstd * gg[i].z * (1.f + sc[i].z) + sh[i].z, v[rr][i].w * rstd * gg[i].w * (1.f + sc[i].w) + sh[i].w);
        *(uint2*)(p.h + (size_t)(r0 + rr) * DM + c) = o;
      }
    }
  }
}

__device__ void phase_proj(const Params& p, int l, int* ctr) {
  const int MT = RG / 128, NT = INWP / 128;
  const u16* W = p.wt + (size_t)l * W_LAYER + W_IN;
  run_q8(ctr, GEMM_CNT(MT, NT), [&](int q_, int j_) {
    int mt, nt; tile_order(j_, mlo(q_ + 1, MT) - mlo(q_, MT), NT, mt, nt); mt += mlo(q_, MT);
    f32x4 acc[4][4];
    gemm_core<4>(p.h + (size_t)mt * 128 * DM, DM, W + (size_t)nt * 128 * DM, DM, DM, acc);
    EPI_VARS
    uint2 o[4][4];
#pragma unroll
    for (int wi = 0; wi < 4; ++wi)
#pragma unroll
      for (int xi = 0; xi < 4; ++xi) {
        o[wi][xi].x = pack2(acc[wi][xi][0], acc[wi][xi][1]); o[wi][xi].y = pack2(acc[wi][xi][2], acc[wi][xi][3]);
      }
    if (nt * 128 + wc_ * 64 < INW)
      store_tile_bf16<4>(o, p.proj + (size_t)(mt * 128 + wr_ * 64) * INW + nt * 128 + wc_ * 64, INW);
  });
}

__device__ void postproj_rows(const Params& p, int l, int it) {
  const int lane = TIDX & 63, wid = TIDX >> 6;
  const float* scw = p.in[15] + (size_t)l * 3 * 512;
  for (int rr = 0; rr < 4; ++rr) {
    const int r = it * 16 + wid * 4 + rr;
    int bl, pos, isctx; rowinfo(r, NBG, bl, pos, isctx);
    const u16* pr = p.proj + (size_t)r * INW;
    const int Lr = isctx ? CTXL : SEQ;
    const int c0 = lane * 8;
    const uint2 u_cq = *(const uint2*)(pr + C_CQ + lane * 4);
    const unsigned u_ckv = *(const unsigned*)(pr + C_CKV + lane * 2);
    const u16 u_kr = pr[C_KR + (lane & 31)];
    const uint4 sb = *(const uint4*)(pr + C_SB + c0);
    const uint4 sc1 = *(const uint4*)(pr + C_SC + c0);
    const uint4 sx1 = *(const uint4*)(pr + C_SX + c0);
    uint4 sc0 = make_uint4(0, 0, 0, 0), sx0 = sc0, sc2 = sc0, sx2 = sc0;
    if (pos > 0) { sc0 = *(const uint4*)(pr - INW + C_SC + c0); sx0 = *(const uint4*)(pr - INW + C_SX + c0); }
    if (pos < Lr - 1) { sc2 = *(const uint4*)(pr + INW + C_SC + c0); sx2 = *(const uint4*)(pr + INW + C_SX + c0); }
    {
      const uint2 u = u_cq;
      const float a = bflo(u.x), b = bfhi(u.x), c = bflo(u.y), d = bfhi(u.y);
      float ss = wave_sum(a * a + b * b + c * c + d * d);
      if (lane == 0) p.rstdq[r] = rsqrtf(ss * (1.f / 256.f) + EPS);
    }
    {
      const unsigned u = u_ckv;
      const float a = bflo(u), b = bfhi(u);
      float ss = wave_sum(a * a + b * b);
      if (lane == 0) p.rstdkv[r] = rsqrtf(ss * (1.f / 128.f) + EPS);
    }
    {
      const int idx = lane & 31;
      const float val = bf2f(u_kr);
      const float partner = xor_lane<8>(val);
      float o = val;
      if (!isctx) {
        const int axis = idx >> 4, half = (idx >> 3) & 1, f = idx & 7;
        const int pa = axis ? (pos & 63) : (pos >> 6);
        const float c = p.rope[(pa * 8 + f) * 2], s = p.rope[(pa * 8 + f) * 2 + 1];
        o = half ? (val * c + partner * s) : (val * c - partner * s);
      }
      const int j = isctx ? SEQ + pos : pos;
      const u16 ob = f2bf(o);
      if (lane < 32) {
#pragma unroll
        for (int hd = 0; hd < 8; ++hd)
          p.kf[((size_t)(bl * 8 + hd) * NKEY + j) * 96 + 64 + idx] = ob;
      }
    }
    {
      const float4 w0a = *(const float4*)(scw + c0), w0b = *(const float4*)(scw + c0 + 4);
      const float4 w1a = *(const float4*)(scw + 512 + c0), w1b = *(const float4*)(scw + 512 + c0 + 4);
      const float4 w2a = *(const float4*)(scw + 1024 + c0), w2b = *(const float4*)(scw + 1024 + c0 + 4);
      uint4 o;
#define UC2(SBW, A0, X0, A1, X1, A2, X2, W0L, W0H, W1L, W1H, W2L, W2H) \
      pack2(bflo(SBW) * (W0L * bflo(A0) * bflo(X0) + W1L * bflo(A1) * bflo(X1) + W2L * bflo(A2) * bflo(X2)), \
            bfhi(SBW) * (W0H * bfhi(A0) * bfhi(X0) + W1H * bfhi(A1) * bfhi(X1) + W2H * bfhi(A2) * bfhi(X2)))
      o.x = UC2(sb.x, sc0.x, sx0.x, sc1.x, sx1.x, sc2.x, sx2.x, w0a.x, w0a.y, w1a.x, w1a.y, w2a.x, w2a.y);
      o.y = UC2(sb.y, sc0.y, sx0.y, sc1.y, sx1.y, sc2.y, sx2.y, w0a.z, w0a.w, w1a.z, w1a.w, w2a.z, w2a.w);
      o.z = UC2(sb.z, sc0.z, sx0.z, sc1.z, sx1.z, sc2.z, sx2.z, w0b.x, w0b.y, w1b.x, w1b.y, w2b.x, w2b.y);
      o.w = UC2(sb.w, sc0.w, sx0.w, sc1.w, sx1.w, sc2.w, sx2.w, w0b.z, w0b.w, w1b.z, w1b.w, w2b.z, w2b.w);
#undef UC2
      *(uint4*)(p.uc + (size_t)r * 512 + c0) = o;
    }
  }
}

__device__ __forceinline__ float logsig16(float z) {
  return (fminf(z, 0.f) - __logf(1.f + __expf(-fabsf(z)))) * (1.f / 16.f);
}

__device__ void gla_prep(const Params& p, int l, int it) {
  const int tid = TIDX, lane = tid & 63, wid = tid >> 6;
  const int bl = it / (NCHUNK * 4), rem = it % (NCHUNK * 4), cidx = rem >> 2, h = rem & 3;
  const int r0 = chunk_row(bl, cidx, NBG);
  float* lr = (float*)smem;
  float* tot = (float*)(smem + 8192);
  u16* vT = (u16*)(smem + 10752);
  u16* kTf = (u16*)(smem + 29184);
  u16* kTb = (u16*)(smem + 38400);
  {
    const int t = tid >> 2, c8 = (tid & 3) * 8;
    const uint4 u = *(const uint4*)(p.proj + (size_t)(r0 + t) * INW + C_ALR + c8);
    float* d = lr + t * 32 + c8;
    d[0] = bflo(u.x); d[1] = bfhi(u.x); d[2] = bflo(u.y); d[3] = bfhi(u.y);
    d[4] = bflo(u.z); d[5] = bfhi(u.z); d[6] = bflo(u.w); d[7] = bfhi(u.w);
    const int dvc = (tid & 3) * 32;
    const u16* vp = p.proj + (size_t)(r0 + t) * INW + C_VA + h * 128 + dvc;
#pragma unroll
    for (int i = 0; i < 4; ++i) {
      const uint4 vv = *(const uint4*)(vp + i * 8);
      u16* dst = vT + (size_t)(dvc + i * 8) * 72 + t;
      dst[0] = (u16)(vv.x & 0xffff); dst[72] = (u16)(vv.x >> 16);
      dst[144] = (u16)(vv.y & 0xffff); dst[216] = (u16)(vv.y >> 16);
      dst[288] = (u16)(vv.z & 0xffff); dst[360] = (u16)(vv.z >> 16);
      dst[432] = (u16)(vv.w & 0xffff); dst[504] = (u16)(vv.w >> 16);
    }
  }
  __syncthreads();
  const int dk = lane, tg = wid;
  const float* w2f = p.in[8] + ((size_t)(l * 2 + 0) * 16) * 256 + h * 64 + dk;
  const float* w2b = p.in[8] + ((size_t)(l * 2 + 1) * 16) * 256 + h * 64 + dk;
  float wf[16], wb[16];
#pragma unroll
  for (int r = 0; r < 16; ++r) { wf[r] = w2f[r * 256]; wb[r] = w2b[r * 256]; }
  const float biasf = p.in[9][(l * 2 + 0) * 256 + h * 64 + dk];
  const float biasb = p.in[9][(l * 2 + 1) * 256 + h * 64 + dk];
  float pf[16], sbk[16];
#pragma unroll
  for (int i = 0; i < 16; ++i) {
    const float* lrow = lr + (tg * 16 + i) * 32;
    float zf = biasf, zb = biasb;
#pragma unroll
    for (int r = 0; r < 16; ++r) { zf += lrow[r] * wf[r]; zb += lrow[16 + r] * wb[r]; }
    pf[i] = logsig16(zf); sbk[i] = logsig16(zb);
  }
#pragma unroll
  for (int i = 1; i < 16; ++i) pf[i] += pf[i - 1];
#pragma unroll
  for (int i = 14; i >= 0; --i) sbk[i] += sbk[i + 1];
  tot[tg * 64 + dk] = pf[15];
  tot[256 + tg * 64 + dk] = sbk[0];
  __syncthreads();
  float offf = 0.f, offb = 0.f, bfl = 0.f, bb0 = 0.f;
#pragma unroll
  for (int g4 = 0; g4 < 4; ++g4) {
    const float a = tot[g4 * 64 + dk], b = tot[256 + g4 * 64 + dk];
    bfl += a; bb0 += b;
    if (g4 < tg) offf += a;
    if (g4 > tg) offb += b;
  }
  u16* gqf = p.gq;
  u16* gkf = p.gq + (size_t)RG * 256;
  u16* gqb = p.gq + (size_t)RG * 512;
  u16* gkb = p.gq + (size_t)RG * 768;
  unsigned kfp[8], kbp[8];
#pragma unroll
  for (int i = 0; i < 16; ++i) {
    const int t = tg * 16 + i;
    const float bfv = offf + pf[i], bbv = offb + sbk[i];
    const float qv = bf2f(p.proj[(size_t)(r0 + t) * INW + C_QA + h * 64 + dk]);
    const float kv = bf2f(p.proj[(size_t)(r0 + t) * INW + C_KA + h * 64 + dk]);
    const size_t go = (size_t)(r0 + t) * 256 + h * 64 + dk;
    gqf[go] = f2bf(qv * __expf(bfv) * 0.125f);
    gkf[go] = f2bf(kv * __expf(-bfv));
    gqb[go] = f2bf(qv * __expf(bbv) * 0.125f);
    gkb[go] = f2bf(kv * __expf(-bbv));
    const u16 ksf = f2bf(kv * __expf(bfl - bfv));
    const u16 ksb = f2bf(kv * __expf(bb0 - bbv));
    if (i & 1) { kfp[i >> 1] |= ((unsigned)ksf) << 16; kbp[i >> 1] |= ((unsigned)ksb) << 16; }
    else { kfp[i >> 1] = ksf; kbp[i >> 1] = ksb; }
  }
  *(uint4*)(kTf + dk * 72 + tg * 16) = make_uint4(kfp[0], kfp[1], kfp[2], kfp[3]);
  *(uint4*)(kTf + dk * 72 + tg * 16 + 8) = make_uint4(kfp[4], kfp[5], kfp[6], kfp[7]);
  *(uint4*)(kTb + dk * 72 + tg * 16) = make_uint4(kbp[0], kbp[1], kbp[2], kbp[3]);
  *(uint4*)(kTb + dk * 72 + tg * 16 + 8) = make_uint4(kbp[4], kbp[5], kbp[6], kbp[7]);
  const size_t cb = ((size_t)(bl * NCHUNK + cidx) * 4 + h) * 2;
  if (tg == 0) {
    p.dec[(cb + 0) * 64 + dk] = __expf(bfl);
    p.dec[(cb + 1) * 64 + dk] = __expf(bb0);
  }
  __syncthreads();
  const int l31 = lane & 31, hh = lane >> 5;
  u16* U = p.h;
#pragma unroll
  for (int dir = 0; dir < 2; ++dir) {
    const u16* kT = dir ? kTb : kTf;
#pragma unroll
    for (int dkt = 0; dkt < 2; ++dkt) {
      f32x16 acc;
#pragma unroll
      for (int e = 0; e < 16; ++e) acc[e] = 0.f;
#pragma unroll
      for (int s = 0; s < 4; ++s) {
        const bf16x8 a = *(const bf16x8*)(vT + (32 * wid + l31) * 72 + 16 * s + 8 * hh);
        const bf16x8 b = *(const bf16x8*)(kT + (32 * dkt + l31) * 72 + 16 * s + 8 * hh);
        acc = __builtin_amdgcn_mfma_f32_32x32x16_bf16(a, b, acc, 0, 0, 0);
      }
      u16* up = U + (cb + dir) * 8192;
#pragma unroll
      for (int e = 0; e < 16; ++e) {
        const int dv = 32 * wid + (e & 3) + 8 * (e >> 2) + 4 * hh;
        up[dv * 64 + 32 * dkt + l31] = f2bf(acc[e]);
      }
    }
  }
}

__device__ void phase_postproj(const Params& p, int l, int* ctr) {
  const int n_prep = NBG * NCHUNK * 4, n_rows = RG / 16;
  run_q8(ctr, QA_CNT(n_prep + n_rows), [&](int q_, int j_) {
    const int it = QA_ID(q_, j_);
    if (it < n_prep) gla_prep(p, l, it);
    else postproj_rows(p, l, it - n_prep);
  });
}

__device__ void gla_scan(const Params& p, int it) {
  const int tid = TIDX;
  const int sl = it & 7, dir = (it >> 3) & 1, h = (it >> 4) & 3, bl = it >> 6;
  const int e0 = sl * 1024 + tid * 4;
  const int dk = e0 & 63;
  const u16* U = p.h;
  f32x4 S = {0.f, 0.f, 0.f, 0.f};
  for (int s0 = 0; s0 < NCHUNK; s0 += 12) {
    uint2 u4[12]; f32x4 d4[12];
#pragma unroll
    for (int j = 0; j < 12; ++j) {
      const int step = s0 + j;
      const int cidx = dir ? (NCHUNK - 1 - step) : (step < 4 ? 128 + step : step - 4);
      const size_t base = ((size_t)(bl * NCHUNK + cidx) * 4 + h) * 2 + dir;
      u4[j] = *(const uint2*)(U + base * 8192 + e0);
      d4[j] = *(const f32x4*)(p.dec + base * 64 + dk);
    }
#pragma unroll
    for (int j = 0; j < 12; ++j) {
      const int step = s0 + j;
      const int cidx = dir ? (NCHUNK - 1 - step) : (step < 4 ? 128 + step : step - 4);
      const size_t base = ((size_t)(bl * NCHUNK + cidx) * 4 + h) * 2 + dir;
      uint2 o; o.x = pack2(S[0], S[1]); o.y = pack2(S[2], S[3]);
      *(uint2*)(p.ss + base * 8192 + e0) = o;
      S = d4[j] * S + f32x4{bflo(u4[j].x), bfhi(u4[j].x), bflo(u4[j].y), bfhi(u4[j].y)};
    }
  }
}

__device__ void q_tile(const Params& p, int l, int t) {
  const int MT = RG / 128;
  const int nt = t / MT, mt = t % MT;
  f32x4 acc[4][4];
  gemm_core<4>(p.proj + (size_t)mt * 128 * INW + C_CQ, INW, p.wt + (size_t)l * W_LAYER + W_UQ + (size_t)nt * 128 * 256, 256, 256, acc);
  EPI_VARS
  const float QS = 0.10206207261596577f * 1.4426950408889634f;
  int bl, pos0, isctx; rowinfo(mt * 128, NBG, bl, pos0, isctx);
  float rsq[4];
  uint2 qo[4][4];
#pragma unroll
  for (int xi = 0; xi < 4; ++xi) rsq[xi] = p.rstdq[mt * 128 + EPI_TR(xi)] * QS;
#pragma unroll
  for (int xi = 0; xi < 4; ++xi) {
    const int tr = EPI_TR(xi), r = mt * 128 + tr, pos = pos0 + tr;
    const float rs = rsq[xi];
#pragma unroll
    for (int wi = 0; wi < 4; ++wi) {
      const int n16 = (nt * 128 + wc_ * 64 + wi * 16) >> 4;
      const int m6 = n16 % 6;
      float v0 = acc[wi][xi][0] * rs, v1 = acc[wi][xi][1] * rs, v2 = acc[wi][xi][2] * rs, v3 = acc[wi][xi][3] * rs;
      if (m6 >= 4 && !isctx) {
        const float p0 = xor_lane<32>(v0), p1 = xor_lane<32>(v1), p2 = xor_lane<32>(v2), p3 = xor_lane<32>(v3);
        const int pa = (m6 == 5) ? (pos & 63) : (pos >> 6);
        const int f0 = (fq_ & 1) * 4;
        const float* rp = p.rope + (pa * 8 + f0) * 2;
        const float4 cs01 = *(const float4*)rp, cs23 = *(const float4*)(rp + 4);
        const float sg = (fq_ >= 2) ? 1.f : -1.f;
        v0 = v0 * cs01.x + sg * p0 * cs01.y;
        v1 = v1 * cs01.z + sg * p1 * cs01.w;
        v2 = v2 * cs23.x + sg * p2 * cs23.y;
        v3 = v3 * cs23.z + sg * p3 * cs23.w;
      }
      qo[wi][xi].x = pack2(v0, v1); qo[wi][xi].y = pack2(v2, v3);
    }
  }
  store_tile_bf16<4>(qo, p.q + (size_t)(mt * 128 + wr_ * 64) * 768 + nt * 128 + wc_ * 64, 768);
}

__device__ void kv_tile(const Params& p, int l, int t) {
  const int MT = RG / 128;
  const int nt = t / MT, mt = t % MT;
  f32x4 acc[4][4];
  gemm_core<4>(p.proj + (size_t)mt * 128 * INW + C_CKV, INW, p.wt + (size_t)l * W_LAYER + W_UKV + (size_t)nt * 128 * 128, 128, 128, acc);
  EPI_VARS
  int bl, pos0, isctx; rowinfo(mt * 128, NBG, bl, pos0, isctx);
  const int j0 = isctx ? SEQ + pos0 : pos0;
  float rskv[4];
#pragma unroll
  for (int xi = 0; xi < 4; ++xi) rskv[xi] = p.rstdkv[mt * 128 + EPI_TR(xi)];
#pragma unroll
  for (int xi = 0; xi < 4; ++xi) {
    const int tr = EPI_TR(xi), r = mt * 128 + tr, j = j0 + tr;
    const float rs = rskv[xi];
#pragma unroll
    for (int wi = 0; wi < 4; ++wi) {
      const int wn = EPI_NN(wi);
      const float v0 = acc[wi][xi][0] * rs, v1 = acc[wi][xi][1] * rs, v2 = acc[wi][xi][2] * rs, v3 = acc[wi][xi][3] * rs;
      if (wc_ == 0) {
        uint2 o; o.x = pack2(v0, v1); o.y = pack2(v2, v3);
        *(uint2*)(p.kf + ((size_t)(bl * 8 + nt) * NKEY + j) * 96 + wn) = o;
      } else {
        u16* vp = p.vt + ((size_t)(bl * 8 + nt) * 64 + (wn - 64)) * NKEY + j;
        vp[0] = f2bf(v0); vp[NKEY] = f2bf(v1); vp[2 * NKEY] = f2bf(v2); vp[3 * NKEY] = f2bf(v3);
      }
    }
  }
}

__device__ void phase_qkv(const Params& p, int l, int* ctr) {
  const int MT = RG / 128;
  const int n_scan = NBG * 64, n_q = MT * 6, n_kv = MT * 8;
  run_q8(ctr, QA_CNT(n_scan + n_q + n_kv), [&](int q_, int j_) {
    const int it = QA_ID(q_, j_);
    if (it < n_scan) gla_scan(p, it);
    else if (it < n_scan + n_q) q_tile(p, l, it - n_scan);
    else kv_tile(p, l, it - n_scan - n_q);
  });
}

__device__ __forceinline__ bf16x8 pack8(const f32x16& a, int o) {
  union { bf16x8 v; unsigned u[4]; } r;
  r.u[0] = pack2(a[o + 0], a[o + 1]); r.u[1] = pack2(a[o + 2], a[o + 3]);
  r.u[2] = pack2(a[o + 4], a[o + 5]); r.u[3] = pack2(a[o + 6], a[o + 7]);
  return r.v;
}
__device__ __forceinline__ bf16x8 ld2x8(const u16* p0) {
  union { bf16x8 v; uint2 u[2]; } r;
  r.u[0] = *(const uint2*)p0; r.u[1] = *(const uint2*)(p0 + 8);
  return r.v;
}

__device__ void attn_item(const Params& p, int it) {
  const int tid = TIDX, lane = tid & 63, wid = tid >> 6, l31 = lane & 31, hh = lane >> 5;
  const int qb = it % 66, bh = it / 66, h = bh & 7, bl = bh >> 3;
  const int r0 = qb < 64 ? bl * SEQ + qb * 128 : NBG * SEQ + bl * CTXL + (qb - 64) * 128;
  const int kt0 = qb < 64 ? 0 : 128;
  const int nkt = NCHUNK - kt0;
  constexpr int KROW = 208, VROW = 144, BUFB = 64 * KROW + 64 * VROW;
  bf16x8 qf[6];
  {
    const u16* qp = p.q + (size_t)(r0 + 32 * wid + l31) * 768 + h * 96 + 8 * hh;
#pragma unroll
    for (int s = 0; s < 6; ++s) qf[s] = *(const bf16x8*)(qp + 16 * s);
  }
  const u16* kbase = p.kf + (size_t)bh * NKEY * 96;
  const u16* vbase = p.vt + (size_t)bh * 64 * NKEY;
  uint4 kr0, kr1, kr2, vr0, vr1;
  const int kdst0 = (tid / 12) * KROW + (tid % 12) * 16;
  const int kdst1 = ((tid + 256) / 12) * KROW + ((tid + 256) % 12) * 16;
  const int kdst2 = ((tid + 512) / 12) * KROW + ((tid + 512) % 12) * 16;
  const int vdst0 = 64 * KROW + (tid >> 3) * VROW + (tid & 7) * 16;
  const int vdst1 = vdst0 + 32 * VROW;
  const int vsrc0 = (tid >> 3) * NKEY + (tid & 7) * 8;
  const int vsrc1 = vsrc0 + 32 * NKEY;
  {
    const u16* kp = kbase + (size_t)kt0 * 64 * 96 + tid * 8;
    kr0 = *(const uint4*)(kp); kr1 = *(const uint4*)(kp + 2048); kr2 = *(const uint4*)(kp + 4096);
    vr0 = *(const uint4*)(vbase + vsrc0 + kt0 * 64); vr1 = *(const uint4*)(vbase + vsrc1 + kt0 * 64);
    *(uint4*)(smem + kdst0) = kr0; *(uint4*)(smem + kdst1) = kr1; *(uint4*)(smem + kdst2) = kr2;
    *(uint4*)(smem + vdst0) = vr0; *(uint4*)(smem + vdst1) = vr1;
  }
  __builtin_amdgcn_s_waitcnt(0x0F70);
  __syncthreads();
  f32x16 oacc[2];
#pragma unroll
  for (int e = 0; e < 16; ++e) { oacc[0][e] = 0.f; oacc[1][e] = 0.f; }
  float m_run = 0.f, l_run = 0.f;
  for (int t = 0; t < nkt; ++t) {
    const int cur = t & 1;
    {
      const int tn = kt0 + min(t + 1, nkt - 1);
      const u16* kp = kbase + (size_t)tn * 64 * 96 + tid * 8;
      kr0 = *(const uint4*)(kp); kr1 = *(const uint4*)(kp + 2048); kr2 = *(const uint4*)(kp + 4096);
      vr0 = *(const uint4*)(vbase + vsrc0 + tn * 64); vr1 = *(const uint4*)(vbase + vsrc1 + tn * 64);
    }
    __builtin_amdgcn_sched_barrier(0);
    const char* Kl = smem + cur * BUFB;
    const char* Vl = Kl + 64 * KROW;
    f32x16 sacc[2];
#pragma unroll
    for (int kb = 0; kb < 2; ++kb) {
#pragma unroll
      for (int e = 0; e < 16; ++e) sacc[kb][e] = -m_run;
#pragma unroll
      for (int s = 0; s < 6; ++s) {
        const bf16x8 a = *(const bf16x8*)(Kl + (32 * kb + l31) * KROW + 32 * s + 16 * hh);
        sacc[kb] = __builtin_amdgcn_mfma_f32_32x32x16_bf16(a, qf[s], sacc[kb], 0, 0, 0);
      }
    }
    float mx = sacc[0][0];
#pragma unroll
    for (int e = 1; e < 16; ++e) mx = fmaxf(mx, sacc[0][e]);
#pragma unroll
    for (int e = 0; e < 16; ++e) mx = fmaxf(mx, sacc[1][e]);
    {
      const unsigned mu = __float_as_uint(mx);
      const auto sw = __builtin_amdgcn_permlane32_swap(mu, mu, false, false);
      mx = fmaxf(__uint_as_float(sw[0]), __uint_as_float(sw[1]));
    }
    if (t == 0 || !__all(mx <= 8.f)) {
      const float d = (t == 0) ? mx : fmaxf(mx, 0.f);
      const float alpha = __builtin_amdgcn_exp2f(-d);
      m_run += d;
      l_run *= alpha;
#pragma unroll
      for (int e = 0; e < 16; ++e) { oacc[0][e] *= alpha; oacc[1][e] *= alpha; sacc[0][e] -= d; sacc[1][e] -= d; }
    }
    float ps = 0.f;
#pragma unroll
    for (int kb = 0; kb < 2; ++kb)
#pragma unroll
      for (int e = 0; e < 16; ++e) { const float pv = __builtin_amdgcn_exp2f(sacc[kb][e]); sacc[kb][e] = pv; ps += pv; }
    l_run += ps;
#pragma unroll
    for (int kb = 0; kb < 2; ++kb)
#pragma unroll
      for (int s2 = 0; s2 < 2; ++s2) {
        const bf16x8 pfr = pack8(sacc[kb], 8 * s2);
#pragma unroll
        for (int dt = 0; dt < 2; ++dt) {
          const bf16x8 a = ld2x8((const u16*)(Vl + (32 * dt + l31) * VROW) + 32 * kb + 16 * s2 + 4 * hh);
          oacc[dt] = __builtin_amdgcn_mfma_f32_32x32x16_bf16(a, pfr, oacc[dt], 0, 0, 0);
        }
      }
    __builtin_amdgcn_sched_barrier(0);
    {
      char* nb = smem + (cur ^ 1) * BUFB;
      *(uint4*)(nb + kdst0) = kr0; *(uint4*)(nb + kdst1) = kr1; *(uint4*)(nb + kdst2) = kr2;
      *(uint4*)(nb + vdst0) = vr0; *(uint4*)(nb + vdst1) = vr1;
    }
    __syncthreads();
  }
  l_run += xor_lane<32>(l_run);
  const float inv = 1.f / l_run;
  u16* op = p.h + (size_t)RG * 512 + (size_t)(r0 + 32 * wid + l31) * 512 + h * 64;
#pragma unroll
  for (int dt = 0; dt < 2; ++dt)
#pragma unroll
    for (int gq_ = 0; gq_ < 4; ++gq_) {
      const int dv0 = 32 * dt + 8 * gq_ + 4 * hh;
      uint2 o;
      o.x = pack2(oacc[dt][4 * gq_ + 0] * inv, oacc[dt][4 * gq_ + 1] * inv);
      o.y = pack2(oacc[dt][4 * gq_ + 2] * inv, oacc[dt][4 * gq_ + 3] * inv);
      *(uint2*)(op + dv0) = o;
    }
}

__device__ void gla_out(const Params& p, int l, int it) {
  const int tid = TIDX, lane = tid & 63, wid = tid >> 6, l31 = lane & 31, hh = lane >> 5;
  const int bl = it / (NCHUNK * 4), rem = it % (NCHUNK * 4), cidx = rem >> 2, h = rem & 3;
  const int r0 = chunk_row(bl, cidx, NBG);
  u16* tiles = (u16*)smem;
  u16* vT = (u16*)(smem + 36864);
  float* part = (float*)(smem + 55296);
  {
    const int t = tid >> 2, c16 = (tid & 3) * 16;
#pragma unroll
    for (int a = 0; a < 4; ++a) {
      const u16* src = p.gq + (size_t)a * RG * 256 + (size_t)(r0 + t) * 256 + h * 64 + c16;
      const uint4 u0 = *(const uint4*)src, u1 = *(const uint4*)(src + 8);
      u16* d = tiles + a * 4608 + t * 72 + c16;
      *(uint4*)d = u0; *(uint4*)(d + 8) = u1;
    }
    const int dvc = (tid & 3) * 32;
    const u16* vp = p.proj + (size_t)(r0 + t) * INW + C_VA + h * 128 + dvc;
#pragma unroll
    for (int i = 0; i < 4; ++i) {
      const uint4 vv = *(const uint4*)(vp + i * 8);
      u16* dst = vT + (size_t)(dvc + i * 8) * 72 + t;
      dst[0] = (u16)(vv.x & 0xffff); dst[72] = (u16)(vv.x >> 16);
      dst[144] = (u16)(vv.y & 0xffff); dst[216] = (u16)(vv.y >> 16);
      dst[288] = (u16)(vv.z & 0xffff); dst[360] = (u16)(vv.z >> 16);
      dst[432] = (u16)(vv.w & 0xffff); dst[504] = (u16)(vv.w >> 16);
    }
  }
  const int itl = wid & 1, dvh = wid >> 1;
  const size_t cb = ((size_t)(bl * NCHUNK + cidx) * 4 + h) * 2;
  bf16x8 sfr[2][2][4];
#pragma unroll
  for (int dir = 0; dir < 2; ++dir)
#pragma unroll
    for (int dt = 0; dt < 2; ++dt)
#pragma unroll
      for (int s4 = 0; s4 < 4; ++s4)
        sfr[dir][dt][s4] = *(const bf16x8*)(p.ss + (cb + dir) * 8192 + (64 * dvh + 32 * dt + l31) * 64 + 16 * s4 + 8 * hh);
  __syncthreads();
  f32x16 oacc[2];
#pragma unroll
  for (int e = 0; e < 16; ++e) { oacc[0][e] = 0.f; oacc[1][e] = 0.f; }
#pragma unroll
  for (int dir = 0; dir < 2; ++dir) {
    const u16* Qt = tiles + (dir * 2) * 4608;
    const u16* Kt = tiles + (dir * 2 + 1) * 4608;
    bf16x8 qfr[4];
#pragma unroll
    for (int s = 0; s < 4; ++s) qfr[s] = *(const bf16x8*)(Qt + (32 * itl + l31) * 72 + 16 * s + 8 * hh);
    f32x16 aacc[2];
#pragma unroll
    for (int jt = 0; jt < 2; ++jt) {
#pragma unroll
      for (int e = 0; e < 16; ++e) aacc[jt][e] = 0.f;
#pragma unroll
      for (int s = 0; s < 4; ++s) {
        const bf16x8 a = *(const bf16x8*)(Kt + (32 * jt + l31) * 72 + 16 * s + 8 * hh);
        aacc[jt] = __builtin_amdgcn_mfma_f32_32x32x16_bf16(a, qfr[s], aacc[jt], 0, 0, 0);
      }
      const int i_tok = 32 * itl + l31;
#pragma unroll
      for (int e = 0; e < 16; ++e) {
        const int j_tok = 32 * jt + (e & 3) + 8 * (e >> 2) + 4 * hh;
        const bool keep = dir ? (j_tok >= i_tok) : (j_tok <= i_tok);
        if (!keep) aacc[jt][e] = 0.f;
      }
    }
#pragma unroll
    for (int dt = 0; dt < 2; ++dt) {
      const int dvrow = 64 * dvh + 32 * dt + l31;
#pragma unroll
      for (int jt = 0; jt < 2; ++jt)
#pragma unroll
        for (int s2 = 0; s2 < 2; ++s2) {
          const bf16x8 pfr = pack8(aacc[jt], 8 * s2);
          const bf16x8 a = ld2x8(vT + dvrow * 72 + 32 * jt + 16 * s2 + 4 * hh);
          oacc[dt] = __builtin_amdgcn_mfma_f32_32x32x16_bf16(a, pfr, oacc[dt], 0, 0, 0);
        }
#pragma unroll
      for (int s = 0; s < 4; ++s) {
        oacc[dt] = __builtin_amdgcn_mfma_f32_32x32x16_bf16(sfr[dir][dt][s], qfr[s], oacc[dt], 0, 0, 0);
      }
    }
  }
  float ss = 0.f;
#pragma unroll
  for (int e = 0; e < 16; ++e) ss += oacc[0][e] * oacc[0][e] + oacc[1][e] * oacc[1][e];
  ss += xor_lane<32>(ss);
  if (hh == 0) part[wid * 32 + l31] = ss;
  __syncthreads();
  const float totss = part[wid * 32 + l31] + part[(wid ^ 2) * 32 + l31];
  const float rstd = rsqrtf(totss * (1.f / 128.f) + EPS);
  const int r = r0 + 32 * itl + l31;
  const float* gam = p.in[10] + l * 512 + h * 128;
  u16* aa = p.h;
#pragma unroll
  for (int dt = 0; dt < 2; ++dt)
#pragma unroll
    for (int gq_ = 0; gq_ < 4; ++gq_) {
      const int dv0 = 64 * dvh + 32 * dt + 8 * gq_ + 4 * hh;
      const uint2 ra = *(const uint2*)(p.proj + (size_t)r * INW + C_RA + h * 128 + dv0);
      const float4 g4 = *(const float4*)(gam + dv0);
      uint2 o;
      o.x = pack2(oacc[dt][4 * gq_ + 0] * rstd * g4.x * silu_f(bflo(ra.x)), oacc[dt][4 * gq_ + 1] * rstd * g4.y * silu_f(bfhi(ra.x)));
      o.y = pack2(oacc[dt][4 * gq_ + 2] * rstd * g4.z * silu_f(bflo(ra.y)), oacc[dt][4 * gq_ + 3] * rstd * g4.w * silu_f(bfhi(ra.y)));
      *(uint2*)(aa + (size_t)r * 512 + h * 128 + dv0) = o;
    }
}

__device__ void phase_attn(const Params& p, int l, int* ctr) {
  const int nqb = (l == 1) ? 64 : 66, nck = (l == 1) ? 128 : NCHUNK;
  const int per_q = NBG * nqb;
  const int n_gla = NBG * nck * 4;
  run_q8(ctr, [=](int q_) { return per_q + ((n_gla - q_ + 7) >> 3); }, [&](int q_, int j_) {
    if (j_ < per_q) attn_item(p, ((j_ / nqb) * 8 + q_) * 66 + (j_ % nqb));
    else {
      const int gi = QA_ID(q_, j_ - per_q);
      gla_out(p, l, (gi / (nck * 4)) * (NCHUNK * 4) + gi % (nck * 4));
    }
  });
}

__device__ void phase_merge(const Params& p, int l, int* ctr) {
  const int MT = (l == 1 ? NBG * SEQ / 128 : RG / 128), NT = 16;
  const u16* wl = p.wt + (size_t)l * W_LAYER;
  run_q8(ctr, GEMM_CNT(MT, NT), [&](int q_, int j_) {
    int mt, nt; tile_order(j_, mlo(q_ + 1, MT) - mlo(q_, MT), NT, mt, nt); mt += mlo(q_, MT);
    const int tid = TIDX, lane = tid & 63, wid = tid >> 6;
    const int wr = wid >> 1, wc = wid & 1, fr = lane & 15, fq = lane >> 4;
    f32x4 macc[2][4], acc[2][4];
#pragma unroll
    for (int a = 0; a < 2; ++a)
#pragma unroll
      for (int b = 0; b < 4; ++b) { macc[a][b] = f32x4{0.f, 0.f, 0.f, 0.f}; acc[a][b] = f32x4{0.f, 0.f, 0.f, 0.f}; }
    const int srow = tid >> 3, schunk = (tid & 7) ^ ((tid >> 4) & 7);
    const size_t xo = (size_t)(mt * 128 + srow) * 512 + schunk * 8;
    const size_t wo = (size_t)(nt * 64 + srow) * 512 + schunk * 8;
    const u16* xg0 = p.h + xo;
    const u16* xg1 = p.h + (size_t)RG * 512 + xo;
    const u16* xg2 = p.uc + xo;
    const u16* wg0 = wl + W_BRA + wo;
    const u16* wg1 = wl + W_BRB + wo;
    const u16* wg2 = wl + W_BRC + wo;
    const int g = fr >> 1;
    const int lo0 = fr * 128 + ((fq ^ g) << 4), lo1 = fr * 128 + (((fq ^ g) ^ 4) << 4);
    const char* xb = smem + wr * 8192;
    const char* wb = smem + 16384 + wc * 4096;
    char* sdst = smem + tid * 16;
    const u16* gbase = p.proj + (size_t)(mt * 128 + wr * 64 + fr) * INW + C_GATE + nt * 64 + wc * 32 + fq * 4;
    uint2 gts[2][4];
#pragma unroll
    for (int wi = 0; wi < 2; ++wi)
#pragma unroll
      for (int xi = 0; xi < 4; ++xi) gts[wi][xi] = *(const uint2*)(gbase + (size_t)xi * 16 * INW + wi * 16);
    __syncthreads();
#pragma unroll
    for (int i = 0; i < 4; ++i) {
      glds16(xg0 + i * (32 * 512), sdst + i * 4096);
      if (i < 2) glds16(wg0 + i * (32 * 512), sdst + 16384 + i * 4096);
    }
    for (int kt = 0; kt < 24; ++kt) {
      asm volatile("s_waitcnt vmcnt(0)" ::: "memory");
      __syncthreads();
      const int cb = (kt & 1) * 32768;
      if (kt + 1 < 24) {
        const int nbr = (kt + 1) >> 3, ko = ((kt + 1) & 7) * 64, nb = 32768 - cb;
        const u16* xg = (nbr == 0 ? xg0 : nbr == 1 ? xg1 : xg2) + ko;
        const u16* wg = (nbr == 0 ? wg0 : nbr == 1 ? wg1 : wg2) + ko;
#pragma unroll
        for (int i = 0; i < 4; ++i) {
          glds16(xg + i * (32 * 512), sdst + nb + i * 4096);
          if (i < 2) glds16(wg + i * (32 * 512), sdst + nb + 16384 + i * 4096);
        }
      }
      bf16x8 wf[2][2], xf[2][4];
#pragma unroll
      for (int i = 0; i < 2; ++i) {
        wf[0][i] = *(const bf16x8*)(wb + cb + i * 2048 + lo0);
        wf[1][i] = *(const bf16x8*)(wb + cb + i * 2048 + lo1);
      }
#pragma unroll
      for (int i = 0; i < 4; ++i) {
        xf[0][i] = *(const bf16x8*)(xb + cb + i * 2048 + lo0);
        xf[1][i] = *(const bf16x8*)(xb + cb + i * 2048 + lo1);
      }
      __builtin_amdgcn_sched_barrier(0);
#pragma unroll
      for (int k = 0; k < 2; ++k)
#pragma unroll
        for (int wi = 0; wi < 2; ++wi)
#pragma unroll
          for (int xi = 0; xi < 4; ++xi)
            acc[wi][xi] = __builtin_amdgcn_mfma_f32_16x16x32_bf16(wf[k][wi], xf[k][xi], acc[wi][xi], 0, 0, 0);
      __builtin_amdgcn_sched_barrier(0);
      if ((kt & 7) == 7) {
        const int br = kt >> 3;
#pragma unroll
        for (int wi = 0; wi < 2; ++wi)
#pragma unroll
          for (int xi = 0; xi < 4; ++xi) {
            const uint2 gt = gts[wi][xi];
            macc[wi][xi][0] += sigmoid_f(bflo(gt.x)) * acc[wi][xi][0];
            macc[wi][xi][1] += sigmoid_f(bfhi(gt.x)) * acc[wi][xi][1];
            macc[wi][xi][2] += sigmoid_f(bflo(gt.y)) * acc[wi][xi][2];
            macc[wi][xi][3] += sigmoid_f(bfhi(gt.y)) * acc[wi][xi][3];
            acc[wi][xi] = f32x4{0.f, 0.f, 0.f, 0.f};
            if (br < 2) gts[wi][xi] = *(const uint2*)(gbase + (size_t)xi * 16 * INW + wi * 16 + (br + 1) * 1024);
          }
      }
    }
    uint2 o[2][4];
#pragma unroll
    for (int wi = 0; wi < 2; ++wi)
#pragma unroll
      for (int xi = 0; xi < 4; ++xi) {
        o[wi][xi].x = pack2(macc[wi][xi][0], macc[wi][xi][1]); o[wi][xi].y = pack2(macc[wi][xi][2], macc[wi][xi][3]);
      }
    store_tile_bf16<2>(o, p.m + (size_t)(mt * 128 + wr * 64) * DM + nt * 64 + wc * 32, DM);
  });
}

__device__ void phase_resid(const Params& p, int l, int g, int which, int* ctr) {
  const int MT = (l == 1 ? NBG * SEQ / 128 : RG / 128), NT = 8;
  const u16* wl = p.wt + (size_t)l * W_LAYER;
  const u16* X = which == 0 ? p.m : p.proj + (size_t)RG * DFF;
  const int ldx = which == 0 ? DM : DFF, K = which == 0 ? DM : DFF;
  const u16* W = wl + (which == 0 ? W_O : W_DN);
  const int goff = which == 0 ? 2048 : 5120;
  const int from_input = (which == 0 && l == 0);
  run_q8(ctr, GEMM_CNT(MT, NT), [&](int q_, int j_) {
    int mt, nt; tile_order(j_, mlo(q_ + 1, MT) - mlo(q_, MT), NT, mt, nt); mt += mlo(q_, MT);
    f32x4 acc[4][4];
    gemm_core<4>(X + (size_t)mt * 128 * ldx, ldx, W + (size_t)nt * 128 * K, K, K, acc);
    EPI_VARS
    const float* mrow = p.mod + ((size_t)l * 9 + mod_index(p, g, mt * 128)) * 6144 + goff + nt * 128 + wc_ * 64;
    __syncthreads();
    char* lb = smem + wid_ * 16384;
#pragma unroll
    for (int wi = 0; wi < 4; ++wi)
#pragma unroll
      for (int xi = 0; xi < 4; ++xi) {
        const int r = xi * 16 + fr_, c = wi * 4 + fq_;
        *(f32x4*)(lb + r * 256 + ((c ^ (r & 15)) << 4)) = acc[wi][xi];
      }
    const int c16 = lane_ & 15, rsub = lane_ >> 4;
    const float* xs = xsrc_row_ptr(p, g, mt * 128 + wr_ * 64, from_input) + nt * 128 + wc_ * 64 + c16 * 4;
    float* xd = xrow_ptr(p, g, mt * 128 + wr_ * 64) + nt * 128 + wc_ * 64 + c16 * 4;
    const float4 gv = *(const float4*)(mrow + c16 * 4);
#pragma unroll
    for (int half = 0; half < 2; ++half) {
      float4 xv[8];
#pragma unroll
      for (int it = 0; it < 8; ++it) xv[it] = *(const float4*)(xs + (size_t)((half * 8 + it) * 4 + rsub) * DM);
#pragma unroll
      for (int it = 0; it < 8; ++it) {
        const int row = (half * 8 + it) * 4 + rsub;
        const f32x4 a = *(const f32x4*)(lb + row * 256 + ((c16 ^ (row & 15)) << 4));
        float4 o;
        o.x = xv[it].x + gv.x * a[0]; o.y = xv[it].y + gv.y * a[1]; o.z = xv[it].z + gv.z * a[2]; o.w = xv[it].w + gv.w * a[3];
        *(float4*)(xd + (size_t)row * DM) = o;
      }
    }
  });
}

__device__ void phase_gu(const Params& p, int l, int* ctr) {
  const int MT = (l == 1 ? NBG * SEQ / 128 : RG / 128), NT = 44;
  const u16* W = p.wt + (size_t)l * W_LAYER + W_GU;
  run_q8(ctr, GEMM_CNT(MT, NT), [&](int q_, int j_) {
    int mt, nt; tile_order(j_, mlo(q_ + 1, MT) - mlo(q_, MT), NT, mt, nt); mt += mlo(q_, MT);
    f32x4 acc[4][4];
    gemm_core<4>(p.h + (size_t)mt * 128 * DM, DM, W + (size_t)nt * 128 * DM, DM, DM, acc);
    EPI_VARS
    u16* dst = p.proj + (nt >= 22 ? (size_t)RG * DFF : 0);
    const int nb = (nt >= 22 ? nt - 22 : nt) * 128;
    uint2 o[4][4];
#pragma unroll
    for (int wi = 0; wi < 4; ++wi)
#pragma unroll
      for (int xi = 0; xi < 4; ++xi) {
        o[wi][xi].x = pack2(acc[wi][xi][0], acc[wi][xi][1]); o[wi][xi].y = pack2(acc[wi][xi][2], acc[wi][xi][3]);
      }
    store_tile_bf16<4>(o, dst + (size_t)(mt * 128 + wr_ * 64) * DFF + nb + wc_ * 64, DFF);
  });
}

struct ActIn { uint4 g0, g1, g2, uu; float4 w0a, w0b, w1a, w1b, w2a, w2b, ba, bb; };
__device__ __forceinline__ void act_load(ActIn& a, const u16* G, const u16* UP, const float* cw, const float* cb, int r, int c0) {
  int bl, pos, isctx; rowinfo(r, NBG, bl, pos, isctx);
  const int L = isctx ? CTXL : SEQ;
  const u16* gp = G + (size_t)r * DFF + c0;
  a.g1 = *(const uint4*)gp;
  a.g0 = make_uint4(0, 0, 0, 0); a.g2 = a.g0;
  if (pos > 0) a.g0 = *(const uint4*)(gp - DFF);
  if (pos < L - 1) a.g2 = *(const uint4*)(gp + DFF);
  a.uu = *(const uint4*)(UP + (size_t)r * DFF + c0);
  a.w0a = *(const float4*)(cw + c0); a.w0b = *(const float4*)(cw + c0 + 4);
  a.w1a = *(const float4*)(cw + DFF + c0); a.w1b = *(const float4*)(cw + DFF + c0 + 4);
  a.w2a = *(const float4*)(cw + 2 * DFF + c0); a.w2b = *(const float4*)(cw + 2 * DFF + c0 + 4);
  a.ba = *(const float4*)(cb + c0); a.bb = *(const float4*)(cb + c0 + 4);
}
__device__ __forceinline__ uint4 act_compute(const ActIn& a) {
  uint4 o;
#define ACT2(G0, G1, G2, UU, W0L, W0H, W1L, W1H, W2L, W2H, BL, BH) \
  pack2(silu_f(W0L * bflo(G0) + W1L * bflo(G1) + W2L * bflo(G2) + BL) * bflo(UU), \
        silu_f(W0H * bfhi(G0) + W1H * bfhi(G1) + W2H * bfhi(G2) + BH) * bfhi(UU))
  o.x = ACT2(a.g0.x, a.g1.x, a.g2.x, a.uu.x, a.w0a.x, a.w0a.y, a.w1a.x, a.w1a.y, a.w2a.x, a.w2a.y, a.ba.x, a.ba.y);
  o.y = ACT2(a.g0.y, a.g1.y, a.g2.y, a.uu.y, a.w0a.z, a.w0a.w, a.w1a.z, a.w1a.w, a.w2a.z, a.w2a.w, a.ba.z, a.ba.w);
  o.z = ACT2(a.g0.z, a.g1.z, a.g2.z, a.uu.z, a.w0b.x, a.w0b.y, a.w1b.x, a.w1b.y, a.w2b.x, a.w2b.y, a.bb.x, a.bb.y);
  o.w = ACT2(a.g0.w, a.g1.w, a.g2.w, a.uu.w, a.w0b.z, a.w0b.w, a.w1b.z, a.w1b.w, a.w2b.z, a.w2b.w, a.bb.z, a.bb.w);
#undef ACT2
  return o;
}

__device__ void phase_act(const Params& p, int l, int* ctr) {
  const int nitems = (l == 1) ? NBG * SEQ / 8 : RG / 8;
  const float* cw = p.in[23] + (size_t)l * 3 * DFF;
  const float* cb = p.in[24] + (size_t)l * DFF;
  const u16* G = p.proj;
  u16* UP = p.proj + (size_t)RG * DFF;
  for (int it = blockIdx.x; it < nitems; it += gridDim.x) {
    const int tid = TIDX;
    for (int k = 0; k < 12; k += 2) {
      const int e0 = tid + k * 256, e1 = e0 + 256;
      const bool two = (k + 1 < 11);
      const int r0 = it * 8 + e0 / 352, c00 = (e0 % 352) * 8;
      const int r1 = it * 8 + (two ? e1 / 352 : 0), c01 = two ? (e1 % 352) * 8 : 0;
      ActIn a0, a1;
      act_load(a0, G, UP, cw, cb, r0, c00);
      act_load(a1, G, UP, cw, cb, r1, c01);
      const uint4 o0 = act_compute(a0), o1 = act_compute(a1);
      *(uint4*)(UP + (size_t)r0 * DFF + c00) = o0;
      if (two) *(uint4*)(UP + (size_t)r1 * DFF + c01) = o1;
    }
  }
}

__device__ void phase_final(const Params& p, int* ctr) {
  const int nitems = NBATCH * SEQ / 16;
  const float* gam = p.in[26];
  for (int it = blockIdx.x; it < nitems; it += gridDim.x) {
    const int lane = TIDX & 63, wid = TIDX >> 6;
    float* xr = p.out + ((size_t)it * 16 + wid * 4) * DM;
    float4 v[4][4], gg[4];
#pragma unroll
    for (int rr = 0; rr < 4; ++rr)
#pragma unroll
      for (int i = 0; i < 4; ++i) v[rr][i] = *(const float4*)(xr + (size_t)rr * DM + lane * 4 + i * 256);
#pragma unroll
    for (int i = 0; i < 4; ++i) gg[i] = *(const float4*)(gam + lane * 4 + i * 256);
#pragma unroll
    for (int rr = 0; rr < 4; ++rr) {
      float ss = 0.f;
#pragma unroll
      for (int i = 0; i < 4; ++i)
        ss += v[rr][i].x * v[rr][i].x + v[rr][i].y * v[rr][i].y + v[rr][i].z * v[rr][i].z + v[rr][i].w * v[rr][i].w;
      ss = wave_sum(ss);
      const float rstd = rsqrtf(ss * (1.f / 1024.f) + EPS);
#pragma unroll
      for (int i = 0; i < 4; ++i) {
        float4 o; o.x = v[rr][i].x * rstd * gg[i].x; o.y = v[rr][i].y * rstd * gg[i].y; o.z = v[rr][i].z * rstd * gg[i].z; o.w = v[rr][i].w * rstd * gg[i].w;
        *(float4*)(xr + (size_t)rr * DM + lane * 4 + i * 256) = o;
      }
    }
  }
}

#define XB_TMO      128
#define XB_XCNT(j)  (256  + 64 * (j))
#define XB_XSUB(j)  (1280 + 64 * (j))
#define XB_XGEN(j)  (2304 + 64 * (j))
#define XB_TOP      3328
#define XB_TOPGEN   3392
#define XCD_BAR_WORDS 3456
#define XB_SPIN_CAP (1u << 22)
#define LAS __attribute__((address_space(3)))
__device__ __forceinline__ unsigned xb_ld(unsigned* p)              { return __hip_atomic_load(p, __ATOMIC_RELAXED, __HIP_MEMORY_SCOPE_AGENT); }
__device__ __forceinline__ unsigned xb_add(unsigned* p, unsigned v) { return __hip_atomic_fetch_add(p, v, __ATOMIC_RELAXED, __HIP_MEMORY_SCOPE_AGENT); }
__device__ __forceinline__ unsigned xb_xcc_id() { return (unsigned)__builtin_amdgcn_s_getreg((3 << 11) | 20) & 0xFu; }
#define XB_SPIN(cond, bar) do { unsigned _sp = 0; while (cond) { __builtin_amdgcn_s_sleep(1); \
    if ((++_sp & 255u) == 0u) { if (xb_ld(&(bar)[XB_TMO])) break; if (_sp > XB_SPIN_CAP) { atomicAdd(&(bar)[XB_TMO], 1u); break; } } } } while (0)
struct XcdBarrier { unsigned* bar; unsigned x; volatile LAS unsigned* st; };
__device__ __forceinline__ XcdBarrier xcd_barrier_post(unsigned* bar, volatile LAS unsigned* st) {
  XcdBarrier b; b.bar = bar; b.x = xb_xcc_id(); b.st = st;
  if (threadIdx.x == 0) (void)xb_add(&bar[XB_XCNT(b.x)], 1u);
  return b;
}
__device__ __forceinline__ void xcd_barrier_complete(unsigned* bar, unsigned x, unsigned& nloc, unsigned& nx) {
  const unsigned G = gridDim.x * gridDim.y * gridDim.z;
  unsigned sum, cnt, mine, sp = 0u;
  for (;;) {
    sum = 0u; cnt = 0u; mine = 0u;
#pragma unroll
    for (unsigned j = 0; j < 16; ++j) { const unsigned c = xb_ld(&bar[XB_XCNT(j)]); sum += c; cnt += (c > 0u) ? 1u : 0u; mine = (j == x) ? c : mine; }
    if (sum == G) break;
    __builtin_amdgcn_s_sleep(1);
    if ((++sp & 255u) == 0u) { if (xb_ld(&bar[XB_TMO])) break; if (sp > XB_SPIN_CAP) { atomicAdd(&bar[XB_TMO], 1u); break; } }
  }
  nloc = mine > 0u ? mine : 1u; nx = cnt > 0u ? cnt : 1u;
}
__device__ __forceinline__ void xcd_barrier(const XcdBarrier& b) {
  asm volatile("s_waitcnt vmcnt(0)" ::: "memory");
  __syncthreads();
  if (threadIdx.x == 0) {
    unsigned* bar = b.bar;
    __builtin_amdgcn_s_waitcnt(0);
    unsigned nloc = b.st[0], nx = b.st[1];
    if (nloc == 0u) { xcd_barrier_complete(bar, b.x, nloc, nx); b.st[0] = nloc; b.st[1] = nx; }
    const unsigned old = xb_add(&bar[XB_XSUB(b.x)], 1u);
    const unsigned gen = old / nloc;
    if (old + 1u == (gen + 1u) * nloc) {
      __builtin_amdgcn_fence(__ATOMIC_RELEASE, "agent");
      asm volatile("s_waitcnt vmcnt(0)" ::: "memory");
      const unsigned og = xb_add(&bar[XB_TOP], 1u);
      const unsigned tg = og / nx;
      if (og + 1u == (tg + 1u) * nx) xb_add(&bar[XB_TOPGEN], 1u);
      else XB_SPIN(xb_ld(&bar[XB_TOPGEN]) == tg, bar);
      __builtin_amdgcn_fence(__ATOMIC_ACQUIRE, "agent");
      xb_add(&bar[XB_XGEN(b.x)], 1u);
      asm volatile("s_waitcnt vmcnt(0)" ::: "memory");
    } else {
      XB_SPIN(xb_ld(&bar[XB_XGEN(b.x)]) == gen, bar);
      __builtin_amdgcn_fence(__ATOMIC_ACQUIRE, "agent");
      asm volatile("s_waitcnt vmcnt(0)" ::: "memory");
    }
  }
  __syncthreads();
}

__device__ void run_phase(const Params& p, int ph, int* ctr) {
  if (ph == 0) { phase0(p, ctr); return; }
  if (ph == NPHASES - 1) { phase_final(p, ctr); return; }
  const int idx = ph - 1, lg = idx / NPH_PER, sub = idx % NPH_PER;
  const int l = lg / NGRP, g = lg % NGRP;
  switch (sub) {
    case 0: phase_norm(p, l, g, 0, ctr); break;
    case 1: phase_proj(p, l, ctr); break;
    case 2: phase_postproj(p, l, ctr); break;
    case 3: phase_qkv(p, l, ctr); break;
    case 4: phase_attn(p, l, ctr); break;
    case 5: phase_merge(p, l, ctr); break;
    case 6: phase_resid(p, l, g, 0, ctr); break;
    case 7: phase_norm(p, l, g, 1, ctr); break;
    case 8: phase_gu(p, l, ctr); break;
    case 9: phase_act(p, l, ctr); break;
    default: phase_resid(p, l, g, 1, ctr); break;
  }
}

__global__ void __launch_bounds__(256, 2) mega_kernel(KArgs ka, int ph_lo, int ph_hi, int coop) {
  Params p;
#pragma unroll
  for (int i = 0; i < 27; ++i) p.in[i] = ka.in[i];
  p.out = ka.out;
  char* ws = ka.ws;
  p.ctr = (int*)(ws + O_CTR); p.mod = (float*)(ws + O_MOD); p.rope = (float*)(ws + O_ROPE); p.xc = (float*)(ws + O_XC);
  p.rstdq = (float*)(ws + O_RSQ); p.rstdkv = (float*)(ws + O_RSKV); p.dec = (float*)(ws + O_DEC); p.wt = (u16*)(ws + O_WT);
  p.proj = (u16*)(ws + O_PROJ); p.h = (u16*)(ws + O_H); p.m = (u16*)(ws + O_M); p.q = (u16*)(ws + O_Q);
  p.kf = (u16*)(ws + O_KF); p.vt = (u16*)(ws + O_VT); p.uc = (u16*)(ws + O_UC); p.gq = (u16*)(ws + O_GQ);
  p.ss = (u16*)(ws + O_SS);
  volatile LAS unsigned* st = (volatile LAS unsigned*)(smem + SLOT_OFF + 64);
  if (threadIdx.x == 0) { st[0] = 0u; st[1] = 0u; }
  __syncthreads();
  XcdBarrier xb;
  xb.bar = (unsigned*)(ws + O_BAR); xb.x = 0; xb.st = st;
  if (coop) xb = xcd_barrier_post((unsigned*)(ws + O_BAR), st);
  for (int ph = ph_lo; ph < ph_hi; ++ph) {
#ifdef PROBE_MASK
    const int nrep = (ph > 0 && ph < NPHASES - 1 && ((PROBE_MASK >> ((ph - 1) % NPH_PER)) & 1)) ? 2 : 1;
#else
    const int nrep = 1;
#endif
    for (int rep = 0; rep < nrep; ++rep) {
      if (rep) xcd_barrier(xb);
      run_phase(p, ph, p.ctr + rep * 512 + ph * 8);
    }
    if (coop && ph + 1 < ph_hi) {
      if (ph == ph_lo) cg::this_grid().sync();
      else xcd_barrier(xb);
    }
  }
}

static inline size_t align_up(size_t v) { return (v + 255) & ~(size_t)255; }

extern "C" void kernel_launch(void* const* d_in, const int* in_sizes, int n_in, void* d_out, int out_size,
                              void* d_ws, size_t ws_size, hipStream_t stream) {
  static int grid_blocks = 0;
  if (!grid_blocks) {
    int dev = 0, cus = 0, per_cu = 0;
    hipGetDevice(&dev);
    hipDeviceGetAttribute(&cus, hipDeviceAttributeMultiprocessorCount, dev);
    hipFuncSetAttribute((const void*)mega_kernel, hipFuncAttributeMaxDynamicSharedMemorySize, LDS_BYTES);
    hipOccupancyMaxActiveBlocksPerMultiprocessor(&per_cu, (const void*)mega_kernel, 256, LDS_BYTES);
    if (per_cu < 1) per_cu = 1;
    if (per_cu > 2) per_cu = 2;
    grid_blocks = cus * per_cu;
  }
  KArgs p{};
  for (int i = 0; i < 27; ++i) p.in[i] = (const float*)d_in[i];
  p.out = (float*)d_out;
  p.ws = (char*)d_ws;
  if (ws_size < WS_END) { fprintf(stderr, "workspace too small: %zu < %zu\n", ws_size, (size_t)WS_END); return; }
  hipMemsetAsync((char*)d_ws + O_CTR, 0, 4096 + XCD_BAR_BYTES, stream);
#if SINGLE_LAUNCH
  int lo = 0, hi = NPHASES, coop = 1;
  void* args[] = {&p, &lo, &hi, &coop};
  hipError_t e = hipLaunchCooperativeKernel((const void*)mega_kernel, dim3(grid_blocks), dim3(256), args, LDS_BYTES, stream);
  if (e != hipSuccess) fprintf(stderr, "cooperative launch failed: %s (grid %d)\n", hipGetErrorString(e), grid_blocks);
#else
  for (int ph = 0; ph < NPHASES; ++ph)
    hipLaunchKernelGGL(mega_kernel, dim3(grid_blocks), dim3(256), LDS_BYTES, stream, p, ph, ph + 1, 0);
#endif
}
```

```cpp
#include <hip/hip_runtime.h>
#include <hip/hip_cooperative_groups.h>
#include <cstdio>
#include <cstdint>
namespace cg = cooperative_groups;

typedef unsigned short u16;
typedef __attribute__((ext_vector_type(8))) short bf16x8;
typedef __attribute__((ext_vector_type(4))) float f32x4;
typedef __attribute__((ext_vector_type(16))) float f32x16;

#ifndef SINGLE_LAUNCH
#define SINGLE_LAUNCH 1
#endif

constexpr int DM = 1024, SEQ = 8192, CTXL = 256, NBATCH = 8, INW = 6592, INWP = 6656, DFF = 2816;
constexpr int C_QA = 0, C_KA = 256, C_VA = 512, C_RA = 1024, C_ALR = 1536, C_CQ = 1568, C_CKV = 1824,
              C_KR = 1952, C_SB = 1984, C_SC = 2496, C_SX = 3008, C_GATE = 3520;
constexpr int NKEY = SEQ + CTXL;
constexpr int NCHUNK = NKEY / 64;
constexpr float EPS = 1e-6f;
constexpr int LDS_BYTES = 65536 + 256;
constexpr int SLOT_OFF = 65536;
constexpr int NPH_PER = 11;
constexpr int NBG = 4;
constexpr int NGRP = NBATCH / NBG;
constexpr int RG = NBG * (SEQ + CTXL);
constexpr int NPHASES = 1 + 2 * NGRP * NPH_PER + 1;

constexpr size_t W_IN = 0;
constexpr size_t W_UQ = W_IN + (size_t)INWP * 1024;
constexpr size_t W_UKV = W_UQ + 768 * 256;
constexpr size_t W_BRA = W_UKV + 1024 * 128;
constexpr size_t W_BRB = W_BRA + 1024 * 512;
constexpr size_t W_BRC = W_BRB + 1024 * 512;
constexpr size_t W_O = W_BRC + 1024 * 512;
constexpr size_t W_GU = W_O + 1024 * 1024;
constexpr size_t W_DN = W_GU + (size_t)5632 * 1024;
constexpr size_t W_LAYER = W_DN + (size_t)1024 * 2816;

struct KArgs {
  const float* in[27];
  float* out;
  char* ws;
};
struct Params {
  const float* in[27];
  float* out;
  float* xc;
  u16* wt;
  float* mod;
  float* rope;
  int* ctr;
  float* rstdq;
  float* rstdkv;
  float* dec;
  u16* proj;
  u16* h;
  u16* m;
  u16* q;
  u16* kf;
  u16* vt;
  u16* uc;
  u16* gq;
  u16* ss;
};
constexpr size_t al256(size_t v) { return (v + 255) & ~(size_t)255; }
constexpr size_t XCD_BAR_BYTES = 3456 * 4;
constexpr size_t O_CTR = 0;
constexpr size_t O_BAR = O_CTR + 4096;
constexpr size_t O_MOD = al256(O_BAR + XCD_BAR_BYTES);
constexpr size_t O_ROPE = al256(O_MOD + (size_t)2 * 9 * 6144 * 4);
constexpr size_t O_XC = al256(O_ROPE + 1024 * 2 * 4);
constexpr size_t O_RSQ = al256(O_XC + (size_t)NBATCH * CTXL * DM * 4);
constexpr size_t O_RSKV = al256(O_RSQ + (size_t)RG * 4);
constexpr size_t O_DEC = al256(O_RSKV + (size_t)RG * 4);
constexpr size_t O_WT = al256(O_DEC + (size_t)NBG * NCHUNK * 4 * 2 * 64 * 4);
constexpr size_t O_PROJ = al256(O_WT + 2 * W_LAYER * 2);
constexpr size_t O_H = al256(O_PROJ + (size_t)RG * INW * 2);
constexpr size_t O_M = O_H + (size_t)RG * DM * 2;
constexpr size_t O_Q = al256(O_M + (size_t)RG * DM * 2);
constexpr size_t O_KF = al256(O_Q + (size_t)RG * 768 * 2);
constexpr size_t O_VT = al256(O_KF + (size_t)NBG * 8 * NKEY * 96 * 2);
constexpr size_t O_UC = al256(O_VT + (size_t)NBG * 8 * 64 * NKEY * 2);
constexpr size_t O_GQ = al256(O_UC + (size_t)RG * 512 * 2);
constexpr size_t O_SS = al256(O_GQ + (size_t)RG * 1024 * 2);
constexpr size_t WS_END = al256(O_SS + (size_t)NBG * NCHUNK * 4 * 2 * 8192 * 2);
static_assert(WS_END <= ((size_t)1 << 30), "workspace layout must fit 1 GiB");

extern __shared__ __attribute__((aligned(16))) char smem[];

typedef __bf16 hbf2 __attribute__((ext_vector_type(2)));
typedef float hf2 __attribute__((ext_vector_type(2)));
__device__ __forceinline__ unsigned pack2(float a, float b) {
  hf2 v = {a, b};
  return __builtin_bit_cast(unsigned, __builtin_convertvector(v, hbf2));
}
__device__ __forceinline__ u16 f2bf(float f) { return (u16)(pack2(f, 0.f) & 0xffffu); }
__device__ __forceinline__ float bf2f(u16 h) { return __uint_as_float(((unsigned)h) << 16); }
__device__ __forceinline__ float bflo(unsigned u) { return __uint_as_float(u << 16); }
__device__ __forceinline__ float bfhi(unsigned u) { return __uint_as_float(u & 0xffff0000u); }
typedef unsigned nt_u32x4 __attribute__((ext_vector_type(4)));
typedef unsigned nt_u32x2 __attribute__((ext_vector_type(2)));
__device__ __forceinline__ void st_nt(void* p, uint4 v) { nt_u32x4 t = {v.x, v.y, v.z, v.w}; __builtin_nontemporal_store(t, (nt_u32x4*)p); }
__device__ __forceinline__ void st_nt(void* p, uint2 v) { nt_u32x2 t = {v.x, v.y}; __builtin_nontemporal_store(t, (nt_u32x2*)p); }
__device__ __forceinline__ void st_nt(void* p, float4 v) { f32x4 t = {v.x, v.y, v.z, v.w}; __builtin_nontemporal_store(t, (f32x4*)p); }
__device__ __forceinline__ float silu_f(float x) { return x / (1.f + __expf(-x)); }
__device__ __forceinline__ float sigmoid_f(float x) { return 1.f / (1.f + __expf(-x)); }

__device__ __forceinline__ void rowinfo(int r, int NB, int& bl, int& pos, int& isctx) {
  const int nl = NB * SEQ;
  if (r < nl) { bl = r >> 13; pos = r & (SEQ - 1); isctx = 0; }
  else { const int rc = r - nl; bl = rc >> 8; pos = rc & (CTXL - 1); isctx = 1; }
}
__device__ __forceinline__ int chunk_row(int bl, int cidx, int NB) {
  return cidx < 128 ? bl * SEQ + cidx * 64 : NB * SEQ + bl * CTXL + (cidx - 128) * 64;
}

template <class CntF, class BodyF>
__device__ __forceinline__ void run_q8(int* ctr8, CntF cntf, BodyF body) {
  volatile int* slot = (volatile int*)(smem + SLOT_OFF);
  int q = blockIdx.x & 7, tries = 0, item;
  __syncthreads();
  if (threadIdx.x == 0) {
    int v = atomicAdd(&ctr8[q], 1);
    while (v >= cntf(q) && tries < 8) { q = (q + 1) & 7; ++tries; if (tries < 8) v = atomicAdd(&ctr8[q], 1); }
    slot[0] = (tries < 8) ? v : -1; slot[1] = q; slot[2] = tries;
  }
  __syncthreads();
  item = slot[0]; q = slot[1]; tries = slot[2];
  while (item >= 0) {
    int nxt = 0;
    if (threadIdx.x == 0) nxt = atomicAdd(&ctr8[q], 1);
    body(q, item);
    __syncthreads();
    if (threadIdx.x == 0) {
      int qq = q, t = tries;
      while (nxt >= cntf(qq) && t < 8) { qq = (qq + 1) & 7; ++t; if (t < 8) nxt = atomicAdd(&ctr8[qq], 1); }
      slot[0] = (t < 8) ? nxt : -1; slot[1] = qq; slot[2] = t;
    }
    __syncthreads();
    item = slot[0]; q = slot[1]; tries = slot[2];
  }
}
#define QA_CNT(N) [=](int q_) { return ((N) - q_ + 7) >> 3; }
#define QA_ID(q_, j_) ((j_) * 8 + (q_))

__device__ __forceinline__ int opaque_tid() {
  int t = threadIdx.x;
  asm volatile("" : "+v"(t));
  return t;
}
#define TIDX opaque_tid()
template <int M>
__device__ __forceinline__ float xor_lane(float v) {
  if constexpr (M == 32) {
    const unsigned u = __float_as_uint(v);
    const auto sw = __builtin_amdgcn_permlane32_swap(u, u, false, false);
    const int lane = __builtin_amdgcn_mbcnt_hi(~0u, __builtin_amdgcn_mbcnt_lo(~0u, 0u));
    return __uint_as_float(lane < 32 ? sw[1] : sw[0]);
  } else {
    return __uint_as_float((unsigned)__builtin_amdgcn_ds_swizzle((int)__float_as_uint(v), 0x1f | (M << 10)));
  }
}
__device__ __forceinline__ float wave_sum(float v) {
  v += xor_lane<32>(v); v += xor_lane<16>(v); v += xor_lane<8>(v);
  v += xor_lane<4>(v); v += xor_lane<2>(v); v += xor_lane<1>(v);
  return v;
}

__device__ __forceinline__ int lds_byte(int r, int c) {
  const int st = (r >> 4) * 2 + (c >> 5), rr = r & 15, cc = c & 31, ob = rr * 64 + cc * 2;
  return st * 1024 + (ob ^ (((ob >> 9) & 1) << 5));
}
__device__ __forceinline__ void stage_rc(int b, int& R, int& C) {
  const int st = b >> 10, sb = b & 1023, swz = sb ^ (((sb >> 9) & 1) << 5);
  R = (st >> 1) * 16 + (swz >> 6); C = (st & 1) * 32 + ((swz & 63) >> 1);
}

__device__ __forceinline__ void glds16(const void* g, void* l) {
  __builtin_amdgcn_global_load_lds((const __attribute__((address_space(1))) unsigned*)g,
                                   (__attribute__((address_space(3))) unsigned*)l, 16, 0, 0);
}

template <int NWI>
__device__ __forceinline__ void gemm_core(const u16* __restrict__ X, int ldx, const u16* __restrict__ W, int ldw,
                                          int K, f32x4 (&acc)[NWI][4]) {
  const int tid = TIDX, lane = tid & 63, wid = tid >> 6;
  const int wr = wid >> 1, wc = wid & 1, fr = lane & 15, fq = lane >> 4;
#pragma unroll
  for (int a = 0; a < NWI; ++a)
#pragma unroll
    for (int b = 0; b < 4; ++b) acc[a][b] = f32x4{0.f, 0.f, 0.f, 0.f};
  const int srow = tid >> 3, schunk = (tid & 7) ^ ((tid >> 4) & 7);
  const u16* xg = X + (size_t)srow * ldx + schunk * 8;
  const u16* wg = W + (size_t)srow * ldw + schunk * 8;
  const int xs = 32 * ldx, ws_ = 32 * ldw;
  const int g = fr >> 1;
  const int lo0 = fr * 128 + ((fq ^ g) << 4), lo1 = fr * 128 + (((fq ^ g) ^ 4) << 4);
  const char* xb = smem + wr * 8192;
  const char* wb = smem + 16384 + wc * (NWI * 2048);
  char* sdst = smem + tid * 16;
  const int nt = K >> 6;
  __syncthreads();
#pragma unroll
  for (int i = 0; i < 4; ++i) {
    glds16(xg + i * xs, sdst + i * 4096);
    if (i < NWI) glds16(wg + i * ws_, sdst + 16384 + i * 4096);
  }
  for (int kt = 0; kt < nt; ++kt) {
    asm volatile("s_waitcnt vmcnt(0)" ::: "memory");
    __syncthreads();
    const int cb = (kt & 1) * 32768;
    if (kt + 1 < nt) {
      const int nb = 32768 - cb;
      const int ko = (kt + 1) * 64;
#pragma unroll
      for (int i = 0; i < 4; ++i) {
        glds16(xg + i * xs + ko, sdst + nb + i * 4096);
        if (i < NWI) glds16(wg + i * ws_ + ko, sdst + nb + 16384 + i * 4096);
      }
    }
    bf16x8 wf[2][NWI], xf[2][4];
#pragma unroll
    for (int i = 0; i < NWI; ++i) {
      wf[0][i] = *(const bf16x8*)(wb + cb + i * 2048 + lo0);
      wf[1][i] = *(const bf16x8*)(wb + cb + i * 2048 + lo1);
    }
#pragma unroll
    for (int i = 0; i < 4; ++i) {
      xf[0][i] = *(const bf16x8*)(xb + cb + i * 2048 + lo0);
      xf[1][i] = *(const bf16x8*)(xb + cb + i * 2048 + lo1);
    }
    __builtin_amdgcn_sched_barrier(0);
#pragma unroll
    for (int k = 0; k < 2; ++k)
#pragma unroll
      for (int wi = 0; wi < NWI; ++wi)
#pragma unroll
        for (int xi = 0; xi < 4; ++xi)
          acc[wi][xi] = __builtin_amdgcn_mfma_f32_16x16x32_bf16(wf[k][wi], xf[k][xi], acc[wi][xi], 0, 0, 0);
    __builtin_amdgcn_sched_barrier(0);
  }
}

#define EPI_VARS const int tid_ = TIDX, lane_ = tid_ & 63, wid_ = tid_ >> 6; \
  const int wr_ = wid_ >> 1, wc_ = wid_ & 1, fr_ = lane_ & 15, fq_ = lane_ >> 4; (void)fq_; (void)fr_; (void)wr_; (void)wc_;
#define EPI_TR(xi) (wr_ * 64 + (xi) * 16 + fr_)
#define EPI_NN(wi) (wc_ * 64 + (wi) * 16 + fq_ * 4)

template <int NWI>
__device__ __forceinline__ void store_tile_bf16(const uint2 (&o)[NWI][4], u16* dst_wave, size_t ld) {
  constexpr int RB = NWI * 32, CPR = RB / 16;
  const int tid = TIDX, lane = tid & 63, wid = tid >> 6, fr = lane & 15, fq = lane >> 4;
  char* lb = smem + wid * 8192;
#pragma unroll
  for (int wi = 0; wi < NWI; ++wi)
#pragma unroll
    for (int xi = 0; xi < 4; ++xi) {
      const int r = xi * 16 + fr, c = wi * 2 + (fq >> 1);
      *(uint2*)(lb + r * RB + ((c ^ (r & (CPR - 1))) << 4) + (fq & 1) * 8) = o[wi][xi];
    }
#pragma unroll
  for (int it = 0; it < CPR; ++it) {
    const int idx = it * 64 + lane, row = idx / CPR, c = idx % CPR;
    typedef unsigned u32x4_t __attribute__((ext_vector_type(4)));
    const u32x4_t v = *(const u32x4_t*)(lb + row * RB + ((c ^ (row & (CPR - 1))) << 4));
    __builtin_nontemporal_store(v, (u32x4_t*)(dst_wave + (size_t)row * ld + c * 8));
  }
}

__device__ __forceinline__ void tile_order(int t, int MT, int NT, int& mt, int& nt) {
  constexpr int GM = 4;
  const int band = t / (GM * NT), rem = t - band * GM * NT;
  const int m0 = band * GM;
  const int gsz = min(GM, MT - m0);
  nt = rem / gsz; mt = m0 + rem - nt * gsz;
}

__device__ __forceinline__ int mlo(int q, int MT) { return (q * MT) >> 3; }
#define GEMM_CNT(MT, NT) [=](int q_) { return (mlo(q_ + 1, MT) - mlo(q_, MT)) * (NT); }

__device__ __forceinline__ float* xrow_ptr(const Params& p, int g, int r) {
  int bl, pos, isctx; rowinfo(r, NBG, bl, pos, isctx);
  const int b = g * NBG + bl;
  return isctx ? p.xc + ((size_t)b * CTXL + pos) * DM : p.out + ((size_t)b * SEQ + pos) * DM;
}
__device__ __forceinline__ const float* xsrc_row_ptr(const Params& p, int g, int r, int from_input) {
  int bl, pos, isctx; rowinfo(r, NBG, bl, pos, isctx);
  const int b = g * NBG + bl;
  if (from_input) return isctx ? p.in[2] + ((size_t)b * CTXL + pos) * DM : p.in[0] + ((size_t)b * SEQ + pos) * DM;
  return isctx ? p.xc + ((size_t)b * CTXL + pos) * DM : p.out + ((size_t)b * SEQ + pos) * DM;
}
__device__ __forceinline__ int mod_index(const Params& p, int g, int r) {
  int bl, pos, isctx; rowinfo(r, NBG, bl, pos, isctx);
  return isctx ? 8 : g * NBG + bl;
}

__device__ void conv_tile4(const float* __restrict__ src, int K, int N, u16* __restrict__ dst,
                           const float* __restrict__ scale, int ktile, int ngrp) {
  float* tile = (float*)smem;
  const int tid = TIDX;
  const int k0 = ktile * 64;
  const int kk = tid >> 4, n4 = (tid & 15) * 4;
  float4 v[4][4];
  float sc[4];
#pragma unroll
  for (int i = 0; i < 4; ++i) sc[i] = scale ? scale[k0 + kk + 16 * i] : 1.f;
#pragma unroll
  for (int t = 0; t < 4; ++t) {
    const int n0 = (ngrp * 4 + t) * 64;
#pragma unroll
    for (int i = 0; i < 4; ++i) {
      v[t][i] = make_float4(0.f, 0.f, 0.f, 0.f);
      if (n0 < N) v[t][i] = *(const float4*)(src + (size_t)(k0 + kk + 16 * i) * N + n0 + n4);
    }
  }
  const int nn = tid >> 3, k8 = (tid & 7) * 8;
#pragma unroll
  for (int t = 0; t < 4; ++t) {
    const int n0 = (ngrp * 4 + t) * 64;
    __syncthreads();
#pragma unroll
    for (int i = 0; i < 4; ++i) {
      const int k = kk + 16 * i;
      tile[k * 65 + n4 + 0] = v[t][i].x * sc[i]; tile[k * 65 + n4 + 1] = v[t][i].y * sc[i];
      tile[k * 65 + n4 + 2] = v[t][i].z * sc[i]; tile[k * 65 + n4 + 3] = v[t][i].w * sc[i];
    }
    __syncthreads();
#pragma unroll
    for (int i = 0; i < 2; ++i) {
      const int n = nn + 32 * i;
      uint4 o;
      o.x = pack2(tile[(k8 + 0) * 65 + n], tile[(k8 + 1) * 65 + n]);
      o.y = pack2(tile[(k8 + 2) * 65 + n], tile[(k8 + 3) * 65 + n]);
      o.z = pack2(tile[(k8 + 4) * 65 + n], tile[(k8 + 5) * 65 + n]);
      o.w = pack2(tile[(k8 + 6) * 65 + n], tile[(k8 + 7) * 65 + n]);
      *(uint4*)(dst + (size_t)(n0 + n) * K + k0 + k8) = o;
    }
  }
}

__device__ void sincos_d(double a, double& s, double& c) {
  const double k = rint(a * 0.6366197723675814);
  double r = fma(-k, 1.5707963267948966, a);
  r = fma(-k, 6.123233995736766e-17, r);
  const int q = ((int)k) & 3;
  const double r2 = r * r;
  const double sp = r * (1.0 + r2 * (-1.0 / 6 + r2 * (1.0 / 120 + r2 * (-1.0 / 5040 + r2 * (1.0 / 362880 + r2 * (-1.0 / 39916800 + r2 * (1.0 / 6227020800.0)))))));
  const double cp = 1.0 + r2 * (-0.5 + r2 * (1.0 / 24 + r2 * (-1.0 / 720 + r2 * (1.0 / 40320 + r2 * (-1.0 / 3628800 + r2 * (1.0 / 479001600.0 + r2 * (-1.0 / 87178291200.0)))))));
  s = (q == 0) ? sp : (q == 1) ? cp : (q == 2) ? -sp : -cp;
  c = (q == 0) ? cp : (q == 1) ? -sp : (q == 2) ? -cp : sp;
}

constexpr int CV_WIN = 0, CV_UQ = 416, CV_UKV = 428, CV_BRA = 436, CV_BRB = 468, CV_BRC = 500,
              CV_WO = 532, CV_GATE = 596, CV_UP = 772, CV_DN = 948, CV_LAYER = 1124;
constexpr int P0_CONV = 2 * CV_LAYER, P0_ADA = 2 * 192, P0_TOTAL = P0_CONV + P0_ADA + 1;

__device__ void phase0(const Params& p, int* ctr) {
  run_q8(ctr, QA_CNT(P0_TOTAL), [&](int q_, int j_) {
    const int it = QA_ID(q_, j_);
    const int tid = TIDX;
    if (it >= P0_ADA + 1) {
      const int ci = it - (P0_ADA + 1);
      const int l = ci / CV_LAYER, j = ci % CV_LAYER;
      u16* wl = p.wt + (size_t)l * W_LAYER;
      if (j < CV_UQ)       { const int jj = j - CV_WIN;  conv_tile4(p.in[7] + (size_t)l * 1024 * INW, 1024, INW, wl + W_IN, nullptr, jj / 26, jj % 26); }
      else if (j < CV_UKV) { const int jj = j - CV_UQ;   conv_tile4(p.in[12] + (size_t)l * 256 * 768, 256, 768, wl + W_UQ, p.in[11] + l * 256, jj / 3, jj % 3); }
      else if (j < CV_BRA) { const int jj = j - CV_UKV;  conv_tile4(p.in[14] + (size_t)l * 128 * 1024, 128, 1024, wl + W_UKV, p.in[13] + l * 128, jj / 4, jj % 4); }
      else if (j < CV_BRB) { const int jj = j - CV_BRA;  conv_tile4(p.in[16] + (size_t)l * 512 * 1024, 512, 1024, wl + W_BRA, nullptr, jj / 4, jj % 4); }
      else if (j < CV_BRC) { const int jj = j - CV_BRB;  conv_tile4(p.in[17] + (size_t)l * 512 * 1024, 512, 1024, wl + W_BRB, nullptr, jj / 4, jj % 4); }
      else if (j < CV_WO)  { const int jj = j - CV_BRC;  conv_tile4(p.in[18] + (size_t)l * 512 * 1024, 512, 1024, wl + W_BRC, nullptr, jj / 4, jj % 4); }
      else if (j < CV_GATE){ const int jj = j - CV_WO;   conv_tile4(p.in[19] + (size_t)l * 1024 * 1024, 1024, 1024, wl + W_O, nullptr, jj / 4, jj % 4); }
      else if (j < CV_UP)  { const int jj = j - CV_GATE; conv_tile4(p.in[21] + (size_t)l * 1024 * DFF, 1024, DFF, wl + W_GU, nullptr, jj / 11, jj % 11); }
      else if (j < CV_DN)  { const int jj = j - CV_UP;   conv_tile4(p.in[22] + (size_t)l * 1024 * DFF, 1024, DFF, wl + W_GU + (size_t)DFF * 1024, nullptr, jj / 11, jj % 11); }
      else                 { const int jj = j - CV_DN;   conv_tile4(p.in[25] + (size_t)l * DFF * 1024, DFF, 1024, wl + W_DN, nullptr, jj / 4, jj % 4); }
    } else if (it < P0_ADA) {
      const int a = it, l = a / 192, cg_ = a % 192;
      float* sc = (float*)smem;
      float* red = sc + 9 * 1024;
      for (int e = tid; e < 9 * 1024; e += 256) {
        const int v = e >> 10, k = e & 1023;
        const float cv = (v < 8) ? p.in[1][v * 1024 + k] : p.in[3][k];
        sc[e] = cv / (1.f + expf(-cv));
      }
      __syncthreads();
      const int kg = tid >> 5, cn = tid & 31;
      const float* wa = p.in[4] + (size_t)l * 1024 * 6144 + cg_ * 32 + cn;
      float a0 = 0, a1 = 0, a2 = 0, a3 = 0, a4 = 0, a5 = 0, a6 = 0, a7 = 0, a8 = 0;
#pragma unroll 8
      for (int i = 0; i < 128; ++i) {
        const int k = kg + 8 * i;
        const float w = wa[(size_t)k * 6144];
        a0 += sc[k] * w; a1 += sc[1024 + k] * w; a2 += sc[2048 + k] * w; a3 += sc[3072 + k] * w;
        a4 += sc[4096 + k] * w; a5 += sc[5120 + k] * w; a6 += sc[6144 + k] * w; a7 += sc[7168 + k] * w;
        a8 += sc[8192 + k] * w;
      }
      float* rr = red + kg * 288 + cn;
      rr[0] = a0; rr[32] = a1; rr[64] = a2; rr[96] = a3; rr[128] = a4; rr[160] = a5; rr[192] = a6; rr[224] = a7; rr[256] = a8;
      __syncthreads();
      for (int e = tid; e < 288; e += 256) {
        float s = 0.f;
#pragma unroll
        for (int g8 = 0; g8 < 8; ++g8) s += red[g8 * 288 + e];
        const int v = e >> 5, n = cg_ * 32 + (e & 31);
        p.mod[((size_t)l * 9 + v) * 6144 + n] = s + p.in[5][l * 6144 + n];
      }
    } else {
      for (int e = tid; e < 1024; e += 256) {
        const int pos = e >> 3, f = e & 7;
        const float inv = (f == 0) ? 1.0f : (f == 1) ? 0.31622776601683794f : (f == 2) ? 0.1f : (f == 3) ? 0.031622776601683794f
                        : (f == 4) ? 0.01f : (f == 5) ? 0.0031622776601683794f : (f == 6) ? 0.001f : 0.00031622776601683794f;
        const float ang = (float)pos * inv;
        double s, c; sincos_d((double)ang, s, c);
        p.rope[e * 2] = (float)c; p.rope[e * 2 + 1] = (float)s;
      }
    }
  });
}

__device__ void phase_norm(const Params& p, int l, int g, int which, int* ctr) {
  const int nitems = (which == 1 && l == 1) ? NBG * SEQ / 16 : RG / 16;
  const float* gam = (which == 0 ? p.in[6] : p.in[20]) + l * DM;
  const int shoff = which == 0 ? 0 : 3072, scoff = which == 0 ? 1024 : 4096;
  const int from_input = (which == 0 && l == 0);
  for (int it = blockIdx.x; it < nitems; it += gridDim.x) {
    const int lane = TIDX & 63, wid = TIDX >> 6;
    const int r0 = it * 16 + wid * 4;
    const float* xr = xsrc_row_ptr(p, g, r0, from_input);
    const float* mrow = p.mod + ((size_t)l * 9 + mod_index(p, g, r0)) * 6144;
    float4 v[4][4], gg[4], sh[4], sc[4];
#pragma unroll
    for (int rr = 0; rr < 4; ++rr)
#pragma unroll
      for (int i = 0; i < 4; ++i) v[rr][i] = *(const float4*)(xr + (size_t)rr * DM + lane * 4 + i * 256);
#pragma unroll
    for (int i = 0; i < 4; ++i) {
      const int c = lane * 4 + i * 256;
      gg[i] = *(const float4*)(gam + c); sh[i] = *(const float4*)(mrow + shoff + c); sc[i] = *(const float4*)(mrow + scoff + c);
    }
#pragma unroll
    for (int rr = 0; rr < 4; ++rr) {
      float ss = 0.f;
#pragma unroll
      for (int i = 0; i < 4; ++i)
        ss += v[rr][i].x * v[rr][i].x + v[rr][i].y * v[rr][i].y + v[rr][i].z * v[rr][i].z + v[rr][i].w * v[rr][i].w;
      ss = wave_sum(ss);
      const float rstd = rsqrtf(ss * (1.f / 1024.f) + EPS);
#pragma unroll
      for (int i = 0; i < 4; ++i) {
        const int c = lane * 4 + i * 256;
        uint2 o;
        o.x = pack2(v[rr][i].x * rstd * gg[i].x * (1.f + sc[i].x) + sh[i].x, v[rr][i].y * rstd * gg[i].y * (1.f + sc[i].y) + sh[i].y);
        o.y = pack2(v[rr][i].z * rstd * gg[i].z * (1.f + sc[i].z) + sh[i].z, v[rr][i].w * rstd * gg[i].w * (1.f + sc[i].w) + sh[i].w);
        st_nt(p.h + (size_t)(r0 + rr) * DM + c, o);
      }
    }
  }
}

__device__ void phase_proj(const Params& p, int l, int* ctr) {
  const int MT = RG / 128, NT = INWP / 128;
  const u16* W = p.wt + (size_t)l * W_LAYER + W_IN;
  run_q8(ctr, GEMM_CNT(MT, NT), [&](int q_, int j_) {
    int mt, nt; tile_order(j_, mlo(q_ + 1, MT) - mlo(q_, MT), NT, mt, nt); mt += mlo(q_, MT);
    f32x4 acc[4][4];
    gemm_core<4>(p.h + (size_t)mt * 128 * DM, DM, W + (size_t)nt * 128 * DM, DM, DM, acc);
    EPI_VARS
    uint2 o[4][4];
#pragma unroll
    for (int wi = 0; wi < 4; ++wi)
#pragma unroll
      for (int xi = 0; xi < 4; ++xi) {
        o[wi][xi].x = pack2(acc[wi][xi][0], acc[wi][xi][1]); o[wi][xi].y = pack2(acc[wi][xi][2], acc[wi][xi][3]);
      }
    if (nt * 128 + wc_ * 64 < INW)
      store_tile_bf16<4>(o, p.proj + (size_t)(mt * 128 + wr_ * 64) * INW + nt * 128 + wc_ * 64, INW);
  });
}

__device__ void postproj_rows(const Params& p, int l, int it) {
  const int lane = TIDX & 63, wid = TIDX >> 6;
  const float* scw = p.in[15] + (size_t)l * 3 * 512;
  for (int rr = 0; rr < 4; ++rr) {
    const int r = it * 16 + wid * 4 + rr;
    int bl, pos, isctx; rowinfo(r, NBG, bl, pos, isctx);
    const u16* pr = p.proj + (size_t)r * INW;
    const int Lr = isctx ? CTXL : SEQ;
    const int c0 = lane * 8;
    const uint2 u_cq = *(const uint2*)(pr + C_CQ + lane * 4);
    const unsigned u_ckv = *(const unsigned*)(pr + C_CKV + lane * 2);
    const u16 u_kr = pr[C_KR + (lane & 31)];
    const uint4 sb = *(const uint4*)(pr + C_SB + c0);
    const uint4 sc1 = *(const uint4*)(pr + C_SC + c0);
    const uint4 sx1 = *(const uint4*)(pr + C_SX + c0);
    uint4 sc0 = make_uint4(0, 0, 0, 0), sx0 = sc0, sc2 = sc0, sx2 = sc0;
    if (pos > 0) { sc0 = *(const uint4*)(pr - INW + C_SC + c0); sx0 = *(const uint4*)(pr - INW + C_SX + c0); }
    if (pos < Lr - 1) { sc2 = *(const uint4*)(pr + INW + C_SC + c0); sx2 = *(const uint4*)(pr + INW + C_SX + c0); }
    {
      const uint2 u = u_cq;
      const float a = bflo(u.x), b = bfhi(u.x), c = bflo(u.y), d = bfhi(u.y);
      float ss = wave_sum(a * a + b * b + c * c + d * d);
      if (lane == 0) p.rstdq[r] = rsqrtf(ss * (1.f / 256.f) + EPS);
    }
    {
      const unsigned u = u_ckv;
      const float a = bflo(u), b = bfhi(u);
      float ss = wave_sum(a * a + b * b);
      if (lane == 0) p.rstdkv[r] = rsqrtf(ss * (1.f / 128.f) + EPS);
    }
    {
      const int idx = lane & 31;
      const float val = bf2f(u_kr);
      const float partner = xor_lane<8>(val);
      float o = val;
      if (!isctx) {
        const int axis = idx >> 4, half = (idx >> 3) & 1, f = idx & 7;
        const int pa = axis ? (pos & 63) : (pos >> 6);
        const float c = p.rope[(pa * 8 + f) * 2], s = p.rope[(pa * 8 + f) * 2 + 1];
        o = half ? (val * c + partner * s) : (val * c - partner * s);
      }
      const int j = isctx ? SEQ + pos : pos;
      const u16 ob = f2bf(o);
      if (lane < 32) {
#pragma unroll
        for (int hd = 0; hd < 8; ++hd)
          p.kf[((size_t)(bl * 8 + hd) * NKEY + j) * 96 + 64 + idx] = ob;
      }
    }
    {
      const float4 w0a = *(const float4*)(scw + c0), w0b = *(const float4*)(scw + c0 + 4);
      const float4 w1a = *(const float4*)(scw + 512 + c0), w1b = *(const float4*)(scw + 512 + c0 + 4);
      const float4 w2a = *(const float4*)(scw + 1024 + c0), w2b = *(const float4*)(scw + 1024 + c0 + 4);
      uint4 o;
#define UC2(SBW, A0, X0, A1, X1, A2, X2, W0L, W0H, W1L, W1H, W2L, W2H) \
      pack2(bflo(SBW) * (W0L * bflo(A0) * bflo(X0) + W1L * bflo(A1) * bflo(X1) + W2L * bflo(A2) * bflo(X2)), \
            bfhi(SBW) * (W0H * bfhi(A0) * bfhi(X0) + W1H * bfhi(A1) * bfhi(X1) + W2H * bfhi(A2) * bfhi(X2)))
      o.x = UC2(sb.x, sc0.x, sx0.x, sc1.x, sx1.x, sc2.x, sx2.x, w0a.x, w0a.y, w1a.x, w1a.y, w2a.x, w2a.y);
      o.y = UC2(sb.y, sc0.y, sx0.y, sc1.y, sx1.y, sc2.y, sx2.y, w0a.z, w0a.w, w1a.z, w1a.w, w2a.z, w2a.w);
      o.z = UC2(sb.z, sc0.z, sx0.z, sc1.z, sx1.z, sc2.z, sx2.z, w0b.x, w0b.y, w1b.x, w1b.y, w2b.x, w2b.y);
      o.w = UC2(sb.w, sc0.w, sx0.w, sc1.w, sx1.w, sc2.w, sx2.w, w0b.z, w0b.w, w1b.z, w1b.w, w2b.z, w2b.w);
#undef UC2
      st_nt(p.uc + (size_t)r * 512 + c0, o);
    }
  }
}

__device__ __forceinline__ float logsig16(float z) {
  return (fminf(z, 0.f) - __logf(1.f + __expf(-fabsf(z)))) * (1.f / 16.f);
}

__device__ void gla_prep(const Params& p, int l, int it) {
  const int tid = TIDX, lane = tid & 63, wid = tid >> 6;
  const int bl = it / (NCHUNK * 4), rem = it % (NCHUNK * 4), cidx = rem >> 2, h = rem & 3;
  const int r0 = chunk_row(bl, cidx, NBG);
  float* lr = (float*)smem;
  float* tot = (float*)(smem + 8192);
  u16* vT = (u16*)(smem + 10752);
  u16* kTf = (u16*)(smem + 29184);
  u16* kTb = (u16*)(smem + 38400);
  {
    const int t = tid >> 2, c8 = (tid & 3) * 8;
    const uint4 u = *(const uint4*)(p.proj + (size_t)(r0 + t) * INW + C_ALR + c8);
    float* d = lr + t * 32 + c8;
    d[0] = bflo(u.x); d[1] = bfhi(u.x); d[2] = bflo(u.y); d[3] = bfhi(u.y);
    d[4] = bflo(u.z); d[5] = bfhi(u.z); d[6] = bflo(u.w); d[7] = bfhi(u.w);
    const int dvc = (tid & 3) * 32;
    const u16* vp = p.proj + (size_t)(r0 + t) * INW + C_VA + h * 128 + dvc;
#pragma unroll
    for (int i = 0; i < 4; ++i) {
      const uint4 vv = *(const uint4*)(vp + i * 8);
      u16* dst = vT + (size_t)(dvc + i * 8) * 72 + t;
      dst[0] = (u16)(vv.x & 0xffff); dst[72] = (u16)(vv.x >> 16);
      dst[144] = (u16)(vv.y & 0xffff); dst[216] = (u16)(vv.y >> 16);
      dst[288] = (u16)(vv.z & 0xffff); dst[360] = (u16)(vv.z >> 16);
      dst[432] = (u16)(vv.w & 0xffff); dst[504] = (u16)(vv.w >> 16);
    }
  }
  __syncthreads();
  const int dk = lane, tg = wid;
  const float* w2f = p.in[8] + ((size_t)(l * 2 + 0) * 16) * 256 + h * 64 + dk;
  const float* w2b = p.in[8] + ((size_t)(l * 2 + 1) * 16) * 256 + h * 64 + dk;
  float wf[16], wb[16];
#pragma unroll
  for (int r = 0; r < 16; ++r) { wf[r] = w2f[r * 256]; wb[r] = w2b[r * 256]; }
  const float biasf = p.in[9][(l * 2 + 0) * 256 + h * 64 + dk];
  const float biasb = p.in[9][(l * 2 + 1) * 256 + h * 64 + dk];
  float pf[16], sbk[16];
#pragma unroll
  for (int i = 0; i < 16; ++i) {
    const float* lrow = lr + (tg * 16 + i) * 32;
    float zf = biasf, zb = biasb;
#pragma unroll
    for (int r = 0; r < 16; ++r) { zf += lrow[r] * wf[r]; zb += lrow[16 + r] * wb[r]; }
    pf[i] = logsig16(zf); sbk[i] = logsig16(zb);
  }
#pragma unroll
  for (int i = 1; i < 16; ++i) pf[i] += pf[i - 1];
#pragma unroll
  for (int i = 14; i >= 0; --i) sbk[i] += sbk[i + 1];
  tot[tg * 64 + dk] = pf[15];
  tot[256 + tg * 64 + dk] = sbk[0];
  __syncthreads();
  float offf = 0.f, offb = 0.f, bfl = 0.f, bb0 = 0.f;
#pragma unroll
  for (int g4 = 0; g4 < 4; ++g4) {
    const float a = tot[g4 * 64 + dk], b = tot[256 + g4 * 64 + dk];
    bfl += a; bb0 += b;
    if (g4 < tg) offf += a;
    if (g4 > tg) offb += b;
  }
  u16* gqf = p.gq;
  u16* gkf = p.gq + (size_t)RG * 256;
  u16* gqb = p.gq + (size_t)RG * 512;
  u16* gkb = p.gq + (size_t)RG * 768;
  unsigned kfp[8], kbp[8];
#pragma unroll
  for (int i = 0; i < 16; ++i) {
    const int t = tg * 16 + i;
    const float bfv = offf + pf[i], bbv = offb + sbk[i];
    const float qv = bf2f(p.proj[(size_t)(r0 + t) * INW + C_QA + h * 64 + dk]);
    const float kv = bf2f(p.proj[(size_t)(r0 + t) * INW + C_KA + h * 64 + dk]);
    const size_t go = (size_t)(r0 + t) * 256 + h * 64 + dk;
    gqf[go] = f2bf(qv * __expf(bfv) * 0.125f);
    gkf[go] = f2bf(kv * __expf(-bfv));
    gqb[go] = f2bf(qv * __expf(bbv) * 0.125f);
    gkb[go] = f2bf(kv * __expf(-bbv));
    const u16 ksf = f2bf(kv * __expf(bfl - bfv));
    const u16 ksb = f2bf(kv * __expf(bb0 - bbv));
    if (i & 1) { kfp[i >> 1] |= ((unsigned)ksf) << 16; kbp[i >> 1] |= ((unsigned)ksb) << 16; }
    else { kfp[i >> 1] = ksf; kbp[i >> 1] = ksb; }
  }
  *(uint4*)(kTf + dk * 72 + tg * 16) = make_uint4(kfp[0], kfp[1], kfp[2], kfp[3]);
  *(uint4*)(kTf + dk * 72 + tg * 16 + 8) = make_uint4(kfp[4], kfp[5], kfp[6], kfp[7]);
  *(uint4*)(kTb + dk * 72 + tg * 16) = make_uint4(kbp[0], kbp[1], kbp[2], kbp[3]);
  *(uint4*)(kTb + dk * 72 + tg * 16 + 8) = make_uint4(kbp[4], kbp[5], kbp[6], kbp[7]);
  const size_t cb = ((size_t)(bl * NCHUNK + cidx) * 4 + h) * 2;
  if (tg == 0) {
    p.dec[(cb + 0) * 64 + dk] = __expf(bfl);
    p.dec[(cb + 1) * 64 + dk] = __expf(bb0);
  }
  __syncthreads();
  const int l31 = lane & 31, hh = lane >> 5;
  u16* U = p.h;
#pragma unroll
  for (int dir = 0; dir < 2; ++dir) {
    const u16* kT = dir ? kTb : kTf;
#pragma unroll
    for (int dkt = 0; dkt < 2; ++dkt) {
      f32x16 acc;
#pragma unroll
      for (int e = 0; e < 16; ++e) acc[e] = 0.f;
#pragma unroll
      for (int s = 0; s < 4; ++s) {
        const bf16x8 a = *(const bf16x8*)(vT + (32 * wid + l31) * 72 + 16 * s + 8 * hh);
        const bf16x8 b = *(const bf16x8*)(kT + (32 * dkt + l31) * 72 + 16 * s + 8 * hh);
        acc = __builtin_amdgcn_mfma_f32_32x32x16_bf16(a, b, acc, 0, 0, 0);
      }
      u16* up = U + (cb + dir) * 8192;
#pragma unroll
      for (int e = 0; e < 16; ++e) {
        const int dv = 32 * wid + (e & 3) + 8 * (e >> 2) + 4 * hh;
        up[dv * 64 + 32 * dkt + l31] = f2bf(acc[e]);
      }
    }
  }
}

__device__ void phase_postproj(const Params& p, int l, int* ctr) {
  const int n_prep = NBG * NCHUNK * 4, n_rows = RG / 16;
  run_q8(ctr, QA_CNT(n_prep + n_rows), [&](int q_, int j_) {
    const int it = QA_ID(q_, j_);
    if (it < n_prep) gla_prep(p, l, it);
    else postproj_rows(p, l, it - n_prep);
  });
}

__device__ void gla_scan(const Params& p, int it) {
  const int tid = TIDX;
  const int sl = it & 7, dir = (it >> 3) & 1, h = (it >> 4) & 3, bl = it >> 6;
  const int e0 = sl * 1024 + tid * 4;
  const int dk = e0 & 63;
  const u16* U = p.h;
  f32x4 S = {0.f, 0.f, 0.f, 0.f};
  for (int s0 = 0; s0 < NCHUNK; s0 += 12) {
    uint2 u4[12]; f32x4 d4[12];
#pragma unroll
    for (int j = 0; j < 12; ++j) {
      const int step = s0 + j;
      const int cidx = dir ? (NCHUNK - 1 - step) : (step < 4 ? 128 + step : step - 4);
      const size_t base = ((size_t)(bl * NCHUNK + cidx) * 4 + h) * 2 + dir;
      u4[j] = *(const uint2*)(U + base * 8192 + e0);
      d4[j] = *(const f32x4*)(p.dec + base * 64 + dk);
    }
#pragma unroll
    for (int j = 0; j < 12; ++j) {
      const int step = s0 + j;
      const int cidx = dir ? (NCHUNK - 1 - step) : (step < 4 ? 128 + step : step - 4);
      const size_t base = ((size_t)(bl * NCHUNK + cidx) * 4 + h) * 2 + dir;
      uint2 o; o.x = pack2(S[0], S[1]); o.y = pack2(S[2], S[3]);
      st_nt(p.ss + base * 8192 + e0, o);
      S = d4[j] * S + f32x4{bflo(u4[j].x), bfhi(u4[j].x), bflo(u4[j].y), bfhi(u4[j].y)};
    }
  }
}

__device__ void q_tile(const Params& p, int l, int t) {
  const int MT = RG / 128;
  const int nt = t / MT, mt = t % MT;
  f32x4 acc[4][4];
  gemm_core<4>(p.proj + (size_t)mt * 128 * INW + C_CQ, INW, p.wt + (size_t)l * W_LAYER + W_UQ + (size_t)nt * 128 * 256, 256, 256, acc);
  EPI_VARS
  const float QS = 0.10206207261596577f * 1.4426950408889634f;
  int bl, pos0, isctx; rowinfo(mt * 128, NBG, bl, pos0, isctx);
  float rsq[4];
  uint2 qo[4][4];
#pragma unroll
  for (int xi = 0; xi < 4; ++xi) rsq[xi] = p.rstdq[mt * 128 + EPI_TR(xi)] * QS;
#pragma unroll
  for (int xi = 0; xi < 4; ++xi) {
    const int tr = EPI_TR(xi), r = mt * 128 + tr, pos = pos0 + tr;
    const float rs = rsq[xi];
#pragma unroll
    for (int wi = 0; wi < 4; ++wi) {
      const int n16 = (nt * 128 + wc_ * 64 + wi * 16) >> 4;
      const int m6 = n16 % 6;
      float v0 = acc[wi][xi][0] * rs, v1 = acc[wi][xi][1] * rs, v2 = acc[wi][xi][2] * rs, v3 = acc[wi][xi][3] * rs;
      if (m6 >= 4 && !isctx) {
        const float p0 = xor_lane<32>(v0), p1 = xor_lane<32>(v1), p2 = xor_lane<32>(v2), p3 = xor_lane<32>(v3);
        const int pa = (m6 == 5) ? (pos & 63) : (pos >> 6);
        const int f0 = (fq_ & 1) * 4;
        const float* rp = p.rope + (pa * 8 + f0) * 2;
        const float4 cs01 = *(const float4*)rp, cs23 = *(const float4*)(rp + 4);
        const float sg = (fq_ >= 2) ? 1.f : -1.f;
        v0 = v0 * cs01.x + sg * p0 * cs01.y;
        v1 = v1 * cs01.z + sg * p1 * cs01.w;
        v2 = v2 * cs23.x + sg * p2 * cs23.y;
        v3 = v3 * cs23.z + sg * p3 * cs23.w;
      }
      qo[wi][xi].x = pack2(v0, v1); qo[wi][xi].y = pack2(v2, v3);
    }
  }
  store_tile_bf16<4>(qo, p.q + (size_t)(mt * 128 + wr_ * 64) * 768 + nt * 128 + wc_ * 64, 768);
}

__device__ void kv_tile(const Params& p, int l, int t) {
  const int MT = RG / 128;
  const int nt = t / MT, mt = t % MT;
  f32x4 acc[4][4];
  gemm_core<4>(p.proj + (size_t)mt * 128 * INW + C_CKV, INW, p.wt + (size_t)l * W_LAYER + W_UKV + (size_t)nt * 128 * 128, 128, 128, acc);
  EPI_VARS
  int bl, pos0, isctx; rowinfo(mt * 128, NBG, bl, pos0, isctx);
  const int j0 = isctx ? SEQ + pos0 : pos0;
  float rskv[4];
#pragma unroll
  for (int xi = 0; xi < 4; ++xi) rskv[xi] = p.rstdkv[mt * 128 + EPI_TR(xi)];
#pragma unroll
  for (int xi = 0; xi < 4; ++xi) {
    const int tr = EPI_TR(xi), r = mt * 128 + tr, j = j0 + tr;
    const float rs = rskv[xi];
#pragma unroll
    for (int wi = 0; wi < 4; ++wi) {
      const int wn = EPI_NN(wi);
      const float v0 = acc[wi][xi][0] * rs, v1 = acc[wi][xi][1] * rs, v2 = acc[wi][xi][2] * rs, v3 = acc[wi][xi][3] * rs;
      if (wc_ == 0) {
        uint2 o; o.x = pack2(v0, v1); o.y = pack2(v2, v3);
        *(uint2*)(p.kf + ((size_t)(bl * 8 + nt) * NKEY + j) * 96 + wn) = o;
      } else {
        u16* vp = p.vt + ((size_t)(bl * 8 + nt) * 64 + (wn - 64)) * NKEY + j;
        vp[0] = f2bf(v0); vp[NKEY] = f2bf(v1); vp[2 * NKEY] = f2bf(v2); vp[3 * NKEY] = f2bf(v3);
      }
    }
  }
}

__device__ void phase_qkv(const Params& p, int l, int* ctr) {
  const int MT = RG / 128;
  const int n_scan = NBG * 64, n_q = MT * 6, n_kv = MT * 8;
  run_q8(ctr, QA_CNT(n_scan + n_q + n_kv), [&](int q_, int j_) {
    const int it = QA_ID(q_, j_);
    if (it < n_scan) gla_scan(p, it);
    else if (it < n_scan + n_q) q_tile(p, l, it - n_scan);
    else kv_tile(p, l, it - n_scan - n_q);
  });
}

__device__ __forceinline__ bf16x8 pack8(const f32x16& a, int o) {
  union { bf16x8 v; unsigned u[4]; } r;
  r.u[0] = pack2(a[o + 0], a[o + 1]); r.u[1] = pack2(a[o + 2], a[o + 3]);
  r.u[2] = pack2(a[o + 4], a[o + 5]); r.u[3] = pack2(a[o + 6], a[o + 7]);
  return r.v;
}
__device__ __forceinline__ bf16x8 ld2x8(const u16* p0) {
  union { bf16x8 v; uint2 u[2]; } r;
  r.u[0] = *(const uint2*)p0; r.u[1] = *(const uint2*)(p0 + 8);
  return r.v;
}

__device__ void attn_item(const Params& p, int it) {
  const int tid = TIDX, lane = tid & 63, wid = tid >> 6, l31 = lane & 31, hh = lane >> 5;
  const int qb = it % 66, bh = it / 66, h = bh & 7, bl = bh >> 3;
  const int r0 = qb < 64 ? bl * SEQ + qb * 128 : NBG * SEQ + bl * CTXL + (qb - 64) * 128;
  const int kt0 = qb < 64 ? 0 : 128;
  const int nkt = NCHUNK - kt0;
  constexpr int KROW = 208, VROW = 144, BUFB = 64 * KROW + 64 * VROW;
  bf16x8 qf[6];
  {
    const u16* qp = p.q + (size_t)(r0 + 32 * wid + l31) * 768 + h * 96 + 8 * hh;
#pragma unroll
    for (int s = 0; s < 6; ++s) qf[s] = *(const bf16x8*)(qp + 16 * s);
  }
  const u16* kbase = p.kf + (size_t)bh * NKEY * 96;
  const u16* vbase = p.vt + (size_t)bh * 64 * NKEY;
  uint4 kr0, kr1, kr2, vr0, vr1;
  const int kdst0 = (tid / 12) * KROW + (tid % 12) * 16;
  const int kdst1 = ((tid + 256) / 12) * KROW + ((tid + 256) % 12) * 16;
  const int kdst2 = ((tid + 512) / 12) * KROW + ((tid + 512) % 12) * 16;
  const int vdst0 = 64 * KROW + (tid >> 3) * VROW + (tid & 7) * 16;
  const int vdst1 = vdst0 + 32 * VROW;
  const int vsrc0 = (tid >> 3) * NKEY + (tid & 7) * 8;
  const int vsrc1 = vsrc0 + 32 * NKEY;
  {
    const u16* kp = kbase + (size_t)kt0 * 64 * 96 + tid * 8;
    kr0 = *(const uint4*)(kp); kr1 = *(const uint4*)(kp + 2048); kr2 = *(const uint4*)(kp + 4096);
    vr0 = *(const uint4*)(vbase + vsrc0 + kt0 * 64); vr1 = *(const uint4*)(vbase + vsrc1 + kt0 * 64);
    *(uint4*)(smem + kdst0) = kr0; *(uint4*)(smem + kdst1) = kr1; *(uint4*)(smem + kdst2) = kr2;
    *(uint4*)(smem + vdst0) = vr0; *(uint4*)(smem + vdst1) = vr1;
  }
  __builtin_amdgcn_s_waitcnt(0x0F70);
  __syncthreads();
  f32x16 oacc[2];
#pragma unroll
  for (int e = 0; e < 16; ++e) { oacc[0][e] = 0.f; oacc[1][e] = 0.f; }
  float m_run = 0.f, l_run = 0.f;
  for (int t = 0; t < nkt; ++t) {
    const int cur = t & 1;
    {
      const int tn = kt0 + min(t + 1, nkt - 1);
      const u16* kp = kbase + (size_t)tn * 64 * 96 + tid * 8;
      kr0 = *(const uint4*)(kp); kr1 = *(const uint4*)(kp + 2048); kr2 = *(const uint4*)(kp + 4096);
      vr0 = *(const uint4*)(vbase + vsrc0 + tn * 64); vr1 = *(const uint4*)(vbase + vsrc1 + tn * 64);
    }
    __builtin_amdgcn_sched_barrier(0);
    const char* Kl = smem + cur * BUFB;
    const char* Vl = Kl + 64 * KROW;
    f32x16 sacc[2];
#pragma unroll
    for (int kb = 0; kb < 2; ++kb) {
#pragma unroll
      for (int e = 0; e < 16; ++e) sacc[kb][e] = -m_run;
#pragma unroll
      for (int s = 0; s < 6; ++s) {
        const bf16x8 a = *(const bf16x8*)(Kl + (32 * kb + l31) * KROW + 32 * s + 16 * hh);
        sacc[kb] = __builtin_amdgcn_mfma_f32_32x32x16_bf16(a, qf[s], sacc[kb], 0, 0, 0);
      }
    }
    float mx = sacc[0][0];
#pragma unroll
    for (int e = 1; e < 16; ++e) mx = fmaxf(mx, sacc[0][e]);
#pragma unroll
    for (int e = 0; e < 16; ++e) mx = fmaxf(mx, sacc[1][e]);
    {
      const unsigned mu = __float_as_uint(mx);
      const auto sw = __builtin_amdgcn_permlane32_swap(mu, mu, false, false);
      mx = fmaxf(__uint_as_float(sw[0]), __uint_as_float(sw[1]));
    }
    if (t == 0 || !__all(mx <= 8.f)) {
      const float d = (t == 0) ? mx : fmaxf(mx, 0.f);
      const float alpha = __builtin_amdgcn_exp2f(-d);
      m_run += d;
      l_run *= alpha;
#pragma unroll
      for (int e = 0; e < 16; ++e) { oacc[0][e] *= alpha; oacc[1][e] *= alpha; sacc[0][e] -= d; sacc[1][e] -= d; }
    }
    float ps = 0.f;
#pragma unroll
    for (int kb = 0; kb < 2; ++kb)
#pragma unroll
      for (int e = 0; e < 16; ++e) { const float pv = __builtin_amdgcn_exp2f(sacc[kb][e]); sacc[kb][e] = pv; ps += pv; }
    l_run += ps;
#pragma unroll
    for (int kb = 0; kb < 2; ++kb)
#pragma unroll
      for (int s2 = 0; s2 < 2; ++s2) {
        const bf16x8 pfr = pack8(sacc[kb], 8 * s2);
#pragma unroll
        for (int dt = 0; dt < 2; ++dt) {
          const bf16x8 a = ld2x8((const u16*)(Vl + (32 * dt + l31) * VROW) + 32 * kb + 16 * s2 + 4 * hh);
          oacc[dt] = __builtin_amdgcn_mfma_f32_32x32x16_bf16(a, pfr, oacc[dt], 0, 0, 0);
        }
      }
    __builtin_amdgcn_sched_barrier(0);
    {
      char* nb = smem + (cur ^ 1) * BUFB;
      *(uint4*)(nb + kdst0) = kr0; *(uint4*)(nb + kdst1) = kr1; *(uint4*)(nb + kdst2) = kr2;
      *(uint4*)(nb + vdst0) = vr0; *(uint4*)(nb + vdst1) = vr1;
    }
    __syncthreads();
  }
  l_run += xor_lane<32>(l_run);
  const float inv = 1.f / l_run;
  u16* op = p.h + (size_t)RG * 512 + (size_t)(r0 + 32 * wid + l31) * 512 + h * 64;
#pragma unroll
  for (int dt = 0; dt < 2; ++dt)
#pragma unroll
    for (int gq_ = 0; gq_ < 4; ++gq_) {
      const int dv0 = 32 * dt + 8 * gq_ + 4 * hh;
      uint2 o;
      o.x = pack2(oacc[dt][4 * gq_ + 0] * inv, oacc[dt][4 * gq_ + 1] * inv);
      o.y = pack2(oacc[dt][4 * gq_ + 2] * inv, oacc[dt][4 * gq_ + 3] * inv);
      *(uint2*)(op + dv0) = o;
    }
}

__device__ void gla_out(const Params& p, int l, int it) {
  const int tid = TIDX, lane = tid & 63, wid = tid >> 6, l31 = lane & 31, hh = lane >> 5;
  const int bl = it / (NCHUNK * 4), rem = it % (NCHUNK * 4), cidx = rem >> 2, h = rem & 3;
  const int r0 = chunk_row(bl, cidx, NBG);
  u16* tiles = (u16*)smem;
  u16* vT = (u16*)(smem + 36864);
  float* part = (float*)(smem + 55296);
  {
    const int t = tid >> 2, c16 = (tid & 3) * 16;
#pragma unroll
    for (int a = 0; a < 4; ++a) {
      const u16* src = p.gq + (size_t)a * RG * 256 + (size_t)(r0 + t) * 256 + h * 64 + c16;
      const uint4 u0 = *(const uint4*)src, u1 = *(const uint4*)(src + 8);
      u16* d = tiles + a * 4608 + t * 72 + c16;
      *(uint4*)d = u0; *(uint4*)(d + 8) = u1;
    }
    const int dvc = (tid & 3) * 32;
    const u16* vp = p.proj + (size_t)(r0 + t) * INW + C_VA + h * 128 + dvc;
#pragma unroll
    for (int i = 0; i < 4; ++i) {
      const uint4 vv = *(const uint4*)(vp + i * 8);
      u16* dst = vT + (size_t)(dvc + i * 8) * 72 + t;
      dst[0] = (u16)(vv.x & 0xffff); dst[72] = (u16)(vv.x >> 16);
      dst[144] = (u16)(vv.y & 0xffff); dst[216] = (u16)(vv.y >> 16);
      dst[288] = (u16)(vv.z & 0xffff); dst[360] = (u16)(vv.z >> 16);
      dst[432] = (u16)(vv.w & 0xffff); dst[504] = (u16)(vv.w >> 16);
    }
  }
  const int itl = wid & 1, dvh = wid >> 1;
  const size_t cb = ((size_t)(bl * NCHUNK + cidx) * 4 + h) * 2;
  bf16x8 sfr[2][2][4];
#pragma unroll
  for (int dir = 0; dir < 2; ++dir)
#pragma unroll
    for (int dt = 0; dt < 2; ++dt)
#pragma unroll
      for (int s4 = 0; s4 < 4; ++s4)
        sfr[dir][dt][s4] = *(const bf16x8*)(p.ss + (cb + dir) * 8192 + (64 * dvh + 32 * dt + l31) * 64 + 16 * s4 + 8 * hh);
  __syncthreads();
  f32x16 oacc[2];
#pragma unroll
  for (int e = 0; e < 16; ++e) { oacc[0][e] = 0.f; oacc[1][e] = 0.f; }
#pragma unroll
  for (int dir = 0; dir < 2; ++dir) {
    const u16* Qt = tiles + (dir * 2) * 4608;
    const u16* Kt = tiles + (dir * 2 + 1) * 4608;
    bf16x8 qfr[4];
#pragma unroll
    for (int s = 0; s < 4; ++s) qfr[s] = *(const bf16x8*)(Qt + (32 * itl + l31) * 72 + 16 * s + 8 * hh);
    f32x16 aacc[2];
#pragma unroll
    for (int jt = 0; jt < 2; ++jt) {
#pragma unroll
      for (int e = 0; e < 16; ++e) aacc[jt][e] = 0.f;
#pragma unroll
      for (int s = 0; s < 4; ++s) {
        const bf16x8 a = *(const bf16x8*)(Kt + (32 * jt + l31) * 72 + 16 * s + 8 * hh);
        aacc[jt] = __builtin_amdgcn_mfma_f32_32x32x16_bf16(a, qfr[s], aacc[jt], 0, 0, 0);
      }
      const int i_tok = 32 * itl + l31;
#pragma unroll
      for (int e = 0; e < 16; ++e) {
        const int j_tok = 32 * jt + (e & 3) + 8 * (e >> 2) + 4 * hh;
        const bool keep = dir ? (j_tok >= i_tok) : (j_tok <= i_tok);
        if (!keep) aacc[jt][e] = 0.f;
      }
    }
#pragma unroll
    for (int dt = 0; dt < 2; ++dt) {
      const int dvrow = 64 * dvh + 32 * dt + l31;
#pragma unroll
      for (int jt = 0; jt < 2; ++jt)
#pragma unroll
        for (int s2 = 0; s2 < 2; ++s2) {
          const bf16x8 pfr = pack8(aacc[jt], 8 * s2);
          const bf16x8 a = ld2x8(vT + dvrow * 72 + 32 * jt + 16 * s2 + 4 * hh);
          oacc[dt] = __builtin_amdgcn_mfma_f32_32x32x16_bf16(a, pfr, oacc[dt], 0, 0, 0);
        }
#pragma unroll
      for (int s = 0; s < 4; ++s) {
        oacc[dt] = __builtin_amdgcn_mfma_f32_32x32x16_bf16(sfr[dir][dt][s], qfr[s], oacc[dt], 0, 0, 0);
      }
    }
  }
  float ss = 0.f;
#pragma unroll
  for (int e = 0; e < 16; ++e) ss += oacc[0][e] * oacc[0][e] + oacc[1][e] * oacc[1][e];
  ss += xor_lane<32>(ss);
  if (hh == 0) part[wid * 32 + l31] = ss;
  __syncthreads();
  const float totss = part[wid * 32 + l31] + part[(wid ^ 2) * 32 + l31];
  const float rstd = rsqrtf(totss * (1.f / 128.f) + EPS);
  const int r = r0 + 32 * itl + l31;
  const float* gam = p.in[10] + l * 512 + h * 128;
  u16* aa = p.h;
#pragma unroll
  for (int dt = 0; dt < 2; ++dt)
#pragma unroll
    for (int gq_ = 0; gq_ < 4; ++gq_) {
      const int dv0 = 64 * dvh + 32 * dt + 8 * gq_ + 4 * hh;
      const uint2 ra = *(const uint2*)(p.proj + (size_t)r * INW + C_RA + h * 128 + dv0);
      const float4 g4 = *(const float4*)(gam + dv0);
      uint2 o;
      o.x = pack2(oacc[dt][4 * gq_ + 0] * rstd * g4.x * silu_f(bflo(ra.x)), oacc[dt][4 * gq_ + 1] * rstd * g4.y * silu_f(bfhi(ra.x)));
      o.y = pack2(oacc[dt][4 * gq_ + 2] * rstd * g4.z * silu_f(bflo(ra.y)), oacc[dt][4 * gq_ + 3] * rstd * g4.w * silu_f(bfhi(ra.y)));
      *(uint2*)(aa + (size_t)r * 512 + h * 128 + dv0) = o;
    }
}

__device__ void phase_attn(const Params& p, int l, int* ctr) {
  const int nqb = (l == 1) ? 64 : 66, nck = (l == 1) ? 128 : NCHUNK;
  const int per_q = NBG * nqb;
  const int n_gla = NBG * nck * 4;
  run_q8(ctr, [=](int q_) { return per_q + ((n_gla - q_ + 7) >> 3); }, [&](int q_, int j_) {
    if (j_ < per_q) attn_item(p, ((j_ / nqb) * 8 + q_) * 66 + (j_ % nqb));
    else {
      const int gi = QA_ID(q_, j_ - per_q);
      gla_out(p, l, (gi / (nck * 4)) * (NCHUNK * 4) + gi % (nck * 4));
    }
  });
}

__device__ void phase_merge(const Params& p, int l, int* ctr) {
  const int MT = (l == 1 ? NBG * SEQ / 128 : RG / 128), NT = 16;
  const u16* wl = p.wt + (size_t)l * W_LAYER;
  run_q8(ctr, GEMM_CNT(MT, NT), [&](int q_, int j_) {
    int mt, nt; tile_order(j_, mlo(q_ + 1, MT) - mlo(q_, MT), NT, mt, nt); mt += mlo(q_, MT);
    const int tid = TIDX, lane = tid & 63, wid = tid >> 6;
    const int wr = wid >> 1, wc = wid & 1, fr = lane & 15, fq = lane >> 4;
    f32x4 macc[2][4], acc[2][4];
#pragma unroll
    for (int a = 0; a < 2; ++a)
#pragma unroll
      for (int b = 0; b < 4; ++b) { macc[a][b] = f32x4{0.f, 0.f, 0.f, 0.f}; acc[a][b] = f32x4{0.f, 0.f, 0.f, 0.f}; }
    const int srow = tid >> 3, schunk = (tid & 7) ^ ((tid >> 4) & 7);
    const size_t xo = (size_t)(mt * 128 + srow) * 512 + schunk * 8;
    const size_t wo = (size_t)(nt * 64 + srow) * 512 + schunk * 8;
    const u16* xg0 = p.h + xo;
    const u16* xg1 = p.h + (size_t)RG * 512 + xo;
    const u16* xg2 = p.uc + xo;
    const u16* wg0 = wl + W_BRA + wo;
    const u16* wg1 = wl + W_BRB + wo;
    const u16* wg2 = wl + W_BRC + wo;
    const int g = fr >> 1;
    const int lo0 = fr * 128 + ((fq ^ g) << 4), lo1 = fr * 128 + (((fq ^ g) ^ 4) << 4);
    const char* xb = smem + wr * 8192;
    const char* wb = smem + 16384 + wc * 4096;
    char* sdst = smem + tid * 16;
    const u16* gbase = p.proj + (size_t)(mt * 128 + wr * 64 + fr) * INW + C_GATE + nt * 64 + wc * 32 + fq * 4;
    uint2 gts[2][4];
#pragma unroll
    for (int wi = 0; wi < 2; ++wi)
#pragma unroll
      for (int xi = 0; xi < 4; ++xi) gts[wi][xi] = *(const uint2*)(gbase + (size_t)xi * 16 * INW + wi * 16);
    __syncthreads();
#pragma unroll
    for (int i = 0; i < 4; ++i) {
      glds16(xg0 + i * (32 * 512), sdst + i * 4096);
      if (i < 2) glds16(wg0 + i * (32 * 512), sdst + 16384 + i * 4096);
    }
    for (int kt = 0; kt < 24; ++kt) {
      asm volatile("s_waitcnt vmcnt(0)" ::: "memory");
      __syncthreads();
      const int cb = (kt & 1) * 32768;
      if (kt + 1 < 24) {
        const int nbr = (kt + 1) >> 3, ko = ((kt + 1) & 7) * 64, nb = 32768 - cb;
        const u16* xg = (nbr == 0 ? xg0 : nbr == 1 ? xg1 : xg2) + ko;
        const u16* wg = (nbr == 0 ? wg0 : nbr == 1 ? wg1 : wg2) + ko;
#pragma unroll
        for (int i = 0; i < 4; ++i) {
          glds16(xg + i * (32 * 512), sdst + nb + i * 4096);
          if (i < 2) glds16(wg + i * (32 * 512), sdst + nb + 16384 + i * 4096);
        }
      }
      bf16x8 wf[2][2], xf[2][4];
#pragma unroll
      for (int i = 0; i < 2; ++i) {
        wf[0][i] = *(const bf16x8*)(wb + cb + i * 2048 + lo0);
        wf[1][i] = *(const bf16x8*)(wb + cb + i * 2048 + lo1);
      }
#pragma unroll
      for (int i = 0; i < 4; ++i) {
        xf[0][i] = *(const bf16x8*)(xb + cb + i * 2048 + lo0);
        xf[1][i] = *(const bf16x8*)(xb + cb + i * 2048 + lo1);
      }
      __builtin_amdgcn_sched_barrier(0);
#pragma unroll
      for (int k = 0; k < 2; ++k)
#pragma unroll
        for (int wi = 0; wi < 2; ++wi)
#pragma unroll
          for (int xi = 0; xi < 4; ++xi)
            acc[wi][xi] = __builtin_amdgcn_mfma_f32_16x16x32_bf16(wf[k][wi], xf[k][xi], acc[wi][xi], 0, 0, 0);
      __builtin_amdgcn_sched_barrier(0);
      if ((kt & 7) == 7) {
        const int br = kt >> 3;
#pragma unroll
        for (int wi = 0; wi < 2; ++wi)
#pragma unroll
          for (int xi = 0; xi < 4; ++xi) {
            const uint2 gt = gts[wi][xi];
            macc[wi][xi][0] += sigmoid_f(bflo(gt.x)) * acc[wi][xi][0];
            macc[wi][xi][1] += sigmoid_f(bfhi(gt.x)) * acc[wi][xi][1];
            macc[wi][xi][2] += sigmoid_f(bflo(gt.y)) * acc[wi][xi][2];
            macc[wi][xi][3] += sigmoid_f(bfhi(gt.y)) * acc[wi][xi][3];
            acc[wi][xi] = f32x4{0.f, 0.f, 0.f, 0.f};
            if (br < 2) gts[wi][xi] = *(const uint2*)(gbase + (size_t)xi * 16 * INW + wi * 16 + (br + 1) * 1024);
          }
      }
    }
    uint2 o[2][4];
#pragma unroll
    for (int wi = 0; wi < 2; ++wi)
#pragma unroll
      for (int xi = 0; xi < 4; ++xi) {
        o[wi][xi].x = pack2(macc[wi][xi][0], macc[wi][xi][1]); o[wi][xi].y = pack2(macc[wi][xi][2], macc[wi][xi][3]);
      }
    store_tile_bf16<2>(o, p.m + (size_t)(mt * 128 + wr * 64) * DM + nt * 64 + wc * 32, DM);
  });
}

__device__ void phase_resid(const Params& p, int l, int g, int which, int* ctr) {
  const int MT = (l == 1 ? NBG * SEQ / 128 : RG / 128), NT = 8;
  const u16* wl = p.wt + (size_t)l * W_LAYER;
  const u16* X = which == 0 ? p.m : p.proj + (size_t)RG * DFF;
  const int ldx = which == 0 ? DM : DFF, K = which == 0 ? DM : DFF;
  const u16* W = wl + (which == 0 ? W_O : W_DN);
  const int goff = which == 0 ? 2048 : 5120;
  const int from_input = (which == 0 && l == 0);
  run_q8(ctr, GEMM_CNT(MT, NT), [&](int q_, int j_) {
    int mt, nt; tile_order(j_, mlo(q_ + 1, MT) - mlo(q_, MT), NT, mt, nt); mt += mlo(q_, MT);
    f32x4 acc[4][4];
    gemm_core<4>(X + (size_t)mt * 128 * ldx, ldx, W + (size_t)nt * 128 * K, K, K, acc);
    EPI_VARS
    const float* mrow = p.mod + ((size_t)l * 9 + mod_index(p, g, mt * 128)) * 6144 + goff + nt * 128 + wc_ * 64;
    __syncthreads();
    char* lb = smem + wid_ * 16384;
#pragma unroll
    for (int wi = 0; wi < 4; ++wi)
#pragma unroll
      for (int xi = 0; xi < 4; ++xi) {
        const int r = xi * 16 + fr_, c = wi * 4 + fq_;
        *(f32x4*)(lb + r * 256 + ((c ^ (r & 15)) << 4)) = acc[wi][xi];
      }
    const int c16 = lane_ & 15, rsub = lane_ >> 4;
    const float* xs = xsrc_row_ptr(p, g, mt * 128 + wr_ * 64, from_input) + nt * 128 + wc_ * 64 + c16 * 4;
    float* xd = xrow_ptr(p, g, mt * 128 + wr_ * 64) + nt * 128 + wc_ * 64 + c16 * 4;
    const float4 gv = *(const float4*)(mrow + c16 * 4);
#pragma unroll
    for (int half = 0; half < 2; ++half) {
      float4 xv[8];
#pragma unroll
      for (int it = 0; it < 8; ++it) xv[it] = *(const float4*)(xs + (size_t)((half * 8 + it) * 4 + rsub) * DM);
#pragma unroll
      for (int it = 0; it < 8; ++it) {
        const int row = (half * 8 + it) * 4 + rsub;
        const f32x4 a = *(const f32x4*)(lb + row * 256 + ((c16 ^ (row & 15)) << 4));
        float4 o;
        o.x = xv[it].x + gv.x * a[0]; o.y = xv[it].y + gv.y * a[1]; o.z = xv[it].z + gv.z * a[2]; o.w = xv[it].w + gv.w * a[3];
        *(float4*)(xd + (size_t)row * DM) = o;
      }
    }
  });
}

__device__ void phase_gu(const Params& p, int l, int* ctr) {
  const int MT = (l == 1 ? NBG * SEQ / 128 : RG / 128), NT = 44;
  const u16* W = p.wt + (size_t)l * W_LAYER + W_GU;
  run_q8(ctr, GEMM_CNT(MT, NT), [&](int q_, int j_) {
    int mt, nt; tile_order(j_, mlo(q_ + 1, MT) - mlo(q_, MT), NT, mt, nt); mt += mlo(q_, MT);
    f32x4 acc[4][4];
    gemm_core<4>(p.h + (size_t)mt * 128 * DM, DM, W + (size_t)nt * 128 * DM, DM, DM, acc);
    EPI_VARS
    u16* dst = p.proj + (nt >= 22 ? (size_t)RG * DFF : 0);
    const int nb = (nt >= 22 ? nt - 22 : nt) * 128;
    uint2 o[4][4];
#pragma unroll
    for (int wi = 0; wi < 4; ++wi)
#pragma unroll
      for (int xi = 0; xi < 4; ++xi) {
        o[wi][xi].x = pack2(acc[wi][xi][0], acc[wi][xi][1]); o[wi][xi].y = pack2(acc[wi][xi][2], acc[wi][xi][3]);
      }
    store_tile_bf16<4>(o, dst + (size_t)(mt * 128 + wr_ * 64) * DFF + nb + wc_ * 64, DFF);
  });
}

struct ActIn { uint4 g0, g1, g2, uu; float4 w0a, w0b, w1a, w1b, w2a, w2b, ba, bb; };
__device__ __forceinline__ void act_load(ActIn& a, const u16* G, const u16* UP, const float* cw, const float* cb, int r, int c0) {
  int bl, pos, isctx; rowinfo(r, NBG, bl, pos, isctx);
  const int L = isctx ? CTXL : SEQ;
  const u16* gp = G + (size_t)r * DFF + c0;
  a.g1 = *(const uint4*)gp;
  a.g0 = make_uint4(0, 0, 0, 0); a.g2 = a.g0;
  if (pos > 0) a.g0 = *(const uint4*)(gp - DFF);
  if (pos < L - 1) a.g2 = *(const uint4*)(gp + DFF);
  a.uu = *(const uint4*)(UP + (size_t)r * DFF + c0);
  a.w0a = *(const float4*)(cw + c0); a.w0b = *(const float4*)(cw + c0 + 4);
  a.w1a = *(const float4*)(cw + DFF + c0); a.w1b = *(const float4*)(cw + DFF + c0 + 4);
  a.w2a = *(const float4*)(cw + 2 * DFF + c0); a.w2b = *(const float4*)(cw + 2 * DFF + c0 + 4);
  a.ba = *(const float4*)(cb + c0); a.bb = *(const float4*)(cb + c0 + 4);
}
__device__ __forceinline__ uint4 act_compute(const ActIn& a) {
  uint4 o;
#define ACT2(G0, G1, G2, UU, W0L, W0H, W1L, W1H, W2L, W2H, BL, BH) \
  pack2(silu_f(W0L * bflo(G0) + W1L * bflo(G1) + W2L * bflo(G2) + BL) * bflo(UU), \
        silu_f(W0H * bfhi(G0) + W1H * bfhi(G1) + W2H * bfhi(G2) + BH) * bfhi(UU))
  o.x = ACT2(a.g0.x, a.g1.x, a.g2.x, a.uu.x, a.w0a.x, a.w0a.y, a.w1a.x, a.w1a.y, a.w2a.x, a.w2a.y, a.ba.x, a.ba.y);
  o.y = ACT2(a.g0.y, a.g1.y, a.g2.y, a.uu.y, a.w0a.z, a.w0a.w, a.w1a.z, a.w1a.w, a.w2a.z, a.w2a.w, a.ba.z, a.ba.w);
  o.z = ACT2(a.g0.z, a.g1.z, a.g2.z, a.uu.z, a.w0b.x, a.w0b.y, a.w1b.x, a.w1b.y, a.w2b.x, a.w2b.y, a.bb.x, a.bb.y);
  o.w = ACT2(a.g0.w, a.g1.w, a.g2.w, a.uu.w, a.w0b.z, a.w0b.w, a.w1b.z, a.w1b.w, a.w2b.z, a.w2b.w, a.bb.z, a.bb.w);
#undef ACT2
  return o;
}

__device__ void phase_act(const Params& p, int l, int* ctr) {
  const int nitems = (l == 1) ? NBG * SEQ / 8 : RG / 8;
  const float* cw = p.in[23] + (size_t)l * 3 * DFF;
  const float* cb = p.in[24] + (size_t)l * DFF;
  const u16* G = p.proj;
  u16* UP = p.proj + (size_t)RG * DFF;
  for (int it = blockIdx.x; it < nitems; it += gridDim.x) {
    const int tid = TIDX;
    for (int k = 0; k < 12; k += 2) {
      const int e0 = tid + k * 256, e1 = e0 + 256;
      const bool two = (k + 1 < 11);
      const int r0 = it * 8 + e0 / 352, c00 = (e0 % 352) * 8;
      const int r1 = it * 8 + (two ? e1 / 352 : 0), c01 = two ? (e1 % 352) * 8 : 0;
      ActIn a0, a1;
      act_load(a0, G, UP, cw, cb, r0, c00);
      act_load(a1, G, UP, cw, cb, r1, c01);
      const uint4 o0 = act_compute(a0), o1 = act_compute(a1);
      st_nt(UP + (size_t)r0 * DFF + c00, o0);
      if (two) st_nt(UP + (size_t)r1 * DFF + c01, o1);
    }
  }
}

__device__ void phase_final(const Params& p, int* ctr) {
  const int nitems = NBATCH * SEQ / 16;
  const float* gam = p.in[26];
  for (int it = blockIdx.x; it < nitems; it += gridDim.x) {
    const int lane = TIDX & 63, wid = TIDX >> 6;
    float* xr = p.out + ((size_t)it * 16 + wid * 4) * DM;
    float4 v[4][4], gg[4];
#pragma unroll
    for (int rr = 0; rr < 4; ++rr)
#pragma unroll
      for (int i = 0; i < 4; ++i) v[rr][i] = *(const float4*)(xr + (size_t)rr * DM + lane * 4 + i * 256);
#pragma unroll
    for (int i = 0; i < 4; ++i) gg[i] = *(const float4*)(gam + lane * 4 + i * 256);
#pragma unroll
    for (int rr = 0; rr < 4; ++rr) {
      float ss = 0.f;
#pragma unroll
      for (int i = 0; i < 4; ++i)
        ss += v[rr][i].x * v[rr][i].x + v[rr][i].y * v[rr][i].y + v[rr][i].z * v[rr][i].z + v[rr][i].w * v[rr][i].w;
      ss = wave_sum(ss);
      const float rstd = rsqrtf(ss * (1.f / 1024.f) + EPS);
#pragma unroll
      for (int i = 0; i < 4; ++i) {
        float4 o; o.x = v[rr][i].x * rstd * gg[i].x; o.y = v[rr][i].y * rstd * gg[i].y; o.z = v[rr][i].z * rstd * gg[i].z; o.w = v[rr][i].w * rstd * gg[i].w;
        st_nt(xr + (size_t)rr * DM + lane * 4 + i * 256, o);
      }
    }
  }
}

#define XB_TMO      128
#define XB_XCNT(j)  (256  + 64 * (j))
#define XB_XSUB(j)  (1280 + 64 * (j))
#define XB_XGEN(j)  (2304 + 64 * (j))
#define XB_TOP      3328
#define XB_TOPGEN   3392
#define XCD_BAR_WORDS 3456
#define XB_SPIN_CAP (1u << 22)
#define LAS __attribute__((address_space(3)))
__device__ __forceinline__ unsigned xb_ld(unsigned* p)              { return __hip_atomic_load(p, __ATOMIC_RELAXED, __HIP_MEMORY_SCOPE_AGENT); }
__device__ __forceinline__ unsigned xb_add(unsigned* p, unsigned v) { return __hip_atomic_fetch_add(p, v, __ATOMIC_RELAXED, __HIP_MEMORY_SCOPE_AGENT); }
__device__ __forceinline__ unsigned xb_xcc_id() { return (unsigned)__builtin_amdgcn_s_getreg((3 << 11) | 20) & 0xFu; }
#define XB_SPIN(cond, bar) do { unsigned _sp = 0; while (cond) { __builtin_amdgcn_s_sleep(1); \
    if ((++_sp & 255u) == 0u) { if (xb_ld(&(bar)[XB_TMO])) break; if (_sp > XB_SPIN_CAP) { atomicAdd(&(bar)[XB_TMO], 1u); break; } } } } while (0)
struct XcdBarrier { unsigned* bar; unsigned x; volatile LAS unsigned* st; };
__device__ __forceinline__ XcdBarrier xcd_barrier_post(unsigned* bar, volatile LAS unsigned* st) {
  XcdBarrier b; b.bar = bar; b.x = xb_xcc_id(); b.st = st;
  if (threadIdx.x == 0) (void)xb_add(&bar[XB_XCNT(b.x)], 1u);
  return b;
}
__device__ __forceinline__ void xcd_barrier_complete(unsigned* bar, unsigned x, unsigned& nloc, unsigned& nx) {
  const unsigned G = gridDim.x * gridDim.y * gridDim.z;
  unsigned sum, cnt, mine, sp = 0u;
  for (;;) {
    sum = 0u; cnt = 0u; mine = 0u;
#pragma unroll
    for (unsigned j = 0; j < 16; ++j) { const unsigned c = xb_ld(&bar[XB_XCNT(j)]); sum += c; cnt += (c > 0u) ? 1u : 0u; mine = (j == x) ? c : mine; }
    if (sum == G) break;
    __builtin_amdgcn_s_sleep(1);
    if ((++sp & 255u) == 0u) { if (xb_ld(&bar[XB_TMO])) break; if (sp > XB_SPIN_CAP) { atomicAdd(&bar[XB_TMO], 1u); break; } }
  }
  nloc = mine > 0u ? mine : 1u; nx = cnt > 0u ? cnt : 1u;
}
__device__ __forceinline__ void xcd_barrier(const XcdBarrier& b) {
  asm volatile("s_waitcnt vmcnt(0)" ::: "memory");
  __syncthreads();
  if (threadIdx.x == 0) {
    unsigned* bar = b.bar;
    __builtin_amdgcn_s_waitcnt(0);
    unsigned nloc = b.st[0], nx = b.st[1];
    if (nloc == 0u) { xcd_barrier_complete(bar, b.x, nloc, nx); b.st[0] = nloc; b.st[1] = nx; }
    const unsigned old = xb_add(&bar[XB_XSUB(b.x)], 1u);
    const unsigned gen = old / nloc;
    if (old + 1u == (gen + 1u) * nloc) {
      __builtin_amdgcn_fence(__ATOMIC_RELEASE, "agent");
      asm volatile("s_waitcnt vmcnt(0)" ::: "memory");
      const unsigned og = xb_add(&bar[XB_TOP], 1u);
      const unsigned tg = og / nx;
      if (og + 1u == (tg + 1u) * nx) xb_add(&bar[XB_TOPGEN], 1u);
      else XB_SPIN(xb_ld(&bar[XB_TOPGEN]) == tg, bar);
      __builtin_amdgcn_fence(__ATOMIC_ACQUIRE, "agent");
      xb_add(&bar[XB_XGEN(b.x)], 1u);
      asm volatile("s_waitcnt vmcnt(0)" ::: "memory");
    } else {
      XB_SPIN(xb_ld(&bar[XB_XGEN(b.x)]) == gen, bar);
      __builtin_amdgcn_fence(__ATOMIC_ACQUIRE, "agent");
      asm volatile("s_waitcnt vmcnt(0)" ::: "memory");
    }
  }
  __syncthreads();
}

__device__ void run_phase(const Params& p, int ph, int* ctr) {
  if (ph == 0) { phase0(p, ctr); return; }
  if (ph == NPHASES - 1) { phase_final(p, ctr); return; }
  const int idx = ph - 1, lg = idx / NPH_PER, sub = idx % NPH_PER;
  const int g = lg / 2, l = lg % 2;
  switch (sub) {
    case 0: phase_norm(p, l, g, 0, ctr); break;
    case 1: phase_proj(p, l, ctr); break;
    case 2: phase_postproj(p, l, ctr); break;
    case 3: phase_qkv(p, l, ctr); break;
    case 4: phase_attn(p, l, ctr); break;
    case 5: phase_merge(p, l, ctr); break;
    case 6: phase_resid(p, l, g, 0, ctr); break;
    case 7: phase_norm(p, l, g, 1, ctr); break;
    case 8: phase_gu(p, l, ctr); break;
    case 9: phase_act(p, l, ctr); break;
    default: phase_resid(p, l, g, 1, ctr); break;
  }
}

__global__ void __launch_bounds__(256, 2) mega_kernel(KArgs ka, int ph_lo, int ph_hi, int coop) {
  Params p;
#pragma unroll
  for (int i = 0; i < 27; ++i) p.in[i] = ka.in[i];
  p.out = ka.out;
  char* ws = ka.ws;
  p.ctr = (int*)(ws + O_CTR); p.mod = (float*)(ws + O_MOD); p.rope = (float*)(ws + O_ROPE); p.xc = (float*)(ws + O_XC);
  p.rstdq = (float*)(ws + O_RSQ); p.rstdkv = (float*)(ws + O_RSKV); p.dec = (float*)(ws + O_DEC); p.wt = (u16*)(ws + O_WT);
  p.proj = (u16*)(ws + O_PROJ); p.h = (u16*)(ws + O_H); p.m = (u16*)(ws + O_M); p.q = (u16*)(ws + O_Q);
  p.kf = (u16*)(ws + O_KF); p.vt = (u16*)(ws + O_VT); p.uc = (u16*)(ws + O_UC); p.gq = (u16*)(ws + O_GQ);
  p.ss = (u16*)(ws + O_SS);
  volatile LAS unsigned* st = (volatile LAS unsigned*)(smem + SLOT_OFF + 64);
  if (threadIdx.x == 0) { st[0] = 0u; st[1] = 0u; }
  __syncthreads();
  XcdBarrier xb;
  xb.bar = (unsigned*)(ws + O_BAR); xb.x = 0; xb.st = st;
  if (coop) xb = xcd_barrier_post((unsigned*)(ws + O_BAR), st);
  for (int ph = ph_lo; ph < ph_hi; ++ph) {
#ifdef PROBE_MASK
    const int nrep = (ph > 0 && ph < NPHASES - 1 && ((PROBE_MASK >> ((ph - 1) % NPH_PER)) & 1)) ? 2 : 1;
#else
    const int nrep = 1;
#endif
    for (int rep = 0; rep < nrep; ++rep) {
      if (rep) xcd_barrier(xb);
      run_phase(p, ph, p.ctr + rep * 512 + ph * 8);
    }
    if (coop && ph + 1 < ph_hi) {
      if (ph == ph_lo) cg::this_grid().sync();
      else xcd_barrier(xb);
    }
  }
}

static inline size_t align_up(size_t v) { return (v + 255) & ~(size_t)255; }

extern "C" void kernel_launch(void* const* d_in, const int* in_sizes, int n_in, void* d_out, int out_size,
                              void* d_ws, size_t ws_size, hipStream_t stream) {
  static int grid_blocks = 0;
  if (!grid_blocks) {
    int dev = 0, cus = 0, per_cu = 0;
    hipGetDevice(&dev);
    hipDeviceGetAttribute(&cus, hipDeviceAttributeMultiprocessorCount, dev);
    hipFuncSetAttribute((const void*)mega_kernel, hipFuncAttributeMaxDynamicSharedMemorySize, LDS_BYTES);
    hipOccupancyMaxActiveBlocksPerMultiprocessor(&per_cu, (const void*)mega_kernel, 256, LDS_BYTES);
    if (per_cu < 1) per_cu = 1;
    if (per_cu > 2) per_cu = 2;
    grid_blocks = cus * per_cu;
  }
  KArgs p{};
  for (int i = 0; i < 27; ++i) p.in[i] = (const float*)d_in[i];
  p.out = (float*)d_out;
  p.ws = (char*)d_ws;
  if (ws_size < WS_END) { fprintf(stderr, "workspace too small: %zu < %zu\n", ws_size, (size_t)WS_END); return; }
  hipMemsetAsync((char*)d_ws + O_CTR, 0, 4096 + XCD_BAR_BYTES, stream);
#if SINGLE_LAUNCH
  int lo = 0, hi = NPHASES, coop = 1;
  void* args[] = {&p, &lo, &hi, &coop};
  hipError_t e = hipLaunchCooperativeKernel((const void*)mega_kernel, dim3(grid_blocks), dim3(256), args, LDS_BYTES, stream);
  if (e != hipSuccess) fprintf(stderr, "cooperative launch failed: %s (grid %d)\n", hipGetErrorString(e), grid_blocks);
#else
  for (int ph = 0; ph < NPHASES; ++ph)
    hipLaunchKernelGGL(mega_kernel, dim3(grid_blocks), dim3(256), LDS_BYTES, stream, p, ph, ph + 1, 0);
#endif
}
```

```cpp
#include <hip/hip_runtime.h>
#include <hip/hip_cooperative_groups.h>
#include <cstdio>
#include <cstdint>
namespace cg = cooperative_groups;

typedef unsigned short u16;
typedef __attribute__((ext_vector_type(8))) short bf16x8;
typedef __attribute__((ext_vector_type(4))) float f32x4;
typedef __attribute__((ext_vector_type(16))) float f32x16;

#ifndef SINGLE_LAUNCH
#define SINGLE_LAUNCH 1
#endif

constexpr int DM = 1024, SEQ = 8192, CTXL = 256, NBATCH = 8, INW = 6592, INWP = 6656, DFF = 2816;
constexpr int C_QA = 0, C_KA = 256, C_VA = 512, C_RA = 1024, C_ALR = 1536, C_CQ = 1568, C_CKV = 1824,
              C_KR = 1952, C_SB = 1984, C_SC = 2496, C_SX = 3008, C_GATE = 3520;
constexpr int NKEY = SEQ + CTXL;
constexpr int NCHUNK = NKEY / 64;
constexpr float EPS = 1e-6f;
constexpr int LDS_BYTES = 65536 + 256;
constexpr int SLOT_OFF = 65536;
constexpr int NPH_PER = 11;
constexpr int NBG = 4;
constexpr int NGRP = NBATCH / NBG;
constexpr int RG = NBG * (SEQ + CTXL);
constexpr int NPHASES = 1 + 2 * NGRP * NPH_PER + 1;

constexpr size_t W_IN = 0;
constexpr size_t W_UQ = W_IN + (size_t)INWP * 1024;
constexpr size_t W_UKV = W_UQ + 768 * 256;
constexpr size_t W_BRA = W_UKV + 1024 * 128;
constexpr size_t W_BRB = W_BRA + 1024 * 512;
constexpr size_t W_BRC = W_BRB + 1024 * 512;
constexpr size_t W_O = W_BRC + 1024 * 512;
constexpr size_t W_GU = W_O + 1024 * 1024;
constexpr size_t W_DN = W_GU + (size_t)5632 * 1024;
constexpr size_t W_LAYER = W_DN + (size_t)1024 * 2816;

struct KArgs {
  const float* in[27];
  float* out;
  char* ws;
};
struct Params {
  const float* in[27];
  float* out;
  float* xc;
  u16* wt;
  float* mod;
  float* rope;
  int* ctr;
  float* rstdq;
  float* rstdkv;
  float* dec;
  u16* proj;
  u16* h;
  u16* m;
  u16* q;
  u16* kf;
  u16* vt;
  u16* uc;
  u16* gq;
  u16* ss;
};
constexpr size_t al256(size_t v) { return (v + 255) & ~(size_t)255; }
constexpr size_t XCD_BAR_BYTES = 3456 * 4;
constexpr size_t O_CTR = 0;
constexpr size_t O_BAR = O_CTR + 4096;
constexpr size_t O_MOD = al256(O_BAR + XCD_BAR_BYTES);
constexpr size_t O_ROPE = al256(O_MOD + (size_t)2 * 9 * 6144 * 4);
constexpr size_t O_XC = al256(O_ROPE + 1024 * 2 * 4);
constexpr size_t O_RSQ = al256(O_XC + (size_t)NBATCH * CTXL * DM * 4);
constexpr size_t O_RSKV = al256(O_RSQ + (size_t)RG * 4);
constexpr size_t O_DEC = al256(O_RSKV + (size_t)RG * 4);
constexpr size_t O_WT = al256(O_DEC + (size_t)NBG * NCHUNK * 4 * 2 * 64 * 4);
constexpr size_t O_PROJ = al256(O_WT + 2 * W_LAYER * 2);
constexpr size_t O_H = al256(O_PROJ + (size_t)RG * INW * 2);
constexpr size_t O_M = O_H + (size_t)RG * DM * 2;
constexpr size_t O_Q = al256(O_M + (size_t)RG * DM * 2);
constexpr size_t O_KF = al256(O_Q + (size_t)RG * 768 * 2);
constexpr size_t O_VT = al256(O_KF + (size_t)NBG * 8 * NKEY * 96 * 2);
constexpr size_t O_UC = al256(O_VT + (size_t)NBG * 8 * 64 * NKEY * 2);
constexpr size_t O_GQ = al256(O_UC + (size_t)RG * 512 * 2);
constexpr size_t O_SS = al256(O_GQ + (size_t)RG * 1024 * 2);
constexpr size_t WS_END = al256(O_SS + (size_t)NBG * NCHUNK * 4 * 2 * 8192 * 2);
static_assert(WS_END <= ((size_t)1 << 30), "workspace layout must fit 1 GiB");

extern __shared__ __attribute__((aligned(16))) char smem[];

typedef __bf16 hbf2 __attribute__((ext_vector_type(2)));
typedef float hf2 __attribute__((ext_vector_type(2)));
__device__ __forceinline__ unsigned pack2(float a, float b) {
  hf2 v = {a, b};
  return __builtin_bit_cast(unsigned, __builtin_convertvector(v, hbf2));
}
__device__ __forceinline__ u16 f2bf(float f) { return (u16)(pack2(f, 0.f) & 0xffffu); }
__device__ __forceinline__ float bf2f(u16 h) { return __uint_as_float(((unsigned)h) << 16); }
__device__ __forceinline__ float bflo(unsigned u) { return __uint_as_float(u << 16); }
__device__ __forceinline__ float bfhi(unsigned u) { return __uint_as_float(u & 0xffff0000u); }
typedef unsigned nt_u32x4 __attribute__((ext_vector_type(4)));
typedef unsigned nt_u32x2 __attribute__((ext_vector_type(2)));
__device__ __forceinline__ void st_nt(void* p, uint4 v) { nt_u32x4 t = {v.x, v.y, v.z, v.w}; __builtin_nontemporal_store(t, (nt_u32x4*)p); }
__device__ __forceinline__ void st_nt(void* p, uint2 v) { nt_u32x2 t = {v.x, v.y}; __builtin_nontemporal_store(t, (nt_u32x2*)p); }
__device__ __forceinline__ void st_nt(void* p, float4 v) { f32x4 t = {v.x, v.y, v.z, v.w}; __builtin_nontemporal_store(t, (f32x4*)p); }
__device__ __forceinline__ float silu_f(float x) { return x / (1.f + __expf(-x)); }
__device__ __forceinline__ float sigmoid_f(float x) { return 1.f / (1.f + __expf(-x)); }

__device__ __forceinline__ void rowinfo(int r, int NB, int& bl, int& pos, int& isctx) {
  const int nl = NB * SEQ;
  if (r < nl) { bl = r >> 13; pos = r & (SEQ - 1); isctx = 0; }
  else { const int rc = r - nl; bl = rc >> 8; pos = rc & (CTXL - 1); isctx = 1; }
}
__device__ __forceinline__ int chunk_row(int bl, int cidx, int NB) {
  return cidx < 128 ? bl * SEQ + cidx * 64 : NB * SEQ + bl * CTXL + (cidx - 128) * 64;
}

template <class CntF, class BodyF>
__device__ __forceinline__ void run_q8(int* ctr8, CntF cntf, BodyF body) {
  volatile int* slot = (volatile int*)(smem + SLOT_OFF);
  int q = blockIdx.x & 7, tries = 0, item;
  __syncthreads();
  if (threadIdx.x == 0) {
    int v = atomicAdd(&ctr8[q], 1);
    while (v >= cntf(q) && tries < 8) { q = (q + 1) & 7; ++tries; if (tries < 8) v = atomicAdd(&ctr8[q], 1); }
    slot[0] = (tries < 8) ? v : -1; slot[1] = q; slot[2] = tries;
  }
  __syncthreads();
  item = slot[0]; q = slot[1]; tries = slot[2];
  while (item >= 0) {
    int nxt = 0;
    if (threadIdx.x == 0) nxt = atomicAdd(&ctr8[q], 1);
    body(q, item);
    __syncthreads();
    if (threadIdx.x == 0) {
      int qq = q, t = tries;
      while (nxt >= cntf(qq) && t < 8) { qq = (qq + 1) & 7; ++t; if (t < 8) nxt = atomicAdd(&ctr8[qq], 1); }
      slot[0] = (t < 8) ? nxt : -1; slot[1] = qq; slot[2] = t;
    }
    __syncthreads();
    item = slot[0]; q = slot[1]; tries = slot[2];
  }
}
#define QA_CNT(N) [=](int q_) { return ((N) - q_ + 7) >> 3; }
#define QA_ID(q_, j_) ((j_) * 8 + (q_))

__device__ __forceinline__ int opaque_tid() {
  int t = threadIdx.x;
  asm volatile("" : "+v"(t));
  return t;
}
#define TIDX opaque_tid()
template <int M>
__device__ __forceinline__ float xor_lane(float v) {
  if constexpr (M == 32) {
    const unsigned u = __float_as_uint(v);
    const auto sw = __builtin_amdgcn_permlane32_swap(u, u, false, false);
    const int lane = __builtin_amdgcn_mbcnt_hi(~0u, __builtin_amdgcn_mbcnt_lo(~0u, 0u));
    return __uint_as_float(lane < 32 ? sw[1] : sw[0]);
  } else {
    return __uint_as_float((unsigned)__builtin_amdgcn_ds_swizzle((int)__float_as_uint(v), 0x1f | (M << 10)));
  }
}
__device__ __forceinline__ float wave_sum(float v) {
  v += xor_lane<32>(v); v += xor_lane<16>(v); v += xor_lane<8>(v);
  v += xor_lane<4>(v); v += xor_lane<2>(v); v += xor_lane<1>(v);
  return v;
}

__device__ __forceinline__ int lds_byte(int r, int c) {
  const int st = (r >> 4) * 2 + (c >> 5), rr = r & 15, cc = c & 31, ob = rr * 64 + cc * 2;
  return st * 1024 + (ob ^ (((ob >> 9) & 1) << 5));
}
__device__ __forceinline__ void stage_rc(int b, int& R, int& C) {
  const int st = b >> 10, sb = b & 1023, swz = sb ^ (((sb >> 9) & 1) << 5);
  R = (st >> 1) * 16 + (swz >> 6); C = (st & 1) * 32 + ((swz & 63) >> 1);
}

__device__ __forceinline__ void glds16(const void* g, void* l) {
  __builtin_amdgcn_global_load_lds((const __attribute__((address_space(1))) unsigned*)g,
                                   (__attribute__((address_space(3))) unsigned*)l, 16, 0, 0);
}

template <int NWI>
__device__ __forceinline__ void gemm_core(const u16* __restrict__ X, int ldx, const u16* __restrict__ W, int ldw,
                                          int K, f32x4 (&acc)[NWI][4]) {
  const int tid = TIDX, lane = tid & 63, wid = tid >> 6;
  const int wr = wid >> 1, wc = wid & 1, fr = lane & 15, fq = lane >> 4;
#pragma unroll
  for (int a = 0; a < NWI; ++a)
#pragma unroll
    for (int b = 0; b < 4; ++b) acc[a][b] = f32x4{0.f, 0.f, 0.f, 0.f};
  const int srow = tid >> 3, schunk = (tid & 7) ^ ((tid >> 4) & 7);
  const u16* xg = X + (size_t)srow * ldx + schunk * 8;
  const u16* wg = W + (size_t)srow * ldw + schunk * 8;
  const int xs = 32 * ldx, ws_ = 32 * ldw;
  const int g = fr >> 1;
  const int lo0 = fr * 128 + ((fq ^ g) << 4), lo1 = fr * 128 + (((fq ^ g) ^ 4) << 4);
  const char* xb = smem + wr * 8192;
  const char* wb = smem + 16384 + wc * (NWI * 2048);
  char* sdst = smem + tid * 16;
  const int nt = K >> 6;
  __syncthreads();
#pragma unroll
  for (int i = 0; i < 4; ++i) {
    glds16(xg + i * xs, sdst + i * 4096);
    if (i < NWI) glds16(wg + i * ws_, sdst + 16384 + i * 4096);
  }
  for (int kt = 0; kt < nt; ++kt) {
    asm volatile("s_waitcnt vmcnt(0)" ::: "memory");
    __syncthreads();
    const int cb = (kt & 1) * 32768;
    if (kt + 1 < nt) {
      const int nb = 32768 - cb;
      const int ko = (kt + 1) * 64;
#pragma unroll
      for (int i = 0; i < 4; ++i) {
        glds16(xg + i * xs + ko, sdst + nb + i * 4096);
        if (i < NWI) glds16(wg + i * ws_ + ko, sdst + nb + 16384 + i * 4096);
      }
    }
    bf16x8 wf[2][NWI], xf[2][4];
#pragma unroll
    for (int i = 0; i < NWI; ++i) {
      wf[0][i] = *(const bf16x8*)(wb + cb + i * 2048 + lo0);
      wf[1][i] = *(const bf16x8*)(wb + cb + i * 2048 + lo1);
    }
#pragma unroll
    for (int i = 0; i < 4; ++i) {
      xf[0][i] = *(const bf16x8*)(xb + cb + i * 2048 + lo0);
      xf[1][i] = *(const bf16x8*)(xb + cb + i * 2048 + lo1);
    }
    __builtin_amdgcn_sched_barrier(0);
#pragma unroll
    for (int k = 0; k < 2; ++k)
#pragma unroll
      for (int wi = 0; wi < NWI; ++wi)
#pragma unroll
        for (int xi = 0; xi < 4; ++xi)
          acc[wi][xi] = __builtin_amdgcn_mfma_f32_16x16x32_bf16(wf[k][wi], xf[k][xi], acc[wi][xi], 0, 0, 0);
    __builtin_amdgcn_sched_barrier(0);
  }
}

#define EPI_VARS const int tid_ = TIDX, lane_ = tid_ & 63, wid_ = tid_ >> 6; \
  const int wr_ = wid_ >> 1, wc_ = wid_ & 1, fr_ = lane_ & 15, fq_ = lane_ >> 4; (void)fq_; (void)fr_; (void)wr_; (void)wc_;
#define EPI_TR(xi) (wr_ * 64 + (xi) * 16 + fr_)
#define EPI_NN(wi) (wc_ * 64 + (wi) * 16 + fq_ * 4)

template <int NWI>
__device__ __forceinline__ void store_tile_bf16(const uint2 (&o)[NWI][4], u16* dst_wave, size_t ld) {
  constexpr int RB = NWI * 32, CPR = RB / 16;
  const int tid = TIDX, lane = tid & 63, wid = tid >> 6, fr = lane & 15, fq = lane >> 4;
  char* lb = smem + wid * 8192;
#pragma unroll
  for (int wi = 0; wi < NWI; ++wi)
#pragma unroll
    for (int xi = 0; xi < 4; ++xi) {
      const int r = xi * 16 + fr, c = wi * 2 + (fq >> 1);
      *(uint2*)(lb + r * RB + ((c ^ (r & (CPR - 1))) << 4) + (fq & 1) * 8) = o[wi][xi];
    }
#pragma unroll
  for (int it = 0; it < CPR; ++it) {
    const int idx = it * 64 + lane, row = idx / CPR, c = idx % CPR;
    typedef unsigned u32x4_t __attribute__((ext_vector_type(4)));
    const u32x4_t v = *(const u32x4_t*)(lb + row * RB + ((c ^ (row & (CPR - 1))) << 4));
    __builtin_nontemporal_store(v, (u32x4_t*)(dst_wave + (size_t)row * ld + c * 8));
  }
}

__device__ __forceinline__ void tile_order(int t, int MT, int NT, int& mt, int& nt) {
  constexpr int GM = 4;
  const int band = t / (GM * NT), rem = t - band * GM * NT;
  const int m0 = band * GM;
  const int gsz = min(GM, MT - m0);
  nt = rem / gsz; mt = m0 + rem - nt * gsz;
}

__device__ __forceinline__ int mlo(int q, int MT) { return (q * MT) >> 3; }
#define GEMM_CNT(MT, NT) [=](int q_) { return (mlo(q_ + 1, MT) - mlo(q_, MT)) * (NT); }

__device__ __forceinline__ float* xrow_ptr(const Params& p, int g, int r) {
  int bl, pos, isctx; rowinfo(r, NBG, bl, pos, isctx);
  const int b = g * NBG + bl;
  return isctx ? p.xc + ((size_t)b * CTXL + pos) * DM : p.out + ((size_t)b * SEQ + pos) * DM;
}
__device__ __forceinline__ const float* xsrc_row_ptr(const Params& p, int g, int r, int from_input) {
  int bl, pos, isctx; rowinfo(r, NBG, bl, pos, isctx);
  const int b = g * NBG + bl;
  if (from_input) return isctx ? p.in[2] + ((size_t)b * CTXL + pos) * DM : p.in[0] + ((size_t)b * SEQ + pos) * DM;
  return isctx ? p.xc + ((size_t)b * CTXL + pos) * DM : p.out + ((size_t)b * SEQ + pos) * DM;
}
__device__ __forceinline__ int mod_index(const Params& p, int g, int r) {
  int bl, pos, isctx; rowinfo(r, NBG, bl, pos, isctx);
  return isctx ? 8 : g * NBG + bl;
}

__device__ void conv_tile4(const float* __restrict__ src, int K, int N, u16* __restrict__ dst,
                           const float* __restrict__ scale, int ktile, int ngrp) {
  float* tile = (float*)smem;
  const int tid = TIDX;
  const int k0 = ktile * 64;
  const int kk = tid >> 4, n4 = (tid & 15) * 4;
  float4 v[4][4];
  float sc[4];
#pragma unroll
  for (int i = 0; i < 4; ++i) sc[i] = scale ? scale[k0 + kk + 16 * i] : 1.f;
#pragma unroll
  for (int t = 0; t < 4; ++t) {
    const int n0 = (ngrp * 4 + t) * 64;
#pragma unroll
    for (int i = 0; i < 4; ++i) {
      v[t][i] = make_float4(0.f, 0.f, 0.f, 0.f);
      if (n0 < N) v[t][i] = *(const float4*)(src + (size_t)(k0 + kk + 16 * i) * N + n0 + n4);
    }
  }
  const int nn = tid >> 3, k8 = (tid & 7) * 8;
#pragma unroll
  for (int t = 0; t < 4; ++t) {
    const int n0 = (ngrp * 4 + t) * 64;
    __syncthreads();
#pragma unroll
    for (int i = 0; i < 4; ++i) {
      const int k = kk + 16 * i;
      tile[k * 65 + n4 + 0] = v[t][i].x * sc[i]; tile[k * 65 + n4 + 1] = v[t][i].y * sc[i];
      tile[k * 65 + n4 + 2] = v[t][i].z * sc[i]; tile[k * 65 + n4 + 3] = v[t][i].w * sc[i];
    }
    __syncthreads();
#pragma unroll
    for (int i = 0; i < 2; ++i) {
      const int n = nn + 32 * i;
      uint4 o;
      o.x = pack2(tile[(k8 + 0) * 65 + n], tile[(k8 + 1) * 65 + n]);
      o.y = pack2(tile[(k8 + 2) * 65 + n], tile[(k8 + 3) * 65 + n]);
      o.z = pack2(tile[(k8 + 4) * 65 + n], tile[(k8 + 5) * 65 + n]);
      o.w = pack2(tile[(k8 + 6) * 65 + n], tile[(k8 + 7) * 65 + n]);
      *(uint4*)(dst + (size_t)(n0 + n) * K + k0 + k8) = o;
    }
  }
}

__device__ void sincos_d(double a, double& s, double& c) {
  const double k = rint(a * 0.6366197723675814);
  double r = fma(-k, 1.5707963267948966, a);
  r = fma(-k, 6.123233995736766e-17, r);
  const int q = ((int)k) & 3;
  const double r2 = r * r;
  const double sp = r * (1.0 + r2 * (-1.0 / 6 + r2 * (1.0 / 120 + r2 * (-1.0 / 5040 + r2 * (1.0 / 362880 + r2 * (-1.0 / 39916800 + r2 * (1.0 / 6227020800.0)))))));
  const double cp = 1.0 + r2 * (-0.5 + r2 * (1.0 / 24 + r2 * (-1.0 / 720 + r2 * (1.0 / 40320 + r2 * (-1.0 / 3628800 + r2 * (1.0 / 479001600.0 + r2 * (-1.0 / 87178291200.0)))))));
  s = (q == 0) ? sp : (q == 1) ? cp : (q == 2) ? -sp : -cp;
  c = (q == 0) ? cp : (q == 1) ? -sp : (q == 2) ? -cp : sp;
}

constexpr int CV_WIN = 0, CV_UQ = 416, CV_UKV = 428, CV_BRA = 436, CV_BRB = 468, CV_BRC = 500,
              CV_WO = 532, CV_GATE = 596, CV_UP = 772, CV_DN = 948, CV_LAYER = 1124;
constexpr int P0_CONV = 2 * CV_LAYER, P0_ADA = 2 * 192, P0_TOTAL = P0_CONV + P0_ADA + 1;

__device__ __forceinline__ void conv_item(const Params& p, int ci) {
  const int l = ci / CV_LAYER, j = ci % CV_LAYER;
  u16* wl = p.wt + (size_t)l * W_LAYER;
  if (j < CV_UQ)       { const int jj = j - CV_WIN;  conv_tile4(p.in[7] + (size_t)l * 1024 * INW, 1024, INW, wl + W_IN, nullptr, jj / 26, jj % 26); }
  else if (j < CV_UKV) { const int jj = j - CV_UQ;   conv_tile4(p.in[12] + (size_t)l * 256 * 768, 256, 768, wl + W_UQ, p.in[11] + l * 256, jj / 3, jj % 3); }
  else if (j < CV_BRA) { const int jj = j - CV_UKV;  conv_tile4(p.in[14] + (size_t)l * 128 * 1024, 128, 1024, wl + W_UKV, p.in[13] + l * 128, jj / 4, jj % 4); }
  else if (j < CV_BRB) { const int jj = j - CV_BRA;  conv_tile4(p.in[16] + (size_t)l * 512 * 1024, 512, 1024, wl + W_BRA, nullptr, jj / 4, jj % 4); }
  else if (j < CV_BRC) { const int jj = j - CV_BRB;  conv_tile4(p.in[17] + (size_t)l * 512 * 1024, 512, 1024, wl + W_BRB, nullptr, jj / 4, jj % 4); }
  else if (j < CV_WO)  { const int jj = j - CV_BRC;  conv_tile4(p.in[18] + (size_t)l * 512 * 1024, 512, 1024, wl + W_BRC, nullptr, jj / 4, jj % 4); }
  else if (j < CV_GATE){ const int jj = j - CV_WO;   conv_tile4(p.in[19] + (size_t)l * 1024 * 1024, 1024, 1024, wl + W_O, nullptr, jj / 4, jj % 4); }
  else if (j < CV_UP)  { const int jj = j - CV_GATE; conv_tile4(p.in[21] + (size_t)l * 1024 * DFF, 1024, DFF, wl + W_GU, nullptr, jj / 11, jj % 11); }
  else if (j < CV_DN)  { const int jj = j - CV_UP;   conv_tile4(p.in[22] + (size_t)l * 1024 * DFF, 1024, DFF, wl + W_GU + (size_t)DFF * 1024, nullptr, jj / 11, jj % 11); }
  else                 { const int jj = j - CV_DN;   conv_tile4(p.in[25] + (size_t)l * DFF * 1024, DFF, 1024, wl + W_DN, nullptr, jj / 4, jj % 4); }
}
constexpr int P0_EARLY = CV_UQ;
constexpr int P0_DEFER = P0_CONV - P0_EARLY;

__device__ void phase0(const Params& p, int* ctr) {
  run_q8(ctr, QA_CNT(P0_ADA + 1 + P0_EARLY), [&](int q_, int j_) {
    const int it = QA_ID(q_, j_);
    const int tid = TIDX;
    if (it >= P0_ADA + 1) {
      conv_item(p, it - (P0_ADA + 1));
    } else if (it < P0_ADA) {
      const int a = it, l = a / 192, cg_ = a % 192;
      float* sc = (float*)smem;
      float* red = sc + 9 * 1024;
      for (int e = tid; e < 9 * 1024; e += 256) {
        const int v = e >> 10, k = e & 1023;
        const float cv = (v < 8) ? p.in[1][v * 1024 + k] : p.in[3][k];
        sc[e] = cv / (1.f + expf(-cv));
      }
      __syncthreads();
      const int kg = tid >> 5, cn = tid & 31;
      const float* wa = p.in[4] + (size_t)l * 1024 * 6144 + cg_ * 32 + cn;
      float a0 = 0, a1 = 0, a2 = 0, a3 = 0, a4 = 0, a5 = 0, a6 = 0, a7 = 0, a8 = 0;
#pragma unroll 8
      for (int i = 0; i < 128; ++i) {
        const int k = kg + 8 * i;
        const float w = wa[(size_t)k * 6144];
        a0 += sc[k] * w; a1 += sc[1024 + k] * w; a2 += sc[2048 + k] * w; a3 += sc[3072 + k] * w;
        a4 += sc[4096 + k] * w; a5 += sc[5120 + k] * w; a6 += sc[6144 + k] * w; a7 += sc[7168 + k] * w;
        a8 += sc[8192 + k] * w;
      }
      float* rr = red + kg * 288 + cn;
      rr[0] = a0; rr[32] = a1; rr[64] = a2; rr[96] = a3; rr[128] = a4; rr[160] = a5; rr[192] = a6; rr[224] = a7; rr[256] = a8;
      __syncthreads();
      for (int e = tid; e < 288; e += 256) {
        float s = 0.f;
#pragma unroll
        for (int g8 = 0; g8 < 8; ++g8) s += red[g8 * 288 + e];
        const int v = e >> 5, n = cg_ * 32 + (e & 31);
        p.mod[((size_t)l * 9 + v) * 6144 + n] = s + p.in[5][l * 6144 + n];
      }
    } else {
      for (int e = tid; e < 1024; e += 256) {
        const int pos = e >> 3, f = e & 7;
        const float inv = (f == 0) ? 1.0f : (f == 1) ? 0.31622776601683794f : (f == 2) ? 0.1f : (f == 3) ? 0.031622776601683794f
                        : (f == 4) ? 0.01f : (f == 5) ? 0.0031622776601683794f : (f == 6) ? 0.001f : 0.00031622776601683794f;
        const float ang = (float)pos * inv;
        double s, c; sincos_d((double)ang, s, c);
        p.rope[e * 2] = (float)c; p.rope[e * 2 + 1] = (float)s;
      }
    }
  });
}

__device__ void phase_norm(const Params& p, int l, int g, int which, int* ctr) {
  const int nitems = (which == 1 && l == 1) ? NBG * SEQ / 16 : RG / 16;
  const float* gam = (which == 0 ? p.in[6] : p.in[20]) + l * DM;
  const int shoff = which == 0 ? 0 : 3072, scoff = which == 0 ? 1024 : 4096;
  const int from_input = (which == 0 && l == 0);
  for (int it = blockIdx.x; it < nitems; it += gridDim.x) {
    const int lane = TIDX & 63, wid = TIDX >> 6;
    const int r0 = it * 16 + wid * 4;
    const float* xr = xsrc_row_ptr(p, g, r0, from_input);
    const float* mrow = p.mod + ((size_t)l * 9 + mod_index(p, g, r0)) * 6144;
    float4 v[4][4], gg[4], sh[4], sc[4];
#pragma unroll
    for (int rr = 0; rr < 4; ++rr)
#pragma unroll
      for (int i = 0; i < 4; ++i) v[rr][i] = *(const float4*)(xr + (size_t)rr * DM + lane * 4 + i * 256);
#pragma unroll
    for (int i = 0; i < 4; ++i) {
      const int c = lane * 4 + i * 256;
      gg[i] = *(const float4*)(gam + c); sh[i] = *(const float4*)(mrow + shoff + c); sc[i] = *(const float4*)(mrow + scoff + c);
    }
#pragma unroll
    for (int rr = 0; rr < 4; ++rr) {
      float ss = 0.f;
#pragma unroll
      for (int i = 0; i < 4; ++i)
        ss += v[rr][i].x * v[rr][i].x + v[rr][i].y * v[rr][i].y + v[rr][i].z * v[rr][i].z + v[rr][i].w * v[rr][i].w;
      ss = wave_sum(ss);
      const float rstd = rsqrtf(ss * (1.f / 1024.f) + EPS);
#pragma unroll
      for (int i = 0; i < 4; ++i) {
        const int c = lane * 4 + i * 256;
        uint2 o;
        o.x = pack2(v[rr][i].x * rstd * gg[i].x * (1.f + sc[i].x) + sh[i].x, v[rr][i].y * rstd * gg[i].y * (1.f + sc[i].y) + sh[i].y);
        o.y = pack2(v[rr][i].z * rstd * gg[i].z * (1.f + sc[i].z) + sh[i].z, v[rr][i].w * rstd * gg[i].w * (1.f + sc[i].w) + sh[i].w);
        st_nt(p.h + (size_t)(r0 + rr) * DM + c, o);
      }
    }
  }
}

__device__ void phase_proj(const Params& p, int l, int* ctr, bool first) {
  const int MT = RG / 128, NT = INWP / 128;
  const u16* W = p.wt + (size_t)l * W_LAYER + W_IN;
  const int ndef = first ? P0_DEFER : 0;
  run_q8(ctr, [=](int q_) { return ((ndef - q_ + 7) >> 3) + (mlo(q_ + 1, MT) - mlo(q_, MT)) * NT; }, [&](int q_, int jq_) {
    const int nd = (ndef - q_ + 7) >> 3;
    if (jq_ < nd) { conv_item(p, P0_EARLY + QA_ID(q_, jq_)); return; }
    const int j_ = jq_ - nd;
    int mt, nt; tile_order(j_, mlo(q_ + 1, MT) - mlo(q_, MT), NT, mt, nt); mt += mlo(q_, MT);
    f32x4 acc[4][4];
    gemm_core<4>(p.h + (size_t)mt * 128 * DM, DM, W + (size_t)nt * 128 * DM, DM, DM, acc);
    EPI_VARS
    uint2 o[4][4];
#pragma unroll
    for (int wi = 0; wi < 4; ++wi)
#pragma unroll
      for (int xi = 0; xi < 4; ++xi) {
        o[wi][xi].x = pack2(acc[wi][xi][0], acc[wi][xi][1]); o[wi][xi].y = pack2(acc[wi][xi][2], acc[wi][xi][3]);
      }
    if (nt * 128 + wc_ * 64 < INW)
      store_tile_bf16<4>(o, p.proj + (size_t)(mt * 128 + wr_ * 64) * INW + nt * 128 + wc_ * 64, INW);
  });
}

__device__ void postproj_rows(const Params& p, int l, int it) {
  const int lane = TIDX & 63, wid = TIDX >> 6;
  const float* scw = p.in[15] + (size_t)l * 3 * 512;
  for (int rr = 0; rr < 4; ++rr) {
    const int r = it * 16 + wid * 4 + rr;
    int bl, pos, isctx; rowinfo(r, NBG, bl, pos, isctx);
    const u16* pr = p.proj + (size_t)r * INW;
    const int Lr = isctx ? CTXL : SEQ;
    const int c0 = lane * 8;
    const uint2 u_cq = *(const uint2*)(pr + C_CQ + lane * 4);
    const unsigned u_ckv = *(const unsigned*)(pr + C_CKV + lane * 2);
    const u16 u_kr = pr[C_KR + (lane & 31)];
    const uint4 sb = *(const uint4*)(pr + C_SB + c0);
    const uint4 sc1 = *(const uint4*)(pr + C_SC + c0);
    const uint4 sx1 = *(const uint4*)(pr + C_SX + c0);
    uint4 sc0 = make_uint4(0, 0, 0, 0), sx0 = sc0, sc2 = sc0, sx2 = sc0;
    if (pos > 0) { sc0 = *(const uint4*)(pr - INW + C_SC + c0); sx0 = *(const uint4*)(pr - INW + C_SX + c0); }
    if (pos < Lr - 1) { sc2 = *(const uint4*)(pr + INW + C_SC + c0); sx2 = *(const uint4*)(pr + INW + C_SX + c0); }
    {
      const uint2 u = u_cq;
      const float a = bflo(u.x), b = bfhi(u.x), c = bflo(u.y), d = bfhi(u.y);
      float ss = wave_sum(a * a + b * b + c * c + d * d);
      if (lane == 0) p.rstdq[r] = rsqrtf(ss * (1.f / 256.f) + EPS);
    }
    {
      const unsigned u = u_ckv;
      const float a = bflo(u), b = bfhi(u);
      float ss = wave_sum(a * a + b * b);
      if (lane == 0) p.rstdkv[r] = rsqrtf(ss * (1.f / 128.f) + EPS);
    }
    {
      const int idx = lane & 31;
      const float val = bf2f(u_kr);
      const float partner = xor_lane<8>(val);
      float o = val;
      if (!isctx) {
        const int axis = idx >> 4, half = (idx >> 3) & 1, f = idx & 7;
        const int pa = axis ? (pos & 63) : (pos >> 6);
        const float c = p.rope[(pa * 8 + f) * 2], s = p.rope[(pa * 8 + f) * 2 + 1];
        o = half ? (val * c + partner * s) : (val * c - partner * s);
      }
      const int j = isctx ? SEQ + pos : pos;
      const u16 ob = f2bf(o);
      if (lane < 32) {
#pragma unroll
        for (int hd = 0; hd < 8; ++hd)
          p.kf[((size_t)(bl * 8 + hd) * NKEY + j) * 96 + 64 + idx] = ob;
      }
    }
    {
      const float4 w0a = *(const float4*)(scw + c0), w0b = *(const float4*)(scw + c0 + 4);
      const float4 w1a = *(const float4*)(scw + 512 + c0), w1b = *(const float4*)(scw + 512 + c0 + 4);
      const float4 w2a = *(const float4*)(scw + 1024 + c0), w2b = *(const float4*)(scw + 1024 + c0 + 4);
      uint4 o;
#define UC2(SBW, A0, X0, A1, X1, A2, X2, W0L, W0H, W1L, W1H, W2L, W2H) \
      pack2(bflo(SBW) * (W0L * bflo(A0) * bflo(X0) + W1L * bflo(A1) * bflo(X1) + W2L * bflo(A2) * bflo(X2)), \
            bfhi(SBW) * (W0H * bfhi(A0) * bfhi(X0) + W1H * bfhi(A1) * bfhi(X1) + W2H * bfhi(A2) * bfhi(X2)))
      o.x = UC2(sb.x, sc0.x, sx0.x, sc1.x, sx1.x, sc2.x, sx2.x, w0a.x, w0a.y, w1a.x, w1a.y, w2a.x, w2a.y);
      o.y = UC2(sb.y, sc0.y, sx0.y, sc1.y, sx1.y, sc2.y, sx2.y, w0a.z, w0a.w, w1a.z, w1a.w, w2a.z, w2a.w);
      o.z = UC2(sb.z, sc0.z, sx0.z, sc1.z, sx1.z, sc2.z, sx2.z, w0b.x, w0b.y, w1b.x, w1b.y, w2b.x, w2b.y);
      o.w = UC2(sb.w, sc0.w, sx0.w, sc1.w, sx1.w, sc2.w, sx2.w, w0b.z, w0b.w, w1b.z, w1b.w, w2b.z, w2b.w);
#undef UC2
      st_nt(p.uc + (size_t)r * 512 + c0, o);
    }
  }
}

__device__ __forceinline__ float logsig16(float z) {
  return (fminf(z, 0.f) - __logf(1.f + __expf(-fabsf(z)))) * (1.f / 16.f);
}

__device__ void gla_prep(const Params& p, int l, int it) {
  const int tid = TIDX, lane = tid & 63, wid = tid >> 6;
  const int bl = it / (NCHUNK * 4), rem = it % (NCHUNK * 4), cidx = rem >> 2, h = rem & 3;
  const int r0 = chunk_row(bl, cidx, NBG);
  float* lr = (float*)smem;
  float* tot = (float*)(smem + 8192);
  u16* vT = (u16*)(smem + 10752);
  u16* kTf = (u16*)(smem + 29184);
  u16* kTb = (u16*)(smem + 38400);
  {
    const int t = tid >> 2, c8 = (tid & 3) * 8;
    const uint4 u = *(const uint4*)(p.proj + (size_t)(r0 + t) * INW + C_ALR + c8);
    float* d = lr + t * 32 + c8;
    d[0] = bflo(u.x); d[1] = bfhi(u.x); d[2] = bflo(u.y); d[3] = bfhi(u.y);
    d[4] = bflo(u.z); d[5] = bfhi(u.z); d[6] = bflo(u.w); d[7] = bfhi(u.w);
    const int dvc = (tid & 3) * 32;
    const u16* vp = p.proj + (size_t)(r0 + t) * INW + C_VA + h * 128 + dvc;
#pragma unroll
    for (int i = 0; i < 4; ++i) {
      const uint4 vv = *(const uint4*)(vp + i * 8);
      u16* dst = vT + (size_t)(dvc + i * 8) * 72 + t;
      dst[0] = (u16)(vv.x & 0xffff); dst[72] = (u16)(vv.x >> 16);
      dst[144] = (u16)(vv.y & 0xffff); dst[216] = (u16)(vv.y >> 16);
      dst[288] = (u16)(vv.z & 0xffff); dst[360] = (u16)(vv.z >> 16);
      dst[432] = (u16)(vv.w & 0xffff); dst[504] = (u16)(vv.w >> 16);
    }
  }
  __syncthreads();
  const int dk = lane, tg = wid;
  const float* w2f = p.in[8] + ((size_t)(l * 2 + 0) * 16) * 256 + h * 64 + dk;
  const float* w2b = p.in[8] + ((size_t)(l * 2 + 1) * 16) * 256 + h * 64 + dk;
  float wf[16], wb[16];
#pragma unroll
  for (int r = 0; r < 16; ++r) { wf[r] = w2f[r * 256]; wb[r] = w2b[r * 256]; }
  const float biasf = p.in[9][(l * 2 + 0) * 256 + h * 64 + dk];
  const float biasb = p.in[9][(l * 2 + 1) * 256 + h * 64 + dk];
  float pf[16], sbk[16];
#pragma unroll
  for (int i = 0; i < 16; ++i) {
    const float* lrow = lr + (tg * 16 + i) * 32;
    float zf = biasf, zb = biasb;
#pragma unroll
    for (int r = 0; r < 16; ++r) { zf += lrow[r] * wf[r]; zb += lrow[16 + r] * wb[r]; }
    pf[i] = logsig16(zf); sbk[i] = logsig16(zb);
  }
#pragma unroll
  for (int i = 1; i < 16; ++i) pf[i] += pf[i - 1];
#pragma unroll
  for (int i = 14; i >= 0; --i) sbk[i] += sbk[i + 1];
  tot[tg * 64 + dk] = pf[15];
  tot[256 + tg * 64 + dk] = sbk[0];
  __syncthreads();
  float offf = 0.f, offb = 0.f, bfl = 0.f, bb0 = 0.f;
#pragma unroll
  for (int g4 = 0; g4 < 4; ++g4) {
    const float a = tot[g4 * 64 + dk], b = tot[256 + g4 * 64 + dk];
    bfl += a; bb0 += b;
    if (g4 < tg) offf += a;
    if (g4 > tg) offb += b;
  }
  u16* gqf = p.gq;
  u16* gkf = p.gq + (size_t)RG * 256;
  u16* gqb = p.gq + (size_t)RG * 512;
  u16* gkb = p.gq + (size_t)RG * 768;
  unsigned kfp[8], kbp[8];
#pragma unroll
  for (int i = 0; i < 16; ++i) {
    const int t = tg * 16 + i;
    const float bfv = offf + pf[i], bbv = offb + sbk[i];
    const float qv = bf2f(p.proj[(size_t)(r0 + t) * INW + C_QA + h * 64 + dk]);
    const float kv = bf2f(p.proj[(size_t)(r0 + t) * INW + C_KA + h * 64 + dk]);
    const size_t go = (size_t)(r0 + t) * 256 + h * 64 + dk;
    gqf[go] = f2bf(qv * __expf(bfv) * 0.125f);
    gkf[go] = f2bf(kv * __expf(-bfv));
    gqb[go] = f2bf(qv * __expf(bbv) * 0.125f);
    gkb[go] = f2bf(kv * __expf(-bbv));
    const u16 ksf = f2bf(kv * __expf(bfl - bfv));
    const u16 ksb = f2bf(kv * __expf(bb0 - bbv));
    if (i & 1) { kfp[i >> 1] |= ((unsigned)ksf) << 16; kbp[i >> 1] |= ((unsigned)ksb) << 16; }
    else { kfp[i >> 1] = ksf; kbp[i >> 1] = ksb; }
  }
  *(uint4*)(kTf + dk * 72 + tg * 16) = make_uint4(kfp[0], kfp[1], kfp[2], kfp[3]);
  *(uint4*)(kTf + dk * 72 + tg * 16 + 8) = make_uint4(kfp[4], kfp[5], kfp[6], kfp[7]);
  *(uint4*)(kTb + dk * 72 + tg * 16) = make_uint4(kbp[0], kbp[1], kbp[2], kbp[3]);
  *(uint4*)(kTb + dk * 72 + tg * 16 + 8) = make_uint4(kbp[4], kbp[5], kbp[6], kbp[7]);
  const size_t cb = ((size_t)(bl * NCHUNK + cidx) * 4 + h) * 2;
  if (tg == 0) {
    p.dec[(cb + 0) * 64 + dk] = __expf(bfl);
    p.dec[(cb + 1) * 64 + dk] = __expf(bb0);
  }
  __syncthreads();
  const int l31 = lane & 31, hh = lane >> 5;
  u16* U = p.h;
#pragma unroll
  for (int dir = 0; dir < 2; ++dir) {
    const u16* kT = dir ? kTb : kTf;
#pragma unroll
    for (int dkt = 0; dkt < 2; ++dkt) {
      f32x16 acc;
#pragma unroll
      for (int e = 0; e < 16; ++e) acc[e] = 0.f;
#pragma unroll
      for (int s = 0; s < 4; ++s) {
        const bf16x8 a = *(const bf16x8*)(vT + (32 * wid + l31) * 72 + 16 * s + 8 * hh);
        const bf16x8 b = *(const bf16x8*)(kT + (32 * dkt + l31) * 72 + 16 * s + 8 * hh);
        acc = __builtin_amdgcn_mfma_f32_32x32x16_bf16(a, b, acc, 0, 0, 0);
      }
      u16* up = U + (cb + dir) * 8192;
#pragma unroll
      for (int e = 0; e < 16; ++e) {
        const int dv = 32 * wid + (e & 3) + 8 * (e >> 2) + 4 * hh;
        up[dv * 64 + 32 * dkt + l31] = f2bf(acc[e]);
      }
    }
  }
}

__device__ void phase_postproj(const Params& p, int l, int* ctr) {
  const int n_prep = NBG * NCHUNK * 4, n_rows = RG / 16;
  run_q8(ctr, QA_CNT(n_prep + n_rows), [&](int q_, int j_) {
    const int it = QA_ID(q_, j_);
    if (it < n_prep) gla_prep(p, l, it);
    else postproj_rows(p, l, it - n_prep);
  });
}

__device__ void gla_scan(const Params& p, int it) {
  const int tid = TIDX;
  const int sl = it & 7, dir = (it >> 3) & 1, h = (it >> 4) & 3, bl = it >> 6;
  const int e0 = sl * 1024 + tid * 4;
  const int dk = e0 & 63;
  const u16* U = p.h;
  f32x4 S = {0.f, 0.f, 0.f, 0.f};
  for (int s0 = 0; s0 < NCHUNK; s0 += 12) {
    uint2 u4[12]; f32x4 d4[12];
#pragma unroll
    for (int j = 0; j < 12; ++j) {
      const int step = s0 + j;
      const int cidx = dir ? (NCHUNK - 1 - step) : (step < 4 ? 128 + step : step - 4);
      const size_t base = ((size_t)(bl * NCHUNK + cidx) * 4 + h) * 2 + dir;
      u4[j] = *(const uint2*)(U + base * 8192 + e0);
      d4[j] = *(const f32x4*)(p.dec + base * 64 + dk);
    }
#pragma unroll
    for (int j = 0; j < 12; ++j) {
      const int step = s0 + j;
      const int cidx = dir ? (NCHUNK - 1 - step) : (step < 4 ? 128 + step : step - 4);
      const size_t base = ((size_t)(bl * NCHUNK + cidx) * 4 + h) * 2 + dir;
      uint2 o; o.x = pack2(S[0], S[1]); o.y = pack2(S[2], S[3]);
      st_nt(p.ss + base * 8192 + e0, o);
      S = d4[j] * S + f32x4{bflo(u4[j].x), bfhi(u4[j].x), bflo(u4[j].y), bfhi(u4[j].y)};
    }
  }
}

__device__ void q_tile(const Params& p, int l, int t) {
  const int MT = RG / 128;
  const int nt = t / MT, mt = t % MT;
  f32x4 acc[4][4];
  gemm_core<4>(p.proj + (size_t)mt * 128 * INW + C_CQ, INW, p.wt + (size_t)l * W_LAYER + W_UQ + (size_t)nt * 128 * 256, 256, 256, acc);
  EPI_VARS
  const float QS = 0.10206207261596577f * 1.4426950408889634f;
  int bl, pos0, isctx; rowinfo(mt * 128, NBG, bl, pos0, isctx);
  float rsq[4];
  uint2 qo[4][4];
#pragma unroll
  for (int xi = 0; xi < 4; ++xi) rsq[xi] = p.rstdq[mt * 128 + EPI_TR(xi)] * QS;
#pragma unroll
  for (int xi = 0; xi < 4; ++xi) {
    const int tr = EPI_TR(xi), r = mt * 128 + tr, pos = pos0 + tr;
    const float rs = rsq[xi];
#pragma unroll
    for (int wi = 0; wi < 4; ++wi) {
      const int n16 = (nt * 128 + wc_ * 64 + wi * 16) >> 4;
      const int m6 = n16 % 6;
      float v0 = acc[wi][xi][0] * rs, v1 = acc[wi][xi][1] * rs, v2 = acc[wi][xi][2] * rs, v3 = acc[wi][xi][3] * rs;
      if (m6 >= 4 && !isctx) {
        const float p0 = xor_lane<32>(v0), p1 = xor_lane<32>(v1), p2 = xor_lane<32>(v2), p3 = xor_lane<32>(v3);
        const int pa = (m6 == 5) ? (pos & 63) : (pos >> 6);
        const int f0 = (fq_ & 1) * 4;
        const float* rp = p.rope + (pa * 8 + f0) * 2;
        const float4 cs01 = *(const float4*)rp, cs23 = *(const float4*)(rp + 4);
        const float sg = (fq_ >= 2) ? 1.f : -1.f;
        v0 = v0 * cs01.x + sg * p0 * cs01.y;
        v1 = v1 * cs01.z + sg * p1 * cs01.w;
        v2 = v2 * cs23.x + sg * p2 * cs23.y;
        v3 = v3 * cs23.z + sg * p3 * cs23.w;
      }
      qo[wi][xi].x = pack2(v0, v1); qo[wi][xi].y = pack2(v2, v3);
    }
  }
  store_tile_bf16<4>(qo, p.q + (size_t)(mt * 128 + wr_ * 64) * 768 + nt * 128 + wc_ * 64, 768);
}

__device__ void kv_tile(const Params& p, int l, int t) {
  const int MT = RG / 128;
  const int nt = t / MT, mt = t % MT;
  f32x4 acc[4][4];
  gemm_core<4>(p.proj + (size_t)mt * 128 * INW + C_CKV, INW, p.wt + (size_t)l * W_LAYER + W_UKV + (size_t)nt * 128 * 128, 128, 128, acc);
  EPI_VARS
  int bl, pos0, isctx; rowinfo(mt * 128, NBG, bl, pos0, isctx);
  const int j0 = isctx ? SEQ + pos0 : pos0;
  float rskv[4];
#pragma unroll
  for (int xi = 0; xi < 4; ++xi) rskv[xi] = p.rstdkv[mt * 128 + EPI_TR(xi)];
#pragma unroll
  for (int xi = 0; xi < 4; ++xi) {
    const int tr = EPI_TR(xi), r = mt * 128 + tr, j = j0 + tr;
    const float rs = rskv[xi];
#pragma unroll
    for (int wi = 0; wi < 4; ++wi) {
      const int wn = EPI_NN(wi);
      const float v0 = acc[wi][xi][0] * rs, v1 = acc[wi][xi][1] * rs, v2 = acc[wi][xi][2] * rs, v3 = acc[wi][xi][3] * rs;
      if (wc_ == 0) {
        uint2 o; o.x = pack2(v0, v1); o.y = pack2(v2, v3);
        *(uint2*)(p.kf + ((size_t)(bl * 8 + nt) * NKEY + j) * 96 + wn) = o;
      } else {
        u16* vp = p.vt + ((size_t)(bl * 8 + nt) * 64 + (wn - 64)) * NKEY + j;
        vp[0] = f2bf(v0); vp[NKEY] = f2bf(v1); vp[2 * NKEY] = f2bf(v2); vp[3 * NKEY] = f2bf(v3);
      }
    }
  }
}

__device__ void phase_qkv(const Params& p, int l, int* ctr) {
  const int MT = RG / 128;
  const int n_scan = NBG * 64, n_q = MT * 6, n_kv = MT * 8;
  run_q8(ctr, QA_CNT(n_scan + n_q + n_kv), [&](int q_, int j_) {
    const int it = QA_ID(q_, j_);
    if (it < n_scan) gla_scan(p, it);
    else if (it < n_scan + n_q) q_tile(p, l, it - n_scan);
    else kv_tile(p, l, it - n_scan - n_q);
  });
}

__device__ __forceinline__ bf16x8 pack8(const f32x16& a, int o) {
  union { bf16x8 v; unsigned u[4]; } r;
  r.u[0] = pack2(a[o + 0], a[o + 1]); r.u[1] = pack2(a[o + 2], a[o + 3]);
  r.u[2] = pack2(a[o + 4], a[o + 5]); r.u[3] = pack2(a[o + 6], a[o + 7]);
  return r.v;
}
__device__ __forceinline__ bf16x8 ld2x8(const u16* p0) {
  union { bf16x8 v; uint2 u[2]; } r;
  r.u[0] = *(const uint2*)p0; r.u[1] = *(const uint2*)(p0 + 8);
  return r.v;
}

__device__ void attn_item(const Params& p, int it) {
  const int tid = TIDX, lane = tid & 63, wid = tid >> 6, l31 = lane & 31, hh = lane >> 5;
  const int qb = it % 66, bh = it / 66, h = bh & 7, bl = bh >> 3;
  const int r0 = qb < 64 ? bl * SEQ + qb * 128 : NBG * SEQ + bl * CTXL + (qb - 64) * 128;
  const int kt0 = qb < 64 ? 0 : 128;
  const int nkt = NCHUNK - kt0;
  constexpr int KROW = 208, VROW = 144, BUFB = 64 * KROW + 64 * VROW;
  bf16x8 qf[6];
  {
    const u16* qp = p.q + (size_t)(r0 + 32 * wid + l31) * 768 + h * 96 + 8 * hh;
#pragma unroll
    for (int s = 0; s < 6; ++s) qf[s] = *(const bf16x8*)(qp + 16 * s);
  }
  const u16* kbase = p.kf + (size_t)bh * NKEY * 96;
  const u16* vbase = p.vt + (size_t)bh * 64 * NKEY;
  uint4 kr0, kr1, kr2, vr0, vr1;
  const int kdst0 = (tid / 12) * KROW + (tid % 12) * 16;
  const int kdst1 = ((tid + 256) / 12) * KROW + ((tid + 256) % 12) * 16;
  const int kdst2 = ((tid + 512) / 12) * KROW + ((tid + 512) % 12) * 16;
  const int vdst0 = 64 * KROW + (tid >> 3) * VROW + (tid & 7) * 16;
  const int vdst1 = vdst0 + 32 * VROW;
  const int vsrc0 = (tid >> 3) * NKEY + (tid & 7) * 8;
  const int vsrc1 = vsrc0 + 32 * NKEY;
  {
    const u16* kp = kbase + (size_t)kt0 * 64 * 96 + tid * 8;
    kr0 = *(const uint4*)(kp); kr1 = *(const uint4*)(kp + 2048); kr2 = *(const uint4*)(kp + 4096);
    vr0 = *(const uint4*)(vbase + vsrc0 + kt0 * 64); vr1 = *(const uint4*)(vbase + vsrc1 + kt0 * 64);
    *(uint4*)(smem + kdst0) = kr0; *(uint4*)(smem + kdst1) = kr1; *(uint4*)(smem + kdst2) = kr2;
    *(uint4*)(smem + vdst0) = vr0; *(uint4*)(smem + vdst1) = vr1;
  }
  __builtin_amdgcn_s_waitcnt(0x0F70);
  __syncthreads();
  f32x16 oacc[2];
#pragma unroll
  for (int e = 0; e < 16; ++e) { oacc[0][e] = 0.f; oacc[1][e] = 0.f; }
  float m_run = 0.f, l_run = 0.f;
  for (int t = 0; t < nkt; ++t) {
    const int cur = t & 1;
    {
      const int tn = kt0 + min(t + 1, nkt - 1);
      const u16* kp = kbase + (size_t)tn * 64 * 96 + tid * 8;
      kr0 = *(const uint4*)(kp); kr1 = *(const uint4*)(kp + 2048); kr2 = *(const uint4*)(kp + 4096);
      vr0 = *(const uint4*)(vbase + vsrc0 + tn * 64); vr1 = *(const uint4*)(vbase + vsrc1 + tn * 64);
    }
    __builtin_amdgcn_sched_barrier(0);
    const char* Kl = smem + cur * BUFB;
    const char* Vl = Kl + 64 * KROW;
    f32x16 sacc[2];
#pragma unroll
    for (int kb = 0; kb < 2; ++kb) {
#pragma unroll
      for (int e = 0; e < 16; ++e) sacc[kb][e] = -m_run;
#pragma unroll
      for (int s = 0; s < 6; ++s) {
        const bf16x8 a = *(const bf16x8*)(Kl + (32 * kb + l31) * KROW + 32 * s + 16 * hh);
        sacc[kb] = __builtin_amdgcn_mfma_f32_32x32x16_bf16(a, qf[s], sacc[kb], 0, 0, 0);
      }
    }
    float mx = sacc[0][0];
#pragma unroll
    for (int e = 1; e < 16; ++e) mx = fmaxf(mx, sacc[0][e]);
#pragma unroll
    for (int e = 0; e < 16; ++e) mx = fmaxf(mx, sacc[1][e]);
    {
      const unsigned mu = __float_as_uint(mx);
      const auto sw = __builtin_amdgcn_permlane32_swap(mu, mu, false, false);
      mx = fmaxf(__uint_as_float(sw[0]), __uint_as_float(sw[1]));
    }
    if (t == 0 || !__all(mx <= 8.f)) {
      const float d = (t == 0) ? mx : fmaxf(mx, 0.f);
      const float alpha = __builtin_amdgcn_exp2f(-d);
      m_run += d;
      l_run *= alpha;
#pragma unroll
      for (int e = 0; e < 16; ++e) { oacc[0][e] *= alpha; oacc[1][e] *= alpha; sacc[0][e] -= d; sacc[1][e] -= d; }
    }
    float ps = 0.f;
#pragma unroll
    for (int kb = 0; kb < 2; ++kb)
#pragma unroll
      for (int e = 0; e < 16; ++e) { const float pv = __builtin_amdgcn_exp2f(sacc[kb][e]); sacc[kb][e] = pv; ps += pv; }
    l_run += ps;
#pragma unroll
    for (int kb = 0; kb < 2; ++kb)
#pragma unroll
      for (int s2 = 0; s2 < 2; ++s2) {
        const bf16x8 pfr = pack8(sacc[kb], 8 * s2);
#pragma unroll
        for (int dt = 0; dt < 2; ++dt) {
          const bf16x8 a = ld2x8((const u16*)(Vl + (32 * dt + l31) * VROW) + 32 * kb + 16 * s2 + 4 * hh);
          oacc[dt] = __builtin_amdgcn_mfma_f32_32x32x16_bf16(a, pfr, oacc[dt], 0, 0, 0);
        }
      }
    __builtin_amdgcn_sched_barrier(0);
    {
      char* nb = smem + (cur ^ 1) * BUFB;
      *(uint4*)(nb + kdst0) = kr0; *(uint4*)(nb + kdst1) = kr1; *(uint4*)(nb + kdst2) = kr2;
      *(uint4*)(nb + vdst0) = vr0; *(uint4*)(nb + vdst1) = vr1;
    }
    __syncthreads();
  }
  l_run += xor_lane<32>(l_run);
  const float inv = 1.f / l_run;
  u16* op = p.h + (size_t)RG * 512 + (size_t)(r0 + 32 * wid + l31) * 512 + h * 64;
#pragma unroll
  for (int dt = 0; dt < 2; ++dt)
#pragma unroll
    for (int gq_ = 0; gq_ < 4; ++gq_) {
      const int dv0 = 32 * dt + 8 * gq_ + 4 * hh;
      uint2 o;
      o.x = pack2(oacc[dt][4 * gq_ + 0] * inv, oacc[dt][4 * gq_ + 1] * inv);
      o.y = pack2(oacc[dt][4 * gq_ + 2] * inv, oacc[dt][4 * gq_ + 3] * inv);
      *(uint2*)(op + dv0) = o;
    }
}

__device__ void gla_out(const Params& p, int l, int it) {
  const int tid = TIDX, lane = tid & 63, wid = tid >> 6, l31 = lane & 31, hh = lane >> 5;
  const int bl = it / (NCHUNK * 4), rem = it % (NCHUNK * 4), cidx = rem >> 2, h = rem & 3;
  const int r0 = chunk_row(bl, cidx, NBG);
  u16* tiles = (u16*)smem;
  u16* vT = (u16*)(smem + 36864);
  float* part = (float*)(smem + 55296);
  {
    const int t = tid >> 2, c16 = (tid & 3) * 16;
#pragma unroll
    for (int a = 0; a < 4; ++a) {
      const u16* src = p.gq + (size_t)a * RG * 256 + (size_t)(r0 + t) * 256 + h * 64 + c16;
      const uint4 u0 = *(const uint4*)src, u1 = *(const uint4*)(src + 8);
      u16* d = tiles + a * 4608 + t * 72 + c16;
      *(uint4*)d = u0; *(uint4*)(d + 8) = u1;
    }
    const int dvc = (tid & 3) * 32;
    const u16* vp = p.proj + (size_t)(r0 + t) * INW + C_VA + h * 128 + dvc;
#pragma unroll
    for (int i = 0; i < 4; ++i) {
      const uint4 vv = *(const uint4*)(vp + i * 8);
      u16* dst = vT + (size_t)(dvc + i * 8) * 72 + t;
      dst[0] = (u16)(vv.x & 0xffff); dst[72] = (u16)(vv.x >> 16);
      dst[144] = (u16)(vv.y & 0xffff); dst[216] = (u16)(vv.y >> 16);
      dst[288] = (u16)(vv.z & 0xffff); dst[360] = (u16)(vv.z >> 16);
      dst[432] = (u16)(vv.w & 0xffff); dst[504] = (u16)(vv.w >> 16);
    }
  }
  const int itl = wid & 1, dvh = wid >> 1;
  const size_t cb = ((size_t)(bl * NCHUNK + cidx) * 4 + h) * 2;
  bf16x8 sfr[2][2][4];
#pragma unroll
  for (int dir = 0; dir < 2; ++dir)
#pragma unroll
    for (int dt = 0; dt < 2; ++dt)
#pragma unroll
      for (int s4 = 0; s4 < 4; ++s4)
        sfr[dir][dt][s4] = *(const bf16x8*)(p.ss + (cb + dir) * 8192 + (64 * dvh + 32 * dt + l31) * 64 + 16 * s4 + 8 * hh);
  __syncthreads();
  f32x16 oacc[2];
#pragma unroll
  for (int e = 0; e < 16; ++e) { oacc[0][e] = 0.f; oacc[1][e] = 0.f; }
#pragma unroll
  for (int dir = 0; dir < 2; ++dir) {
    const u16* Qt = tiles + (dir * 2) * 4608;
    const u16* Kt = tiles + (dir * 2 + 1) * 4608;
    bf16x8 qfr[4];
#pragma unroll
    for (int s = 0; s < 4; ++s) qfr[s] = *(const bf16x8*)(Qt + (32 * itl + l31) * 72 + 16 * s + 8 * hh);
    f32x16 aacc[2];
#pragma unroll
    for (int jt = 0; jt < 2; ++jt) {
#pragma unroll
      for (int e = 0; e < 16; ++e) aacc[jt][e] = 0.f;
#pragma unroll
      for (int s = 0; s < 4; ++s) {
        const bf16x8 a = *(const bf16x8*)(Kt + (32 * jt + l31) * 72 + 16 * s + 8 * hh);
        aacc[jt] = __builtin_amdgcn_mfma_f32_32x32x16_bf16(a, qfr[s], aacc[jt], 0, 0, 0);
      }
      const int i_tok = 32 * itl + l31;
#pragma unroll
      for (int e = 0; e < 16; ++e) {
        const int j_tok = 32 * jt + (e & 3) + 8 * (e >> 2) + 4 * hh;
        const bool keep = dir ? (j_tok >= i_tok) : (j_tok <= i_tok);
        if (!keep) aacc[jt][e] = 0.f;
      }
    }
#pragma unroll
    for (int dt = 0; dt < 2; ++dt) {
      const int dvrow = 64 * dvh + 32 * dt + l31;
#pragma unroll
      for (int jt = 0; jt < 2; ++jt)
#pragma unroll
        for (int s2 = 0; s2 < 2; ++s2) {
          const bf16x8 pfr = pack8(aacc[jt], 8 * s2);
          const bf16x8 a = ld2x8(vT + dvrow * 72 + 32 * jt + 16 * s2 + 4 * hh);
          oacc[dt] = __builtin_amdgcn_mfma_f32_32x32x16_bf16(a, pfr, oacc[dt], 0, 0, 0);
        }
#pragma unroll
      for (int s = 0; s < 4; ++s) {
        oacc[dt] = __builtin_amdgcn_mfma_f32_32x32x16_bf16(sfr[dir][dt][s], qfr[s], oacc[dt], 0, 0, 0);
      }
    }
  }
  float ss = 0.f;
#pragma unroll
  for (int e = 0; e < 16; ++e) ss += oacc[0][e] * oacc[0][e] + oacc[1][e] * oacc[1][e];
  ss += xor_lane<32>(ss);
  if (hh == 0) part[wid * 32 + l31] = ss;
  __syncthreads();
  const float totss = part[wid * 32 + l31] + part[(wid ^ 2) * 32 + l31];
  const float rstd = rsqrtf(totss * (1.f / 128.f) + EPS);
  const int r = r0 + 32 * itl + l31;
  const float* gam = p.in[10] + l * 512 + h * 128;
  u16* aa = p.h;
#pragma unroll
  for (int dt = 0; dt < 2; ++dt)
#pragma unroll
    for (int gq_ = 0; gq_ < 4; ++gq_) {
      const int dv0 = 64 * dvh + 32 * dt + 8 * gq_ + 4 * hh;
      const uint2 ra = *(const uint2*)(p.proj + (size_t)r * INW + C_RA + h * 128 + dv0);
      const float4 g4 = *(const float4*)(gam + dv0);
      uint2 o;
      o.x = pack2(oacc[dt][4 * gq_ + 0] * rstd * g4.x * silu_f(bflo(ra.x)), oacc[dt][4 * gq_ + 1] * rstd * g4.y * silu_f(bfhi(ra.x)));
      o.y = pack2(oacc[dt][4 * gq_ + 2] * rstd * g4.z * silu_f(bflo(ra.y)), oacc[dt][4 * gq_ + 3] * rstd * g4.w * silu_f(bfhi(ra.y)));
      *(uint2*)(aa + (size_t)r * 512 + h * 128 + dv0) = o;
    }
}

__device__ void phase_attn(const Params& p, int l, int* ctr) {
  const int nqb = (l == 1) ? 64 : 66, nck = (l == 1) ? 128 : NCHUNK;
  const int per_q = NBG * nqb;
  const int n_gla = NBG * nck * 4;
  run_q8(ctr, [=](int q_) { return per_q + ((n_gla - q_ + 7) >> 3); }, [&](int q_, int j_) {
    if (j_ < per_q) attn_item(p, ((j_ / nqb) * 8 + q_) * 66 + (j_ % nqb));
    else {
      const int gi = QA_ID(q_, j_ - per_q);
      gla_out(p, l, (gi / (nck * 4)) * (NCHUNK * 4) + gi % (nck * 4));
    }
  });
}

__device__ void phase_merge(const Params& p, int l, int* ctr) {
  const int MT = (l == 1 ? NBG * SEQ / 128 : RG / 128), NT = 16;
  const u16* wl = p.wt + (size_t)l * W_LAYER;
  run_q8(ctr, GEMM_CNT(MT, NT), [&](int q_, int j_) {
    int mt, nt; tile_order(j_, mlo(q_ + 1, MT) - mlo(q_, MT), NT, mt, nt); mt += mlo(q_, MT);
    const int tid = TIDX, lane = tid & 63, wid = tid >> 6;
    const int wr = wid >> 1, wc = wid & 1, fr = lane & 15, fq = lane >> 4;
    f32x4 macc[2][4], acc[2][4];
#pragma unroll
    for (int a = 0; a < 2; ++a)
#pragma unroll
      for (int b = 0; b < 4; ++b) { macc[a][b] = f32x4{0.f, 0.f, 0.f, 0.f}; acc[a][b] = f32x4{0.f, 0.f, 0.f, 0.f}; }
    const int srow = tid >> 3, schunk = (tid & 7) ^ ((tid >> 4) & 7);
    const size_t xo = (size_t)(mt * 128 + srow) * 512 + schunk * 8;
    const size_t wo = (size_t)(nt * 64 + srow) * 512 + schunk * 8;
    const u16* xg0 = p.h + xo;
    const u16* xg1 = p.h + (size_t)RG * 512 + xo;
    const u16* xg2 = p.uc + xo;
    const u16* wg0 = wl + W_BRA + wo;
    const u16* wg1 = wl + W_BRB + wo;
    const u16* wg2 = wl + W_BRC + wo;
    const int g = fr >> 1;
    const int lo0 = fr * 128 + ((fq ^ g) << 4), lo1 = fr * 128 + (((fq ^ g) ^ 4) << 4);
    const char* xb = smem + wr * 8192;
    const char* wb = smem + 16384 + wc * 4096;
    char* sdst = smem + tid * 16;
    const u16* gbase = p.proj + (size_t)(mt * 128 + wr * 64 + fr) * INW + C_GATE + nt * 64 + wc * 32 + fq * 4;
    uint2 gts[2][4];
#pragma unroll
    for (int wi = 0; wi < 2; ++wi)
#pragma unroll
      for (int xi = 0; xi < 4; ++xi) gts[wi][xi] = *(const uint2*)(gbase + (size_t)xi * 16 * INW + wi * 16);
    __syncthreads();
#pragma unroll
    for (int i = 0; i < 4; ++i) {
      glds16(xg0 + i * (32 * 512), sdst + i * 4096);
      if (i < 2) glds16(wg0 + i * (32 * 512), sdst + 16384 + i * 4096);
    }
    for (int kt = 0; kt < 24; ++kt) {
      asm volatile("s_waitcnt vmcnt(0)" ::: "memory");
      __syncthreads();
      const int cb = (kt & 1) * 32768;
      if (kt + 1 < 24) {
        const int nbr = (kt + 1) >> 3, ko = ((kt + 1) & 7) * 64, nb = 32768 - cb;
        const u16* xg = (nbr == 0 ? xg0 : nbr == 1 ? xg1 : xg2) + ko;
        const u16* wg = (nbr == 0 ? wg0 : nbr == 1 ? wg1 : wg2) + ko;
#pragma unroll
        for (int i = 0; i < 4; ++i) {
          glds16(xg + i * (32 * 512), sdst + nb + i * 4096);
          if (i < 2) glds16(wg + i * (32 * 512), sdst + nb + 16384 + i * 4096);
        }
      }
      bf16x8 wf[2][2], xf[2][4];
#pragma unroll
      for (int i = 0; i < 2; ++i) {
        wf[0][i] = *(const bf16x8*)(wb + cb + i * 2048 + lo0);
        wf[1][i] = *(const bf16x8*)(wb + cb + i * 2048 + lo1);
      }
#pragma unroll
      for (int i = 0; i < 4; ++i) {
        xf[0][i] = *(const bf16x8*)(xb + cb + i * 2048 + lo0);
        xf[1][i] = *(const bf16x8*)(xb + cb + i * 2048 + lo1);
      }
      __builtin_amdgcn_sched_barrier(0);
#pragma unroll
      for (int k = 0; k < 2; ++k)
#pragma unroll
        for (int wi = 0; wi < 2; ++wi)
#pragma unroll
          for (int xi = 0; xi < 4; ++xi)
            acc[wi][xi] = __builtin_amdgcn_mfma_f32_16x16x32_bf16(wf[k][wi], xf[k][xi], acc[wi][xi], 0, 0, 0);
      __builtin_amdgcn_sched_barrier(0);
      if ((kt & 7) == 7) {
        const int br = kt >> 3;
#pragma unroll
        for (int wi = 0; wi < 2; ++wi)
#pragma unroll
          for (int xi = 0; xi < 4; ++xi) {
            const uint2 gt = gts[wi][xi];
            macc[wi][xi][0] += sigmoid_f(bflo(gt.x)) * acc[wi][xi][0];
            macc[wi][xi][1] += sigmoid_f(bfhi(gt.x)) * acc[wi][xi][1];
            macc[wi][xi][2] += sigmoid_f(bflo(gt.y)) * acc[wi][xi][2];
            macc[wi][xi][3] += sigmoid_f(bfhi(gt.y)) * acc[wi][xi][3];
            acc[wi][xi] = f32x4{0.f, 0.f, 0.f, 0.f};
            if (br < 2) gts[wi][xi] = *(const uint2*)(gbase + (size_t)xi * 16 * INW + wi * 16 + (br + 1) * 1024);
          }
      }
    }
    uint2 o[2][4];
#pragma unroll
    for (int wi = 0; wi < 2; ++wi)
#pragma unroll
      for (int xi = 0; xi < 4; ++xi) {
        o[wi][xi].x = pack2(macc[wi][xi][0], macc[wi][xi][1]); o[wi][xi].y = pack2(macc[wi][xi][2], macc[wi][xi][3]);
      }
    store_tile_bf16<2>(o, p.m + (size_t)(mt * 128 + wr * 64) * DM + nt * 64 + wc * 32, DM);
  });
}

__device__ void phase_resid(const Params& p, int l, int g, int which, int* ctr) {
  const int MT = (l == 1 ? NBG * SEQ / 128 : RG / 128), NT = 8;
  const u16* wl = p.wt + (size_t)l * W_LAYER;
  const u16* X = which == 0 ? p.m : p.proj + (size_t)RG * DFF;
  const int ldx = which == 0 ? DM : DFF, K = which == 0 ? DM : DFF;
  const u16* W = wl + (which == 0 ? W_O : W_DN);
  const int goff = which == 0 ? 2048 : 5120;
  const int from_input = (which == 0 && l == 0);
  run_q8(ctr, GEMM_CNT(MT, NT), [&](int q_, int j_) {
    int mt, nt; tile_order(j_, mlo(q_ + 1, MT) - mlo(q_, MT), NT, mt, nt); mt += mlo(q_, MT);
    f32x4 acc[4][4];
    gemm_core<4>(X + (size_t)mt * 128 * ldx, ldx, W + (size_t)nt * 128 * K, K, K, acc);
    EPI_VARS
    const float* mrow = p.mod + ((size_t)l * 9 + mod_index(p, g, mt * 128)) * 6144 + goff + nt * 128 + wc_ * 64;
    __syncthreads();
    char* lb = smem + wid_ * 16384;
#pragma unroll
    for (int wi = 0; wi < 4; ++wi)
#pragma unroll
      for (int xi = 0; xi < 4; ++xi) {
        const int r = xi * 16 + fr_, c = wi * 4 + fq_;
        *(f32x4*)(lb + r * 256 + ((c ^ (r & 15)) << 4)) = acc[wi][xi];
      }
    const int c16 = lane_ & 15, rsub = lane_ >> 4;
    const float* xs = xsrc_row_ptr(p, g, mt * 128 + wr_ * 64, from_input) + nt * 128 + wc_ * 64 + c16 * 4;
    float* xd = xrow_ptr(p, g, mt * 128 + wr_ * 64) + nt * 128 + wc_ * 64 + c16 * 4;
    const float4 gv = *(const float4*)(mrow + c16 * 4);
#pragma unroll
    for (int half = 0; half < 2; ++half) {
      float4 xv[8];
#pragma unroll
      for (int it = 0; it < 8; ++it) xv[it] = *(const float4*)(xs + (size_t)((half * 8 + it) * 4 + rsub) * DM);
#pragma unroll
      for (int it = 0; it < 8; ++it) {
        const int row = (half * 8 + it) * 4 + rsub;
        const f32x4 a = *(const f32x4*)(lb + row * 256 + ((c16 ^ (row & 15)) << 4));
        float4 o;
        o.x = xv[it].x + gv.x * a[0]; o.y = xv[it].y + gv.y * a[1]; o.z = xv[it].z + gv.z * a[2]; o.w = xv[it].w + gv.w * a[3];
        *(float4*)(xd + (size_t)row * DM) = o;
      }
    }
  });
}

__device__ void phase_gu(const Params& p, int l, int* ctr) {
  const int MT = (l == 1 ? NBG * SEQ / 128 : RG / 128), NT = 44;
  const u16* W = p.wt + (size_t)l * W_LAYER + W_GU;
  run_q8(ctr, GEMM_CNT(MT, NT), [&](int q_, int j_) {
    int mt, nt; tile_order(j_, mlo(q_ + 1, MT) - mlo(q_, MT), NT, mt, nt); mt += mlo(q_, MT);
    f32x4 acc[4][4];
    gemm_core<4>(p.h + (size_t)mt * 128 * DM, DM, W + (size_t)nt * 128 * DM, DM, DM, acc);
    EPI_VARS
    u16* dst = p.proj + (nt >= 22 ? (size_t)RG * DFF : 0);
    const int nb = (nt >= 22 ? nt - 22 : nt) * 128;
    uint2 o[4][4];
#pragma unroll
    for (int wi = 0; wi < 4; ++wi)
#pragma unroll
      for (int xi = 0; xi < 4; ++xi) {
        o[wi][xi].x = pack2(acc[wi][xi][0], acc[wi][xi][1]); o[wi][xi].y = pack2(acc[wi][xi][2], acc[wi][xi][3]);
      }
    store_tile_bf16<4>(o, dst + (size_t)(mt * 128 + wr_ * 64) * DFF + nb + wc_ * 64, DFF);
  });
}

struct ActIn { uint4 g0, g1, g2, uu; float4 w0a, w0b, w1a, w1b, w2a, w2b, ba, bb; };
__device__ __forceinline__ void act_load(ActIn& a, const u16* G, const u16* UP, const float* cw, const float* cb, int r, int c0) {
  int bl, pos, isctx; rowinfo(r, NBG, bl, pos, isctx);
  const int L = isctx ? CTXL : SEQ;
  const u16* gp = G + (size_t)r * DFF + c0;
  a.g1 = *(const uint4*)gp;
  a.g0 = make_uint4(0, 0, 0, 0); a.g2 = a.g0;
  if (pos > 0) a.g0 = *(const uint4*)(gp - DFF);
  if (pos < L - 1) a.g2 = *(const uint4*)(gp + DFF);
  a.uu = *(const uint4*)(UP + (size_t)r * DFF + c0);
  a.w0a = *(const float4*)(cw + c0); a.w0b = *(const float4*)(cw + c0 + 4);
  a.w1a = *(const float4*)(cw + DFF + c0); a.w1b = *(const float4*)(cw + DFF + c0 + 4);
  a.w2a = *(const float4*)(cw + 2 * DFF + c0); a.w2b = *(const float4*)(cw + 2 * DFF + c0 + 4);
  a.ba = *(const float4*)(cb + c0); a.bb = *(const float4*)(cb + c0 + 4);
}
__device__ __forceinline__ uint4 act_compute(const ActIn& a) {
  uint4 o;
#define ACT2(G0, G1, G2, UU, W0L, W0H, W1L, W1H, W2L, W2H, BL, BH) \
  pack2(silu_f(W0L * bflo(G0) + W1L * bflo(G1) + W2L * bflo(G2) + BL) * bflo(UU), \
        silu_f(W0H * bfhi(G0) + W1H * bfhi(G1) + W2H * bfhi(G2) + BH) * bfhi(UU))
  o.x = ACT2(a.g0.x, a.g1.x, a.g2.x, a.uu.x, a.w0a.x, a.w0a.y, a.w1a.x, a.w1a.y, a.w2a.x, a.w2a.y, a.ba.x, a.ba.y);
  o.y = ACT2(a.g0.y, a.g1.y, a.g2.y, a.uu.y, a.w0a.z, a.w0a.w, a.w1a.z, a.w1a.w, a.w2a.z, a.w2a.w, a.ba.z, a.ba.w);
  o.z = ACT2(a.g0.z, a.g1.z, a.g2.z, a.uu.z, a.w0b.x, a.w0b.y, a.w1b.x, a.w1b.y, a.w2b.x, a.w2b.y, a.bb.x, a.bb.y);
  o.w = ACT2(a.g0.w, a.g1.w, a.g2.w, a.uu.w, a.w0b.z, a.w0b.w, a.w1b.z, a.w1b.w, a.w2b.z, a.w2b.w, a.bb.z, a.bb.w);
#undef ACT2
  return o;
}

__device__ void phase_act(const Params& p, int l, int* ctr) {
  const int nitems = (l == 1) ? NBG * SEQ / 8 : RG / 8;
  const float* cw = p.in[23] + (size_t)l * 3 * DFF;
  const float* cb = p.in[24] + (size_t)l * DFF;
  const u16* G = p.proj;
  u16* UP = p.proj + (size_t)RG * DFF;
  for (int it = blockIdx.x; it < nitems; it += gridDim.x) {
    const int tid = TIDX;
    for (int k = 0; k < 12; k += 2) {
      const int e0 = tid + k * 256, e1 = e0 + 256;
      const bool two = (k + 1 < 11);
      const int r0 = it * 8 + e0 / 352, c00 = (e0 % 352) * 8;
      const int r1 = it * 8 + (two ? e1 / 352 : 0), c01 = two ? (e1 % 352) * 8 : 0;
      ActIn a0, a1;
      act_load(a0, G, UP, cw, cb, r0, c00);
      act_load(a1, G, UP, cw, cb, r1, c01);
      const uint4 o0 = act_compute(a0), o1 = act_compute(a1);
      st_nt(UP + (size_t)r0 * DFF + c00, o0);
      if (two) st_nt(UP + (size_t)r1 * DFF + c01, o1);
    }
  }
}

__device__ void phase_final(const Params& p, int* ctr) {
  const int nitems = NBATCH * SEQ / 16;
  const float* gam = p.in[26];
  for (int it = blockIdx.x; it < nitems; it += gridDim.x) {
    const int lane = TIDX & 63, wid = TIDX >> 6;
    float* xr = p.out + ((size_t)it * 16 + wid * 4) * DM;
    float4 v[4][4], gg[4];
#pragma unroll
    for (int rr = 0; rr < 4; ++rr)
#pragma unroll
      for (int i = 0; i < 4; ++i) v[rr][i] = *(const float4*)(xr + (size_t)rr * DM + lane * 4 + i * 256);
#pragma unroll
    for (int i = 0; i < 4; ++i) gg[i] = *(const float4*)(gam + lane * 4 + i * 256);
#pragma unroll
    for (int rr = 0; rr < 4; ++rr) {
      float ss = 0.f;
#pragma unroll
      for (int i = 0; i < 4; ++i)
        ss += v[rr][i].x * v[rr][i].x + v[rr][i].y * v[rr][i].y + v[rr][i].z * v[rr][i].z + v[rr][i].w * v[rr][i].w;
      ss = wave_sum(ss);
      const float rstd = rsqrtf(ss * (1.f / 1024.f) + EPS);
#pragma unroll
      for (int i = 0; i < 4; ++i) {
        float4 o; o.x = v[rr][i].x * rstd * gg[i].x; o.y = v[rr][i].y * rstd * gg[i].y; o.z = v[rr][i].z * rstd * gg[i].z; o.w = v[rr][i].w * rstd * gg[i].w;
        st_nt(xr + (size_t)rr * DM + lane * 4 + i * 256, o);
      }
    }
  }
}

#define XB_TMO      128
#define XB_XCNT(j)  (256  + 64 * (j))
#define XB_XSUB(j)  (1280 + 64 * (j))
#define XB_XGEN(j)  (2304 + 64 * (j))
#define XB_TOP      3328
#define XB_TOPGEN   3392
#define XCD_BAR_WORDS 3456
#define XB_SPIN_CAP (1u << 22)
#define LAS __attribute__((address_space(3)))
__device__ __forceinline__ unsigned xb_ld(unsigned* p)              { return __hip_atomic_load(p, __ATOMIC_RELAXED, __HIP_MEMORY_SCOPE_AGENT); }
__device__ __forceinline__ unsigned xb_add(unsigned* p, unsigned v) { return __hip_atomic_fetch_add(p, v, __ATOMIC_RELAXED, __HIP_MEMORY_SCOPE_AGENT); }
__device__ __forceinline__ unsigned xb_xcc_id() { return (unsigned)__builtin_amdgcn_s_getreg((3 << 11) | 20) & 0xFu; }
#define XB_SPIN(cond, bar) do { unsigned _sp = 0; while (cond) { __builtin_amdgcn_s_sleep(1); \
    if ((++_sp & 255u) == 0u) { if (xb_ld(&(bar)[XB_TMO])) break; if (_sp > XB_SPIN_CAP) { atomicAdd(&(bar)[XB_TMO], 1u); break; } } } } while (0)
struct XcdBarrier { unsigned* bar; unsigned x; volatile LAS unsigned* st; };
__device__ __forceinline__ XcdBarrier xcd_barrier_post(unsigned* bar, volatile LAS unsigned* st) {
  XcdBarrier b; b.bar = bar; b.x = xb_xcc_id(); b.st = st;
  if (threadIdx.x == 0) (void)xb_add(&bar[XB_XCNT(b.x)], 1u);
  return b;
}
__device__ __forceinline__ void xcd_barrier_complete(unsigned* bar, unsigned x, unsigned& nloc, unsigned& nx) {
  const unsigned G = gridDim.x * gridDim.y * gridDim.z;
  unsigned sum, cnt, mine, sp = 0u;
  for (;;) {
    sum = 0u; cnt = 0u; mine = 0u;
#pragma unroll
    for (unsigned j = 0; j < 16; ++j) { const unsigned c = xb_ld(&bar[XB_XCNT(j)]); sum += c; cnt += (c > 0u) ? 1u : 0u; mine = (j == x) ? c : mine; }
    if (sum == G) break;
    __builtin_amdgcn_s_sleep(1);
    if ((++sp & 255u) == 0u) { if (xb_ld(&bar[XB_TMO])) break; if (sp > XB_SPIN_CAP) { atomicAdd(&bar[XB_TMO], 1u); break; } }
  }
  nloc = mine > 0u ? mine : 1u; nx = cnt > 0u ? cnt : 1u;
}
__device__ __forceinline__ void xcd_barrier(const XcdBarrier& b) {
  asm volatile("s_waitcnt vmcnt(0)" ::: "memory");
  __syncthreads();
  if (threadIdx.x == 0) {
    unsigned* bar = b.bar;
    __builtin_amdgcn_s_waitcnt(0);
    unsigned nloc = b.st[0], nx = b.st[1];
    if (nloc == 0u) { xcd_barrier_complete(bar, b.x, nloc, nx); b.st[0] = nloc; b.st[1] = nx; }
    const unsigned old = xb_add(&bar[XB_XSUB(b.x)], 1u);
    const unsigned gen = old / nloc;
    if (old + 1u == (gen + 1u) * nloc) {
      __builtin_amdgcn_fence(__ATOMIC_RELEASE, "agent");
      asm volatile("s_waitcnt vmcnt(0)" ::: "memory");
      const unsigned og = xb_add(&bar[XB_TOP], 1u);
      const unsigned tg = og / nx;
      if (og + 1u == (tg + 1u) * nx) xb_add(&bar[XB_TOPGEN], 1u);
      else XB_SPIN(xb_ld(&bar[XB_TOPGEN]) == tg, bar);
      __builtin_amdgcn_fence(__ATOMIC_ACQUIRE, "agent");
      xb_add(&bar[XB_XGEN(b.x)], 1u);
      asm volatile("s_waitcnt vmcnt(0)" ::: "memory");
    } else {
      XB_SPIN(xb_ld(&bar[XB_XGEN(b.x)]) == gen, bar);
      __builtin_amdgcn_fence(__ATOMIC_ACQUIRE, "agent");
      asm volatile("s_waitcnt vmcnt(0)" ::: "memory");
    }
  }
  __syncthreads();
}

__device__ void run_phase(const Params& p, int ph, int* ctr) {
  if (ph == 0) { phase0(p, ctr); return; }
  if (ph == NPHASES - 1) { phase_final(p, ctr); return; }
  const int idx = ph - 1, lg = idx / NPH_PER, sub = idx % NPH_PER;
  const int g = lg / 2, l = lg % 2;
  switch (sub) {
    case 0: phase_norm(p, l, g, 0, ctr); break;
    case 1: phase_proj(p, l, ctr, lg == 0); break;
    case 2: phase_postproj(p, l, ctr); break;
    case 3: phase_qkv(p, l, ctr); break;
    case 4: phase_attn(p, l, ctr); break;
    case 5: phase_merge(p, l, ctr); break;
    case 6: phase_resid(p, l, g, 0, ctr); break;
    case 7: phase_norm(p, l, g, 1, ctr); break;
    case 8: phase_gu(p, l, ctr); break;
    case 9: phase_act(p, l, ctr); break;
    default: phase_resid(p, l, g, 1, ctr); break;
  }
}

__global__ void __launch_bounds__(256, 2) mega_kernel(KArgs ka, int ph_lo, int ph_hi, int coop) {
  Params p;
#pragma unroll
  for (int i = 0; i < 27; ++i) p.in[i] = ka.in[i];
  p.out = ka.out;
  char* ws = ka.ws;
  p.ctr = (int*)(ws + O_CTR); p.mod = (float*)(ws + O_MOD); p.rope = (float*)(ws + O_ROPE); p.xc = (float*)(ws + O_XC);
  p.rstdq = (float*)(ws + O_RSQ); p.rstdkv = (float*)(ws + O_RSKV); p.dec = (float*)(ws + O_DEC); p.wt = (u16*)(ws + O_WT);
  p.proj = (u16*)(ws + O_PROJ); p.h = (u16*)(ws + O_H); p.m = (u16*)(ws + O_M); p.q = (u16*)(ws + O_Q);
  p.kf = (u16*)(ws + O_KF); p.vt = (u16*)(ws + O_VT); p.uc = (u16*)(ws + O_UC); p.gq = (u16*)(ws + O_GQ);
  p.ss = (u16*)(ws + O_SS);
  volatile LAS unsigned* st = (volatile LAS unsigned*)(smem + SLOT_OFF + 64);
  if (threadIdx.x == 0) { st[0] = 0u; st[1] = 0u; }
  __syncthreads();
  XcdBarrier xb;
  xb.bar = (unsigned*)(ws + O_BAR); xb.x = 0; xb.st = st;
  if (coop) xb = xcd_barrier_post((unsigned*)(ws + O_BAR), st);
  for (int ph = ph_lo; ph < ph_hi; ++ph) {
#ifdef PROBE_MASK
    const int nrep = (ph > 0 && ph < NPHASES - 1 && ((PROBE_MASK >> ((ph - 1) % NPH_PER)) & 1)) ? 2 : 1;
#else
    const int nrep = 1;
#endif
    for (int rep = 0; rep < nrep; ++rep) {
      if (rep) xcd_barrier(xb);
      run_phase(p, ph, p.ctr + rep * 512 + ph * 8);
    }
    if (coop && ph + 1 < ph_hi) {
      if (ph == ph_lo) cg::this_grid().sync();
      else xcd_barrier(xb);
    }
  }
}

static inline size_t align_up(size_t v) { return (v + 255) & ~(size_t)255; }

extern "C" void kernel_launch(void* const* d_in, const int* in_sizes, int n_in, void* d_out, int out_size,
                              void* d_ws, size_t ws_size, hipStream_t stream) {
  static int grid_blocks = 0;
  if (!grid_blocks) {
    int dev = 0, cus = 0, per_cu = 0;
    hipGetDevice(&dev);
    hipDeviceGetAttribute(&cus, hipDeviceAttributeMultiprocessorCount, dev);
    hipFuncSetAttribute((const void*)mega_kernel, hipFuncAttributeMaxDynamicSharedMemorySize, LDS_BYTES);
    hipOccupancyMaxActiveBlocksPerMultiprocessor(&per_cu, (const void*)mega_kernel, 256, LDS_BYTES);
    if (per_cu < 1) per_cu = 1;
    if (per_cu > 2) per_cu = 2;
    grid_blocks = cus * per_cu;
  }
  KArgs p{};
  for (int i = 0; i < 27; ++i) p.in[i] = (const float*)d_in[i];
  p.out = (float*)d_out;
  p.ws = (char*)d_ws;
  if (ws_size < WS_END) { fprintf(stderr, "workspace too small: %zu < %zu\n", ws_size, (size_t)WS_END); return; }
  hipMemsetAsync((char*)d_ws + O_CTR, 0, 4096 + XCD_BAR_BYTES, stream);
#if SINGLE_LAUNCH
  int lo = 0, hi = NPHASES, coop = 1;
  void* args[] = {&p, &lo, &hi, &coop};
  hipError_t e = hipLaunchCooperativeKernel((const void*)mega_kernel, dim3(grid_blocks), dim3(256), args, LDS_BYTES, stream);
  if (e != hipSuccess) fprintf(stderr, "cooperative launch failed: %s (grid %d)\n", hipGetErrorString(e), grid_blocks);
#else
  for (int ph = 0; ph < NPHASES; ++ph)
    hipLaunchKernelGGL(mega_kernel, dim3(grid_blocks), dim3(256), LDS_BYTES, stream, p, ph, ph + 1, 0);
#endif
}
```

```cpp
#include <hip/hip_runtime.h>
#include <hip/hip_cooperative_groups.h>
#include <cstdio>
#include <cstdint>
namespace cg = cooperative_groups;

typedef unsigned short u16;
typedef __attribute__((ext_vector_type(8))) short bf16x8;
typedef __attribute__((ext_vector_type(4))) float f32x4;
typedef __attribute__((ext_vector_type(16))) float f32x16;

#ifndef SINGLE_LAUNCH
#define SINGLE_LAUNCH 1
#endif

constexpr int DM = 1024, SEQ = 8192, CTXL = 256, NBATCH = 8, INW = 6592, INWP = 6656, DFF = 2816;
constexpr int C_QA = 0, C_KA = 256, C_VA = 512, C_RA = 1024, C_ALR = 1536, C_CQ = 1568, C_CKV = 1824,
              C_KR = 1952, C_SB = 1984, C_SC = 2496, C_SX = 3008, C_GATE = 3520;
constexpr int NKEY = SEQ + CTXL;
constexpr int NCHUNK = NKEY / 64;
constexpr float EPS = 1e-6f;
constexpr int LDS_BYTES = 65536 + 256;
constexpr int SLOT_OFF = 65536;
constexpr int NPH_PER = 11;
constexpr int NBG = 4;
constexpr int NGRP = NBATCH / NBG;
constexpr int RG = NBG * (SEQ + CTXL);
constexpr int NPHASES = 1 + 2 * NGRP * NPH_PER + 1;

constexpr size_t W_IN = 0;
constexpr size_t W_UQ = W_IN + (size_t)INWP * 1024;
constexpr size_t W_UKV = W_UQ + 768 * 256;
constexpr size_t W_BRA = W_UKV + 1024 * 128;
constexpr size_t W_BRB = W_BRA + 1024 * 512;
constexpr size_t W_BRC = W_BRB + 1024 * 512;
constexpr size_t W_O = W_BRC + 1024 * 512;
constexpr size_t W_GU = W_O + 1024 * 1024;
constexpr size_t W_DN = W_GU + (size_t)5632 * 1024;
constexpr size_t W_LAYER = W_DN + (size_t)1024 * 2816;

struct KArgs {
  const float* in[27];
  float* out;
  char* ws;
};
struct Params {
  const float* in[27];
  float* out;
  float* xc;
  u16* wt;
  float* mod;
  float* rope;
  int* ctr;
  float* rstdq;
  float* rstdkv;
  float* dec;
  u16* proj;
  u16* h;
  u16* m;
  u16* q;
  u16* kf;
  u16* vt;
  u16* uc;
  u16* gq;
  u16* ss;
};
constexpr size_t al256(size_t v) { return (v + 255) & ~(size_t)255; }
constexpr size_t XCD_BAR_BYTES = 3456 * 4;
constexpr size_t O_CTR = 0;
constexpr size_t O_BAR = O_CTR + 4096;
constexpr size_t O_MOD = al256(O_BAR + XCD_BAR_BYTES);
constexpr size_t O_ROPE = al256(O_MOD + (size_t)2 * 9 * 6144 * 4);
constexpr size_t O_XC = al256(O_ROPE + 1024 * 2 * 4);
constexpr size_t O_RSQ = al256(O_XC + (size_t)NBATCH * CTXL * DM * 4);
constexpr size_t O_RSKV = al256(O_RSQ + (size_t)RG * 4);
constexpr size_t O_DEC = al256(O_RSKV + (size_t)RG * 4);
constexpr size_t O_WT = al256(O_DEC + (size_t)NBG * NCHUNK * 4 * 2 * 64 * 4);
constexpr size_t O_PROJ = al256(O_WT + 2 * W_LAYER * 2);
constexpr size_t O_H = al256(O_PROJ + (size_t)RG * INW * 2);
constexpr size_t O_M = O_H + (size_t)RG * DM * 2;
constexpr size_t O_Q = al256(O_M + (size_t)RG * DM * 2);
constexpr size_t O_KF = al256(O_Q + (size_t)RG * 768 * 2);
constexpr size_t O_VT = al256(O_KF + (size_t)NBG * 8 * NKEY * 96 * 2);
constexpr size_t O_UC = al256(O_VT + (size_t)NBG * 8 * 64 * NKEY * 2);
constexpr size_t O_GQ = al256(O_UC + (size_t)RG * 512 * 2);
constexpr size_t O_SS = al256(O_GQ + (size_t)RG * 1024 * 2);
constexpr size_t WS_END = al256(O_SS + (size_t)NBG * NCHUNK * 4 * 2 * 8192 * 2);
static_assert(WS_END <= ((size_t)1 << 30), "workspace layout must fit 1 GiB");

extern __shared__ __attribute__((aligned(16))) char smem[];

typedef __bf16 hbf2 __attribute__((ext_vector_type(2)));
typedef float hf2 __attribute__((ext_vector_type(2)));
__device__ __forceinline__ unsigned pack2(float a, float b) {
  hf2 v = {a, b};
  return __builtin_bit_cast(unsigned, __builtin_convertvector(v, hbf2));
}
__device__ __forceinline__ u16 f2bf(float f) { return (u16)(pack2(f, 0.f) & 0xffffu); }
__device__ __forceinline__ float bf2f(u16 h) { return __uint_as_float(((unsigned)h) << 16); }
__device__ __forceinline__ float bflo(unsigned u) { return __uint_as_float(u << 16); }
__device__ __forceinline__ float bfhi(unsigned u) { return __uint_as_float(u & 0xffff0000u); }
typedef unsigned nt_u32x4 __attribute__((ext_vector_type(4)));
typedef unsigned nt_u32x2 __attribute__((ext_vector_type(2)));
__device__ __forceinline__ void st_nt(void* p, uint4 v) { nt_u32x4 t = {v.x, v.y, v.z, v.w}; __builtin_nontemporal_store(t, (nt_u32x4*)p); }
__device__ __forceinline__ void st_nt(void* p, uint2 v) { nt_u32x2 t = {v.x, v.y}; __builtin_nontemporal_store(t, (nt_u32x2*)p); }
__device__ __forceinline__ void st_nt(void* p, float4 v) { f32x4 t = {v.x, v.y, v.z, v.w}; __builtin_nontemporal_store(t, (f32x4*)p); }
__device__ __forceinline__ float silu_f(float x) { return x / (1.f + __expf(-x)); }
__device__ __forceinline__ float sigmoid_f(float x) { return 1.f / (1.f + __expf(-x)); }

__device__ __forceinline__ void rowinfo(int r, int NB, int& bl, int& pos, int& isctx) {
  const int nl = NB * SEQ;
  if (r < nl) { bl = r >> 13; pos = r & (SEQ - 1); isctx = 0; }
  else { const int rc = r - nl; bl = rc >> 8; pos = rc & (CTXL - 1); isctx = 1; }
}
__device__ __forceinline__ int chunk_row(int bl, int cidx, int NB) {
  return cidx < 128 ? bl * SEQ + cidx * 64 : NB * SEQ + bl * CTXL + (cidx - 128) * 64;
}

template <class CntF, class BodyF>
__device__ __forceinline__ void run_q8(int* ctr8, CntF cntf, BodyF body) {
  volatile int* slot = (volatile int*)(smem + SLOT_OFF);
  int q = blockIdx.x & 7, tries = 0, item;
  __syncthreads();
  if (threadIdx.x == 0) {
    int v = atomicAdd(&ctr8[q], 1);
    while (v >= cntf(q) && tries < 8) { q = (q + 1) & 7; ++tries; if (tries < 8) v = atomicAdd(&ctr8[q], 1); }
    slot[0] = (tries < 8) ? v : -1; slot[1] = q; slot[2] = tries;
  }
  __syncthreads();
  item = slot[0]; q = slot[1]; tries = slot[2];
  while (item >= 0) {
    int nxt = 0;
    if (threadIdx.x == 0) nxt = atomicAdd(&ctr8[q], 1);
    body(q, item);
    __syncthreads();
    if (threadIdx.x == 0) {
      int qq = q, t = tries;
      while (nxt >= cntf(qq) && t < 8) { qq = (qq + 1) & 7; ++t; if (t < 8) nxt = atomicAdd(&ctr8[qq], 1); }
      slot[0] = (t < 8) ? nxt : -1; slot[1] = qq; slot[2] = t;
    }
    __syncthreads();
    item = slot[0]; q = slot[1]; tries = slot[2];
  }
}
#define QA_CNT(N) [=](int q_) { return ((N) - q_ + 7) >> 3; }
#define QA_ID(q_, j_) ((j_) * 8 + (q_))

__device__ __forceinline__ int opaque_tid() {
  int t = threadIdx.x;
  asm volatile("" : "+v"(t));
  return t;
}
#define TIDX opaque_tid()
template <int M>
__device__ __forceinline__ float xor_lane(float v) {
  if constexpr (M == 32) {
    const unsigned u = __float_as_uint(v);
    const auto sw = __builtin_amdgcn_permlane32_swap(u, u, false, false);
    const int lane = __builtin_amdgcn_mbcnt_hi(~0u, __builtin_amdgcn_mbcnt_lo(~0u, 0u));
    return __uint_as_float(lane < 32 ? sw[1] : sw[0]);
  } else {
    return __uint_as_float((unsigned)__builtin_amdgcn_ds_swizzle((int)__float_as_uint(v), 0x1f | (M << 10)));
  }
}
__device__ __forceinline__ float wave_sum(float v) {
  v += xor_lane<32>(v); v += xor_lane<16>(v); v += xor_lane<8>(v);
  v += xor_lane<4>(v); v += xor_lane<2>(v); v += xor_lane<1>(v);
  return v;
}

__device__ __forceinline__ int lds_byte(int r, int c) {
  const int st = (r >> 4) * 2 + (c >> 5), rr = r & 15, cc = c & 31, ob = rr * 64 + cc * 2;
  return st * 1024 + (ob ^ (((ob >> 9) & 1) << 5));
}
__device__ __forceinline__ void stage_rc(int b, int& R, int& C) {
  const int st = b >> 10, sb = b & 1023, swz = sb ^ (((sb >> 9) & 1) << 5);
  R = (st >> 1) * 16 + (swz >> 6); C = (st & 1) * 32 + ((swz & 63) >> 1);
}

__device__ __forceinline__ void glds16(const void* g, void* l) {
  __builtin_amdgcn_global_load_lds((const __attribute__((address_space(1))) unsigned*)g,
                                   (__attribute__((address_space(3))) unsigned*)l, 16, 0, 0);
}

template <int NWI>
__device__ __forceinline__ void gemm_core(const u16* __restrict__ X, int ldx, const u16* __restrict__ W, int ldw,
                                          int K, f32x4 (&acc)[NWI][4]) {
  const int tid = TIDX, lane = tid & 63, wid = tid >> 6;
  const int wr = wid >> 1, wc = wid & 1, fr = lane & 15, fq = lane >> 4;
#pragma unroll
  for (int a = 0; a < NWI; ++a)
#pragma unroll
    for (int b = 0; b < 4; ++b) acc[a][b] = f32x4{0.f, 0.f, 0.f, 0.f};
  const int srow = tid >> 3, schunk = (tid & 7) ^ ((tid >> 4) & 7);
  const u16* xg = X + (size_t)srow * ldx + schunk * 8;
  const u16* wg = W + (size_t)srow * ldw + schunk * 8;
  const int xs = 32 * ldx, ws_ = 32 * ldw;
  const int g = fr >> 1;
  const int lo0 = fr * 128 + ((fq ^ g) << 4), lo1 = fr * 128 + (((fq ^ g) ^ 4) << 4);
  const char* xb = smem + wr * 8192;
  const char* wb = smem + 16384 + wc * (NWI * 2048);
  char* sdst = smem + tid * 16;
  const int nt = K >> 6;
  __syncthreads();
#pragma unroll
  for (int i = 0; i < 4; ++i) {
    glds16(xg + i * xs, sdst + i * 4096);
    if (i < NWI) glds16(wg + i * ws_, sdst + 16384 + i * 4096);
  }
  for (int kt = 0; kt < nt; ++kt) {
    asm volatile("s_waitcnt vmcnt(0)" ::: "memory");
    __syncthreads();
    const int cb = (kt & 1) * 32768;
    if (kt + 1 < nt) {
      const int nb = 32768 - cb;
      const int ko = (kt + 1) * 64;
#pragma unroll
      for (int i = 0; i < 4; ++i) {
        glds16(xg + i * xs + ko, sdst + nb + i * 4096);
        if (i < NWI) glds16(wg + i * ws_ + ko, sdst + nb + 16384 + i * 4096);
      }
    }
    bf16x8 wf[2][NWI], xf[2][4];
#pragma unroll
    for (int i = 0; i < NWI; ++i) {
      wf[0][i] = *(const bf16x8*)(wb + cb + i * 2048 + lo0);
      wf[1][i] = *(const bf16x8*)(wb + cb + i * 2048 + lo1);
    }
#pragma unroll
    for (int i = 0; i < 4; ++i) {
      xf[0][i] = *(const bf16x8*)(xb + cb + i * 2048 + lo0);
      xf[1][i] = *(const bf16x8*)(xb + cb + i * 2048 + lo1);
    }
    __builtin_amdgcn_sched_barrier(0);
#pragma unroll
    for (int k = 0; k < 2; ++k)
#pragma unroll
      for (int wi = 0; wi < NWI; ++wi)
#pragma unroll
        for (int xi = 0; xi < 4; ++xi)
          acc[wi][xi] = __builtin_amdgcn_mfma_f32_16x16x32_bf16(wf[k][wi], xf[k][xi], acc[wi][xi], 0, 0, 0);
    __builtin_amdgcn_sched_barrier(0);
  }
}

#define EPI_VARS const int tid_ = TIDX, lane_ = tid_ & 63, wid_ = tid_ >> 6; \
  const int wr_ = wid_ >> 1, wc_ = wid_ & 1, fr_ = lane_ & 15, fq_ = lane_ >> 4; (void)fq_; (void)fr_; (void)wr_; (void)wc_;
#define EPI_TR(xi) (wr_ * 64 + (xi) * 16 + fr_)
#define EPI_NN(wi) (wc_ * 64 + (wi) * 16 + fq_ * 4)

template <int NWI>
__device__ __forceinline__ void store_tile_bf16(const uint2 (&o)[NWI][4], u16* dst_wave, size_t ld) {
  constexpr int RB = NWI * 32, CPR = RB / 16;
  const int tid = TIDX, lane = tid & 63, wid = tid >> 6, fr = lane & 15, fq = lane >> 4;
  char* lb = smem + wid * 8192;
#pragma unroll
  for (int wi = 0; wi < NWI; ++wi)
#pragma unroll
    for (int xi = 0; xi < 4; ++xi) {
      const int r = xi * 16 + fr, c = wi * 2 + (fq >> 1);
      *(uint2*)(lb + r * RB + ((c ^ (r & (CPR - 1))) << 4) + (fq & 1) * 8) = o[wi][xi];
    }
#pragma unroll
  for (int it = 0; it < CPR; ++it) {
    const int idx = it * 64 + lane, row = idx / CPR, c = idx % CPR;
    typedef unsigned u32x4_t __attribute__((ext_vector_type(4)));
    const u32x4_t v = *(const u32x4_t*)(lb + row * RB + ((c ^ (row & (CPR - 1))) << 4));
    __builtin_nontemporal_store(v, (u32x4_t*)(dst_wave + (size_t)row * ld + c * 8));
  }
}

__device__ __forceinline__ void tile_order(int t, int MT, int NT, int& mt, int& nt) {
  constexpr int GM = 4;
  const int band = t / (GM * NT), rem = t - band * GM * NT;
  const int m0 = band * GM;
  const int gsz = min(GM, MT - m0);
  nt = rem / gsz; mt = m0 + rem - nt * gsz;
}

__device__ __forceinline__ int mlo(int q, int MT) { return (q * MT) >> 3; }
#define GEMM_CNT(MT, NT) [=](int q_) { return (mlo(q_ + 1, MT) - mlo(q_, MT)) * (NT); }

__device__ __forceinline__ float* xrow_ptr(const Params& p, int g, int r) {
  int bl, pos, isctx; rowinfo(r, NBG, bl, pos, isctx);
  const int b = g * NBG + bl;
  return isctx ? p.xc + ((size_t)b * CTXL + pos) * DM : p.out + ((size_t)b * SEQ + pos) * DM;
}
__device__ __forceinline__ const float* xsrc_row_ptr(const Params& p, int g, int r, int from_input) {
  int bl, pos, isctx; rowinfo(r, NBG, bl, pos, isctx);
  const int b = g * NBG + bl;
  if (from_input) return isctx ? p.in[2] + ((size_t)b * CTXL + pos) * DM : p.in[0] + ((size_t)b * SEQ + pos) * DM;
  return isctx ? p.xc + ((size_t)b * CTXL + pos) * DM : p.out + ((size_t)b * SEQ + pos) * DM;
}
__device__ __forceinline__ int mod_index(const Params& p, int g, int r) {
  int bl, pos, isctx; rowinfo(r, NBG, bl, pos, isctx);
  return isctx ? 8 : g * NBG + bl;
}

__device__ void conv_tile4(const float* __restrict__ src, int K, int N, u16* __restrict__ dst,
                           const float* __restrict__ scale, int ktile, int ngrp) {
  float* tile = (float*)smem;
  const int tid = TIDX;
  const int k0 = ktile * 64;
  const int kk = tid >> 4, n4 = (tid & 15) * 4;
  float4 v[4][4];
  float sc[4];
#pragma unroll
  for (int i = 0; i < 4; ++i) sc[i] = scale ? scale[k0 + kk + 16 * i] : 1.f;
#pragma unroll
  for (int t = 0; t < 4; ++t) {
    const int n0 = (ngrp * 4 + t) * 64;
#pragma unroll
    for (int i = 0; i < 4; ++i) {
      v[t][i] = make_float4(0.f, 0.f, 0.f, 0.f);
      if (n0 < N) v[t][i] = *(const float4*)(src + (size_t)(k0 + kk + 16 * i) * N + n0 + n4);
    }
  }
  const int nn = tid >> 3, k8 = (tid & 7) * 8;
#pragma unroll
  for (int t = 0; t < 4; ++t) {
    const int n0 = (ngrp * 4 + t) * 64;
    __syncthreads();
#pragma unroll
    for (int i = 0; i < 4; ++i) {
      const int k = kk + 16 * i;
      tile[k * 65 + n4 + 0] = v[t][i].x * sc[i]; tile[k * 65 + n4 + 1] = v[t][i].y * sc[i];
      tile[k * 65 + n4 + 2] = v[t][i].z * sc[i]; tile[k * 65 + n4 + 3] = v[t][i].w * sc[i];
    }
    __syncthreads();
#pragma unroll
    for (int i = 0; i < 2; ++i) {
      const int n = nn + 32 * i;
      uint4 o;
      o.x = pack2(tile[(k8 + 0) * 65 + n], tile[(k8 + 1) * 65 + n]);
      o.y = pack2(tile[(k8 + 2) * 65 + n], tile[(k8 + 3) * 65 + n]);
      o.z = pack2(tile[(k8 + 4) * 65 + n], tile[(k8 + 5) * 65 + n]);
      o.w = pack2(tile[(k8 + 6) * 65 + n], tile[(k8 + 7) * 65 + n]);
      *(uint4*)(dst + (size_t)(n0 + n) * K + k0 + k8) = o;
    }
  }
}

__device__ void sincos_d(double a, double& s, double& c) {
  const double k = rint(a * 0.6366197723675814);
  double r = fma(-k, 1.5707963267948966, a);
  r = fma(-k, 6.123233995736766e-17, r);
  const int q = ((int)k) & 3;
  const double r2 = r * r;
  const double sp = r * (1.0 + r2 * (-1.0 / 6 + r2 * (1.0 / 120 + r2 * (-1.0 / 5040 + r2 * (1.0 / 362880 + r2 * (-1.0 / 39916800 + r2 * (1.0 / 6227020800.0)))))));
  const double cp = 1.0 + r2 * (-0.5 + r2 * (1.0 / 24 + r2 * (-1.0 / 720 + r2 * (1.0 / 40320 + r2 * (-1.0 / 3628800 + r2 * (1.0 / 479001600.0 + r2 * (-1.0 / 87178291200.0)))))));
  s = (q == 0) ? sp : (q == 1) ? cp : (q == 2) ? -sp : -cp;
  c = (q == 0) ? cp : (q == 1) ? -sp : (q == 2) ? -cp : sp;
}

constexpr int CV_WIN = 0, CV_UQ = 416, CV_UKV = 428, CV_BRA = 436, CV_BRB = 468, CV_BRC = 500,
              CV_WO = 532, CV_GATE = 596, CV_UP = 772, CV_DN = 948, CV_LAYER = 1124;
constexpr int P0_CONV = 2 * CV_LAYER, P0_ADA = 2 * 192, P0_TOTAL = P0_CONV + P0_ADA + 1;

__device__ __forceinline__ void conv_item(const Params& p, int ci) {
  const int l = ci / CV_LAYER, j = ci % CV_LAYER;
  u16* wl = p.wt + (size_t)l * W_LAYER;
  if (j < CV_UQ)       { const int jj = j - CV_WIN;  conv_tile4(p.in[7] + (size_t)l * 1024 * INW, 1024, INW, wl + W_IN, nullptr, jj / 26, jj % 26); }
  else if (j < CV_UKV) { const int jj = j - CV_UQ;   conv_tile4(p.in[12] + (size_t)l * 256 * 768, 256, 768, wl + W_UQ, p.in[11] + l * 256, jj / 3, jj % 3); }
  else if (j < CV_BRA) { const int jj = j - CV_UKV;  conv_tile4(p.in[14] + (size_t)l * 128 * 1024, 128, 1024, wl + W_UKV, p.in[13] + l * 128, jj / 4, jj % 4); }
  else if (j < CV_BRB) { const int jj = j - CV_BRA;  conv_tile4(p.in[16] + (size_t)l * 512 * 1024, 512, 1024, wl + W_BRA, nullptr, jj / 4, jj % 4); }
  else if (j < CV_BRC) { const int jj = j - CV_BRB;  conv_tile4(p.in[17] + (size_t)l * 512 * 1024, 512, 1024, wl + W_BRB, nullptr, jj / 4, jj % 4); }
  else if (j < CV_WO)  { const int jj = j - CV_BRC;  conv_tile4(p.in[18] + (size_t)l * 512 * 1024, 512, 1024, wl + W_BRC, nullptr, jj / 4, jj % 4); }
  else if (j < CV_GATE){ const int jj = j - CV_WO;   conv_tile4(p.in[19] + (size_t)l * 1024 * 1024, 1024, 1024, wl + W_O, nullptr, jj / 4, jj % 4); }
  else if (j < CV_UP)  { const int jj = j - CV_GATE; conv_tile4(p.in[21] + (size_t)l * 1024 * DFF, 1024, DFF, wl + W_GU, nullptr, jj / 11, jj % 11); }
  else if (j < CV_DN)  { const int jj = j - CV_UP;   conv_tile4(p.in[22] + (size_t)l * 1024 * DFF, 1024, DFF, wl + W_GU + (size_t)DFF * 1024, nullptr, jj / 11, jj % 11); }
  else                 { const int jj = j - CV_DN;   conv_tile4(p.in[25] + (size_t)l * DFF * 1024, DFF, 1024, wl + W_DN, nullptr, jj / 4, jj % 4); }
}
constexpr int P0_EARLY = CV_UQ;
constexpr int P0_DEFER = P0_CONV - P0_EARLY;

__device__ void phase0(const Params& p, int* ctr) {
  run_q8(ctr, QA_CNT(P0_ADA + 1 + P0_EARLY), [&](int q_, int j_) {
    const int it = QA_ID(q_, j_);
    const int tid = TIDX;
    if (it >= P0_ADA + 1) {
      conv_item(p, it - (P0_ADA + 1));
    } else if (it < P0_ADA) {
      const int a = it, l = a / 192, cg_ = a % 192;
      float* sc = (float*)smem;
      float* red = sc + 9 * 1024;
      for (int e = tid; e < 9 * 1024; e += 256) {
        const int v = e >> 10, k = e & 1023;
        const float cv = (v < 8) ? p.in[1][v * 1024 + k] : p.in[3][k];
        sc[e] = cv / (1.f + expf(-cv));
      }
      __syncthreads();
      const int kg = tid >> 5, cn = tid & 31;
      const float* wa = p.in[4] + (size_t)l * 1024 * 6144 + cg_ * 32 + cn;
      float a0 = 0, a1 = 0, a2 = 0, a3 = 0, a4 = 0, a5 = 0, a6 = 0, a7 = 0, a8 = 0;
#pragma unroll 8
      for (int i = 0; i < 128; ++i) {
        const int k = kg + 8 * i;
        const float w = wa[(size_t)k * 6144];
        a0 += sc[k] * w; a1 += sc[1024 + k] * w; a2 += sc[2048 + k] * w; a3 += sc[3072 + k] * w;
        a4 += sc[4096 + k] * w; a5 += sc[5120 + k] * w; a6 += sc[6144 + k] * w; a7 += sc[7168 + k] * w;
        a8 += sc[8192 + k] * w;
      }
      float* rr = red + kg * 288 + cn;
      rr[0] = a0; rr[32] = a1; rr[64] = a2; rr[96] = a3; rr[128] = a4; rr[160] = a5; rr[192] = a6; rr[224] = a7; rr[256] = a8;
      __syncthreads();
      for (int e = tid; e < 288; e += 256) {
        float s = 0.f;
#pragma unroll
        for (int g8 = 0; g8 < 8; ++g8) s += red[g8 * 288 + e];
        const int v = e >> 5, n = cg_ * 32 + (e & 31);
        p.mod[((size_t)l * 9 + v) * 6144 + n] = s + p.in[5][l * 6144 + n];
      }
    } else {
      for (int e = tid; e < 1024; e += 256) {
        const int pos = e >> 3, f = e & 7;
        const float inv = (f == 0) ? 1.0f : (f == 1) ? 0.31622776601683794f : (f == 2) ? 0.1f : (f == 3) ? 0.031622776601683794f
                        : (f == 4) ? 0.01f : (f == 5) ? 0.0031622776601683794f : (f == 6) ? 0.001f : 0.00031622776601683794f;
        const float ang = (float)pos * inv;
        double s, c; sincos_d((double)ang, s, c);
        p.rope[e * 2] = (float)c; p.rope[e * 2 + 1] = (float)s;
      }
    }
  });
}

__device__ void phase_norm(const Params& p, int l, int g, int which, int* ctr) {
  const int nitems = (which == 1 && l == 1) ? NBG * SEQ / 16 : RG / 16;
  const float* gam = (which == 0 ? p.in[6] : p.in[20]) + l * DM;
  const int shoff = which == 0 ? 0 : 3072, scoff = which == 0 ? 1024 : 4096;
  const int from_input = (which == 0 && l == 0);
  for (int it = blockIdx.x; it < nitems; it += gridDim.x) {
    const int lane = TIDX & 63, wid = TIDX >> 6;
    const int r0 = it * 16 + wid * 4;
    const float* xr = xsrc_row_ptr(p, g, r0, from_input);
    const float* mrow = p.mod + ((size_t)l * 9 + mod_index(p, g, r0)) * 6144;
    float4 v[4][4], gg[4], sh[4], sc[4];
#pragma unroll
    for (int rr = 0; rr < 4; ++rr)
#pragma unroll
      for (int i = 0; i < 4; ++i) v[rr][i] = *(const float4*)(xr + (size_t)rr * DM + lane * 4 + i * 256);
#pragma unroll
    for (int i = 0; i < 4; ++i) {
      const int c = lane * 4 + i * 256;
      gg[i] = *(const float4*)(gam + c); sh[i] = *(const float4*)(mrow + shoff + c); sc[i] = *(const float4*)(mrow + scoff + c);
    }
#pragma unroll
    for (int rr = 0; rr < 4; ++rr) {
      float ss = 0.f;
#pragma unroll
      for (int i = 0; i < 4; ++i)
        ss += v[rr][i].x * v[rr][i].x + v[rr][i].y * v[rr][i].y + v[rr][i].z * v[rr][i].z + v[rr][i].w * v[rr][i].w;
      ss = wave_sum(ss);
      const float rstd = rsqrtf(ss * (1.f / 1024.f) + EPS);
#pragma unroll
      for (int i = 0; i < 4; ++i) {
        const int c = lane * 4 + i * 256;
        uint2 o;
        o.x = pack2(v[rr][i].x * rstd * gg[i].x * (1.f + sc[i].x) + sh[i].x, v[rr][i].y * rstd * gg[i].y * (1.f + sc[i].y) + sh[i].y);
        o.y = pack2(v[rr][i].z * rstd * gg[i].z * (1.f + sc[i].z) + sh[i].z, v[rr][i].w * rstd * gg[i].w * (1.f + sc[i].w) + sh[i].w);
        st_nt(p.h + (size_t)(r0 + rr) * DM + c, o);
      }
    }
  }
}

__device__ void phase_proj(const Params& p, int l, int* ctr, bool first) {
  const int MT = RG / 128, NT = INWP / 128;
  const u16* W = p.wt + (size_t)l * W_LAYER + W_IN;
  const int ndef = first ? P0_DEFER : 0;
  run_q8(ctr, [=](int q_) { return ((ndef - q_ + 7) >> 3) + (mlo(q_ + 1, MT) - mlo(q_, MT)) * NT; }, [&](int q_, int jq_) {
    const int nd = (ndef - q_ + 7) >> 3;
    if (jq_ < nd) { conv_item(p, P0_EARLY + QA_ID(q_, jq_)); return; }
    const int j_ = jq_ - nd;
    int mt, nt; tile_order(j_, mlo(q_ + 1, MT) - mlo(q_, MT), NT, mt, nt); mt += mlo(q_, MT);
    f32x4 acc[4][4];
    gemm_core<4>(p.h + (size_t)mt * 128 * DM, DM, W + (size_t)nt * 128 * DM, DM, DM, acc);
    EPI_VARS
    uint2 o[4][4];
#pragma unroll
    for (int wi = 0; wi < 4; ++wi)
#pragma unroll
      for (int xi = 0; xi < 4; ++xi) {
        o[wi][xi].x = pack2(acc[wi][xi][0], acc[wi][xi][1]); o[wi][xi].y = pack2(acc[wi][xi][2], acc[wi][xi][3]);
      }
    if (nt * 128 + wc_ * 64 < INW)
      store_tile_bf16<4>(o, p.proj + (size_t)(mt * 128 + wr_ * 64) * INW + nt * 128 + wc_ * 64, INW);
  });
}

__device__ void postproj_rows(const Params& p, int l, int it) {
  const int lane = TIDX & 63, wid = TIDX >> 6;
  const float* scw = p.in[15] + (size_t)l * 3 * 512;
  for (int rr = 0; rr < 4; ++rr) {
    const int r = it * 16 + wid * 4 + rr;
    int bl, pos, isctx; rowinfo(r, NBG, bl, pos, isctx);
    const u16* pr = p.proj + (size_t)r * INW;
    const int Lr = isctx ? CTXL : SEQ;
    const int c0 = lane * 8;
    const uint2 u_cq = *(const uint2*)(pr + C_CQ + lane * 4);
    const unsigned u_ckv = *(const unsigned*)(pr + C_CKV + lane * 2);
    const u16 u_kr = pr[C_KR + (lane & 31)];
    const uint4 sb = *(const uint4*)(pr + C_SB + c0);
    const uint4 sc1 = *(const uint4*)(pr + C_SC + c0);
    const uint4 sx1 = *(const uint4*)(pr + C_SX + c0);
    uint4 sc0 = make_uint4(0, 0, 0, 0), sx0 = sc0, sc2 = sc0, sx2 = sc0;
    if (pos > 0) { sc0 = *(const uint4*)(pr - INW + C_SC + c0); sx0 = *(const uint4*)(pr - INW + C_SX + c0); }
    if (pos < Lr - 1) { sc2 = *(const uint4*)(pr + INW + C_SC + c0); sx2 = *(const uint4*)(pr + INW + C_SX + c0); }
    {
      const uint2 u = u_cq;
      const float a = bflo(u.x), b = bfhi(u.x), c = bflo(u.y), d = bfhi(u.y);
      float ss = wave_sum(a * a + b * b + c * c + d * d);
      if (lane == 0) p.rstdq[r] = rsqrtf(ss * (1.f / 256.f) + EPS);
    }
    {
      const unsigned u = u_ckv;
      const float a = bflo(u), b = bfhi(u);
      float ss = wave_sum(a * a + b * b);
      if (lane == 0) p.rstdkv[r] = rsqrtf(ss * (1.f / 128.f) + EPS);
    }
    {
      const int idx = lane & 31;
      const float val = bf2f(u_kr);
      const float partner = xor_lane<8>(val);
      float o = val;
      if (!isctx) {
        const int axis = idx >> 4, half = (idx >> 3) & 1, f = idx & 7;
        const int pa = axis ? (pos & 63) : (pos >> 6);
        const float c = p.rope[(pa * 8 + f) * 2], s = p.rope[(pa * 8 + f) * 2 + 1];
        o = half ? (val * c + partner * s) : (val * c - partner * s);
      }
      const int j = isctx ? SEQ + pos : pos;
      const u16 ob = f2bf(o);
      if (lane < 32) {
#pragma unroll
        for (int hd = 0; hd < 8; ++hd)
          p.kf[((size_t)(bl * 8 + hd) * NKEY + j) * 96 + 64 + idx] = ob;
      }
    }
    {
      const float4 w0a = *(const float4*)(scw + c0), w0b = *(const float4*)(scw + c0 + 4);
      const float4 w1a = *(const float4*)(scw + 512 + c0), w1b = *(const float4*)(scw + 512 + c0 + 4);
      const float4 w2a = *(const float4*)(scw + 1024 + c0), w2b = *(const float4*)(scw + 1024 + c0 + 4);
      uint4 o;
#define UC2(SBW, A0, X0, A1, X1, A2, X2, W0L, W0H, W1L, W1H, W2L, W2H) \
      pack2(bflo(SBW) * (W0L * bflo(A0) * bflo(X0) + W1L * bflo(A1) * bflo(X1) + W2L * bflo(A2) * bflo(X2)), \
            bfhi(SBW) * (W0H * bfhi(A0) * bfhi(X0) + W1H * bfhi(A1) * bfhi(X1) + W2H * bfhi(A2) * bfhi(X2)))
      o.x = UC2(sb.x, sc0.x, sx0.x, sc1.x, sx1.x, sc2.x, sx2.x, w0a.x, w0a.y, w1a.x, w1a.y, w2a.x, w2a.y);
      o.y = UC2(sb.y, sc0.y, sx0.y, sc1.y, sx1.y, sc2.y, sx2.y, w0a.z, w0a.w, w1a.z, w1a.w, w2a.z, w2a.w);
      o.z = UC2(sb.z, sc0.z, sx0.z, sc1.z, sx1.z, sc2.z, sx2.z, w0b.x, w0b.y, w1b.x, w1b.y, w2b.x, w2b.y);
      o.w = UC2(sb.w, sc0.w, sx0.w, sc1.w, sx1.w, sc2.w, sx2.w, w0b.z, w0b.w, w1b.z, w1b.w, w2b.z, w2b.w);
#undef UC2
      st_nt(p.uc + (size_t)r * 512 + c0, o);
    }
  }
}

__device__ __forceinline__ float logsig16(float z) {
  return (fminf(z, 0.f) - __logf(1.f + __expf(-fabsf(z)))) * (1.f / 16.f);
}

__device__ void gla_prep(const Params& p, int l, int it) {
  const int tid = TIDX, lane = tid & 63, wid = tid >> 6;
  const int bl = it / (NCHUNK * 4), rem = it % (NCHUNK * 4), cidx = rem >> 2, h = rem & 3;
  const int r0 = chunk_row(bl, cidx, NBG);
  float* lr = (float*)smem;
  float* tot = (float*)(smem + 8192);
  u16* vT = (u16*)(smem + 10752);
  u16* kTf = (u16*)(smem + 29184);
  u16* kTb = (u16*)(smem + 38400);
  {
    const int t = tid >> 2, c8 = (tid & 3) * 8;
    const uint4 u = *(const uint4*)(p.proj + (size_t)(r0 + t) * INW + C_ALR + c8);
    float* d = lr + t * 32 + c8;
    d[0] = bflo(u.x); d[1] = bfhi(u.x); d[2] = bflo(u.y); d[3] = bfhi(u.y);
    d[4] = bflo(u.z); d[5] = bfhi(u.z); d[6] = bflo(u.w); d[7] = bfhi(u.w);
    const int dvc = (tid & 3) * 32;
    const u16* vp = p.proj + (size_t)(r0 + t) * INW + C_VA + h * 128 + dvc;
#pragma unroll
    for (int i = 0; i < 4; ++i) {
      const uint4 vv = *(const uint4*)(vp + i * 8);
      u16* dst = vT + (size_t)(dvc + i * 8) * 72 + t;
      dst[0] = (u16)(vv.x & 0xffff); dst[72] = (u16)(vv.x >> 16);
      dst[144] = (u16)(vv.y & 0xffff); dst[216] = (u16)(vv.y >> 16);
      dst[288] = (u16)(vv.z & 0xffff); dst[360] = (u16)(vv.z >> 16);
      dst[432] = (u16)(vv.w & 0xffff); dst[504] = (u16)(vv.w >> 16);
    }
  }
  __syncthreads();
  const int dk = lane, tg = wid;
  const float* w2f = p.in[8] + ((size_t)(l * 2 + 0) * 16) * 256 + h * 64 + dk;
  const float* w2b = p.in[8] + ((size_t)(l * 2 + 1) * 16) * 256 + h * 64 + dk;
  float wf[16], wb[16];
#pragma unroll
  for (int r = 0; r < 16; ++r) { wf[r] = w2f[r * 256]; wb[r] = w2b[r * 256]; }
  const float biasf = p.in[9][(l * 2 + 0) * 256 + h * 64 + dk];
  const float biasb = p.in[9][(l * 2 + 1) * 256 + h * 64 + dk];
  float pf[16], sbk[16];
#pragma unroll
  for (int i = 0; i < 16; ++i) {
    const float* lrow = lr + (tg * 16 + i) * 32;
    float zf = biasf, zb = biasb;
#pragma unroll
    for (int r = 0; r < 16; ++r) { zf += lrow[r] * wf[r]; zb += lrow[16 + r] * wb[r]; }
    pf[i] = logsig16(zf); sbk[i] = logsig16(zb);
  }
#pragma unroll
  for (int i = 1; i < 16; ++i) pf[i] += pf[i - 1];
#pragma unroll
  for (int i = 14; i >= 0; --i) sbk[i] += sbk[i + 1];
  tot[tg * 64 + dk] = pf[15];
  tot[256 + tg * 64 + dk] = sbk[0];
  __syncthreads();
  float offf = 0.f, offb = 0.f, bfl = 0.f, bb0 = 0.f;
#pragma unroll
  for (int g4 = 0; g4 < 4; ++g4) {
    const float a = tot[g4 * 64 + dk], b = tot[256 + g4 * 64 + dk];
    bfl += a; bb0 += b;
    if (g4 < tg) offf += a;
    if (g4 > tg) offb += b;
  }
  u16* gqf = p.gq;
  u16* gkf = p.gq + (size_t)RG * 256;
  u16* gqb = p.gq + (size_t)RG * 512;
  u16* gkb = p.gq + (size_t)RG * 768;
  unsigned kfp[8], kbp[8];
#pragma unroll
  for (int i = 0; i < 16; ++i) {
    const int t = tg * 16 + i;
    const float bfv = offf + pf[i], bbv = offb + sbk[i];
    const float qv = bf2f(p.proj[(size_t)(r0 + t) * INW + C_QA + h * 64 + dk]);
    const float kv = bf2f(p.proj[(size_t)(r0 + t) * INW + C_KA + h * 64 + dk]);
    const size_t go = (size_t)(r0 + t) * 256 + h * 64 + dk;
    gqf[go] = f2bf(qv * __expf(bfv) * 0.125f);
    gkf[go] = f2bf(kv * __expf(-bfv));
    gqb[go] = f2bf(qv * __expf(bbv) * 0.125f);
    gkb[go] = f2bf(kv * __expf(-bbv));
    const u16 ksf = f2bf(kv * __expf(bfl - bfv));
    const u16 ksb = f2bf(kv * __expf(bb0 - bbv));
    if (i & 1) { kfp[i >> 1] |= ((unsigned)ksf) << 16; kbp[i >> 1] |= ((unsigned)ksb) << 16; }
    else { kfp[i >> 1] = ksf; kbp[i >> 1] = ksb; }
  }
  *(uint4*)(kTf + dk * 72 + tg * 16) = make_uint4(kfp[0], kfp[1], kfp[2], kfp[3]);
  *(uint4*)(kTf + dk * 72 + tg * 16 + 8) = make_uint4(kfp[4], kfp[5], kfp[6], kfp[7]);
  *(uint4*)(kTb + dk * 72 + tg * 16) = make_uint4(kbp[0], kbp[1], kbp[2], kbp[3]);
  *(uint4*)(kTb + dk * 72 + tg * 16 + 8) = make_uint4(kbp[4], kbp[5], kbp[6], kbp[7]);
  const size_t cb = ((size_t)(bl * NCHUNK + cidx) * 4 + h) * 2;
  if (tg == 0) {
    p.dec[(cb + 0) * 64 + dk] = __expf(bfl);
    p.dec[(cb + 1) * 64 + dk] = __expf(bb0);
  }
  __syncthreads();
  const int l31 = lane & 31, hh = lane >> 5;
  u16* U = p.h;
#pragma unroll
  for (int dir = 0; dir < 2; ++dir) {
    const u16* kT = dir ? kTb : kTf;
#pragma unroll
    for (int dkt = 0; dkt < 2; ++dkt) {
      f32x16 acc;
#pragma unroll
      for (int e = 0; e < 16; ++e) acc[e] = 0.f;
#pragma unroll
      for (int s = 0; s < 4; ++s) {
        const bf16x8 a = *(const bf16x8*)(vT + (32 * wid + l31) * 72 + 16 * s + 8 * hh);
        const bf16x8 b = *(const bf16x8*)(kT + (32 * dkt + l31) * 72 + 16 * s + 8 * hh);
        acc = __builtin_amdgcn_mfma_f32_32x32x16_bf16(a, b, acc, 0, 0, 0);
      }
      u16* up = U + (cb + dir) * 8192;
#pragma unroll
      for (int e = 0; e < 16; ++e) {
        const int dv = 32 * wid + (e & 3) + 8 * (e >> 2) + 4 * hh;
        up[dv * 64 + 32 * dkt + l31] = f2bf(acc[e]);
      }
    }
  }
}

__device__ void phase_postproj(const Params& p, int l, int* ctr) {
  const int n_prep = NBG * NCHUNK * 4, n_rows = RG / 16;
  run_q8(ctr, QA_CNT(n_prep + n_rows), [&](int q_, int j_) {
    const int it = QA_ID(q_, j_);
    if (it < n_prep) gla_prep(p, l, it);
    else postproj_rows(p, l, it - n_prep);
  });
}

__device__ void gla_scan(const Params& p, int it) {
  const int tid = TIDX;
  const int sl = it & 7, dir = (it >> 3) & 1, h = (it >> 4) & 3, bl = it >> 6;
  const int e0 = sl * 1024 + tid * 4;
  const int dk = e0 & 63;
  const u16* U = p.h;
  f32x4 S = {0.f, 0.f, 0.f, 0.f};
  for (int s0 = 0; s0 < NCHUNK; s0 += 12) {
    uint2 u4[12]; f32x4 d4[12];
#pragma unroll
    for (int j = 0; j < 12; ++j) {
      const int step = s0 + j;
      const int cidx = dir ? (NCHUNK - 1 - step) : (step < 4 ? 128 + step : step - 4);
      const size_t base = ((size_t)(bl * NCHUNK + cidx) * 4 + h) * 2 + dir;
      u4[j] = *(const uint2*)(U + base * 8192 + e0);
      d4[j] = *(const f32x4*)(p.dec + base * 64 + dk);
    }
#pragma unroll
    for (int j = 0; j < 12; ++j) {
      const int step = s0 + j;
      const int cidx = dir ? (NCHUNK - 1 - step) : (step < 4 ? 128 + step : step - 4);
      const size_t base = ((size_t)(bl * NCHUNK + cidx) * 4 + h) * 2 + dir;
      uint2 o; o.x = pack2(S[0], S[1]); o.y = pack2(S[2], S[3]);
      st_nt(p.ss + base * 8192 + e0, o);
      S = d4[j] * S + f32x4{bflo(u4[j].x), bfhi(u4[j].x), bflo(u4[j].y), bfhi(u4[j].y)};
    }
  }
}

__device__ void q_tile(const Params& p, int l, int t) {
  const int MT = RG / 128;
  const int nt = t / MT, mt = t % MT;
  f32x4 acc[4][4];
  gemm_core<4>(p.proj + (size_t)mt * 128 * INW + C_CQ, INW, p.wt + (size_t)l * W_LAYER + W_UQ + (size_t)nt * 128 * 256, 256, 256, acc);
  EPI_VARS
  const float QS = 0.10206207261596577f * 1.4426950408889634f;
  int bl, pos0, isctx; rowinfo(mt * 128, NBG, bl, pos0, isctx);
  float rsq[4];
  uint2 qo[4][4];
#pragma unroll
  for (int xi = 0; xi < 4; ++xi) rsq[xi] = p.rstdq[mt * 128 + EPI_TR(xi)] * QS;
#pragma unroll
  for (int xi = 0; xi < 4; ++xi) {
    const int tr = EPI_TR(xi), r = mt * 128 + tr, pos = pos0 + tr;
    const float rs = rsq[xi];
#pragma unroll
    for (int wi = 0; wi < 4; ++wi) {
      const int n16 = (nt * 128 + wc_ * 64 + wi * 16) >> 4;
      const int m6 = n16 % 6;
      float v0 = acc[wi][xi][0] * rs, v1 = acc[wi][xi][1] * rs, v2 = acc[wi][xi][2] * rs, v3 = acc[wi][xi][3] * rs;
      if (m6 >= 4 && !isctx) {
        const float p0 = xor_lane<32>(v0), p1 = xor_lane<32>(v1), p2 = xor_lane<32>(v2), p3 = xor_lane<32>(v3);
        const int pa = (m6 == 5) ? (pos & 63) : (pos >> 6);
        const int f0 = (fq_ & 1) * 4;
        const float* rp = p.rope + (pa * 8 + f0) * 2;
        const float4 cs01 = *(const float4*)rp, cs23 = *(const float4*)(rp + 4);
        const float sg = (fq_ >= 2) ? 1.f : -1.f;
        v0 = v0 * cs01.x + sg * p0 * cs01.y;
        v1 = v1 * cs01.z + sg * p1 * cs01.w;
        v2 = v2 * cs23.x + sg * p2 * cs23.y;
        v3 = v3 * cs23.z + sg * p3 * cs23.w;
      }
      qo[wi][xi].x = pack2(v0, v1); qo[wi][xi].y = pack2(v2, v3);
    }
  }
  store_tile_bf16<4>(qo, p.q + (size_t)(mt * 128 + wr_ * 64) * 768 + nt * 128 + wc_ * 64, 768);
}

__device__ void kv_tile(const Params& p, int l, int t) {
  const int MT = RG / 128;
  const int nt = t / MT, mt = t % MT;
  f32x4 acc[4][4];
  gemm_core<4>(p.proj + (size_t)mt * 128 * INW + C_CKV, INW, p.wt + (size_t)l * W_LAYER + W_UKV + (size_t)nt * 128 * 128, 128, 128, acc);
  EPI_VARS
  int bl, pos0, isctx; rowinfo(mt * 128, NBG, bl, pos0, isctx);
  const int j0 = isctx ? SEQ + pos0 : pos0;
  float rskv[4];
#pragma unroll
  for (int xi = 0; xi < 4; ++xi) rskv[xi] = p.rstdkv[mt * 128 + EPI_TR(xi)];
#pragma unroll
  for (int xi = 0; xi < 4; ++xi) {
    const int tr = EPI_TR(xi), r = mt * 128 + tr, j = j0 + tr;
    const float rs = rskv[xi];
#pragma unroll
    for (int wi = 0; wi < 4; ++wi) {
      const int wn = EPI_NN(wi);
      const float v0 = acc[wi][xi][0] * rs, v1 = acc[wi][xi][1] * rs, v2 = acc[wi][xi][2] * rs, v3 = acc[wi][xi][3] * rs;
      if (wc_ == 0) {
        uint2 o; o.x = pack2(v0, v1); o.y = pack2(v2, v3);
        *(uint2*)(p.kf + ((size_t)(bl * 8 + nt) * NKEY + j) * 96 + wn) = o;
      } else {
        u16* vp = p.vt + ((size_t)(bl * 8 + nt) * 64 + (wn - 64)) * NKEY + j;
        vp[0] = f2bf(v0); vp[NKEY] = f2bf(v1); vp[2 * NKEY] = f2bf(v2); vp[3 * NKEY] = f2bf(v3);
      }
    }
  }
}

__device__ void phase_qkv(const Params& p, int l, int* ctr) {
  const int MT = RG / 128;
  const int n_scan = NBG * 64, n_q = MT * 6, n_kv = MT * 8;
  run_q8(ctr, QA_CNT(n_scan + n_q + n_kv), [&](int q_, int j_) {
    const int it = QA_ID(q_, j_);
    if (it < n_scan) gla_scan(p, it);
    else if (it < n_scan + n_q) q_tile(p, l, it - n_scan);
    else kv_tile(p, l, it - n_scan - n_q);
  });
}

__device__ __forceinline__ bf16x8 pack8(const f32x16& a, int o) {
  union { bf16x8 v; unsigned u[4]; } r;
  r.u[0] = pack2(a[o + 0], a[o + 1]); r.u[1] = pack2(a[o + 2], a[o + 3]);
  r.u[2] = pack2(a[o + 4], a[o + 5]); r.u[3] = pack2(a[o + 6], a[o + 7]);
  return r.v;
}
__device__ __forceinline__ bf16x8 ld2x8(const u16* p0) {
  union { bf16x8 v; uint2 u[2]; } r;
  r.u[0] = *(const uint2*)p0; r.u[1] = *(const uint2*)(p0 + 8);
  return r.v;
}

__device__ void attn_item(const Params& p, int it) {
  const int tid = TIDX, lane = tid & 63, wid = tid >> 6, l31 = lane & 31, hh = lane >> 5;
  const int qb = it % 66, bh = it / 66, h = bh & 7, bl = bh >> 3;
  const int r0 = qb < 64 ? bl * SEQ + qb * 128 : NBG * SEQ + bl * CTXL + (qb - 64) * 128;
  const int kt0 = qb < 64 ? 0 : 128;
  const int nkt = NCHUNK - kt0;
  constexpr int KROW = 208, VROW = 144, BUFB = 64 * KROW + 64 * VROW;
  bf16x8 qf[6];
  {
    const u16* qp = p.q + (size_t)(r0 + 32 * wid + l31) * 768 + h * 96 + 8 * hh;
#pragma unroll
    for (int s = 0; s < 6; ++s) qf[s] = *(const bf16x8*)(qp + 16 * s);
  }
  const u16* kbase = p.kf + (size_t)bh * NKEY * 96;
  const u16* vbase = p.vt + (size_t)bh * 64 * NKEY;
  uint4 kr0, kr1, kr2, vr0, vr1;
  const int kdst0 = (tid / 12) * KROW + (tid % 12) * 16;
  const int kdst1 = ((tid + 256) / 12) * KROW + ((tid + 256) % 12) * 16;
  const int kdst2 = ((tid + 512) / 12) * KROW + ((tid + 512) % 12) * 16;
  const int vdst0 = 64 * KROW + (tid >> 3) * VROW + (tid & 7) * 16;
  const int vdst1 = vdst0 + 32 * VROW;
  const int vsrc0 = (tid >> 3) * NKEY + (tid & 7) * 8;
  const int vsrc1 = vsrc0 + 32 * NKEY;
  {
    const u16* kp = kbase + (size_t)kt0 * 64 * 96 + tid * 8;
    kr0 = *(const uint4*)(kp); kr1 = *(const uint4*)(kp + 2048); kr2 = *(const uint4*)(kp + 4096);
    vr0 = *(const uint4*)(vbase + vsrc0 + kt0 * 64); vr1 = *(const uint4*)(vbase + vsrc1 + kt0 * 64);
    *(uint4*)(smem + kdst0) = kr0; *(uint4*)(smem + kdst1) = kr1; *(uint4*)(smem + kdst2) = kr2;
    *(uint4*)(smem + vdst0) = vr0; *(uint4*)(smem + vdst1) = vr1;
  }
  __builtin_amdgcn_s_waitcnt(0x0F70);
  __syncthreads();
  f32x16 oacc[2];
#pragma unroll
  for (int e = 0; e < 16; ++e) { oacc[0][e] = 0.f; oacc[1][e] = 0.f; }
  float m_run = 0.f, l_run = 0.f;
  for (int t = 0; t < nkt; ++t) {
    const int cur = t & 1;
    {
      const int tn = kt0 + min(t + 1, nkt - 1);
      const u16* kp = kbase + (size_t)tn * 64 * 96 + tid * 8;
      kr0 = *(const uint4*)(kp); kr1 = *(const uint4*)(kp + 2048); kr2 = *(const uint4*)(kp + 4096);
      vr0 = *(const uint4*)(vbase + vsrc0 + tn * 64); vr1 = *(const uint4*)(vbase + vsrc1 + tn * 64);
    }
    __builtin_amdgcn_sched_barrier(0);
    const char* Kl = smem + cur * BUFB;
    const char* Vl = Kl + 64 * KROW;
    f32x16 sacc[2];
#pragma unroll
    for (int kb = 0; kb < 2; ++kb) {
#pragma unroll
      for (int e = 0; e < 16; ++e) sacc[kb][e] = -m_run;
#pragma unroll
      for (int s = 0; s < 6; ++s) {
        const bf16x8 a = *(const bf16x8*)(Kl + (32 * kb + l31) * KROW + 32 * s + 16 * hh);
        sacc[kb] = __builtin_amdgcn_mfma_f32_32x32x16_bf16(a, qf[s], sacc[kb], 0, 0, 0);
      }
    }
    float mx = sacc[0][0];
#pragma unroll
    for (int e = 1; e < 16; ++e) mx = fmaxf(mx, sacc[0][e]);
#pragma unroll
    for (int e = 0; e < 16; ++e) mx = fmaxf(mx, sacc[1][e]);
    {
      const unsigned mu = __float_as_uint(mx);
      const auto sw = __builtin_amdgcn_permlane32_swap(mu, mu, false, false);
      mx = fmaxf(__uint_as_float(sw[0]), __uint_as_float(sw[1]));
    }
    if (t == 0 || !__all(mx <= 8.f)) {
      const float d = (t == 0) ? mx : fmaxf(mx, 0.f);
      const float alpha = __builtin_amdgcn_exp2f(-d);
      m_run += d;
      l_run *= alpha;
#pragma unroll
      for (int e = 0; e < 16; ++e) { oacc[0][e] *= alpha; oacc[1][e] *= alpha; sacc[0][e] -= d; sacc[1][e] -= d; }
    }
    float ps = 0.f;
#pragma unroll
    for (int kb = 0; kb < 2; ++kb)
#pragma unroll
      for (int e = 0; e < 16; ++e) { const float pv = __builtin_amdgcn_exp2f(sacc[kb][e]); sacc[kb][e] = pv; ps += pv; }
    l_run += ps;
#pragma unroll
    for (int kb = 0; kb < 2; ++kb)
#pragma unroll
      for (int s2 = 0; s2 < 2; ++s2) {
        const bf16x8 pfr = pack8(sacc[kb], 8 * s2);
#pragma unroll
        for (int dt = 0; dt < 2; ++dt) {
          const bf16x8 a = ld2x8((const u16*)(Vl + (32 * dt + l31) * VROW) + 32 * kb + 16 * s2 + 4 * hh);
          oacc[dt] = __builtin_amdgcn_mfma_f32_32x32x16_bf16(a, pfr, oacc[dt], 0, 0, 0);
        }
      }
    __builtin_amdgcn_sched_barrier(0);
    {
      char* nb = smem + (cur ^ 1) * BUFB;
      *(uint4*)(nb + kdst0) = kr0; *(uint4*)(nb + kdst1) = kr1; *(uint4*)(nb + kdst2) = kr2;
      *(uint4*)(nb + vdst0) = vr0; *(uint4*)(nb + vdst1) = vr1;
    }
    __syncthreads();
  }
  l_run += xor_lane<32>(l_run);
  const float inv = 1.f / l_run;
  u16* op = p.h + (size_t)RG * 512 + (size_t)(r0 + 32 * wid + l31) * 512 + h * 64;
#pragma unroll
  for (int dt = 0; dt < 2; ++dt)
#pragma unroll
    for (int gq_ = 0; gq_ < 4; ++gq_) {
      const int dv0 = 32 * dt + 8 * gq_ + 4 * hh;
      uint2 o;
      o.x = pack2(oacc[dt][4 * gq_ + 0] * inv, oacc[dt][4 * gq_ + 1] * inv);
      o.y = pack2(oacc[dt][4 * gq_ + 2] * inv, oacc[dt][4 * gq_ + 3] * inv);
      *(uint2*)(op + dv0) = o;
    }
}

__device__ void gla_out(const Params& p, int l, int it) {
  const int tid = TIDX, lane = tid & 63, wid = tid >> 6, l31 = lane & 31, hh = lane >> 5;
  const int bl = it / (NCHUNK * 4), rem = it % (NCHUNK * 4), cidx = rem >> 2, h = rem & 3;
  const int r0 = chunk_row(bl, cidx, NBG);
  u16* tiles = (u16*)smem;
  u16* vT = (u16*)(smem + 36864);
  float* part = (float*)(smem + 55296);
  {
    const int t = tid >> 2, c16 = (tid & 3) * 16;
#pragma unroll
    for (int a = 0; a < 4; ++a) {
      const u16* src = p.gq + (size_t)a * RG * 256 + (size_t)(r0 + t) * 256 + h * 64 + c16;
      const uint4 u0 = *(const uint4*)src, u1 = *(const uint4*)(src + 8);
      u16* d = tiles + a * 4608 + t * 72 + c16;
      *(uint4*)d = u0; *(uint4*)(d + 8) = u1;
    }
    const int dvc = (tid & 3) * 32;
    const u16* vp = p.proj + (size_t)(r0 + t) * INW + C_VA + h * 128 + dvc;
#pragma unroll
    for (int i = 0; i < 4; ++i) {
      const uint4 vv = *(const uint4*)(vp + i * 8);
      u16* dst = vT + (size_t)(dvc + i * 8) * 72 + t;
      dst[0] = (u16)(vv.x & 0xffff); dst[72] = (u16)(vv.x >> 16);
      dst[144] = (u16)(vv.y & 0xffff); dst[216] = (u16)(vv.y >> 16);
      dst[288] = (u16)(vv.z & 0xffff); dst[360] = (u16)(vv.z >> 16);
      dst[432] = (u16)(vv.w & 0xffff); dst[504] = (u16)(vv.w >> 16);
    }
  }
  const int itl = wid & 1, dvh = wid >> 1;
  const size_t cb = ((size_t)(bl * NCHUNK + cidx) * 4 + h) * 2;
  bf16x8 sfr[2][2][4];
#pragma unroll
  for (int dir = 0; dir < 2; ++dir)
#pragma unroll
    for (int dt = 0; dt < 2; ++dt)
#pragma unroll
      for (int s4 = 0; s4 < 4; ++s4)
        sfr[dir][dt][s4] = *(const bf16x8*)(p.ss + (cb + dir) * 8192 + (64 * dvh + 32 * dt + l31) * 64 + 16 * s4 + 8 * hh);
  __syncthreads();
  f32x16 oacc[2];
#pragma unroll
  for (int e = 0; e < 16; ++e) { oacc[0][e] = 0.f; oacc[1][e] = 0.f; }
#pragma unroll
  for (int dir = 0; dir < 2; ++dir) {
    const u16* Qt = tiles + (dir * 2) * 4608;
    const u16* Kt = tiles + (dir * 2 + 1) * 4608;
    bf16x8 qfr[4];
#pragma unroll
    for (int s = 0; s < 4; ++s) qfr[s] = *(const bf16x8*)(Qt + (32 * itl + l31) * 72 + 16 * s + 8 * hh);
    f32x16 aacc[2];
#pragma unroll
    for (int jt = 0; jt < 2; ++jt) {
#pragma unroll
      for (int e = 0; e < 16; ++e) aacc[jt][e] = 0.f;
#pragma unroll
      for (int s = 0; s < 4; ++s) {
        const bf16x8 a = *(const bf16x8*)(Kt + (32 * jt + l31) * 72 + 16 * s + 8 * hh);
        aacc[jt] = __builtin_amdgcn_mfma_f32_32x32x16_bf16(a, qfr[s], aacc[jt], 0, 0, 0);
      }
      const int i_tok = 32 * itl + l31;
#pragma unroll
      for (int e = 0; e < 16; ++e) {
        const int j_tok = 32 * jt + (e & 3) + 8 * (e >> 2) + 4 * hh;
        const bool keep = dir ? (j_tok >= i_tok) : (j_tok <= i_tok);
        if (!keep) aacc[jt][e] = 0.f;
      }
    }
#pragma unroll
    for (int dt = 0; dt < 2; ++dt) {
      const int dvrow = 64 * dvh + 32 * dt + l31;
#pragma unroll
      for (int jt = 0; jt < 2; ++jt)
#pragma unroll
        for (int s2 = 0; s2 < 2; ++s2) {
          const bf16x8 pfr = pack8(aacc[jt], 8 * s2);
          const bf16x8 a = ld2x8(vT + dvrow * 72 + 32 * jt + 16 * s2 + 4 * hh);
          oacc[dt] = __builtin_amdgcn_mfma_f32_32x32x16_bf16(a, pfr, oacc[dt], 0, 0, 0);
        }
#pragma unroll
      for (int s = 0; s < 4; ++s) {
        oacc[dt] = __builtin_amdgcn_mfma_f32_32x32x16_bf16(sfr[dir][dt][s], qfr[s], oacc[dt], 0, 0, 0);
      }
    }
  }
  float ss = 0.f;
#pragma unroll
  for (int e = 0; e < 16; ++e) ss += oacc[0][e] * oacc[0][e] + oacc[1][e] * oacc[1][e];
  ss += xor_lane<32>(ss);
  if (hh == 0) part[wid * 32 + l31] = ss;
  __syncthreads();
  const float totss = part[wid * 32 + l31] + part[(wid ^ 2) * 32 + l31];
  const float rstd = rsqrtf(totss * (1.f / 128.f) + EPS);
  const int r = r0 + 32 * itl + l31;
  const float* gam = p.in[10] + l * 512 + h * 128;
  u16* aa = p.h;
#pragma unroll
  for (int dt = 0; dt < 2; ++dt)
#pragma unroll
    for (int gq_ = 0; gq_ < 4; ++gq_) {
      const int dv0 = 64 * dvh + 32 * dt + 8 * gq_ + 4 * hh;
      const uint2 ra = *(const uint2*)(p.proj + (size_t)r * INW + C_RA + h * 128 + dv0);
      const float4 g4 = *(const float4*)(gam + dv0);
      uint2 o;
      o.x = pack2(oacc[dt][4 * gq_ + 0] * rstd * g4.x * silu_f(bflo(ra.x)), oacc[dt][4 * gq_ + 1] * rstd * g4.y * silu_f(bfhi(ra.x)));
      o.y = pack2(oacc[dt][4 * gq_ + 2] * rstd * g4.z * silu_f(bflo(ra.y)), oacc[dt][4 * gq_ + 3] * rstd * g4.w * silu_f(bfhi(ra.y)));
      *(uint2*)(aa + (size_t)r * 512 + h * 128 + dv0) = o;
    }
}

__device__ void phase_attn(const Params& p, int l, int* ctr) {
  const int nqb = (l == 1) ? 64 : 66, nck = (l == 1) ? 128 : NCHUNK;
  const int per_q = NBG * nqb;
  const int n_gla = NBG * nck * 4;
  run_q8(ctr, [=](int q_) { return per_q + ((n_gla - q_ + 7) >> 3); }, [&](int q_, int j_) {
    if (j_ < per_q) attn_item(p, ((j_ / nqb) * 8 + q_) * 66 + (j_ % nqb));
    else {
      const int gi = QA_ID(q_, j_ - per_q);
      gla_out(p, l, (gi / (nck * 4)) * (NCHUNK * 4) + gi % (nck * 4));
    }
  });
}

__device__ void phase_merge(const Params& p, int l, int* ctr) {
  const int MT = (l == 1 ? NBG * SEQ / 128 : RG / 128), NT = 16;
  const u16* wl = p.wt + (size_t)l * W_LAYER;
  run_q8(ctr, GEMM_CNT(MT, NT), [&](int q_, int j_) {
    int mt, nt; tile_order(j_, mlo(q_ + 1, MT) - mlo(q_, MT), NT, mt, nt); mt += mlo(q_, MT);
    const int tid = TIDX, lane = tid & 63, wid = tid >> 6;
    const int wr = wid >> 1, wc = wid & 1, fr = lane & 15, fq = lane >> 4;
    f32x4 macc[2][4], acc[2][4];
#pragma unroll
    for (int a = 0; a < 2; ++a)
#pragma unroll
      for (int b = 0; b < 4; ++b) { macc[a][b] = f32x4{0.f, 0.f, 0.f, 0.f}; acc[a][b] = f32x4{0.f, 0.f, 0.f, 0.f}; }
    const int srow = tid >> 3, schunk = (tid & 7) ^ ((tid >> 4) & 7);
    const size_t xo = (size_t)(mt * 128 + srow) * 512 + schunk * 8;
    const size_t wo = (size_t)(nt * 64 + srow) * 512 + schunk * 8;
    const u16* xg0 = p.h + xo;
    const u16* xg1 = p.h + (size_t)RG * 512 + xo;
    const u16* xg2 = p.uc + xo;
    const u16* wg0 = wl + W_BRA + wo;
    const u16* wg1 = wl + W_BRB + wo;
    const u16* wg2 = wl + W_BRC + wo;
    const int g = fr >> 1;
    const int lo0 = fr * 128 + ((fq ^ g) << 4), lo1 = fr * 128 + (((fq ^ g) ^ 4) << 4);
    const char* xb = smem + wr * 8192;
    const char* wb = smem + 16384 + wc * 4096;
    char* sdst = smem + tid * 16;
    const u16* gbase = p.proj + (size_t)(mt * 128 + wr * 64 + fr) * INW + C_GATE + nt * 64 + wc * 32 + fq * 4;
    uint2 gts[2][4];
#pragma unroll
    for (int wi = 0; wi < 2; ++wi)
#pragma unroll
      for (int xi = 0; xi < 4; ++xi) gts[wi][xi] = *(const uint2*)(gbase + (size_t)xi * 16 * INW + wi * 16);
    __syncthreads();
#pragma unroll
    for (int i = 0; i < 4; ++i) {
      glds16(xg0 + i * (32 * 512), sdst + i * 4096);
      if (i < 2) glds16(wg0 + i * (32 * 512), sdst + 16384 + i * 4096);
    }
    for (int kt = 0; kt < 24; ++kt) {
      asm volatile("s_waitcnt vmcnt(0)" ::: "memory");
      __syncthreads();
      const int cb = (kt & 1) * 32768;
      if (kt + 1 < 24) {
        const int nbr = (kt + 1) >> 3, ko = ((kt + 1) & 7) * 64, nb = 32768 - cb;
        const u16* xg = (nbr == 0 ? xg0 : nbr == 1 ? xg1 : xg2) + ko;
        const u16* wg = (nbr == 0 ? wg0 : nbr == 1 ? wg1 : wg2) + ko;
#pragma unroll
        for (int i = 0; i < 4; ++i) {
          glds16(xg + i * (32 * 512), sdst + nb + i * 4096);
          if (i < 2) glds16(wg + i * (32 * 512), sdst + nb + 16384 + i * 4096);
        }
      }
      bf16x8 wf[2][2], xf[2][4];
#pragma unroll
      for (int i = 0; i < 2; ++i) {
        wf[0][i] = *(const bf16x8*)(wb + cb + i * 2048 + lo0);
        wf[1][i] = *(const bf16x8*)(wb + cb + i * 2048 + lo1);
      }
#pragma unroll
      for (int i = 0; i < 4; ++i) {
        xf[0][i] = *(const bf16x8*)(xb + cb + i * 2048 + lo0);
        xf[1][i] = *(const bf16x8*)(xb + cb + i * 2048 + lo1);
      }
      __builtin_amdgcn_sched_barrier(0);
#pragma unroll
      for (int k = 0; k < 2; ++k)
#pragma unroll
        for (int wi = 0; wi < 2; ++wi)
#pragma unroll
          for (int xi = 0; xi < 4; ++xi)
            acc[wi][xi] = __builtin_amdgcn_mfma_f32_16x16x32_bf16(wf[k][wi], xf[k][xi], acc[wi][xi], 0, 0, 0);
      __builtin_amdgcn_sched_barrier(0);
      if ((kt & 7) == 7) {
        const int br = kt >> 3;
#pragma unroll
        for (int wi = 0; wi < 2; ++wi)
#pragma unroll
          for (int xi = 0; xi < 4; ++xi) {
            const uint2 gt = gts[wi][xi];
            macc[wi][xi][0] += sigmoid_f(bflo(gt.x)) * acc[wi][xi][0];
            macc[wi][xi][1] += sigmoid_f(bfhi(gt.x)) * acc[wi][xi][1];
            macc[wi][xi][2] += sigmoid_f(bflo(gt.y)) * acc[wi][xi][2];
            macc[wi][xi][3] += sigmoid_f(bfhi(gt.y)) * acc[wi][xi][3];
            acc[wi][xi] = f32x4{0.f, 0.f, 0.f, 0.f};
            if (br < 2) gts[wi][xi] = *(const uint2*)(gbase + (size_t)xi * 16 * INW + wi * 16 + (br + 1) * 1024);
          }
      }
    }
    uint2 o[2][4];
#pragma unroll
    for (int wi = 0; wi < 2; ++wi)
#pragma unroll
      for (int xi = 0; xi < 4; ++xi) {
        o[wi][xi].x = pack2(macc[wi][xi][0], macc[wi][xi][1]); o[wi][xi].y = pack2(macc[wi][xi][2], macc[wi][xi][3]);
      }
    store_tile_bf16<2>(o, p.m + (size_t)(mt * 128 + wr * 64) * DM + nt * 64 + wc * 32, DM);
  });
}

__device__ void phase_resid(const Params& p, int l, int g, int which, int* ctr) {
  const int MT = (l == 1 ? NBG * SEQ / 128 : RG / 128), NT = 8;
  const u16* wl = p.wt + (size_t)l * W_LAYER;
  const u16* X = which == 0 ? p.m : p.proj + (size_t)RG * DFF;
  const int ldx = which == 0 ? DM : DFF, K = which == 0 ? DM : DFF;
  const u16* W = wl + (which == 0 ? W_O : W_DN);
  const int goff = which == 0 ? 2048 : 5120;
  const int from_input = (which == 0 && l == 0);
  run_q8(ctr, GEMM_CNT(MT, NT), [&](int q_, int j_) {
    int mt, nt; tile_order(j_, mlo(q_ + 1, MT) - mlo(q_, MT), NT, mt, nt); mt += mlo(q_, MT);
    f32x4 acc[4][4];
    gemm_core<4>(X + (size_t)mt * 128 * ldx, ldx, W + (size_t)nt * 128 * K, K, K, acc);
    EPI_VARS
    const float* mrow = p.mod + ((size_t)l * 9 + mod_index(p, g, mt * 128)) * 6144 + goff + nt * 128 + wc_ * 64;
    __syncthreads();
    char* lb = smem + wid_ * 16384;
#pragma unroll
    for (int wi = 0; wi < 4; ++wi)
#pragma unroll
      for (int xi = 0; xi < 4; ++xi) {
        const int r = xi * 16 + fr_, c = wi * 4 + fq_;
        *(f32x4*)(lb + r * 256 + ((c ^ (r & 15)) << 4)) = acc[wi][xi];
      }
    const int c16 = lane_ & 15, rsub = lane_ >> 4;
    const float* xs = xsrc_row_ptr(p, g, mt * 128 + wr_ * 64, from_input) + nt * 128 + wc_ * 64 + c16 * 4;
    float* xd = xrow_ptr(p, g, mt * 128 + wr_ * 64) + nt * 128 + wc_ * 64 + c16 * 4;
    const float4 gv = *(const float4*)(mrow + c16 * 4);
#pragma unroll
    for (int half = 0; half < 2; ++half) {
      float4 xv[8];
#pragma unroll
      for (int it = 0; it < 8; ++it) xv[it] = *(const float4*)(xs + (size_t)((half * 8 + it) * 4 + rsub) * DM);
#pragma unroll
      for (int it = 0; it < 8; ++it) {
        const int row = (half * 8 + it) * 4 + rsub;
        const f32x4 a = *(const f32x4*)(lb + row * 256 + ((c16 ^ (row & 15)) << 4));
        float4 o;
        o.x = xv[it].x + gv.x * a[0]; o.y = xv[it].y + gv.y * a[1]; o.z = xv[it].z + gv.z * a[2]; o.w = xv[it].w + gv.w * a[3];
        *(float4*)(xd + (size_t)row * DM) = o;
      }
    }
  });
}

__device__ void phase_gate(const Params& p, int l, int* ctr) {
  const int MT = (l == 1 ? NBG * SEQ / 128 : RG / 128), NT = 22;
  const u16* W = p.wt + (size_t)l * W_LAYER + W_GU;
  run_q8(ctr, GEMM_CNT(MT, NT), [&](int q_, int j_) {
    int mt, nt; tile_order(j_, mlo(q_ + 1, MT) - mlo(q_, MT), NT, mt, nt); mt += mlo(q_, MT);
    f32x4 acc[4][4];
    gemm_core<4>(p.h + (size_t)mt * 128 * DM, DM, W + (size_t)nt * 128 * DM, DM, DM, acc);
    EPI_VARS
    uint2 o[4][4];
#pragma unroll
    for (int wi = 0; wi < 4; ++wi)
#pragma unroll
      for (int xi = 0; xi < 4; ++xi) {
        o[wi][xi].x = pack2(acc[wi][xi][0], acc[wi][xi][1]); o[wi][xi].y = pack2(acc[wi][xi][2], acc[wi][xi][3]);
      }
    store_tile_bf16<4>(o, p.proj + (size_t)(mt * 128 + wr_ * 64) * DFF + nt * 128 + wc_ * 64, DFF);
  });
}

struct ActIn { uint4 g0, g1, g2, uu; float4 w0a, w0b, w1a, w1b, w2a, w2b, ba, bb; };
__device__ __forceinline__ void act_load(ActIn& a, const u16* G, const u16* UP, const float* cw, const float* cb, int r, int c0) {
  int bl, pos, isctx; rowinfo(r, NBG, bl, pos, isctx);
  const int L = isctx ? CTXL : SEQ;
  const u16* gp = G + (size_t)r * DFF + c0;
  a.g1 = *(const uint4*)gp;
  a.g0 = make_uint4(0, 0, 0, 0); a.g2 = a.g0;
  if (pos > 0) a.g0 = *(const uint4*)(gp - DFF);
  if (pos < L - 1) a.g2 = *(const uint4*)(gp + DFF);
  a.uu = *(const uint4*)(UP + (size_t)r * DFF + c0);
  a.w0a = *(const float4*)(cw + c0); a.w0b = *(const float4*)(cw + c0 + 4);
  a.w1a = *(const float4*)(cw + DFF + c0); a.w1b = *(const float4*)(cw + DFF + c0 + 4);
  a.w2a = *(const float4*)(cw + 2 * DFF + c0); a.w2b = *(const float4*)(cw + 2 * DFF + c0 + 4);
  a.ba = *(const float4*)(cb + c0); a.bb = *(const float4*)(cb + c0 + 4);
}
__device__ __forceinline__ uint4 act_compute(const ActIn& a) {
  uint4 o;
#define ACT2(G0, G1, G2, UU, W0L, W0H, W1L, W1H, W2L, W2H, BL, BH) \
  pack2(silu_f(W0L * bflo(G0) + W1L * bflo(G1) + W2L * bflo(G2) + BL) * bflo(UU), \
        silu_f(W0H * bfhi(G0) + W1H * bfhi(G1) + W2H * bfhi(G2) + BH) * bfhi(UU))
  o.x = ACT2(a.g0.x, a.g1.x, a.g2.x, a.uu.x, a.w0a.x, a.w0a.y, a.w1a.x, a.w1a.y, a.w2a.x, a.w2a.y, a.ba.x, a.ba.y);
  o.y = ACT2(a.g0.y, a.g1.y, a.g2.y, a.uu.y, a.w0a.z, a.w0a.w, a.w1a.z, a.w1a.w, a.w2a.z, a.w2a.w, a.ba.z, a.ba.w);
  o.z = ACT2(a.g0.z, a.g1.z, a.g2.z, a.uu.z, a.w0b.x, a.w0b.y, a.w1b.x, a.w1b.y, a.w2b.x, a.w2b.y, a.bb.x, a.bb.y);
  o.w = ACT2(a.g0.w, a.g1.w, a.g2.w, a.uu.w, a.w0b.z, a.w0b.w, a.w1b.z, a.w1b.w, a.w2b.z, a.w2b.w, a.bb.z, a.bb.w);
#undef ACT2
  return o;
}

__device__ void phase_upact(const Params& p, int l, int* ctr) {
  const int MT = (l == 1 ? NBG * SEQ / 128 : RG / 128), NT = 22;
  const u16* W = p.wt + (size_t)l * W_LAYER + W_GU + (size_t)DFF * 1024;
  const float* cw = p.in[23] + (size_t)l * 3 * DFF;
  const float* cb = p.in[24] + (size_t)l * DFF;
  const u16* G = p.proj;
  u16* ACT = p.proj + (size_t)RG * DFF;
  run_q8(ctr, GEMM_CNT(MT, NT), [&](int q_, int j_) {
    int mt, nt; tile_order(j_, mlo(q_ + 1, MT) - mlo(q_, MT), NT, mt, nt); mt += mlo(q_, MT);
    f32x4 acc[4][4];
    gemm_core<4>(p.h + (size_t)mt * 128 * DM, DM, W + (size_t)nt * 128 * DM, DM, DM, acc);
    EPI_VARS
    char* lb = smem + wid_ * 8192;
#pragma unroll
    for (int wi = 0; wi < 4; ++wi)
#pragma unroll
      for (int xi = 0; xi < 4; ++xi) {
        uint2 o; o.x = pack2(acc[wi][xi][0], acc[wi][xi][1]); o.y = pack2(acc[wi][xi][2], acc[wi][xi][3]);
        const int r = xi * 16 + fr_, c = wi * 2 + (fq_ >> 1);
        *(uint2*)(lb + r * 128 + ((c ^ (r & 7)) << 4) + (fq_ & 1) * 8) = o;
      }
    const int c8 = lane_ & 7, rsub = lane_ >> 3;
    const int n = nt * 128 + wc_ * 64 + c8 * 8;
    const int rowbase = mt * 128 + wr_ * 64;
    int bl, pos0, isctx; rowinfo(rowbase, NBG, bl, pos0, isctx);
    const int L = isctx ? CTXL : SEQ;
    ActIn a;
    a.w0a = *(const float4*)(cw + n); a.w0b = *(const float4*)(cw + n + 4);
    a.w1a = *(const float4*)(cw + DFF + n); a.w1b = *(const float4*)(cw + DFF + n + 4);
    a.w2a = *(const float4*)(cw + 2 * DFF + n); a.w2b = *(const float4*)(cw + 2 * DFF + n + 4);
    a.ba = *(const float4*)(cb + n); a.bb = *(const float4*)(cb + n + 4);
#pragma unroll
    for (int half = 0; half < 2; ++half) {
      uint4 g0[4], g1[4], g2[4];
#pragma unroll
      for (int it = 0; it < 4; ++it) {
        const int row = (half * 4 + it) * 8 + rsub, pos = pos0 + row;
        const u16* gp = G + (size_t)(rowbase + row) * DFF + n;
        g1[it] = *(const uint4*)gp;
        g0[it] = make_uint4(0, 0, 0, 0); g2[it] = g0[it];
        if (pos > 0) g0[it] = *(const uint4*)(gp - DFF);
        if (pos < L - 1) g2[it] = *(const uint4*)(gp + DFF);
      }
#pragma unroll
      for (int it = 0; it < 4; ++it) {
        const int row = (half * 4 + it) * 8 + rsub;
        a.g0 = g0[it]; a.g1 = g1[it]; a.g2 = g2[it];
        a.uu = *(const uint4*)(lb + row * 128 + ((c8 ^ (row & 7)) << 4));
        st_nt(ACT + (size_t)(rowbase + row) * DFF + n, act_compute(a));
      }
    }
  });
}

__device__ void phase_final(const Params& p, int* ctr) {
  const int nitems = NBATCH * SEQ / 16;
  const float* gam = p.in[26];
  for (int it = blockIdx.x; it < nitems; it += gridDim.x) {
    const int lane = TIDX & 63, wid = TIDX >> 6;
    float* xr = p.out + ((size_t)it * 16 + wid * 4) * DM;
    float4 v[4][4], gg[4];
#pragma unroll
    for (int rr = 0; rr < 4; ++rr)
#pragma unroll
      for (int i = 0; i < 4; ++i) v[rr][i] = *(const float4*)(xr + (size_t)rr * DM + lane * 4 + i * 256);
#pragma unroll
    for (int i = 0; i < 4; ++i) gg[i] = *(const float4*)(gam + lane * 4 + i * 256);
#pragma unroll
    for (int rr = 0; rr < 4; ++rr) {
      float ss = 0.f;
#pragma unroll
      for (int i = 0; i < 4; ++i)
        ss += v[rr][i].x * v[rr][i].x + v[rr][i].y * v[rr][i].y + v[rr][i].z * v[rr][i].z + v[rr][i].w * v[rr][i].w;
      ss = wave_sum(ss);
      const float rstd = rsqrtf(ss * (1.f / 1024.f) + EPS);
#pragma unroll
      for (int i = 0; i < 4; ++i) {
        float4 o; o.x = v[rr][i].x * rstd * gg[i].x; o.y = v[rr][i].y * rstd * gg[i].y; o.z = v[rr][i].z * rstd * gg[i].z; o.w = v[rr][i].w * rstd * gg[i].w;
        st_nt(xr + (size_t)rr * DM + lane * 4 + i * 256, o);
      }
    }
  }
}

#define XB_TMO      128
#define XB_XCNT(j)  (256  + 64 * (j))
#define XB_XSUB(j)  (1280 + 64 * (j))
#define XB_XGEN(j)  (2304 + 64 * (j))
#define XB_TOP      3328
#define XB_TOPGEN   3392
#define XCD_BAR_WORDS 3456
#define XB_SPIN_CAP (1u << 22)
#define LAS __attribute__((address_space(3)))
__device__ __forceinline__ unsigned xb_ld(unsigned* p)              { return __hip_atomic_load(p, __ATOMIC_RELAXED, __HIP_MEMORY_SCOPE_AGENT); }
__device__ __forceinline__ unsigned xb_add(unsigned* p, unsigned v) { return __hip_atomic_fetch_add(p, v, __ATOMIC_RELAXED, __HIP_MEMORY_SCOPE_AGENT); }
__device__ __forceinline__ unsigned xb_xcc_id() { return (unsigned)__builtin_amdgcn_s_getreg((3 << 11) | 20) & 0xFu; }
#define XB_SPIN(cond, bar) do { unsigned _sp = 0; while (cond) { __builtin_amdgcn_s_sleep(1); \
    if ((++_sp & 255u) == 0u) { if (xb_ld(&(bar)[XB_TMO])) break; if (_sp > XB_SPIN_CAP) { atomicAdd(&(bar)[XB_TMO], 1u); break; } } } } while (0)
struct XcdBarrier { unsigned* bar; unsigned x; volatile LAS unsigned* st; };
__device__ __forceinline__ XcdBarrier xcd_barrier_post(unsigned* bar, volatile LAS unsigned* st) {
  XcdBarrier b; b.bar = bar; b.x = xb_xcc_id(); b.st = st;
  if (threadIdx.x == 0) (void)xb_add(&bar[XB_XCNT(b.x)], 1u);
  return b;
}
__device__ __forceinline__ void xcd_barrier_complete(unsigned* bar, unsigned x, unsigned& nloc, unsigned& nx) {
  const unsigned G = gridDim.x * gridDim.y * gridDim.z;
  unsigned sum, cnt, mine, sp = 0u;
  for (;;) {
    sum = 0u; cnt = 0u; mine = 0u;
#pragma unroll
    for (unsigned j = 0; j < 16; ++j) { const unsigned c = xb_ld(&bar[XB_XCNT(j)]); sum += c; cnt += (c > 0u) ? 1u : 0u; mine = (j == x) ? c : mine; }
    if (sum == G) break;
    __builtin_amdgcn_s_sleep(1);
    if ((++sp & 255u) == 0u) { if (xb_ld(&bar[XB_TMO])) break; if (sp > XB_SPIN_CAP) { atomicAdd(&bar[XB_TMO], 1u); break; } }
  }
  nloc = mine > 0u ? mine : 1u; nx = cnt > 0u ? cnt : 1u;
}
__device__ __forceinline__ void xcd_barrier(const XcdBarrier& b) {
  asm volatile("s_waitcnt vmcnt(0)" ::: "memory");
  __syncthreads();
  if (threadIdx.x == 0) {
    unsigned* bar = b.bar;
    __builtin_amdgcn_s_waitcnt(0);
    unsigned nloc = b.st[0], nx = b.st[1];
    if (nloc == 0u) { xcd_barrier_complete(bar, b.x, nloc, nx); b.st[0] = nloc; b.st[1] = nx; }
    const unsigned old = xb_add(&bar[XB_XSUB(b.x)], 1u);
    const unsigned gen = old / nloc;
    if (old + 1u == (gen + 1u) * nloc) {
      __builtin_amdgcn_fence(__ATOMIC_RELEASE, "agent");
      asm volatile("s_waitcnt vmcnt(0)" ::: "memory");
      const unsigned og = xb_add(&bar[XB_TOP], 1u);
      const unsigned tg = og / nx;
      if (og + 1u == (tg + 1u) * nx) xb_add(&bar[XB_TOPGEN], 1u);
      else XB_SPIN(xb_ld(&bar[XB_TOPGEN]) == tg, bar);
      __builtin_amdgcn_fence(__ATOMIC_ACQUIRE, "agent");
      xb_add(&bar[XB_XGEN(b.x)], 1u);
      asm volatile("s_waitcnt vmcnt(0)" ::: "memory");
    } else {
      XB_SPIN(xb_ld(&bar[XB_XGEN(b.x)]) == gen, bar);
      __builtin_amdgcn_fence(__ATOMIC_ACQUIRE, "agent");
      asm volatile("s_waitcnt vmcnt(0)" ::: "memory");
    }
  }
  __syncthreads();
}

__device__ void run_phase(const Params& p, int ph, int* ctr) {
  if (ph == 0) { phase0(p, ctr); return; }
  if (ph == NPHASES - 1) { phase_final(p, ctr); return; }
  const int idx = ph - 1, lg = idx / NPH_PER, sub = idx % NPH_PER;
  const int g = lg / 2, l = lg % 2;
  switch (sub) {
    case 0: phase_norm(p, l, g, 0, ctr); break;
    case 1: phase_proj(p, l, ctr, lg == 0); break;
    case 2: phase_postproj(p, l, ctr); break;
    case 3: phase_qkv(p, l, ctr); break;
    case 4: phase_attn(p, l, ctr); break;
    case 5: phase_merge(p, l, ctr); break;
    case 6: phase_resid(p, l, g, 0, ctr); break;
    case 7: phase_norm(p, l, g, 1, ctr); break;
    case 8: phase_gate(p, l, ctr); break;
    case 9: phase_upact(p, l, ctr); break;
    default: phase_resid(p, l, g, 1, ctr); break;
  }
}

__global__ void __launch_bounds__(256, 2) mega_kernel(KArgs ka, int ph_lo, int ph_hi, int coop) {
  Params p;
#pragma unroll
  for (int i = 0; i < 27; ++i) p.in[i] = ka.in[i];
  p.out = ka.out;
  char* ws = ka.ws;
  p.ctr = (int*)(ws + O_CTR); p.mod = (float*)(ws + O_MOD); p.rope = (float*)(ws + O_ROPE); p.xc = (float*)(ws + O_XC);
  p.rstdq = (float*)(ws + O_RSQ); p.rstdkv = (float*)(ws + O_RSKV); p.dec = (float*)(ws + O_DEC); p.wt = (u16*)(ws + O_WT);
  p.proj = (u16*)(ws + O_PROJ); p.h = (u16*)(ws + O_H); p.m = (u16*)(ws + O_M); p.q = (u16*)(ws + O_Q);
  p.kf = (u16*)(ws + O_KF); p.vt = (u16*)(ws + O_VT); p.uc = (u16*)(ws + O_UC); p.gq = (u16*)(ws + O_GQ);
  p.ss = (u16*)(ws + O_SS);
  volatile LAS unsigned* st = (volatile LAS unsigned*)(smem + SLOT_OFF + 64);
  if (threadIdx.x == 0) { st[0] = 0u; st[1] = 0u; }
  __syncthreads();
  XcdBarrier xb;
  xb.bar = (unsigned*)(ws + O_BAR); xb.x = 0; xb.st = st;
  if (coop) xb = xcd_barrier_post((unsigned*)(ws + O_BAR), st);
  for (int ph = ph_lo; ph < ph_hi; ++ph) {
#ifdef PROBE_MASK
    const int nrep = (ph > 0 && ph < NPHASES - 1 && ((PROBE_MASK >> ((ph - 1) % NPH_PER)) & 1)) ? 2 : 1;
#else
    const int nrep = 1;
#endif
    for (int rep = 0; rep < nrep; ++rep) {
      if (rep) xcd_barrier(xb);
      run_phase(p, ph, p.ctr + rep * 512 + ph * 8);
    }
    if (coop && ph + 1 < ph_hi) {
      if (ph == ph_lo) cg::this_grid().sync();
      else xcd_barrier(xb);
    }
  }
}

static inline size_t align_up(size_t v) { return (v + 255) & ~(size_t)255; }

extern "C" void kernel_launch(void* const* d_in, const int* in_sizes, int n_in, void* d_out, int out_size,
                              void* d_ws, size_t ws_size, hipStream_t stream) {
  static int grid_blocks = 0;
  if (!grid_blocks) {
    int dev = 0, cus = 0, per_cu = 0;
    hipGetDevice(&dev);
    hipDeviceGetAttribute(&cus, hipDeviceAttributeMultiprocessorCount, dev);
    hipFuncSetAttribute((const void*)mega_kernel, hipFuncAttributeMaxDynamicSharedMemorySize, LDS_BYTES);
    hipOccupancyMaxActiveBlocksPerMultiprocessor(&per_cu, (const void*)mega_kernel, 256, LDS_BYTES);
    if (per_cu < 1) per_cu = 1;
    if (per_cu > 2) per_cu = 2;
    grid_blocks = cus * per_cu;
  }
  KArgs p{};
  for (int i = 0; i < 27; ++i) p.in[i] = (const float*)d_in[i];
  p.out = (float*)d_out;
  p.ws = (char*)d_ws;
  if (ws_size < WS_END) { fprintf(stderr, "workspace too small: %zu < %zu\n", ws_size, (size_t)WS_END); return; }
  hipMemsetAsync((char*)d_ws + O_CTR, 0, 4096 + XCD_BAR_BYTES, stream);
#if SINGLE_LAUNCH
  int lo = 0, hi = NPHASES, coop = 1;
  void* args[] = {&p, &lo, &hi, &coop};
  hipError_t e = hipLaunchCooperativeKernel((const void*)mega_kernel, dim3(grid_blocks), dim3(256), args, LDS_BYTES, stream);
  if (e != hipSuccess) fprintf(stderr, "cooperative launch failed: %s (grid %d)\n", hipGetErrorString(e), grid_blocks);
#else
  for (int ph = 0; ph < NPHASES; ++ph)
    hipLaunchKernelGGL(mega_kernel, dim3(grid_blocks), dim3(256), LDS_BYTES, stream, p, ph, ph + 1, 0);
#endif
}
```

```cpp
#include <hip/hip_runtime.h>
#include <hip/hip_cooperative_groups.h>
#include <cstdio>
#include <cstdint>
namespace cg = cooperative_groups;

typedef unsigned short u16;
typedef __attribute__((ext_vector_type(8))) short bf16x8;
typedef __attribute__((ext_vector_type(4))) float f32x4;
typedef __attribute__((ext_vector_type(16))) float f32x16;

#ifndef SINGLE_LAUNCH
#define SINGLE_LAUNCH 1
#endif

constexpr int DM = 1024, SEQ = 8192, CTXL = 256, NBATCH = 8, INW = 6592, INWP = 6656, DFF = 2816;
constexpr int C_QA = 0, C_KA = 256, C_VA = 512, C_RA = 1024, C_ALR = 1536, C_CQ = 1568, C_CKV = 1824,
              C_KR = 1952, C_SB = 1984, C_SC = 2496, C_SX = 3008, C_GATE = 3520;
constexpr int NKEY = SEQ + CTXL;
constexpr int NCHUNK = NKEY / 64;
constexpr float EPS = 1e-6f;
constexpr int LDS_BYTES = 65536 + 256;
constexpr int SLOT_OFF = 65536;
constexpr int NPH_PER = 11;
constexpr int NBG = 4;
constexpr int NGRP = NBATCH / NBG;
constexpr int RG = NBG * (SEQ + CTXL);
constexpr int NPHASES = 1 + 2 * NGRP * NPH_PER + 1;

constexpr size_t W_IN = 0;
constexpr size_t W_UQ = W_IN + (size_t)INWP * 1024;
constexpr size_t W_UKV = W_UQ + 768 * 256;
constexpr size_t W_BRA = W_UKV + 1024 * 128;
constexpr size_t W_BRB = W_BRA + 1024 * 512;
constexpr size_t W_BRC = W_BRB + 1024 * 512;
constexpr size_t W_O = W_BRC + 1024 * 512;
constexpr size_t W_GU = W_O + 1024 * 1024;
constexpr size_t W_DN = W_GU + (size_t)5632 * 1024;
constexpr size_t W_LAYER = W_DN + (size_t)1024 * 2816;

struct KArgs {
  const float* in[27];
  float* out;
  char* ws;
};
struct Params {
  const float* in[27];
  float* out;
  float* xc;
  u16* wt;
  float* mod;
  float* rope;
  int* ctr;
  float* rstdq;
  float* rstdkv;
  float* dec;
  u16* proj;
  u16* h;
  u16* m;
  u16* q;
  u16* kf;
  u16* vt;
  u16* uc;
  u16* gq;
  u16* ss;
};
constexpr size_t al256(size_t v) { return (v + 255) & ~(size_t)255; }
constexpr size_t XCD_BAR_BYTES = 3456 * 4;
constexpr size_t O_CTR = 0;
constexpr size_t O_BAR = O_CTR + 4096;
constexpr size_t O_MOD = al256(O_BAR + XCD_BAR_BYTES);
constexpr size_t O_ROPE = al256(O_MOD + (size_t)2 * 9 * 6144 * 4);
constexpr size_t O_XC = al256(O_ROPE + 1024 * 2 * 4);
constexpr size_t O_RSQ = al256(O_XC + (size_t)NBATCH * CTXL * DM * 4);
constexpr size_t O_RSKV = al256(O_RSQ + (size_t)RG * 4);
constexpr size_t O_DEC = al256(O_RSKV + (size_t)RG * 4);
constexpr size_t O_WT = al256(O_DEC + (size_t)NBG * NCHUNK * 4 * 2 * 64 * 4);
constexpr size_t O_PROJ = al256(O_WT + 2 * W_LAYER * 2);
constexpr size_t O_H = al256(O_PROJ + (size_t)RG * INW * 2);
constexpr size_t O_M = O_H + (size_t)RG * DM * 2;
constexpr size_t O_Q = al256(O_M + (size_t)RG * DM * 2);
constexpr size_t O_KF = al256(O_Q + (size_t)RG * 768 * 2);
constexpr size_t O_VT = al256(O_KF + (size_t)NBG * 8 * NKEY * 96 * 2);
constexpr size_t O_UC = al256(O_VT + (size_t)NBG * 8 * 64 * NKEY * 2);
constexpr size_t O_GQ = al256(O_UC + (size_t)RG * 512 * 2);
constexpr size_t O_SS = al256(O_GQ + (size_t)RG * 1024 * 2);
constexpr size_t WS_END = al256(O_SS + (size_t)NBG * NCHUNK * 4 * 2 * 8192 * 2);
static_assert(WS_END <= ((size_t)1 << 30), "workspace layout must fit 1 GiB");

extern __shared__ __attribute__((aligned(16))) char smem[];

typedef __bf16 hbf2 __attribute__((ext_vector_type(2)));
typedef float hf2 __attribute__((ext_vector_type(2)));
__device__ __forceinline__ unsigned pack2(float a, float b) {
  hf2 v = {a, b};
  return __builtin_bit_cast(unsigned, __builtin_convertvector(v, hbf2));
}
__device__ __forceinline__ u16 f2bf(float f) { return (u16)(pack2(f, 0.f) & 0xffffu); }
__device__ __forceinline__ float bf2f(u16 h) { return __uint_as_float(((unsigned)h) << 16); }
__device__ __forceinline__ float bflo(unsigned u) { return __uint_as_float(u << 16); }
__device__ __forceinline__ float bfhi(unsigned u) { return __uint_as_float(u & 0xffff0000u); }
typedef unsigned nt_u32x4 __attribute__((ext_vector_type(4)));
typedef unsigned nt_u32x2 __attribute__((ext_vector_type(2)));
__device__ __forceinline__ void st_nt(void* p, uint4 v) { nt_u32x4 t = {v.x, v.y, v.z, v.w}; __builtin_nontemporal_store(t, (nt_u32x4*)p); }
__device__ __forceinline__ void st_nt(void* p, uint2 v) { nt_u32x2 t = {v.x, v.y}; __builtin_nontemporal_store(t, (nt_u32x2*)p); }
__device__ __forceinline__ void st_nt(void* p, float4 v) { f32x4 t = {v.x, v.y, v.z, v.w}; __builtin_nontemporal_store(t, (f32x4*)p); }
__device__ __forceinline__ float silu_f(float x) { return x / (1.f + __expf(-x)); }
__device__ __forceinline__ float sigmoid_f(float x) { return 1.f / (1.f + __expf(-x)); }

__device__ __forceinline__ void rowinfo(int r, int NB, int& bl, int& pos, int& isctx) {
  const int nl = NB * SEQ;
  if (r < nl) { bl = r >> 13; pos = r & (SEQ - 1); isctx = 0; }
  else { const int rc = r - nl; bl = rc >> 8; pos = rc & (CTXL - 1); isctx = 1; }
}
__device__ __forceinline__ int chunk_row(int bl, int cidx, int NB) {
  return cidx < 128 ? bl * SEQ + cidx * 64 : NB * SEQ + bl * CTXL + (cidx - 128) * 64;
}

template <class CntF, class BodyF>
__device__ __forceinline__ void run_q8(int* ctr8, CntF cntf, BodyF body) {
  volatile int* slot = (volatile int*)(smem + SLOT_OFF);
  int q = blockIdx.x & 7, tries = 0, item;
  __syncthreads();
  if (threadIdx.x == 0) {
    int v = atomicAdd(&ctr8[q], 1);
    while (v >= cntf(q) && tries < 8) { q = (q + 1) & 7; ++tries; if (tries < 8) v = atomicAdd(&ctr8[q], 1); }
    slot[0] = (tries < 8) ? v : -1; slot[1] = q; slot[2] = tries;
  }
  __syncthreads();
  item = slot[0]; q = slot[1]; tries = slot[2];
  while (item >= 0) {
    int nxt = 0;
    if (threadIdx.x == 0) nxt = atomicAdd(&ctr8[q], 1);
    body(q, item);
    __syncthreads();
    if (threadIdx.x == 0) {
      int qq = q, t = tries;
      while (nxt >= cntf(qq) && t < 8) { qq = (qq + 1) & 7; ++t; if (t < 8) nxt = atomicAdd(&ctr8[qq], 1); }
      slot[0] = (t < 8) ? nxt : -1; slot[1] = qq; slot[2] = t;
    }
    __syncthreads();
    item = slot[0]; q = slot[1]; tries = slot[2];
  }
}
#define QA_CNT(N) [=](int q_) { return ((N) - q_ + 7) >> 3; }
#define QA_ID(q_, j_) ((j_) * 8 + (q_))

__device__ __forceinline__ int opaque_tid() {
  int t = threadIdx.x;
  asm volatile("" : "+v"(t));
  return t;
}
#define TIDX opaque_tid()
template <int M>
__device__ __forceinline__ float xor_lane(float v) {
  if constexpr (M == 32) {
    const unsigned u = __float_as_uint(v);
    const auto sw = __builtin_amdgcn_permlane32_swap(u, u, false, false);
    return __uint_as_float(sw[0] ^ sw[1] ^ u);
  } else {
    return __uint_as_float((unsigned)__builtin_amdgcn_ds_swizzle((int)__float_as_uint(v), 0x1f | (M << 10)));
  }
}
__device__ __forceinline__ float wave_sum(float v) {
  v += xor_lane<32>(v); v += xor_lane<16>(v); v += xor_lane<8>(v);
  v += xor_lane<4>(v); v += xor_lane<2>(v); v += xor_lane<1>(v);
  return v;
}

__device__ __forceinline__ int lds_byte(int r, int c) {
  const int st = (r >> 4) * 2 + (c >> 5), rr = r & 15, cc = c & 31, ob = rr * 64 + cc * 2;
  return st * 1024 + (ob ^ (((ob >> 9) & 1) << 5));
}
__device__ __forceinline__ void stage_rc(int b, int& R, int& C) {
  const int st = b >> 10, sb = b & 1023, swz = sb ^ (((sb >> 9) & 1) << 5);
  R = (st >> 1) * 16 + (swz >> 6); C = (st & 1) * 32 + ((swz & 63) >> 1);
}

__device__ __forceinline__ void glds16(const void* g, void* l) {
  __builtin_amdgcn_global_load_lds((const __attribute__((address_space(1))) unsigned*)g,
                                   (__attribute__((address_space(3))) unsigned*)l, 16, 0, 0);
}

template <int NWI>
__device__ __forceinline__ void gemm_core(const u16* __restrict__ X, int ldx, const u16* __restrict__ W, int ldw,
                                          int K, f32x4 (&acc)[NWI][4]) {
  const int tid = TIDX, lane = tid & 63, wid = tid >> 6;
  const int wr = wid >> 1, wc = wid & 1, fr = lane & 15, fq = lane >> 4;
#pragma unroll
  for (int a = 0; a < NWI; ++a)
#pragma unroll
    for (int b = 0; b < 4; ++b) acc[a][b] = f32x4{0.f, 0.f, 0.f, 0.f};
  const int srow = tid >> 3, schunk = (tid & 7) ^ ((tid >> 4) & 7);
  const u16* xg = X + (size_t)srow * ldx + schunk * 8;
  const u16* wg = W + (size_t)srow * ldw + schunk * 8;
  const int xs = 32 * ldx, ws_ = 32 * ldw;
  const int g = fr >> 1;
  const int lo0 = fr * 128 + ((fq ^ g) << 4), lo1 = fr * 128 + (((fq ^ g) ^ 4) << 4);
  const char* xb = smem + wr * 8192;
  const char* wb = smem + 16384 + wc * (NWI * 2048);
  char* sdst = smem + tid * 16;
  const int nt = K >> 6;
  __syncthreads();
#pragma unroll
  for (int i = 0; i < 4; ++i) {
    glds16(xg + i * xs, sdst + i * 4096);
    if (i < NWI) glds16(wg + i * ws_, sdst + 16384 + i * 4096);
  }
  for (int kt = 0; kt < nt; ++kt) {
    asm volatile("s_waitcnt vmcnt(0)" ::: "memory");
    __syncthreads();
    const int cb = (kt & 1) * 32768;
    if (kt + 1 < nt) {
      const int nb = 32768 - cb;
      const int ko = (kt + 1) * 64;
#pragma unroll
      for (int i = 0; i < 4; ++i) {
        glds16(xg + i * xs + ko, sdst + nb + i * 4096);
        if (i < NWI) glds16(wg + i * ws_ + ko, sdst + nb + 16384 + i * 4096);
      }
    }
    bf16x8 wf[2][NWI], xf[2][4];
#pragma unroll
    for (int i = 0; i < NWI; ++i) {
      wf[0][i] = *(const bf16x8*)(wb + cb + i * 2048 + lo0);
      wf[1][i] = *(const bf16x8*)(wb + cb + i * 2048 + lo1);
    }
#pragma unroll
    for (int i = 0; i < 4; ++i) {
      xf[0][i] = *(const bf16x8*)(xb + cb + i * 2048 + lo0);
      xf[1][i] = *(const bf16x8*)(xb + cb + i * 2048 + lo1);
    }
    __builtin_amdgcn_sched_barrier(0);
#pragma unroll
    for (int k = 0; k < 2; ++k)
#pragma unroll
      for (int wi = 0; wi < NWI; ++wi)
#pragma unroll
        for (int xi = 0; xi < 4; ++xi)
          acc[wi][xi] = __builtin_amdgcn_mfma_f32_16x16x32_bf16(wf[k][wi], xf[k][xi], acc[wi][xi], 0, 0, 0);
    __builtin_amdgcn_sched_barrier(0);
  }
}

#define EPI_VARS const int tid_ = TIDX, lane_ = tid_ & 63, wid_ = tid_ >> 6; \
  const int wr_ = wid_ >> 1, wc_ = wid_ & 1, fr_ = lane_ & 15, fq_ = lane_ >> 4; (void)fq_; (void)fr_; (void)wr_; (void)wc_;
#define EPI_TR(xi) (wr_ * 64 + (xi) * 16 + fr_)
#define EPI_NN(wi) (wc_ * 64 + (wi) * 16 + fq_ * 4)

template <int NWI>
__device__ __forceinline__ void store_tile_bf16(const uint2 (&o)[NWI][4], u16* dst_wave, size_t ld) {
  constexpr int RB = NWI * 32, CPR = RB / 16;
  const int tid = TIDX, lane = tid & 63, wid = tid >> 6, fr = lane & 15, fq = lane >> 4;
  char* lb = smem + wid * 8192;
#pragma unroll
  for (int wi = 0; wi < NWI; ++wi)
#pragma unroll
    for (int xi = 0; xi < 4; ++xi) {
      const int r = xi * 16 + fr, c = wi * 2 + (fq >> 1);
      *(uint2*)(lb + r * RB + ((c ^ (r & (CPR - 1))) << 4) + (fq & 1) * 8) = o[wi][xi];
    }
#pragma unroll
  for (int it = 0; it < CPR; ++it) {
    const int idx = it * 64 + lane, row = idx / CPR, c = idx % CPR;
    typedef unsigned u32x4_t __attribute__((ext_vector_type(4)));
    const u32x4_t v = *(const u32x4_t*)(lb + row * RB + ((c ^ (row & (CPR - 1))) << 4));
    __builtin_nontemporal_store(v, (u32x4_t*)(dst_wave + (size_t)row * ld + c * 8));
  }
}

__device__ __forceinline__ void tile_order(int t, int MT, int NT, int& mt, int& nt) {
  constexpr int GM = 4;
  const int band = t / (GM * NT), rem = t - band * GM * NT;
  const int m0 = band * GM;
  const int gsz = min(GM, MT - m0);
  nt = rem / gsz; mt = m0 + rem - nt * gsz;
}

__device__ __forceinline__ int mlo(int q, int MT) { return (q * MT) >> 3; }
#define GEMM_CNT(MT, NT) [=](int q_) { return (mlo(q_ + 1, MT) - mlo(q_, MT)) * (NT); }

__device__ __forceinline__ float* xrow_ptr(const Params& p, int g, int r) {
  int bl, pos, isctx; rowinfo(r, NBG, bl, pos, isctx);
  const int b = g * NBG + bl;
  return isctx ? p.xc + ((size_t)b * CTXL + pos) * DM : p.out + ((size_t)b * SEQ + pos) * DM;
}
__device__ __forceinline__ const float* xsrc_row_ptr(const Params& p, int g, int r, int from_input) {
  int bl, pos, isctx; rowinfo(r, NBG, bl, pos, isctx);
  const int b = g * NBG + bl;
  if (from_input) return isctx ? p.in[2] + ((size_t)b * CTXL + pos) * DM : p.in[0] + ((size_t)b * SEQ + pos) * DM;
  return isctx ? p.xc + ((size_t)b * CTXL + pos) * DM : p.out + ((size_t)b * SEQ + pos) * DM;
}
__device__ __forceinline__ int mod_index(const Params& p, int g, int r) {
  int bl, pos, isctx; rowinfo(r, NBG, bl, pos, isctx);
  return isctx ? 8 : g * NBG + bl;
}

__device__ void conv_tile4(const float* __restrict__ src, int K, int N, u16* __restrict__ dst,
                           const float* __restrict__ scale, int ktile, int ngrp) {
  float* tile = (float*)smem;
  const int tid = TIDX;
  const int k0 = ktile * 64;
  const int kk = tid >> 4, n4 = (tid & 15) * 4;
  float4 v[4][4];
  float sc[4];
#pragma unroll
  for (int i = 0; i < 4; ++i) sc[i] = scale ? scale[k0 + kk + 16 * i] : 1.f;
#pragma unroll
  for (int t = 0; t < 4; ++t) {
    const int n0 = (ngrp * 4 + t) * 64;
#pragma unroll
    for (int i = 0; i < 4; ++i) {
      v[t][i] = make_float4(0.f, 0.f, 0.f, 0.f);
      if (n0 < N) v[t][i] = *(const float4*)(src + (size_t)(k0 + kk + 16 * i) * N + n0 + n4);
    }
  }
  const int nn = tid >> 3, k8 = (tid & 7) * 8;
#pragma unroll
  for (int t = 0; t < 4; ++t) {
    const int n0 = (ngrp * 4 + t) * 64;
    __syncthreads();
#pragma unroll
    for (int i = 0; i < 4; ++i) {
      const int k = kk + 16 * i;
      tile[k * 65 + n4 + 0] = v[t][i].x * sc[i]; tile[k * 65 + n4 + 1] = v[t][i].y * sc[i];
      tile[k * 65 + n4 + 2] = v[t][i].z * sc[i]; tile[k * 65 + n4 + 3] = v[t][i].w * sc[i];
    }
    __syncthreads();
#pragma unroll
    for (int i = 0; i < 2; ++i) {
      const int n = nn + 32 * i;
      uint4 o;
      o.x = pack2(tile[(k8 + 0) * 65 + n], tile[(k8 + 1) * 65 + n]);
      o.y = pack2(tile[(k8 + 2) * 65 + n], tile[(k8 + 3) * 65 + n]);
      o.z = pack2(tile[(k8 + 4) * 65 + n], tile[(k8 + 5) * 65 + n]);
      o.w = pack2(tile[(k8 + 6) * 65 + n], tile[(k8 + 7) * 65 + n]);
      *(uint4*)(dst + (size_t)(n0 + n) * K + k0 + k8) = o;
    }
  }
}

__device__ __forceinline__ void sincos_f(float a, float& s, float& c) {
  const float k = rintf(a * 0.63661977236758134f);
  float r = fmaf(-k, 1.5707963705062866f, a);
  r = fmaf(-k, -4.371138828673793e-08f, r);
  const int q = ((int)k) & 3;
  const float r2 = r * r;
  const float sp = r * (1.0f + r2 * (-1.6666667e-1f + r2 * (8.3333333e-3f + r2 * (-1.9841270e-4f + r2 * 2.7557319e-6f))));
  const float cp = 1.0f + r2 * (-0.5f + r2 * (4.1666667e-2f + r2 * (-1.3888889e-3f + r2 * (2.4801587e-5f + r2 * -2.7557319e-7f))));
  s = (q == 0) ? sp : (q == 1) ? cp : (q == 2) ? -sp : -cp;
  c = (q == 0) ? cp : (q == 1) ? -sp : (q == 2) ? -cp : sp;
}

constexpr int CV_WIN = 0, CV_UQ = 416, CV_UKV = 428, CV_BRA = 436, CV_BRB = 468, CV_BRC = 500,
              CV_WO = 532, CV_GATE = 596, CV_UP = 772, CV_DN = 948, CV_LAYER = 1124;
constexpr int P0_CONV = 2 * CV_LAYER, P0_ADA = 2 * 192, P0_TOTAL = P0_CONV + P0_ADA + 1;

__device__ __forceinline__ void conv_item(const Params& p, int ci) {
  const int l = ci / CV_LAYER, j = ci % CV_LAYER;
  u16* wl = p.wt + (size_t)l * W_LAYER;
  if (j < CV_UQ)       { const int jj = j - CV_WIN;  conv_tile4(p.in[7] + (size_t)l * 1024 * INW, 1024, INW, wl + W_IN, nullptr, jj / 26, jj % 26); }
  else if (j < CV_UKV) { const int jj = j - CV_UQ;   conv_tile4(p.in[12] + (size_t)l * 256 * 768, 256, 768, wl + W_UQ, p.in[11] + l * 256, jj / 3, jj % 3); }
  else if (j < CV_BRA) { const int jj = j - CV_UKV;  conv_tile4(p.in[14] + (size_t)l * 128 * 1024, 128, 1024, wl + W_UKV, p.in[13] + l * 128, jj / 4, jj % 4); }
  else if (j < CV_BRB) { const int jj = j - CV_BRA;  conv_tile4(p.in[16] + (size_t)l * 512 * 1024, 512, 1024, wl + W_BRA, nullptr, jj / 4, jj % 4); }
  else if (j < CV_BRC) { const int jj = j - CV_BRB;  conv_tile4(p.in[17] + (size_t)l * 512 * 1024, 512, 1024, wl + W_BRB, nullptr, jj / 4, jj % 4); }
  else if (j < CV_WO)  { const int jj = j - CV_BRC;  conv_tile4(p.in[18] + (size_t)l * 512 * 1024, 512, 1024, wl + W_BRC, nullptr, jj / 4, jj % 4); }
  else if (j < CV_GATE){ const int jj = j - CV_WO;   conv_tile4(p.in[19] + (size_t)l * 1024 * 1024, 1024, 1024, wl + W_O, nullptr, jj / 4, jj % 4); }
  else if (j < CV_UP)  { const int jj = j - CV_GATE; conv_tile4(p.in[21] + (size_t)l * 1024 * DFF, 1024, DFF, wl + W_GU, nullptr, jj / 11, jj % 11); }
  else if (j < CV_DN)  { const int jj = j - CV_UP;   conv_tile4(p.in[22] + (size_t)l * 1024 * DFF, 1024, DFF, wl + W_GU + (size_t)DFF * 1024, nullptr, jj / 11, jj % 11); }
  else                 { const int jj = j - CV_DN;   conv_tile4(p.in[25] + (size_t)l * DFF * 1024, DFF, 1024, wl + W_DN, nullptr, jj / 4, jj % 4); }
}
constexpr int P0_EARLY = CV_UQ;
constexpr int P0_DEFER = P0_CONV - P0_EARLY;

__device__ void phase0(const Params& p, int* ctr) {
  run_q8(ctr, QA_CNT(P0_ADA + 1 + P0_EARLY), [&](int q_, int j_) {
    const int it = QA_ID(q_, j_);
    const int tid = TIDX;
    if (it >= P0_ADA + 1) {
      conv_item(p, it - (P0_ADA + 1));
    } else if (it < P0_ADA) {
      const int a = it, l = a / 192, cg_ = a % 192;
      float* sc = (float*)smem;
      float* red = sc + 9 * 1024;
      for (int e = tid; e < 9 * 1024; e += 256) {
        const int v = e >> 10, k = e & 1023;
        const float cv = (v < 8) ? p.in[1][v * 1024 + k] : p.in[3][k];
        sc[e] = cv / (1.f + expf(-cv));
      }
      __syncthreads();
      const int kg = tid >> 5, cn = tid & 31;
      const float* wa = p.in[4] + (size_t)l * 1024 * 6144 + cg_ * 32 + cn;
      float a0 = 0, a1 = 0, a2 = 0, a3 = 0, a4 = 0, a5 = 0, a6 = 0, a7 = 0, a8 = 0;
#pragma unroll 8
      for (int i = 0; i < 128; ++i) {
        const int k = kg + 8 * i;
        const float w = wa[(size_t)k * 6144];
        a0 += sc[k] * w; a1 += sc[1024 + k] * w; a2 += sc[2048 + k] * w; a3 += sc[3072 + k] * w;
        a4 += sc[4096 + k] * w; a5 += sc[5120 + k] * w; a6 += sc[6144 + k] * w; a7 += sc[7168 + k] * w;
        a8 += sc[8192 + k] * w;
      }
      float* rr = red + kg * 288 + cn;
      rr[0] = a0; rr[32] = a1; rr[64] = a2; rr[96] = a3; rr[128] = a4; rr[160] = a5; rr[192] = a6; rr[224] = a7; rr[256] = a8;
      __syncthreads();
      for (int e = tid; e < 288; e += 256) {
        float s = 0.f;
#pragma unroll
        for (int g8 = 0; g8 < 8; ++g8) s += red[g8 * 288 + e];
        const int v = e >> 5, n = cg_ * 32 + (e & 31);
        p.mod[((size_t)l * 9 + v) * 6144 + n] = s + p.in[5][l * 6144 + n];
      }
    } else {
      for (int e = tid; e < 1024; e += 256) {
        const int pos = e >> 3, f = e & 7;
        const float inv = (f == 0) ? 1.0f : (f == 1) ? 0.31622776601683794f : (f == 2) ? 0.1f : (f == 3) ? 0.031622776601683794f
                        : (f == 4) ? 0.01f : (f == 5) ? 0.0031622776601683794f : (f == 6) ? 0.001f : 0.00031622776601683794f;
        const float ang = (float)pos * inv;
        float s, c; sincos_f(ang, s, c);
        p.rope[e * 2] = c; p.rope[e * 2 + 1] = s;
      }
    }
  });
}

__device__ void phase_norm(const Params& p, int l, int g, int which, int* ctr) {
  const int nitems = (which == 1 && l == 1) ? NBG * SEQ / 16 : RG / 16;
  const float* gam = (which == 0 ? p.in[6] : p.in[20]) + l * DM;
  const int shoff = which == 0 ? 0 : 3072, scoff = which == 0 ? 1024 : 4096;
  const int from_input = (which == 0 && l == 0);
  for (int it = blockIdx.x; it < nitems; it += gridDim.x) {
    const int lane = TIDX & 63, wid = TIDX >> 6;
    const int r0 = it * 16 + wid * 4;
    const float* xr = xsrc_row_ptr(p, g, r0, from_input);
    const float* mrow = p.mod + ((size_t)l * 9 + mod_index(p, g, r0)) * 6144;
    float4 v[4][4], gg[4], sh[4], sc[4];
#pragma unroll
    for (int rr = 0; rr < 4; ++rr)
#pragma unroll
      for (int i = 0; i < 4; ++i) v[rr][i] = *(const float4*)(xr + (size_t)rr * DM + lane * 4 + i * 256);
#pragma unroll
    for (int i = 0; i < 4; ++i) {
      const int c = lane * 4 + i * 256;
      gg[i] = *(const float4*)(gam + c); sh[i] = *(const float4*)(mrow + shoff + c); sc[i] = *(const float4*)(mrow + scoff + c);
    }
#pragma unroll
    for (int rr = 0; rr < 4; ++rr) {
      float ss = 0.f;
#pragma unroll
      for (int i = 0; i < 4; ++i)
        ss += v[rr][i].x * v[rr][i].x + v[rr][i].y * v[rr][i].y + v[rr][i].z * v[rr][i].z + v[rr][i].w * v[rr][i].w;
      ss = wave_sum(ss);
      const float rstd = rsqrtf(ss * (1.f / 1024.f) + EPS);
#pragma unroll
      for (int i = 0; i < 4; ++i) {
        const int c = lane * 4 + i * 256;
        uint2 o;
        o.x = pack2(v[rr][i].x * rstd * gg[i].x * (1.f + sc[i].x) + sh[i].x, v[rr][i].y * rstd * gg[i].y * (1.f + sc[i].y) + sh[i].y);
        o.y = pack2(v[rr][i].z * rstd * gg[i].z * (1.f + sc[i].z) + sh[i].z, v[rr][i].w * rstd * gg[i].w * (1.f + sc[i].w) + sh[i].w);
        st_nt(p.h + (size_t)(r0 + rr) * DM + c, o);
      }
    }
  }
}

__device__ void phase_proj(const Params& p, int l, int* ctr, bool first) {
  const int MT = RG / 128, NT = INWP / 128;
  const u16* W = p.wt + (size_t)l * W_LAYER + W_IN;
  const int ndef = first ? P0_DEFER : 0;
  run_q8(ctr, [=](int q_) { return ((ndef - q_ + 7) >> 3) + (mlo(q_ + 1, MT) - mlo(q_, MT)) * NT; }, [&](int q_, int jq_) {
    const int nd = (ndef - q_ + 7) >> 3;
    if (jq_ < nd) { conv_item(p, P0_EARLY + QA_ID(q_, jq_)); return; }
    const int j_ = jq_ - nd;
    int mt, nt; tile_order(j_, mlo(q_ + 1, MT) - mlo(q_, MT), NT, mt, nt); mt += mlo(q_, MT);
    f32x4 acc[4][4];
    gemm_core<4>(p.h + (size_t)mt * 128 * DM, DM, W + (size_t)nt * 128 * DM, DM, DM, acc);
    EPI_VARS
    uint2 o[4][4];
#pragma unroll
    for (int wi = 0; wi < 4; ++wi)
#pragma unroll
      for (int xi = 0; xi < 4; ++xi) {
        o[wi][xi].x = pack2(acc[wi][xi][0], acc[wi][xi][1]); o[wi][xi].y = pack2(acc[wi][xi][2], acc[wi][xi][3]);
      }
    if (nt * 128 + wc_ * 64 < INW)
      store_tile_bf16<4>(o, p.proj + (size_t)(mt * 128 + wr_ * 64) * INW + nt * 128 + wc_ * 64, INW);
  });
}

__device__ void postproj_rows(const Params& p, int l, int it) {
  const int lane = TIDX & 63, wid = TIDX >> 6;
  const float* scw = p.in[15] + (size_t)l * 3 * 512;
  for (int rr = 0; rr < 4; ++rr) {
    const int r = it * 16 + wid * 4 + rr;
    int bl, pos, isctx; rowinfo(r, NBG, bl, pos, isctx);
    const u16* pr = p.proj + (size_t)r * INW;
    const int Lr = isctx ? CTXL : SEQ;
    const int c0 = lane * 8;
    const uint2 u_cq = *(const uint2*)(pr + C_CQ + lane * 4);
    const unsigned u_ckv = *(const unsigned*)(pr + C_CKV + lane * 2);
    const u16 u_kr = pr[C_KR + (lane & 31)];
    const uint4 sb = *(const uint4*)(pr + C_SB + c0);
    const uint4 sc1 = *(const uint4*)(pr + C_SC + c0);
    const uint4 sx1 = *(const uint4*)(pr + C_SX + c0);
    uint4 sc0 = make_uint4(0, 0, 0, 0), sx0 = sc0, sc2 = sc0, sx2 = sc0;
    if (pos > 0) { sc0 = *(const uint4*)(pr - INW + C_SC + c0); sx0 = *(const uint4*)(pr - INW + C_SX + c0); }
    if (pos < Lr - 1) { sc2 = *(const uint4*)(pr + INW + C_SC + c0); sx2 = *(const uint4*)(pr + INW + C_SX + c0); }
    {
      const uint2 u = u_cq;
      const float a = bflo(u.x), b = bfhi(u.x), c = bflo(u.y), d = bfhi(u.y);
      float ss = wave_sum(a * a + b * b + c * c + d * d);
      if (lane == 0) p.rstdq[r] = rsqrtf(ss * (1.f / 256.f) + EPS);
    }
    {
      const unsigned u = u_ckv;
      const float a = bflo(u), b = bfhi(u);
      float ss = wave_sum(a * a + b * b);
      if (lane == 0) p.rstdkv[r] = rsqrtf(ss * (1.f / 128.f) + EPS);
    }
    {
      const int idx = lane & 31;
      const float val = bf2f(u_kr);
      const float partner = xor_lane<8>(val);
      float o = val;
      if (!isctx) {
        const int axis = idx >> 4, half = (idx >> 3) & 1, f = idx & 7;
        const int pa = axis ? (pos & 63) : (pos >> 6);
        const float c = p.rope[(pa * 8 + f) * 2], s = p.rope[(pa * 8 + f) * 2 + 1];
        o = half ? (val * c + partner * s) : (val * c - partner * s);
      }
      const int j = isctx ? SEQ + pos : pos;
      const u16 ob = f2bf(o);
      if (lane < 32) {
#pragma unroll
        for (int hd = 0; hd < 8; ++hd)
          p.kf[((size_t)(bl * 8 + hd) * NKEY + j) * 96 + 64 + idx] = ob;
      }
    }
    {
      const float4 w0a = *(const float4*)(scw + c0), w0b = *(const float4*)(scw + c0 + 4);
      const float4 w1a = *(const float4*)(scw + 512 + c0), w1b = *(const float4*)(scw + 512 + c0 + 4);
      const float4 w2a = *(const float4*)(scw + 1024 + c0), w2b = *(const float4*)(scw + 1024 + c0 + 4);
      uint4 o;
#define UC2(SBW, A0, X0, A1, X1, A2, X2, W0L, W0H, W1L, W1H, W2L, W2H) \
      pack2(bflo(SBW) * (W0L * bflo(A0) * bflo(X0) + W1L * bflo(A1) * bflo(X1) + W2L * bflo(A2) * bflo(X2)), \
            bfhi(SBW) * (W0H * bfhi(A0) * bfhi(X0) + W1H * bfhi(A1) * bfhi(X1) + W2H * bfhi(A2) * bfhi(X2)))
      o.x = UC2(sb.x, sc0.x, sx0.x, sc1.x, sx1.x, sc2.x, sx2.x, w0a.x, w0a.y, w1a.x, w1a.y, w2a.x, w2a.y);
      o.y = UC2(sb.y, sc0.y, sx0.y, sc1.y, sx1.y, sc2.y, sx2.y, w0a.z, w0a.w, w1a.z, w1a.w, w2a.z, w2a.w);
      o.z = UC2(sb.z, sc0.z, sx0.z, sc1.z, sx1.z, sc2.z, sx2.z, w0b.x, w0b.y, w1b.x, w1b.y, w2b.x, w2b.y);
      o.w = UC2(sb.w, sc0.w, sx0.w, sc1.w, sx1.w, sc2.w, sx2.w, w0b.z, w0b.w, w1b.z, w1b.w, w2b.z, w2b.w);
#undef UC2
      st_nt(p.uc + (size_t)r * 512 + c0, o);
    }
  }
}

__device__ __forceinline__ float logsig16(float z) {
  return (fminf(z, 0.f) - __logf(1.f + __expf(-fabsf(z)))) * (1.f / 16.f);
}

__device__ void gla_prep(const Params& p, int l, int it) {
  const int tid = TIDX, lane = tid & 63, wid = tid >> 6;
  const int bl = it / (NCHUNK * 4), rem = it % (NCHUNK * 4), cidx = rem >> 2, h = rem & 3;
  const int r0 = chunk_row(bl, cidx, NBG);
  float* lr = (float*)smem;
  float* tot = (float*)(smem + 8192);
  u16* vT = (u16*)(smem + 10752);
  u16* kTf = (u16*)(smem + 29184);
  u16* kTb = (u16*)(smem + 38400);
  {
    const int t = tid >> 2, c8 = (tid & 3) * 8;
    const uint4 u = *(const uint4*)(p.proj + (size_t)(r0 + t) * INW + C_ALR + c8);
    float* d = lr + t * 32 + c8;
    d[0] = bflo(u.x); d[1] = bfhi(u.x); d[2] = bflo(u.y); d[3] = bfhi(u.y);
    d[4] = bflo(u.z); d[5] = bfhi(u.z); d[6] = bflo(u.w); d[7] = bfhi(u.w);
    const int dvc = (tid & 3) * 32;
    const u16* vp = p.proj + (size_t)(r0 + t) * INW + C_VA + h * 128 + dvc;
#pragma unroll
    for (int i = 0; i < 4; ++i) {
      const uint4 vv = *(const uint4*)(vp + i * 8);
      u16* dst = vT + (size_t)(dvc + i * 8) * 72 + t;
      dst[0] = (u16)(vv.x & 0xffff); dst[72] = (u16)(vv.x >> 16);
      dst[144] = (u16)(vv.y & 0xffff); dst[216] = (u16)(vv.y >> 16);
      dst[288] = (u16)(vv.z & 0xffff); dst[360] = (u16)(vv.z >> 16);
      dst[432] = (u16)(vv.w & 0xffff); dst[504] = (u16)(vv.w >> 16);
    }
  }
  __syncthreads();
  const int dk = lane, tg = wid;
  const float* w2f = p.in[8] + ((size_t)(l * 2 + 0) * 16) * 256 + h * 64 + dk;
  const float* w2b = p.in[8] + ((size_t)(l * 2 + 1) * 16) * 256 + h * 64 + dk;
  float wf[16], wb[16];
#pragma unroll
  for (int r = 0; r < 16; ++r) { wf[r] = w2f[r * 256]; wb[r] = w2b[r * 256]; }
  const float biasf = p.in[9][(l * 2 + 0) * 256 + h * 64 + dk];
  const float biasb = p.in[9][(l * 2 + 1) * 256 + h * 64 + dk];
  float pf[16], sbk[16];
#pragma unroll
  for (int i = 0; i < 16; ++i) {
    const float* lrow = lr + (tg * 16 + i) * 32;
    float zf = biasf, zb = biasb;
#pragma unroll
    for (int r = 0; r < 16; ++r) { zf += lrow[r] * wf[r]; zb += lrow[16 + r] * wb[r]; }
    pf[i] = logsig16(zf); sbk[i] = logsig16(zb);
  }
#pragma unroll
  for (int i = 1; i < 16; ++i) pf[i] += pf[i - 1];
#pragma unroll
  for (int i = 14; i >= 0; --i) sbk[i] += sbk[i + 1];
  tot[tg * 64 + dk] = pf[15];
  tot[256 + tg * 64 + dk] = sbk[0];
  __syncthreads();
  float offf = 0.f, offb = 0.f, bfl = 0.f, bb0 = 0.f;
#pragma unroll
  for (int g4 = 0; g4 < 4; ++g4) {
    const float a = tot[g4 * 64 + dk], b = tot[256 + g4 * 64 + dk];
    bfl += a; bb0 += b;
    if (g4 < tg) offf += a;
    if (g4 > tg) offb += b;
  }
  u16* gqf = p.gq;
  u16* gkf = p.gq + (size_t)RG * 256;
  u16* gqb = p.gq + (size_t)RG * 512;
  u16* gkb = p.gq + (size_t)RG * 768;
  unsigned kfp[8], kbp[8];
#pragma unroll
  for (int i = 0; i < 16; ++i) {
    const int t = tg * 16 + i;
    const float bfv = offf + pf[i], bbv = offb + sbk[i];
    const float qv = bf2f(p.proj[(size_t)(r0 + t) * INW + C_QA + h * 64 + dk]);
    const float kv = bf2f(p.proj[(size_t)(r0 + t) * INW + C_KA + h * 64 + dk]);
    const size_t go = (size_t)(r0 + t) * 256 + h * 64 + dk;
    gqf[go] = f2bf(qv * __expf(bfv) * 0.125f);
    gkf[go] = f2bf(kv * __expf(-bfv));
    gqb[go] = f2bf(qv * __expf(bbv) * 0.125f);
    gkb[go] = f2bf(kv * __expf(-bbv));
    const u16 ksf = f2bf(kv * __expf(bfl - bfv));
    const u16 ksb = f2bf(kv * __expf(bb0 - bbv));
    if (i & 1) { kfp[i >> 1] |= ((unsigned)ksf) << 16; kbp[i >> 1] |= ((unsigned)ksb) << 16; }
    else { kfp[i >> 1] = ksf; kbp[i >> 1] = ksb; }
  }
  *(uint4*)(kTf + dk * 72 + tg * 16) = make_uint4(kfp[0], kfp[1], kfp[2], kfp[3]);
  *(uint4*)(kTf + dk * 72 + tg * 16 + 8) = make_uint4(kfp[4], kfp[5], kfp[6], kfp[7]);
  *(uint4*)(kTb + dk * 72 + tg * 16) = make_uint4(kbp[0], kbp[1], kbp[2], kbp[3]);
  *(uint4*)(kTb + dk * 72 + tg * 16 + 8) = make_uint4(kbp[4], kbp[5], kbp[6], kbp[7]);
  const size_t cb = ((size_t)(bl * NCHUNK + cidx) * 4 + h) * 2;
  if (tg == 0) {
    p.dec[(cb + 0) * 64 + dk] = __expf(bfl);
    p.dec[(cb + 1) * 64 + dk] = __expf(bb0);
  }
  __syncthreads();
  const int l31 = lane & 31, hh = lane >> 5;
  u16* U = p.h;
#pragma unroll
  for (int dir = 0; dir < 2; ++dir) {
    const u16* kT = dir ? kTb : kTf;
#pragma unroll
    for (int dkt = 0; dkt < 2; ++dkt) {
      f32x16 acc;
#pragma unroll
      for (int e = 0; e < 16; ++e) acc[e] = 0.f;
#pragma unroll
      for (int s = 0; s < 4; ++s) {
        const bf16x8 a = *(const bf16x8*)(vT + (32 * wid + l31) * 72 + 16 * s + 8 * hh);
        const bf16x8 b = *(const bf16x8*)(kT + (32 * dkt + l31) * 72 + 16 * s + 8 * hh);
        acc = __builtin_amdgcn_mfma_f32_32x32x16_bf16(a, b, acc, 0, 0, 0);
      }
      u16* up = U + (cb + dir) * 8192;
#pragma unroll
      for (int e = 0; e < 16; ++e) {
        const int dv = 32 * wid + (e & 3) + 8 * (e >> 2) + 4 * hh;
        up[dv * 64 + 32 * dkt + l31] = f2bf(acc[e]);
      }
    }
  }
}

__device__ void phase_postproj(const Params& p, int l, int* ctr) {
  const int n_prep = NBG * NCHUNK * 4, n_rows = RG / 16;
  run_q8(ctr, QA_CNT(n_prep + n_rows), [&](int q_, int j_) {
    const int it = QA_ID(q_, j_);
    if (it < n_prep) gla_prep(p, l, it);
    else postproj_rows(p, l, it - n_prep);
  });
}

__device__ void gla_scan(const Params& p, int it) {
  const int tid = TIDX;
  const int sl = it & 7, dir = (it >> 3) & 1, h = (it >> 4) & 3, bl = it >> 6;
  const int e0 = sl * 1024 + tid * 4;
  const int dk = e0 & 63;
  const u16* U = p.h;
  float z0 = 0.f;
  asm volatile("" : "+v"(z0));
  f32x4 S = {z0, z0, z0, z0};
  for (int s0 = 0; s0 < NCHUNK; s0 += 12) {
    uint2 u4[12]; f32x4 d4[12];
#pragma unroll
    for (int j = 0; j < 12; ++j) {
      const int step = s0 + j;
      const int cidx = dir ? (NCHUNK - 1 - step) : (step < 4 ? 128 + step : step - 4);
      const size_t base = ((size_t)(bl * NCHUNK + cidx) * 4 + h) * 2 + dir;
      u4[j] = *(const uint2*)(U + base * 8192 + e0);
      d4[j] = *(const f32x4*)(p.dec + base * 64 + dk);
    }
#pragma unroll
    for (int j = 0; j < 12; ++j) {
      const int step = s0 + j;
      const int cidx = dir ? (NCHUNK - 1 - step) : (step < 4 ? 128 + step : step - 4);
      const size_t base = ((size_t)(bl * NCHUNK + cidx) * 4 + h) * 2 + dir;
      uint2 o; o.x = pack2(S[0], S[1]); o.y = pack2(S[2], S[3]);
      st_nt(p.ss + base * 8192 + e0, o);
      S = d4[j] * S + f32x4{bflo(u4[j].x), bfhi(u4[j].x), bflo(u4[j].y), bfhi(u4[j].y)};
    }
  }
}

__device__ void q_tile(const Params& p, int l, int t) {
  const int MT = RG / 128;
  const int nt = t / MT, mt = t % MT;
  f32x4 acc[4][4];
  gemm_core<4>(p.proj + (size_t)mt * 128 * INW + C_CQ, INW, p.wt + (size_t)l * W_LAYER + W_UQ + (size_t)nt * 128 * 256, 256, 256, acc);
  EPI_VARS
  const float QS = 0.10206207261596577f * 1.4426950408889634f;
  int bl, pos0, isctx; rowinfo(mt * 128, NBG, bl, pos0, isctx);
  float rsq[4];
  uint2 qo[4][4];
#pragma unroll
  for (int xi = 0; xi < 4; ++xi) rsq[xi] = p.rstdq[mt * 128 + EPI_TR(xi)] * QS;
#pragma unroll
  for (int xi = 0; xi < 4; ++xi) {
    const int tr = EPI_TR(xi), r = mt * 128 + tr, pos = pos0 + tr;
    const float rs = rsq[xi];
#pragma unroll
    for (int wi = 0; wi < 4; ++wi) {
      const int n16 = (nt * 128 + wc_ * 64 + wi * 16) >> 4;
      const int m6 = n16 % 6;
      float v0 = acc[wi][xi][0] * rs, v1 = acc[wi][xi][1] * rs, v2 = acc[wi][xi][2] * rs, v3 = acc[wi][xi][3] * rs;
      if (m6 >= 4 && !isctx) {
        const float p0 = xor_lane<32>(v0), p1 = xor_lane<32>(v1), p2 = xor_lane<32>(v2), p3 = xor_lane<32>(v3);
        const int pa = (m6 == 5) ? (pos & 63) : (pos >> 6);
        const int f0 = (fq_ & 1) * 4;
        const float* rp = p.rope + (pa * 8 + f0) * 2;
        const float4 cs01 = *(const float4*)rp, cs23 = *(const float4*)(rp + 4);
        const float sg = (fq_ >= 2) ? 1.f : -1.f;
        v0 = v0 * cs01.x + sg * p0 * cs01.y;
        v1 = v1 * cs01.z + sg * p1 * cs01.w;
        v2 = v2 * cs23.x + sg * p2 * cs23.y;
        v3 = v3 * cs23.z + sg * p3 * cs23.w;
      }
      qo[wi][xi].x = pack2(v0, v1); qo[wi][xi].y = pack2(v2, v3);
    }
  }
  store_tile_bf16<4>(qo, p.q + (size_t)(mt * 128 + wr_ * 64) * 768 + nt * 128 + wc_ * 64, 768);
}

__device__ void kv_tile(const Params& p, int l, int t) {
  const int MT = RG / 128;
  const int nt = t / MT, mt = t % MT;
  f32x4 acc[4][4];
  gemm_core<4>(p.proj + (size_t)mt * 128 * INW + C_CKV, INW, p.wt + (size_t)l * W_LAYER + W_UKV + (size_t)nt * 128 * 128, 128, 128, acc);
  EPI_VARS
  int bl, pos0, isctx; rowinfo(mt * 128, NBG, bl, pos0, isctx);
  const int j0 = isctx ? SEQ + pos0 : pos0;
  float rskv[4];
#pragma unroll
  for (int xi = 0; xi < 4; ++xi) rskv[xi] = p.rstdkv[mt * 128 + EPI_TR(xi)];
#pragma unroll
  for (int xi = 0; xi < 4; ++xi) {
    const int tr = EPI_TR(xi), r = mt * 128 + tr, j = j0 + tr;
    const float rs = rskv[xi];
#pragma unroll
    for (int wi = 0; wi < 4; ++wi) {
      const int wn = EPI_NN(wi);
      const float v0 = acc[wi][xi][0] * rs, v1 = acc[wi][xi][1] * rs, v2 = acc[wi][xi][2] * rs, v3 = acc[wi][xi][3] * rs;
      if (wc_ == 0) {
        uint2 o; o.x = pack2(v0, v1); o.y = pack2(v2, v3);
        *(uint2*)(p.kf + ((size_t)(bl * 8 + nt) * NKEY + j) * 96 + wn) = o;
      } else {
        u16* vp = p.vt + ((size_t)(bl * 8 + nt) * 64 + (wn - 64)) * NKEY + j;
        vp[0] = f2bf(v0); vp[NKEY] = f2bf(v1); vp[2 * NKEY] = f2bf(v2); vp[3 * NKEY] = f2bf(v3);
      }
    }
  }
}

__device__ void phase_qkv(const Params& p, int l, int* ctr) {
  const int MT = RG / 128;
  const int n_scan = NBG * 64, n_q = MT * 6, n_kv = MT * 8;
  run_q8(ctr, QA_CNT(n_scan + n_q + n_kv), [&](int q_, int j_) {
    const int it = QA_ID(q_, j_);
    if (it < n_scan) gla_scan(p, it);
    else if (it < n_scan + n_q) q_tile(p, l, it - n_scan);
    else kv_tile(p, l, it - n_scan - n_q);
  });
}

__device__ __forceinline__ bf16x8 pack8(const f32x16& a, int o) {
  union { bf16x8 v; unsigned u[4]; } r;
  r.u[0] = pack2(a[o + 0], a[o + 1]); r.u[1] = pack2(a[o + 2], a[o + 3]);
  r.u[2] = pack2(a[o + 4], a[o + 5]); r.u[3] = pack2(a[o + 6], a[o + 7]);
  return r.v;
}
__device__ __forceinline__ bf16x8 ld2x8(const u16* p0) {
  union { bf16x8 v; uint2 u[2]; } r;
  r.u[0] = *(const uint2*)p0; r.u[1] = *(const uint2*)(p0 + 8);
  return r.v;
}

__device__ void attn_item(const Params& p, int it) {
  const int tid = TIDX, lane = tid & 63, wid = tid >> 6, l31 = lane & 31, hh = lane >> 5;
  const int qb = it % 66, bh = it / 66, h = bh & 7, bl = bh >> 3;
  const int r0 = qb < 64 ? bl * SEQ + qb * 128 : NBG * SEQ + bl * CTXL + (qb - 64) * 128;
  const int kt0 = qb < 64 ? 0 : 128;
  const int nkt = NCHUNK - kt0;
  constexpr int KROW = 208, VROW = 144, BUFB = 64 * KROW + 64 * VROW;
  bf16x8 qf[6];
  {
    const u16* qp = p.q + (size_t)(r0 + 32 * wid + l31) * 768 + h * 96 + 8 * hh;
#pragma unroll
    for (int s = 0; s < 6; ++s) qf[s] = *(const bf16x8*)(qp + 16 * s);
  }
  const u16* kbase = p.kf + (size_t)bh * NKEY * 96;
  const u16* vbase = p.vt + (size_t)bh * 64 * NKEY;
  uint4 kr0, kr1, kr2, vr0, vr1;
  const int kdst0 = (tid / 12) * KROW + (tid % 12) * 16;
  const int kdst1 = ((tid + 256) / 12) * KROW + ((tid + 256) % 12) * 16;
  const int kdst2 = ((tid + 512) / 12) * KROW + ((tid + 512) % 12) * 16;
  const int vdst0 = 64 * KROW + (tid >> 3) * VROW + (tid & 7) * 16;
  const int vdst1 = vdst0 + 32 * VROW;
  const int vsrc0 = (tid >> 3) * NKEY + (tid & 7) * 8;
  const int vsrc1 = vsrc0 + 32 * NKEY;
  {
    const u16* kp = kbase + (size_t)kt0 * 64 * 96 + tid * 8;
    kr0 = *(const uint4*)(kp); kr1 = *(const uint4*)(kp + 2048); kr2 = *(const uint4*)(kp + 4096);
    vr0 = *(const uint4*)(vbase + vsrc0 + kt0 * 64); vr1 = *(const uint4*)(vbase + vsrc1 + kt0 * 64);
    *(uint4*)(smem + kdst0) = kr0; *(uint4*)(smem + kdst1) = kr1; *(uint4*)(smem + kdst2) = kr2;
    *(uint4*)(smem + vdst0) = vr0; *(uint4*)(smem + vdst1) = vr1;
  }
  __builtin_amdgcn_s_waitcnt(0x0F70);
  __syncthreads();
  f32x16 oacc[2];
#pragma unroll
  for (int e = 0; e < 16; ++e) { oacc[0][e] = 0.f; oacc[1][e] = 0.f; }
  float m_run = 0.f, l_run = 0.f;
  for (int t = 0; t < nkt; ++t) {
    const int cur = t & 1;
    {
      const int tn = kt0 + min(t + 1, nkt - 1);
      const u16* kp = kbase + (size_t)tn * 64 * 96 + tid * 8;
      kr0 = *(const uint4*)(kp); kr1 = *(const uint4*)(kp + 2048); kr2 = *(const uint4*)(kp + 4096);
      vr0 = *(const uint4*)(vbase + vsrc0 + tn * 64); vr1 = *(const uint4*)(vbase + vsrc1 + tn * 64);
    }
    __builtin_amdgcn_sched_barrier(0);
    const char* Kl = smem + cur * BUFB;
    const char* Vl = Kl + 64 * KROW;
    f32x16 sacc[2];
#pragma unroll
    for (int kb = 0; kb < 2; ++kb) {
#pragma unroll
      for (int e = 0; e < 16; ++e) sacc[kb][e] = -m_run;
#pragma unroll
      for (int s = 0; s < 6; ++s) {
        const bf16x8 a = *(const bf16x8*)(Kl + (32 * kb + l31) * KROW + 32 * s + 16 * hh);
        sacc[kb] = __builtin_amdgcn_mfma_f32_32x32x16_bf16(a, qf[s], sacc[kb], 0, 0, 0);
      }
    }
    float mx = sacc[0][0];
#pragma unroll
    for (int e = 1; e < 16; ++e) mx = fmaxf(mx, sacc[0][e]);
#pragma unroll
    for (int e = 0; e < 16; ++e) mx = fmaxf(mx, sacc[1][e]);
    {
      const unsigned mu = __float_as_uint(mx);
      const auto sw = __builtin_amdgcn_permlane32_swap(mu, mu, false, false);
      mx = fmaxf(__uint_as_float(sw[0]), __uint_as_float(sw[1]));
    }
    if (t == 0 || !__all(mx <= 8.f)) {
      const float d = (t == 0) ? mx : fmaxf(mx, 0.f);
      const float alpha = __builtin_amdgcn_exp2f(-d);
      m_run += d;
      l_run *= alpha;
#pragma unroll
      for (int e = 0; e < 16; ++e) { oacc[0][e] *= alpha; oacc[1][e] *= alpha; sacc[0][e] -= d; sacc[1][e] -= d; }
    }
    float ps = 0.f;
#pragma unroll
    for (int kb = 0; kb < 2; ++kb)
#pragma unroll
      for (int e = 0; e < 16; ++e) { const float pv = __builtin_amdgcn_exp2f(sacc[kb][e]); sacc[kb][e] = pv; ps += pv; }
    l_run += ps;
#pragma unroll
    for (int kb = 0; kb < 2; ++kb)
#pragma unroll
      for (int s2 = 0; s2 < 2; ++s2) {
        const bf16x8 pfr = pack8(sacc[kb], 8 * s2);
#pragma unroll
        for (int dt = 0; dt < 2; ++dt) {
          const bf16x8 a = ld2x8((const u16*)(Vl + (32 * dt + l31) * VROW) + 32 * kb + 16 * s2 + 4 * hh);
          oacc[dt] = __builtin_amdgcn_mfma_f32_32x32x16_bf16(a, pfr, oacc[dt], 0, 0, 0);
        }
      }
    __builtin_amdgcn_sched_barrier(0);
    {
      char* nb = smem + (cur ^ 1) * BUFB;
      *(uint4*)(nb + kdst0) = kr0; *(uint4*)(nb + kdst1) = kr1; *(uint4*)(nb + kdst2) = kr2;
      *(uint4*)(nb + vdst0) = vr0; *(uint4*)(nb + vdst1) = vr1;
    }
    __syncthreads();
  }
  l_run += xor_lane<32>(l_run);
  const float inv = 1.f / l_run;
  u16* op = p.h + (size_t)RG * 512 + (size_t)(r0 + 32 * wid + l31) * 512 + h * 64;
#pragma unroll
  for (int dt = 0; dt < 2; ++dt)
#pragma unroll
    for (int gq_ = 0; gq_ < 4; ++gq_) {
      const int dv0 = 32 * dt + 8 * gq_ + 4 * hh;
      uint2 o;
      o.x = pack2(oacc[dt][4 * gq_ + 0] * inv, oacc[dt][4 * gq_ + 1] * inv);
      o.y = pack2(oacc[dt][4 * gq_ + 2] * inv, oacc[dt][4 * gq_ + 3] * inv);
      *(uint2*)(op + dv0) = o;
    }
}

__device__ void gla_out(const Params& p, int l, int it) {
  const int tid = TIDX, lane = tid & 63, wid = tid >> 6, l31 = lane & 31, hh = lane >> 5;
  const int bl = it / (NCHUNK * 4), rem = it % (NCHUNK * 4), cidx = rem >> 2, h = rem & 3;
  const int r0 = chunk_row(bl, cidx, NBG);
  u16* tiles = (u16*)smem;
  u16* vT = (u16*)(smem + 36864);
  float* part = (float*)(smem + 55296);
  {
    const int t = tid >> 2, c16 = (tid & 3) * 16;
#pragma unroll
    for (int a = 0; a < 4; ++a) {
      const u16* src = p.gq + (size_t)a * RG * 256 + (size_t)(r0 + t) * 256 + h * 64 + c16;
      const uint4 u0 = *(const uint4*)src, u1 = *(const uint4*)(src + 8);
      u16* d = tiles + a * 4608 + t * 72 + c16;
      *(uint4*)d = u0; *(uint4*)(d + 8) = u1;
    }
    const int dvc = (tid & 3) * 32;
    const u16* vp = p.proj + (size_t)(r0 + t) * INW + C_VA + h * 128 + dvc;
#pragma unroll
    for (int i = 0; i < 4; ++i) {
      const uint4 vv = *(const uint4*)(vp + i * 8);
      u16* dst = vT + (size_t)(dvc + i * 8) * 72 + t;
      dst[0] = (u16)(vv.x & 0xffff); dst[72] = (u16)(vv.x >> 16);
      dst[144] = (u16)(vv.y & 0xffff); dst[216] = (u16)(vv.y >> 16);
      dst[288] = (u16)(vv.z & 0xffff); dst[360] = (u16)(vv.z >> 16);
      dst[432] = (u16)(vv.w & 0xffff); dst[504] = (u16)(vv.w >> 16);
    }
  }
  const int itl = wid & 1, dvh = wid >> 1;
  const size_t cb = ((size_t)(bl * NCHUNK + cidx) * 4 + h) * 2;
  bf16x8 sfr[2][2][4];
#pragma unroll
  for (int dir = 0; dir < 2; ++dir)
#pragma unroll
    for (int dt = 0; dt < 2; ++dt)
#pragma unroll
      for (int s4 = 0; s4 < 4; ++s4)
        sfr[dir][dt][s4] = *(const bf16x8*)(p.ss + (cb + dir) * 8192 + (64 * dvh + 32 * dt + l31) * 64 + 16 * s4 + 8 * hh);
  __syncthreads();
  f32x16 oacc[2];
#pragma unroll
  for (int e = 0; e < 16; ++e) { oacc[0][e] = 0.f; oacc[1][e] = 0.f; }
#pragma unroll
  for (int dir = 0; dir < 2; ++dir) {
    const u16* Qt = tiles + (dir * 2) * 4608;
    const u16* Kt = tiles + (dir * 2 + 1) * 4608;
    bf16x8 qfr[4];
#pragma unroll
    for (int s = 0; s < 4; ++s) qfr[s] = *(const bf16x8*)(Qt + (32 * itl + l31) * 72 + 16 * s + 8 * hh);
    f32x16 aacc[2];
#pragma unroll
    for (int jt = 0; jt < 2; ++jt) {
#pragma unroll
      for (int e = 0; e < 16; ++e) aacc[jt][e] = 0.f;
#pragma unroll
      for (int s = 0; s < 4; ++s) {
        const bf16x8 a = *(const bf16x8*)(Kt + (32 * jt + l31) * 72 + 16 * s + 8 * hh);
        aacc[jt] = __builtin_amdgcn_mfma_f32_32x32x16_bf16(a, qfr[s], aacc[jt], 0, 0, 0);
      }
      const int i_tok = 32 * itl + l31;
#pragma unroll
      for (int e = 0; e < 16; ++e) {
        const int j_tok = 32 * jt + (e & 3) + 8 * (e >> 2) + 4 * hh;
        const bool keep = dir ? (j_tok >= i_tok) : (j_tok <= i_tok);
        if (!keep) aacc[jt][e] = 0.f;
      }
    }
#pragma unroll
    for (int dt = 0; dt < 2; ++dt) {
      const int dvrow = 64 * dvh + 32 * dt + l31;
#pragma unroll
      for (int jt = 0; jt < 2; ++jt)
#pragma unroll
        for (int s2 = 0; s2 < 2; ++s2) {
          const bf16x8 pfr = pack8(aacc[jt], 8 * s2);
          const bf16x8 a = ld2x8(vT + dvrow * 72 + 32 * jt + 16 * s2 + 4 * hh);
          oacc[dt] = __builtin_amdgcn_mfma_f32_32x32x16_bf16(a, pfr, oacc[dt], 0, 0, 0);
        }
#pragma unroll
      for (int s = 0; s < 4; ++s) {
        oacc[dt] = __builtin_amdgcn_mfma_f32_32x32x16_bf16(sfr[dir][dt][s], qfr[s], oacc[dt], 0, 0, 0);
      }
    }
  }
  float ss = 0.f;
#pragma unroll
  for (int e = 0; e < 16; ++e) ss += oacc[0][e] * oacc[0][e] + oacc[1][e] * oacc[1][e];
  ss += xor_lane<32>(ss);
  if (hh == 0) part[wid * 32 + l31] = ss;
  __syncthreads();
  const float totss = part[wid * 32 + l31] + part[(wid ^ 2) * 32 + l31];
  const float rstd = rsqrtf(totss * (1.f / 128.f) + EPS);
  const int r = r0 + 32 * itl + l31;
  const float* gam = p.in[10] + l * 512 + h * 128;
  u16* aa = p.h;
#pragma unroll
  for (int dt = 0; dt < 2; ++dt)
#pragma unroll
    for (int gq_ = 0; gq_ < 4; ++gq_) {
      const int dv0 = 64 * dvh + 32 * dt + 8 * gq_ + 4 * hh;
      const uint2 ra = *(const uint2*)(p.proj + (size_t)r * INW + C_RA + h * 128 + dv0);
      const float4 g4 = *(const float4*)(gam + dv0);
      uint2 o;
      o.x = pack2(oacc[dt][4 * gq_ + 0] * rstd * g4.x * silu_f(bflo(ra.x)), oacc[dt][4 * gq_ + 1] * rstd * g4.y * silu_f(bfhi(ra.x)));
      o.y = pack2(oacc[dt][4 * gq_ + 2] * rstd * g4.z * silu_f(bflo(ra.y)), oacc[dt][4 * gq_ + 3] * rstd * g4.w * silu_f(bfhi(ra.y)));
      *(uint2*)(aa + (size_t)r * 512 + h * 128 + dv0) = o;
    }
}

__device__ void phase_attn(const Params& p, int l, int* ctr) {
  const int nqb = (l == 1) ? 64 : 66, nck = (l == 1) ? 128 : NCHUNK;
  const int per_q = NBG * nqb;
  const int n_gla = NBG * nck * 4;
  run_q8(ctr, [=](int q_) { return per_q + ((n_gla - q_ + 7) >> 3); }, [&](int q_, int j_) {
    if (j_ < per_q) attn_item(p, ((j_ / nqb) * 8 + q_) * 66 + (j_ % nqb));
    else {
      const int gi = QA_ID(q_, j_ - per_q);
      gla_out(p, l, (gi / (nck * 4)) * (NCHUNK * 4) + gi % (nck * 4));
    }
  });
}

__device__ void phase_merge(const Params& p, int l, int* ctr) {
  const int MT = (l == 1 ? NBG * SEQ / 128 : RG / 128), NT = 8;
  const u16* wl = p.wt + (size_t)l * W_LAYER;
  run_q8(ctr, GEMM_CNT(MT, NT), [&](int q_, int j_) {
    int mt, nt; tile_order(j_, mlo(q_ + 1, MT) - mlo(q_, MT), NT, mt, nt); mt += mlo(q_, MT);
    const int tid = TIDX, lane = tid & 63, wid = tid >> 6;
    const int wr = wid >> 1, wc = wid & 1, fr = lane & 15, fq = lane >> 4;
    f32x4 macc[4][4], acc[4][4];
#pragma unroll
    for (int a = 0; a < 4; ++a)
#pragma unroll
      for (int b = 0; b < 4; ++b) { macc[a][b] = f32x4{0.f, 0.f, 0.f, 0.f}; acc[a][b] = f32x4{0.f, 0.f, 0.f, 0.f}; }
    const int srow = tid >> 3, schunk = (tid & 7) ^ ((tid >> 4) & 7);
    const size_t xo = (size_t)(mt * 128 + srow) * 512 + schunk * 8;
    const size_t wo = (size_t)(nt * 128 + srow) * 512 + schunk * 8;
    const u16* xg0 = p.h + xo;
    const u16* xg1 = p.h + (size_t)RG * 512 + xo;
    const u16* xg2 = p.uc + xo;
    const u16* wg0 = wl + W_BRA + wo;
    const u16* wg1 = wl + W_BRB + wo;
    const u16* wg2 = wl + W_BRC + wo;
    const int g = fr >> 1;
    const int lo0 = fr * 128 + ((fq ^ g) << 4), lo1 = fr * 128 + (((fq ^ g) ^ 4) << 4);
    const char* xb = smem + wr * 8192;
    const char* wb = smem + 16384 + wc * 8192;
    char* sdst = smem + tid * 16;
    const u16* gbase = p.proj + (size_t)(mt * 128 + wr * 64 + fr) * INW + C_GATE + nt * 128 + wc * 64 + fq * 4;
    __syncthreads();
#pragma unroll
    for (int i = 0; i < 4; ++i) {
      glds16(xg0 + i * (32 * 512), sdst + i * 4096);
      glds16(wg0 + i * (32 * 512), sdst + 16384 + i * 4096);
    }
    for (int kt = 0; kt < 24; ++kt) {
      asm volatile("s_waitcnt vmcnt(0)" ::: "memory");
      __syncthreads();
      const int cb = (kt & 1) * 32768;
      if (kt + 1 < 24) {
        const int nbr = (kt + 1) >> 3, ko = ((kt + 1) & 7) * 64, nb = 32768 - cb;
        const u16* xg = (nbr == 0 ? xg0 : nbr == 1 ? xg1 : xg2) + ko;
        const u16* wg = (nbr == 0 ? wg0 : nbr == 1 ? wg1 : wg2) + ko;
#pragma unroll
        for (int i = 0; i < 4; ++i) {
          glds16(xg + i * (32 * 512), sdst + nb + i * 4096);
          glds16(wg + i * (32 * 512), sdst + nb + 16384 + i * 4096);
        }
      }
      const bool last = (kt & 7) == 7;
      const int br = kt >> 3;
      uint2 gts[4][4];
      if (last) {
#pragma unroll
        for (int wi = 0; wi < 4; ++wi)
#pragma unroll
          for (int xi = 0; xi < 4; ++xi) gts[wi][xi] = *(const uint2*)(gbase + (size_t)xi * 16 * INW + wi * 16 + br * 1024);
      }
#pragma unroll
      for (int k = 0; k < 2; ++k) {
        const int lo = k ? lo1 : lo0;
        bf16x8 wf[4], xf[4];
#pragma unroll
        for (int i = 0; i < 4; ++i) wf[i] = *(const bf16x8*)(wb + cb + i * 2048 + lo);
#pragma unroll
        for (int i = 0; i < 4; ++i) xf[i] = *(const bf16x8*)(xb + cb + i * 2048 + lo);
#pragma unroll
        for (int wi = 0; wi < 4; ++wi)
#pragma unroll
          for (int xi = 0; xi < 4; ++xi)
            acc[wi][xi] = __builtin_amdgcn_mfma_f32_16x16x32_bf16(wf[wi], xf[xi], acc[wi][xi], 0, 0, 0);
      }
      if (last) {
#pragma unroll
        for (int wi = 0; wi < 4; ++wi)
#pragma unroll
          for (int xi = 0; xi < 4; ++xi) {
            const uint2 gt = gts[wi][xi];
            macc[wi][xi][0] += sigmoid_f(bflo(gt.x)) * acc[wi][xi][0];
            macc[wi][xi][1] += sigmoid_f(bfhi(gt.x)) * acc[wi][xi][1];
            macc[wi][xi][2] += sigmoid_f(bflo(gt.y)) * acc[wi][xi][2];
            macc[wi][xi][3] += sigmoid_f(bfhi(gt.y)) * acc[wi][xi][3];
            acc[wi][xi] = f32x4{0.f, 0.f, 0.f, 0.f};
          }
      }
    }
    uint2 o[4][4];
#pragma unroll
    for (int wi = 0; wi < 4; ++wi)
#pragma unroll
      for (int xi = 0; xi < 4; ++xi) {
        o[wi][xi].x = pack2(macc[wi][xi][0], macc[wi][xi][1]); o[wi][xi].y = pack2(macc[wi][xi][2], macc[wi][xi][3]);
      }
    store_tile_bf16<4>(o, p.m + (size_t)(mt * 128 + wr * 64) * DM + nt * 128 + wc * 64, DM);
  });
}

__device__ void phase_resid(const Params& p, int l, int g, int which, int* ctr) {
  const int MT = (l == 1 ? NBG * SEQ / 128 : RG / 128), NT = 8;
  const u16* wl = p.wt + (size_t)l * W_LAYER;
  const u16* X = which == 0 ? p.m : p.proj + (size_t)RG * DFF;
  const int ldx = which == 0 ? DM : DFF, K = which == 0 ? DM : DFF;
  const u16* W = wl + (which == 0 ? W_O : W_DN);
  const int goff = which == 0 ? 2048 : 5120;
  const int from_input = (which == 0 && l == 0);
  run_q8(ctr, GEMM_CNT(MT, NT), [&](int q_, int j_) {
    int mt, nt; tile_order(j_, mlo(q_ + 1, MT) - mlo(q_, MT), NT, mt, nt); mt += mlo(q_, MT);
    f32x4 acc[4][4];
    gemm_core<4>(X + (size_t)mt * 128 * ldx, ldx, W + (size_t)nt * 128 * K, K, K, acc);
    EPI_VARS
    const float* mrow = p.mod + ((size_t)l * 9 + mod_index(p, g, mt * 128)) * 6144 + goff + nt * 128 + wc_ * 64;
    __syncthreads();
    char* lb = smem + wid_ * 16384;
#pragma unroll
    for (int wi = 0; wi < 4; ++wi)
#pragma unroll
      for (int xi = 0; xi < 4; ++xi) {
        const int r = xi * 16 + fr_, c = wi * 4 + fq_;
        *(f32x4*)(lb + r * 256 + ((c ^ (r & 15)) << 4)) = acc[wi][xi];
      }
    const int c16 = lane_ & 15, rsub = lane_ >> 4;
    const float* xs = xsrc_row_ptr(p, g, mt * 128 + wr_ * 64, from_input) + nt * 128 + wc_ * 64 + c16 * 4;
    float* xd = xrow_ptr(p, g, mt * 128 + wr_ * 64) + nt * 128 + wc_ * 64 + c16 * 4;
    const float4 gv = *(const float4*)(mrow + c16 * 4);
#pragma unroll
    for (int half = 0; half < 2; ++half) {
      float4 xv[8];
#pragma unroll
      for (int it = 0; it < 8; ++it) xv[it] = *(const float4*)(xs + (size_t)((half * 8 + it) * 4 + rsub) * DM);
#pragma unroll
      for (int it = 0; it < 8; ++it) {
        const int row = (half * 8 + it) * 4 + rsub;
        const f32x4 a = *(const f32x4*)(lb + row * 256 + ((c16 ^ (row & 15)) << 4));
        float4 o;
        o.x = xv[it].x + gv.x * a[0]; o.y = xv[it].y + gv.y * a[1]; o.z = xv[it].z + gv.z * a[2]; o.w = xv[it].w + gv.w * a[3];
        *(float4*)(xd + (size_t)row * DM) = o;
      }
    }
  });
}

__device__ void phase_gate(const Params& p, int l, int* ctr) {
  const int MT = (l == 1 ? NBG * SEQ / 128 : RG / 128), NT = 22;
  const u16* W = p.wt + (size_t)l * W_LAYER + W_GU;
  run_q8(ctr, GEMM_CNT(MT, NT), [&](int q_, int j_) {
    int mt, nt; tile_order(j_, mlo(q_ + 1, MT) - mlo(q_, MT), NT, mt, nt); mt += mlo(q_, MT);
    f32x4 acc[4][4];
    gemm_core<4>(p.h + (size_t)mt * 128 * DM, DM, W + (size_t)nt * 128 * DM, DM, DM, acc);
    EPI_VARS
    uint2 o[4][4];
#pragma unroll
    for (int wi = 0; wi < 4; ++wi)
#pragma unroll
      for (int xi = 0; xi < 4; ++xi) {
        o[wi][xi].x = pack2(acc[wi][xi][0], acc[wi][xi][1]); o[wi][xi].y = pack2(acc[wi][xi][2], acc[wi][xi][3]);
      }
    store_tile_bf16<4>(o, p.proj + (size_t)(mt * 128 + wr_ * 64) * DFF + nt * 128 + wc_ * 64, DFF);
  });
}

struct ActIn { uint4 g0, g1, g2, uu; float4 w0a, w0b, w1a, w1b, w2a, w2b, ba, bb; };
__device__ __forceinline__ void act_load(ActIn& a, const u16* G, const u16* UP, const float* cw, const float* cb, int r, int c0) {
  int bl, pos, isctx; rowinfo(r, NBG, bl, pos, isctx);
  const int L = isctx ? CTXL : SEQ;
  const u16* gp = G + (size_t)r * DFF + c0;
  a.g1 = *(const uint4*)gp;
  a.g0 = make_uint4(0, 0, 0, 0); a.g2 = a.g0;
  if (pos > 0) a.g0 = *(const uint4*)(gp - DFF);
  if (pos < L - 1) a.g2 = *(const uint4*)(gp + DFF);
  a.uu = *(const uint4*)(UP + (size_t)r * DFF + c0);
  a.w0a = *(const float4*)(cw + c0); a.w0b = *(const float4*)(cw + c0 + 4);
  a.w1a = *(const float4*)(cw + DFF + c0); a.w1b = *(const float4*)(cw + DFF + c0 + 4);
  a.w2a = *(const float4*)(cw + 2 * DFF + c0); a.w2b = *(const float4*)(cw + 2 * DFF + c0 + 4);
  a.ba = *(const float4*)(cb + c0); a.bb = *(const float4*)(cb + c0 + 4);
}
__device__ __forceinline__ uint4 act_compute(const ActIn& a) {
  uint4 o;
#define ACT2(G0, G1, G2, UU, W0L, W0H, W1L, W1H, W2L, W2H, BL, BH) \
  pack2(silu_f(W0L * bflo(G0) + W1L * bflo(G1) + W2L * bflo(G2) + BL) * bflo(UU), \
        silu_f(W0H * bfhi(G0) + W1H * bfhi(G1) + W2H * bfhi(G2) + BH) * bfhi(UU))
  o.x = ACT2(a.g0.x, a.g1.x, a.g2.x, a.uu.x, a.w0a.x, a.w0a.y, a.w1a.x, a.w1a.y, a.w2a.x, a.w2a.y, a.ba.x, a.ba.y);
  o.y = ACT2(a.g0.y, a.g1.y, a.g2.y, a.uu.y, a.w0a.z, a.w0a.w, a.w1a.z, a.w1a.w, a.w2a.z, a.w2a.w, a.ba.z, a.ba.w);
  o.z = ACT2(a.g0.z, a.g1.z, a.g2.z, a.uu.z, a.w0b.x, a.w0b.y, a.w1b.x, a.w1b.y, a.w2b.x, a.w2b.y, a.bb.x, a.bb.y);
  o.w = ACT2(a.g0.w, a.g1.w, a.g2.w, a.uu.w, a.w0b.z, a.w0b.w, a.w1b.z, a.w1b.w, a.w2b.z, a.w2b.w, a.bb.z, a.bb.w);
#undef ACT2
  return o;
}

__device__ void phase_upact(const Params& p, int l, int* ctr) {
  const int MT = (l == 1 ? NBG * SEQ / 128 : RG / 128), NT = 22;
  const u16* W = p.wt + (size_t)l * W_LAYER + W_GU + (size_t)DFF * 1024;
  const float* cw = p.in[23] + (size_t)l * 3 * DFF;
  const float* cb = p.in[24] + (size_t)l * DFF;
  const u16* G = p.proj;
  u16* ACT = p.proj + (size_t)RG * DFF;
  run_q8(ctr, GEMM_CNT(MT, NT), [&](int q_, int j_) {
    int mt, nt; tile_order(j_, mlo(q_ + 1, MT) - mlo(q_, MT), NT, mt, nt); mt += mlo(q_, MT);
    f32x4 acc[4][4];
    gemm_core<4>(p.h + (size_t)mt * 128 * DM, DM, W + (size_t)nt * 128 * DM, DM, DM, acc);
    EPI_VARS
    char* lb = smem + wid_ * 8192;
#pragma unroll
    for (int wi = 0; wi < 4; ++wi)
#pragma unroll
      for (int xi = 0; xi < 4; ++xi) {
        uint2 o; o.x = pack2(acc[wi][xi][0], acc[wi][xi][1]); o.y = pack2(acc[wi][xi][2], acc[wi][xi][3]);
        const int r = xi * 16 + fr_, c = wi * 2 + (fq_ >> 1);
        *(uint2*)(lb + r * 128 + ((c ^ (r & 7)) << 4) + (fq_ & 1) * 8) = o;
      }
    const int c8 = lane_ & 7, rsub = lane_ >> 3;
    const int n = nt * 128 + wc_ * 64 + c8 * 8;
    const int rowbase = mt * 128 + wr_ * 64;
    int bl, pos0, isctx; rowinfo(rowbase, NBG, bl, pos0, isctx);
    const int L = isctx ? CTXL : SEQ;
    ActIn a;
    a.w0a = *(const float4*)(cw + n); a.w0b = *(const float4*)(cw + n + 4);
    a.w1a = *(const float4*)(cw + DFF + n); a.w1b = *(const float4*)(cw + DFF + n + 4);
    a.w2a = *(const float4*)(cw + 2 * DFF + n); a.w2b = *(const float4*)(cw + 2 * DFF + n + 4);
    a.ba = *(const float4*)(cb + n); a.bb = *(const float4*)(cb + n + 4);
#pragma unroll
    for (int half = 0; half < 2; ++half) {
      uint4 g0[4], g1[4], g2[4];
#pragma unroll
      for (int it = 0; it < 4; ++it) {
        const int row = (half * 4 + it) * 8 + rsub, pos = pos0 + row;
        const u16* gp = G + (size_t)(rowbase + row) * DFF + n;
        g1[it] = *(const uint4*)gp;
        g0[it] = make_uint4(0, 0, 0, 0); g2[it] = g0[it];
        if (pos > 0) g0[it] = *(const uint4*)(gp - DFF);
        if (pos < L - 1) g2[it] = *(const uint4*)(gp + DFF);
      }
#pragma unroll
      for (int it = 0; it < 4; ++it) {
        const int row = (half * 4 + it) * 8 + rsub;
        a.g0 = g0[it]; a.g1 = g1[it]; a.g2 = g2[it];
        a.uu = *(const uint4*)(lb + row * 128 + ((c8 ^ (row & 7)) << 4));
        st_nt(ACT + (size_t)(rowbase + row) * DFF + n, act_compute(a));
      }
    }
  });
}

__device__ void phase_final(const Params& p, int* ctr) {
  const int nitems = NBATCH * SEQ / 16;
  const float* gam = p.in[26];
  for (int it = blockIdx.x; it < nitems; it += gridDim.x) {
    const int lane = TIDX & 63, wid = TIDX >> 6;
    float* xr = p.out + ((size_t)it * 16 + wid * 4) * DM;
    float4 v[4][4], gg[4];
#pragma unroll
    for (int rr = 0; rr < 4; ++rr)
#pragma unroll
      for (int i = 0; i < 4; ++i) v[rr][i] = *(const float4*)(xr + (size_t)rr * DM + lane * 4 + i * 256);
#pragma unroll
    for (int i = 0; i < 4; ++i) gg[i] = *(const float4*)(gam + lane * 4 + i * 256);
#pragma unroll
    for (int rr = 0; rr < 4; ++rr) {
      float ss = 0.f;
#pragma unroll
      for (int i = 0; i < 4; ++i)
        ss += v[rr][i].x * v[rr][i].x + v[rr][i].y * v[rr][i].y + v[rr][i].z * v[rr][i].z + v[rr][i].w * v[rr][i].w;
      ss = wave_sum(ss);
      const float rstd = rsqrtf(ss * (1.f / 1024.f) + EPS);
#pragma unroll
      for (int i = 0; i < 4; ++i) {
        float4 o; o.x = v[rr][i].x * rstd * gg[i].x; o.y = v[rr][i].y * rstd * gg[i].y; o.z = v[rr][i].z * rstd * gg[i].z; o.w = v[rr][i].w * rstd * gg[i].w;
        st_nt(xr + (size_t)rr * DM + lane * 4 + i * 256, o);
      }
    }
  }
}

#define XB_TMO      128
#define XB_XCNT(j)  (256  + 64 * (j))
#define XB_XSUB(j)  (1280 + 64 * (j))
#define XB_XGEN(j)  (2304 + 64 * (j))
#define XB_TOP      3328
#define XB_TOPGEN   3392
#define XCD_BAR_WORDS 3456
#define XB_SPIN_CAP (1u << 22)
#define LAS __attribute__((address_space(3)))
__device__ __forceinline__ unsigned xb_ld(unsigned* p)              { return __hip_atomic_load(p, __ATOMIC_RELAXED, __HIP_MEMORY_SCOPE_AGENT); }
__device__ __forceinline__ unsigned xb_add(unsigned* p, unsigned v) { return __hip_atomic_fetch_add(p, v, __ATOMIC_RELAXED, __HIP_MEMORY_SCOPE_AGENT); }
__device__ __forceinline__ unsigned xb_xcc_id() { return (unsigned)__builtin_amdgcn_s_getreg((3 << 11) | 20) & 0xFu; }
#define XB_SPIN(cond, bar) do { unsigned _sp = 0; while (cond) { __builtin_amdgcn_s_sleep(1); \
    if ((++_sp & 255u) == 0u) { if (xb_ld(&(bar)[XB_TMO])) break; if (_sp > XB_SPIN_CAP) { atomicAdd(&(bar)[XB_TMO], 1u); break; } } } } while (0)
struct XcdBarrier { unsigned* bar; unsigned x; volatile LAS unsigned* st; };
__device__ __forceinline__ XcdBarrier xcd_barrier_post(unsigned* bar, volatile LAS unsigned* st) {
  XcdBarrier b; b.bar = bar; b.x = xb_xcc_id(); b.st = st;
  if (threadIdx.x == 0) (void)xb_add(&bar[XB_XCNT(b.x)], 1u);
  return b;
}
__device__ __forceinline__ void xcd_barrier_complete(unsigned* bar, unsigned x, unsigned& nloc, unsigned& nx) {
  const unsigned G = gridDim.x * gridDim.y * gridDim.z;
  unsigned sum, cnt, mine, sp = 0u;
  for (;;) {
    sum = 0u; cnt = 0u; mine = 0u;
#pragma unroll
    for (unsigned j = 0; j < 16; ++j) { const unsigned c = xb_ld(&bar[XB_XCNT(j)]); sum += c; cnt += (c > 0u) ? 1u : 0u; mine = (j == x) ? c : mine; }
    if (sum == G) break;
    __builtin_amdgcn_s_sleep(1);
    if ((++sp & 255u) == 0u) { if (xb_ld(&bar[XB_TMO])) break; if (sp > XB_SPIN_CAP) { atomicAdd(&bar[XB_TMO], 1u); break; } }
  }
  nloc = mine > 0u ? mine : 1u; nx = cnt > 0u ? cnt : 1u;
}
__device__ __forceinline__ void xcd_barrier(const XcdBarrier& b) {
  asm volatile("s_waitcnt vmcnt(0)" ::: "memory");
  __syncthreads();
  if (threadIdx.x == 0) {
    unsigned* bar = b.bar;
    __builtin_amdgcn_s_waitcnt(0);
    unsigned nloc = b.st[0], nx = b.st[1];
    if (nloc == 0u) { xcd_barrier_complete(bar, b.x, nloc, nx); b.st[0] = nloc; b.st[1] = nx; }
    const unsigned old = xb_add(&bar[XB_XSUB(b.x)], 1u);
    const unsigned gen = old / nloc;
    if (old + 1u == (gen + 1u) * nloc) {
      __builtin_amdgcn_fence(__ATOMIC_RELEASE, "agent");
      asm volatile("s_waitcnt vmcnt(0)" ::: "memory");
      const unsigned og = xb_add(&bar[XB_TOP], 1u);
      const unsigned tg = og / nx;
      if (og + 1u == (tg + 1u) * nx) xb_add(&bar[XB_TOPGEN], 1u);
      else XB_SPIN(xb_ld(&bar[XB_TOPGEN]) == tg, bar);
      __builtin_amdgcn_fence(__ATOMIC_ACQUIRE, "agent");
      xb_add(&bar[XB_XGEN(b.x)], 1u);
      asm volatile("s_waitcnt vmcnt(0)" ::: "memory");
    } else {
      XB_SPIN(xb_ld(&bar[XB_XGEN(b.x)]) == gen, bar);
      __builtin_amdgcn_fence(__ATOMIC_ACQUIRE, "agent");
      asm volatile("s_waitcnt vmcnt(0)" ::: "memory");
    }
  }
  __syncthreads();
}

__device__ void run_phase(const Params& p, int ph, int* ctr) {
  if (ph == 0) { phase0(p, ctr); return; }
  if (ph == NPHASES - 1) { phase_final(p, ctr); return; }
  const int idx = ph - 1, lg = idx / NPH_PER, sub = idx % NPH_PER;
  const int g = lg / 2, l = lg % 2;
  switch (sub) {
    case 0: phase_norm(p, l, g, 0, ctr); break;
    case 1: phase_proj(p, l, ctr, lg == 0); break;
    case 2: phase_postproj(p, l, ctr); break;
    case 3: phase_qkv(p, l, ctr); break;
    case 4: phase_attn(p, l, ctr); break;
    case 5: phase_merge(p, l, ctr); break;
    case 6: phase_resid(p, l, g, 0, ctr); break;
    case 7: phase_norm(p, l, g, 1, ctr); break;
    case 8: phase_gate(p, l, ctr); break;
    case 9: phase_upact(p, l, ctr); break;
    default: phase_resid(p, l, g, 1, ctr); break;
  }
}

__global__ void __launch_bounds__(256, 2) mega_kernel(KArgs ka, int ph_lo, int ph_hi, int coop) {
  Params p;
#pragma unroll
  for (int i = 0; i < 27; ++i) p.in[i] = ka.in[i];
  p.out = ka.out;
  char* ws = ka.ws;
  p.ctr = (int*)(ws + O_CTR); p.mod = (float*)(ws + O_MOD); p.rope = (float*)(ws + O_ROPE); p.xc = (float*)(ws + O_XC);
  p.rstdq = (float*)(ws + O_RSQ); p.rstdkv = (float*)(ws + O_RSKV); p.dec = (float*)(ws + O_DEC); p.wt = (u16*)(ws + O_WT);
  p.proj = (u16*)(ws + O_PROJ); p.h = (u16*)(ws + O_H); p.m = (u16*)(ws + O_M); p.q = (u16*)(ws + O_Q);
  p.kf = (u16*)(ws + O_KF); p.vt = (u16*)(ws + O_VT); p.uc = (u16*)(ws + O_UC); p.gq = (u16*)(ws + O_GQ);
  p.ss = (u16*)(ws + O_SS);
  volatile LAS unsigned* st = (volatile LAS unsigned*)(smem + SLOT_OFF + 64);
  if (threadIdx.x == 0) { st[0] = 0u; st[1] = 0u; }
  __syncthreads();
  XcdBarrier xb;
  xb.bar = (unsigned*)(ws + O_BAR); xb.x = 0; xb.st = st;
  if (coop) xb = xcd_barrier_post((unsigned*)(ws + O_BAR), st);
  for (int ph = ph_lo; ph < ph_hi; ++ph) {
#ifdef PROBE_MASK
    const int nrep = (ph > 0 && ph < NPHASES - 1 && ((PROBE_MASK >> ((ph - 1) % NPH_PER)) & 1)) ? 2 : 1;
#else
    const int nrep = 1;
#endif
    for (int rep = 0; rep < nrep; ++rep) {
      if (rep) xcd_barrier(xb);
      run_phase(p, ph, p.ctr + rep * 512 + ph * 8);
    }
    if (coop && ph + 1 < ph_hi) {
      if (ph == ph_lo) cg::this_grid().sync();
      else xcd_barrier(xb);
    }
  }
}

static inline size_t align_up(size_t v) { return (v + 255) & ~(size_t)255; }

extern "C" void kernel_launch(void* const* d_in, const int* in_sizes, int n_in, void* d_out, int out_size,
                              void* d_ws, size_t ws_size, hipStream_t stream) {
  static int grid_blocks = 0;
  if (!grid_blocks) {
    int dev = 0, cus = 0, per_cu = 0;
    hipGetDevice(&dev);
    hipDeviceGetAttribute(&cus, hipDeviceAttributeMultiprocessorCount, dev);
    hipFuncSetAttribute((const void*)mega_kernel, hipFuncAttributeMaxDynamicSharedMemorySize, LDS_BYTES);
    hipOccupancyMaxActiveBlocksPerMultiprocessor(&per_cu, (const void*)mega_kernel, 256, LDS_BYTES);
    if (per_cu < 1) per_cu = 1;
    if (per_cu > 2) per_cu = 2;
    grid_blocks = cus * per_cu;
  }
  KArgs p{};
  for (int i = 0; i < 27; ++i) p.in[i] = (const float*)d_in[i];
  p.out = (float*)d_out;
  p.ws = (char*)d_ws;
  if (ws_size < WS_END) { fprintf(stderr, "workspace too small: %zu < %zu\n", ws_size, (size_t)WS_END); return; }
  hipMemsetAsync((char*)d_ws + O_CTR, 0, 4096 + XCD_BAR_BYTES, stream);
#if SINGLE_LAUNCH
  int lo = 0, hi = NPHASES, coop = 1;
  void* args[] = {&p, &lo, &hi, &coop};
  hipError_t e = hipLaunchCooperativeKernel((const void*)mega_kernel, dim3(grid_blocks), dim3(256), args, LDS_BYTES, stream);
  if (e != hipSuccess) fprintf(stderr, "cooperative launch failed: %s (grid %d)\n", hipGetErrorString(e), grid_blocks);
#else
  for (int ph = 0; ph < NPHASES; ++ph)
    hipLaunchKernelGGL(mega_kernel, dim3(grid_blocks), dim3(256), LDS_BYTES, stream, p, ph, ph + 1, 0);
#endif
}
```

```cpp
#include <hip/hip_runtime.h>
#include <hip/hip_cooperative_groups.h>
#include <cstdio>
#include <cstdint>
namespace cg = cooperative_groups;

typedef unsigned short u16;
typedef __attribute__((ext_vector_type(8))) short bf16x8;
typedef __attribute__((ext_vector_type(4))) float f32x4;
typedef __attribute__((ext_vector_type(16))) float f32x16;

#ifndef SINGLE_LAUNCH
#define SINGLE_LAUNCH 1
#endif

constexpr int DM = 1024, SEQ = 8192, CTXL = 256, NBATCH = 8, INW = 6592, INWP = 6656, DFF = 2816;
constexpr int C_QA = 0, C_KA = 256, C_VA = 512, C_RA = 1024, C_ALR = 1536, C_CQ = 1568, C_CKV = 1824,
              C_KR = 1952, C_SB = 1984, C_SC = 2496, C_SX = 3008, C_GATE = 3520;
constexpr int NKEY = SEQ + CTXL;
constexpr int NCHUNK = NKEY / 64;
constexpr float EPS = 1e-6f;
constexpr int LDS_BYTES = 65536 + 256;
constexpr int SLOT_OFF = 65536;
constexpr int NPH_PER = 11;
constexpr int NBG = 4;
constexpr int NGRP = NBATCH / NBG;
constexpr int RG = NBG * (SEQ + CTXL);
constexpr int NPHASES = 1 + 2 * NGRP * NPH_PER + 1;

constexpr size_t W_IN = 0;
constexpr size_t W_UQ = W_IN + (size_t)INWP * 1024;
constexpr size_t W_UKV = W_UQ + 768 * 256;
constexpr size_t W_BRA = W_UKV + 1024 * 128;
constexpr size_t W_BRB = W_BRA + 1024 * 512;
constexpr size_t W_BRC = W_BRB + 1024 * 512;
constexpr size_t W_O = W_BRC + 1024 * 512;
constexpr size_t W_GU = W_O + 1024 * 1024;
constexpr size_t W_DN = W_GU + (size_t)5632 * 1024;
constexpr size_t W_LAYER = W_DN + (size_t)1024 * 2816;

struct KArgs {
  const float* in[27];
  float* out;
  char* ws;
};
struct Params {
  const float* in[27];
  float* out;
  float* xc;
  u16* wt;
  float* mod;
  float* rope;
  int* ctr;
  float* rstdq;
  float* rstdkv;
  float* dec;
  u16* proj;
  u16* h;
  u16* m;
  u16* q;
  u16* kf;
  u16* vt;
  u16* uc;
  u16* gq;
  u16* ss;
};
constexpr size_t al256(size_t v) { return (v + 255) & ~(size_t)255; }
constexpr size_t XCD_BAR_BYTES = 3456 * 4;
constexpr size_t O_CTR = 0;
constexpr size_t O_BAR = O_CTR + 4096;
constexpr size_t O_MOD = al256(O_BAR + XCD_BAR_BYTES);
constexpr size_t O_ROPE = al256(O_MOD + (size_t)2 * 9 * 6144 * 4);
constexpr size_t O_XC = al256(O_ROPE + 1024 * 2 * 4);
constexpr size_t O_RSQ = al256(O_XC + (size_t)NBATCH * CTXL * DM * 4);
constexpr size_t O_RSKV = al256(O_RSQ + (size_t)RG * 4);
constexpr size_t O_DEC = al256(O_RSKV + (size_t)RG * 4);
constexpr size_t O_WT = al256(O_DEC + (size_t)NBG * NCHUNK * 4 * 2 * 64 * 4);
constexpr size_t O_PROJ = al256(O_WT + 2 * W_LAYER * 2);
constexpr size_t O_H = al256(O_PROJ + (size_t)RG * INW * 2);
constexpr size_t O_M = O_H + (size_t)RG * DM * 2;
constexpr size_t O_Q = al256(O_M + (size_t)RG * DM * 2);
constexpr size_t O_KF = al256(O_Q + (size_t)RG * 768 * 2);
constexpr size_t O_VT = al256(O_KF + (size_t)NBG * 8 * NKEY * 96 * 2);
constexpr size_t O_UC = al256(O_VT + (size_t)NBG * 8 * 64 * NKEY * 2);
constexpr size_t O_GQ = al256(O_UC + (size_t)RG * 512 * 2);
constexpr size_t O_SS = al256(O_GQ + (size_t)RG * 1024 * 2);
constexpr size_t WS_END = al256(O_SS + (size_t)NBG * NCHUNK * 4 * 2 * 8192 * 2);
static_assert(WS_END <= ((size_t)1 << 30), "workspace layout must fit 1 GiB");

extern __shared__ __attribute__((aligned(16))) char smem[];

typedef __bf16 hbf2 __attribute__((ext_vector_type(2)));
typedef float hf2 __attribute__((ext_vector_type(2)));
__device__ __forceinline__ unsigned pack2(float a, float b) {
  hf2 v = {a, b};
  return __builtin_bit_cast(unsigned, __builtin_convertvector(v, hbf2));
}
__device__ __forceinline__ u16 f2bf(float f) { return (u16)(pack2(f, 0.f) & 0xffffu); }
__device__ __forceinline__ float bf2f(u16 h) { return __uint_as_float(((unsigned)h) << 16); }
__device__ __forceinline__ float bflo(unsigned u) { return __uint_as_float(u << 16); }
__device__ __forceinline__ float bfhi(unsigned u) { return __uint_as_float(u & 0xffff0000u); }
typedef unsigned nt_u32x4 __attribute__((ext_vector_type(4)));
typedef unsigned nt_u32x2 __attribute__((ext_vector_type(2)));
__device__ __forceinline__ void st_nt(void* p, uint4 v) { nt_u32x4 t = {v.x, v.y, v.z, v.w}; __builtin_nontemporal_store(t, (nt_u32x4*)p); }
__device__ __forceinline__ void st_nt(void* p, uint2 v) { nt_u32x2 t = {v.x, v.y}; __builtin_nontemporal_store(t, (nt_u32x2*)p); }
__device__ __forceinline__ void st_nt(void* p, float4 v) { f32x4 t = {v.x, v.y, v.z, v.w}; __builtin_nontemporal_store(t, (f32x4*)p); }
__device__ __forceinline__ float silu_f(float x) { return x / (1.f + __expf(-x)); }
__device__ __forceinline__ float sigmoid_f(float x) { return 1.f / (1.f + __expf(-x)); }

__device__ __forceinline__ void rowinfo(int r, int NB, int& bl, int& pos, int& isctx) {
  const int nl = NB * SEQ;
  if (r < nl) { bl = r >> 13; pos = r & (SEQ - 1); isctx = 0; }
  else { const int rc = r - nl; bl = rc >> 8; pos = rc & (CTXL - 1); isctx = 1; }
}
__device__ __forceinline__ int chunk_row(int bl, int cidx, int NB) {
  return cidx < 128 ? bl * SEQ + cidx * 64 : NB * SEQ + bl * CTXL + (cidx - 128) * 64;
}

template <class CntF, class BodyF>
__device__ __forceinline__ void run_q8(int* ctr8, CntF cntf, BodyF body) {
  volatile int* slot = (volatile int*)(smem + SLOT_OFF);
  int q = blockIdx.x & 7, tries = 0, item;
  __syncthreads();
  if (threadIdx.x == 0) {
    int v = atomicAdd(&ctr8[q], 1);
    while (v >= cntf(q) && tries < 8) { q = (q + 1) & 7; ++tries; if (tries < 8) v = atomicAdd(&ctr8[q], 1); }
    slot[0] = (tries < 8) ? v : -1; slot[1] = q; slot[2] = tries;
  }
  __syncthreads();
  item = slot[0]; q = slot[1]; tries = slot[2];
  while (item >= 0) {
    int nxt = 0;
    if (threadIdx.x == 0) nxt = atomicAdd(&ctr8[q], 1);
    body(q, item);
    __syncthreads();
    if (threadIdx.x == 0) {
      int qq = q, t = tries;
      while (nxt >= cntf(qq) && t < 8) { qq = (qq + 1) & 7; ++t; if (t < 8) nxt = atomicAdd(&ctr8[qq], 1); }
      slot[0] = (t < 8) ? nxt : -1; slot[1] = qq; slot[2] = t;
    }
    __syncthreads();
    item = slot[0]; q = slot[1]; tries = slot[2];
  }
}
#define QA_CNT(N) [=](int q_) { return ((N) - q_ + 7) >> 3; }
#define QA_ID(q_, j_) ((j_) * 8 + (q_))

__device__ __forceinline__ int opaque_tid() {
  int t = threadIdx.x;
  asm volatile("" : "+v"(t));
  return t;
}
#define TIDX opaque_tid()
template <int M>
__device__ __forceinline__ float xor_lane(float v) {
  if constexpr (M == 32) {
    const unsigned u = __float_as_uint(v);
    const auto sw = __builtin_amdgcn_permlane32_swap(u, u, false, false);
    return __uint_as_float(sw[0] ^ sw[1] ^ u);
  } else {
    return __uint_as_float((unsigned)__builtin_amdgcn_ds_swizzle((int)__float_as_uint(v), 0x1f | (M << 10)));
  }
}
__device__ __forceinline__ float wave_sum(float v) {
  v += xor_lane<32>(v); v += xor_lane<16>(v); v += xor_lane<8>(v);
  v += xor_lane<4>(v); v += xor_lane<2>(v); v += xor_lane<1>(v);
  return v;
}

__device__ __forceinline__ int lds_byte(int r, int c) {
  const int st = (r >> 4) * 2 + (c >> 5), rr = r & 15, cc = c & 31, ob = rr * 64 + cc * 2;
  return st * 1024 + (ob ^ (((ob >> 9) & 1) << 5));
}
__device__ __forceinline__ void stage_rc(int b, int& R, int& C) {
  const int st = b >> 10, sb = b & 1023, swz = sb ^ (((sb >> 9) & 1) << 5);
  R = (st >> 1) * 16 + (swz >> 6); C = (st & 1) * 32 + ((swz & 63) >> 1);
}

__device__ __forceinline__ void glds16(const void* g, void* l) {
  __builtin_amdgcn_global_load_lds((const __attribute__((address_space(1))) unsigned*)g,
                                   (__attribute__((address_space(3))) unsigned*)l, 16, 0, 0);
}

template <int NWI>
__device__ __forceinline__ void gemm_core(const u16* __restrict__ X, int ldx, const u16* __restrict__ W, int ldw,
                                          int K, f32x4 (&acc)[NWI][4]) {
  const int tid = TIDX, lane = tid & 63, wid = tid >> 6;
  const int wr = wid >> 1, wc = wid & 1, fr = lane & 15, fq = lane >> 4;
#pragma unroll
  for (int a = 0; a < NWI; ++a)
#pragma unroll
    for (int b = 0; b < 4; ++b) acc[a][b] = f32x4{0.f, 0.f, 0.f, 0.f};
  const int srow = tid >> 3, schunk = (tid & 7) ^ ((tid >> 4) & 7);
  const u16* xg = X + (size_t)srow * ldx + schunk * 8;
  const u16* wg = W + (size_t)srow * ldw + schunk * 8;
  const int xs = 32 * ldx, ws_ = 32 * ldw;
  const int g = fr >> 1;
  const int lo0 = fr * 128 + ((fq ^ g) << 4), lo1 = fr * 128 + (((fq ^ g) ^ 4) << 4);
  const char* xb = smem + wr * 8192;
  const char* wb = smem + 16384 + wc * (NWI * 2048);
  char* sdst = smem + tid * 16;
  const int nt = K >> 6;
  __syncthreads();
#pragma unroll
  for (int i = 0; i < 4; ++i) {
    glds16(xg + i * xs, sdst + i * 4096);
    if (i < NWI) glds16(wg + i * ws_, sdst + 16384 + i * 4096);
  }
  for (int kt = 0; kt < nt; ++kt) {
    asm volatile("s_waitcnt vmcnt(0)" ::: "memory");
    __syncthreads();
    const int cb = (kt & 1) * 32768;
    if (kt + 1 < nt) {
      const int nb = 32768 - cb;
      const int ko = (kt + 1) * 64;
#pragma unroll
      for (int i = 0; i < 4; ++i) {
        glds16(xg + i * xs + ko, sdst + nb + i * 4096);
        if (i < NWI) glds16(wg + i * ws_ + ko, sdst + nb + 16384 + i * 4096);
      }
    }
    bf16x8 wf[2][NWI], xf[2][4];
#pragma unroll
    for (int i = 0; i < NWI; ++i) {
      wf[0][i] = *(const bf16x8*)(wb + cb + i * 2048 + lo0);
      wf[1][i] = *(const bf16x8*)(wb + cb + i * 2048 + lo1);
    }
#pragma unroll
    for (int i = 0; i < 4; ++i) {
      xf[0][i] = *(const bf16x8*)(xb + cb + i * 2048 + lo0);
      xf[1][i] = *(const bf16x8*)(xb + cb + i * 2048 + lo1);
    }
    __builtin_amdgcn_sched_barrier(0);
#pragma unroll
    for (int k = 0; k < 2; ++k)
#pragma unroll
      for (int wi = 0; wi < NWI; ++wi)
#pragma unroll
        for (int xi = 0; xi < 4; ++xi)
          acc[wi][xi] = __builtin_amdgcn_mfma_f32_16x16x32_bf16(wf[k][wi], xf[k][xi], acc[wi][xi], 0, 0, 0);
    __builtin_amdgcn_sched_barrier(0);
  }
}

#define EPI_VARS const int tid_ = TIDX, lane_ = tid_ & 63, wid_ = tid_ >> 6; \
  const int wr_ = wid_ >> 1, wc_ = wid_ & 1, fr_ = lane_ & 15, fq_ = lane_ >> 4; (void)fq_; (void)fr_; (void)wr_; (void)wc_;
#define EPI_TR(xi) (wr_ * 64 + (xi) * 16 + fr_)
#define EPI_NN(wi) (wc_ * 64 + (wi) * 16 + fq_ * 4)

template <int NWI>
__device__ __forceinline__ void store_tile_bf16(const uint2 (&o)[NWI][4], u16* dst_wave, size_t ld) {
  constexpr int RB = NWI * 32, CPR = RB / 16;
  const int tid = TIDX, lane = tid & 63, wid = tid >> 6, fr = lane & 15, fq = lane >> 4;
  char* lb = smem + wid * 8192;
#pragma unroll
  for (int wi = 0; wi < NWI; ++wi)
#pragma unroll
    for (int xi = 0; xi < 4; ++xi) {
      const int r = xi * 16 + fr, c = wi * 2 + (fq >> 1);
      *(uint2*)(lb + r * RB + ((c ^ (r & (CPR - 1))) << 4) + (fq & 1) * 8) = o[wi][xi];
    }
#pragma unroll
  for (int it = 0; it < CPR; ++it) {
    const int idx = it * 64 + lane, row = idx / CPR, c = idx % CPR;
    typedef unsigned u32x4_t __attribute__((ext_vector_type(4)));
    const u32x4_t v = *(const u32x4_t*)(lb + row * RB + ((c ^ (row & (CPR - 1))) << 4));
    __builtin_nontemporal_store(v, (u32x4_t*)(dst_wave + (size_t)row * ld + c * 8));
  }
}

__device__ __forceinline__ void tile_order(int t, int MT, int NT, int& mt, int& nt) {
  constexpr int GM = 4;
  const int band = t / (GM * NT), rem = t - band * GM * NT;
  const int m0 = band * GM;
  const int gsz = min(GM, MT - m0);
  nt = rem / gsz; mt = m0 + rem - nt * gsz;
}

__device__ __forceinline__ int mlo(int q, int MT) { return (q * MT) >> 3; }
#define GEMM_CNT(MT, NT) [=](int q_) { return (mlo(q_ + 1, MT) - mlo(q_, MT)) * (NT); }

__device__ __forceinline__ float* xrow_ptr(const Params& p, int g, int r) {
  int bl, pos, isctx; rowinfo(r, NBG, bl, pos, isctx);
  const int b = g * NBG + bl;
  return isctx ? p.xc + ((size_t)b * CTXL + pos) * DM : p.out + ((size_t)b * SEQ + pos) * DM;
}
__device__ __forceinline__ const float* xsrc_row_ptr(const Params& p, int g, int r, int from_input) {
  int bl, pos, isctx; rowinfo(r, NBG, bl, pos, isctx);
  const int b = g * NBG + bl;
  if (from_input) return isctx ? p.in[2] + ((size_t)b * CTXL + pos) * DM : p.in[0] + ((size_t)b * SEQ + pos) * DM;
  return isctx ? p.xc + ((size_t)b * CTXL + pos) * DM : p.out + ((size_t)b * SEQ + pos) * DM;
}
__device__ __forceinline__ int mod_index(const Params& p, int g, int r) {
  int bl, pos, isctx; rowinfo(r, NBG, bl, pos, isctx);
  return isctx ? 8 : g * NBG + bl;
}

__device__ void conv_tile4(const float* __restrict__ src, int K, int N, u16* __restrict__ dst,
                           const float* __restrict__ scale, int ktile, int ngrp) {
  float* tile = (float*)smem;
  const int tid = TIDX;
  const int k0 = ktile * 64;
  const int kk = tid >> 4, n4 = (tid & 15) * 4;
  float4 v[4][4];
  float sc[4];
#pragma unroll
  for (int i = 0; i < 4; ++i) sc[i] = scale ? scale[k0 + kk + 16 * i] : 1.f;
#pragma unroll
  for (int t = 0; t < 4; ++t) {
    const int n0 = (ngrp * 4 + t) * 64;
#pragma unroll
    for (int i = 0; i < 4; ++i) {
      v[t][i] = make_float4(0.f, 0.f, 0.f, 0.f);
      if (n0 < N) v[t][i] = *(const float4*)(src + (size_t)(k0 + kk + 16 * i) * N + n0 + n4);
    }
  }
  const int nn = tid >> 3, k8 = (tid & 7) * 8;
#pragma unroll
  for (int t = 0; t < 4; ++t) {
    const int n0 = (ngrp * 4 + t) * 64;
    __syncthreads();
#pragma unroll
    for (int i = 0; i < 4; ++i) {
      const int k = kk + 16 * i;
      tile[k * 65 + n4 + 0] = v[t][i].x * sc[i]; tile[k * 65 + n4 + 1] = v[t][i].y * sc[i];
      tile[k * 65 + n4 + 2] = v[t][i].z * sc[i]; tile[k * 65 + n4 + 3] = v[t][i].w * sc[i];
    }
    __syncthreads();
#pragma unroll
    for (int i = 0; i < 2; ++i) {
      const int n = nn + 32 * i;
      uint4 o;
      o.x = pack2(tile[(k8 + 0) * 65 + n], tile[(k8 + 1) * 65 + n]);
      o.y = pack2(tile[(k8 + 2) * 65 + n], tile[(k8 + 3) * 65 + n]);
      o.z = pack2(tile[(k8 + 4) * 65 + n], tile[(k8 + 5) * 65 + n]);
      o.w = pack2(tile[(k8 + 6) * 65 + n], tile[(k8 + 7) * 65 + n]);
      *(uint4*)(dst + (size_t)(n0 + n) * K + k0 + k8) = o;
    }
  }
}

__device__ __forceinline__ void sincos_f(float a, float& s, float& c) {
  const float k = rintf(a * 0.63661977236758134f);
  float r = fmaf(-k, 1.5707963705062866f, a);
  r = fmaf(-k, -4.371138828673793e-08f, r);
  const int q = ((int)k) & 3;
  const float r2 = r * r;
  const float sp = r * (1.0f + r2 * (-1.6666667e-1f + r2 * (8.3333333e-3f + r2 * (-1.9841270e-4f + r2 * 2.7557319e-6f))));
  const float cp = 1.0f + r2 * (-0.5f + r2 * (4.1666667e-2f + r2 * (-1.3888889e-3f + r2 * (2.4801587e-5f + r2 * -2.7557319e-7f))));
  s = (q == 0) ? sp : (q == 1) ? cp : (q == 2) ? -sp : -cp;
  c = (q == 0) ? cp : (q == 1) ? -sp : (q == 2) ? -cp : sp;
}

constexpr int CV_WIN = 0, CV_UQ = 416, CV_UKV = 428, CV_BRA = 436, CV_BRB = 468, CV_BRC = 500,
              CV_WO = 532, CV_GATE = 596, CV_UP = 772, CV_DN = 948, CV_LAYER = 1124;
constexpr int P0_CONV = 2 * CV_LAYER, P0_ADA = 2 * 192, P0_TOTAL = P0_CONV + P0_ADA + 1;

__device__ __forceinline__ void conv_item(const Params& p, int ci) {
  const int l = ci / CV_LAYER, j = ci % CV_LAYER;
  u16* wl = p.wt + (size_t)l * W_LAYER;
  if (j < CV_UQ)       { const int jj = j - CV_WIN;  conv_tile4(p.in[7] + (size_t)l * 1024 * INW, 1024, INW, wl + W_IN, nullptr, jj / 26, jj % 26); }
  else if (j < CV_UKV) { const int jj = j - CV_UQ;   conv_tile4(p.in[12] + (size_t)l * 256 * 768, 256, 768, wl + W_UQ, p.in[11] + l * 256, jj / 3, jj % 3); }
  else if (j < CV_BRA) { const int jj = j - CV_UKV;  conv_tile4(p.in[14] + (size_t)l * 128 * 1024, 128, 1024, wl + W_UKV, p.in[13] + l * 128, jj / 4, jj % 4); }
  else if (j < CV_BRB) { const int jj = j - CV_BRA;  conv_tile4(p.in[16] + (size_t)l * 512 * 1024, 512, 1024, wl + W_BRA, nullptr, jj / 4, jj % 4); }
  else if (j < CV_BRC) { const int jj = j - CV_BRB;  conv_tile4(p.in[17] + (size_t)l * 512 * 1024, 512, 1024, wl + W_BRB, nullptr, jj / 4, jj % 4); }
  else if (j < CV_WO)  { const int jj = j - CV_BRC;  conv_tile4(p.in[18] + (size_t)l * 512 * 1024, 512, 1024, wl + W_BRC, nullptr, jj / 4, jj % 4); }
  else if (j < CV_GATE){ const int jj = j - CV_WO;   conv_tile4(p.in[19] + (size_t)l * 1024 * 1024, 1024, 1024, wl + W_O, nullptr, jj / 4, jj % 4); }
  else if (j < CV_UP)  { const int jj = j - CV_GATE; conv_tile4(p.in[21] + (size_t)l * 1024 * DFF, 1024, DFF, wl + W_GU, nullptr, jj / 11, jj % 11); }
  else if (j < CV_DN)  { const int jj = j - CV_UP;   conv_tile4(p.in[22] + (size_t)l * 1024 * DFF, 1024, DFF, wl + W_GU + (size_t)DFF * 1024, nullptr, jj / 11, jj % 11); }
  else                 { const int jj = j - CV_DN;   conv_tile4(p.in[25] + (size_t)l * DFF * 1024, DFF, 1024, wl + W_DN, nullptr, jj / 4, jj % 4); }
}
constexpr int P0_EARLY = CV_UQ;
constexpr int P0_DEFER = P0_CONV - P0_EARLY;

__device__ void phase0(const Params& p, int* ctr) {
  run_q8(ctr, QA_CNT(P0_ADA + 1 + P0_EARLY), [&](int q_, int j_) {
    const int it = QA_ID(q_, j_);
    const int tid = TIDX;
    if (it >= P0_ADA + 1) {
      conv_item(p, it - (P0_ADA + 1));
    } else if (it < P0_ADA) {
      const int a = it, l = a / 192, cg_ = a % 192;
      float* sc = (float*)smem;
      float* red = sc + 9 * 1024;
      for (int e = tid; e < 9 * 1024; e += 256) {
        const int v = e >> 10, k = e & 1023;
        const float cv = (v < 8) ? p.in[1][v * 1024 + k] : p.in[3][k];
        sc[e] = cv / (1.f + expf(-cv));
      }
      __syncthreads();
      const int kg = tid >> 5, cn = tid & 31;
      const float* wa = p.in[4] + (size_t)l * 1024 * 6144 + cg_ * 32 + cn;
      float a0 = 0, a1 = 0, a2 = 0, a3 = 0, a4 = 0, a5 = 0, a6 = 0, a7 = 0, a8 = 0;
#pragma unroll 8
      for (int i = 0; i < 128; ++i) {
        const int k = kg + 8 * i;
        const float w = wa[(size_t)k * 6144];
        a0 += sc[k] * w; a1 += sc[1024 + k] * w; a2 += sc[2048 + k] * w; a3 += sc[3072 + k] * w;
        a4 += sc[4096 + k] * w; a5 += sc[5120 + k] * w; a6 += sc[6144 + k] * w; a7 += sc[7168 + k] * w;
        a8 += sc[8192 + k] * w;
      }
      float* rr = red + kg * 288 + cn;
      rr[0] = a0; rr[32] = a1; rr[64] = a2; rr[96] = a3; rr[128] = a4; rr[160] = a5; rr[192] = a6; rr[224] = a7; rr[256] = a8;
      __syncthreads();
      for (int e = tid; e < 288; e += 256) {
        float s = 0.f;
#pragma unroll
        for (int g8 = 0; g8 < 8; ++g8) s += red[g8 * 288 + e];
        const int v = e >> 5, n = cg_ * 32 + (e & 31);
        p.mod[((size_t)l * 9 + v) * 6144 + n] = s + p.in[5][l * 6144 + n];
      }
    } else {
      for (int e = tid; e < 1024; e += 256) {
        const int pos = e >> 3, f = e & 7;
        const float inv = (f == 0) ? 1.0f : (f == 1) ? 0.31622776601683794f : (f == 2) ? 0.1f : (f == 3) ? 0.031622776601683794f
                        : (f == 4) ? 0.01f : (f == 5) ? 0.0031622776601683794f : (f == 6) ? 0.001f : 0.00031622776601683794f;
        const float ang = (float)pos * inv;
        float s, c; sincos_f(ang, s, c);
        p.rope[e * 2] = c; p.rope[e * 2 + 1] = s;
      }
    }
  });
}

__device__ void phase_norm(const Params& p, int l, int g, int which, int* ctr) {
  const int nitems = (which == 1 && l == 1) ? NBG * SEQ / 16 : RG / 16;
  const float* gam = (which == 0 ? p.in[6] : p.in[20]) + l * DM;
  const int shoff = which == 0 ? 0 : 3072, scoff = which == 0 ? 1024 : 4096;
  const int from_input = (which == 0 && l == 0);
  for (int it = blockIdx.x; it < nitems; it += gridDim.x) {
    const int lane = TIDX & 63, wid = TIDX >> 6;
    const int r0 = it * 16 + wid * 4;
    const float* xr = xsrc_row_ptr(p, g, r0, from_input);
    const float* mrow = p.mod + ((size_t)l * 9 + mod_index(p, g, r0)) * 6144;
    float4 v[4][4], gg[4], sh[4], sc[4];
#pragma unroll
    for (int rr = 0; rr < 4; ++rr)
#pragma unroll
      for (int i = 0; i < 4; ++i) v[rr][i] = *(const float4*)(xr + (size_t)rr * DM + lane * 4 + i * 256);
#pragma unroll
    for (int i = 0; i < 4; ++i) {
      const int c = lane * 4 + i * 256;
      gg[i] = *(const float4*)(gam + c); sh[i] = *(const float4*)(mrow + shoff + c); sc[i] = *(const float4*)(mrow + scoff + c);
    }
#pragma unroll
    for (int rr = 0; rr < 4; ++rr) {
      float ss = 0.f;
#pragma unroll
      for (int i = 0; i < 4; ++i)
        ss += v[rr][i].x * v[rr][i].x + v[rr][i].y * v[rr][i].y + v[rr][i].z * v[rr][i].z + v[rr][i].w * v[rr][i].w;
      ss = wave_sum(ss);
      const float rstd = rsqrtf(ss * (1.f / 1024.f) + EPS);
#pragma unroll
      for (int i = 0; i < 4; ++i) {
        const int c = lane * 4 + i * 256;
        uint2 o;
        o.x = pack2(v[rr][i].x * rstd * gg[i].x * (1.f + sc[i].x) + sh[i].x, v[rr][i].y * rstd * gg[i].y * (1.f + sc[i].y) + sh[i].y);
        o.y = pack2(v[rr][i].z * rstd * gg[i].z * (1.f + sc[i].z) + sh[i].z, v[rr][i].w * rstd * gg[i].w * (1.f + sc[i].w) + sh[i].w);
        st_nt(p.h + (size_t)(r0 + rr) * DM + c, o);
      }
    }
  }
}

__device__ void phase_proj(const Params& p, int l, int* ctr, bool first) {
  const int MT = RG / 128, NT = INWP / 128;
  const u16* W = p.wt + (size_t)l * W_LAYER + W_IN;
  const int ndef = first ? P0_DEFER : 0;
  run_q8(ctr, [=](int q_) { return ((ndef - q_ + 7) >> 3) + (mlo(q_ + 1, MT) - mlo(q_, MT)) * NT; }, [&](int q_, int jq_) {
    const int nd = (ndef - q_ + 7) >> 3;
    if (jq_ < nd) { conv_item(p, P0_EARLY + QA_ID(q_, jq_)); return; }
    const int j_ = jq_ - nd;
    int mt, nt; tile_order(j_, mlo(q_ + 1, MT) - mlo(q_, MT), NT, mt, nt); mt += mlo(q_, MT);
    f32x4 acc[4][4];
    gemm_core<4>(p.h + (size_t)mt * 128 * DM, DM, W + (size_t)nt * 128 * DM, DM, DM, acc);
    EPI_VARS
    uint2 o[4][4];
#pragma unroll
    for (int wi = 0; wi < 4; ++wi)
#pragma unroll
      for (int xi = 0; xi < 4; ++xi) {
        o[wi][xi].x = pack2(acc[wi][xi][0], acc[wi][xi][1]); o[wi][xi].y = pack2(acc[wi][xi][2], acc[wi][xi][3]);
      }
    if (nt * 128 + wc_ * 64 < INW)
      store_tile_bf16<4>(o, p.proj + (size_t)(mt * 128 + wr_ * 64) * INW + nt * 128 + wc_ * 64, INW);
  });
}

__device__ void postproj_rows(const Params& p, int l, int it) {
  const int lane = TIDX & 63, wid = TIDX >> 6;
  const float* scw = p.in[15] + (size_t)l * 3 * 512;
  for (int rr = 0; rr < 4; ++rr) {
    const int r = it * 16 + wid * 4 + rr;
    int bl, pos, isctx; rowinfo(r, NBG, bl, pos, isctx);
    const u16* pr = p.proj + (size_t)r * INW;
    const int Lr = isctx ? CTXL : SEQ;
    const int c0 = lane * 8;
    const uint2 u_cq = *(const uint2*)(pr + C_CQ + lane * 4);
    const unsigned u_ckv = *(const unsigned*)(pr + C_CKV + lane * 2);
    const u16 u_kr = pr[C_KR + (lane & 31)];
    const uint4 sb = *(const uint4*)(pr + C_SB + c0);
    const uint4 sc1 = *(const uint4*)(pr + C_SC + c0);
    const uint4 sx1 = *(const uint4*)(pr + C_SX + c0);
    uint4 sc0 = make_uint4(0, 0, 0, 0), sx0 = sc0, sc2 = sc0, sx2 = sc0;
    if (pos > 0) { sc0 = *(const uint4*)(pr - INW + C_SC + c0); sx0 = *(const uint4*)(pr - INW + C_SX + c0); }
    if (pos < Lr - 1) { sc2 = *(const uint4*)(pr + INW + C_SC + c0); sx2 = *(const uint4*)(pr + INW + C_SX + c0); }
    {
      const uint2 u = u_cq;
      const float a = bflo(u.x), b = bfhi(u.x), c = bflo(u.y), d = bfhi(u.y);
      float ss = wave_sum(a * a + b * b + c * c + d * d);
      if (lane == 0) p.rstdq[r] = rsqrtf(ss * (1.f / 256.f) + EPS);
    }
    {
      const unsigned u = u_ckv;
      const float a = bflo(u), b = bfhi(u);
      float ss = wave_sum(a * a + b * b);
      if (lane == 0) p.rstdkv[r] = rsqrtf(ss * (1.f / 128.f) + EPS);
    }
    {
      const int idx = lane & 31;
      const float val = bf2f(u_kr);
      const float partner = xor_lane<8>(val);
      float o = val;
      if (!isctx) {
        const int axis = idx >> 4, half = (idx >> 3) & 1, f = idx & 7;
        const int pa = axis ? (pos & 63) : (pos >> 6);
        const float c = p.rope[(pa * 8 + f) * 2], s = p.rope[(pa * 8 + f) * 2 + 1];
        o = half ? (val * c + partner * s) : (val * c - partner * s);
      }
      const int j = isctx ? SEQ + pos : pos;
      const u16 ob = f2bf(o);
      if (lane < 32) {
#pragma unroll
        for (int hd = 0; hd < 8; ++hd)
          p.kf[((size_t)(bl * 8 + hd) * NKEY + j) * 96 + 64 + idx] = ob;
      }
    }
    {
      const float4 w0a = *(const float4*)(scw + c0), w0b = *(const float4*)(scw + c0 + 4);
      const float4 w1a = *(const float4*)(scw + 512 + c0), w1b = *(const float4*)(scw + 512 + c0 + 4);
      const float4 w2a = *(const float4*)(scw + 1024 + c0), w2b = *(const float4*)(scw + 1024 + c0 + 4);
      uint4 o;
#define UC2(SBW, A0, X0, A1, X1, A2, X2, W0L, W0H, W1L, W1H, W2L, W2H) \
      pack2(bflo(SBW) * (W0L * bflo(A0) * bflo(X0) + W1L * bflo(A1) * bflo(X1) + W2L * bflo(A2) * bflo(X2)), \
            bfhi(SBW) * (W0H * bfhi(A0) * bfhi(X0) + W1H * bfhi(A1) * bfhi(X1) + W2H * bfhi(A2) * bfhi(X2)))
      o.x = UC2(sb.x, sc0.x, sx0.x, sc1.x, sx1.x, sc2.x, sx2.x, w0a.x, w0a.y, w1a.x, w1a.y, w2a.x, w2a.y);
      o.y = UC2(sb.y, sc0.y, sx0.y, sc1.y, sx1.y, sc2.y, sx2.y, w0a.z, w0a.w, w1a.z, w1a.w, w2a.z, w2a.w);
      o.z = UC2(sb.z, sc0.z, sx0.z, sc1.z, sx1.z, sc2.z, sx2.z, w0b.x, w0b.y, w1b.x, w1b.y, w2b.x, w2b.y);
      o.w = UC2(sb.w, sc0.w, sx0.w, sc1.w, sx1.w, sc2.w, sx2.w, w0b.z, w0b.w, w1b.z, w1b.w, w2b.z, w2b.w);
#undef UC2
      st_nt(p.uc + (size_t)r * 512 + c0, o);
    }
  }
}

__device__ __forceinline__ float logsig16(float z) {
  return (fminf(z, 0.f) - __logf(1.f + __expf(-fabsf(z)))) * (1.f / 16.f);
}

__device__ void gla_prep(const Params& p, int l, int it) {
  const int tid = TIDX, lane = tid & 63, wid = tid >> 6;
  const int bl = it / (NCHUNK * 4), rem = it % (NCHUNK * 4), cidx = rem >> 2, h = rem & 3;
  const int r0 = chunk_row(bl, cidx, NBG);
  float* lr = (float*)smem;
  float* tot = (float*)(smem + 8192);
  u16* vT = (u16*)(smem + 10752);
  u16* kTf = (u16*)(smem + 29184);
  u16* kTb = (u16*)(smem + 38400);
  u16* qraw = (u16*)(smem + 47616);
  u16* kraw = (u16*)(smem + 55808);
  {
    const int t = tid >> 2, c8 = (tid & 3) * 8;
    const uint4 u = *(const uint4*)(p.proj + (size_t)(r0 + t) * INW + C_ALR + c8);
    float* d = lr + t * 32 + c8;
    d[0] = bflo(u.x); d[1] = bfhi(u.x); d[2] = bflo(u.y); d[3] = bfhi(u.y);
    d[4] = bflo(u.z); d[5] = bfhi(u.z); d[6] = bflo(u.w); d[7] = bfhi(u.w);
    const int dvc = (tid & 3) * 32;
    const u16* vp = p.proj + (size_t)(r0 + t) * INW + C_VA + h * 128 + dvc;
    const int c16 = (tid & 3) * 16;
    const u16* qp = p.proj + (size_t)(r0 + t) * INW + C_QA + h * 64 + c16;
    const uint4 q0 = *(const uint4*)qp, q1 = *(const uint4*)(qp + 8);
    const uint4 k0 = *(const uint4*)(qp + (C_KA - C_QA)), k1 = *(const uint4*)(qp + (C_KA - C_QA) + 8);
    *(uint4*)(qraw + t * 64 + c16) = q0; *(uint4*)(qraw + t * 64 + c16 + 8) = q1;
    *(uint4*)(kraw + t * 64 + c16) = k0; *(uint4*)(kraw + t * 64 + c16 + 8) = k1;
#pragma unroll
    for (int i = 0; i < 4; ++i) {
      const uint4 vv = *(const uint4*)(vp + i * 8);
      u16* dst = vT + (size_t)(dvc + i * 8) * 72 + t;
      dst[0] = (u16)(vv.x & 0xffff); dst[72] = (u16)(vv.x >> 16);
      dst[144] = (u16)(vv.y & 0xffff); dst[216] = (u16)(vv.y >> 16);
      dst[288] = (u16)(vv.z & 0xffff); dst[360] = (u16)(vv.z >> 16);
      dst[432] = (u16)(vv.w & 0xffff); dst[504] = (u16)(vv.w >> 16);
    }
  }
  __syncthreads();
  const int dk = lane, tg = wid;
  const float* w2f = p.in[8] + ((size_t)(l * 2 + 0) * 16) * 256 + h * 64 + dk;
  const float* w2b = p.in[8] + ((size_t)(l * 2 + 1) * 16) * 256 + h * 64 + dk;
  float wf[16], wb[16];
#pragma unroll
  for (int r = 0; r < 16; ++r) { wf[r] = w2f[r * 256]; wb[r] = w2b[r * 256]; }
  const float biasf = p.in[9][(l * 2 + 0) * 256 + h * 64 + dk];
  const float biasb = p.in[9][(l * 2 + 1) * 256 + h * 64 + dk];
  float pf[16], sbk[16];
#pragma unroll
  for (int i = 0; i < 16; ++i) {
    const float* lrow = lr + (tg * 16 + i) * 32;
    float zf = biasf, zb = biasb;
#pragma unroll
    for (int r = 0; r < 16; ++r) { zf += lrow[r] * wf[r]; zb += lrow[16 + r] * wb[r]; }
    pf[i] = logsig16(zf); sbk[i] = logsig16(zb);
  }
#pragma unroll
  for (int i = 1; i < 16; ++i) pf[i] += pf[i - 1];
#pragma unroll
  for (int i = 14; i >= 0; --i) sbk[i] += sbk[i + 1];
  tot[tg * 64 + dk] = pf[15];
  tot[256 + tg * 64 + dk] = sbk[0];
  __syncthreads();
  float offf = 0.f, offb = 0.f, bfl = 0.f, bb0 = 0.f;
#pragma unroll
  for (int g4 = 0; g4 < 4; ++g4) {
    const float a = tot[g4 * 64 + dk], b = tot[256 + g4 * 64 + dk];
    bfl += a; bb0 += b;
    if (g4 < tg) offf += a;
    if (g4 > tg) offb += b;
  }
  u16* gqf = p.gq;
  u16* gkf = p.gq + (size_t)RG * 256;
  u16* gqb = p.gq + (size_t)RG * 512;
  u16* gkb = p.gq + (size_t)RG * 768;
  unsigned kfp = 0, kbp = 0;
#pragma unroll
  for (int i = 0; i < 16; ++i) {
    const int t = tg * 16 + i;
    const float bfv = offf + pf[i], bbv = offb + sbk[i];
    const float qv = bf2f(qraw[t * 64 + dk]);
    const float kv = bf2f(kraw[t * 64 + dk]);
    const size_t go = (size_t)(r0 + t) * 256 + h * 64 + dk;
    gqf[go] = f2bf(qv * __expf(bfv) * 0.125f);
    gkf[go] = f2bf(kv * __expf(-bfv));
    gqb[go] = f2bf(qv * __expf(bbv) * 0.125f);
    gkb[go] = f2bf(kv * __expf(-bbv));
    const u16 ksf = f2bf(kv * __expf(bfl - bfv));
    const u16 ksb = f2bf(kv * __expf(bb0 - bbv));
    if (i & 1) {
      kfp |= ((unsigned)ksf) << 16; kbp |= ((unsigned)ksb) << 16;
      *(unsigned*)(kTf + dk * 72 + tg * 16 + (i - 1)) = kfp;
      *(unsigned*)(kTb + dk * 72 + tg * 16 + (i - 1)) = kbp;
    } else { kfp = ksf; kbp = ksb; }
  }
  const size_t cb = ((size_t)(bl * NCHUNK + cidx) * 4 + h) * 2;
  if (tg == 0) {
    p.dec[(cb + 0) * 64 + dk] = __expf(bfl);
    p.dec[(cb + 1) * 64 + dk] = __expf(bb0);
  }
  __syncthreads();
  const int l31 = lane & 31, hh = lane >> 5;
  u16* U = p.h;
#pragma unroll
  for (int dir = 0; dir < 2; ++dir) {
    const u16* kT = dir ? kTb : kTf;
#pragma unroll
    for (int dkt = 0; dkt < 2; ++dkt) {
      f32x16 acc;
#pragma unroll
      for (int e = 0; e < 16; ++e) acc[e] = 0.f;
#pragma unroll
      for (int s = 0; s < 4; ++s) {
        const bf16x8 a = *(const bf16x8*)(vT + (32 * wid + l31) * 72 + 16 * s + 8 * hh);
        const bf16x8 b = *(const bf16x8*)(kT + (32 * dkt + l31) * 72 + 16 * s + 8 * hh);
        acc = __builtin_amdgcn_mfma_f32_32x32x16_bf16(a, b, acc, 0, 0, 0);
      }
      u16* up = U + (cb + dir) * 8192;
#pragma unroll
      for (int e = 0; e < 16; ++e) {
        const int dv = 32 * wid + (e & 3) + 8 * (e >> 2) + 4 * hh;
        up[dv * 64 + 32 * dkt + l31] = f2bf(acc[e]);
      }
    }
  }
}

__device__ void phase_postproj(const Params& p, int l, int* ctr) {
  const int n_prep = NBG * NCHUNK * 4, n_rows = RG / 16;
  run_q8(ctr, QA_CNT(n_prep + n_rows), [&](int q_, int j_) {
    const int it = QA_ID(q_, j_);
    if (it < n_prep) gla_prep(p, l, it);
    else postproj_rows(p, l, it - n_prep);
  });
}

__device__ void gla_scan(const Params& p, int it) {
  const int tid = TIDX;
  const int sl = it & 7, dir = (it >> 3) & 1, h = (it >> 4) & 3, bl = it >> 6;
  const int e0 = sl * 1024 + tid * 4;
  const int dk = e0 & 63;
  const u16* U = p.h;
  float z0 = 0.f;
  asm volatile("" : "+v"(z0));
  f32x4 S = {z0, z0, z0, z0};
  for (int s0 = 0; s0 < NCHUNK; s0 += 12) {
    uint2 u4[12]; f32x4 d4[12];
#pragma unroll
    for (int j = 0; j < 12; ++j) {
      const int step = s0 + j;
      const int cidx = dir ? (NCHUNK - 1 - step) : (step < 4 ? 128 + step : step - 4);
      const size_t base = ((size_t)(bl * NCHUNK + cidx) * 4 + h) * 2 + dir;
      u4[j] = *(const uint2*)(U + base * 8192 + e0);
      d4[j] = *(const f32x4*)(p.dec + base * 64 + dk);
    }
#pragma unroll
    for (int j = 0; j < 12; ++j) {
      const int step = s0 + j;
      const int cidx = dir ? (NCHUNK - 1 - step) : (step < 4 ? 128 + step : step - 4);
      const size_t base = ((size_t)(bl * NCHUNK + cidx) * 4 + h) * 2 + dir;
      uint2 o; o.x = pack2(S[0], S[1]); o.y = pack2(S[2], S[3]);
      st_nt(p.ss + base * 8192 + e0, o);
      S = d4[j] * S + f32x4{bflo(u4[j].x), bfhi(u4[j].x), bflo(u4[j].y), bfhi(u4[j].y)};
    }
  }
}

__device__ void q_tile(const Params& p, int l, int t) {
  const int MT = RG / 128;
  const int nt = t / MT, mt = t % MT;
  f32x4 acc[4][4];
  gemm_core<4>(p.proj + (size_t)mt * 128 * INW + C_CQ, INW, p.wt + (size_t)l * W_LAYER + W_UQ + (size_t)nt * 128 * 256, 256, 256, acc);
  EPI_VARS
  const float QS = 0.10206207261596577f * 1.4426950408889634f;
  int bl, pos0, isctx; rowinfo(mt * 128, NBG, bl, pos0, isctx);
  float rsq[4];
  uint2 qo[4][4];
#pragma unroll
  for (int xi = 0; xi < 4; ++xi) rsq[xi] = p.rstdq[mt * 128 + EPI_TR(xi)] * QS;
#pragma unroll
  for (int xi = 0; xi < 4; ++xi) {
    const int tr = EPI_TR(xi), r = mt * 128 + tr, pos = pos0 + tr;
    const float rs = rsq[xi];
#pragma unroll
    for (int wi = 0; wi < 4; ++wi) {
      const int n16 = (nt * 128 + wc_ * 64 + wi * 16) >> 4;
      const int m6 = n16 % 6;
      float v0 = acc[wi][xi][0] * rs, v1 = acc[wi][xi][1] * rs, v2 = acc[wi][xi][2] * rs, v3 = acc[wi][xi][3] * rs;
      if (m6 >= 4 && !isctx) {
        const float p0 = xor_lane<32>(v0), p1 = xor_lane<32>(v1), p2 = xor_lane<32>(v2), p3 = xor_lane<32>(v3);
        const int pa = (m6 == 5) ? (pos & 63) : (pos >> 6);
        const int f0 = (fq_ & 1) * 4;
        const float* rp = p.rope + (pa * 8 + f0) * 2;
        const float4 cs01 = *(const float4*)rp, cs23 = *(const float4*)(rp + 4);
        const float sg = (fq_ >= 2) ? 1.f : -1.f;
        v0 = v0 * cs01.x + sg * p0 * cs01.y;
        v1 = v1 * cs01.z + sg * p1 * cs01.w;
        v2 = v2 * cs23.x + sg * p2 * cs23.y;
        v3 = v3 * cs23.z + sg * p3 * cs23.w;
      }
      qo[wi][xi].x = pack2(v0, v1); qo[wi][xi].y = pack2(v2, v3);
    }
  }
  store_tile_bf16<4>(qo, p.q + (size_t)(mt * 128 + wr_ * 64) * 768 + nt * 128 + wc_ * 64, 768);
}

__device__ void kv_tile(const Params& p, int l, int t) {
  const int MT = RG / 128;
  const int nt = t / MT, mt = t % MT;
  f32x4 acc[4][4];
  gemm_core<4>(p.proj + (size_t)mt * 128 * INW + C_CKV, INW, p.wt + (size_t)l * W_LAYER + W_UKV + (size_t)nt * 128 * 128, 128, 128, acc);
  EPI_VARS
  int bl, pos0, isctx; rowinfo(mt * 128, NBG, bl, pos0, isctx);
  const int j0 = isctx ? SEQ + pos0 : pos0;
  float rskv[4];
#pragma unroll
  for (int xi = 0; xi < 4; ++xi) rskv[xi] = p.rstdkv[mt * 128 + EPI_TR(xi)];
#pragma unroll
  for (int xi = 0; xi < 4; ++xi) {
    const int tr = EPI_TR(xi), r = mt * 128 + tr, j = j0 + tr;
    const float rs = rskv[xi];
#pragma unroll
    for (int wi = 0; wi < 4; ++wi) {
      const int wn = EPI_NN(wi);
      const float v0 = acc[wi][xi][0] * rs, v1 = acc[wi][xi][1] * rs, v2 = acc[wi][xi][2] * rs, v3 = acc[wi][xi][3] * rs;
      if (wc_ == 0) {
        uint2 o; o.x = pack2(v0, v1); o.y = pack2(v2, v3);
        *(uint2*)(p.kf + ((size_t)(bl * 8 + nt) * NKEY + j) * 96 + wn) = o;
      } else {
        u16* vp = p.vt + ((size_t)(bl * 8 + nt) * 64 + (wn - 64)) * NKEY + j;
        vp[0] = f2bf(v0); vp[NKEY] = f2bf(v1); vp[2 * NKEY] = f2bf(v2); vp[3 * NKEY] = f2bf(v3);
      }
    }
  }
}

__device__ void phase_qkv(const Params& p, int l, int* ctr) {
  const int MT = RG / 128;
  const int n_scan = NBG * 64, n_q = MT * 6, n_kv = MT * 8;
  run_q8(ctr, QA_CNT(n_scan + n_q + n_kv), [&](int q_, int j_) {
    const int it = QA_ID(q_, j_);
    if (it < n_scan) gla_scan(p, it);
    else if (it < n_scan + n_q) q_tile(p, l, it - n_scan);
    else kv_tile(p, l, it - n_scan - n_q);
  });
}

__device__ __forceinline__ bf16x8 pack8(const f32x16& a, int o) {
  union { bf16x8 v; unsigned u[4]; } r;
  r.u[0] = pack2(a[o + 0], a[o + 1]); r.u[1] = pack2(a[o + 2], a[o + 3]);
  r.u[2] = pack2(a[o + 4], a[o + 5]); r.u[3] = pack2(a[o + 6], a[o + 7]);
  return r.v;
}
__device__ __forceinline__ bf16x8 ld2x8(const u16* p0) {
  union { bf16x8 v; uint2 u[2]; } r;
  r.u[0] = *(const uint2*)p0; r.u[1] = *(const uint2*)(p0 + 8);
  return r.v;
}

__device__ void attn_item(const Params& p, int it) {
  const int tid = TIDX, lane = tid & 63, wid = tid >> 6, l31 = lane & 31, hh = lane >> 5;
  const int qb = it % 66, bh = it / 66, h = bh & 7, bl = bh >> 3;
  const int r0 = qb < 64 ? bl * SEQ + qb * 128 : NBG * SEQ + bl * CTXL + (qb - 64) * 128;
  const int kt0 = qb < 64 ? 0 : 128;
  const int nkt = NCHUNK - kt0;
  constexpr int KROW = 208, VROW = 144, BUFB = 64 * KROW + 64 * VROW;
  bf16x8 qf[6];
  {
    const u16* qp = p.q + (size_t)(r0 + 32 * wid + l31) * 768 + h * 96 + 8 * hh;
#pragma unroll
    for (int s = 0; s < 6; ++s) qf[s] = *(const bf16x8*)(qp + 16 * s);
  }
  const u16* kbase = p.kf + (size_t)bh * NKEY * 96;
  const u16* vbase = p.vt + (size_t)bh * 64 * NKEY;
  uint4 kr0, kr1, kr2, vr0, vr1;
  const int kdst0 = (tid / 12) * KROW + (tid % 12) * 16;
  const int kdst1 = ((tid + 256) / 12) * KROW + ((tid + 256) % 12) * 16;
  const int kdst2 = ((tid + 512) / 12) * KROW + ((tid + 512) % 12) * 16;
  const int vdst0 = 64 * KROW + (tid >> 3) * VROW + (tid & 7) * 16;
  const int vdst1 = vdst0 + 32 * VROW;
  const int vsrc0 = (tid >> 3) * NKEY + (tid & 7) * 8;
  const int vsrc1 = vsrc0 + 32 * NKEY;
  {
    const u16* kp = kbase + (size_t)kt0 * 64 * 96 + tid * 8;
    kr0 = *(const uint4*)(kp); kr1 = *(const uint4*)(kp + 2048); kr2 = *(const uint4*)(kp + 4096);
    vr0 = *(const uint4*)(vbase + vsrc0 + kt0 * 64); vr1 = *(const uint4*)(vbase + vsrc1 + kt0 * 64);
    *(uint4*)(smem + kdst0) = kr0; *(uint4*)(smem + kdst1) = kr1; *(uint4*)(smem + kdst2) = kr2;
    *(uint4*)(smem + vdst0) = vr0; *(uint4*)(smem + vdst1) = vr1;
  }
  __builtin_amdgcn_s_waitcnt(0x0F70);
  __syncthreads();
  f32x16 oacc[2];
#pragma unroll
  for (int e = 0; e < 16; ++e) { oacc[0][e] = 0.f; oacc[1][e] = 0.f; }
  float m_run = 0.f, l_run = 0.f;
  for (int t = 0; t < nkt; ++t) {
    const int cur = t & 1;
    {
      const int tn = kt0 + min(t + 1, nkt - 1);
      const u16* kp = kbase + (size_t)tn * 64 * 96 + tid * 8;
      kr0 = *(const uint4*)(kp); kr1 = *(const uint4*)(kp + 2048); kr2 = *(const uint4*)(kp + 4096);
      vr0 = *(const uint4*)(vbase + vsrc0 + tn * 64); vr1 = *(const uint4*)(vbase + vsrc1 + tn * 64);
    }
    __builtin_amdgcn_sched_barrier(0);
    const char* Kl = smem + cur * BUFB;
    const char* Vl = Kl + 64 * KROW;
    f32x16 sacc[2];
#pragma unroll
    for (int kb = 0; kb < 2; ++kb) {
#pragma unroll
      for (int e = 0; e < 16; ++e) sacc[kb][e] = -m_run;
#pragma unroll
      for (int s = 0; s < 6; ++s) {
        const bf16x8 a = *(const bf16x8*)(Kl + (32 * kb + l31) * KROW + 32 * s + 16 * hh);
        sacc[kb] = __builtin_amdgcn_mfma_f32_32x32x16_bf16(a, qf[s], sacc[kb], 0, 0, 0);
      }
    }
    float mx = sacc[0][0];
#pragma unroll
    for (int e = 1; e < 16; ++e) mx = fmaxf(mx, sacc[0][e]);
#pragma unroll
    for (int e = 0; e < 16; ++e) mx = fmaxf(mx, sacc[1][e]);
    {
      const unsigned mu = __float_as_uint(mx);
      const auto sw = __builtin_amdgcn_permlane32_swap(mu, mu, false, false);
      mx = fmaxf(__uint_as_float(sw[0]), __uint_as_float(sw[1]));
    }
    if (t == 0 || !__all(mx <= 8.f)) {
      const float d = (t == 0) ? mx : fmaxf(mx, 0.f);
      const float alpha = __builtin_amdgcn_exp2f(-d);
      m_run += d;
      l_run *= alpha;
#pragma unroll
      for (int e = 0; e < 16; ++e) { oacc[0][e] *= alpha; oacc[1][e] *= alpha; sacc[0][e] -= d; sacc[1][e] -= d; }
    }
    float ps = 0.f;
#pragma unroll
    for (int kb = 0; kb < 2; ++kb)
#pragma unroll
      for (int e = 0; e < 16; ++e) { const float pv = __builtin_amdgcn_exp2f(sacc[kb][e]); sacc[kb][e] = pv; ps += pv; }
    l_run += ps;
#pragma unroll
    for (int kb = 0; kb < 2; ++kb)
#pragma unroll
      for (int s2 = 0; s2 < 2; ++s2) {
        const bf16x8 pfr = pack8(sacc[kb], 8 * s2);
#pragma unroll
        for (int dt = 0; dt < 2; ++dt) {
          const bf16x8 a = ld2x8((const u16*)(Vl + (32 * dt + l31) * VROW) + 32 * kb + 16 * s2 + 4 * hh);
          oacc[dt] = __builtin_amdgcn_mfma_f32_32x32x16_bf16(a, pfr, oacc[dt], 0, 0, 0);
        }
      }
    __builtin_amdgcn_sched_barrier(0);
    {
      char* nb = smem + (cur ^ 1) * BUFB;
      *(uint4*)(nb + kdst0) = kr0; *(uint4*)(nb + kdst1) = kr1; *(uint4*)(nb + kdst2) = kr2;
      *(uint4*)(nb + vdst0) = vr0; *(uint4*)(nb + vdst1) = vr1;
    }
    __syncthreads();
  }
  l_run += xor_lane<32>(l_run);
  const float inv = 1.f / l_run;
  u16* op = p.h + (size_t)RG * 512 + (size_t)(r0 + 32 * wid + l31) * 512 + h * 64;
#pragma unroll
  for (int dt = 0; dt < 2; ++dt)
#pragma unroll
    for (int gq_ = 0; gq_ < 4; ++gq_) {
      const int dv0 = 32 * dt + 8 * gq_ + 4 * hh;
      uint2 o;
      o.x = pack2(oacc[dt][4 * gq_ + 0] * inv, oacc[dt][4 * gq_ + 1] * inv);
      o.y = pack2(oacc[dt][4 * gq_ + 2] * inv, oacc[dt][4 * gq_ + 3] * inv);
      *(uint2*)(op + dv0) = o;
    }
}

__device__ void gla_out(const Params& p, int l, int it) {
  const int tid = TIDX, lane = tid & 63, wid = tid >> 6, l31 = lane & 31, hh = lane >> 5;
  const int bl = it / (NCHUNK * 4), rem = it % (NCHUNK * 4), cidx = rem >> 2, h = rem & 3;
  const int r0 = chunk_row(bl, cidx, NBG);
  u16* tiles = (u16*)smem;
  u16* vT = (u16*)(smem + 36864);
  float* part = (float*)(smem + 55296);
  {
    const int t = tid >> 2, c16 = (tid & 3) * 16;
#pragma unroll
    for (int a = 0; a < 4; ++a) {
      const u16* src = p.gq + (size_t)a * RG * 256 + (size_t)(r0 + t) * 256 + h * 64 + c16;
      const uint4 u0 = *(const uint4*)src, u1 = *(const uint4*)(src + 8);
      u16* d = tiles + a * 4608 + t * 72 + c16;
      *(uint4*)d = u0; *(uint4*)(d + 8) = u1;
    }
    const int dvc = (tid & 3) * 32;
    const u16* vp = p.proj + (size_t)(r0 + t) * INW + C_VA + h * 128 + dvc;
#pragma unroll
    for (int i = 0; i < 4; ++i) {
      const uint4 vv = *(const uint4*)(vp + i * 8);
      u16* dst = vT + (size_t)(dvc + i * 8) * 72 + t;
      dst[0] = (u16)(vv.x & 0xffff); dst[72] = (u16)(vv.x >> 16);
      dst[144] = (u16)(vv.y & 0xffff); dst[216] = (u16)(vv.y >> 16);
      dst[288] = (u16)(vv.z & 0xffff); dst[360] = (u16)(vv.z >> 16);
      dst[432] = (u16)(vv.w & 0xffff); dst[504] = (u16)(vv.w >> 16);
    }
  }
  const int itl = wid & 1, dvh = wid >> 1;
  const size_t cb = ((size_t)(bl * NCHUNK + cidx) * 4 + h) * 2;
  bf16x8 sfr[2][2][4];
#pragma unroll
  for (int dir = 0; dir < 2; ++dir)
#pragma unroll
    for (int dt = 0; dt < 2; ++dt)
#pragma unroll
      for (int s4 = 0; s4 < 4; ++s4)
        sfr[dir][dt][s4] = *(const bf16x8*)(p.ss + (cb + dir) * 8192 + (64 * dvh + 32 * dt + l31) * 64 + 16 * s4 + 8 * hh);
  __syncthreads();
  f32x16 oacc[2];
#pragma unroll
  for (int e = 0; e < 16; ++e) { oacc[0][e] = 0.f; oacc[1][e] = 0.f; }
#pragma unroll
  for (int dir = 0; dir < 2; ++dir) {
    const u16* Qt = tiles + (dir * 2) * 4608;
    const u16* Kt = tiles + (dir * 2 + 1) * 4608;
    bf16x8 qfr[4];
#pragma unroll
    for (int s = 0; s < 4; ++s) qfr[s] = *(const bf16x8*)(Qt + (32 * itl + l31) * 72 + 16 * s + 8 * hh);
    f32x16 aacc[2];
#pragma unroll
    for (int jt = 0; jt < 2; ++jt) {
#pragma unroll
      for (int e = 0; e < 16; ++e) aacc[jt][e] = 0.f;
#pragma unroll
      for (int s = 0; s < 4; ++s) {
        const bf16x8 a = *(const bf16x8*)(Kt + (32 * jt + l31) * 72 + 16 * s + 8 * hh);
        aacc[jt] = __builtin_amdgcn_mfma_f32_32x32x16_bf16(a, qfr[s], aacc[jt], 0, 0, 0);
      }
      const int i_tok = 32 * itl + l31;
#pragma unroll
      for (int e = 0; e < 16; ++e) {
        const int j_tok = 32 * jt + (e & 3) + 8 * (e >> 2) + 4 * hh;
        const bool keep = dir ? (j_tok >= i_tok) : (j_tok <= i_tok);
        if (!keep) aacc[jt][e] = 0.f;
      }
    }
#pragma unroll
    for (int dt = 0; dt < 2; ++dt) {
      const int dvrow = 64 * dvh + 32 * dt + l31;
#pragma unroll
      for (int jt = 0; jt < 2; ++jt)
#pragma unroll
        for (int s2 = 0; s2 < 2; ++s2) {
          const bf16x8 pfr = pack8(aacc[jt], 8 * s2);
          const bf16x8 a = ld2x8(vT + dvrow * 72 + 32 * jt + 16 * s2 + 4 * hh);
          oacc[dt] = __builtin_amdgcn_mfma_f32_32x32x16_bf16(a, pfr, oacc[dt], 0, 0, 0);
        }
#pragma unroll
      for (int s = 0; s < 4; ++s) {
        oacc[dt] = __builtin_amdgcn_mfma_f32_32x32x16_bf16(sfr[dir][dt][s], qfr[s], oacc[dt], 0, 0, 0);
      }
    }
  }
  float ss = 0.f;
#pragma unroll
  for (int e = 0; e < 16; ++e) ss += oacc[0][e] * oacc[0][e] + oacc[1][e] * oacc[1][e];
  ss += xor_lane<32>(ss);
  if (hh == 0) part[wid * 32 + l31] = ss;
  __syncthreads();
  const float totss = part[wid * 32 + l31] + part[(wid ^ 2) * 32 + l31];
  const float rstd = rsqrtf(totss * (1.f / 128.f) + EPS);
  const int r = r0 + 32 * itl + l31;
  const float* gam = p.in[10] + l * 512 + h * 128;
  u16* aa = p.h;
#pragma unroll
  for (int dt = 0; dt < 2; ++dt)
#pragma unroll
    for (int gq_ = 0; gq_ < 4; ++gq_) {
      const int dv0 = 64 * dvh + 32 * dt + 8 * gq_ + 4 * hh;
      const uint2 ra = *(const uint2*)(p.proj + (size_t)r * INW + C_RA + h * 128 + dv0);
      const float4 g4 = *(const float4*)(gam + dv0);
      uint2 o;
      o.x = pack2(oacc[dt][4 * gq_ + 0] * rstd * g4.x * silu_f(bflo(ra.x)), oacc[dt][4 * gq_ + 1] * rstd * g4.y * silu_f(bfhi(ra.x)));
      o.y = pack2(oacc[dt][4 * gq_ + 2] * rstd * g4.z * silu_f(bflo(ra.y)), oacc[dt][4 * gq_ + 3] * rstd * g4.w * silu_f(bfhi(ra.y)));
      *(uint2*)(aa + (size_t)r * 512 + h * 128 + dv0) = o;
    }
}

__device__ void phase_attn(const Params& p, int l, int* ctr) {
  const int nqb = (l == 1) ? 64 : 66, nck = (l == 1) ? 128 : NCHUNK;
  const int per_q = NBG * nqb;
  const int n_gla = NBG * nck * 4;
  run_q8(ctr, [=](int q_) { return per_q + ((n_gla - q_ + 7) >> 3); }, [&](int q_, int j_) {
    if (j_ < per_q) attn_item(p, ((j_ / nqb) * 8 + q_) * 66 + (j_ % nqb));
    else {
      const int gi = QA_ID(q_, j_ - per_q);
      gla_out(p, l, (gi / (nck * 4)) * (NCHUNK * 4) + gi % (nck * 4));
    }
  });
}

__device__ void phase_merge(const Params& p, int l, int* ctr) {
  const int MT = (l == 1 ? NBG * SEQ / 128 : RG / 128), NT = 8;
  const u16* wl = p.wt + (size_t)l * W_LAYER;
  run_q8(ctr, GEMM_CNT(MT, NT), [&](int q_, int j_) {
    int mt, nt; tile_order(j_, mlo(q_ + 1, MT) - mlo(q_, MT), NT, mt, nt); mt += mlo(q_, MT);
    const int tid = TIDX, lane = tid & 63, wid = tid >> 6;
    const int wr = wid >> 1, wc = wid & 1, fr = lane & 15, fq = lane >> 4;
    f32x4 macc[4][4], acc[4][4];
#pragma unroll
    for (int a = 0; a < 4; ++a)
#pragma unroll
      for (int b = 0; b < 4; ++b) { macc[a][b] = f32x4{0.f, 0.f, 0.f, 0.f}; acc[a][b] = f32x4{0.f, 0.f, 0.f, 0.f}; }
    const int srow = tid >> 3, schunk = (tid & 7) ^ ((tid >> 4) & 7);
    const size_t xo = (size_t)(mt * 128 + srow) * 512 + schunk * 8;
    const size_t wo = (size_t)(nt * 128 + srow) * 512 + schunk * 8;
    const u16* xg0 = p.h + xo;
    const u16* xg1 = p.h + (size_t)RG * 512 + xo;
    const u16* xg2 = p.uc + xo;
    const u16* wg0 = wl + W_BRA + wo;
    const u16* wg1 = wl + W_BRB + wo;
    const u16* wg2 = wl + W_BRC + wo;
    const int g = fr >> 1;
    const int lo0 = fr * 128 + ((fq ^ g) << 4), lo1 = fr * 128 + (((fq ^ g) ^ 4) << 4);
    const char* xb = smem + wr * 8192;
    const char* wb = smem + 16384 + wc * 8192;
    char* sdst = smem + tid * 16;
    const u16* gbase = p.proj + (size_t)(mt * 128 + wr * 64 + fr) * INW + C_GATE + nt * 128 + wc * 64 + fq * 4;
    __syncthreads();
#pragma unroll
    for (int i = 0; i < 4; ++i) {
      glds16(xg0 + i * (32 * 512), sdst + i * 4096);
      glds16(wg0 + i * (32 * 512), sdst + 16384 + i * 4096);
    }
    for (int kt = 0; kt < 24; ++kt) {
      asm volatile("s_waitcnt vmcnt(0)" ::: "memory");
      __syncthreads();
      const int cb = (kt & 1) * 32768;
      if (kt + 1 < 24) {
        const int nbr = (kt + 1) >> 3, ko = ((kt + 1) & 7) * 64, nb = 32768 - cb;
        const u16* xg = (nbr == 0 ? xg0 : nbr == 1 ? xg1 : xg2) + ko;
        const u16* wg = (nbr == 0 ? wg0 : nbr == 1 ? wg1 : wg2) + ko;
#pragma unroll
        for (int i = 0; i < 4; ++i) {
          glds16(xg + i * (32 * 512), sdst + nb + i * 4096);
          glds16(wg + i * (32 * 512), sdst + nb + 16384 + i * 4096);
        }
      }
      const bool last = (kt & 7) == 7;
      const int br = kt >> 3;
      uint2 gts[4][4];
      if (last) {
#pragma unroll
        for (int wi = 0; wi < 4; ++wi)
#pragma unroll
          for (int xi = 0; xi < 4; ++xi) gts[wi][xi] = *(const uint2*)(gbase + (size_t)xi * 16 * INW + wi * 16 + br * 1024);
      }
#pragma unroll
      for (int k = 0; k < 2; ++k) {
        const int lo = k ? lo1 : lo0;
        bf16x8 wf[4], xf[4];
#pragma unroll
        for (int i = 0; i < 4; ++i) wf[i] = *(const bf16x8*)(wb + cb + i * 2048 + lo);
#pragma unroll
        for (int i = 0; i < 4; ++i) xf[i] = *(const bf16x8*)(xb + cb + i * 2048 + lo);
#pragma unroll
        for (int wi = 0; wi < 4; ++wi)
#pragma unroll
          for (int xi = 0; xi < 4; ++xi)
            acc[wi][xi] = __builtin_amdgcn_mfma_f32_16x16x32_bf16(wf[wi], xf[xi], acc[wi][xi], 0, 0, 0);
      }
      if (last) {
#pragma unroll
        for (int wi = 0; wi < 4; ++wi)
#pragma unroll
          for (int xi = 0; xi < 4; ++xi) {
            const uint2 gt = gts[wi][xi];
            macc[wi][xi][0] += sigmoid_f(bflo(gt.x)) * acc[wi][xi][0];
            macc[wi][xi][1] += sigmoid_f(bfhi(gt.x)) * acc[wi][xi][1];
            macc[wi][xi][2] += sigmoid_f(bflo(gt.y)) * acc[wi][xi][2];
            macc[wi][xi][3] += sigmoid_f(bfhi(gt.y)) * acc[wi][xi][3];
            acc[wi][xi] = f32x4{0.f, 0.f, 0.f, 0.f};
          }
      }
    }
    uint2 o[4][4];
#pragma unroll
    for (int wi = 0; wi < 4; ++wi)
#pragma unroll
      for (int xi = 0; xi < 4; ++xi) {
        o[wi][xi].x = pack2(macc[wi][xi][0], macc[wi][xi][1]); o[wi][xi].y = pack2(macc[wi][xi][2], macc[wi][xi][3]);
      }
    store_tile_bf16<4>(o, p.m + (size_t)(mt * 128 + wr * 64) * DM + nt * 128 + wc * 64, DM);
  });
}

__device__ void phase_resid(const Params& p, int l, int g, int which, int* ctr) {
  const int MT = (l == 1 ? NBG * SEQ / 128 : RG / 128), NT = 8;
  const u16* wl = p.wt + (size_t)l * W_LAYER;
  const u16* X = which == 0 ? p.m : p.proj + (size_t)RG * DFF;
  const int ldx = which == 0 ? DM : DFF, K = which == 0 ? DM : DFF;
  const u16* W = wl + (which == 0 ? W_O : W_DN);
  const int goff = which == 0 ? 2048 : 5120;
  const int from_input = (which == 0 && l == 0);
  run_q8(ctr, GEMM_CNT(MT, NT), [&](int q_, int j_) {
    int mt, nt; tile_order(j_, mlo(q_ + 1, MT) - mlo(q_, MT), NT, mt, nt); mt += mlo(q_, MT);
    f32x4 acc[4][4];
    gemm_core<4>(X + (size_t)mt * 128 * ldx, ldx, W + (size_t)nt * 128 * K, K, K, acc);
    EPI_VARS
    const float* mrow = p.mod + ((size_t)l * 9 + mod_index(p, g, mt * 128)) * 6144 + goff + nt * 128 + wc_ * 64;
    __syncthreads();
    char* lb = smem + wid_ * 16384;
#pragma unroll
    for (int wi = 0; wi < 4; ++wi)
#pragma unroll
      for (int xi = 0; xi < 4; ++xi) {
        const int r = xi * 16 + fr_, c = wi * 4 + fq_;
        *(f32x4*)(lb + r * 256 + ((c ^ (r & 15)) << 4)) = acc[wi][xi];
      }
    const int c16 = lane_ & 15, rsub = lane_ >> 4;
    const float* xs = xsrc_row_ptr(p, g, mt * 128 + wr_ * 64, from_input) + nt * 128 + wc_ * 64 + c16 * 4;
    float* xd = xrow_ptr(p, g, mt * 128 + wr_ * 64) + nt * 128 + wc_ * 64 + c16 * 4;
    const float4 gv = *(const float4*)(mrow + c16 * 4);
#pragma unroll
    for (int half = 0; half < 2; ++half) {
      float4 xv[8];
#pragma unroll
      for (int it = 0; it < 8; ++it) xv[it] = *(const float4*)(xs + (size_t)((half * 8 + it) * 4 + rsub) * DM);
#pragma unroll
      for (int it = 0; it < 8; ++it) {
        const int row = (half * 8 + it) * 4 + rsub;
        const f32x4 a = *(const f32x4*)(lb + row * 256 + ((c16 ^ (row & 15)) << 4));
        float4 o;
        o.x = xv[it].x + gv.x * a[0]; o.y = xv[it].y + gv.y * a[1]; o.z = xv[it].z + gv.z * a[2]; o.w = xv[it].w + gv.w * a[3];
        *(float4*)(xd + (size_t)row * DM) = o;
      }
    }
  });
}

__device__ void phase_gate(const Params& p, int l, int* ctr) {
  const int MT = (l == 1 ? NBG * SEQ / 128 : RG / 128), NT = 22;
  const u16* W = p.wt + (size_t)l * W_LAYER + W_GU;
  run_q8(ctr, GEMM_CNT(MT, NT), [&](int q_, int j_) {
    int mt, nt; tile_order(j_, mlo(q_ + 1, MT) - mlo(q_, MT), NT, mt, nt); mt += mlo(q_, MT);
    f32x4 acc[4][4];
    gemm_core<4>(p.h + (size_t)mt * 128 * DM, DM, W + (size_t)nt * 128 * DM, DM, DM, acc);
    EPI_VARS
    uint2 o[4][4];
#pragma unroll
    for (int wi = 0; wi < 4; ++wi)
#pragma unroll
      for (int xi = 0; xi < 4; ++xi) {
        o[wi][xi].x = pack2(acc[wi][xi][0], acc[wi][xi][1]); o[wi][xi].y = pack2(acc[wi][xi][2], acc[wi][xi][3]);
      }
    store_tile_bf16<4>(o, p.proj + (size_t)(mt * 128 + wr_ * 64) * DFF + nt * 128 + wc_ * 64, DFF);
  });
}

struct ActIn { uint4 g0, g1, g2, uu; float4 w0a, w0b, w1a, w1b, w2a, w2b, ba, bb; };
__device__ __forceinline__ void act_load(ActIn& a, const u16* G, const u16* UP, const float* cw, const float* cb, int r, int c0) {
  int bl, pos, isctx; rowinfo(r, NBG, bl, pos, isctx);
  const int L = isctx ? CTXL : SEQ;
  const u16* gp = G + (size_t)r * DFF + c0;
  a.g1 = *(const uint4*)gp;
  a.g0 = make_uint4(0, 0, 0, 0); a.g2 = a.g0;
  if (pos > 0) a.g0 = *(const uint4*)(gp - DFF);
  if (pos < L - 1) a.g2 = *(const uint4*)(gp + DFF);
  a.uu = *(const uint4*)(UP + (size_t)r * DFF + c0);
  a.w0a = *(const float4*)(cw + c0); a.w0b = *(const float4*)(cw + c0 + 4);
  a.w1a = *(const float4*)(cw + DFF + c0); a.w1b = *(const float4*)(cw + DFF + c0 + 4);
  a.w2a = *(const float4*)(cw + 2 * DFF + c0); a.w2b = *(const float4*)(cw + 2 * DFF + c0 + 4);
  a.ba = *(const float4*)(cb + c0); a.bb = *(const float4*)(cb + c0 + 4);
}
__device__ __forceinline__ uint4 act_compute(const ActIn& a) {
  uint4 o;
#define ACT2(G0, G1, G2, UU, W0L, W0H, W1L, W1H, W2L, W2H, BL, BH) \
  pack2(silu_f(W0L * bflo(G0) + W1L * bflo(G1) + W2L * bflo(G2) + BL) * bflo(UU), \
        silu_f(W0H * bfhi(G0) + W1H * bfhi(G1) + W2H * bfhi(G2) + BH) * bfhi(UU))
  o.x = ACT2(a.g0.x, a.g1.x, a.g2.x, a.uu.x, a.w0a.x, a.w0a.y, a.w1a.x, a.w1a.y, a.w2a.x, a.w2a.y, a.ba.x, a.ba.y);
  o.y = ACT2(a.g0.y, a.g1.y, a.g2.y, a.uu.y, a.w0a.z, a.w0a.w, a.w1a.z, a.w1a.w, a.w2a.z, a.w2a.w, a.ba.z, a.ba.w);
  o.z = ACT2(a.g0.z, a.g1.z, a.g2.z, a.uu.z, a.w0b.x, a.w0b.y, a.w1b.x, a.w1b.y, a.w2b.x, a.w2b.y, a.bb.x, a.bb.y);
  o.w = ACT2(a.g0.w, a.g1.w, a.g2.w, a.uu.w, a.w0b.z, a.w0b.w, a.w1b.z, a.w1b.w, a.w2b.z, a.w2b.w, a.bb.z, a.bb.w);
#undef ACT2
  return o;
}

__device__ void phase_upact(const Params& p, int l, int* ctr) {
  const int MT = (l == 1 ? NBG * SEQ / 128 : RG / 128), NT = 22;
  const u16* W = p.wt + (size_t)l * W_LAYER + W_GU + (size_t)DFF * 1024;
  const float* cw = p.in[23] + (size_t)l * 3 * DFF;
  const float* cb = p.in[24] + (size_t)l * DFF;
  const u16* G = p.proj;
  u16* ACT = p.proj + (size_t)RG * DFF;
  run_q8(ctr, GEMM_CNT(MT, NT), [&](int q_, int j_) {
    int mt, nt; tile_order(j_, mlo(q_ + 1, MT) - mlo(q_, MT), NT, mt, nt); mt += mlo(q_, MT);
    f32x4 acc[4][4];
    gemm_core<4>(p.h + (size_t)mt * 128 * DM, DM, W + (size_t)nt * 128 * DM, DM, DM, acc);
    EPI_VARS
    char* lb = smem + wid_ * 8192;
#pragma unroll
    for (int wi = 0; wi < 4; ++wi)
#pragma unroll
      for (int xi = 0; xi < 4; ++xi) {
        uint2 o; o.x = pack2(acc[wi][xi][0], acc[wi][xi][1]); o.y = pack2(acc[wi][xi][2], acc[wi][xi][3]);
        const int r = xi * 16 + fr_, c = wi * 2 + (fq_ >> 1);
        *(uint2*)(lb + r * 128 + ((c ^ (r & 7)) << 4) + (fq_ & 1) * 8) = o;
      }
    const int c8 = lane_ & 7, rsub = lane_ >> 3;
    const int n = nt * 128 + wc_ * 64 + c8 * 8;
    const int rowbase = mt * 128 + wr_ * 64;
    int bl, pos0, isctx; rowinfo(rowbase, NBG, bl, pos0, isctx);
    const int L = isctx ? CTXL : SEQ;
    ActIn a;
    a.w0a = *(const float4*)(cw + n); a.w0b = *(const float4*)(cw + n + 4);
    a.w1a = *(const float4*)(cw + DFF + n); a.w1b = *(const float4*)(cw + DFF + n + 4);
    a.w2a = *(const float4*)(cw + 2 * DFF + n); a.w2b = *(const float4*)(cw + 2 * DFF + n + 4);
    a.ba = *(const float4*)(cb + n); a.bb = *(const float4*)(cb + n + 4);
#pragma unroll
    for (int half = 0; half < 2; ++half) {
      uint4 g0[4], g1[4], g2[4];
#pragma unroll
      for (int it = 0; it < 4; ++it) {
        const int row = (half * 4 + it) * 8 + rsub, pos = pos0 + row;
        const u16* gp = G + (size_t)(rowbase + row) * DFF + n;
        g1[it] = *(const uint4*)gp;
        g0[it] = make_uint4(0, 0, 0, 0); g2[it] = g0[it];
        if (pos > 0) g0[it] = *(const uint4*)(gp - DFF);
        if (pos < L - 1) g2[it] = *(const uint4*)(gp + DFF);
      }
#pragma unroll
      for (int it = 0; it < 4; ++it) {
        const int row = (half * 4 + it) * 8 + rsub;
        a.g0 = g0[it]; a.g1 = g1[it]; a.g2 = g2[it];
        a.uu = *(const uint4*)(lb + row * 128 + ((c8 ^ (row & 7)) << 4));
        st_nt(ACT + (size_t)(rowbase + row) * DFF + n, act_compute(a));
      }
    }
  });
}

__device__ void phase_final(const Params& p, int* ctr) {
  const int nitems = NBATCH * SEQ / 16;
  const float* gam = p.in[26];
  for (int it = blockIdx.x; it < nitems; it += gridDim.x) {
    const int lane = TIDX & 63, wid = TIDX >> 6;
    float* xr = p.out + ((size_t)it * 16 + wid * 4) * DM;
    float4 v[4][4], gg[4];
#pragma unroll
    for (int rr = 0; rr < 4; ++rr)
#pragma unroll
      for (int i = 0; i < 4; ++i) v[rr][i] = *(const float4*)(xr + (size_t)rr * DM + lane * 4 + i * 256);
#pragma unroll
    for (int i = 0; i < 4; ++i) gg[i] = *(const float4*)(gam + lane * 4 + i * 256);
#pragma unroll
    for (int rr = 0; rr < 4; ++rr) {
      float ss = 0.f;
#pragma unroll
      for (int i = 0; i < 4; ++i)
        ss += v[rr][i].x * v[rr][i].x + v[rr][i].y * v[rr][i].y + v[rr][i].z * v[rr][i].z + v[rr][i].w * v[rr][i].w;
      ss = wave_sum(ss);
      const float rstd = rsqrtf(ss * (1.f / 1024.f) + EPS);
#pragma unroll
      for (int i = 0; i < 4; ++i) {
        float4 o; o.x = v[rr][i].x * rstd * gg[i].x; o.y = v[rr][i].y * rstd * gg[i].y; o.z = v[rr][i].z * rstd * gg[i].z; o.w = v[rr][i].w * rstd * gg[i].w;
        st_nt(xr + (size_t)rr * DM + lane * 4 + i * 256, o);
      }
    }
  }
}

#define XB_TMO      128
#define XB_XCNT(j)  (256  + 64 * (j))
#define XB_XSUB(j)  (1280 + 64 * (j))
#define XB_XGEN(j)  (2304 + 64 * (j))
#define XB_TOP      3328
#define XB_TOPGEN   3392
#define XCD_BAR_WORDS 3456
#define XB_SPIN_CAP (1u << 22)
#define LAS __attribute__((address_space(3)))
__device__ __forceinline__ unsigned xb_ld(unsigned* p)              { return __hip_atomic_load(p, __ATOMIC_RELAXED, __HIP_MEMORY_SCOPE_AGENT); }
__device__ __forceinline__ unsigned xb_add(unsigned* p, unsigned v) { return __hip_atomic_fetch_add(p, v, __ATOMIC_RELAXED, __HIP_MEMORY_SCOPE_AGENT); }
__device__ __forceinline__ unsigned xb_xcc_id() { return (unsigned)__builtin_amdgcn_s_getreg((3 << 11) | 20) & 0xFu; }
#define XB_SPIN(cond, bar) do { unsigned _sp = 0; while (cond) { __builtin_amdgcn_s_sleep(1); \
    if ((++_sp & 255u) == 0u) { if (xb_ld(&(bar)[XB_TMO])) break; if (_sp > XB_SPIN_CAP) { atomicAdd(&(bar)[XB_TMO], 1u); break; } } } } while (0)
struct XcdBarrier { unsigned* bar; unsigned x; volatile LAS unsigned* st; };
__device__ __forceinline__ XcdBarrier xcd_barrier_post(unsigned* bar, volatile LAS unsigned* st) {
  XcdBarrier b; b.bar = bar; b.x = xb_xcc_id(); b.st = st;
  if (threadIdx.x == 0) (void)xb_add(&bar[XB_XCNT(b.x)], 1u);
  return b;
}
__device__ __forceinline__ void xcd_barrier_complete(unsigned* bar, unsigned x, unsigned& nloc, unsigned& nx) {
  const unsigned G = gridDim.x * gridDim.y * gridDim.z;
  unsigned sum, cnt, mine, sp = 0u;
  for (;;) {
    sum = 0u; cnt = 0u; mine = 0u;
#pragma unroll
    for (unsigned j = 0; j < 16; ++j) { const unsigned c = xb_ld(&bar[XB_XCNT(j)]); sum += c; cnt += (c > 0u) ? 1u : 0u; mine = (j == x) ? c : mine; }
    if (sum == G) break;
    __builtin_amdgcn_s_sleep(1);
    if ((++sp & 255u) == 0u) { if (xb_ld(&bar[XB_TMO])) break; if (sp > XB_SPIN_CAP) { atomicAdd(&bar[XB_TMO], 1u); break; } }
  }
  nloc = mine > 0u ? mine : 1u; nx = cnt > 0u ? cnt : 1u;
}
__device__ __forceinline__ void xcd_barrier(const XcdBarrier& b) {
  asm volatile("s_waitcnt vmcnt(0)" ::: "memory");
  __syncthreads();
  if (threadIdx.x == 0) {
    unsigned* bar = b.bar;
    __builtin_amdgcn_s_waitcnt(0);
    unsigned nloc = b.st[0], nx = b.st[1];
    if (nloc == 0u) { xcd_barrier_complete(bar, b.x, nloc, nx); b.st[0] = nloc; b.st[1] = nx; }
    const unsigned old = xb_add(&bar[XB_XSUB(b.x)], 1u);
    const unsigned gen = old / nloc;
    if (old + 1u == (gen + 1u) * nloc) {
      __builtin_amdgcn_fence(__ATOMIC_RELEASE, "agent");
      asm volatile("s_waitcnt vmcnt(0)" ::: "memory");
      const unsigned og = xb_add(&bar[XB_TOP], 1u);
      const unsigned tg = og / nx;
      if (og + 1u == (tg + 1u) * nx) xb_add(&bar[XB_TOPGEN], 1u);
      else XB_SPIN(xb_ld(&bar[XB_TOPGEN]) == tg, bar);
      __builtin_amdgcn_fence(__ATOMIC_ACQUIRE, "agent");
      xb_add(&bar[XB_XGEN(b.x)], 1u);
      asm volatile("s_waitcnt vmcnt(0)" ::: "memory");
    } else {
      XB_SPIN(xb_ld(&bar[XB_XGEN(b.x)]) == gen, bar);
      __builtin_amdgcn_fence(__ATOMIC_ACQUIRE, "agent");
      asm volatile("s_waitcnt vmcnt(0)" ::: "memory");
    }
  }
  __syncthreads();
}

__device__ void run_phase(const Params& p, int ph, int* ctr) {
  if (ph == 0) { phase0(p, ctr); return; }
  if (ph == NPHASES - 1) { phase_final(p, ctr); return; }
  const int idx = ph - 1, lg = idx / NPH_PER, sub = idx % NPH_PER;
  const int g = lg / 2, l = lg % 2;
  switch (sub) {
    case 0: phase_norm(p, l, g, 0, ctr); break;
    case 1: phase_proj(p, l, ctr, lg == 0); break;
    case 2: phase_postproj(p, l, ctr); break;
    case 3: phase_qkv(p, l, ctr); break;
    case 4: phase_attn(p, l, ctr); break;
    case 5: phase_merge(p, l, ctr); break;
    case 6: phase_resid(p, l, g, 0, ctr); break;
    case 7: phase_norm(p, l, g, 1, ctr); break;
    case 8: phase_gate(p, l, ctr); break;
    case 9: phase_upact(p, l, ctr); break;
    default: phase_resid(p, l, g, 1, ctr); break;
  }
}

__global__ void __launch_bounds__(256, 2) mega_kernel(KArgs ka, int ph_lo, int ph_hi, int coop) {
  Params p;
#pragma unroll
  for (int i = 0; i < 27; ++i) p.in[i] = ka.in[i];
  p.out = ka.out;
  char* ws = ka.ws;
  p.ctr = (int*)(ws + O_CTR); p.mod = (float*)(ws + O_MOD); p.rope = (float*)(ws + O_ROPE); p.xc = (float*)(ws + O_XC);
  p.rstdq = (float*)(ws + O_RSQ); p.rstdkv = (float*)(ws + O_RSKV); p.dec = (float*)(ws + O_DEC); p.wt = (u16*)(ws + O_WT);
  p.proj = (u16*)(ws + O_PROJ); p.h = (u16*)(ws + O_H); p.m = (u16*)(ws + O_M); p.q = (u16*)(ws + O_Q);
  p.kf = (u16*)(ws + O_KF); p.vt = (u16*)(ws + O_VT); p.uc = (u16*)(ws + O_UC); p.gq = (u16*)(ws + O_GQ);
  p.ss = (u16*)(ws + O_SS);
  volatile LAS unsigned* st = (volatile LAS unsigned*)(smem + SLOT_OFF + 64);
  if (threadIdx.x == 0) { st[0] = 0u; st[1] = 0u; }
  __syncthreads();
  XcdBarrier xb;
  xb.bar = (unsigned*)(ws + O_BAR); xb.x = 0; xb.st = st;
  if (coop) xb = xcd_barrier_post((unsigned*)(ws + O_BAR), st);
  for (int ph = ph_lo; ph < ph_hi; ++ph) {
#ifdef PROBE_MASK
    const int nrep = (ph > 0 && ph < NPHASES - 1 && ((PROBE_MASK >> ((ph - 1) % NPH_PER)) & 1)) ? 2 : 1;
#else
    const int nrep = 1;
#endif
    for (int rep = 0; rep < nrep; ++rep) {
      if (rep) xcd_barrier(xb);
      run_phase(p, ph, p.ctr + rep * 512 + ph * 8);
    }
    if (coop && ph + 1 < ph_hi) {
      if (ph == ph_lo) cg::this_grid().sync();
      else xcd_barrier(xb);
    }
  }
}

static inline size_t align_up(size_t v) { return (v + 255) & ~(size_t)255; }

extern "C" void kernel_launch(void* const* d_in, const int* in_sizes, int n_in, void* d_out, int out_size,
                              void* d_ws, size_t ws_size, hipStream_t stream) {
  static int grid_blocks = 0;
  if (!grid_blocks) {
    int dev = 0, cus = 0, per_cu = 0;
    hipGetDevice(&dev);
    hipDeviceGetAttribute(&cus, hipDeviceAttributeMultiprocessorCount, dev);
    hipFuncSetAttribute((const void*)mega_kernel, hipFuncAttributeMaxDynamicSharedMemorySize, LDS_BYTES);
    hipOccupancyMaxActiveBlocksPerMultiprocessor(&per_cu, (const void*)mega_kernel, 256, LDS_BYTES);
    if (per_cu < 1) per_cu = 1;
    if (per_cu > 2) per_cu = 2;
    grid_blocks = cus * per_cu;
  }
  KArgs p{};
  for (int i = 0; i < 27; ++i) p.in[i] = (const float*)d_in[i];
  p.out = (float*)d_out;
  p.ws = (char*)d_ws;
  if (ws_size < WS_END) { fprintf(stderr, "workspace too small: %zu < %zu\n", ws_size, (size_t)WS_END); return; }
  hipMemsetAsync((char*)d_ws + O_CTR, 0, 4096 + XCD_BAR_BYTES, stream);
#if SINGLE_LAUNCH
  int lo = 0, hi = NPHASES, coop = 1;
  void* args[] = {&p, &lo, &hi, &coop};
  hipError_t e = hipLaunchCooperativeKernel((const void*)mega_kernel, dim3(grid_blocks), dim3(256), args, LDS_BYTES, stream);
  if (e != hipSuccess) fprintf(stderr, "cooperative launch failed: %s (grid %d)\n", hipGetErrorString(e), grid_blocks);
#else
  for (int ph = 0; ph < NPHASES; ++ph)
    hipLaunchKernelGGL(mega_kernel, dim3(grid_blocks), dim3(256), LDS_BYTES, stream, p, ph, ph + 1, 0);
#endif
}
```
